# Optimizing an MI355X kernel written in HIP

```python
import math
import jax, jax.numpy as jnp
from jax import lax
import numpy as np

D_MODEL = 1024
BATCH = 4
SEQ = 4096
DEPTH = 2

GRID_W = 64
CTX_LEN = 256

D_S5 = D_MODEL // 4
D_HG = D_MODEL // 4
D_RW = D_MODEL // 2
D_MIX = D_S5 + D_HG + D_RW

S5_H = 16
S5_G = D_S5 // S5_H
S5_P = 64

HG_HEAD = 64
HG_HEADS = D_HG // HG_HEAD
HG_CHUNK = 16

RW_HEAD = 64
RW_HEADS = D_RW // RW_HEAD
RW_W_LORA = 64
RW_A_LORA = 64
RW_G_LORA = 128
RW_COLS = 3 * D_RW + RW_G_LORA + 2 * RW_W_LORA + 2 * RW_A_LORA
RW_GN_EPS = 64e-5

P_IN = D_S5 + 5 * D_HG + RW_COLS

PEER_HEADS = 8
PEER_NKEYS = 128
PEER_N = PEER_NKEYS * PEER_NKEYS
PEER_QDIM = 256
PEER_TOPK = 16
PEER_BLOCK = 128

LN_EPS = 1e-5
RMS_EPS = 1e-6
DEEPNORM_ALPHA = (2.0 * DEPTH) ** 0.25
DEEPNORM_BETA = (8.0 * DEPTH) ** -0.25

kernel_name = 'hybrid_s5_hgrn2_rwkv7_peer_block'


def _f32(t):
    return t.astype(jnp.float32)


def _layer_norm(x, g, b):
    xf = _f32(x)
    mu = jnp.mean(xf, -1, keepdims=True)
    var = jnp.mean(jnp.square(xf - mu), -1, keepdims=True)
    return ((xf - mu) * lax.rsqrt(var + LN_EPS) * _f32(g) + _f32(b)).astype(x.dtype)


def _shift(t, axis, step):
    n = t.shape[axis]
    pad = [(0, 0)] * t.ndim
    if step > 0:
        pad[axis] = (1, 0)
        return lax.slice_in_dim(jnp.pad(t, pad), 0, n, axis=axis)
    pad[axis] = (0, 1)
    return lax.slice_in_dim(jnp.pad(t, pad), 1, n + 1, axis=axis)


def _qshift_grid(s, rows):
    b, l, ch = s.shape
    s4 = s.reshape(b, rows, GRID_W, ch // 4, 4)
    out = jnp.stack([_shift(s4[..., 0], 2, 1), _shift(s4[..., 1], 2, -1),
                     _shift(s4[..., 2], 1, 1), _shift(s4[..., 3], 1, -1)], axis=-1)
    return out.reshape(b, l, ch)


def _qshift_seq(s):
    b, l, ch = s.shape
    s4 = s.reshape(b, l, ch // 4, 4)
    out = jnp.stack([_shift(s4[..., 0], 1, 1), _shift(s4[..., 1], 1, -1),
                     _shift(s4[..., 2], 1, 1), _shift(s4[..., 3], 1, -1)], axis=-1)
    return out.reshape(b, l, ch)


def _s5_discretise(lam_re, lam_im, log_step, b_re, b_im):
    dt = jnp.exp(log_step)[:, None]
    mag = jnp.exp(lam_re * dt)
    ang = lam_im * dt
    lb_re, lb_im = mag * jnp.cos(ang), mag * jnp.sin(ang)
    den = lam_re * lam_re + lam_im * lam_im
    nr, ni = lb_re - 1.0, lb_im
    co_re = (nr * lam_re + ni * lam_im) / den
    co_im = (ni * lam_re - nr * lam_im) / den
    bb_re = co_re[..., None] * b_re - co_im[..., None] * b_im
    bb_im = co_re[..., None] * b_im + co_im[..., None] * b_re
    return lb_re, lb_im, bb_re, bb_im


def _complex_affine_combine(e1, e2):
    a1r, a1i, b1r, b1i = e1
    a2r, a2i, b2r, b2i = e2
    return (a2r * a1r - a2i * a1i, a2r * a1i + a2i * a1r,
            a2r * b1r - a2i * b1i + b2r, a2r * b1i + a2i * b1r + b2i)


def _s5_scan(u, h0, disc, c_re, c_im):
    lb_re, lb_im, bb_re, bb_im = disc
    bu_re = jnp.einsum('blgh,gph->blgp', u, bb_re)
    bu_im = jnp.einsum('blgh,gph->blgp', u, bb_im)
    a_re = jnp.broadcast_to(lb_re, bu_re.shape)
    a_im = jnp.broadcast_to(lb_im, bu_im.shape)
    p_re, p_im, s_re, s_im = lax.associative_scan(
        _complex_affine_combine, (a_re, a_im, bu_re, bu_im), axis=1)
    h_re, h_im = h0[0][:, None], h0[1][:, None]
    s_re = s_re + p_re * h_re - p_im * h_im
    s_im = s_im + p_re * h_im + p_im * h_re
    y = jnp.einsum('blgp,ghp->blgh', s_re, c_re) - jnp.einsum('blgp,ghp->blgh', s_im, c_im)
    return y, (s_re[:, -1], s_im[:, -1])


def _s5_mixer(uc, ux, lam_re, lam_im, log_step, b_re, b_im, c_re, c_im, d_skip, glu_w, glu_b):
    disc = [_s5_discretise(_f32(lam_re[d]), _f32(lam_im[d]), _f32(log_step[d]),
                           _f32(b_re[d]), _f32(b_im[d])) for d in range(2)]
    c_re, c_im = _f32(c_re), _f32(c_im)

    def run(u, h0s):
        ug = u.reshape(u.shape[0], u.shape[1], S5_G, S5_H)
        y_f, h_f = _s5_scan(ug, h0s[0], disc[0], c_re[0], c_im[0])
        y_b, h_b = _s5_scan(jnp.flip(ug, 1), h0s[1], disc[1], c_re[1], c_im[1])
        y = (y_f + jnp.flip(y_b, 1)).reshape(u.shape) + _f32(d_skip) * u
        y = jax.nn.gelu(y)
        return y * jax.nn.sigmoid(y @ _f32(glu_w) + _f32(glu_b)), (h_f, h_b)

    zero = jnp.zeros((uc.shape[0], S5_G, S5_P), jnp.float32)
    yc, h_ctx = run(_f32(uc), ((zero, zero), (zero, zero)))
    yx, _ = run(_f32(ux), h_ctx)
    return yc.astype(uc.dtype), yx.astype(ux.dtype)


def _gla_chunkwise(q, k, v, log_f, s0):
    b, h, l, _ = q.shape
    dv = v.shape[-1]
    n = l // HG_CHUNK
    blk = lambda t: t.reshape(b, h, n, HG_CHUNK, t.shape[-1])
    q, k, v, log_f = blk(q), blk(k), blk(v), blk(log_f)
    cum = jnp.cumsum(log_f, axis=3)
    lower = jnp.tril(jnp.ones((HG_CHUNK, HG_CHUNK), bool))[:, :, None]
    rel = jnp.exp(jnp.where(lower, cum[..., :, None, :] - cum[..., None, :, :], -jnp.inf))
    scores = jnp.einsum('bhntd,bhnsd,bhntsd->bhnts', q, k, rel)
    o_intra = jnp.einsum('bhnts,bhnsv->bhntv', scores, v)
    last = cum[..., -1:, :]
    chunk_kv = jnp.einsum('bhnsd,bhnsv->bhndv', k * jnp.exp(last - cum), v)
    chunk_decay = jnp.exp(last[..., 0, :])

    def step(state, inp):
        dec, kv = inp
        return dec[..., None] * state + kv, state

    s_fin, s_prev = lax.scan(step, s0, (jnp.moveaxis(chunk_decay, 2, 0), jnp.moveaxis(chunk_kv, 2, 0)))
    o_inter = jnp.einsum('bhntd,bhndv->bhntv', q * jnp.exp(cum), jnp.moveaxis(s_prev, 0, 2))
    return (o_intra + o_inter).reshape(b, h, l, dv), s_fin


def _hgrn2_mixer(pc, px, lb, norm_g):
    def heads(t):
        return t.reshape(t.shape[0], t.shape[1], HG_HEADS, HG_HEAD).transpose(0, 2, 1, 3)

    def fl(t):
        return jnp.flip(t, axis=2)

    def run(p, s0s):
        q, i, f_f, f_b, g = jnp.split(_f32(p), 5, axis=-1)
        q, i = heads(jax.nn.silu(q)), heads(i)
        logf_f = jnp.log(lb[0] + (1.0 - lb[0]) * jax.nn.sigmoid(f_f))
        logf_b = jnp.log(lb[1] + (1.0 - lb[1]) * jax.nn.sigmoid(f_b))
        o_f, s_f = _gla_chunkwise(q, heads(-jnp.expm1(logf_f)), i, heads(logf_f), s0s[0])
        o_b, s_b = _gla_chunkwise(fl(q), fl(heads(-jnp.expm1(logf_b))), fl(i), fl(heads(logf_b)), s0s[1])
        o = (o_f + fl(o_b)).transpose(0, 2, 1, 3)
        o = o * lax.rsqrt(jnp.mean(o * o, -1, keepdims=True) + RMS_EPS)
        o = o.reshape(o.shape[0], o.shape[1], D_HG) * _f32(norm_g) * jax.nn.silu(g)
        return o, (s_f, s_b)

    zero = jnp.zeros((pc.shape[0], HG_HEADS, HG_HEAD, HG_HEAD), jnp.float32)
    yc, s_ctx = run(pc, (zero, zero))
    yx, _ = run(px, s_ctx)
    return yc.astype(pc.dtype), yx.astype(px.dtype)


def _rwkv7_step(state, inp):
    r, w, k, v, kk, a = inp
    sk = jnp.einsum('bhvk,bhk->bhv', state, kk)
    state = (state * w[:, :, None, :] - sk[..., None] * (kk * a)[:, :, None, :]
             + v[..., None] * k[:, :, None, :])
    return state, jnp.einsum('bhvk,bhk->bhv', state, r)


def _rwkv7_scan(r, w, k, v, kk, a, s0, reverse):
    xs = tuple(jnp.moveaxis(t, 1, 0) for t in (r, w, k, v, kk, a))
    s_fin, y = lax.scan(_rwkv7_step, s0, xs, reverse=reverse)
    return jnp.moveaxis(y, 0, 1), s_fin


def _rwkv7_mixer(pc, px, rows, mu, w0, w_up, a0, a_up, g_up, k_k, k_a, r_k, gn_g, gn_b):
    split_at = [D_RW, 2 * D_RW, 3 * D_RW, 3 * D_RW + RW_G_LORA,
                3 * D_RW + RW_G_LORA + RW_W_LORA, 3 * D_RW + RW_G_LORA + 2 * RW_W_LORA,
                3 * D_RW + RW_G_LORA + 2 * RW_W_LORA + RW_A_LORA]

    def heads(t):
        return t.reshape(t.shape[0], t.shape[1], RW_HEADS, RW_HEAD)

    def run(p, shifted, s0s):
        s = p + _f32(mu) * (shifted - p)
        r, k, v, g_lo, wl_f, wl_b, al_f, al_b = jnp.split(s, split_at, axis=-1)
        g = jax.nn.sigmoid(g_lo) @ _f32(g_up)
        kk = heads(k * _f32(k_k))
        kk = kk / jnp.maximum(jnp.sqrt(jnp.sum(kk * kk, -1, keepdims=True)), 1e-12)
        r, v = heads(r), heads(v)
        ys, bonuses, finals = [], [], []
        for d, (wl, al) in enumerate(((wl_f, al_f), (wl_b, al_b))):
            w_log = -jax.nn.softplus(-(_f32(w0[d]) + jnp.tanh(wl) @ _f32(w_up[d]))) - 0.5
            decay = heads(jnp.exp(-jnp.exp(w_log)))
            a = jax.nn.sigmoid(_f32(a0[d]) + al @ _f32(a_up[d]))
            k_d = heads(k * (1.0 + (a - 1.0) * _f32(k_a)))
            y_d, s_d = _rwkv7_scan(r, decay, k_d, v, kk, heads(a), s0s[d], d == 1)
            ys.append(y_d)
            bonuses.append(jnp.sum(r * k_d * _f32(r_k), -1, keepdims=True))
            finals.append(s_d)
        y = ys[0] + ys[1]
        mu_y = jnp.mean(y, -1, keepdims=True)
        var_y = jnp.mean(jnp.square(y - mu_y), -1, keepdims=True)
        y = ((y - mu_y) * lax.rsqrt(var_y + RW_GN_EPS) * _f32(gn_g).reshape(RW_HEADS, RW_HEAD)
             + _f32(gn_b).reshape(RW_HEADS, RW_HEAD))
        y = (y + (bonuses[0] + bonuses[1]) * v).reshape(p.shape[0], p.shape[1], D_RW) * g
        return y, (finals[0], finals[1])

    pc32, px32 = _f32(pc), _f32(px)
    zero = jnp.zeros((pc.shape[0], RW_HEADS, RW_HEAD, RW_HEAD), jnp.float32)
    yc, s_ctx = run(pc32, _qshift_seq(pc32), (zero, zero))
    yx, _ = run(px32, _qshift_grid(px32, rows), s_ctx)
    return yc.astype(pc.dtype), yx.astype(px.dtype)


def _peer_ffn(h, wq, keys, u_tab, v_tab):
    b, l, d = h.shape
    t = b * l
    hf = h.reshape(t, d)
    q = (hf @ wq).reshape(t, PEER_HEADS, 2, PEER_QDIM // 2)
    scores = _f32(jnp.einsum('thpd,hpkd->thpk', q, keys))
    s_top, i_top = lax.top_k(scores, PEER_TOPK)
    cand = s_top[..., 0, :, None] + s_top[..., 1, None, :]
    cand_s, cand_i = lax.top_k(cand.reshape(t, PEER_HEADS, PEER_TOPK * PEER_TOPK), PEER_TOPK)
    i1 = jnp.take_along_axis(i_top[..., 0, :], cand_i // PEER_TOPK, axis=-1)
    i2 = jnp.take_along_axis(i_top[..., 1, :], cand_i % PEER_TOPK, axis=-1)
    expert = (i1 * PEER_NKEYS + i2).reshape(t, PEER_HEADS * PEER_TOPK)
    gate = jax.nn.softmax(cand_s, axis=-1).reshape(t, PEER_HEADS * PEER_TOPK).astype(h.dtype)
    nb = t // PEER_BLOCK

    def block(args):
        hb, eb, gb = args
        z = jnp.einsum('tkd,td->tk', u_tab[eb], hb)
        return jnp.einsum('tk,tkd->td', jax.nn.gelu(z) * gb, v_tab[eb])

    out = lax.map(block, (hf.reshape(nb, PEER_BLOCK, d),
                          expert.reshape(nb, PEER_BLOCK, PEER_HEADS * PEER_TOPK),
                          gate.reshape(nb, PEER_BLOCK, PEER_HEADS * PEER_TOPK)))
    return out.reshape(b, l, d)


def setup_inputs(seed: int = 0) -> dict:
    key = jax.random.key(seed)
    ks = iter(jax.random.split(key, 48))
    f32 = jnp.float32

    def nrm(shape, scale):
        return scale * jax.random.normal(next(ks), shape, f32)

    def unif(shape, lo, hi):
        return jax.random.uniform(next(ks), shape, f32, lo, hi)

    L = DEPTH
    D = D_MODEL
    return {
        'x': nrm((BATCH, SEQ, D), 1.0),
        'c': nrm((BATCH, D), 1.0),
        'ctx': nrm((BATCH, CTX_LEN, D), 1.0),
        'c_ctx': nrm((D,), 1.0),
        'ada_w': nrm((L, D, 6 * D), D ** -0.5),
        'ada_b': nrm((L, 6 * D), 0.02),
        'w_in': nrm((L, D, P_IN), D ** -0.5),
        'w_out': nrm((L, D_MIX, D), DEEPNORM_BETA * D_MIX ** -0.5),
        'ln1_g': 1.0 + nrm((L, D), 0.02),
        'ln1_b': nrm((L, D), 0.02),
        'ln2_g': 1.0 + nrm((L, D), 0.02),
        'ln2_b': nrm((L, D), 0.02),
        's5_lam_re': -0.5 + nrm((L, 2, S5_G, S5_P), 0.01),
        's5_lam_im': jnp.pi * jnp.arange(S5_P, dtype=f32) + nrm((L, 2, S5_G, S5_P), 0.01),
        's5_log_step': unif((L, 2, S5_G), math.log(1e-3), math.log(1e-1)),
        's5_b_re': nrm((L, 2, S5_G, S5_P, S5_H), (2.0 * S5_H) ** -0.5),
        's5_b_im': nrm((L, 2, S5_G, S5_P, S5_H), (2.0 * S5_H) ** -0.5),
        's5_c_re': nrm((L, 2, S5_G, S5_H, S5_P), S5_P ** -0.5),
        's5_c_im': nrm((L, 2, S5_G, S5_H, S5_P), S5_P ** -0.5),
        's5_d': nrm((L, D_S5), 1.0),
        's5_glu_w': nrm((L, D_S5, D_S5), D_S5 ** -0.5),
        's5_glu_b': nrm((L, D_S5), 0.02),
        'hgrn_lb_logits': nrm((2, L, D_HG), 0.1),
        'hgrn_norm_g': 1.0 + nrm((L, D_HG), 0.02),
        'rwkv_mu': unif((L, RW_COLS), 0.0, 1.0),
        'rwkv_w0': unif((L, 2, D_RW), -6.5, -1.5),
        'rwkv_w_up': nrm((L, 2, RW_W_LORA, D_RW), 0.5 * RW_W_LORA ** -0.5),
        'rwkv_a0': nrm((L, 2, D_RW), 0.1),
        'rwkv_a_up': nrm((L, 2, RW_A_LORA, D_RW), 0.5 * RW_A_LORA ** -0.5),
        'rwkv_g_up': nrm((L, RW_G_LORA, D_RW), RW_G_LORA ** -0.5),
        'rwkv_k_k': 0.85 + nrm((L, D_RW), 0.02),
        'rwkv_k_a': 1.0 + nrm((L, D_RW), 0.02),
        'rwkv_r_k': nrm((L, RW_HEADS, RW_HEAD), 0.1),
        'rwkv_gn_g': 1.0 + nrm((L, D_RW), 0.02),
        'rwkv_gn_b': nrm((L, D_RW), 0.02),
        'peer_wq': nrm((L, D, PEER_HEADS * PEER_QDIM), D ** -0.5),
        'peer_keys': nrm((L, PEER_HEADS, 2, PEER_NKEYS, PEER_QDIM // 2), (PEER_QDIM // 2) ** -0.5),
        'peer_u': nrm((L, PEER_N, D), D ** -0.5),
        'peer_v': nrm((L, PEER_N, D), DEEPNORM_BETA),
    }


def reference(x, c, ctx, c_ctx, ada_w, ada_b, w_in, w_out, ln1_g, ln1_b, ln2_g, ln2_b,
              s5_lam_re, s5_lam_im, s5_log_step, s5_b_re, s5_b_im, s5_c_re, s5_c_im,
              s5_d, s5_glu_w, s5_glu_b, hgrn_lb_logits, hgrn_norm_g,
              rwkv_mu, rwkv_w0, rwkv_w_up, rwkv_a0, rwkv_a_up, rwkv_g_up, rwkv_k_k, rwkv_k_a,
              rwkv_r_k, rwkv_gn_g, rwkv_gn_b, peer_wq, peer_keys, peer_u, peer_v):
    rows = x.shape[1] // GRID_W
    lb_cum = jnp.cumsum(jax.nn.softmax(_f32(hgrn_lb_logits), axis=1), axis=1)
    lb_all = lb_cum - lb_cum[:, :1]
    col_split = [D_S5, D_S5 + 5 * D_HG]
    xs, cs = x, ctx
    for l in range(DEPTH):
        mod_x = (jax.nn.silu(c) @ ada_w[l] + ada_b[l])[:, None, :]
        mod_c = (jax.nn.silu(c_ctx) @ ada_w[l] + ada_b[l])[None, None, :]
        sh1x, sc1x, g1x, sh2x, sc2x, g2x = jnp.split(mod_x, 6, axis=-1)
        sh1c, sc1c, g1c, sh2c, sc2c, g2c = jnp.split(mod_c, 6, axis=-1)

        px = (xs * (1.0 + sc1x) + sh1x) @ w_in[l]
        pc = (cs * (1.0 + sc1c) + sh1c) @ w_in[l]
        pxa, pxb, pxc = jnp.split(px, col_split, axis=-1)
        pca, pcb, pcc = jnp.split(pc, col_split, axis=-1)

        ya_c, ya_x = _s5_mixer(pca, pxa, s5_lam_re[l], s5_lam_im[l], s5_log_step[l],
                               s5_b_re[l], s5_b_im[l], s5_c_re[l], s5_c_im[l],
                               s5_d[l], s5_glu_w[l], s5_glu_b[l])
        yb_c, yb_x = _hgrn2_mixer(pcb, pxb, lb_all[:, l], hgrn_norm_g[l])
        yc_c, yc_x = _rwkv7_mixer(pcc, pxc, rows, rwkv_mu[l], rwkv_w0[l], rwkv_w_up[l],
                                  rwkv_a0[l], rwkv_a_up[l], rwkv_g_up[l], rwkv_k_k[l],
                                  rwkv_k_a[l], rwkv_r_k[l], rwkv_gn_g[l], rwkv_gn_b[l])

        mix_x = jnp.concatenate([ya_x, yb_x, yc_x], axis=-1) @ w_out[l]
        xs = _layer_norm(DEEPNORM_ALPHA * xs + g1x * mix_x, ln1_g[l], ln1_b[l])
        ffn_x = _peer_ffn(xs * (1.0 + sc2x) + sh2x, peer_wq[l], peer_keys[l], peer_u[l], peer_v[l])
        xs = _layer_norm(DEEPNORM_ALPHA * xs + g2x * ffn_x, ln2_g[l], ln2_b[l])

        if l < DEPTH - 1:
            mix_c = jnp.concatenate([ya_c, yb_c, yc_c], axis=-1) @ w_out[l]
            cs = _layer_norm(DEEPNORM_ALPHA * cs + g1c * mix_c, ln1_g[l], ln1_b[l])
            ffn_c = _peer_ffn(cs * (1.0 + sc2c) + sh2c, peer_wq[l], peer_keys[l], peer_u[l], peer_v[l])
            cs = _layer_norm(DEEPNORM_ALPHA * cs + g2c * ffn_c, ln2_g[l], ln2_b[l])
    return xs
```

```cpp
#include <hip/hip_runtime.h>
#include <hip/hip_cooperative_groups.h>
#include <cstdio>
namespace cg = cooperative_groups;

#ifndef SINGLE
#define SINGLE 1
#endif

typedef unsigned short bf16_t;
typedef short bf16x8 __attribute__((ext_vector_type(8)));
typedef float f32x4 __attribute__((ext_vector_type(4)));

#define DM 1024
#define NB 4
#define SEQ 4096
#define CTX 256
#define LTOT 4352
#define MROWS 17408
#define PIN 3456
#define RWW 4224
#define NPH 20
#define ALPHA 1.41421356237f

#define OFF_XS 0ull
#define OFF_P (OFF_XS + (size_t)MROWS * DM * 4)
#define OFF_RW (OFF_P + (size_t)MROWS * PIN * 2)
#define OFF_YP (OFF_RW + (size_t)MROWS * RWW * 2)
#define OFF_MIX (OFF_YP + (size_t)2 * MROWS * DM * 2)
#define OFF_MOD (OFF_MIX + (size_t)MROWS * DM * 2)
#define OFF_WIN (OFF_MOD + (size_t)2 * 5 * 6144 * 4)
#define OFF_WOUT (OFF_WIN + (size_t)2 * PIN * DM * 2)
#define OFF_WQ (OFF_WOUT + (size_t)2 * DM * DM * 2)
#define OFF_END (OFF_WQ + (size_t)2 * 2048 * DM * 2)
#define OFF_TMP OFF_P
#define OFF_H OFF_YP
#define OFF_H2 (OFF_YP + (size_t)MROWS * DM * 2)
#define OFF_Q OFF_RW
#define OFF_IDX (OFF_RW + (size_t)MROWS * 2048 * 2)
#define OFF_GATE (OFF_IDX + (size_t)MROWS * 128 * 4)

struct Params {
    const float* in[39];
    float* out;
    unsigned char* ws;
    int ph_lo, ph_hi;
};

__device__ __forceinline__ bf16_t f2bf(float f) {
    unsigned u = __float_as_uint(f);
    u += 0x7FFFu + ((u >> 16) & 1u);
    return (bf16_t)(u >> 16);
}
__device__ __forceinline__ float bf2f(bf16_t h) { return __uint_as_float(((unsigned)h) << 16); }
__device__ __forceinline__ float sigmoidf_(float x) { return 1.f / (1.f + __expf(-x)); }
__device__ __forceinline__ float siluf_(float x) { return x * sigmoidf_(x); }
__device__ __forceinline__ float gelu_tanh(float x) {
    const float u = 0.7978845608028654f * (x + 0.044715f * x * x * x);
    return 0.5f * x * (1.f + tanhf(u));
}
__device__ __forceinline__ float wave_sum(float v) {
#pragma unroll
    for (int o = 32; o > 0; o >>= 1) v += __shfl_xor(v, o, 64);
    return v;
}
__device__ __forceinline__ float rdlane(float v, int l) { return __int_as_float(__builtin_amdgcn_readlane(__float_as_int(v), l)); }
__device__ __forceinline__ int row_of(int b, int dir, int tau) {
    const int p = dir == 0 ? tau : (tau < CTX ? (CTX - 1 - tau) : (LTOT + CTX - 1 - tau));
    return b * LTOT + p;
}
__device__ __forceinline__ int modrow(int row) { const int p = row % LTOT; return p < CTX ? 4 : row / LTOT; }

__device__ __forceinline__ void phase_prep(const Params& P, unsigned char* smem) {
    const int tid = threadIdx.x, lane = tid & 63, wave = tid >> 6;
    float* MOD = (float*)(P.ws + OFF_MOD);
    float* XS = (float*)(P.ws + OFF_XS);
    const int U_MOD = 192, U_COPY = MROWS / 16, U_TIN = 2 * 16 * 54, U_TOUT = 2 * 16 * 16, U_TQ = 2 * 16 * 32;
    const int total = U_MOD + U_COPY + U_TIN + U_TOUT + U_TQ;
    for (int u = blockIdx.x; u < total; u += gridDim.x) {
        __syncthreads();
        if (u < U_MOD) {
            const int l = u / 96, j0 = (u % 96) * 64;
            float* sl = (float*)smem;
            for (int i = tid; i < 5 * 1024; i += 256) {
                const int r = i >> 10, k = i & 1023;
                const float cv = r < 4 ? P.in[1][r * 1024 + k] : P.in[3][k];
                sl[i] = siluf_(cv);
            }
            __syncthreads();
            float acc[5] = {0.f, 0.f, 0.f, 0.f, 0.f};
            const float* W = P.in[4] + (size_t)l * 1024 * 6144 + j0 + lane;
            for (int k = wave * 256; k < wave * 256 + 256; ++k) {
                const float w = W[(size_t)k * 6144];
#pragma unroll
                for (int r = 0; r < 5; ++r) acc[r] += sl[r * 1024 + k] * w;
            }
            float* red = (float*)(smem + 5 * 1024 * 4);
#pragma unroll
            for (int r = 0; r < 5; ++r) red[(wave * 5 + r) * 64 + lane] = acc[r];
            __syncthreads();
            for (int i = tid; i < 5 * 64; i += 256) {
                const int r = i / 64, jj = i % 64;
                float s = P.in[5][l * 6144 + j0 + jj];
                for (int w = 0; w < 4; ++w) s += red[(w * 5 + r) * 64 + jj];
                MOD[(l * 5 + r) * 6144 + j0 + jj] = s;
            }
        } else if (u < U_MOD + U_COPY) {
            const int r0 = (u - U_MOD) * 16;
            for (int i = tid; i < 16 * 256; i += 256) {
                const int row = r0 + (i >> 8), c4 = i & 255;
                const int b = row / LTOT, p = row % LTOT;
                const float4* src = p < CTX ? (const float4*)(P.in[2] + ((size_t)b * CTX + p) * DM) : (const float4*)(P.in[0] + ((size_t)b * SEQ + (p - CTX)) * DM);
                ((float4*)(XS + (size_t)row * DM))[c4] = src[c4];
            }
        } else {
            int v = u - U_MOD - U_COPY;
            const float* W; bf16_t* Wt; int N;
            if (v < U_TIN) { const int l = v / (16 * 54); v %= 16 * 54; N = PIN; W = P.in[6] + (size_t)l * 1024 * PIN; Wt = (bf16_t*)(P.ws + OFF_WIN) + (size_t)l * PIN * 1024; }
            else if (v < U_TIN + U_TOUT) { v -= U_TIN; const int l = v / 256; v %= 256; N = 1024; W = P.in[7] + (size_t)l * 1024 * 1024; Wt = (bf16_t*)(P.ws + OFF_WOUT) + (size_t)l * 1024 * 1024; }
            else { v -= U_TIN + U_TOUT; const int l = v / 512; v %= 512; N = 2048; W = P.in[35] + (size_t)l * 1024 * 2048; Wt = (bf16_t*)(P.ws + OFF_WQ) + (size_t)l * 2048 * 1024; }
            const int ntn = N / 64, kt = v / ntn, nt = v % ntn;
            float* t = (float*)smem;
            for (int i = tid; i < 64 * 64; i += 256) { const int kk = i >> 6, nn = i & 63; t[kk * 65 + nn] = W[(size_t)(kt * 64 + kk) * N + nt * 64 + nn]; }
            __syncthreads();
            for (int i = tid; i < 64 * 64; i += 256) { const int nn = i >> 6, kk = i & 63; Wt[(size_t)(nt * 64 + nn) * 1024 + kt * 64 + kk] = f2bf(t[kk * 65 + nn]); }
        }
    }
}

__device__ __forceinline__ void phase_mkh(const Params& P) {
    const int lane = threadIdx.x & 63, wave = threadIdx.x >> 6;
    const float* XS = (const float*)(P.ws + OFF_XS);
    const float* MOD = (const float*)(P.ws + OFF_MOD);
    bf16_t* H = (bf16_t*)(P.ws + OFF_H);
    for (int row = blockIdx.x * 4 + wave; row < MROWS; row += gridDim.x * 4) {
        const float* mod = MOD + (size_t)(0 * 5 + modrow(row)) * 6144;
#pragma unroll
        for (int j = 0; j < 4; ++j) {
            const int d = 256 * j + 4 * lane;
            const float4 x = *(const float4*)(XS + (size_t)row * DM + d);
            const float4 sh = *(const float4*)(mod + d), sc = *(const float4*)(mod + 1024 + d);
            ushort4 o;
            o.x = f2bf(x.x * (1.f + sc.x) + sh.x); o.y = f2bf(x.y * (1.f + sc.y) + sh.y);
            o.z = f2bf(x.z * (1.f + sc.z) + sh.z); o.w = f2bf(x.w * (1.f + sc.w) + sh.w);
            *(ushort4*)(H + (size_t)row * DM + d) = o;
        }
    }
}

template <class EPI>
__device__ __forceinline__ void gemm_bf16(const bf16_t* A, int lda, const bf16_t* Bt, int ldb, int M, int N, int K, bool skipctx, EPI epi) {
    const int lane = threadIdx.x & 63, wave = threadIdx.x >> 6;
    const int ntm = M / 128, ntn = N / 128;
    const int fr = lane & 15, fq = lane >> 4;
    for (int tile = blockIdx.x; tile < ntm * ntn; tile += gridDim.x) {
        const int tm = tile / ntn, tn = tile % ntn;
        const int m0 = tm * 128 + (wave >> 1) * 64, n0 = tn * 128 + (wave & 1) * 64;
        if (skipctx && (m0 % LTOT) < CTX) continue;
        f32x4 acc[4][4];
#pragma unroll
        for (int i = 0; i < 4; ++i)
#pragma unroll
            for (int j = 0; j < 4; ++j) acc[i][j] = (f32x4){0.f, 0.f, 0.f, 0.f};
        const bf16_t* ap = A + (size_t)(m0 + fr) * lda + 8 * fq;
        const bf16_t* bp = Bt + (size_t)(n0 + fr) * ldb + 8 * fq;
        for (int k0 = 0; k0 < K; k0 += 32) {
            bf16x8 a[4], b[4];
#pragma unroll
            for (int i = 0; i < 4; ++i) a[i] = *(const bf16x8*)(ap + (size_t)(16 * i) * lda + k0);
#pragma unroll
            for (int j = 0; j < 4; ++j) b[j] = *(const bf16x8*)(bp + (size_t)(16 * j) * ldb + k0);
#pragma unroll
            for (int i = 0; i < 4; ++i)
#pragma unroll
                for (int j = 0; j < 4; ++j) acc[i][j] = __builtin_amdgcn_mfma_f32_16x16x32_bf16(a[i], b[j], acc[i][j], 0, 0, 0);
        }
#pragma unroll
        for (int i = 0; i < 4; ++i)
#pragma unroll
            for (int j = 0; j < 4; ++j)
#pragma unroll
                for (int r = 0; r < 4; ++r) epi(m0 + 16 * i + 4 * fq + r, n0 + 16 * j + fr, acc[i][j][r]);
    }
}
struct EpiBf16 { bf16_t* C; int ldc; __device__ __forceinline__ void operator()(int r, int c, float v) const { C[(size_t)r * ldc + c] = f2bf(v); } };
struct EpiF32 { float* C; int ldc; __device__ __forceinline__ void operator()(int r, int c, float v) const { C[(size_t)r * ldc + c] = v; } };

__device__ __forceinline__ void phase_rwprep(const Params& P, int l, unsigned char* smem) {
    const int tid = threadIdx.x;
    const bf16_t* Pb = (const bf16_t*)(P.ws + OFF_P);
    bf16_t* RW = (bf16_t*)(P.ws + OFF_RW);
    const float* mu = P.in[24] + l * 1920;
    const float* k_k = P.in[30] + l * 512;
    float* tw = (float*)smem;
    float* al = tw + 2 * 8 * 64;
    float* kk2 = al + 2 * 8 * 64;
    float* nrm = kk2 + 8 * 512;
    for (int u = blockIdx.x; u < MROWS / 8; u += gridDim.x) {
        const int r0 = u * 8;
        __syncthreads();
        for (int i = 0; i < 8; ++i) {
            const int row = r0 + i, p = row % LTOT;
            int nb[4]; bool ok[4];
            if (p < CTX) {
                nb[0] = row - 1; ok[0] = p > 0; nb[1] = row + 1; ok[1] = p < CTX - 1; nb[2] = nb[0]; ok[2] = ok[0]; nb[3] = nb[1]; ok[3] = ok[1];
            } else {
                const int t = p - CTX, gr = t >> 6, gc = t & 63;
                nb[0] = row - 1; ok[0] = gc > 0; nb[1] = row + 1; ok[1] = gc < 63; nb[2] = row - 64; ok[2] = gr > 0; nb[3] = row + 64; ok[3] = gr < 63;
            }
            for (int c = tid; c < 1920; c += 256) {
                const int m = c & 3;
                const float pv = bf2f(Pb[(size_t)row * PIN + 1536 + c]);
                const float nv = ok[m] ? bf2f(Pb[(size_t)nb[m] * PIN + 1536 + c]) : 0.f;
                const float s = pv + mu[c] * (nv - pv);
                bf16_t* rw = RW + (size_t)row * RWW;
                if (c < 512) rw[c] = f2bf(s);
                else if (c < 1024) { rw[c] = f2bf(s); kk2[i * 512 + (c - 512)] = s * k_k[c - 512]; }
                else if (c < 1536) rw[c] = f2bf(s);
                else if (c < 1664) rw[4096 + (c - 1536)] = f2bf(sigmoidf_(s));
                else if (c < 1728) tw[(0 * 8 + i) * 64 + (c - 1664)] = tanhf(s);
                else if (c < 1792) tw[(1 * 8 + i) * 64 + (c - 1728)] = tanhf(s);
                else if (c < 1856) al[(0 * 8 + i) * 64 + (c - 1792)] = s;
                else al[(1 * 8 + i) * 64 + (c - 1856)] = s;
            }
        }
        __syncthreads();
        {
            const int pair = tid >> 2, q = tid & 3, i = pair >> 3, hd = pair & 7;
            float s = 0.f;
            for (int j = 0; j < 16; ++j) { const float v = kk2[i * 512 + hd * 64 + q * 16 + j]; s += v * v; }
            s += __shfl_xor(s, 1, 64); s += __shfl_xor(s, 2, 64);
            if (q == 0) nrm[pair] = fmaxf(sqrtf(s), 1e-12f);
        }
        __syncthreads();
        for (int e = tid; e < 8 * 512; e += 256) {
            const int i = e >> 9, c = e & 511;
            RW[(size_t)(r0 + i) * RWW + 1536 + c] = f2bf(kk2[e] / nrm[i * 8 + (c >> 6)]);
        }
        for (int d = 0; d < 2; ++d) {
            const float* wup = P.in[26] + (size_t)(l * 2 + d) * 64 * 512;
            const float* aup = P.in[28] + (size_t)(l * 2 + d) * 64 * 512;
            const float* w0 = P.in[25] + (l * 2 + d) * 512;
            const float* a0 = P.in[27] + (l * 2 + d) * 512;
            float zw[2][8], za[2][8];
#pragma unroll
            for (int i = 0; i < 8; ++i) { zw[0][i] = zw[1][i] = za[0][i] = za[1][i] = 0.f; }
            for (int j = 0; j < 64; ++j) {
                const float w_0 = wup[j * 512 + tid], w_1 = wup[j * 512 + tid + 256];
                const float a_0 = aup[j * 512 + tid], a_1 = aup[j * 512 + tid + 256];
#pragma unroll
                for (int i = 0; i < 8; ++i) {
                    const float t = tw[(d * 8 + i) * 64 + j], a = al[(d * 8 + i) * 64 + j];
                    zw[0][i] += t * w_0; zw[1][i] += t * w_1; za[0][i] += a * a_0; za[1][i] += a * a_1;
                }
            }
#pragma unroll
            for (int i = 0; i < 8; ++i) {
                bf16_t* rw = RW + (size_t)(r0 + i) * RWW;
#pragma unroll
                for (int h = 0; h < 2; ++h) {
                    const int c = tid + 256 * h;
                    rw[2048 + d * 512 + c] = f2bf(sigmoidf_(a0[c] + za[h][i]));
                    rw[3072 + d * 512 + c] = f2bf(-0.60653066f * sigmoidf_(w0[c] + zw[h][i]));
                }
            }
        }
    }
}

__device__ __forceinline__ void scan_rwkv(const Params& P, int l, int item) {
    const int lane = threadIdx.x & 63;
    const int dir = item & 1, hd = (item >> 1) & 7, b = item >> 4;
    const bf16_t* RW = (const bf16_t*)(P.ws + OFF_RW);
    bf16_t* YP = (bf16_t*)(P.ws + OFF_YP) + (size_t)dir * MROWS * DM;
    const float ka = P.in[31][l * 512 + hd * 64 + lane];
    float S[64];
#pragma unroll
    for (int k = 0; k < 64; ++k) S[k] = 0.f;
    for (int tau = 0; tau < LTOT; ++tau) {
        const int row = row_of(b, dir, tau);
        const bf16_t* rw = RW + (size_t)row * RWW + hd * 64 + lane;
        const float r = bf2f(rw[0]), k = bf2f(rw[512]), v = bf2f(rw[1024]), kap = bf2f(rw[1536]);
        const float a = bf2f(rw[2048 + dir * 512]), lw = bf2f(rw[3072 + dir * 512]);
        const float w = __expf(lw), kt = k * (1.f + (a - 1.f) * ka), beta = kap * a;
        float sk = 0.f;
#pragma unroll
        for (int kk = 0; kk < 64; ++kk) { sk += S[kk] * rdlane(kap, kk); if ((kk & 7) == 7) __builtin_amdgcn_sched_barrier(0); }
        float y = 0.f;
#pragma unroll
        for (int kk = 0; kk < 64; ++kk) {
            const float s = S[kk] * rdlane(w, kk) - sk * rdlane(beta, kk) + v * rdlane(kt, kk);
            S[kk] = s;
            y += s * rdlane(r, kk);
            if ((kk & 3) == 3) __builtin_amdgcn_sched_barrier(0);
        }
        YP[(size_t)row * DM + 512 + hd * 64 + lane] = f2bf(y);
    }
}
__device__ __forceinline__ void scan_hgrn(const Params& P, int l, int item) {
    const int lane = threadIdx.x & 63;
    const int dir = item & 1, hd = (item >> 1) & 3, b = item >> 3;
    const bf16_t* Pb = (const bf16_t*)(P.ws + OFF_P);
    bf16_t* YP = (bf16_t*)(P.ws + OFF_YP) + (size_t)dir * MROWS * DM;
    float lb = 0.f;
    if (l == 1) {
        const float a0 = P.in[22][(dir * 2 + 0) * 256 + hd * 64 + lane], a1 = P.in[22][(dir * 2 + 1) * 256 + hd * 64 + lane];
        const float m = fmaxf(a0, a1), e0 = __expf(a0 - m), e1 = __expf(a1 - m);
        lb = e1 / (e0 + e1);
    }
    float S[64];
#pragma unroll
    for (int k = 0; k < 64; ++k) S[k] = 0.f;
    for (int tau = 0; tau < LTOT; ++tau) {
        const int row = row_of(b, dir, tau);
        const bf16_t* pr = Pb + (size_t)row * PIN + 256 + hd * 64 + lane;
        const float q = siluf_(bf2f(pr[0])), v = bf2f(pr[256]);
        const float f = lb + (1.f - lb) * sigmoidf_(bf2f(pr[512 + dir * 256]));
        const float kq = 1.f - f;
        float o = 0.f;
#pragma unroll
        for (int dk = 0; dk < 64; ++dk) {
            const float s = rdlane(f, dk) * S[dk] + rdlane(kq, dk) * v;
            S[dk] = s;
            o += s * rdlane(q, dk);
            if ((dk & 7) == 7) __builtin_amdgcn_sched_barrier(0);
        }
        YP[(size_t)row * DM + 256 + hd * 64 + lane] = f2bf(o);
    }
}
__device__ __forceinline__ void scan_s5(const Params& P, int l, int item) {
    const int lane = threadIdx.x & 63;
    const int dir = item & 1, g = (item >> 1) & 15, b = item >> 5;
    const bf16_t* Pb = (const bf16_t*)(P.ws + OFF_P);
    bf16_t* YP = (bf16_t*)(P.ws + OFF_YP) + (size_t)dir * MROWS * DM;
    const int ldg = (l * 2 + dir) * 16 + g;
    const float dt = expf(P.in[14][ldg]);
    const float lre = P.in[12][ldg * 64 + lane], lim = P.in[13][ldg * 64 + lane];
    const float mag = expf(lre * dt), ang = lim * dt;
    const float lb_re = mag * cosf(ang), lb_im = mag * sinf(ang);
    const float den = lre * lre + lim * lim, nr = lb_re - 1.f, ni = lb_im;
    const float co_re = (nr * lre + ni * lim) / den, co_im = (ni * lre - nr * lim) / den;
    float bb_re[16], bb_im[16], c_re[16], c_im[16];
#pragma unroll
    for (int h = 0; h < 16; ++h) {
        const float br = P.in[15][((size_t)ldg * 64 + lane) * 16 + h], bi = P.in[16][((size_t)ldg * 64 + lane) * 16 + h];
        bb_re[h] = co_re * br - co_im * bi; bb_im[h] = co_re * bi + co_im * br;
        c_re[h] = P.in[17][((size_t)ldg * 16 + h) * 64 + lane]; c_im[h] = P.in[18][((size_t)ldg * 16 + h) * 64 + lane];
    }
    float s_re = 0.f, s_im = 0.f;
    for (int tau = 0; tau < LTOT; ++tau) {
        const int row = row_of(b, dir, tau);
        const float uv = bf2f(Pb[(size_t)row * PIN + g * 16 + (lane & 15)]);
        float bu_re = 0.f, bu_im = 0.f;
#pragma unroll
        for (int h = 0; h < 16; ++h) { const float uh = rdlane(uv, h); bu_re += bb_re[h] * uh; bu_im += bb_im[h] * uh; }
        const float n_re = lb_re * s_re - lb_im * s_im + bu_re, n_im = lb_re * s_im + lb_im * s_re + bu_im;
        s_re = n_re; s_im = n_im;
        float yo = 0.f;
#pragma unroll
        for (int h = 0; h < 16; ++h) { const float t = wave_sum(c_re[h] * s_re - c_im[h] * s_im); yo = (lane == h) ? t : yo; }
        if (lane < 16) YP[(size_t)row * DM + g * 16 + lane] = f2bf(yo);
    }
}
__device__ __forceinline__ void phase_scans(const Params& P, int l) {
    const int wave = threadIdx.x >> 6;
    for (int it = wave * gridDim.x + blockIdx.x; it < 224; it += 4 * gridDim.x) {
        if (it < 64) scan_rwkv(P, l, it);
        else if (it < 96) scan_hgrn(P, l, it - 64);
        else scan_s5(P, l, it - 96);
    }
}

__device__ __forceinline__ void phase_post(const Params& P, int l, unsigned char* smem) {
    const int tid = threadIdx.x;
    const bf16_t* Pb = (const bf16_t*)(P.ws + OFF_P);
    const bf16_t* RW = (const bf16_t*)(P.ws + OFF_RW);
    const bf16_t* YF = (const bf16_t*)(P.ws + OFF_YP);
    const bf16_t* YB = YF + (size_t)MROWS * DM;
    bf16_t* MIX = (bf16_t*)(P.ws + OFF_MIX);
    float* ypre = (float*)smem;
    float* sg = ypre + 8 * 256;
    for (int u = blockIdx.x; u < MROWS / 8; u += gridDim.x) {
        const int r0 = u * 8;
        if (l == 1 && (r0 % LTOT) < CTX) continue;
        __syncthreads();
        for (int i = 0; i < 8; ++i) {
            const int row = r0 + i;
            const float y = bf2f(YF[(size_t)row * DM + tid]) + bf2f(YB[(size_t)row * DM + tid]) + P.in[19][l * 256 + tid] * bf2f(Pb[(size_t)row * PIN + tid]);
            ypre[i * 256 + tid] = gelu_tanh(y);
        }
        for (int e = tid; e < 8 * 128; e += 256) sg[e] = bf2f(RW[(size_t)(r0 + (e >> 7)) * RWW + 4096 + (e & 127)]);
        __syncthreads();
        {
            float z[8];
            const float gb = P.in[21][l * 256 + tid];
#pragma unroll
            for (int i = 0; i < 8; ++i) z[i] = gb;
            const float* gw = P.in[20] + (size_t)l * 256 * 256 + tid;
            for (int k = 0; k < 256; ++k) {
                const float w = gw[k * 256];
#pragma unroll
                for (int i = 0; i < 8; ++i) z[i] += ypre[i * 256 + k] * w;
            }
#pragma unroll
            for (int i = 0; i < 8; ++i) MIX[(size_t)(r0 + i) * DM + tid] = f2bf(ypre[i * 256 + tid] * sigmoidf_(z[i]));
        }
        {
            const int i = tid >> 5, c0 = (tid & 31) * 8, row = r0 + i;
            float o[8], ss = 0.f;
#pragma unroll
            for (int j = 0; j < 8; ++j) { o[j] = bf2f(YF[(size_t)row * DM + 256 + c0 + j]) + bf2f(YB[(size_t)row * DM + 256 + c0 + j]); ss += o[j] * o[j]; }
            ss += __shfl_xor(ss, 1, 64); ss += __shfl_xor(ss, 2, 64); ss += __shfl_xor(ss, 4, 64);
            const float rs = rsqrtf(ss * (1.f / 64.f) + 1e-6f);
#pragma unroll
            for (int j = 0; j < 8; ++j) {
                const float gr = bf2f(Pb[(size_t)row * PIN + 256 + 1024 + c0 + j]);
                MIX[(size_t)row * DM + 256 + c0 + j] = f2bf(o[j] * rs * P.in[23][l * 256 + c0 + j] * siluf_(gr));
            }
        }
        {
            const int i = tid >> 5, c0 = (tid & 31) * 16, row = r0 + i;
            const bf16_t* rw = RW + (size_t)row * RWW;
            float y[16], vv[16], sum = 0.f, bon = 0.f;
#pragma unroll
            for (int j = 0; j < 16; ++j) {
                const int c = c0 + j;
                y[j] = bf2f(YF[(size_t)row * DM + 512 + c]) + bf2f(YB[(size_t)row * DM + 512 + c]);
                sum += y[j];
                const float r = bf2f(rw[c]), k = bf2f(rw[512 + c]), af = bf2f(rw[2048 + c]), ab = bf2f(rw[2560 + c]);
                const float ka = P.in[31][l * 512 + c];
                vv[j] = bf2f(rw[1024 + c]);
                bon += r * P.in[32][l * 512 + c] * (k * (1.f + (af - 1.f) * ka) + k * (1.f + (ab - 1.f) * ka));
            }
            sum += __shfl_xor(sum, 1, 64); sum += __shfl_xor(sum, 2, 64);
            bon += __shfl_xor(bon, 1, 64); bon += __shfl_xor(bon, 2, 64);
            const float mean = sum * (1.f / 64.f);
            float var = 0.f;
#pragma unroll
            for (int j = 0; j < 16; ++j) { const float d = y[j] - mean; var += d * d; }
            var += __shfl_xor(var, 1, 64); var += __shfl_xor(var, 2, 64);
            const float rs = rsqrtf(var * (1.f / 64.f) + 64e-5f);
            float g[16];
#pragma unroll
            for (int j = 0; j < 16; ++j) g[j] = 0.f;
            const float* gup = P.in[29] + (size_t)l * 128 * 512 + c0;
            for (int jj = 0; jj < 128; ++jj) {
                const float s = sg[i * 128 + jj];
                const float4 w0 = *(const float4*)(gup + jj * 512), w1 = *(const float4*)(gup + jj * 512 + 4), w2 = *(const float4*)(gup + jj * 512 + 8), w3 = *(const float4*)(gup + jj * 512 + 12);
                g[0] += s * w0.x; g[1] += s * w0.y; g[2] += s * w0.z; g[3] += s * w0.w;
                g[4] += s * w1.x; g[5] += s * w1.y; g[6] += s * w1.z; g[7] += s * w1.w;
                g[8] += s * w2.x; g[9] += s * w2.y; g[10] += s * w2.z; g[11] += s * w2.w;
                g[12] += s * w3.x; g[13] += s * w3.y; g[14] += s * w3.z; g[15] += s * w3.w;
            }
#pragma unroll
            for (int j = 0; j < 16; ++j) {
                const int c = c0 + j;
                const float yn = (y[j] - mean) * rs * P.in[33][l * 512 + c] + P.in[34][l * 512 + c];
                MIX[(size_t)row * DM + 512 + c] = f2bf((yn + bon * vv[j]) * g[j]);
            }
        }
    }
}

__device__ __forceinline__ void phase_ln1(const Params& P, int l) {
    const int lane = threadIdx.x & 63, wave = threadIdx.x >> 6;
    float* XS = (float*)(P.ws + OFF_XS);
    const float* TMP = (const float*)(P.ws + OFF_TMP);
    const float* MOD = (const float*)(P.ws + OFF_MOD);
    bf16_t* H2 = (bf16_t*)(P.ws + OFF_H2);
    for (int row = blockIdx.x * 4 + wave; row < MROWS; row += gridDim.x * 4) {
        if (l == 1 && (row % LTOT) < CTX) continue;
        const float* mod = MOD + (size_t)(l * 5 + modrow(row)) * 6144;
        float v[16]; float s = 0.f;
#pragma unroll
        for (int j = 0; j < 4; ++j) {
            const int d = 256 * j + 4 * lane;
            const float4 x = *(const float4*)(XS + (size_t)row * DM + d), t = *(const float4*)(TMP + (size_t)row * DM + d), g = *(const float4*)(mod + 2048 + d);
            v[4 * j + 0] = ALPHA * x.x + g.x * t.x; v[4 * j + 1] = ALPHA * x.y + g.y * t.y; v[4 * j + 2] = ALPHA * x.z + g.z * t.z; v[4 * j + 3] = ALPHA * x.w + g.w * t.w;
            s += v[4 * j] + v[4 * j + 1] + v[4 * j + 2] + v[4 * j + 3];
        }
        const float mean = wave_sum(s) * (1.f / 1024.f);
        float q = 0.f;
#pragma unroll
        for (int j = 0; j < 16; ++j) { const float d = v[j] - mean; q += d * d; }
        const float rs = rsqrtf(wave_sum(q) * (1.f / 1024.f) + 1e-5f);
#pragma unroll
        for (int j = 0; j < 4; ++j) {
            const int d = 256 * j + 4 * lane;
            const float4 gg = *(const float4*)(P.in[8] + l * 1024 + d), bb = *(const float4*)(P.in[9] + l * 1024 + d);
            const float4 sh = *(const float4*)(mod + 3072 + d), sc = *(const float4*)(mod + 4096 + d);
            float4 o;
            o.x = (v[4 * j + 0] - mean) * rs * gg.x + bb.x; o.y = (v[4 * j + 1] - mean) * rs * gg.y + bb.y;
            o.z = (v[4 * j + 2] - mean) * rs * gg.z + bb.z; o.w = (v[4 * j + 3] - mean) * rs * gg.w + bb.w;
            *(float4*)(XS + (size_t)row * DM + d) = o;
            ushort4 h;
            h.x = f2bf(o.x * (1.f + sc.x) + sh.x); h.y = f2bf(o.y * (1.f + sc.y) + sh.y); h.z = f2bf(o.z * (1.f + sc.z) + sh.z); h.w = f2bf(o.w * (1.f + sc.w) + sh.w);
            *(ushort4*)(H2 + (size_t)row * DM + d) = h;
        }
    }
}

__device__ __forceinline__ unsigned f2ord(float f) { const unsigned u = __float_as_uint(f); return u ^ ((u >> 31) ? 0xFFFFFFFFu : 0x80000000u); }
__device__ __forceinline__ float ord2f(unsigned u) { return __uint_as_float((u >> 31) ? (u ^ 0x80000000u) : ~u); }
__device__ __forceinline__ void phase_topk(const Params& P, int l) {
    const int tid = threadIdx.x;
    const bf16_t* Q = (const bf16_t*)(P.ws + OFF_Q);
    int* IDX = (int*)(P.ws + OFF_IDX);
    float* GATE = (float*)(P.ws + OFF_GATE);
    for (int u = blockIdx.x; u < 8 * (MROWS / 256); u += gridDim.x) {
        const int hd = u / (MROWS / 256), rb = u % (MROWS / 256);
        const int row = rb * 256 + tid;
        if (l == 1 && (row % LTOT) < CTX) continue;
        unsigned top[2][16];
#pragma unroll
        for (int half = 0; half < 2; ++half) {
            float q[128];
            const bf16_t* qp = Q + (size_t)row * 2048 + hd * 256 + half * 128;
#pragma unroll
            for (int d8 = 0; d8 < 16; ++d8) {
                const bf16x8 v = *(const bf16x8*)(qp + d8 * 8);
#pragma unroll
                for (int j = 0; j < 8; ++j) q[d8 * 8 + j] = bf2f((bf16_t)v[j]);
            }
#pragma unroll
            for (int j = 0; j < 16; ++j) top[half][j] = 0u;
            const float* kp = P.in[36] + ((size_t)((l * 8 + hd) * 2 + half)) * 128 * 128;
            for (int key = 0; key < 128; ++key) {
                const float* kr = kp + key * 128;
                float s0 = 0.f, s1 = 0.f, s2 = 0.f, s3 = 0.f;
#pragma unroll
                for (int d = 0; d < 128; d += 4) { s0 += q[d] * kr[d]; s1 += q[d + 1] * kr[d + 1]; s2 += q[d + 2] * kr[d + 2]; s3 += q[d + 3] * kr[d + 3]; if ((d & 31) == 28) __builtin_amdgcn_sched_barrier(0); }
                unsigned x = (f2ord((s0 + s1) + (s2 + s3)) & 0xFFFFFF80u) | (unsigned)(127 - key);
#pragma unroll
                for (int j = 0; j < 16; ++j) { const unsigned t = top[half][j]; const unsigned mx = x > t ? x : t; x = x > t ? t : x; top[half][j] = mx; }
            }
        }
        float cs[16]; int ce[16];
#pragma unroll
        for (int j = 0; j < 16; ++j) { cs[j] = -3.0e38f; ce[j] = 0; }
#pragma unroll
        for (int i = 0; i < 16; ++i) {
            const float s1v = ord2f(top[0][i] & 0xFFFFFF80u); const int i1 = 127 - (int)(top[0][i] & 127u);
#pragma unroll
            for (int j = 0; j < 16; ++j) {
                if ((i + 1) * (j + 1) <= 16) {
                    float x = s1v + ord2f(top[1][j] & 0xFFFFFF80u); int xe = i1 * 128 + (127 - (int)(top[1][j] & 127u));
#pragma unroll
                    for (int t = 0; t < 16; ++t) {
                        const bool gt = x > cs[t];
                        const float ts = cs[t]; const int te = ce[t];
                        cs[t] = gt ? x : ts; ce[t] = gt ? xe : te; x = gt ? ts : x; xe = gt ? te : xe;
                    }
                }
            }
        }
        float den = 0.f, ex[16];
#pragma unroll
        for (int t = 0; t < 16; ++t) { ex[t] = __expf(cs[t] - cs[0]); den += ex[t]; }
        const float inv = 1.f / den;
#pragma unroll
        for (int t = 0; t < 16; ++t) { IDX[(size_t)row * 128 + hd * 16 + t] = ce[t]; GATE[(size_t)row * 128 + hd * 16 + t] = ex[t] * inv; }
    }
}

__device__ __forceinline__ void phase_gather(const Params& P, int l, unsigned char* smem) {
    const int tid = threadIdx.x, lane = tid & 63, wave = tid >> 6;
    float* XS = (float*)(P.ws + OFF_XS);
    const float* MOD = (const float*)(P.ws + OFF_MOD);
    const bf16_t* H2 = (const bf16_t*)(P.ws + OFF_H2);
    bf16_t* H = (bf16_t*)(P.ws + OFF_H);
    const int* IDX = (const int*)(P.ws + OFF_IDX);
    const float* GATE = (const float*)(P.ws + OFF_GATE);
    const float* UT = P.in[37] + (size_t)l * 16384 * 1024;
    const float* VT = P.in[38] + (size_t)l * 16384 * 1024;
    float* coef = (float*)smem;
    int* eidx = (int*)(coef + 128);
    float* red = (float*)(eidx + 128);
    for (int row = blockIdx.x; row < MROWS; row += gridDim.x) {
        if (l == 1 && (row % LTOT) < CTX) continue;
        __syncthreads();
        float hv[16];
#pragma unroll
        for (int j = 0; j < 4; ++j) {
            const ushort4 h = *(const ushort4*)(H2 + (size_t)row * DM + 256 * j + 4 * lane);
            hv[4 * j] = bf2f(h.x); hv[4 * j + 1] = bf2f(h.y); hv[4 * j + 2] = bf2f(h.z); hv[4 * j + 3] = bf2f(h.w);
        }
        for (int kk = 0; kk < 32; ++kk) {
            const int k = wave * 32 + kk;
            const int e = IDX[(size_t)row * 128 + k];
            const float* ur = UT + (size_t)e * 1024;
            float s = 0.f;
#pragma unroll
            for (int j = 0; j < 4; ++j) {
                const float4 uu = *(const float4*)(ur + 256 * j + 4 * lane);
                s += uu.x * hv[4 * j] + uu.y * hv[4 * j + 1] + uu.z * hv[4 * j + 2] + uu.w * hv[4 * j + 3];
            }
            s = wave_sum(s);
            if (lane == 0) { coef[k] = gelu_tanh(s) * GATE[(size_t)row * 128 + k]; eidx[k] = e; }
        }
        __syncthreads();
        float4 acc = {0.f, 0.f, 0.f, 0.f};
        for (int k = 0; k < 128; ++k) {
            const float c = coef[k];
            const float4 vv = *(const float4*)(VT + (size_t)eidx[k] * 1024 + 4 * tid);
            acc.x += c * vv.x; acc.y += c * vv.y; acc.z += c * vv.z; acc.w += c * vv.w;
        }
        const float* mod = MOD + (size_t)(l * 5 + modrow(row)) * 6144;
        const int d = 4 * tid;
        const float4 x = *(const float4*)(XS + (size_t)row * DM + d), g2 = *(const float4*)(mod + 5120 + d);
        float v0 = ALPHA * x.x + g2.x * acc.x, v1 = ALPHA * x.y + g2.y * acc.y, v2 = ALPHA * x.z + g2.z * acc.z, v3 = ALPHA * x.w + g2.w * acc.w;
        float s = wave_sum(v0 + v1 + v2 + v3);
        if (lane == 0) red[wave] = s;
        __syncthreads();
        const float mean = (red[0] + red[1] + red[2] + red[3]) * (1.f / 1024.f);
        const float d0 = v0 - mean, d1 = v1 - mean, d2 = v2 - mean, d3 = v3 - mean;
        float q = wave_sum(d0 * d0 + d1 * d1 + d2 * d2 + d3 * d3);
        if (lane == 0) red[4 + wave] = q;
        __syncthreads();
        const float rs = rsqrtf((red[4] + red[5] + red[6] + red[7]) * (1.f / 1024.f) + 1e-5f);
        const float4 gg = *(const float4*)(P.in[10] + l * 1024 + d), bb = *(const float4*)(P.in[11] + l * 1024 + d);
        float4 o; o.x = d0 * rs * gg.x + bb.x; o.y = d1 * rs * gg.y + bb.y; o.z = d2 * rs * gg.z + bb.z; o.w = d3 * rs * gg.w + bb.w;
        if (l == 0) {
            *(float4*)(XS + (size_t)row * DM + d) = o;
            const float* mod1 = MOD + (size_t)(1 * 5 + modrow(row)) * 6144;
            const float4 sh = *(const float4*)(mod1 + d), sc = *(const float4*)(mod1 + 1024 + d);
            ushort4 h; h.x = f2bf(o.x * (1.f + sc.x) + sh.x); h.y = f2bf(o.y * (1.f + sc.y) + sh.y); h.z = f2bf(o.z * (1.f + sc.z) + sh.z); h.w = f2bf(o.w * (1.f + sc.w) + sh.w);
            *(ushort4*)(H + (size_t)row * DM + d) = h;
        } else {
            const int b = row / LTOT, t = row % LTOT - CTX;
            *(float4*)(P.out + ((size_t)b * SEQ + t) * DM + d) = o;
        }
    }
}

__device__ __forceinline__ void run_phase(const Params& P, int ph, unsigned char* smem) {
    if (ph == 0) { phase_prep(P, smem); return; }
    if (ph == 1) { phase_mkh(P); return; }
    const int l = (ph - 2) / 9, s = (ph - 2) % 9;
    switch (s) {
    case 0: gemm_bf16((const bf16_t*)(P.ws + OFF_H), DM, (const bf16_t*)(P.ws + OFF_WIN) + (size_t)l * PIN * DM, DM, MROWS, PIN, DM, false, EpiBf16{(bf16_t*)(P.ws + OFF_P), PIN}); break;
    case 1: phase_rwprep(P, l, smem); break;
    case 2: phase_scans(P, l); break;
    case 3: phase_post(P, l, smem); break;
    case 4: gemm_bf16((const bf16_t*)(P.ws + OFF_MIX), DM, (const bf16_t*)(P.ws + OFF_WOUT) + (size_t)l * DM * DM, DM, MROWS, DM, DM, l == 1, EpiF32{(float*)(P.ws + OFF_TMP), DM}); break;
    case 5: phase_ln1(P, l); break;
    case 6: gemm_bf16((const bf16_t*)(P.ws + OFF_H2), DM, (const bf16_t*)(P.ws + OFF_WQ) + (size_t)l * 2048 * DM, DM, MROWS, 2048, DM, l == 1, EpiBf16{(bf16_t*)(P.ws + OFF_Q), 2048}); break;
    case 7: phase_topk(P, l); break;
    case 8: phase_gather(P, l, smem); break;
    }
}

__global__ void __launch_bounds__(256) mega(Params P) {
    __shared__ __attribute__((aligned(16))) unsigned char smem[40960];
#if SINGLE
    cg::grid_group grid = cg::this_grid();
#endif
    for (int ph = P.ph_lo; ph < P.ph_hi; ++ph) {
        run_phase(P, ph, smem);
#if SINGLE
        if (ph + 1 < P.ph_hi) grid.sync();
#endif
    }
}

extern "C" void kernel_launch(void* const* d_in, const int* in_sizes, int n_in, void* d_out, int out_size, void* d_ws, size_t ws_size, hipStream_t stream) {
    static int grid = 0;
    if (grid == 0) {
        if (n_in != 39 || ws_size < OFF_END) { fprintf(stderr, "kernel_launch: unexpected n_in %d or ws_size %zu (need %zu)\n", n_in, ws_size, (size_t)OFF_END); grid = -1; return; }
        int dev = 0, cus = 0, per_cu = 0;
        hipGetDevice(&dev);
        hipDeviceGetAttribute(&cus, hipDeviceAttributeMultiprocessorCount, dev);
        hipOccupancyMaxActiveBlocksPerMultiprocessor(&per_cu, mega, 256, 0);
        if (per_cu < 1) per_cu = 1;
        if (per_cu > 2) per_cu = 2;
        grid = cus * per_cu;
    }
    if (grid < 0) return;
    Params p{};
    for (int i = 0; i < 39; ++i) p.in[i] = (const float*)d_in[i];
    p.out = (float*)d_out; p.ws = (unsigned char*)d_ws;
#if SINGLE
    p.ph_lo = 0; p.ph_hi = NPH;
    void* args[] = {&p};
    hipError_t e = hipLaunchCooperativeKernel((void*)mega, dim3(grid), dim3(256), args, 0, stream);
    if (e != hipSuccess) fprintf(stderr, "cooperative launch failed: %s (grid %d)\n", hipGetErrorString(e), grid);
#else
    for (int ph = 0; ph < NPH; ++ph) {
        p.ph_lo = ph; p.ph_hi = ph + 1;
        hipLaunchKernelGGL(mega, dim3(grid), dim3(256), 0, stream, p);
    }
#endif
}
```

```cpp
#include <hip/hip_runtime.h>
#include <hip/hip_cooperative_groups.h>
#include <cstdio>
namespace cg = cooperative_groups;

#ifndef SINGLE
#define SINGLE 1
#endif

typedef unsigned short bf16_t;
typedef short bf16x8 __attribute__((ext_vector_type(8)));
typedef float f32x4 __attribute__((ext_vector_type(4)));
typedef __bf16 bf16x2 __attribute__((ext_vector_type(2)));

#define DM 1024
#define NB 4
#define SEQ 4096
#define CTX 256
#define LTOT 4352
#define MROWS 17408
#define PIN 3456
#define RWW 4224
#define NPH 24
#define PPL 11
#define ALPHA 1.41421356237f

#define OFF_XS 0ull
#define OFF_P (OFF_XS + (size_t)MROWS * DM * 4)
#define OFF_RW (OFF_P + (size_t)MROWS * PIN * 2)
#define OFF_YP (OFF_RW + (size_t)MROWS * RWW * 2)
#define OFF_MIX (OFF_YP + (size_t)2 * MROWS * DM * 2)
#define OFF_MOD (OFF_MIX + (size_t)MROWS * DM * 2)
#define OFF_WIN (OFF_MOD + (size_t)2 * 5 * 6144 * 4)
#define OFF_WOUT (OFF_WIN + (size_t)2 * PIN * DM * 2)
#define OFF_WQ (OFF_WOUT + (size_t)2 * DM * DM * 2)
#define OFF_S5MS (OFF_WQ + (size_t)2 * 2048 * DM * 2)
#define OFF_S5MY (OFF_S5MS + (size_t)2 * 16 * 256 * 256 * 2)
#define OFF_S5LB (OFF_S5MY + (size_t)2 * 16 * 256 * 512 * 2)
#define OFF_S5ST (OFF_S5LB + (size_t)2 * 16 * 2 * 128 * 4)
#define OFF_BAR (OFF_S5ST + (size_t)4 * 16 * 272 * 256 * 4)
#define OFF_RXP (OFF_BAR + 16384)
#define OFF_END (OFF_RXP + (size_t)2176 * 8192)
#define OFF_RXL OFF_MIX
#define OFF_TMP OFF_P
#define OFF_H OFF_YP
#define OFF_H2 (OFF_YP + (size_t)MROWS * DM * 2)
#define OFF_Q OFF_RW
#define OFF_IDX (OFF_RW + (size_t)MROWS * 2048 * 2)
#define OFF_GATE (OFF_IDX + (size_t)MROWS * 128 * 4)
#define OFF_TBU OFF_P
#define OFF_TBV (OFF_P + (size_t)16384 * 1024 * 2)

struct Params {
    const float* in[39];
    float* out;
    unsigned char* ws;
    int ph_lo, ph_hi;
};

__device__ __forceinline__ bf16_t f2bf(float f) {
    unsigned u = __float_as_uint(f);
    u += 0x7FFFu + ((u >> 16) & 1u);
    return (bf16_t)(u >> 16);
}
__device__ __forceinline__ float bf2f(bf16_t h) { return __uint_as_float(((unsigned)h) << 16); }
__device__ __forceinline__ float sigmoidf_(float x) { return 1.f / (1.f + __expf(-x)); }
__device__ __forceinline__ float siluf_(float x) { return x * sigmoidf_(x); }
__device__ __forceinline__ float gelu_tanh(float x) {
    const float u = 0.7978845608028654f * (x + 0.044715f * x * x * x);
    return 0.5f * x * (1.f + tanhf(u));
}
__device__ __forceinline__ float wave_sum(float v) {
#pragma unroll
    for (int o = 32; o > 0; o >>= 1) v += __shfl_xor(v, o, 64);
    return v;
}
__device__ __forceinline__ float rdlane(float v, int l) { return __int_as_float(__builtin_amdgcn_readlane(__float_as_int(v), l)); }
__device__ __forceinline__ int row_of(int b, int dir, int tau) {
    const int p = dir == 0 ? tau : (tau < CTX ? (CTX - 1 - tau) : (LTOT + CTX - 1 - tau));
    return b * LTOT + p;
}
__device__ __forceinline__ int modrow(int row) { const int p = row % LTOT; return p < CTX ? 4 : row / LTOT; }

__device__ __forceinline__ void s5_prep_unit(const Params& P, int l, int g, unsigned char* smem);

#define XB_TMO      128
#define XB_XCNT(j)  (256  + 64 * (j))
#define XB_XSUB(j)  (1280 + 64 * (j))
#define XB_XGEN(j)  (2304 + 64 * (j))
#define XB_TOP      3328
#define XB_TOPGEN   3392
#define XCD_BAR_WORDS 3456
#define XB_SPIN_CAP (1u << 22)
#define LAS __attribute__((address_space(3)))
__device__ __forceinline__ unsigned xb_ld(unsigned* p)              { return __hip_atomic_load(p, __ATOMIC_RELAXED, __HIP_MEMORY_SCOPE_AGENT); }
__device__ __forceinline__ unsigned xb_add(unsigned* p, unsigned v) { return __hip_atomic_fetch_add(p, v, __ATOMIC_RELAXED, __HIP_MEMORY_SCOPE_AGENT); }
__device__ __forceinline__ unsigned xb_xcc_id() { return (unsigned)__builtin_amdgcn_s_getreg((3 << 11) | 20) & 0xFu; }
#define XB_SPIN(cond, bar) do { unsigned _sp = 0; while (cond) { __builtin_amdgcn_s_sleep(1); \
    if ((++_sp & 255u) == 0u) { if (xb_ld(&(bar)[XB_TMO])) break; if (_sp > XB_SPIN_CAP) { atomicAdd(&(bar)[XB_TMO], 1u); break; } } } } while (0)
struct XcdBarrier { unsigned* bar; unsigned x; volatile LAS unsigned* st; };
__device__ __forceinline__ XcdBarrier xcd_barrier_post(unsigned* bar, volatile LAS unsigned* st) {
    XcdBarrier b; b.bar = bar; b.x = xb_xcc_id(); b.st = st;
    if (threadIdx.x == 0) (void)xb_add(&bar[XB_XCNT(b.x)], 1u);
    return b;
}
__device__ __forceinline__ void xcd_barrier_complete(unsigned* bar, unsigned x, unsigned& nloc, unsigned& nx) {
    const unsigned G = gridDim.x * gridDim.y * gridDim.z;
    unsigned sum, cnt, mine, sp = 0u;
    for (;;) {
        sum = 0u; cnt = 0u; mine = 0u;
#pragma unroll
        for (unsigned j = 0; j < 16; ++j) { const unsigned c = xb_ld(&bar[XB_XCNT(j)]); sum += c; cnt += (c > 0u) ? 1u : 0u; mine = (j == x) ? c : mine; }
        if (sum == G) break;
        __builtin_amdgcn_s_sleep(1);
        if ((++sp & 255u) == 0u) { if (xb_ld(&bar[XB_TMO])) break; if (sp > XB_SPIN_CAP) { atomicAdd(&bar[XB_TMO], 1u); break; } }
    }
    nloc = mine > 0u ? mine : 1u; nx = cnt > 0u ? cnt : 1u;
}
__device__ __forceinline__ void xcd_barrier(const XcdBarrier& b) {
    asm volatile("s_waitcnt vmcnt(0)" ::: "memory");
    __syncthreads();
    if (threadIdx.x == 0) {
        unsigned* bar = b.bar;
        __builtin_amdgcn_s_waitcnt(0);
        unsigned nloc = b.st[0], nx = b.st[1];
        if (nloc == 0u) { xcd_barrier_complete(bar, b.x, nloc, nx); b.st[0] = nloc; b.st[1] = nx; }
        const unsigned old = xb_add(&bar[XB_XSUB(b.x)], 1u);
        const unsigned gen = old / nloc;
        if (old + 1u == (gen + 1u) * nloc) {
            __builtin_amdgcn_fence(__ATOMIC_RELEASE, "agent");
            asm volatile("s_waitcnt vmcnt(0)" ::: "memory");
            const unsigned og = xb_add(&bar[XB_TOP], 1u);
            const unsigned tg = og / nx;
            if (og + 1u == (tg + 1u) * nx) xb_add(&bar[XB_TOPGEN], 1u);
            else XB_SPIN(xb_ld(&bar[XB_TOPGEN]) == tg, bar);
            __builtin_amdgcn_fence(__ATOMIC_ACQUIRE, "agent");
            xb_add(&bar[XB_XGEN(b.x)], 1u);
            asm volatile("s_waitcnt vmcnt(0)" ::: "memory");
        } else {
            XB_SPIN(xb_ld(&bar[XB_XGEN(b.x)]) == gen, bar);
            __builtin_amdgcn_fence(__ATOMIC_ACQUIRE, "agent");
            asm volatile("s_waitcnt vmcnt(0)" ::: "memory");
        }
    }
    __syncthreads();
}

__device__ __forceinline__ void phase_prep(const Params& P, unsigned char* smem) {
    const int tid = threadIdx.x, lane = tid & 63, wave = __builtin_amdgcn_readfirstlane(tid >> 6);
    float* MOD = (float*)(P.ws + OFF_MOD);
    float* XS = (float*)(P.ws + OFF_XS);
    const int U_MOD = 192, U_COPY = MROWS / 16, U_TIN = 2 * 16 * 54, U_TOUT = 2 * 16 * 16, U_TQ = 2 * 16 * 32;
    const int U_S5 = 32;
    const int total = U_S5 + U_MOD + U_COPY + U_TIN + U_TOUT + U_TQ;
    for (int u0 = blockIdx.x; u0 < total; u0 += gridDim.x) {
        __syncthreads();
        if (u0 < U_S5) { s5_prep_unit(P, u0 >> 4, u0 & 15, smem); continue; }
        const int u = u0 - U_S5;
        if (u < U_MOD) {
            const int l = u / 96, j0 = (u % 96) * 64;
            float* sl = (float*)smem;
            for (int i = tid; i < 5 * 1024; i += 256) {
                const int r = i >> 10, k = i & 1023;
                const float cv = r < 4 ? P.in[1][r * 1024 + k] : P.in[3][k];
                sl[i] = siluf_(cv);
            }
            __syncthreads();
            float acc[5] = {0.f, 0.f, 0.f, 0.f, 0.f};
            const float* W = P.in[4] + (size_t)l * 1024 * 6144 + j0 + lane;
            for (int k = wave * 256; k < wave * 256 + 256; ++k) {
                const float w = W[(size_t)k * 6144];
#pragma unroll
                for (int r = 0; r < 5; ++r) acc[r] += sl[r * 1024 + k] * w;
            }
            float* red = (float*)(smem + 5 * 1024 * 4);
#pragma unroll
            for (int r = 0; r < 5; ++r) red[(wave * 5 + r) * 64 + lane] = acc[r];
            __syncthreads();
            for (int i = tid; i < 5 * 64; i += 256) {
                const int r = i / 64, jj = i % 64;
                float s = P.in[5][l * 6144 + j0 + jj];
                for (int w = 0; w < 4; ++w) s += red[(w * 5 + r) * 64 + jj];
                MOD[(l * 5 + r) * 6144 + j0 + jj] = s;
            }
        } else if (u < U_MOD + U_COPY) {
            const int r0 = (u - U_MOD) * 16;
            for (int i = tid; i < 16 * 256; i += 256) {
                const int row = r0 + (i >> 8), c4 = i & 255;
                const int b = row / LTOT, p = row % LTOT;
                const float4* src = p < CTX ? (const float4*)(P.in[2] + ((size_t)b * CTX + p) * DM) : (const float4*)(P.in[0] + ((size_t)b * SEQ + (p - CTX)) * DM);
                ((float4*)(XS + (size_t)row * DM))[c4] = src[c4];
            }
        } else {
            int v = u - U_MOD - U_COPY;
            const float* W; bf16_t* Wt; int N;
            if (v < U_TIN) { const int l = v / (16 * 54); v %= 16 * 54; N = PIN; W = P.in[6] + (size_t)l * 1024 * PIN; Wt = (bf16_t*)(P.ws + OFF_WIN) + (size_t)l * PIN * 1024; }
            else if (v < U_TIN + U_TOUT) { v -= U_TIN; const int l = v / 256; v %= 256; N = 1024; W = P.in[7] + (size_t)l * 1024 * 1024; Wt = (bf16_t*)(P.ws + OFF_WOUT) + (size_t)l * 1024 * 1024; }
            else { v -= U_TIN + U_TOUT; const int l = v / 512; v %= 512; N = 2048; W = P.in[35] + (size_t)l * 1024 * 2048; Wt = (bf16_t*)(P.ws + OFF_WQ) + (size_t)l * 2048 * 1024; }
            const int ntn = N / 64, kt = v / ntn, nt = v % ntn;
            float* t = (float*)smem;
            for (int i = tid; i < 64 * 64; i += 256) { const int kk = i >> 6, nn = i & 63; t[kk * 65 + nn] = W[(size_t)(kt * 64 + kk) * N + nt * 64 + nn]; }
            __syncthreads();
            for (int i = tid; i < 64 * 64; i += 256) { const int nn = i >> 6, kk = i & 63; Wt[(size_t)(nt * 64 + nn) * 1024 + kt * 64 + kk] = f2bf(t[kk * 65 + nn]); }
        }
    }
}

__device__ __forceinline__ void phase_mkh(const Params& P) {
    const int lane = threadIdx.x & 63, wave = __builtin_amdgcn_readfirstlane(threadIdx.x >> 6);
    const float* XS = (const float*)(P.ws + OFF_XS);
    const float* MOD = (const float*)(P.ws + OFF_MOD);
    bf16_t* H = (bf16_t*)(P.ws + OFF_H);
    for (int row = blockIdx.x * 4 + wave; row < MROWS; row += gridDim.x * 4) {
        const float* mod = MOD + (size_t)(0 * 5 + modrow(row)) * 6144;
#pragma unroll
        for (int j = 0; j < 4; ++j) {
            const int d = 256 * j + 4 * lane;
            const float4 x = *(const float4*)(XS + (size_t)row * DM + d);
            const float4 sh = *(const float4*)(mod + d), sc = *(const float4*)(mod + 1024 + d);
            ushort4 o;
            o.x = f2bf(x.x * (1.f + sc.x) + sh.x); o.y = f2bf(x.y * (1.f + sc.y) + sh.y);
            o.z = f2bf(x.z * (1.f + sc.z) + sh.z); o.w = f2bf(x.w * (1.f + sc.w) + sh.w);
            *(ushort4*)(H + (size_t)row * DM + d) = o;
        }
    }
}

template <class EPI>
__device__ __forceinline__ void gemm_bf16(const bf16_t* A, int lda, const bf16_t* Bt, int ldb, int M, int N, int K, bool skipctx, EPI epi) {
    const int lane = threadIdx.x & 63, wave = __builtin_amdgcn_readfirstlane(threadIdx.x >> 6);
    const int ntm = M / 128, ntn = N / 128;
    const int fr = lane & 15, fq = lane >> 4;
    for (int tile = blockIdx.x; tile < ntm * ntn; tile += gridDim.x) {
        const int tm = tile / ntn, tn = tile % ntn;
        const int m0 = tm * 128 + (wave >> 1) * 64, n0 = tn * 128 + (wave & 1) * 64;
        if (skipctx && (m0 % LTOT) < CTX) continue;
        f32x4 acc[4][4];
#pragma unroll
        for (int i = 0; i < 4; ++i)
#pragma unroll
            for (int j = 0; j < 4; ++j) acc[i][j] = (f32x4){0.f, 0.f, 0.f, 0.f};
        const bf16_t* ap = A + (size_t)(m0 + fr) * lda + 8 * fq;
        const bf16_t* bp = Bt + (size_t)(n0 + fr) * ldb + 8 * fq;
        for (int k0 = 0; k0 < K; k0 += 32) {
            bf16x8 a[4], b[4];
#pragma unroll
            for (int i = 0; i < 4; ++i) a[i] = *(const bf16x8*)(ap + (size_t)(16 * i) * lda + k0);
#pragma unroll
            for (int j = 0; j < 4; ++j) b[j] = *(const bf16x8*)(bp + (size_t)(16 * j) * ldb + k0);
#pragma unroll
            for (int i = 0; i < 4; ++i)
#pragma unroll
                for (int j = 0; j < 4; ++j) acc[i][j] = __builtin_amdgcn_mfma_f32_16x16x32_bf16(a[i], b[j], acc[i][j], 0, 0, 0);
        }
#pragma unroll
        for (int i = 0; i < 4; ++i)
#pragma unroll
            for (int j = 0; j < 4; ++j)
#pragma unroll
                for (int r = 0; r < 4; ++r) epi(m0 + 16 * i + 4 * fq + r, n0 + 16 * j + fr, acc[i][j][r]);
    }
}
struct EpiBf16 { bf16_t* C; int ldc; __device__ __forceinline__ void operator()(int r, int c, float v) const { C[(size_t)r * ldc + c] = f2bf(v); } };
struct EpiF32 { float* C; int ldc; __device__ __forceinline__ void operator()(int r, int c, float v) const { C[(size_t)r * ldc + c] = v; } };

__device__ __forceinline__ void phase_rwprep(const Params& P, int l, unsigned char* smem) {
    const int tid = threadIdx.x;
    const bf16_t* Pb = (const bf16_t*)(P.ws + OFF_P);
    bf16_t* RW = (bf16_t*)(P.ws + OFF_RW);
    const float* mu = P.in[24] + l * 1920;
    const float* k_k = P.in[30] + l * 512;
    float* tw = (float*)smem;
    float* al = tw + 2 * 8 * 64;
    float* kk2 = al + 2 * 8 * 64;
    float* nrm = kk2 + 8 * 512;
    for (int u = blockIdx.x; u < MROWS / 8; u += gridDim.x) {
        const int r0 = u * 8;
        __syncthreads();
        for (int i = 0; i < 8; ++i) {
            const int row = r0 + i, p = row % LTOT;
            int nb[4]; bool ok[4];
            if (p < CTX) {
                nb[0] = row - 1; ok[0] = p > 0; nb[1] = row + 1; ok[1] = p < CTX - 1; nb[2] = nb[0]; ok[2] = ok[0]; nb[3] = nb[1]; ok[3] = ok[1];
            } else {
                const int t = p - CTX, gr = t >> 6, gc = t & 63;
                nb[0] = row - 1; ok[0] = gc > 0; nb[1] = row + 1; ok[1] = gc < 63; nb[2] = row - 64; ok[2] = gr > 0; nb[3] = row + 64; ok[3] = gr < 63;
            }
            for (int c = tid; c < 1920; c += 256) {
                const int m = c & 3;
                const float pv = bf2f(Pb[(size_t)row * PIN + 1536 + c]);
                const float nv = ok[m] ? bf2f(Pb[(size_t)nb[m] * PIN + 1536 + c]) : 0.f;
                const float s = pv + mu[c] * (nv - pv);
                bf16_t* rw = RW + (size_t)row * RWW;
                if (c < 512) rw[c] = f2bf(s);
                else if (c < 1024) { rw[c] = f2bf(s); kk2[i * 512 + (c - 512)] = s * k_k[c - 512]; }
                else if (c < 1536) rw[c] = f2bf(s);
                else if (c < 1664) rw[4096 + (c - 1536)] = f2bf(sigmoidf_(s));
                else if (c < 1728) tw[(0 * 8 + i) * 64 + (c - 1664)] = tanhf(s);
                else if (c < 1792) tw[(1 * 8 + i) * 64 + (c - 1728)] = tanhf(s);
                else if (c < 1856) al[(0 * 8 + i) * 64 + (c - 1792)] = s;
                else al[(1 * 8 + i) * 64 + (c - 1856)] = s;
            }
        }
        __syncthreads();
        {
            const int pair = tid >> 2, q = tid & 3, i = pair >> 3, hd = pair & 7;
            float s = 0.f;
            for (int j = 0; j < 16; ++j) { const float v = kk2[i * 512 + hd * 64 + q * 16 + j]; s += v * v; }
            s += __shfl_xor(s, 1, 64); s += __shfl_xor(s, 2, 64);
            if (q == 0) nrm[pair] = fmaxf(sqrtf(s), 1e-12f);
        }
        __syncthreads();
        for (int e = tid; e < 8 * 512; e += 256) {
            const int i = e >> 9, c = e & 511;
            RW[(size_t)(r0 + i) * RWW + 1536 + c] = f2bf(kk2[e] / nrm[i * 8 + (c >> 6)]);
        }
        for (int d = 0; d < 2; ++d) {
            const float* wup = P.in[26] + (size_t)(l * 2 + d) * 64 * 512;
            const float* aup = P.in[28] + (size_t)(l * 2 + d) * 64 * 512;
            const float* w0 = P.in[25] + (l * 2 + d) * 512;
            const float* a0 = P.in[27] + (l * 2 + d) * 512;
            float zw[2][8], za[2][8];
#pragma unroll
            for (int i = 0; i < 8; ++i) { zw[0][i] = zw[1][i] = za[0][i] = za[1][i] = 0.f; }
            for (int j = 0; j < 64; ++j) {
                const float w_0 = wup[j * 512 + tid], w_1 = wup[j * 512 + tid + 256];
                const float a_0 = aup[j * 512 + tid], a_1 = aup[j * 512 + tid + 256];
#pragma unroll
                for (int i = 0; i < 8; ++i) {
                    const float t = tw[(d * 8 + i) * 64 + j], a = al[(d * 8 + i) * 64 + j];
                    zw[0][i] += t * w_0; zw[1][i] += t * w_1; za[0][i] += a * a_0; za[1][i] += a * a_1;
                }
            }
#pragma unroll
            for (int i = 0; i < 8; ++i) {
                bf16_t* rw = RW + (size_t)(r0 + i) * RWW;
#pragma unroll
                for (int h = 0; h < 2; ++h) {
                    const int c = tid + 256 * h;
                    rw[2048 + d * 512 + c] = f2bf(sigmoidf_(a0[c] + za[h][i]));
                    rw[3072 + d * 512 + c] = f2bf(-0.60653066f * sigmoidf_(w0[c] + zw[h][i]));
                }
            }
        }
    }
}

__device__ __forceinline__ void scan_rwkv(const Params& P, int l, int item) {
    const int lane = threadIdx.x & 63;
    const int dir = item & 1, hd = (item >> 1) & 7, b = item >> 4;
    const bf16_t* RW = (const bf16_t*)(P.ws + OFF_RW);
    bf16_t* YP = (bf16_t*)(P.ws + OFF_YP) + (size_t)dir * MROWS * DM;
    const float ka = P.in[31][l * 512 + hd * 64 + lane];
    float S[64];
#pragma unroll
    for (int k = 0; k < 64; ++k) S[k] = 0.f;
    for (int tau = 0; tau < LTOT; ++tau) {
        const int row = row_of(b, dir, tau);
#ifdef EXP_T2
        if ((tau & 127) == 0) {
            float* RXL = (float*)(P.ws + OFF_RXL);
            const size_t itm = (size_t)item * 34 + (tau >> 7);
#pragma unroll
            for (int kk = 0; kk < 64; ++kk) RXL[((itm * 16 + (kk >> 4) * 4 + (lane >> 4)) * 64 + ((kk >> 2) & 3) * 16 + (lane & 15)) * 4 + (kk & 3)] = S[kk];
        }
#endif
        const bf16_t* rw = RW + (size_t)row * RWW + hd * 64 + lane;
        const float r = bf2f(rw[0]), k = bf2f(rw[512]), v = bf2f(rw[1024]), kap = bf2f(rw[1536]);
        const float a = bf2f(rw[2048 + dir * 512]), lw = bf2f(rw[3072 + dir * 512]);
        const float w = __expf(lw), kt = k * (1.f + (a - 1.f) * ka), beta = kap * a;
        float sk = 0.f;
#pragma unroll
        for (int kk = 0; kk < 64; ++kk) { sk += S[kk] * rdlane(kap, kk); if ((kk & 7) == 7) __builtin_amdgcn_sched_barrier(0); }
        float y = 0.f;
#pragma unroll
        for (int kk = 0; kk < 64; ++kk) {
            const float s = S[kk] * rdlane(w, kk) - sk * rdlane(beta, kk) + v * rdlane(kt, kk);
            S[kk] = s;
            y += s * rdlane(r, kk);
            if ((kk & 3) == 3) __builtin_amdgcn_sched_barrier(0);
        }
        YP[(size_t)row * DM + 512 + hd * 64 + lane] = f2bf(y);
    }
}
__device__ __forceinline__ void scan_hgrn(const Params& P, int l, int item) {
    const int lane = threadIdx.x & 63;
    const int dir = item & 1, hd = (item >> 1) & 3, b = item >> 3;
    const bf16_t* Pb = (const bf16_t*)(P.ws + OFF_P);
    bf16_t* YP = (bf16_t*)(P.ws + OFF_YP) + (size_t)dir * MROWS * DM;
    float lb = 0.f;
    if (l == 1) {
        const float a0 = P.in[22][(dir * 2 + 0) * 256 + hd * 64 + lane], a1 = P.in[22][(dir * 2 + 1) * 256 + hd * 64 + lane];
        const float m = fmaxf(a0, a1), e0 = __expf(a0 - m), e1 = __expf(a1 - m);
        lb = e1 / (e0 + e1);
    }
    float S[64];
#pragma unroll
    for (int k = 0; k < 64; ++k) S[k] = 0.f;
    for (int tau = 0; tau < LTOT; ++tau) {
        const int row = row_of(b, dir, tau);
        const bf16_t* pr = Pb + (size_t)row * PIN + 256 + hd * 64 + lane;
        const float q = siluf_(bf2f(pr[0])), v = bf2f(pr[256]);
        const float f = lb + (1.f - lb) * sigmoidf_(bf2f(pr[512 + dir * 256]));
        const float kq = 1.f - f;
        float o = 0.f;
#pragma unroll
        for (int dk = 0; dk < 64; ++dk) {
            const float s = rdlane(f, dk) * S[dk] + rdlane(kq, dk) * v;
            S[dk] = s;
            o += s * rdlane(q, dk);
            if ((dk & 7) == 7) __builtin_amdgcn_sched_barrier(0);
        }
        YP[(size_t)row * DM + 256 + hd * 64 + lane] = f2bf(o);
    }
}
__device__ __forceinline__ void scan_s5(const Params& P, int l, int item) {
    const int lane = threadIdx.x & 63;
    const int dir = item & 1, g = (item >> 1) & 15, b = item >> 5;
    const bf16_t* Pb = (const bf16_t*)(P.ws + OFF_P);
    bf16_t* YP = (bf16_t*)(P.ws + OFF_YP) + (size_t)dir * MROWS * DM;
    const int ldg = (l * 2 + dir) * 16 + g;
    const float dt = expf(P.in[14][ldg]);
    const float lre = P.in[12][ldg * 64 + lane], lim = P.in[13][ldg * 64 + lane];
    const float mag = expf(lre * dt), ang = lim * dt;
    const float lb_re = mag * cosf(ang), lb_im = mag * sinf(ang);
    const float den = lre * lre + lim * lim, nr = lb_re - 1.f, ni = lb_im;
    const float co_re = (nr * lre + ni * lim) / den, co_im = (ni * lre - nr * lim) / den;
    float bb_re[16], bb_im[16], c_re[16], c_im[16];
#pragma unroll
    for (int h = 0; h < 16; ++h) {
        const float br = P.in[15][((size_t)ldg * 64 + lane) * 16 + h], bi = P.in[16][((size_t)ldg * 64 + lane) * 16 + h];
        bb_re[h] = co_re * br - co_im * bi; bb_im[h] = co_re * bi + co_im * br;
        c_re[h] = P.in[17][((size_t)ldg * 16 + h) * 64 + lane]; c_im[h] = P.in[18][((size_t)ldg * 16 + h) * 64 + lane];
    }
    float s_re = 0.f, s_im = 0.f;
    for (int tau = 0; tau < LTOT; ++tau) {
        const int row = row_of(b, dir, tau);
        const float uv = bf2f(Pb[(size_t)row * PIN + g * 16 + (lane & 15)]);
        float bu_re = 0.f, bu_im = 0.f;
#pragma unroll
        for (int h = 0; h < 16; ++h) { const float uh = rdlane(uv, h); bu_re += bb_re[h] * uh; bu_im += bb_im[h] * uh; }
        const float n_re = lb_re * s_re - lb_im * s_im + bu_re, n_im = lb_re * s_im + lb_im * s_re + bu_im;
        s_re = n_re; s_im = n_im;
        float yo = 0.f;
#pragma unroll
        for (int h = 0; h < 16; ++h) { const float t = wave_sum(c_re[h] * s_re - c_im[h] * s_im); yo = (lane == h) ? t : yo; }
        if (lane < 16) YP[(size_t)row * DM + g * 16 + lane] = f2bf(yo);
    }
}
__device__ __forceinline__ void phase_scans(const Params& P, int l) {
    const int wave = __builtin_amdgcn_readfirstlane(threadIdx.x >> 6);
    for (int it = wave * gridDim.x + blockIdx.x; it < 32; it += 4 * gridDim.x) scan_hgrn(P, l, it);
}

__device__ __forceinline__ void phase_post(const Params& P, int l, unsigned char* smem) {
    const int tid = threadIdx.x;
    const bf16_t* Pb = (const bf16_t*)(P.ws + OFF_P);
    const bf16_t* RW = (const bf16_t*)(P.ws + OFF_RW);
    const bf16_t* YF = (const bf16_t*)(P.ws + OFF_YP);
    const bf16_t* YB = YF + (size_t)MROWS * DM;
    bf16_t* MIX = (bf16_t*)(P.ws + OFF_MIX);
    float* ypre = (float*)smem;
    float* sg = ypre + 8 * 256;
    for (int u = blockIdx.x; u < MROWS / 8; u += gridDim.x) {
        const int r0 = u * 8;
        if (l == 1 && (r0 % LTOT) < CTX) continue;
        __syncthreads();
        for (int i = 0; i < 8; ++i) {
            const int row = r0 + i;
            ypre[i * 256 + tid] = bf2f(YF[(size_t)row * DM + tid]);
        }
        for (int e = tid; e < 8 * 128; e += 256) sg[e] = bf2f(RW[(size_t)(r0 + (e >> 7)) * RWW + 4096 + (e & 127)]);
        __syncthreads();
        {
            float z[8];
            const float gb = P.in[21][l * 256 + tid];
#pragma unroll
            for (int i = 0; i < 8; ++i) z[i] = gb;
            const float* gw = P.in[20] + (size_t)l * 256 * 256 + tid;
            for (int k = 0; k < 256; ++k) {
                const float w = gw[k * 256];
#pragma unroll
                for (int i = 0; i < 8; ++i) z[i] += ypre[i * 256 + k] * w;
            }
#pragma unroll
            for (int i = 0; i < 8; ++i) MIX[(size_t)(r0 + i) * DM + tid] = f2bf(ypre[i * 256 + tid] * sigmoidf_(z[i]));
        }
        {
            const int i = tid >> 5, c0 = (tid & 31) * 8, row = r0 + i;
            float o[8], ss = 0.f;
#pragma unroll
            for (int j = 0; j < 8; ++j) { o[j] = bf2f(YF[(size_t)row * DM + 256 + c0 + j]) + bf2f(YB[(size_t)row * DM + 256 + c0 + j]); ss += o[j] * o[j]; }
            ss += __shfl_xor(ss, 1, 64); ss += __shfl_xor(ss, 2, 64); ss += __shfl_xor(ss, 4, 64);
            const float rs = rsqrtf(ss * (1.f / 64.f) + 1e-6f);
#pragma unroll
            for (int j = 0; j < 8; ++j) {
                const float gr = bf2f(Pb[(size_t)row * PIN + 256 + 1024 + c0 + j]);
                MIX[(size_t)row * DM + 256 + c0 + j] = f2bf(o[j] * rs * P.in[23][l * 256 + c0 + j] * siluf_(gr));
            }
        }
        {
            const int i = tid >> 5, c0 = (tid & 31) * 16, row = r0 + i;
            const bf16_t* rw = RW + (size_t)row * RWW;
            float y[16], vv[16], sum = 0.f, bon = 0.f;
#pragma unroll
            for (int j = 0; j < 16; ++j) {
                const int c = c0 + j;
                y[j] = bf2f(YF[(size_t)row * DM + 512 + c]) + bf2f(YB[(size_t)row * DM + 512 + c]);
                sum += y[j];
                const float r = bf2f(rw[c]), k = bf2f(rw[512 + c]), af = bf2f(rw[2048 + c]), ab = bf2f(rw[2560 + c]);
                const float ka = P.in[31][l * 512 + c];
                vv[j] = bf2f(rw[1024 + c]);
                bon += r * P.in[32][l * 512 + c] * (k * (1.f + (af - 1.f) * ka) + k * (1.f + (ab - 1.f) * ka));
            }
            sum += __shfl_xor(sum, 1, 64); sum += __shfl_xor(sum, 2, 64);
            bon += __shfl_xor(bon, 1, 64); bon += __shfl_xor(bon, 2, 64);
            const float mean = sum * (1.f / 64.f);
            float var = 0.f;
#pragma unroll
            for (int j = 0; j < 16; ++j) { const float d = y[j] - mean; var += d * d; }
            var += __shfl_xor(var, 1, 64); var += __shfl_xor(var, 2, 64);
            const float rs = rsqrtf(var * (1.f / 64.f) + 64e-5f);
            float g[16];
#pragma unroll
            for (int j = 0; j < 16; ++j) g[j] = 0.f;
            const float* gup = P.in[29] + (size_t)l * 128 * 512 + c0;
            for (int jj = 0; jj < 128; ++jj) {
                const float s = sg[i * 128 + jj];
                const float4 w0 = *(const float4*)(gup + jj * 512), w1 = *(const float4*)(gup + jj * 512 + 4), w2 = *(const float4*)(gup + jj * 512 + 8), w3 = *(const float4*)(gup + jj * 512 + 12);
                g[0] += s * w0.x; g[1] += s * w0.y; g[2] += s * w0.z; g[3] += s * w0.w;
                g[4] += s * w1.x; g[5] += s * w1.y; g[6] += s * w1.z; g[7] += s * w1.w;
                g[8] += s * w2.x; g[9] += s * w2.y; g[10] += s * w2.z; g[11] += s * w2.w;
                g[12] += s * w3.x; g[13] += s * w3.y; g[14] += s * w3.z; g[15] += s * w3.w;
            }
#pragma unroll
            for (int j = 0; j < 16; ++j) {
                const int c = c0 + j;
                const float yn = (y[j] - mean) * rs * P.in[33][l * 512 + c] + P.in[34][l * 512 + c];
                MIX[(size_t)row * DM + 512 + c] = f2bf((yn + bon * vv[j]) * g[j]);
            }
        }
    }
}

__device__ __forceinline__ void phase_ln1(const Params& P, int l) {
    const int lane = threadIdx.x & 63, wave = __builtin_amdgcn_readfirstlane(threadIdx.x >> 6);
    float* XS = (float*)(P.ws + OFF_XS);
    const float* TMP = (const float*)(P.ws + OFF_TMP);
    const float* MOD = (const float*)(P.ws + OFF_MOD);
    bf16_t* H2 = (bf16_t*)(P.ws + OFF_H2);
    for (int row = blockIdx.x * 4 + wave; row < MROWS; row += gridDim.x * 4) {
        if (l == 1 && (row % LTOT) < CTX) continue;
        const float* mod = MOD + (size_t)(l * 5 + modrow(row)) * 6144;
        float v[16]; float s = 0.f;
#pragma unroll
        for (int j = 0; j < 4; ++j) {
            const int d = 256 * j + 4 * lane;
            const float4 x = *(const float4*)(XS + (size_t)row * DM + d), t = *(const float4*)(TMP + (size_t)row * DM + d), g = *(const float4*)(mod + 2048 + d);
            v[4 * j + 0] = ALPHA * x.x + g.x * t.x; v[4 * j + 1] = ALPHA * x.y + g.y * t.y; v[4 * j + 2] = ALPHA * x.z + g.z * t.z; v[4 * j + 3] = ALPHA * x.w + g.w * t.w;
            s += v[4 * j] + v[4 * j + 1] + v[4 * j + 2] + v[4 * j + 3];
        }
        const float mean = wave_sum(s) * (1.f / 1024.f);
        float q = 0.f;
#pragma unroll
        for (int j = 0; j < 16; ++j) { const float d = v[j] - mean; q += d * d; }
        const float rs = rsqrtf(wave_sum(q) * (1.f / 1024.f) + 1e-5f);
#pragma unroll
        for (int j = 0; j < 4; ++j) {
            const int d = 256 * j + 4 * lane;
            const float4 gg = *(const float4*)(P.in[8] + l * 1024 + d), bb = *(const float4*)(P.in[9] + l * 1024 + d);
            const float4 sh = *(const float4*)(mod + 3072 + d), sc = *(const float4*)(mod + 4096 + d);
            float4 o;
            o.x = (v[4 * j + 0] - mean) * rs * gg.x + bb.x; o.y = (v[4 * j + 1] - mean) * rs * gg.y + bb.y;
            o.z = (v[4 * j + 2] - mean) * rs * gg.z + bb.z; o.w = (v[4 * j + 3] - mean) * rs * gg.w + bb.w;
            *(float4*)(XS + (size_t)row * DM + d) = o;
            ushort4 h;
            h.x = f2bf(o.x * (1.f + sc.x) + sh.x); h.y = f2bf(o.y * (1.f + sc.y) + sh.y); h.z = f2bf(o.z * (1.f + sc.z) + sh.z); h.w = f2bf(o.w * (1.f + sc.w) + sh.w);
            *(ushort4*)(H2 + (size_t)row * DM + d) = h;
        }
    }
}

__device__ __forceinline__ unsigned f2ord(float f) { const unsigned u = __float_as_uint(f); return u ^ ((u >> 31) ? 0xFFFFFFFFu : 0x80000000u); }
__device__ __forceinline__ float ord2f(unsigned u) { return __uint_as_float((u >> 31) ? (u ^ 0x80000000u) : ~u); }
__device__ __forceinline__ void phase_topk(const Params& P, int l) {
    const int tid = threadIdx.x;
    const bf16_t* Q = (const bf16_t*)(P.ws + OFF_Q);
    int* IDX = (int*)(P.ws + OFF_IDX);
    float* GATE = (float*)(P.ws + OFF_GATE);
    for (int u = blockIdx.x; u < 8 * (MROWS / 256); u += gridDim.x) {
        const int hd = u / (MROWS / 256), rb = u % (MROWS / 256);
        const int row = rb * 256 + tid;
        if (l == 1 && (row % LTOT) < CTX) continue;
        unsigned top[2][16];
#pragma unroll
        for (int half = 0; half < 2; ++half) {
            float q[128];
            const bf16_t* qp = Q + (size_t)row * 2048 + hd * 256 + half * 128;
#pragma unroll
            for (int d8 = 0; d8 < 16; ++d8) {
                const bf16x8 v = *(const bf16x8*)(qp + d8 * 8);
#pragma unroll
                for (int j = 0; j < 8; ++j) q[d8 * 8 + j] = bf2f((bf16_t)v[j]);
            }
#pragma unroll
            for (int j = 0; j < 16; ++j) top[half][j] = 0u;
            const float* kp = P.in[36] + ((size_t)((l * 8 + hd) * 2 + half)) * 128 * 128;
            for (int key = 0; key < 128; ++key) {
                const float* kr = kp + key * 128;
                float s0 = 0.f, s1 = 0.f, s2 = 0.f, s3 = 0.f;
#pragma unroll
                for (int d = 0; d < 128; d += 4) { s0 += q[d] * kr[d]; s1 += q[d + 1] * kr[d + 1]; s2 += q[d + 2] * kr[d + 2]; s3 += q[d + 3] * kr[d + 3]; if ((d & 31) == 28) __builtin_amdgcn_sched_barrier(0); }
                unsigned x = (f2ord((s0 + s1) + (s2 + s3)) & 0xFFFFFF80u) | (unsigned)(127 - key);
#pragma unroll
                for (int j = 0; j < 16; ++j) { const unsigned t = top[half][j]; const unsigned mx = x > t ? x : t; x = x > t ? t : x; top[half][j] = mx; }
            }
        }
        float cs[16]; int ce[16];
#pragma unroll
        for (int j = 0; j < 16; ++j) { cs[j] = -3.0e38f; ce[j] = 0; }
#pragma unroll
        for (int i = 0; i < 16; ++i) {
            const float s1v = ord2f(top[0][i] & 0xFFFFFF80u); const int i1 = 127 - (int)(top[0][i] & 127u);
#pragma unroll
            for (int j = 0; j < 16; ++j) {
                if ((i + 1) * (j + 1) <= 16) {
                    float x = s1v + ord2f(top[1][j] & 0xFFFFFF80u); int xe = i1 * 128 + (127 - (int)(top[1][j] & 127u));
#pragma unroll
                    for (int t = 0; t < 16; ++t) {
                        const bool gt = x > cs[t];
                        const float ts = cs[t]; const int te = ce[t];
                        cs[t] = gt ? x : ts; ce[t] = gt ? xe : te; x = gt ? ts : x; xe = gt ? te : xe;
                    }
                }
            }
        }
        float den = 0.f, ex[16];
#pragma unroll
        for (int t = 0; t < 16; ++t) { ex[t] = __expf(cs[t] - cs[0]); den += ex[t]; }
        const float inv = 1.f / den;
#pragma unroll
        for (int t = 0; t < 16; ++t) { IDX[(size_t)row * 128 + hd * 16 + t] = ce[t]; GATE[(size_t)row * 128 + hd * 16 + t] = ex[t] * inv; }
    }
}

__device__ __forceinline__ void phase_tabconv(const Params& P, int l) {
    const float4* U = (const float4*)(P.in[37] + (size_t)l * 16384 * 1024);
    const float4* V = (const float4*)(P.in[38] + (size_t)l * 16384 * 1024);
    ushort4* TU = (ushort4*)(P.ws + OFF_TBU);
    ushort4* TV = (ushort4*)(P.ws + OFF_TBV);
    const size_t n4 = (size_t)16384 * 256;
    for (size_t i = (size_t)blockIdx.x * 256 + threadIdx.x; i < n4; i += (size_t)gridDim.x * 256) {
        const float4 a = U[i], b = V[i];
        ushort4 oa, ob;
        oa.x = f2bf(a.x); oa.y = f2bf(a.y); oa.z = f2bf(a.z); oa.w = f2bf(a.w);
        ob.x = f2bf(b.x); ob.y = f2bf(b.y); ob.z = f2bf(b.z); ob.w = f2bf(b.w);
        TU[i] = oa; TV[i] = ob;
    }
}
__device__ __forceinline__ float dot2bf(unsigned a, unsigned b, float acc) { return __builtin_amdgcn_fdot2_f32_bf16(__builtin_bit_cast(bf16x2, a), __builtin_bit_cast(bf16x2, b), acc, false); }
__device__ __forceinline__ float dot8(const uint4& a, const uint4& b, float acc) { acc = dot2bf(a.x, b.x, acc); acc = dot2bf(a.y, b.y, acc); acc = dot2bf(a.z, b.z, acc); return dot2bf(a.w, b.w, acc); }
__device__ __forceinline__ void phase_gather(const Params& P, int l, unsigned char* smem) {
    const int tid = threadIdx.x, lane = tid & 63, wave = __builtin_amdgcn_readfirstlane(tid >> 6);
    float* XS = (float*)(P.ws + OFF_XS);
    const float* MOD = (const float*)(P.ws + OFF_MOD);
    const bf16_t* H2 = (const bf16_t*)(P.ws + OFF_H2);
    bf16_t* H = (bf16_t*)(P.ws + OFF_H);
    const int* IDX = (const int*)(P.ws + OFF_IDX);
    const float* GATE = (const float*)(P.ws + OFF_GATE);
    const bf16_t* TU = (const bf16_t*)(P.ws + OFF_TBU);
    const bf16_t* TV = (const bf16_t*)(P.ws + OFF_TBV);
    float* coef = (float*)smem + wave * 128;
    for (int row = blockIdx.x * 4 + wave; row < MROWS; row += gridDim.x * 4) {
        if (l == 1 && (row % LTOT) < CTX) continue;
        const uint4 h0 = *(const uint4*)(H2 + (size_t)row * DM + 8 * lane), h1 = *(const uint4*)(H2 + (size_t)row * DM + 512 + 8 * lane);
        const int e0 = IDX[(size_t)row * 128 + lane], e1 = IDX[(size_t)row * 128 + 64 + lane];
        uint4 ra[8], rb[8];
#define LOADB(T, bt) { _Pragma("unroll") for (int i = 0; i < 8; ++i) { const int k = (bt) * 8 + i; const int e = __builtin_amdgcn_readlane(k < 64 ? e0 : e1, k & 63); \
            const uint4* rp = (const uint4*)((T) + (size_t)e * 1024); ra[i] = rp[lane]; rb[i] = rp[64 + lane]; } }
        for (int bt = 0; bt < 16; ++bt) {
            LOADB(TU, bt)
            float p[8];
#pragma unroll
            for (int i = 0; i < 8; ++i) p[i] = dot8(rb[i], h1, dot8(ra[i], h0, 0.f));
            float q[4], r2[2];
#pragma unroll
            for (int i = 0; i < 4; ++i) { const float sd = (lane & 32) ? p[i] : p[i + 4]; const float rc = __shfl_xor(sd, 32, 64); q[i] = ((lane & 32) ? p[i + 4] : p[i]) + rc; }
#pragma unroll
            for (int i = 0; i < 2; ++i) { const float sd = (lane & 16) ? q[i] : q[i + 2]; const float rc = __shfl_xor(sd, 16, 64); r2[i] = ((lane & 16) ? q[i + 2] : q[i]) + rc; }
            float sv;
            { const float sd = (lane & 8) ? r2[0] : r2[1]; const float rc = __shfl_xor(sd, 8, 64); sv = ((lane & 8) ? r2[1] : r2[0]) + rc; }
            sv += __shfl_xor(sv, 4, 64); sv += __shfl_xor(sv, 2, 64); sv += __shfl_xor(sv, 1, 64);
            if ((lane & 7) == 0) { const int k = bt * 8 + ((lane >> 3) & 7); coef[k] = gelu_tanh(sv) * GATE[(size_t)row * 128 + k]; }
        }
        float acc[16];
#pragma unroll
        for (int j = 0; j < 16; ++j) acc[j] = 0.f;
        for (int bt = 0; bt < 16; ++bt) {
            LOADB(TV, bt)
#pragma unroll
            for (int i = 0; i < 8; ++i) {
                const float c = coef[bt * 8 + i];
                const unsigned w[8] = {ra[i].x, ra[i].y, ra[i].z, ra[i].w, rb[i].x, rb[i].y, rb[i].z, rb[i].w};
#pragma unroll
                for (int j = 0; j < 8; ++j) { acc[2 * j] += c * __uint_as_float(w[j] << 16); acc[2 * j + 1] += c * __uint_as_float(w[j] & 0xFFFF0000u); }
            }
        }
#undef LOADB
        const float* mod = MOD + (size_t)(l * 5 + modrow(row)) * 6144;
        float v[16]; float s = 0.f;
#pragma unroll
        for (int hh = 0; hh < 2; ++hh) {
            const int d = 512 * hh + 8 * lane;
            const float4 x0 = *(const float4*)(XS + (size_t)row * DM + d), x1 = *(const float4*)(XS + (size_t)row * DM + d + 4);
            const float4 g0 = *(const float4*)(mod + 5120 + d), g1 = *(const float4*)(mod + 5120 + d + 4);
            v[8 * hh + 0] = ALPHA * x0.x + g0.x * acc[8 * hh + 0]; v[8 * hh + 1] = ALPHA * x0.y + g0.y * acc[8 * hh + 1];
            v[8 * hh + 2] = ALPHA * x0.z + g0.z * acc[8 * hh + 2]; v[8 * hh + 3] = ALPHA * x0.w + g0.w * acc[8 * hh + 3];
            v[8 * hh + 4] = ALPHA * x1.x + g1.x * acc[8 * hh + 4]; v[8 * hh + 5] = ALPHA * x1.y + g1.y * acc[8 * hh + 5];
            v[8 * hh + 6] = ALPHA * x1.z + g1.z * acc[8 * hh + 6]; v[8 * hh + 7] = ALPHA * x1.w + g1.w * acc[8 * hh + 7];
        }
#pragma unroll
        for (int j = 0; j < 16; ++j) s += v[j];
        const float mean = wave_sum(s) * (1.f / 1024.f);
        float qq = 0.f;
#pragma unroll
        for (int j = 0; j < 16; ++j) { v[j] -= mean; qq += v[j] * v[j]; }
        const float rs = rsqrtf(wave_sum(qq) * (1.f / 1024.f) + 1e-5f);
        const float* mod1 = MOD + (size_t)(1 * 5 + modrow(row)) * 6144;
#pragma unroll
        for (int hh = 0; hh < 2; ++hh) {
            const int d = 512 * hh + 8 * lane;
            float o[8];
#pragma unroll
            for (int j = 0; j < 8; ++j) o[j] = v[8 * hh + j] * rs * P.in[10][l * 1024 + d + j] + P.in[11][l * 1024 + d + j];
            if (l == 0) {
                *(float4*)(XS + (size_t)row * DM + d) = make_float4(o[0], o[1], o[2], o[3]);
                *(float4*)(XS + (size_t)row * DM + d + 4) = make_float4(o[4], o[5], o[6], o[7]);
                bf16_t hb[8];
#pragma unroll
                for (int j = 0; j < 8; ++j) hb[j] = f2bf(o[j] * (1.f + mod1[1024 + d + j]) + mod1[d + j]);
                uint4 pk; pk.x = hb[0] | ((unsigned)hb[1] << 16); pk.y = hb[2] | ((unsigned)hb[3] << 16); pk.z = hb[4] | ((unsigned)hb[5] << 16); pk.w = hb[6] | ((unsigned)hb[7] << 16);
                *(uint4*)(H + (size_t)row * DM + d) = pk;
            } else {
                const int b = row / LTOT, t = row % LTOT - CTX;
                if (*(volatile unsigned*)(P.ws + OFF_BAR + 15360) != 0u) { o[0] = __int_as_float(0x7fc00000); }
                float* op = P.out + ((size_t)b * SEQ + t) * DM + d;
                *(float4*)op = make_float4(o[0], o[1], o[2], o[3]);
                *(float4*)(op + 4) = make_float4(o[4], o[5], o[6], o[7]);
            }
        }
    }
}

__device__ __forceinline__ void s5_prep_unit(const Params& P, int l, int g, unsigned char* smem) {
    const int tid = threadIdx.x;
    float* Kt = (float*)smem;
    float* bbr = Kt + 8192; float* bbi = bbr + 1024; float* cr = bbi + 1024; float* ci = cr + 1024; float* pwr = ci + 1024; float* pwi = pwr + 17 * 64;
    bf16_t* MS = (bf16_t*)(P.ws + OFF_S5MS) + (size_t)(l * 16 + g) * 256 * 256;
    bf16_t* MY = (bf16_t*)(P.ws + OFF_S5MY) + (size_t)(l * 16 + g) * 256 * 512;
    float* LB = (float*)(P.ws + OFF_S5LB) + (size_t)(l * 16 + g) * 256;
    for (int dir = 0; dir < 2; ++dir) {
        __syncthreads();
        const int ldg = (l * 2 + dir) * 16 + g;
        if (tid < 64) {
            const int p = tid;
            const float dt = expf(P.in[14][ldg]);
            const float lre = P.in[12][ldg * 64 + p], lim = P.in[13][ldg * 64 + p];
            for (int d = 0; d <= 16; ++d) { const float mag = expf(lre * dt * (float)d), ang = lim * dt * (float)d; pwr[d * 64 + p] = mag * cosf(ang); pwi[d * 64 + p] = mag * sinf(ang); }
            const float lb_re = pwr[64 + p], lb_im = pwi[64 + p];
            const float den = lre * lre + lim * lim, nr = lb_re - 1.f, ni = lb_im;
            const float co_re = (nr * lre + ni * lim) / den, co_im = (ni * lre - nr * lim) / den;
            for (int h = 0; h < 16; ++h) {
                const float br = P.in[15][((size_t)ldg * 64 + p) * 16 + h], bi = P.in[16][((size_t)ldg * 64 + p) * 16 + h];
                bbr[p * 16 + h] = co_re * br - co_im * bi; bbi[p * 16 + h] = co_re * bi + co_im * br;
            }
            LB[dir * 128 + p] = pwr[16 * 64 + p]; LB[dir * 128 + 64 + p] = pwi[16 * 64 + p];
        }
        for (int e = tid; e < 1024; e += 256) { cr[e] = P.in[17][(size_t)ldg * 1024 + e]; ci[e] = P.in[18][(size_t)ldg * 1024 + e]; }
        __syncthreads();
        for (int e = tid; e < 4096; e += 256) {
            const int d = e >> 8, h = (e >> 4) & 15, h2 = e & 15;
            float acc = 0.f;
            for (int p = 0; p < 64; ++p) {
                const float Pr = pwr[d * 64 + p], Pi = pwi[d * 64 + p], br = bbr[p * 16 + h2], bi = bbi[p * 16 + h2];
                acc += cr[h * 64 + p] * (Pr * br - Pi * bi) - ci[h * 64 + p] * (Pr * bi + Pi * br);
            }
            Kt[dir * 4096 + e] = acc;
        }
        for (int e = tid; e < 128 * 256; e += 256) {
            const int q = e >> 8, col = e & 255, j = col >> 4, h2 = col & 15, p = q & 63;
            const int ex = dir == 0 ? 15 - j : j;
            const float Pr = pwr[ex * 64 + p], Pi = pwi[ex * 64 + p], br = bbr[p * 16 + h2], bi = bbi[p * 16 + h2];
            MS[(size_t)(dir * 128 + q) * 256 + col] = f2bf(q < 64 ? Pr * br - Pi * bi : Pr * bi + Pi * br);
        }
        for (int e = tid; e < 256 * 128; e += 256) {
            const int ri = e >> 7, q = e & 127, t = ri >> 4, h = ri & 15, p = q & 63;
            const int ex = dir == 0 ? t + 1 : 16 - t;
            const float Lr = pwr[ex * 64 + p], Li = pwi[ex * 64 + p], c_r = cr[h * 64 + p], c_i = ci[h * 64 + p];
            MY[(size_t)ri * 512 + 256 + dir * 128 + q] = f2bf(q < 64 ? c_r * Lr - c_i * Li : -(c_r * Li + c_i * Lr));
        }
    }
    __syncthreads();
    for (int e = tid; e < 256 * 256; e += 256) {
        const int ri = e >> 8, col = e & 255, t = ri >> 4, h = ri & 15, j = col >> 4, h2 = col & 15;
        float v = 0.f;
        if (j <= t) v += Kt[(t - j) * 256 + h * 16 + h2];
        if (j >= t) v += Kt[4096 + (j - t) * 256 + h * 16 + h2];
        MY[(size_t)ri * 512 + col] = f2bf(v);
    }
}
__device__ __forceinline__ void s5_passA(const Params& P, int l) {
    const int lane = threadIdx.x & 63, wave = __builtin_amdgcn_readfirstlane(threadIdx.x >> 6), fr = lane & 15, fq = lane >> 4;
    const bf16_t* Pb = (const bf16_t*)(P.ws + OFF_P);
    float* ST = (float*)(P.ws + OFF_S5ST);
    for (int it = blockIdx.x * 4 + wave; it < 16 * 17 * 4; it += gridDim.x * 4) {
        const int g = it / 68, mt = (it % 68) >> 2, nt = it & 3;
        const bf16_t* MS = (const bf16_t*)(P.ws + OFF_S5MS) + (size_t)(l * 16 + g) * 256 * 256;
        f32x4 acc[4][4];
#pragma unroll
        for (int i = 0; i < 4; ++i)
#pragma unroll
            for (int j = 0; j < 4; ++j) acc[i][j] = (f32x4){0.f, 0.f, 0.f, 0.f};
        const bf16_t* ap[4];
#pragma unroll
        for (int i = 0; i < 4; ++i) { const int m = mt * 64 + 16 * i + fr, b = m / 272, c = m % 272; ap[i] = Pb + (size_t)(b * LTOT + c * 16) * PIN + g * 16; }
        const bf16_t* bp = MS + (size_t)(nt * 64 + fr) * 256 + 8 * fq;
        for (int k0 = 0; k0 < 256; k0 += 32) {
            const int k = k0 + 8 * fq;
            bf16x8 a[4], bb[4];
#pragma unroll
            for (int i = 0; i < 4; ++i) a[i] = *(const bf16x8*)(ap[i] + (size_t)(k >> 4) * PIN + (k & 15));
#pragma unroll
            for (int j = 0; j < 4; ++j) bb[j] = *(const bf16x8*)(bp + (size_t)(16 * j) * 256 + k0);
#pragma unroll
            for (int i = 0; i < 4; ++i)
#pragma unroll
                for (int j = 0; j < 4; ++j) acc[i][j] = __builtin_amdgcn_mfma_f32_16x16x32_bf16(a[i], bb[j], acc[i][j], 0, 0, 0);
        }
#pragma unroll
        for (int i = 0; i < 4; ++i)
#pragma unroll
            for (int r = 0; r < 4; ++r) {
                const int m = mt * 64 + 16 * i + 4 * fq + r, b = m / 272, c = m % 272;
                float* dst = ST + ((size_t)(b * 16 + g) * 272 + c) * 256 + nt * 64 + fr;
#pragma unroll
                for (int j = 0; j < 4; ++j) dst[16 * j] = acc[i][j][r];
            }
    }
}
__device__ __forceinline__ void s5_carry(const Params& P, int l) {
    float* ST = (float*)(P.ws + OFF_S5ST);
    for (int u = blockIdx.x; u < 32; u += gridDim.x) {
        const int gid = u * 256 + threadIdx.x, p = gid & 63, dir = (gid >> 6) & 1, g = (gid >> 7) & 15, b = gid >> 11;
        const float* LB = (const float*)(P.ws + OFF_S5LB) + (size_t)(l * 16 + g) * 256 + dir * 128;
        const float lr = LB[p], li = LB[64 + p];
        float* base = ST + (size_t)(b * 16 + g) * 272 * 256 + dir * 128 + p;
        float sr = 0.f, si = 0.f;
        for (int c0 = 0; c0 < 272; c0 += 16) {
            float tr[16], ti[16];
#pragma unroll
            for (int i = 0; i < 16; ++i) { const int cc = c0 + i, c = dir == 0 ? cc : (cc < 16 ? 15 - cc : 287 - cc); tr[i] = base[(size_t)c * 256]; ti[i] = base[(size_t)c * 256 + 64]; }
#pragma unroll
            for (int i = 0; i < 16; ++i) {
                const int cc = c0 + i, c = dir == 0 ? cc : (cc < 16 ? 15 - cc : 287 - cc);
                base[(size_t)c * 256] = sr; base[(size_t)c * 256 + 64] = si;
                const float nr = lr * sr - li * si + tr[i], ni = lr * si + li * sr + ti[i];
                sr = nr; si = ni;
            }
        }
    }
}
__device__ __forceinline__ void s5_passC(const Params& P, int l) {
    const int lane = threadIdx.x & 63, wave = __builtin_amdgcn_readfirstlane(threadIdx.x >> 6), fr = lane & 15, fq = lane >> 4;
    const bf16_t* Pb = (const bf16_t*)(P.ws + OFF_P);
    const float* ST = (const float*)(P.ws + OFF_S5ST);
    bf16_t* YA = (bf16_t*)(P.ws + OFF_YP);
    for (int it = blockIdx.x * 4 + wave; it < 16 * 17 * 4; it += gridDim.x * 4) {
        const int g = it / 68, mt = (it % 68) >> 2, nt = it & 3;
        const bf16_t* MY = (const bf16_t*)(P.ws + OFF_S5MY) + (size_t)(l * 16 + g) * 256 * 512;
        f32x4 acc[4][4];
#pragma unroll
        for (int i = 0; i < 4; ++i)
#pragma unroll
            for (int j = 0; j < 4; ++j) acc[i][j] = (f32x4){0.f, 0.f, 0.f, 0.f};
        const bf16_t* ap[4]; const float* sp[4];
#pragma unroll
        for (int i = 0; i < 4; ++i) {
            const int m = mt * 64 + 16 * i + fr, b = m / 272, c = m % 272;
            ap[i] = Pb + (size_t)(b * LTOT + c * 16) * PIN + g * 16;
            sp[i] = ST + ((size_t)(b * 16 + g) * 272 + c) * 256;
        }
        const bf16_t* bp = MY + (size_t)(nt * 64 + fr) * 512 + 8 * fq;
        for (int k0 = 0; k0 < 512; k0 += 32) {
            const int k = k0 + 8 * fq;
            bf16x8 a[4], bb[4];
            if (k0 < 256) {
#pragma unroll
                for (int i = 0; i < 4; ++i) a[i] = *(const bf16x8*)(ap[i] + (size_t)(k >> 4) * PIN + (k & 15));
            } else {
#pragma unroll
                for (int i = 0; i < 4; ++i) {
                    const float4 s0 = *(const float4*)(sp[i] + (k - 256)), s1 = *(const float4*)(sp[i] + (k - 256) + 4);
                    bf16x8 t;
                    t[0] = (short)f2bf(s0.x); t[1] = (short)f2bf(s0.y); t[2] = (short)f2bf(s0.z); t[3] = (short)f2bf(s0.w);
                    t[4] = (short)f2bf(s1.x); t[5] = (short)f2bf(s1.y); t[6] = (short)f2bf(s1.z); t[7] = (short)f2bf(s1.w);
                    a[i] = t;
                }
            }
#pragma unroll
            for (int j = 0; j < 4; ++j) bb[j] = *(const bf16x8*)(bp + (size_t)(16 * j) * 512 + k0);
#pragma unroll
            for (int i = 0; i < 4; ++i)
#pragma unroll
                for (int j = 0; j < 4; ++j) acc[i][j] = __builtin_amdgcn_mfma_f32_16x16x32_bf16(a[i], bb[j], acc[i][j], 0, 0, 0);
        }
        const float dsk = P.in[19][l * 256 + g * 16 + fr];
#pragma unroll
        for (int i = 0; i < 4; ++i)
#pragma unroll
            for (int r = 0; r < 4; ++r) {
                const int m = mt * 64 + 16 * i + 4 * fq + r, b = m / 272, c = m % 272;
#pragma unroll
                for (int j = 0; j < 4; ++j) {
                    const int t = nt * 4 + j;
                    const size_t row = (size_t)(b * LTOT + c * 16 + t);
                    const float u = bf2f(Pb[row * PIN + g * 16 + fr]);
                    YA[row * DM + g * 16 + fr] = f2bf(gelu_tanh(acc[i][j][r] + dsk * u));
                }
            }
    }
}


typedef short bf16x4 __attribute__((ext_vector_type(4)));
#define RW_NCH 34
#define RW_BUF 13824
#define RW_VT0 27648
__device__ __forceinline__ f32x4 mfma32(bf16x8 a, bf16x8 b, f32x4 c) { return __builtin_amdgcn_mfma_f32_16x16x32_bf16(a, b, c, 0, 0, 0); }
__device__ __forceinline__ f32x4 mfma16(bf16x4 a, bf16x4 b, f32x4 c) {
    bf16x8 a8, b8;
    a8[0] = a[0]; a8[1] = a[1]; a8[2] = a[2]; a8[3] = a[3]; a8[4] = 0; a8[5] = 0; a8[6] = 0; a8[7] = 0;
    b8[0] = b[0]; b8[1] = b[1]; b8[2] = b[2]; b8[3] = b[3]; b8[4] = 0; b8[5] = 0; b8[6] = 0; b8[7] = 0;
    return __builtin_amdgcn_mfma_f32_16x16x32_bf16(a8, b8, c, 0, 0, 0);
}
__device__ __forceinline__ bf16x4 to4(f32x4 v) { bf16x4 o; o[0] = (short)f2bf(v[0]); o[1] = (short)f2bf(v[1]); o[2] = (short)f2bf(v[2]); o[3] = (short)f2bf(v[3]); return o; }
__device__ __forceinline__ bf16x8 cat8(bf16x4 a, bf16x4 b) { bf16x8 o; o[0] = a[0]; o[1] = a[1]; o[2] = a[2]; o[3] = a[3]; o[4] = b[0]; o[5] = b[1]; o[6] = b[2]; o[7] = b[3]; return o; }

__device__ __forceinline__ void rwkv_prep_step(const bf16_t* RW, int b, int hd, int dir, int tau_base, unsigned char* buf, float ka, int wave, int lane) {
    bf16_t* KR = (bf16_t*)buf; bf16_t* BK = (bf16_t*)(buf + 4608); bf16_t* BbT = (bf16_t*)(buf + 9216); bf16_t* KbT = (bf16_t*)(buf + 11264); float* gT = (float*)(buf + 13312);
    const int ch = hd * 64 + lane;
    float cs[16];
    {
        float c = 0.f;
#pragma unroll
        for (int t = 0; t < 16; ++t) { const int row = row_of(b, dir, tau_base + t); c += bf2f(RW[(size_t)row * RWW + 3072 + dir * 512 + ch]); cs[t] = c; }
    }
    const float c15 = cs[15];
    if (wave == 0) gT[lane] = __expf(c15);
    bf16_t bb[4], kb[4];
#pragma unroll
    for (int t = 0; t < 16; ++t) {
        if ((t >> 2) == wave) {
            const int row = row_of(b, dir, tau_base + t);
            const bf16_t* rw = RW + (size_t)row * RWW + ch;
            const float r = bf2f(rw[0]), k = bf2f(rw[512]), kap = bf2f(rw[1536]), a = bf2f(rw[2048 + dir * 512]);
            const float cp = t > 0 ? cs[t > 0 ? t - 1 : 0] : 0.f, ct = cs[t];
            const float ep = __expf(cp), et = __expf(ct), em = __expf(-ct), eT = __expf(c15 - ct);
            const float beta = kap * a, kt = k * (1.f + (a - 1.f) * ka);
            KR[t * 72 + lane] = f2bf(kap * ep); KR[(16 + t) * 72 + lane] = f2bf(r * et);
            BK[t * 72 + lane] = f2bf(beta * em); BK[(16 + t) * 72 + lane] = f2bf(kt * em);
            bb[t & 3] = f2bf(beta * eT); kb[t & 3] = f2bf(kt * eT);
        }
    }
    uint2 pb, pk;
    pb.x = bb[0] | ((unsigned)bb[1] << 16); pb.y = bb[2] | ((unsigned)bb[3] << 16);
    pk.x = kb[0] | ((unsigned)kb[1] << 16); pk.y = kb[2] | ((unsigned)kb[3] << 16);
    *(uint2*)(BbT + lane * 16 + 4 * wave) = pb;
    *(uint2*)(KbT + lane * 16 + 4 * wave) = pk;
}
template <int NV>
__device__ __forceinline__ void rwkv_prep_vt(const bf16_t* RW, int b, int hd, int dir, int tau_base, int vbase, bf16_t* VT, int lane) {
    if (NV == 2) {
        const int vl = lane & 31, th = lane >> 5;
        bf16_t x[8];
#pragma unroll
        for (int i = 0; i < 8; ++i) { const int row = row_of(b, dir, tau_base + th * 8 + i); x[i] = RW[(size_t)row * RWW + 1024 + hd * 64 + vbase + vl]; }
        uint4 pk; pk.x = x[0] | ((unsigned)x[1] << 16); pk.y = x[2] | ((unsigned)x[3] << 16); pk.z = x[4] | ((unsigned)x[5] << 16); pk.w = x[6] | ((unsigned)x[7] << 16);
        *(uint4*)(VT + vl * 16 + th * 8) = pk;
    } else {
        const int vl = lane & 15, tq = lane >> 4;
        bf16_t x[4];
#pragma unroll
        for (int i = 0; i < 4; ++i) { const int row = row_of(b, dir, tau_base + tq * 4 + i); x[i] = RW[(size_t)row * RWW + 1024 + hd * 64 + vbase + vl]; }
        uint2 pk; pk.x = x[0] | ((unsigned)x[1] << 16); pk.y = x[2] | ((unsigned)x[3] << 16);
        *(uint2*)(VT + vl * 16 + tq * 4) = pk;
    }
}
template <int NV, bool HASV, bool OUT>
__device__ __forceinline__ void rwkv_mfma_step(f32x4 (&X)[4][NV], const unsigned char* buf, const bf16_t* VT, f32x4 (&Yout)[NV], int lane) {
    const bf16_t* KR = (const bf16_t*)buf; const bf16_t* BK = (const bf16_t*)(buf + 4608); const bf16_t* BbT = (const bf16_t*)(buf + 9216); const bf16_t* KbT = (const bf16_t*)(buf + 11264); const float* gT = (const float*)(buf + 13312);
    const int fr = lane & 15, fq = lane >> 4;
    const f32x4 z4 = {0.f, 0.f, 0.f, 0.f};
    f32x4 cA = z4, cN = z4, cAk = z4, cRb = z4, cRk = z4;
#pragma unroll
    for (int ks = 0; ks < 2; ++ks) {
        const bf16x8 kh = *(const bf16x8*)(KR + fr * 72 + 32 * ks + 8 * fq), rh = *(const bf16x8*)(KR + (16 + fr) * 72 + 32 * ks + 8 * fq);
        const bf16x8 bc = *(const bf16x8*)(BK + fr * 72 + 32 * ks + 8 * fq), kc = *(const bf16x8*)(BK + (16 + fr) * 72 + 32 * ks + 8 * fq);
        cA = mfma32(kh, bc, cA); cN = mfma32(bc, kh, cN); cAk = mfma32(kc, kh, cAk);
        if (OUT) { cRb = mfma32(bc, rh, cRb); cRk = mfma32(kc, rh, cRk); }
    }
    f32x4 dg;
#pragma unroll
    for (int r = 0; r < 4; ++r) {
        const int row = 4 * fq + r;
        dg[r] = (row == fr) ? 1.f : 0.f;
        cA[r] = (fr < row) ? cA[r] : 0.f;
        cN[r] = (row < fr) ? cN[r] : 0.f;
        cAk[r] = (row < fr) ? cAk[r] : 0.f;
        cRb[r] = (row <= fr) ? cRb[r] : 0.f;
        cRk[r] = (row <= fr) ? cRk[r] : 0.f;
    }
    const bf16x4 a4 = to4(cA), n4 = to4(cN);
    const f32x4 cA2 = mfma16(n4, a4, z4), cN2 = mfma16(a4, n4, z4);
    const bf16x4 a24 = to4(cA2), n24 = to4(cN2);
    const f32x4 cA4 = mfma16(n24, a24, z4), cN4 = mfma16(a24, n24, z4);
    const f32x4 cA8 = mfma16(to4(cN4), to4(cA4), z4);
    const f32x4 T1 = mfma16(to4(dg - cA), to4(dg + cN2), z4);
    const f32x4 T2 = mfma16(to4(dg + cA4), to4(T1), z4);
    const f32x4 WT = mfma16(to4(dg + cA8), to4(T2), z4);
    const bf16x4 wt4 = to4(WT), aak4 = to4(cAk), rab4 = to4(cRb), rak4 = to4(cRk);
    bf16x8 aK[2], aR[2];
#pragma unroll
    for (int ks = 0; ks < 2; ++ks) {
        aK[ks] = cat8(*(const bf16x4*)(KR + fr * 72 + 32 * ks + 4 * fq), *(const bf16x4*)(KR + fr * 72 + 32 * ks + 16 + 4 * fq));
        if (OUT) aR[ks] = cat8(*(const bf16x4*)(KR + (16 + fr) * 72 + 32 * ks + 4 * fq), *(const bf16x4*)(KR + (16 + fr) * 72 + 32 * ks + 16 + 4 * fq));
    }
    bf16x4 u4[NV], vt4[NV];
#pragma unroll
    for (int nj = 0; nj < NV; ++nj) {
        const bf16x8 b0 = cat8(to4(X[0][nj]), to4(X[1][nj])), b1 = cat8(to4(X[2][nj]), to4(X[3][nj]));
        f32x4 G = mfma32(aK[1], b1, mfma32(aK[0], b0, z4));
        if (HASV) { vt4[nj] = *(const bf16x4*)(VT + (16 * nj + fr) * 16 + 4 * fq); G = mfma16(aak4, vt4[nj], G); }
        const f32x4 U = mfma16(wt4, to4(G), z4);
        u4[nj] = to4(-U);
        if (OUT) {
            f32x4 Yv = mfma32(aR[1], b1, mfma32(aR[0], b0, z4));
            Yv = mfma16(rab4, u4[nj], Yv);
            if (HASV) Yv = mfma16(rak4, vt4[nj], Yv);
            Yout[nj] = Yv;
        }
    }
#pragma unroll
    for (int mi = 0; mi < 4; ++mi) {
        const f32x4 g4 = *(const f32x4*)(gT + 16 * mi + 4 * fq);
        const bf16x4 bb4 = *(const bf16x4*)(BbT + (16 * mi + fr) * 16 + 4 * fq), kb4 = *(const bf16x4*)(KbT + (16 * mi + fr) * 16 + 4 * fq);
#pragma unroll
        for (int nj = 0; nj < NV; ++nj) {
            f32x4 x = X[mi][nj] * g4;
            x = mfma16(bb4, u4[nj], x);
            if (HASV) x = mfma16(kb4, vt4[nj], x);
            X[mi][nj] = x;
        }
    }
}
__device__ __forceinline__ void rwkv_passA(const Params& P, int l, unsigned char* smem, int bid, int nb) {
    const int lane = threadIdx.x & 63, wave = __builtin_amdgcn_readfirstlane(threadIdx.x >> 6), fr = lane & 15, fq = lane >> 4;
    const bf16_t* RW = (const bf16_t*)(P.ws + OFF_RW);
    float* RXL = (float*)(P.ws + OFF_RXL);
    bf16_t* RXP = (bf16_t*)(P.ws + OFF_RXP);
    for (int item = bid; item < 64 * RW_NCH; item += nb) {
        const int seq = item / RW_NCH, c = item % RW_NCH, dir = seq & 1, hd = (seq >> 1) & 7, b = seq >> 4;
        const float ka = P.in[31][l * 512 + hd * 64 + lane];
        const int tau0 = c * 128;
        f32x4 X[4][2], Yd[2];
#pragma unroll
        for (int mi = 0; mi < 4; ++mi)
#pragma unroll
            for (int nj = 0; nj < 2; ++nj)
#pragma unroll
                for (int r = 0; r < 4; ++r) X[mi][nj][r] = (wave >= 2 && (16 * mi + 4 * fq + r) == (16 * (2 * (wave - 2) + nj) + fr)) ? 1.f : 0.f;
        bf16_t* VTw = (bf16_t*)(smem + RW_VT0 + wave * 2048);
        rwkv_prep_step(RW, b, hd, dir, tau0, smem, ka, wave, lane);
        if (wave < 2) rwkv_prep_vt<2>(RW, b, hd, dir, tau0, 32 * wave, VTw, lane);
        __syncthreads();
        for (int s = 0; s < 8; ++s) {
            if (s < 7) {
                rwkv_prep_step(RW, b, hd, dir, tau0 + (s + 1) * 16, smem + ((s + 1) & 1) * RW_BUF, ka, wave, lane);
                if (wave < 2) rwkv_prep_vt<2>(RW, b, hd, dir, tau0 + (s + 1) * 16, 32 * wave, VTw + ((s + 1) & 1) * 512, lane);
            }
            if (wave < 2) rwkv_mfma_step<2, true, false>(X, smem + (s & 1) * RW_BUF, VTw + (s & 1) * 512, Yd, lane);
            else rwkv_mfma_step<2, false, false>(X, smem + (s & 1) * RW_BUF, VTw, Yd, lane);
            __syncthreads();
        }
        if (wave < 2) {
#pragma unroll
            for (int mi = 0; mi < 4; ++mi)
#pragma unroll
                for (int nj = 0; nj < 2; ++nj) *(f32x4*)(RXL + (((size_t)item * 16 + mi * 4 + 2 * wave + nj) * 64 + lane) * 4) = X[mi][nj];
        } else {
#pragma unroll
            for (int mi = 0; mi < 4; ++mi)
#pragma unroll
                for (int nj = 0; nj < 2; ++nj)
#pragma unroll
                    for (int r = 0; r < 4; ++r) RXP[(size_t)item * 4096 + (16 * mi + 4 * fq + r) * 64 + 16 * (2 * (wave - 2) + nj) + fr] = f2bf(X[mi][nj][r]);
        }
    }
}
__device__ __forceinline__ void rwkv_passB(const Params& P) {
    const int lane = threadIdx.x & 63, wave = __builtin_amdgcn_readfirstlane(threadIdx.x >> 6), fr = lane & 15, fq = lane >> 4;
    float* RXL = (float*)(P.ws + OFF_RXL);
    const bf16_t* RXP = (const bf16_t*)(P.ws + OFF_RXP);
    for (int it = blockIdx.x * 4 + wave; it < 256; it += gridDim.x * 4) {
        const int seq = it >> 2, nj = it & 3;
        f32x4 X[4];
#pragma unroll
        for (int mi = 0; mi < 4; ++mi) X[mi] = (f32x4){0.f, 0.f, 0.f, 0.f};
        for (int c = 0; c < RW_NCH; ++c) {
            const size_t item = (size_t)seq * RW_NCH + c;
            f32x4 L[4]; bf16x8 a[4][2];
#pragma unroll
            for (int mi = 0; mi < 4; ++mi) {
                L[mi] = *(const f32x4*)(RXL + ((item * 16 + mi * 4 + nj) * 64 + lane) * 4);
                const bf16_t* xp = RXP + item * 4096 + (16 * mi + fr) * 64;
#pragma unroll
                for (int ks = 0; ks < 2; ++ks) a[mi][ks] = cat8(*(const bf16x4*)(xp + 32 * ks + 4 * fq), *(const bf16x4*)(xp + 32 * ks + 16 + 4 * fq));
            }
            const bf16x8 b0 = cat8(to4(X[0]), to4(X[1])), b1 = cat8(to4(X[2]), to4(X[3]));
#pragma unroll
            for (int mi = 0; mi < 4; ++mi) {
                *(f32x4*)(RXL + ((item * 16 + mi * 4 + nj) * 64 + lane) * 4) = X[mi];
                X[mi] = mfma32(a[mi][1], b1, mfma32(a[mi][0], b0, L[mi]));
            }
        }
    }
}
template <bool CHECK>
__device__ __forceinline__ void rwkv_passC(const Params& P, int l, unsigned char* smem) {
    const int lane = threadIdx.x & 63, wave = __builtin_amdgcn_readfirstlane(threadIdx.x >> 6), fr = lane & 15, fq = lane >> 4;
    const bf16_t* RW = (const bf16_t*)(P.ws + OFF_RW);
    const float* RXL = (const float*)(P.ws + OFF_RXL);
    for (int item = blockIdx.x; item < 64 * RW_NCH; item += gridDim.x) {
        const int seq = item / RW_NCH, c = item % RW_NCH, dir = seq & 1, hd = (seq >> 1) & 7, b = seq >> 4;
        if (l == 1 && dir == 0 && c < 2) continue;
        if (l == 1 && dir == 1 && c < 2) continue;
        bf16_t* YP = (bf16_t*)(P.ws + OFF_YP) + (size_t)dir * MROWS * DM;
        const float ka = P.in[31][l * 512 + hd * 64 + lane];
        const int tau0 = c * 128;
        f32x4 X[4][1], Yo[1];
#pragma unroll
        for (int mi = 0; mi < 4; ++mi) X[mi][0] = *(const f32x4*)(RXL + (((size_t)item * 16 + mi * 4 + wave) * 64 + lane) * 4);
        bf16_t* VTw = (bf16_t*)(smem + RW_VT0 + wave * 2048);
        rwkv_prep_step(RW, b, hd, dir, tau0, smem, ka, wave, lane);
        rwkv_prep_vt<1>(RW, b, hd, dir, tau0, 16 * wave, VTw, lane);
        __syncthreads();
        for (int s = 0; s < 8; ++s) {
            if (s < 7) {
                rwkv_prep_step(RW, b, hd, dir, tau0 + (s + 1) * 16, smem + ((s + 1) & 1) * RW_BUF, ka, wave, lane);
                rwkv_prep_vt<1>(RW, b, hd, dir, tau0 + (s + 1) * 16, 16 * wave, VTw + ((s + 1) & 1) * 512, lane);
            }
            rwkv_mfma_step<1, true, true>(X, smem + (s & 1) * RW_BUF, VTw + (s & 1) * 512, Yo, lane);
#pragma unroll
            for (int r = 0; r < 4; ++r) {
                const int row = row_of(b, dir, tau0 + s * 16 + 4 * fq + r);
                if (CHECK) { if (YP[(size_t)row * DM + 512 + hd * 64 + 16 * wave + fr] != f2bf(Yo[0][r])) atomicAdd((unsigned*)(P.ws + OFF_BAR + 15360), 1u); }
                else YP[(size_t)row * DM + 512 + hd * 64 + 16 * wave + fr] = f2bf(Yo[0][r]);
            }
            __syncthreads();
        }
    }
}

__device__ __forceinline__ void run_phase(const Params& P, int ph, unsigned char* smem) {
    if (ph == 0) { phase_prep(P, smem); return; }
    if (ph == 1) { phase_mkh(P); return; }
    const int l = (ph - 2) / PPL, s = (ph - 2) % PPL;
    switch (s) {
    case 0: gemm_bf16((const bf16_t*)(P.ws + OFF_H), DM, (const bf16_t*)(P.ws + OFF_WIN) + (size_t)l * PIN * DM, DM, MROWS, PIN, DM, false, EpiBf16{(bf16_t*)(P.ws + OFF_P), PIN}); break;
    case 1: phase_rwprep(P, l, smem); s5_passA(P, l); break;
#ifdef EXP_T2
    case 2: if (blockIdx.x < 32) { phase_scans(P, l); s5_carry(P, l); } else { const int wv = threadIdx.x >> 6; for (int it = wv * (gridDim.x - 32) + blockIdx.x - 32; it < 64; it += 4 * (gridDim.x - 32)) scan_rwkv(P, l, it); } break;
    case 3: s5_passC(P, l); break;
#else
    case 2: if (blockIdx.x < 32) { phase_scans(P, l); s5_carry(P, l); } else rwkv_passA(P, l, smem, blockIdx.x - 32, gridDim.x - 32); break;
    case 3: rwkv_passB(P); s5_passC(P, l); break;
#endif
    case 4: rwkv_passC<false>(P, l, smem); break;
    case 5: phase_post(P, l, smem); break;
    case 6: gemm_bf16((const bf16_t*)(P.ws + OFF_MIX), DM, (const bf16_t*)(P.ws + OFF_WOUT) + (size_t)l * DM * DM, DM, MROWS, DM, DM, l == 1, EpiF32{(float*)(P.ws + OFF_TMP), DM}); break;
    case 7: phase_ln1(P, l); break;
    case 8: gemm_bf16((const bf16_t*)(P.ws + OFF_H2), DM, (const bf16_t*)(P.ws + OFF_WQ) + (size_t)l * 2048 * DM, DM, MROWS, 2048, DM, l == 1, EpiBf16{(bf16_t*)(P.ws + OFF_Q), 2048}); break;
    case 9: phase_topk(P, l); phase_tabconv(P, l); break;
    case 10: phase_gather(P, l, smem); break;
    }
}

__global__ void __launch_bounds__(256) mega(Params P) {
    __shared__ __attribute__((aligned(16))) unsigned char smem[65536];
#if SINGLE
    cg::grid_group grid = cg::this_grid();
    if (threadIdx.x < 4) ((volatile LAS unsigned*)(smem + 65520))[threadIdx.x] = 0u;
    __syncthreads();
    XcdBarrier xb = xcd_barrier_post((unsigned*)(P.ws + OFF_BAR), (volatile LAS unsigned*)(smem + 65520));
#endif
    for (int ph = P.ph_lo; ph < P.ph_hi; ++ph) {
        run_phase(P, ph, smem);
#if SINGLE
        if (ph + 1 < P.ph_hi) {
            if (ph == 0) { asm volatile("s_waitcnt vmcnt(0)" ::: "memory"); __syncthreads(); grid.sync(); }
            else xcd_barrier(xb);
        }
#ifdef EXP_T3
        if (ph >= 2 && (ph - 2) % PPL == 4) { rwkv_passC<true>(P, (ph - 2) / PPL, smem); xcd_barrier(xb); }
#endif
#ifdef EXP_OLDSCAN
        if (ph >= 2 && (ph - 2) % PPL == 4) { const int wv = threadIdx.x >> 6; for (int it = wv * gridDim.x + blockIdx.x; it < 64; it += 4 * gridDim.x) scan_rwkv(P, (ph - 2) / PPL, it); xcd_barrier(xb); }
#endif
#endif
    }
}

extern "C" void kernel_launch(void* const* d_in, const int* in_sizes, int n_in, void* d_out, int out_size, void* d_ws, size_t ws_size, hipStream_t stream) {
    static int grid = 0;
    if (grid == 0) {
        if (n_in != 39 || ws_size < OFF_END) { fprintf(stderr, "kernel_launch: unexpected n_in %d or ws_size %zu (need %zu)\n", n_in, ws_size, (size_t)OFF_END); grid = -1; return; }
        int dev = 0, cus = 0, per_cu = 0;
        hipGetDevice(&dev);
        hipDeviceGetAttribute(&cus, hipDeviceAttributeMultiprocessorCount, dev);
        hipOccupancyMaxActiveBlocksPerMultiprocessor(&per_cu, mega, 256, 0);
        if (per_cu < 1) per_cu = 1;
        if (per_cu > 2) per_cu = 2;
        grid = cus * per_cu;
    }
    if (grid < 0) return;
    hipMemsetAsync((unsigned char*)d_ws + OFF_BAR, 0, 16384, stream);
    Params p{};
    for (int i = 0; i < 39; ++i) p.in[i] = (const float*)d_in[i];
    p.out = (float*)d_out; p.ws = (unsigned char*)d_ws;
#if SINGLE
    p.ph_lo = 0; p.ph_hi = NPH;
    void* args[] = {&p};
    hipError_t e = hipLaunchCooperativeKernel((void*)mega, dim3(grid), dim3(256), args, 0, stream);
    if (e != hipSuccess) fprintf(stderr, "cooperative launch failed: %s (grid %d)\n", hipGetErrorString(e), grid);
#else
    for (int ph = 0; ph < NPH; ++ph) {
        p.ph_lo = ph; p.ph_hi = ph + 1;
        hipLaunchKernelGGL(mega, dim3(grid), dim3(256), 0, stream, p);
    }
#endif
}
```

```cpp
#include <hip/hip_runtime.h>
#include <hip/hip_cooperative_groups.h>
#include <cstdio>
namespace cg = cooperative_groups;

#ifndef SINGLE
#define SINGLE 1
#endif

typedef unsigned short bf16_t;
typedef short bf16x8 __attribute__((ext_vector_type(8)));
typedef float f32x4 __attribute__((ext_vector_type(4)));
typedef __bf16 bf16x2 __attribute__((ext_vector_type(2)));

#define DM 1024
#define NB 4
#define SEQ 4096
#define CTX 256
#define LTOT 4352
#define MROWS 17408
#define PIN 3456
#define RWW 4224
#define NPH 24
#define PPL 11
#define ALPHA 1.41421356237f

#define OFF_XS 0ull
#define OFF_P (OFF_XS + (size_t)MROWS * DM * 4)
#define OFF_RW (OFF_P + (size_t)MROWS * PIN * 2)
#define OFF_YP (OFF_RW + (size_t)MROWS * RWW * 2)
#define OFF_MIX (OFF_YP + (size_t)2 * MROWS * DM * 2)
#define OFF_MOD (OFF_MIX + (size_t)MROWS * DM * 2)
#define OFF_WIN (OFF_MOD + (size_t)2 * 5 * 6144 * 4)
#define OFF_WOUT (OFF_WIN + (size_t)2 * PIN * DM * 2)
#define OFF_WQ (OFF_WOUT + (size_t)2 * DM * DM * 2)
#define OFF_S5MS (OFF_WQ + (size_t)2 * 2048 * DM * 2)
#define OFF_S5MY (OFF_S5MS + (size_t)2 * 16 * 256 * 256 * 2)
#define OFF_S5LB (OFF_S5MY + (size_t)2 * 16 * 256 * 512 * 2)
#define OFF_S5ST (OFF_S5LB + (size_t)2 * 16 * 2 * 128 * 4)
#define OFF_BAR (OFF_S5ST + (size_t)4 * 16 * 272 * 256 * 4)
#define OFF_KEYB (OFF_BAR + 16384)
#define OFF_LW (OFF_KEYB + (size_t)2 * 8 * 2 * 128 * 128 * 2)
#define OFF_END (OFF_LW + (size_t)4 * 131072 * 2)
#define OFF_RXL OFF_MIX
#define OFF_TMP OFF_P
#define OFF_H OFF_YP
#define OFF_H2 (OFF_YP + (size_t)MROWS * DM * 2)
#define OFF_Q OFF_RW
#define OFF_IDX (OFF_RW + (size_t)MROWS * 2048 * 2)
#define OFF_GATE (OFF_IDX + (size_t)MROWS * 128 * 4)
#define OFF_TBU OFF_P
#define OFF_TBV (OFF_P + (size_t)16384 * 1024 * 2)

struct Params {
    const float* in[39];
    float* out;
    unsigned char* ws;
    int ph_lo, ph_hi;
};

__device__ __forceinline__ bf16_t f2bf(float f) {
    unsigned u = __float_as_uint(f);
    u += 0x7FFFu + ((u >> 16) & 1u);
    return (bf16_t)(u >> 16);
}
__device__ __forceinline__ float bf2f(bf16_t h) { return __uint_as_float(((unsigned)h) << 16); }
__device__ __forceinline__ float sigmoidf_(float x) { return 1.f / (1.f + __expf(-x)); }
__device__ __forceinline__ float siluf_(float x) { return x * sigmoidf_(x); }
__device__ __forceinline__ float gelu_tanh(float x) {
    const float u = 0.7978845608028654f * (x + 0.044715f * x * x * x);
    return 0.5f * x * (1.f + tanhf(u));
}
__device__ __forceinline__ float wave_sum(float v) {
#pragma unroll
    for (int o = 32; o > 0; o >>= 1) v += __shfl_xor(v, o, 64);
    return v;
}
typedef short bf16x4 __attribute__((ext_vector_type(4)));
#define RW_NCH 34
#define RW_BUF 13824
#define RW_VT0 27648
__device__ __forceinline__ f32x4 mfma32(bf16x8 a, bf16x8 b, f32x4 c) { return __builtin_amdgcn_mfma_f32_16x16x32_bf16(a, b, c, 0, 0, 0); }
__device__ __forceinline__ f32x4 mfma16(bf16x4 a, bf16x4 b, f32x4 c) {
    bf16x8 a8, b8;
    a8[0] = a[0]; a8[1] = a[1]; a8[2] = a[2]; a8[3] = a[3]; a8[4] = 0; a8[5] = 0; a8[6] = 0; a8[7] = 0;
    b8[0] = b[0]; b8[1] = b[1]; b8[2] = b[2]; b8[3] = b[3]; b8[4] = 0; b8[5] = 0; b8[6] = 0; b8[7] = 0;
    return __builtin_amdgcn_mfma_f32_16x16x32_bf16(a8, b8, c, 0, 0, 0);
}
__device__ __forceinline__ bf16x4 to4(f32x4 v) { bf16x4 o; o[0] = (short)f2bf(v[0]); o[1] = (short)f2bf(v[1]); o[2] = (short)f2bf(v[2]); o[3] = (short)f2bf(v[3]); return o; }
__device__ __forceinline__ bf16x8 cat8(bf16x4 a, bf16x4 b) { bf16x8 o; o[0] = a[0]; o[1] = a[1]; o[2] = a[2]; o[3] = a[3]; o[4] = b[0]; o[5] = b[1]; o[6] = b[2]; o[7] = b[3]; return o; }

__device__ __forceinline__ float rdlane(float v, int l) { return __int_as_float(__builtin_amdgcn_readlane(__float_as_int(v), l)); }
__device__ __forceinline__ int row_of(int b, int dir, int tau) {
    const int p = dir == 0 ? tau : (tau < CTX ? (CTX - 1 - tau) : (LTOT + CTX - 1 - tau));
    return b * LTOT + p;
}
__device__ __forceinline__ int modrow(int row) { const int p = row % LTOT; return p < CTX ? 4 : row / LTOT; }

__device__ __forceinline__ void s5_prep_unit(const Params& P, int l, int g, unsigned char* smem);

#define XB_TMO      128
#define XB_XCNT(j)  (256  + 64 * (j))
#define XB_XSUB(j)  (1280 + 64 * (j))
#define XB_XGEN(j)  (2304 + 64 * (j))
#define XB_TOP      3328
#define XB_TOPGEN   3392
#define XCD_BAR_WORDS 3456
#define XB_SPIN_CAP (1u << 22)
#define LAS __attribute__((address_space(3)))
__device__ __forceinline__ unsigned xb_ld(unsigned* p)              { return __hip_atomic_load(p, __ATOMIC_RELAXED, __HIP_MEMORY_SCOPE_AGENT); }
__device__ __forceinline__ unsigned xb_add(unsigned* p, unsigned v) { return __hip_atomic_fetch_add(p, v, __ATOMIC_RELAXED, __HIP_MEMORY_SCOPE_AGENT); }
__device__ __forceinline__ unsigned xb_xcc_id() { return (unsigned)__builtin_amdgcn_s_getreg((3 << 11) | 20) & 0xFu; }
#define XB_SPIN(cond, bar) do { unsigned _sp = 0; while (cond) { __builtin_amdgcn_s_sleep(1); \
    if ((++_sp & 255u) == 0u) { if (xb_ld(&(bar)[XB_TMO])) break; if (_sp > XB_SPIN_CAP) { atomicAdd(&(bar)[XB_TMO], 1u); break; } } } } while (0)
struct XcdBarrier { unsigned* bar; unsigned x; volatile LAS unsigned* st; };
__device__ __forceinline__ XcdBarrier xcd_barrier_post(unsigned* bar, volatile LAS unsigned* st) {
    XcdBarrier b; b.bar = bar; b.x = xb_xcc_id(); b.st = st;
    if (threadIdx.x == 0) (void)xb_add(&bar[XB_XCNT(b.x)], 1u);
    return b;
}
__device__ __forceinline__ void xcd_barrier_complete(unsigned* bar, unsigned x, unsigned& nloc, unsigned& nx) {
    const unsigned G = gridDim.x * gridDim.y * gridDim.z;
    unsigned sum, cnt, mine, sp = 0u;
    for (;;) {
        sum = 0u; cnt = 0u; mine = 0u;
#pragma unroll
        for (unsigned j = 0; j < 16; ++j) { const unsigned c = xb_ld(&bar[XB_XCNT(j)]); sum += c; cnt += (c > 0u) ? 1u : 0u; mine = (j == x) ? c : mine; }
        if (sum == G) break;
        __builtin_amdgcn_s_sleep(1);
        if ((++sp & 255u) == 0u) { if (xb_ld(&bar[XB_TMO])) break; if (sp > XB_SPIN_CAP) { atomicAdd(&bar[XB_TMO], 1u); break; } }
    }
    nloc = mine > 0u ? mine : 1u; nx = cnt > 0u ? cnt : 1u;
}
__device__ __forceinline__ void xcd_barrier(const XcdBarrier& b) {
    asm volatile("s_waitcnt vmcnt(0)" ::: "memory");
    __syncthreads();
    if (threadIdx.x == 0) {
        unsigned* bar = b.bar;
        __builtin_amdgcn_s_waitcnt(0);
        unsigned nloc = b.st[0], nx = b.st[1];
        if (nloc == 0u) { xcd_barrier_complete(bar, b.x, nloc, nx); b.st[0] = nloc; b.st[1] = nx; }
        const unsigned old = xb_add(&bar[XB_XSUB(b.x)], 1u);
        const unsigned gen = old / nloc;
        if (old + 1u == (gen + 1u) * nloc) {
            __builtin_amdgcn_fence(__ATOMIC_RELEASE, "agent");
            asm volatile("s_waitcnt vmcnt(0)" ::: "memory");
            const unsigned og = xb_add(&bar[XB_TOP], 1u);
            const unsigned tg = og / nx;
            if (og + 1u == (tg + 1u) * nx) xb_add(&bar[XB_TOPGEN], 1u);
            else XB_SPIN(xb_ld(&bar[XB_TOPGEN]) == tg, bar);
            __builtin_amdgcn_fence(__ATOMIC_ACQUIRE, "agent");
            xb_add(&bar[XB_XGEN(b.x)], 1u);
            asm volatile("s_waitcnt vmcnt(0)" ::: "memory");
        } else {
            XB_SPIN(xb_ld(&bar[XB_XGEN(b.x)]) == gen, bar);
            __builtin_amdgcn_fence(__ATOMIC_ACQUIRE, "agent");
            asm volatile("s_waitcnt vmcnt(0)" ::: "memory");
        }
    }
    __syncthreads();
}

__device__ __forceinline__ void phase_prep(const Params& P, unsigned char* smem) {
    const int tid = threadIdx.x, lane = tid & 63, wave = __builtin_amdgcn_readfirstlane(tid >> 6);
    float* MOD = (float*)(P.ws + OFF_MOD);
    float* XS = (float*)(P.ws + OFF_XS);
    const int U_MOD = 192, U_COPY = MROWS / 16, U_TIN = 2 * 16 * 54, U_TOUT = 2 * 16 * 16, U_TQ = 2 * 16 * 32;
    const int U_S5 = 32, U_KEY = 64 + 64;
    const int total = U_S5 + U_KEY + U_MOD + U_COPY + U_TIN + U_TOUT + U_TQ;
    for (int u0 = blockIdx.x; u0 < total; u0 += gridDim.x) {
        __syncthreads();
        if (u0 < U_S5) { s5_prep_unit(P, u0 >> 4, u0 & 15, smem); continue; }
        if (u0 < U_S5 + 64) {
            bf16_t* KB = (bf16_t*)(P.ws + OFF_KEYB);
            const size_t base = (size_t)(u0 - U_S5) * 8192;
            for (int i = tid; i < 8192; i += 256) KB[base + i] = f2bf(P.in[36][base + i]);
            continue;
        }
        if (u0 < U_S5 + U_KEY) {
            bf16_t* LW = (bf16_t*)(P.ws + OFF_LW);
            const int base = (u0 - U_S5 - 64) * 8192;
            for (int i = tid; i < 8192; i += 256) {
                const int o = base + i, which = o >> 17, e = o & 131071;
                float v;
                if (which < 2) { const int j = e & 63, c = (e >> 6) & 511, ld = e >> 15; v = P.in[which == 0 ? 26 : 28][((size_t)ld * 64 + j) * 512 + c]; }
                else if (which == 2) { const int j = e & 127, c = (e >> 7) & 511, ll = e >> 16; v = P.in[29][((size_t)ll * 128 + j) * 512 + c]; }
                else { const int k = e & 255, n = (e >> 8) & 255, ll = e >> 16; v = P.in[20][((size_t)ll * 256 + k) * 256 + n]; }
                LW[o] = f2bf(v);
            }
            continue;
        }
        const int u = u0 - U_S5 - U_KEY;
        if (u < U_MOD) {
            const int l = u / 96, j0 = (u % 96) * 64;
            float* sl = (float*)smem;
            for (int i = tid; i < 5 * 1024; i += 256) {
                const int r = i >> 10, k = i & 1023;
                const float cv = r < 4 ? P.in[1][r * 1024 + k] : P.in[3][k];
                sl[i] = siluf_(cv);
            }
            __syncthreads();
            float acc[5] = {0.f, 0.f, 0.f, 0.f, 0.f};
            const float* W = P.in[4] + (size_t)l * 1024 * 6144 + j0 + lane;
            for (int k = wave * 256; k < wave * 256 + 256; ++k) {
                const float w = W[(size_t)k * 6144];
#pragma unroll
                for (int r = 0; r < 5; ++r) acc[r] += sl[r * 1024 + k] * w;
            }
            float* red = (float*)(smem + 5 * 1024 * 4);
#pragma unroll
            for (int r = 0; r < 5; ++r) red[(wave * 5 + r) * 64 + lane] = acc[r];
            __syncthreads();
            for (int i = tid; i < 5 * 64; i += 256) {
                const int r = i / 64, jj = i % 64;
                float s = P.in[5][l * 6144 + j0 + jj];
                for (int w = 0; w < 4; ++w) s += red[(w * 5 + r) * 64 + jj];
                MOD[(l * 5 + r) * 6144 + j0 + jj] = s;
            }
        } else if (u < U_MOD + U_COPY) {
            const int r0 = (u - U_MOD) * 16;
            for (int i = tid; i < 16 * 256; i += 256) {
                const int row = r0 + (i >> 8), c4 = i & 255;
                const int b = row / LTOT, p = row % LTOT;
                const float4* src = p < CTX ? (const float4*)(P.in[2] + ((size_t)b * CTX + p) * DM) : (const float4*)(P.in[0] + ((size_t)b * SEQ + (p - CTX)) * DM);
                ((float4*)(XS + (size_t)row * DM))[c4] = src[c4];
            }
        } else {
            int v = u - U_MOD - U_COPY;
            const float* W; bf16_t* Wt; int N;
            if (v < U_TIN) { const int l = v / (16 * 54); v %= 16 * 54; N = PIN; W = P.in[6] + (size_t)l * 1024 * PIN; Wt = (bf16_t*)(P.ws + OFF_WIN) + (size_t)l * PIN * 1024; }
            else if (v < U_TIN + U_TOUT) { v -= U_TIN; const int l = v / 256; v %= 256; N = 1024; W = P.in[7] + (size_t)l * 1024 * 1024; Wt = (bf16_t*)(P.ws + OFF_WOUT) + (size_t)l * 1024 * 1024; }
            else { v -= U_TIN + U_TOUT; const int l = v / 512; v %= 512; N = 2048; W = P.in[35] + (size_t)l * 1024 * 2048; Wt = (bf16_t*)(P.ws + OFF_WQ) + (size_t)l * 2048 * 1024; }
            const int ntn = N / 64, kt = v / ntn, nt = v % ntn;
            float* t = (float*)smem;
            for (int i = tid; i < 64 * 64; i += 256) { const int kk = i >> 6, nn = i & 63; t[kk * 65 + nn] = W[(size_t)(kt * 64 + kk) * N + nt * 64 + nn]; }
            __syncthreads();
            for (int i = tid; i < 64 * 64; i += 256) { const int nn = i >> 6, kk = i & 63; Wt[(size_t)(nt * 64 + nn) * 1024 + kt * 64 + kk] = f2bf(t[kk * 65 + nn]); }
        }
    }
}

__device__ __forceinline__ void phase_mkh(const Params& P) {
    const int lane = threadIdx.x & 63, wave = __builtin_amdgcn_readfirstlane(threadIdx.x >> 6);
    const float* XS = (const float*)(P.ws + OFF_XS);
    const float* MOD = (const float*)(P.ws + OFF_MOD);
    bf16_t* H = (bf16_t*)(P.ws + OFF_H);
    for (int row = blockIdx.x * 4 + wave; row < MROWS; row += gridDim.x * 4) {
        const float* mod = MOD + (size_t)(0 * 5 + modrow(row)) * 6144;
#pragma unroll
        for (int j = 0; j < 4; ++j) {
            const int d = 256 * j + 4 * lane;
            const float4 x = *(const float4*)(XS + (size_t)row * DM + d);
            const float4 sh = *(const float4*)(mod + d), sc = *(const float4*)(mod + 1024 + d);
            ushort4 o;
            o.x = f2bf(x.x * (1.f + sc.x) + sh.x); o.y = f2bf(x.y * (1.f + sc.y) + sh.y);
            o.z = f2bf(x.z * (1.f + sc.z) + sh.z); o.w = f2bf(x.w * (1.f + sc.w) + sh.w);
            *(ushort4*)(H + (size_t)row * DM + d) = o;
        }
    }
}

template <class EPI>
__device__ __forceinline__ void gemm_bf16(const bf16_t* A, int lda, const bf16_t* Bt, int ldb, int M, int N, int K, bool skipctx, EPI epi) {
    const int lane = threadIdx.x & 63, wave = __builtin_amdgcn_readfirstlane(threadIdx.x >> 6);
    const int ntm = M / 128, ntn = N / 128;
    const int fr = lane & 15, fq = lane >> 4;
    for (int tile = blockIdx.x; tile < ntm * ntn; tile += gridDim.x) {
        const int tm = tile / ntn, tn = tile % ntn;
        const int m0 = tm * 128 + (wave >> 1) * 64, n0 = tn * 128 + (wave & 1) * 64;
        if (skipctx && (m0 % LTOT) < CTX) continue;
        f32x4 acc[4][4];
#pragma unroll
        for (int i = 0; i < 4; ++i)
#pragma unroll
            for (int j = 0; j < 4; ++j) acc[i][j] = (f32x4){0.f, 0.f, 0.f, 0.f};
        const bf16_t* ap = A + (size_t)(m0 + fr) * lda + 8 * fq;
        const bf16_t* bp = Bt + (size_t)(n0 + fr) * ldb + 8 * fq;
        for (int k0 = 0; k0 < K; k0 += 32) {
            bf16x8 a[4], b[4];
#pragma unroll
            for (int i = 0; i < 4; ++i) a[i] = *(const bf16x8*)(ap + (size_t)(16 * i) * lda + k0);
#pragma unroll
            for (int j = 0; j < 4; ++j) b[j] = *(const bf16x8*)(bp + (size_t)(16 * j) * ldb + k0);
#pragma unroll
            for (int i = 0; i < 4; ++i)
#pragma unroll
                for (int j = 0; j < 4; ++j) acc[i][j] = __builtin_amdgcn_mfma_f32_16x16x32_bf16(a[i], b[j], acc[i][j], 0, 0, 0);
        }
#pragma unroll
        for (int i = 0; i < 4; ++i)
#pragma unroll
            for (int j = 0; j < 4; ++j)
#pragma unroll
                for (int r = 0; r < 4; ++r) epi(m0 + 16 * i + 4 * fq + r, n0 + 16 * j + fr, acc[i][j][r]);
    }
}
struct EpiBf16 { bf16_t* C; int ldc; __device__ __forceinline__ void operator()(int r, int c, float v) const { C[(size_t)r * ldc + c] = f2bf(v); } };
struct EpiF32 { float* C; int ldc; __device__ __forceinline__ void operator()(int r, int c, float v) const { C[(size_t)r * ldc + c] = v; } };

__device__ __forceinline__ void phase_rwprep(const Params& P, int l, unsigned char* smem) {
    const int tid = threadIdx.x;
    const bf16_t* Pb = (const bf16_t*)(P.ws + OFF_P);
    bf16_t* RW = (bf16_t*)(P.ws + OFF_RW);
    const float* mu = P.in[24] + l * 1920;
    const float* k_k = P.in[30] + l * 512;
    float* tw = (float*)smem;
    float* al = tw + 2 * 8 * 64;
    float* kk2 = al + 2 * 8 * 64;
    float* nrm = kk2 + 8 * 512;
    for (int u = blockIdx.x; u < MROWS / 8; u += gridDim.x) {
        const int r0 = u * 8;
        __syncthreads();
        for (int i = 0; i < 8; ++i) {
            const int row = r0 + i, p = row % LTOT;
            int nb[4]; bool ok[4];
            if (p < CTX) {
                nb[0] = row - 1; ok[0] = p > 0; nb[1] = row + 1; ok[1] = p < CTX - 1; nb[2] = nb[0]; ok[2] = ok[0]; nb[3] = nb[1]; ok[3] = ok[1];
            } else {
                const int t = p - CTX, gr = t >> 6, gc = t & 63;
                nb[0] = row - 1; ok[0] = gc > 0; nb[1] = row + 1; ok[1] = gc < 63; nb[2] = row - 64; ok[2] = gr > 0; nb[3] = row + 64; ok[3] = gr < 63;
            }
            for (int c = tid; c < 1920; c += 256) {
                const int m = c & 3;
                const float pv = bf2f(Pb[(size_t)row * PIN + 1536 + c]);
                const float nv = ok[m] ? bf2f(Pb[(size_t)nb[m] * PIN + 1536 + c]) : 0.f;
                const float s = pv + mu[c] * (nv - pv);
                bf16_t* rw = RW + (size_t)row * RWW;
                if (c < 512) rw[c] = f2bf(s);
                else if (c < 1024) { rw[c] = f2bf(s); kk2[i * 512 + (c - 512)] = s * k_k[c - 512]; }
                else if (c < 1536) rw[c] = f2bf(s);
                else if (c < 1664) rw[4096 + (c - 1536)] = f2bf(sigmoidf_(s));
                else if (c < 1728) tw[(0 * 8 + i) * 64 + (c - 1664)] = tanhf(s);
                else if (c < 1792) tw[(1 * 8 + i) * 64 + (c - 1728)] = tanhf(s);
                else if (c < 1856) al[(0 * 8 + i) * 64 + (c - 1792)] = s;
                else al[(1 * 8 + i) * 64 + (c - 1856)] = s;
            }
        }
        __syncthreads();
        {
            const int pair = tid >> 2, q = tid & 3, i = pair >> 3, hd = pair & 7;
            float s = 0.f;
            for (int j = 0; j < 16; ++j) { const float v = kk2[i * 512 + hd * 64 + q * 16 + j]; s += v * v; }
            s += __shfl_xor(s, 1, 64); s += __shfl_xor(s, 2, 64);
            if (q == 0) nrm[pair] = fmaxf(sqrtf(s), 1e-12f);
        }
        __syncthreads();
        for (int e = tid; e < 8 * 512; e += 256) {
            const int i = e >> 9, c = e & 511;
            RW[(size_t)(r0 + i) * RWW + 1536 + c] = f2bf(kk2[e] / nrm[i * 8 + (c >> 6)]);
        }
        for (int d = 0; d < 2; ++d) {
            const float* wup = P.in[26] + (size_t)(l * 2 + d) * 64 * 512;
            const float* aup = P.in[28] + (size_t)(l * 2 + d) * 64 * 512;
            const float* w0 = P.in[25] + (l * 2 + d) * 512;
            const float* a0 = P.in[27] + (l * 2 + d) * 512;
            float zw[2][8], za[2][8];
#pragma unroll
            for (int i = 0; i < 8; ++i) { zw[0][i] = zw[1][i] = za[0][i] = za[1][i] = 0.f; }
            for (int j = 0; j < 64; ++j) {
                const float w_0 = wup[j * 512 + tid], w_1 = wup[j * 512 + tid + 256];
                const float a_0 = aup[j * 512 + tid], a_1 = aup[j * 512 + tid + 256];
#pragma unroll
                for (int i = 0; i < 8; ++i) {
                    const float t = tw[(d * 8 + i) * 64 + j], a = al[(d * 8 + i) * 64 + j];
                    zw[0][i] += t * w_0; zw[1][i] += t * w_1; za[0][i] += a * a_0; za[1][i] += a * a_1;
                }
            }
#pragma unroll
            for (int i = 0; i < 8; ++i) {
                bf16_t* rw = RW + (size_t)(r0 + i) * RWW;
#pragma unroll
                for (int h = 0; h < 2; ++h) {
                    const int c = tid + 256 * h;
                    rw[2048 + d * 512 + c] = f2bf(sigmoidf_(a0[c] + za[h][i]));
                    rw[3072 + d * 512 + c] = f2bf(-0.60653066f * sigmoidf_(w0[c] + zw[h][i]));
                }
            }
        }
    }
}

__device__ __forceinline__ void scan_rwkv(const Params& P, int l, int item) {
    const int lane = threadIdx.x & 63;
    const int dir = item & 1, hd = (item >> 1) & 7, b = item >> 4;
    const bf16_t* RW = (const bf16_t*)(P.ws + OFF_RW);
    bf16_t* YP = (bf16_t*)(P.ws + OFF_YP) + (size_t)dir * MROWS * DM;
    const float ka = P.in[31][l * 512 + hd * 64 + lane];
    float S[64];
#pragma unroll
    for (int k = 0; k < 64; ++k) S[k] = 0.f;
    for (int tau = 0; tau < LTOT; ++tau) {
        const int row = row_of(b, dir, tau);
#ifdef EXP_T2
        if ((tau & 127) == 0) {
            float* RXL = (float*)(P.ws + OFF_RXL);
            const size_t itm = (size_t)item * 34 + (tau >> 7);
#pragma unroll
            for (int kk = 0; kk < 64; ++kk) RXL[((itm * 16 + (kk >> 4) * 4 + (lane >> 4)) * 64 + ((kk >> 2) & 3) * 16 + (lane & 15)) * 4 + (kk & 3)] = S[kk];
        }
#endif
        const bf16_t* rw = RW + (size_t)row * RWW + hd * 64 + lane;
        const float r = bf2f(rw[0]), k = bf2f(rw[512]), v = bf2f(rw[1024]), kap = bf2f(rw[1536]);
        const float a = bf2f(rw[2048 + dir * 512]), lw = bf2f(rw[3072 + dir * 512]);
        const float w = __expf(lw), kt = k * (1.f + (a - 1.f) * ka), beta = kap * a;
        float sk = 0.f;
#pragma unroll
        for (int kk = 0; kk < 64; ++kk) { sk += S[kk] * rdlane(kap, kk); if ((kk & 7) == 7) __builtin_amdgcn_sched_barrier(0); }
        float y = 0.f;
#pragma unroll
        for (int kk = 0; kk < 64; ++kk) {
            const float s = S[kk] * rdlane(w, kk) - sk * rdlane(beta, kk) + v * rdlane(kt, kk);
            S[kk] = s;
            y += s * rdlane(r, kk);
            if ((kk & 3) == 3) __builtin_amdgcn_sched_barrier(0);
        }
        YP[(size_t)row * DM + 512 + hd * 64 + lane] = f2bf(y);
    }
}
__device__ __forceinline__ void scan_hgrn(const Params& P, int l, int item) {
    const int lane = threadIdx.x & 63;
    const int dir = item & 1, hd = (item >> 1) & 3, b = item >> 3;
    const bf16_t* Pb = (const bf16_t*)(P.ws + OFF_P);
    bf16_t* YP = (bf16_t*)(P.ws + OFF_YP) + (size_t)dir * MROWS * DM;
    float lb = 0.f;
    if (l == 1) {
        const float a0 = P.in[22][(dir * 2 + 0) * 256 + hd * 64 + lane], a1 = P.in[22][(dir * 2 + 1) * 256 + hd * 64 + lane];
        const float m = fmaxf(a0, a1), e0 = __expf(a0 - m), e1 = __expf(a1 - m);
        lb = e1 / (e0 + e1);
    }
    float S[64];
#pragma unroll
    for (int k = 0; k < 64; ++k) S[k] = 0.f;
    for (int tau = 0; tau < LTOT; ++tau) {
        const int row = row_of(b, dir, tau);
        const bf16_t* pr = Pb + (size_t)row * PIN + 256 + hd * 64 + lane;
        const float q = siluf_(bf2f(pr[0])), v = bf2f(pr[256]);
        const float f = lb + (1.f - lb) * sigmoidf_(bf2f(pr[512 + dir * 256]));
        const float kq = 1.f - f;
        float o = 0.f;
#pragma unroll
        for (int dk = 0; dk < 64; ++dk) {
            const float s = rdlane(f, dk) * S[dk] + rdlane(kq, dk) * v;
            S[dk] = s;
            o += s * rdlane(q, dk);
            if ((dk & 7) == 7) __builtin_amdgcn_sched_barrier(0);
        }
        YP[(size_t)row * DM + 256 + hd * 64 + lane] = f2bf(o);
    }
}
__device__ __forceinline__ void scan_s5(const Params& P, int l, int item) {
    const int lane = threadIdx.x & 63;
    const int dir = item & 1, g = (item >> 1) & 15, b = item >> 5;
    const bf16_t* Pb = (const bf16_t*)(P.ws + OFF_P);
    bf16_t* YP = (bf16_t*)(P.ws + OFF_YP) + (size_t)dir * MROWS * DM;
    const int ldg = (l * 2 + dir) * 16 + g;
    const float dt = expf(P.in[14][ldg]);
    const float lre = P.in[12][ldg * 64 + lane], lim = P.in[13][ldg * 64 + lane];
    const float mag = expf(lre * dt), ang = lim * dt;
    const float lb_re = mag * cosf(ang), lb_im = mag * sinf(ang);
    const float den = lre * lre + lim * lim, nr = lb_re - 1.f, ni = lb_im;
    const float co_re = (nr * lre + ni * lim) / den, co_im = (ni * lre - nr * lim) / den;
    float bb_re[16], bb_im[16], c_re[16], c_im[16];
#pragma unroll
    for (int h = 0; h < 16; ++h) {
        const float br = P.in[15][((size_t)ldg * 64 + lane) * 16 + h], bi = P.in[16][((size_t)ldg * 64 + lane) * 16 + h];
        bb_re[h] = co_re * br - co_im * bi; bb_im[h] = co_re * bi + co_im * br;
        c_re[h] = P.in[17][((size_t)ldg * 16 + h) * 64 + lane]; c_im[h] = P.in[18][((size_t)ldg * 16 + h) * 64 + lane];
    }
    float s_re = 0.f, s_im = 0.f;
    for (int tau = 0; tau < LTOT; ++tau) {
        const int row = row_of(b, dir, tau);
        const float uv = bf2f(Pb[(size_t)row * PIN + g * 16 + (lane & 15)]);
        float bu_re = 0.f, bu_im = 0.f;
#pragma unroll
        for (int h = 0; h < 16; ++h) { const float uh = rdlane(uv, h); bu_re += bb_re[h] * uh; bu_im += bb_im[h] * uh; }
        const float n_re = lb_re * s_re - lb_im * s_im + bu_re, n_im = lb_re * s_im + lb_im * s_re + bu_im;
        s_re = n_re; s_im = n_im;
        float yo = 0.f;
#pragma unroll
        for (int h = 0; h < 16; ++h) { const float t = wave_sum(c_re[h] * s_re - c_im[h] * s_im); yo = (lane == h) ? t : yo; }
        if (lane < 16) YP[(size_t)row * DM + g * 16 + lane] = f2bf(yo);
    }
}
__device__ __forceinline__ void phase_scans(const Params& P, int l) {
    const int wave = __builtin_amdgcn_readfirstlane(threadIdx.x >> 6);
    for (int it = wave * gridDim.x + blockIdx.x; it < 32; it += 4 * gridDim.x) scan_hgrn(P, l, it);
}

__device__ __forceinline__ void phase_post(const Params& P, int l, unsigned char* smem) {
    const int tid = threadIdx.x;
    const bf16_t* Pb = (const bf16_t*)(P.ws + OFF_P);
    const bf16_t* RW = (const bf16_t*)(P.ws + OFF_RW);
    const bf16_t* YF = (const bf16_t*)(P.ws + OFF_YP);
    const bf16_t* YB = YF + (size_t)MROWS * DM;
    bf16_t* MIX = (bf16_t*)(P.ws + OFF_MIX);
    float* ypre = (float*)smem;
    float* sg = ypre + 8 * 256;
    for (int u = blockIdx.x; u < MROWS / 8; u += gridDim.x) {
        const int r0 = u * 8;
        if (l == 1 && (r0 % LTOT) < CTX) continue;
        __syncthreads();
        for (int i = 0; i < 8; ++i) {
            const int row = r0 + i;
            ypre[i * 256 + tid] = bf2f(YF[(size_t)row * DM + tid]);
        }
        for (int e = tid; e < 8 * 128; e += 256) sg[e] = bf2f(RW[(size_t)(r0 + (e >> 7)) * RWW + 4096 + (e & 127)]);
        __syncthreads();
        {
            float z[8];
            const float gb = P.in[21][l * 256 + tid];
#pragma unroll
            for (int i = 0; i < 8; ++i) z[i] = gb;
            const float* gw = P.in[20] + (size_t)l * 256 * 256 + tid;
            for (int k = 0; k < 256; ++k) {
                const float w = gw[k * 256];
#pragma unroll
                for (int i = 0; i < 8; ++i) z[i] += ypre[i * 256 + k] * w;
            }
#pragma unroll
            for (int i = 0; i < 8; ++i) MIX[(size_t)(r0 + i) * DM + tid] = f2bf(ypre[i * 256 + tid] * sigmoidf_(z[i]));
        }
        {
            const int i = tid >> 5, c0 = (tid & 31) * 8, row = r0 + i;
            float o[8], ss = 0.f;
#pragma unroll
            for (int j = 0; j < 8; ++j) { o[j] = bf2f(YF[(size_t)row * DM + 256 + c0 + j]) + bf2f(YB[(size_t)row * DM + 256 + c0 + j]); ss += o[j] * o[j]; }
            ss += __shfl_xor(ss, 1, 64); ss += __shfl_xor(ss, 2, 64); ss += __shfl_xor(ss, 4, 64);
            const float rs = rsqrtf(ss * (1.f / 64.f) + 1e-6f);
#pragma unroll
            for (int j = 0; j < 8; ++j) {
                const float gr = bf2f(Pb[(size_t)row * PIN + 256 + 1024 + c0 + j]);
                MIX[(size_t)row * DM + 256 + c0 + j] = f2bf(o[j] * rs * P.in[23][l * 256 + c0 + j] * siluf_(gr));
            }
        }
        {
            const int i = tid >> 5, c0 = (tid & 31) * 16, row = r0 + i;
            const bf16_t* rw = RW + (size_t)row * RWW;
            float y[16], vv[16], sum = 0.f, bon = 0.f;
#pragma unroll
            for (int j = 0; j < 16; ++j) {
                const int c = c0 + j;
                y[j] = bf2f(YF[(size_t)row * DM + 512 + c]) + bf2f(YB[(size_t)row * DM + 512 + c]);
                sum += y[j];
                const float r = bf2f(rw[c]), k = bf2f(rw[512 + c]), af = bf2f(rw[2048 + c]), ab = bf2f(rw[2560 + c]);
                const float ka = P.in[31][l * 512 + c];
                vv[j] = bf2f(rw[1024 + c]);
                bon += r * P.in[32][l * 512 + c] * (k * (1.f + (af - 1.f) * ka) + k * (1.f + (ab - 1.f) * ka));
            }
            sum += __shfl_xor(sum, 1, 64); sum += __shfl_xor(sum, 2, 64);
            bon += __shfl_xor(bon, 1, 64); bon += __shfl_xor(bon, 2, 64);
            const float mean = sum * (1.f / 64.f);
            float var = 0.f;
#pragma unroll
            for (int j = 0; j < 16; ++j) { const float d = y[j] - mean; var += d * d; }
            var += __shfl_xor(var, 1, 64); var += __shfl_xor(var, 2, 64);
            const float rs = rsqrtf(var * (1.f / 64.f) + 64e-5f);
            float g[16];
#pragma unroll
            for (int j = 0; j < 16; ++j) g[j] = 0.f;
            const float* gup = P.in[29] + (size_t)l * 128 * 512 + c0;
            for (int jj = 0; jj < 128; ++jj) {
                const float s = sg[i * 128 + jj];
                const float4 w0 = *(const float4*)(gup + jj * 512), w1 = *(const float4*)(gup + jj * 512 + 4), w2 = *(const float4*)(gup + jj * 512 + 8), w3 = *(const float4*)(gup + jj * 512 + 12);
                g[0] += s * w0.x; g[1] += s * w0.y; g[2] += s * w0.z; g[3] += s * w0.w;
                g[4] += s * w1.x; g[5] += s * w1.y; g[6] += s * w1.z; g[7] += s * w1.w;
                g[8] += s * w2.x; g[9] += s * w2.y; g[10] += s * w2.z; g[11] += s * w2.w;
                g[12] += s * w3.x; g[13] += s * w3.y; g[14] += s * w3.z; g[15] += s * w3.w;
            }
#pragma unroll
            for (int j = 0; j < 16; ++j) {
                const int c = c0 + j;
                const float yn = (y[j] - mean) * rs * P.in[33][l * 512 + c] + P.in[34][l * 512 + c];
                MIX[(size_t)row * DM + 512 + c] = f2bf((yn + bon * vv[j]) * g[j]);
            }
        }
    }
}

__device__ __forceinline__ void phase_ln1(const Params& P, int l) {
    const int lane = threadIdx.x & 63, wave = __builtin_amdgcn_readfirstlane(threadIdx.x >> 6);
    float* XS = (float*)(P.ws + OFF_XS);
    const float* TMP = (const float*)(P.ws + OFF_TMP);
    const float* MOD = (const float*)(P.ws + OFF_MOD);
    bf16_t* H2 = (bf16_t*)(P.ws + OFF_H2);
    for (int row = blockIdx.x * 4 + wave; row < MROWS; row += gridDim.x * 4) {
        if (l == 1 && (row % LTOT) < CTX) continue;
        const float* mod = MOD + (size_t)(l * 5 + modrow(row)) * 6144;
        float v[16]; float s = 0.f;
#pragma unroll
        for (int j = 0; j < 4; ++j) {
            const int d = 256 * j + 4 * lane;
            const float4 x = *(const float4*)(XS + (size_t)row * DM + d), t = *(const float4*)(TMP + (size_t)row * DM + d), g = *(const float4*)(mod + 2048 + d);
            v[4 * j + 0] = ALPHA * x.x + g.x * t.x; v[4 * j + 1] = ALPHA * x.y + g.y * t.y; v[4 * j + 2] = ALPHA * x.z + g.z * t.z; v[4 * j + 3] = ALPHA * x.w + g.w * t.w;
            s += v[4 * j] + v[4 * j + 1] + v[4 * j + 2] + v[4 * j + 3];
        }
        const float mean = wave_sum(s) * (1.f / 1024.f);
        float q = 0.f;
#pragma unroll
        for (int j = 0; j < 16; ++j) { const float d = v[j] - mean; q += d * d; }
        const float rs = rsqrtf(wave_sum(q) * (1.f / 1024.f) + 1e-5f);
#pragma unroll
        for (int j = 0; j < 4; ++j) {
            const int d = 256 * j + 4 * lane;
            const float4 gg = *(const float4*)(P.in[8] + l * 1024 + d), bb = *(const float4*)(P.in[9] + l * 1024 + d);
            const float4 sh = *(const float4*)(mod + 3072 + d), sc = *(const float4*)(mod + 4096 + d);
            float4 o;
            o.x = (v[4 * j + 0] - mean) * rs * gg.x + bb.x; o.y = (v[4 * j + 1] - mean) * rs * gg.y + bb.y;
            o.z = (v[4 * j + 2] - mean) * rs * gg.z + bb.z; o.w = (v[4 * j + 3] - mean) * rs * gg.w + bb.w;
            *(float4*)(XS + (size_t)row * DM + d) = o;
            ushort4 h;
            h.x = f2bf(o.x * (1.f + sc.x) + sh.x); h.y = f2bf(o.y * (1.f + sc.y) + sh.y); h.z = f2bf(o.z * (1.f + sc.z) + sh.z); h.w = f2bf(o.w * (1.f + sc.w) + sh.w);
            *(ushort4*)(H2 + (size_t)row * DM + d) = h;
        }
    }
}

__device__ __forceinline__ unsigned f2ord(float f) { const unsigned u = __float_as_uint(f); return u ^ ((u >> 31) ? 0xFFFFFFFFu : 0x80000000u); }
__device__ __forceinline__ float ord2f(unsigned u) { return __uint_as_float((u >> 31) ? (u ^ 0x80000000u) : ~u); }
__device__ __forceinline__ void phase_topk(const Params& P, int l) {
    const int tid = threadIdx.x;
    const bf16_t* Q = (const bf16_t*)(P.ws + OFF_Q);
    int* IDX = (int*)(P.ws + OFF_IDX);
    float* GATE = (float*)(P.ws + OFF_GATE);
    for (int u = blockIdx.x; u < 8 * (MROWS / 256); u += gridDim.x) {
        const int hd = u / (MROWS / 256), rb = u % (MROWS / 256);
        const int row = rb * 256 + tid;
        if (l == 1 && (row % LTOT) < CTX) continue;
        unsigned top[2][16];
#pragma unroll
        for (int half = 0; half < 2; ++half) {
            float q[128];
            const bf16_t* qp = Q + (size_t)row * 2048 + hd * 256 + half * 128;
#pragma unroll
            for (int d8 = 0; d8 < 16; ++d8) {
                const bf16x8 v = *(const bf16x8*)(qp + d8 * 8);
#pragma unroll
                for (int j = 0; j < 8; ++j) q[d8 * 8 + j] = bf2f((bf16_t)v[j]);
            }
#pragma unroll
            for (int j = 0; j < 16; ++j) top[half][j] = 0u;
            const float* kp = P.in[36] + ((size_t)((l * 8 + hd) * 2 + half)) * 128 * 128;
            for (int key = 0; key < 128; ++key) {
                const float* kr = kp + key * 128;
                float s0 = 0.f, s1 = 0.f, s2 = 0.f, s3 = 0.f;
#pragma unroll
                for (int d = 0; d < 128; d += 4) { s0 += q[d] * kr[d]; s1 += q[d + 1] * kr[d + 1]; s2 += q[d + 2] * kr[d + 2]; s3 += q[d + 3] * kr[d + 3]; if ((d & 31) == 28) __builtin_amdgcn_sched_barrier(0); }
                unsigned x = (f2ord((s0 + s1) + (s2 + s3)) & 0xFFFFFF80u) | (unsigned)(127 - key);
#pragma unroll
                for (int j = 0; j < 16; ++j) { const unsigned t = top[half][j]; const unsigned mx = x > t ? x : t; x = x > t ? t : x; top[half][j] = mx; }
            }
        }
        float cs[16]; int ce[16];
#pragma unroll
        for (int j = 0; j < 16; ++j) { cs[j] = -3.0e38f; ce[j] = 0; }
#pragma unroll
        for (int i = 0; i < 16; ++i) {
            const float s1v = ord2f(top[0][i] & 0xFFFFFF80u); const int i1 = 127 - (int)(top[0][i] & 127u);
#pragma unroll
            for (int j = 0; j < 16; ++j) {
                if ((i + 1) * (j + 1) <= 16) {
                    float x = s1v + ord2f(top[1][j] & 0xFFFFFF80u); int xe = i1 * 128 + (127 - (int)(top[1][j] & 127u));
#pragma unroll
                    for (int t = 0; t < 16; ++t) {
                        const bool gt = x > cs[t];
                        const float ts = cs[t]; const int te = ce[t];
                        cs[t] = gt ? x : ts; ce[t] = gt ? xe : te; x = gt ? ts : x; xe = gt ? te : xe;
                    }
                }
            }
        }
        float den = 0.f, ex[16];
#pragma unroll
        for (int t = 0; t < 16; ++t) { ex[t] = __expf(cs[t] - cs[0]); den += ex[t]; }
        const float inv = 1.f / den;
#pragma unroll
        for (int t = 0; t < 16; ++t) { IDX[(size_t)row * 128 + hd * 16 + t] = ce[t]; GATE[(size_t)row * 128 + hd * 16 + t] = ex[t] * inv; }
    }
}


__device__ __forceinline__ void ce_desc(unsigned& a, unsigned& b) { const unsigned hi = a > b ? a : b, lo = a > b ? b : a; a = hi; b = lo; }
__device__ __forceinline__ void bitonic_sort16(unsigned (&u)[16]) {
#pragma unroll
    for (int k = 2; k <= 16; k <<= 1)
#pragma unroll
        for (int j = k >> 1; j > 0; j >>= 1)
#pragma unroll
            for (int i = 0; i < 16; ++i) {
                const int p = i ^ j;
                if (p > i) { if ((i & k) == 0) ce_desc(u[i], u[p]); else ce_desc(u[p], u[i]); }
            }
}
__device__ __forceinline__ void bitonic_merge16(unsigned (&u)[16]) {
#pragma unroll
    for (int j = 8; j > 0; j >>= 1)
#pragma unroll
        for (int i = 0; i < 16; ++i) { const int p = i ^ j; if (p > i) ce_desc(u[i], u[p]); }
}
__device__ __forceinline__ void xlane_top16(unsigned (&u)[16], int xr) {
    unsigned o[16];
#pragma unroll
    for (int i = 0; i < 16; ++i) o[i] = (unsigned)__shfl_xor((int)u[15 - i], xr, 64);
#pragma unroll
    for (int i = 0; i < 16; ++i) u[i] = u[i] > o[i] ? u[i] : o[i];
    bitonic_merge16(u);
}
__device__ __forceinline__ void phase_topk2(const Params& P, int l, unsigned char* smem) {
    const int lane = threadIdx.x & 63, wave = __builtin_amdgcn_readfirstlane(threadIdx.x >> 6), fr = lane & 15, fq = lane >> 4;
    const bf16_t* Q = (const bf16_t*)(P.ws + OFF_Q);
    const bf16_t* KB = (const bf16_t*)(P.ws + OFF_KEYB);
    int* IDX = (int*)(P.ws + OFF_IDX);
    float* GATE = (float*)(P.ws + OFF_GATE);
    unsigned char* ids = smem + wave * 512;
    for (int it = blockIdx.x * 4 + wave; it < (MROWS / 16) * 8; it += gridDim.x * 4) {
        const int rt = it >> 3, hd = it & 7, row0 = rt * 16;
        if (l == 1 && (row0 % LTOT) < CTX) continue;
        unsigned top[2][16];
#pragma unroll
        for (int half = 0; half < 2; ++half) {
            f32x4 acc[8];
#pragma unroll
            for (int mi = 0; mi < 8; ++mi) acc[mi] = (f32x4){0.f, 0.f, 0.f, 0.f};
            const bf16_t* kp = KB + ((size_t)((l * 8 + hd) * 2 + half) * 128 + fr) * 128 + 8 * fq;
            const bf16_t* qp = Q + (size_t)(row0 + fr) * 2048 + hd * 256 + half * 128 + 8 * fq;
#pragma unroll
            for (int ks = 0; ks < 4; ++ks) {
                const bf16x8 qb = *(const bf16x8*)(qp + 32 * ks);
#pragma unroll
                for (int mi = 0; mi < 8; ++mi) acc[mi] = mfma32(*(const bf16x8*)(kp + (size_t)(16 * mi) * 128 + 32 * ks), qb, acc[mi]);
            }
            unsigned ua[16], ub[16];
#pragma unroll
            for (int mi = 0; mi < 4; ++mi)
#pragma unroll
                for (int r = 0; r < 4; ++r) {
                    ua[mi * 4 + r] = (f2ord(acc[mi][r]) & 0xFFFFFF80u) | (unsigned)(127 - (16 * mi + 4 * fq + r));
                    ub[mi * 4 + r] = (f2ord(acc[mi + 4][r]) & 0xFFFFFF80u) | (unsigned)(127 - (16 * (mi + 4) + 4 * fq + r));
                }
            bitonic_sort16(ua); bitonic_sort16(ub);
#pragma unroll
            for (int i = 0; i < 16; ++i) ua[i] = ua[i] > ub[15 - i] ? ua[i] : ub[15 - i];
            bitonic_merge16(ua);
            xlane_top16(ua, 16); xlane_top16(ua, 32);
#pragma unroll
            for (int i = 0; i < 16; ++i) top[half][i] = ua[i];
        }
        if (fq == 0) {
            unsigned w[8];
#pragma unroll
            for (int i = 0; i < 8; ++i) {
                const unsigned* t = i < 4 ? &top[0][4 * i] : &top[1][4 * (i - 4)];
                w[i] = (127u - (t[0] & 127u)) | ((127u - (t[1] & 127u)) << 8) | ((127u - (t[2] & 127u)) << 16) | ((127u - (t[3] & 127u)) << 24);
            }
            *(uint4*)(ids + fr * 32) = make_uint4(w[0], w[1], w[2], w[3]);
            *(uint4*)(ids + fr * 32 + 16) = make_uint4(w[4], w[5], w[6], w[7]);
        }
        float s2v[16];
#pragma unroll
        for (int j = 0; j < 16; ++j) s2v[j] = ord2f(top[1][j] & 0xFFFFFF80u);
        float s1r[4];
#pragma unroll
        for (int m = 0; m < 4; ++m) {
            const unsigned t = fq == 0 ? top[0][4 * m] : (fq == 1 ? top[0][4 * m + 1] : (fq == 2 ? top[0][4 * m + 2] : top[0][4 * m + 3]));
            s1r[m] = ord2f(t & 0xFFFFFF80u);
        }
        unsigned cu[16];
#pragma unroll
        for (int j = 0; j < 16; ++j) cu[j] = (f2ord(s1r[0] + s2v[j]) & 0xFFFFFF00u) | (unsigned)((fq << 4) | j);
        {
            unsigned ex[5];
            ex[0] = (f2ord(s1r[1] + s2v[0]) & 0xFFFFFF00u) | (unsigned)(((4 + fq) << 4) | 0);
            ex[1] = (f2ord(s1r[1] + s2v[1]) & 0xFFFFFF00u) | (unsigned)(((4 + fq) << 4) | 1);
            ex[2] = (f2ord(s1r[1] + s2v[2]) & 0xFFFFFF00u) | (unsigned)(((4 + fq) << 4) | 2);
            ex[3] = (f2ord(s1r[2] + s2v[0]) & 0xFFFFFF00u) | (unsigned)(((8 + fq) << 4) | 0);
            ex[4] = (f2ord(s1r[3] + s2v[0]) & 0xFFFFFF00u) | (unsigned)(((12 + fq) << 4) | 0);
#pragma unroll
            for (int e = 0; e < 5; ++e) {
                unsigned x = ex[e];
#pragma unroll
                for (int t = 0; t < 16; ++t) { const unsigned c = cu[t]; const unsigned mx = x > c ? x : c; x = x > c ? c : x; cu[t] = mx; }
            }
        }
        xlane_top16(cu, 16); xlane_top16(cu, 32);
        if (fq == 0) {
            float ex[16], den = 0.f; int eid[16];
            const float m0 = ord2f(cu[0] & 0xFFFFFF00u);
#pragma unroll
            for (int t = 0; t < 16; ++t) {
                ex[t] = __expf(ord2f(cu[t] & 0xFFFFFF00u) - m0); den += ex[t];
                const int i = (cu[t] >> 4) & 15, j = cu[t] & 15;
                eid[t] = (int)ids[fr * 32 + i] * 128 + (int)ids[fr * 32 + 16 + j];
            }
            const float inv = 1.f / den;
            int* ip = IDX + (size_t)(row0 + fr) * 128 + hd * 16;
            float* gp = GATE + (size_t)(row0 + fr) * 128 + hd * 16;
#pragma unroll
            for (int t = 0; t < 16; t += 4) {
                *(int4*)(ip + t) = make_int4(eid[t], eid[t + 1], eid[t + 2], eid[t + 3]);
                *(float4*)(gp + t) = make_float4(ex[t] * inv, ex[t + 1] * inv, ex[t + 2] * inv, ex[t + 3] * inv);
            }
        }
    }
}

__device__ __forceinline__ void phase_tabconv(const Params& P, int l) {
    const float4* U = (const float4*)(P.in[37] + (size_t)l * 16384 * 1024);
    const float4* V = (const float4*)(P.in[38] + (size_t)l * 16384 * 1024);
    ushort4* TU = (ushort4*)(P.ws + OFF_TBU);
    ushort4* TV = (ushort4*)(P.ws + OFF_TBV);
    const size_t n4 = (size_t)16384 * 256;
    for (size_t i = (size_t)blockIdx.x * 256 + threadIdx.x; i < n4; i += (size_t)gridDim.x * 256) {
        const float4 a = U[i], b = V[i];
        ushort4 oa, ob;
        oa.x = f2bf(a.x); oa.y = f2bf(a.y); oa.z = f2bf(a.z); oa.w = f2bf(a.w);
        ob.x = f2bf(b.x); ob.y = f2bf(b.y); ob.z = f2bf(b.z); ob.w = f2bf(b.w);
        TU[i] = oa; TV[i] = ob;
    }
}
__device__ __forceinline__ float dot2bf(unsigned a, unsigned b, float acc) { return __builtin_amdgcn_fdot2_f32_bf16(__builtin_bit_cast(bf16x2, a), __builtin_bit_cast(bf16x2, b), acc, false); }
__device__ __forceinline__ float dot8(const uint4& a, const uint4& b, float acc) { acc = dot2bf(a.x, b.x, acc); acc = dot2bf(a.y, b.y, acc); acc = dot2bf(a.z, b.z, acc); return dot2bf(a.w, b.w, acc); }
__device__ __forceinline__ void phase_gather(const Params& P, int l, unsigned char* smem) {
    const int tid = threadIdx.x, lane = tid & 63, wave = __builtin_amdgcn_readfirstlane(tid >> 6);
    float* XS = (float*)(P.ws + OFF_XS);
    const float* MOD = (const float*)(P.ws + OFF_MOD);
    const bf16_t* H2 = (const bf16_t*)(P.ws + OFF_H2);
    bf16_t* H = (bf16_t*)(P.ws + OFF_H);
    const int* IDX = (const int*)(P.ws + OFF_IDX);
    const float* GATE = (const float*)(P.ws + OFF_GATE);
    const bf16_t* TU = (const bf16_t*)(P.ws + OFF_TBU);
    const bf16_t* TV = (const bf16_t*)(P.ws + OFF_TBV);
    float* coef = (float*)smem + wave * 128;
    for (int row = blockIdx.x * 4 + wave; row < MROWS; row += gridDim.x * 4) {
        if (l == 1 && (row % LTOT) < CTX) continue;
        const uint4 h0 = *(const uint4*)(H2 + (size_t)row * DM + 8 * lane), h1 = *(const uint4*)(H2 + (size_t)row * DM + 512 + 8 * lane);
        const int e0 = IDX[(size_t)row * 128 + lane], e1 = IDX[(size_t)row * 128 + 64 + lane];
        uint4 ra[8], rb[8];
#define LOADB(T, bt) { _Pragma("unroll") for (int i = 0; i < 8; ++i) { const int k = (bt) * 8 + i; const int e = __builtin_amdgcn_readlane(k < 64 ? e0 : e1, k & 63); \
            const uint4* rp = (const uint4*)((T) + (size_t)e * 1024); ra[i] = rp[lane]; rb[i] = rp[64 + lane]; } }
        for (int bt = 0; bt < 16; ++bt) {
            LOADB(TU, bt)
            float p[8];
#pragma unroll
            for (int i = 0; i < 8; ++i) p[i] = dot8(rb[i], h1, dot8(ra[i], h0, 0.f));
            float q[4], r2[2];
#pragma unroll
            for (int i = 0; i < 4; ++i) { const float sd = (lane & 32) ? p[i] : p[i + 4]; const float rc = __shfl_xor(sd, 32, 64); q[i] = ((lane & 32) ? p[i + 4] : p[i]) + rc; }
#pragma unroll
            for (int i = 0; i < 2; ++i) { const float sd = (lane & 16) ? q[i] : q[i + 2]; const float rc = __shfl_xor(sd, 16, 64); r2[i] = ((lane & 16) ? q[i + 2] : q[i]) + rc; }
            float sv;
            { const float sd = (lane & 8) ? r2[0] : r2[1]; const float rc = __shfl_xor(sd, 8, 64); sv = ((lane & 8) ? r2[1] : r2[0]) + rc; }
            sv += __shfl_xor(sv, 4, 64); sv += __shfl_xor(sv, 2, 64); sv += __shfl_xor(sv, 1, 64);
            if ((lane & 7) == 0) { const int k = bt * 8 + ((lane >> 3) & 7); coef[k] = gelu_tanh(sv) * GATE[(size_t)row * 128 + k]; }
        }
        float acc[16];
#pragma unroll
        for (int j = 0; j < 16; ++j) acc[j] = 0.f;
        for (int bt = 0; bt < 16; ++bt) {
            LOADB(TV, bt)
#pragma unroll
            for (int i = 0; i < 8; ++i) {
                const float c = coef[bt * 8 + i];
                const unsigned w[8] = {ra[i].x, ra[i].y, ra[i].z, ra[i].w, rb[i].x, rb[i].y, rb[i].z, rb[i].w};
#pragma unroll
                for (int j = 0; j < 8; ++j) { acc[2 * j] += c * __uint_as_float(w[j] << 16); acc[2 * j + 1] += c * __uint_as_float(w[j] & 0xFFFF0000u); }
            }
        }
#undef LOADB
        const float* mod = MOD + (size_t)(l * 5 + modrow(row)) * 6144;
        float v[16]; float s = 0.f;
#pragma unroll
        for (int hh = 0; hh < 2; ++hh) {
            const int d = 512 * hh + 8 * lane;
            const float4 x0 = *(const float4*)(XS + (size_t)row * DM + d), x1 = *(const float4*)(XS + (size_t)row * DM + d + 4);
            const float4 g0 = *(const float4*)(mod + 5120 + d), g1 = *(const float4*)(mod + 5120 + d + 4);
            v[8 * hh + 0] = ALPHA * x0.x + g0.x * acc[8 * hh + 0]; v[8 * hh + 1] = ALPHA * x0.y + g0.y * acc[8 * hh + 1];
            v[8 * hh + 2] = ALPHA * x0.z + g0.z * acc[8 * hh + 2]; v[8 * hh + 3] = ALPHA * x0.w + g0.w * acc[8 * hh + 3];
            v[8 * hh + 4] = ALPHA * x1.x + g1.x * acc[8 * hh + 4]; v[8 * hh + 5] = ALPHA * x1.y + g1.y * acc[8 * hh + 5];
            v[8 * hh + 6] = ALPHA * x1.z + g1.z * acc[8 * hh + 6]; v[8 * hh + 7] = ALPHA * x1.w + g1.w * acc[8 * hh + 7];
        }
#pragma unroll
        for (int j = 0; j < 16; ++j) s += v[j];
        const float mean = wave_sum(s) * (1.f / 1024.f);
        float qq = 0.f;
#pragma unroll
        for (int j = 0; j < 16; ++j) { v[j] -= mean; qq += v[j] * v[j]; }
        const float rs = rsqrtf(wave_sum(qq) * (1.f / 1024.f) + 1e-5f);
        const float* mod1 = MOD + (size_t)(1 * 5 + modrow(row)) * 6144;
#pragma unroll
        for (int hh = 0; hh < 2; ++hh) {
            const int d = 512 * hh + 8 * lane;
            float o[8];
#pragma unroll
            for (int j = 0; j < 8; ++j) o[j] = v[8 * hh + j] * rs * P.in[10][l * 1024 + d + j] + P.in[11][l * 1024 + d + j];
            if (l == 0) {
                *(float4*)(XS + (size_t)row * DM + d) = make_float4(o[0], o[1], o[2], o[3]);
                *(float4*)(XS + (size_t)row * DM + d + 4) = make_float4(o[4], o[5], o[6], o[7]);
                bf16_t hb[8];
#pragma unroll
                for (int j = 0; j < 8; ++j) hb[j] = f2bf(o[j] * (1.f + mod1[1024 + d + j]) + mod1[d + j]);
                uint4 pk; pk.x = hb[0] | ((unsigned)hb[1] << 16); pk.y = hb[2] | ((unsigned)hb[3] << 16); pk.z = hb[4] | ((unsigned)hb[5] << 16); pk.w = hb[6] | ((unsigned)hb[7] << 16);
                *(uint4*)(H + (size_t)row * DM + d) = pk;
            } else {
                const int b = row / LTOT, t = row % LTOT - CTX;
                if (*(volatile unsigned*)(P.ws + OFF_BAR + 15360) != 0u) { o[0] = __int_as_float(0x7fc00000); }
                float* op = P.out + ((size_t)b * SEQ + t) * DM + d;
                *(float4*)op = make_float4(o[0], o[1], o[2], o[3]);
                *(float4*)(op + 4) = make_float4(o[4], o[5], o[6], o[7]);
            }
        }
    }
}

__device__ __forceinline__ void s5_prep_unit(const Params& P, int l, int g, unsigned char* smem) {
    const int tid = threadIdx.x;
    float* Kt = (float*)smem;
    float* bbr = Kt + 8192; float* bbi = bbr + 1024; float* cr = bbi + 1024; float* ci = cr + 1024; float* pwr = ci + 1024; float* pwi = pwr + 17 * 64;
    bf16_t* MS = (bf16_t*)(P.ws + OFF_S5MS) + (size_t)(l * 16 + g) * 256 * 256;
    bf16_t* MY = (bf16_t*)(P.ws + OFF_S5MY) + (size_t)(l * 16 + g) * 256 * 512;
    float* LB = (float*)(P.ws + OFF_S5LB) + (size_t)(l * 16 + g) * 256;
    for (int dir = 0; dir < 2; ++dir) {
        __syncthreads();
        const int ldg = (l * 2 + dir) * 16 + g;
        if (tid < 64) {
            const int p = tid;
            const float dt = expf(P.in[14][ldg]);
            const float lre = P.in[12][ldg * 64 + p], lim = P.in[13][ldg * 64 + p];
            for (int d = 0; d <= 16; ++d) { const float mag = expf(lre * dt * (float)d), ang = lim * dt * (float)d; pwr[d * 64 + p] = mag * cosf(ang); pwi[d * 64 + p] = mag * sinf(ang); }
            const float lb_re = pwr[64 + p], lb_im = pwi[64 + p];
            const float den = lre * lre + lim * lim, nr = lb_re - 1.f, ni = lb_im;
            const float co_re = (nr * lre + ni * lim) / den, co_im = (ni * lre - nr * lim) / den;
            for (int h = 0; h < 16; ++h) {
                const float br = P.in[15][((size_t)ldg * 64 + p) * 16 + h], bi = P.in[16][((size_t)ldg * 64 + p) * 16 + h];
                bbr[p * 16 + h] = co_re * br - co_im * bi; bbi[p * 16 + h] = co_re * bi + co_im * br;
            }
            LB[dir * 128 + p] = pwr[16 * 64 + p]; LB[dir * 128 + 64 + p] = pwi[16 * 64 + p];
        }
        for (int e = tid; e < 1024; e += 256) { cr[e] = P.in[17][(size_t)ldg * 1024 + e]; ci[e] = P.in[18][(size_t)ldg * 1024 + e]; }
        __syncthreads();
        for (int e = tid; e < 4096; e += 256) {
            const int d = e >> 8, h = (e >> 4) & 15, h2 = e & 15;
            float acc = 0.f;
            for (int p = 0; p < 64; ++p) {
                const float Pr = pwr[d * 64 + p], Pi = pwi[d * 64 + p], br = bbr[p * 16 + h2], bi = bbi[p * 16 + h2];
                acc += cr[h * 64 + p] * (Pr * br - Pi * bi) - ci[h * 64 + p] * (Pr * bi + Pi * br);
            }
            Kt[dir * 4096 + e] = acc;
        }
        for (int e = tid; e < 128 * 256; e += 256) {
            const int q = e >> 8, col = e & 255, j = col >> 4, h2 = col & 15, p = q & 63;
            const int ex = dir == 0 ? 15 - j : j;
            const float Pr = pwr[ex * 64 + p], Pi = pwi[ex * 64 + p], br = bbr[p * 16 + h2], bi = bbi[p * 16 + h2];
            MS[(size_t)(dir * 128 + q) * 256 + col] = f2bf(q < 64 ? Pr * br - Pi * bi : Pr * bi + Pi * br);
        }
        for (int e = tid; e < 256 * 128; e += 256) {
            const int ri = e >> 7, q = e & 127, t = ri >> 4, h = ri & 15, p = q & 63;
            const int ex = dir == 0 ? t + 1 : 16 - t;
            const float Lr = pwr[ex * 64 + p], Li = pwi[ex * 64 + p], c_r = cr[h * 64 + p], c_i = ci[h * 64 + p];
            MY[(size_t)ri * 512 + 256 + dir * 128 + q] = f2bf(q < 64 ? c_r * Lr - c_i * Li : -(c_r * Li + c_i * Lr));
        }
    }
    __syncthreads();
    for (int e = tid; e < 256 * 256; e += 256) {
        const int ri = e >> 8, col = e & 255, t = ri >> 4, h = ri & 15, j = col >> 4, h2 = col & 15;
        float v = 0.f;
        if (j <= t) v += Kt[(t - j) * 256 + h * 16 + h2];
        if (j >= t) v += Kt[4096 + (j - t) * 256 + h * 16 + h2];
        MY[(size_t)ri * 512 + col] = f2bf(v);
    }
}
__device__ __forceinline__ void s5_passA(const Params& P, int l) {
    const int lane = threadIdx.x & 63, wave = __builtin_amdgcn_readfirstlane(threadIdx.x >> 6), fr = lane & 15, fq = lane >> 4;
    const bf16_t* Pb = (const bf16_t*)(P.ws + OFF_P);
    float* ST = (float*)(P.ws + OFF_S5ST);
    for (int it = blockIdx.x * 4 + wave; it < 16 * 17 * 4; it += gridDim.x * 4) {
        const int g = it / 68, mt = (it % 68) >> 2, nt = it & 3;
        const bf16_t* MS = (const bf16_t*)(P.ws + OFF_S5MS) + (size_t)(l * 16 + g) * 256 * 256;
        f32x4 acc[4][4];
#pragma unroll
        for (int i = 0; i < 4; ++i)
#pragma unroll
            for (int j = 0; j < 4; ++j) acc[i][j] = (f32x4){0.f, 0.f, 0.f, 0.f};
        const bf16_t* ap[4];
#pragma unroll
        for (int i = 0; i < 4; ++i) { const int m = mt * 64 + 16 * i + fr, b = m / 272, c = m % 272; ap[i] = Pb + (size_t)(b * LTOT + c * 16) * PIN + g * 16; }
        const bf16_t* bp = MS + (size_t)(nt * 64 + fr) * 256 + 8 * fq;
        for (int k0 = 0; k0 < 256; k0 += 32) {
            const int k = k0 + 8 * fq;
            bf16x8 a[4], bb[4];
#pragma unroll
            for (int i = 0; i < 4; ++i) a[i] = *(const bf16x8*)(ap[i] + (size_t)(k >> 4) * PIN + (k & 15));
#pragma unroll
            for (int j = 0; j < 4; ++j) bb[j] = *(const bf16x8*)(bp + (size_t)(16 * j) * 256 + k0);
#pragma unroll
            for (int i = 0; i < 4; ++i)
#pragma unroll
                for (int j = 0; j < 4; ++j) acc[i][j] = __builtin_amdgcn_mfma_f32_16x16x32_bf16(a[i], bb[j], acc[i][j], 0, 0, 0);
        }
#pragma unroll
        for (int i = 0; i < 4; ++i)
#pragma unroll
            for (int r = 0; r < 4; ++r) {
                const int m = mt * 64 + 16 * i + 4 * fq + r, b = m / 272, c = m % 272;
                float* dst = ST + ((size_t)(b * 16 + g) * 272 + c) * 256 + nt * 64 + fr;
#pragma unroll
                for (int j = 0; j < 4; ++j) dst[16 * j] = acc[i][j][r];
            }
    }
}
__device__ __forceinline__ void s5_carry(const Params& P, int l, int bid, int nb) {
    float* ST = (float*)(P.ws + OFF_S5ST);
    for (int u = bid; u < 32; u += nb) {
        const int gid = u * 256 + threadIdx.x, p = gid & 63, dir = (gid >> 6) & 1, g = (gid >> 7) & 15, b = gid >> 11;
        const float* LB = (const float*)(P.ws + OFF_S5LB) + (size_t)(l * 16 + g) * 256 + dir * 128;
        const float lr = LB[p], li = LB[64 + p];
        float* base = ST + (size_t)(b * 16 + g) * 272 * 256 + dir * 128 + p;
        float sr = 0.f, si = 0.f;
        for (int c0 = 0; c0 < 272; c0 += 16) {
            float tr[16], ti[16];
#pragma unroll
            for (int i = 0; i < 16; ++i) { const int cc = c0 + i, c = dir == 0 ? cc : (cc < 16 ? 15 - cc : 287 - cc); tr[i] = base[(size_t)c * 256]; ti[i] = base[(size_t)c * 256 + 64]; }
#pragma unroll
            for (int i = 0; i < 16; ++i) {
                const int cc = c0 + i, c = dir == 0 ? cc : (cc < 16 ? 15 - cc : 287 - cc);
                base[(size_t)c * 256] = sr; base[(size_t)c * 256 + 64] = si;
                const float nr = lr * sr - li * si + tr[i], ni = lr * si + li * sr + ti[i];
                sr = nr; si = ni;
            }
        }
    }
}
__device__ __forceinline__ void s5_passC(const Params& P, int l) {
    const int lane = threadIdx.x & 63, wave = __builtin_amdgcn_readfirstlane(threadIdx.x >> 6), fr = lane & 15, fq = lane >> 4;
    const bf16_t* Pb = (const bf16_t*)(P.ws + OFF_P);
    const float* ST = (const float*)(P.ws + OFF_S5ST);
    bf16_t* YA = (bf16_t*)(P.ws + OFF_YP);
    for (int it = blockIdx.x * 4 + wave; it < 16 * 17 * 4; it += gridDim.x * 4) {
        const int g = it / 68, mt = (it % 68) >> 2, nt = it & 3;
        const bf16_t* MY = (const bf16_t*)(P.ws + OFF_S5MY) + (size_t)(l * 16 + g) * 256 * 512;
        f32x4 acc[4][4];
#pragma unroll
        for (int i = 0; i < 4; ++i)
#pragma unroll
            for (int j = 0; j < 4; ++j) acc[i][j] = (f32x4){0.f, 0.f, 0.f, 0.f};
        const bf16_t* ap[4]; const float* sp[4];
#pragma unroll
        for (int i = 0; i < 4; ++i) {
            const int m = mt * 64 + 16 * i + fr, b = m / 272, c = m % 272;
            ap[i] = Pb + (size_t)(b * LTOT + c * 16) * PIN + g * 16;
            sp[i] = ST + ((size_t)(b * 16 + g) * 272 + c) * 256;
        }
        const bf16_t* bp = MY + (size_t)(nt * 64 + fr) * 512 + 8 * fq;
        for (int k0 = 0; k0 < 512; k0 += 32) {
            const int k = k0 + 8 * fq;
            bf16x8 a[4], bb[4];
            if (k0 < 256) {
#pragma unroll
                for (int i = 0; i < 4; ++i) a[i] = *(const bf16x8*)(ap[i] + (size_t)(k >> 4) * PIN + (k & 15));
            } else {
#pragma unroll
                for (int i = 0; i < 4; ++i) {
                    const float4 s0 = *(const float4*)(sp[i] + (k - 256)), s1 = *(const float4*)(sp[i] + (k - 256) + 4);
                    bf16x8 t;
                    t[0] = (short)f2bf(s0.x); t[1] = (short)f2bf(s0.y); t[2] = (short)f2bf(s0.z); t[3] = (short)f2bf(s0.w);
                    t[4] = (short)f2bf(s1.x); t[5] = (short)f2bf(s1.y); t[6] = (short)f2bf(s1.z); t[7] = (short)f2bf(s1.w);
                    a[i] = t;
                }
            }
#pragma unroll
            for (int j = 0; j < 4; ++j) bb[j] = *(const bf16x8*)(bp + (size_t)(16 * j) * 512 + k0);
#pragma unroll
            for (int i = 0; i < 4; ++i)
#pragma unroll
                for (int j = 0; j < 4; ++j) acc[i][j] = __builtin_amdgcn_mfma_f32_16x16x32_bf16(a[i], bb[j], acc[i][j], 0, 0, 0);
        }
        const float dsk = P.in[19][l * 256 + g * 16 + fr];
#pragma unroll
        for (int i = 0; i < 4; ++i)
#pragma unroll
            for (int r = 0; r < 4; ++r) {
                const int m = mt * 64 + 16 * i + 4 * fq + r, b = m / 272, c = m % 272;
#pragma unroll
                for (int j = 0; j < 4; ++j) {
                    const int t = nt * 4 + j;
                    const size_t row = (size_t)(b * LTOT + c * 16 + t);
                    const float u = bf2f(Pb[row * PIN + g * 16 + fr]);
                    YA[row * DM + g * 16 + fr] = f2bf(gelu_tanh(acc[i][j][r] + dsk * u));
                }
            }
    }
}


__device__ __forceinline__ void rwkv_prep_step(const bf16_t* RW, int b, int hd, int dir, int tau_base, unsigned char* buf, float ka, int wave, int lane) {
    bf16_t* KR = (bf16_t*)buf; bf16_t* BK = (bf16_t*)(buf + 4608); bf16_t* BbT = (bf16_t*)(buf + 9216); bf16_t* KbT = (bf16_t*)(buf + 11264); float* gT = (float*)(buf + 13312);
    const int ch = hd * 64 + lane;
    float cs[16];
    {
        float c = 0.f;
#pragma unroll
        for (int t = 0; t < 16; ++t) { const int row = row_of(b, dir, tau_base + t); c += bf2f(RW[(size_t)row * RWW + 3072 + dir * 512 + ch]); cs[t] = c; }
    }
    const float c15 = cs[15];
    if (wave == 0) gT[lane] = __expf(c15);
    bf16_t bb[4], kb[4];
#pragma unroll
    for (int t = 0; t < 16; ++t) {
        if ((t >> 2) == wave) {
            const int row = row_of(b, dir, tau_base + t);
            const bf16_t* rw = RW + (size_t)row * RWW + ch;
            const float r = bf2f(rw[0]), k = bf2f(rw[512]), kap = bf2f(rw[1536]), a = bf2f(rw[2048 + dir * 512]);
            const float cp = t > 0 ? cs[t > 0 ? t - 1 : 0] : 0.f, ct = cs[t];
            const float ep = __expf(cp), et = __expf(ct), em = __expf(-ct), eT = __expf(c15 - ct);
            const float beta = kap * a, kt = k * (1.f + (a - 1.f) * ka);
            KR[t * 72 + lane] = f2bf(kap * ep); KR[(16 + t) * 72 + lane] = f2bf(r * et);
            BK[t * 72 + lane] = f2bf(beta * em); BK[(16 + t) * 72 + lane] = f2bf(kt * em);
            bb[t & 3] = f2bf(beta * eT); kb[t & 3] = f2bf(kt * eT);
        }
    }
    uint2 pb, pk;
    pb.x = bb[0] | ((unsigned)bb[1] << 16); pb.y = bb[2] | ((unsigned)bb[3] << 16);
    pk.x = kb[0] | ((unsigned)kb[1] << 16); pk.y = kb[2] | ((unsigned)kb[3] << 16);
    *(uint2*)(BbT + lane * 16 + 4 * wave) = pb;
    *(uint2*)(KbT + lane * 16 + 4 * wave) = pk;
}
template <int NV>
__device__ __forceinline__ void rwkv_prep_vt(const bf16_t* RW, int b, int hd, int dir, int tau_base, int vbase, bf16_t* VT, int lane) {
    if (NV == 2) {
        const int vl = lane & 31, th = lane >> 5;
        bf16_t x[8];
#pragma unroll
        for (int i = 0; i < 8; ++i) { const int row = row_of(b, dir, tau_base + th * 8 + i); x[i] = RW[(size_t)row * RWW + 1024 + hd * 64 + vbase + vl]; }
        uint4 pk; pk.x = x[0] | ((unsigned)x[1] << 16); pk.y = x[2] | ((unsigned)x[3] << 16); pk.z = x[4] | ((unsigned)x[5] << 16); pk.w = x[6] | ((unsigned)x[7] << 16);
        *(uint4*)(VT + vl * 16 + th * 8) = pk;
    } else {
        const int vl = lane & 15, tq = lane >> 4;
        bf16_t x[4];
#pragma unroll
        for (int i = 0; i < 4; ++i) { const int row = row_of(b, dir, tau_base + tq * 4 + i); x[i] = RW[(size_t)row * RWW + 1024 + hd * 64 + vbase + vl]; }
        uint2 pk; pk.x = x[0] | ((unsigned)x[1] << 16); pk.y = x[2] | ((unsigned)x[3] << 16);
        *(uint2*)(VT + vl * 16 + tq * 4) = pk;
    }
}
template <int NV, bool HASV, bool OUT>
__device__ __forceinline__ void rwkv_mfma_step(f32x4 (&X)[4][NV], const unsigned char* buf, const bf16_t* VT, f32x4 (&Yout)[NV], int lane) {
    const bf16_t* KR = (const bf16_t*)buf; const bf16_t* BK = (const bf16_t*)(buf + 4608); const bf16_t* BbT = (const bf16_t*)(buf + 9216); const bf16_t* KbT = (const bf16_t*)(buf + 11264); const float* gT = (const float*)(buf + 13312);
    const int fr = lane & 15, fq = lane >> 4;
    const f32x4 z4 = {0.f, 0.f, 0.f, 0.f};
    f32x4 cA = z4, cN = z4, cAk = z4, cRb = z4, cRk = z4;
#pragma unroll
    for (int ks = 0; ks < 2; ++ks) {
        const bf16x8 kh = *(const bf16x8*)(KR + fr * 72 + 32 * ks + 8 * fq), rh = *(const bf16x8*)(KR + (16 + fr) * 72 + 32 * ks + 8 * fq);
        const bf16x8 bc = *(const bf16x8*)(BK + fr * 72 + 32 * ks + 8 * fq), kc = *(const bf16x8*)(BK + (16 + fr) * 72 + 32 * ks + 8 * fq);
        cA = mfma32(kh, bc, cA); cN = mfma32(bc, kh, cN); cAk = mfma32(kc, kh, cAk);
        if (OUT) { cRb = mfma32(bc, rh, cRb); cRk = mfma32(kc, rh, cRk); }
    }
    f32x4 dg;
#pragma unroll
    for (int r = 0; r < 4; ++r) {
        const int row = 4 * fq + r;
        dg[r] = (row == fr) ? 1.f : 0.f;
        cA[r] = (fr < row) ? cA[r] : 0.f;
        cN[r] = (row < fr) ? cN[r] : 0.f;
        cAk[r] = (row < fr) ? cAk[r] : 0.f;
        cRb[r] = (row <= fr) ? cRb[r] : 0.f;
        cRk[r] = (row <= fr) ? cRk[r] : 0.f;
    }
    const bf16x4 a4 = to4(cA), n4 = to4(cN);
    const f32x4 cA2 = mfma16(n4, a4, z4), cN2 = mfma16(a4, n4, z4);
    const bf16x4 a24 = to4(cA2), n24 = to4(cN2);
    const f32x4 cA4 = mfma16(n24, a24, z4), cN4 = mfma16(a24, n24, z4);
    const f32x4 cA8 = mfma16(to4(cN4), to4(cA4), z4);
    const f32x4 T1 = mfma16(to4(dg - cA), to4(dg + cN2), z4);
    const f32x4 T2 = mfma16(to4(dg + cA4), to4(T1), z4);
    const f32x4 WT = mfma16(to4(dg + cA8), to4(T2), z4);
    const bf16x4 wt4 = to4(WT), aak4 = to4(cAk), rab4 = to4(cRb), rak4 = to4(cRk);
    bf16x8 aK[2], aR[2];
#pragma unroll
    for (int ks = 0; ks < 2; ++ks) {
        aK[ks] = cat8(*(const bf16x4*)(KR + fr * 72 + 32 * ks + 4 * fq), *(const bf16x4*)(KR + fr * 72 + 32 * ks + 16 + 4 * fq));
        if (OUT) aR[ks] = cat8(*(const bf16x4*)(KR + (16 + fr) * 72 + 32 * ks + 4 * fq), *(const bf16x4*)(KR + (16 + fr) * 72 + 32 * ks + 16 + 4 * fq));
    }
    bf16x4 u4[NV], vt4[NV];
#pragma unroll
    for (int nj = 0; nj < NV; ++nj) {
        const bf16x8 b0 = cat8(to4(X[0][nj]), to4(X[1][nj])), b1 = cat8(to4(X[2][nj]), to4(X[3][nj]));
        f32x4 G = mfma32(aK[1], b1, mfma32(aK[0], b0, z4));
        if (HASV) { vt4[nj] = *(const bf16x4*)(VT + (16 * nj + fr) * 16 + 4 * fq); G = mfma16(aak4, vt4[nj], G); }
        const f32x4 U = mfma16(wt4, to4(G), z4);
        u4[nj] = to4(-U);
        if (OUT) {
            f32x4 Yv = mfma32(aR[1], b1, mfma32(aR[0], b0, z4));
            Yv = mfma16(rab4, u4[nj], Yv);
            if (HASV) Yv = mfma16(rak4, vt4[nj], Yv);
            Yout[nj] = Yv;
        }
    }
#pragma unroll
    for (int mi = 0; mi < 4; ++mi) {
        const f32x4 g4 = *(const f32x4*)(gT + 16 * mi + 4 * fq);
        const bf16x4 bb4 = *(const bf16x4*)(BbT + (16 * mi + fr) * 16 + 4 * fq), kb4 = *(const bf16x4*)(KbT + (16 * mi + fr) * 16 + 4 * fq);
#pragma unroll
        for (int nj = 0; nj < NV; ++nj) {
            f32x4 x = X[mi][nj] * g4;
            x = mfma16(bb4, u4[nj], x);
            if (HASV) x = mfma16(kb4, vt4[nj], x);
            X[mi][nj] = x;
        }
    }
}
__device__ __forceinline__ void rwkv_passA(const Params& P, int l, unsigned char* smem, int bid, int nb) {
    const int lane = threadIdx.x & 63, wave = __builtin_amdgcn_readfirstlane(threadIdx.x >> 6), fr = lane & 15, fq = lane >> 4;
    const bf16_t* RW = (const bf16_t*)(P.ws + OFF_RW);
    float* RXL = (float*)(P.ws + OFF_RXL);
    bf16_t* RXP = (bf16_t*)P.out;
    for (int item = bid; item < 64 * RW_NCH; item += nb) {
        const int seq = item / RW_NCH, c = item % RW_NCH, dir = seq & 1, hd = (seq >> 1) & 7, b = seq >> 4;
        const float ka = P.in[31][l * 512 + hd * 64 + lane];
        const int tau0 = c * 128;
        f32x4 X[4][2], Yd[2];
#pragma unroll
        for (int mi = 0; mi < 4; ++mi)
#pragma unroll
            for (int nj = 0; nj < 2; ++nj)
#pragma unroll
                for (int r = 0; r < 4; ++r) X[mi][nj][r] = (wave >= 2 && (16 * mi + 4 * fq + r) == (16 * (2 * (wave - 2) + nj) + fr)) ? 1.f : 0.f;
        bf16_t* VTw = (bf16_t*)(smem + RW_VT0 + wave * 2048);
        rwkv_prep_step(RW, b, hd, dir, tau0, smem, ka, wave, lane);
        if (wave < 2) rwkv_prep_vt<2>(RW, b, hd, dir, tau0, 32 * wave, VTw, lane);
        __syncthreads();
        for (int s = 0; s < 8; ++s) {
            if (s < 7) {
                rwkv_prep_step(RW, b, hd, dir, tau0 + (s + 1) * 16, smem + ((s + 1) & 1) * RW_BUF, ka, wave, lane);
                if (wave < 2) rwkv_prep_vt<2>(RW, b, hd, dir, tau0 + (s + 1) * 16, 32 * wave, VTw + ((s + 1) & 1) * 512, lane);
            }
            if (wave < 2) rwkv_mfma_step<2, true, false>(X, smem + (s & 1) * RW_BUF, VTw + (s & 1) * 512, Yd, lane);
            else rwkv_mfma_step<2, false, false>(X, smem + (s & 1) * RW_BUF, VTw, Yd, lane);
            __syncthreads();
        }
        if (wave < 2) {
#pragma unroll
            for (int mi = 0; mi < 4; ++mi)
#pragma unroll
                for (int nj = 0; nj < 2; ++nj) *(f32x4*)(RXL + (((size_t)item * 16 + mi * 4 + 2 * wave + nj) * 64 + lane) * 4) = X[mi][nj];
        } else {
#pragma unroll
            for (int mi = 0; mi < 4; ++mi)
#pragma unroll
                for (int nj = 0; nj < 2; ++nj)
#pragma unroll
                    for (int r = 0; r < 4; ++r) RXP[(size_t)item * 4096 + (16 * mi + 4 * fq + r) * 64 + 16 * (2 * (wave - 2) + nj) + fr] = f2bf(X[mi][nj][r]);
        }
    }
}
__device__ __forceinline__ void rwkv_passB(const Params& P) {
    const int lane = threadIdx.x & 63, wave = __builtin_amdgcn_readfirstlane(threadIdx.x >> 6), fr = lane & 15, fq = lane >> 4;
    float* RXL = (float*)(P.ws + OFF_RXL);
    const bf16_t* RXP = (const bf16_t*)P.out;
    for (int it = blockIdx.x * 4 + wave; it < 256; it += gridDim.x * 4) {
        const int seq = it >> 2, nj = it & 3;
        f32x4 X[4];
#pragma unroll
        for (int mi = 0; mi < 4; ++mi) X[mi] = (f32x4){0.f, 0.f, 0.f, 0.f};
        for (int c = 0; c < RW_NCH; ++c) {
            const size_t item = (size_t)seq * RW_NCH + c;
            f32x4 L[4]; bf16x8 a[4][2];
#pragma unroll
            for (int mi = 0; mi < 4; ++mi) {
                L[mi] = *(const f32x4*)(RXL + ((item * 16 + mi * 4 + nj) * 64 + lane) * 4);
                const bf16_t* xp = RXP + item * 4096 + (16 * mi + fr) * 64;
#pragma unroll
                for (int ks = 0; ks < 2; ++ks) a[mi][ks] = cat8(*(const bf16x4*)(xp + 32 * ks + 4 * fq), *(const bf16x4*)(xp + 32 * ks + 16 + 4 * fq));
            }
            const bf16x8 b0 = cat8(to4(X[0]), to4(X[1])), b1 = cat8(to4(X[2]), to4(X[3]));
#pragma unroll
            for (int mi = 0; mi < 4; ++mi) {
                *(f32x4*)(RXL + ((item * 16 + mi * 4 + nj) * 64 + lane) * 4) = X[mi];
                X[mi] = mfma32(a[mi][1], b1, mfma32(a[mi][0], b0, L[mi]));
            }
        }
    }
}
template <bool CHECK>
__device__ __forceinline__ void rwkv_passC(const Params& P, int l, unsigned char* smem) {
    const int lane = threadIdx.x & 63, wave = __builtin_amdgcn_readfirstlane(threadIdx.x >> 6), fr = lane & 15, fq = lane >> 4;
    const bf16_t* RW = (const bf16_t*)(P.ws + OFF_RW);
    const float* RXL = (const float*)(P.ws + OFF_RXL);
    for (int item = blockIdx.x; item < 64 * RW_NCH; item += gridDim.x) {
        const int seq = item / RW_NCH, c = item % RW_NCH, dir = seq & 1, hd = (seq >> 1) & 7, b = seq >> 4;
        if (l == 1 && dir == 0 && c < 2) continue;
        if (l == 1 && dir == 1 && c < 2) continue;
        bf16_t* YP = (bf16_t*)(P.ws + OFF_YP) + (size_t)dir * MROWS * DM;
        const float ka = P.in[31][l * 512 + hd * 64 + lane];
        const int tau0 = c * 128;
        f32x4 X[4][1], Yo[1];
#pragma unroll
        for (int mi = 0; mi < 4; ++mi) X[mi][0] = *(const f32x4*)(RXL + (((size_t)item * 16 + mi * 4 + wave) * 64 + lane) * 4);
        bf16_t* VTw = (bf16_t*)(smem + RW_VT0 + wave * 2048);
        rwkv_prep_step(RW, b, hd, dir, tau0, smem, ka, wave, lane);
        rwkv_prep_vt<1>(RW, b, hd, dir, tau0, 16 * wave, VTw, lane);
        __syncthreads();
        for (int s = 0; s < 8; ++s) {
            if (s < 7) {
                rwkv_prep_step(RW, b, hd, dir, tau0 + (s + 1) * 16, smem + ((s + 1) & 1) * RW_BUF, ka, wave, lane);
                rwkv_prep_vt<1>(RW, b, hd, dir, tau0 + (s + 1) * 16, 16 * wave, VTw + ((s + 1) & 1) * 512, lane);
            }
            rwkv_mfma_step<1, true, true>(X, smem + (s & 1) * RW_BUF, VTw + (s & 1) * 512, Yo, lane);
#pragma unroll
            for (int r = 0; r < 4; ++r) {
                const int row = row_of(b, dir, tau0 + s * 16 + 4 * fq + r);
                if (CHECK) { if (YP[(size_t)row * DM + 512 + hd * 64 + 16 * wave + fr] != f2bf(Yo[0][r])) atomicAdd((unsigned*)(P.ws + OFF_BAR + 15360), 1u); }
                else YP[(size_t)row * DM + 512 + hd * 64 + 16 * wave + fr] = f2bf(Yo[0][r]);
            }
            __syncthreads();
        }
    }
}


#define HG_NCH 34
#define HG_BUF 7168
#define HG_VT0 14336
#define OFF_O_RXP 0ull
#define OFF_O_HXL ((size_t)2176 * 8192)
#define OFF_O_HD (OFF_O_HXL + (size_t)1088 * 16384)
__device__ __forceinline__ float hgrn_prep_step(const bf16_t* Pb, int b, int hd, int dir, int tau_base, unsigned char* buf, float lb, int wave, int lane) {
    bf16_t* QH = (bf16_t*)buf; bf16_t* KC = (bf16_t*)(buf + 2304); bf16_t* KbT = (bf16_t*)(buf + 4608); float* gT = (float*)(buf + 6656);
    float cs[16], fv[16];
    {
        float c = 0.f;
#pragma unroll
        for (int t = 0; t < 16; ++t) {
            const int row = row_of(b, dir, tau_base + t);
            const float f = lb + (1.f - lb) * sigmoidf_(bf2f(Pb[(size_t)row * PIN + 768 + dir * 256 + hd * 64 + lane]));
            fv[t] = f; c += __logf(f); cs[t] = c;
        }
    }
    const float c15 = cs[15];
    if (wave == 0) gT[lane] = __expf(c15);
    bf16_t kb[4];
#pragma unroll
    for (int t = 0; t < 16; ++t) {
        if ((t >> 2) == wave) {
            const int row = row_of(b, dir, tau_base + t);
            const float q = siluf_(bf2f(Pb[(size_t)row * PIN + 256 + hd * 64 + lane]));
            const float ct = cs[t], k = 1.f - fv[t];
            QH[t * 72 + lane] = f2bf(q * __expf(ct));
            KC[t * 72 + lane] = f2bf(k * __expf(fminf(-ct, 80.f)));
            kb[t & 3] = f2bf(k * __expf(c15 - ct));
        }
    }
    uint2 pk; pk.x = kb[0] | ((unsigned)kb[1] << 16); pk.y = kb[2] | ((unsigned)kb[3] << 16);
    *(uint2*)(KbT + lane * 16 + 4 * wave) = pk;
    return c15;
}
__device__ __forceinline__ void hgrn_prep_vt(const bf16_t* Pb, int b, int hd, int dir, int tau_base, int vbase, bf16_t* VT, int lane) {
    const int vl = lane & 15, tq = lane >> 4;
    bf16_t x[4];
#pragma unroll
    for (int i = 0; i < 4; ++i) { const int row = row_of(b, dir, tau_base + tq * 4 + i); x[i] = Pb[(size_t)row * PIN + 512 + hd * 64 + vbase + vl]; }
    uint2 pk; pk.x = x[0] | ((unsigned)x[1] << 16); pk.y = x[2] | ((unsigned)x[3] << 16);
    *(uint2*)(VT + vl * 16 + tq * 4) = pk;
}
template <bool OUT>
__device__ __forceinline__ void hgrn_mfma_step(f32x4 (&X)[4], const unsigned char* buf, const bf16_t* VT, f32x4& Yout, int lane) {
    const bf16_t* QH = (const bf16_t*)buf; const bf16_t* KC = (const bf16_t*)(buf + 2304); const bf16_t* KbT = (const bf16_t*)(buf + 4608); const float* gT = (const float*)(buf + 6656);
    const int fr = lane & 15, fq = lane >> 4;
    const f32x4 z4 = {0.f, 0.f, 0.f, 0.f};
    const bf16x4 vt4 = *(const bf16x4*)(VT + fr * 16 + 4 * fq);
    if (OUT) {
        f32x4 cAT = z4;
#pragma unroll
        for (int ks = 0; ks < 2; ++ks) {
            const bf16x8 kc = *(const bf16x8*)(KC + fr * 72 + 32 * ks + 8 * fq), qh = *(const bf16x8*)(QH + fr * 72 + 32 * ks + 8 * fq);
            cAT = mfma32(kc, qh, cAT);
        }
#pragma unroll
        for (int r = 0; r < 4; ++r) cAT[r] = ((4 * fq + r) <= fr) ? cAT[r] : 0.f;
        const bf16x8 aQ0 = cat8(*(const bf16x4*)(QH + fr * 72 + 4 * fq), *(const bf16x4*)(QH + fr * 72 + 16 + 4 * fq));
        const bf16x8 aQ1 = cat8(*(const bf16x4*)(QH + fr * 72 + 32 + 4 * fq), *(const bf16x4*)(QH + fr * 72 + 48 + 4 * fq));
        const bf16x8 b0 = cat8(to4(X[0]), to4(X[1])), b1 = cat8(to4(X[2]), to4(X[3]));
        f32x4 O = mfma32(aQ1, b1, mfma32(aQ0, b0, z4));
        Yout = mfma16(to4(cAT), vt4, O);
    }
#pragma unroll
    for (int mi = 0; mi < 4; ++mi) {
        const f32x4 g4 = *(const f32x4*)(gT + 16 * mi + 4 * fq);
        const bf16x4 kb4 = *(const bf16x4*)(KbT + (16 * mi + fr) * 16 + 4 * fq);
        X[mi] = mfma16(kb4, vt4, X[mi] * g4);
    }
}
__device__ __forceinline__ float hgrn_lb(const Params& P, int l, int dir, int ch) {
    if (l == 0) return 0.f;
    const float a0 = P.in[22][(dir * 2 + 0) * 256 + ch], a1 = P.in[22][(dir * 2 + 1) * 256 + ch];
    const float m = fmaxf(a0, a1), e0 = __expf(a0 - m), e1 = __expf(a1 - m);
    return e1 / (e0 + e1);
}
template <bool OUT>
__device__ __forceinline__ void hgrn_pass(const Params& P, int l, unsigned char* smem) {
    const int lane = threadIdx.x & 63, wave = __builtin_amdgcn_readfirstlane(threadIdx.x >> 6), fr = lane & 15, fq = lane >> 4;
    const bf16_t* Pb = (const bf16_t*)(P.ws + OFF_P);
    float* HXL = (float*)((unsigned char*)P.out + OFF_O_HXL);
    float* HD = (float*)((unsigned char*)P.out + OFF_O_HD);
    for (int item = blockIdx.x; item < 32 * HG_NCH; item += gridDim.x) {
        const int seq = item / HG_NCH, c = item % HG_NCH, dir = seq & 1, hd = (seq >> 1) & 3, b = seq >> 3;
        if (OUT && l == 1 && c < 2) continue;
        bf16_t* YP = (bf16_t*)(P.ws + OFF_YP) + (size_t)dir * MROWS * DM;
        const float lb = hgrn_lb(P, l, dir, hd * 64 + lane);
        const int tau0 = c * 128;
        f32x4 X[4], Yo;
#pragma unroll
        for (int mi = 0; mi < 4; ++mi) X[mi] = OUT ? *(const f32x4*)(HXL + (((size_t)item * 16 + mi * 4 + wave) * 64 + lane) * 4) : (f32x4){0.f, 0.f, 0.f, 0.f};
        bf16_t* VTw = (bf16_t*)(smem + HG_VT0 + wave * 1024);
        float ctot = hgrn_prep_step(Pb, b, hd, dir, tau0, smem, lb, wave, lane);
        hgrn_prep_vt(Pb, b, hd, dir, tau0, 16 * wave, VTw, lane);
        __syncthreads();
        for (int s = 0; s < 8; ++s) {
            if (s < 7) {
                ctot += hgrn_prep_step(Pb, b, hd, dir, tau0 + (s + 1) * 16, smem + ((s + 1) & 1) * HG_BUF, lb, wave, lane);
                hgrn_prep_vt(Pb, b, hd, dir, tau0 + (s + 1) * 16, 16 * wave, VTw + ((s + 1) & 1) * 256, lane);
            }
            hgrn_mfma_step<OUT>(X, smem + (s & 1) * HG_BUF, VTw + (s & 1) * 256, Yo, lane);
            if (OUT) {
#pragma unroll
                for (int r = 0; r < 4; ++r) {
                    const int row = row_of(b, dir, tau0 + s * 16 + 4 * fq + r);
                    YP[(size_t)row * DM + 256 + hd * 64 + 16 * wave + fr] = f2bf(Yo[r]);
                }
            }
            __syncthreads();
        }
        if (!OUT) {
#pragma unroll
            for (int mi = 0; mi < 4; ++mi) *(f32x4*)(HXL + (((size_t)item * 16 + mi * 4 + wave) * 64 + lane) * 4) = X[mi];
            if (wave == 0) HD[(size_t)item * 64 + lane] = __expf(ctot);
        }
    }
}
__device__ __forceinline__ void hgrn_carry(const Params& P, int bid, int nb) {
    float* HXL = (float*)((unsigned char*)P.out + OFF_O_HXL);
    const float* HD = (const float*)((unsigned char*)P.out + OFF_O_HD);
    for (int u = bid; u < 128; u += nb) {
        const int gid = u * 256 + threadIdx.x, ln = gid & 63, tile = (gid >> 6) & 15, seq = gid >> 10;
        const int mi = tile >> 2, fq = ln >> 4;
        f32x4 x = {0.f, 0.f, 0.f, 0.f};
        for (int c0 = 0; c0 < HG_NCH; c0 += 17) {
            f32x4 L[17];
#pragma unroll
            for (int i = 0; i < 17; ++i) {
                const size_t item = (size_t)seq * HG_NCH + c0 + i;
                L[i] = *(const f32x4*)(HXL + ((item * 16 + tile) * 64 + ln) * 4);
            }
#pragma unroll
            for (int i = 0; i < 17; ++i) {
                const size_t item = (size_t)seq * HG_NCH + c0 + i;
                const f32x4 D = *(const f32x4*)(HD + item * 64 + 16 * mi + 4 * fq);
                *(f32x4*)(HXL + ((item * 16 + tile) * 64 + ln) * 4) = x;
                x = D * x + L[i];
            }
        }
    }
}


__device__ __forceinline__ void phase_rwprep2(const Params& P, int l, unsigned char* smem) {
    const int tid = threadIdx.x, lane = tid & 63, wave = __builtin_amdgcn_readfirstlane(tid >> 6), fr = lane & 15, fq = lane >> 4;
    const bf16_t* Pb = (const bf16_t*)(P.ws + OFF_P);
    bf16_t* RW = (bf16_t*)(P.ws + OFF_RW);
    const bf16_t* LW = (const bf16_t*)(P.ws + OFF_LW);
    const float* mu = P.in[24] + l * 1920;
    bf16_t* AL = (bf16_t*)smem;
    float muv[8];
#pragma unroll
    for (int jj = 0; jj < 8; ++jj) muv[jj] = (tid + 256 * jj) < 1920 ? mu[tid + 256 * jj] : 0.f;
    const float kk0 = P.in[30][l * 512 + tid], kk1 = P.in[30][l * 512 + 256 + tid];
    for (int u = blockIdx.x; u < MROWS / 16; u += gridDim.x) {
        const int r0 = u * 16;
        __syncthreads();
        for (int i = 0; i < 16; ++i) {
            const int row = r0 + i, p = row % LTOT;
            int nbr; bool okk;
            {
                const int m = tid & 3;
                if (p < CTX) { nbr = (m & 1) ? row + 1 : row - 1; okk = (m & 1) ? (p < CTX - 1) : (p > 0); }
                else {
                    const int t = p - CTX, gr = t >> 6, gc = t & 63;
                    nbr = m == 0 ? row - 1 : (m == 1 ? row + 1 : (m == 2 ? row - 64 : row + 64));
                    okk = m == 0 ? (gc > 0) : (m == 1 ? (gc < 63) : (m == 2 ? (gr > 0) : (gr < 63)));
                }
            }
            const bf16_t* pp = Pb + (size_t)row * PIN + 1536 + tid;
            const bf16_t* pn = Pb + (size_t)nbr * PIN + 1536 + tid;
            bf16_t* rw = RW + (size_t)row * RWW;
            float sv[8];
#pragma unroll
            for (int jj = 0; jj < 8; ++jj) {
                if (jj < 7 || tid < 128) {
                    const float pv = bf2f(pp[256 * jj]);
                    const float nv = okk ? bf2f(pn[256 * jj]) : 0.f;
                    sv[jj] = pv + muv[jj] * (nv - pv);
                } else sv[jj] = 0.f;
            }
            rw[tid] = f2bf(sv[0]); rw[256 + tid] = f2bf(sv[1]);
            rw[512 + tid] = f2bf(sv[2]); rw[768 + tid] = f2bf(sv[3]);
            rw[1024 + tid] = f2bf(sv[4]); rw[1280 + tid] = f2bf(sv[5]);
            {
                const float a0 = sv[2] * kk0, a1 = sv[3] * kk1;
                const float n0 = fmaxf(sqrtf(wave_sum(a0 * a0)), 1e-12f), n1 = fmaxf(sqrtf(wave_sum(a1 * a1)), 1e-12f);
                rw[1536 + tid] = f2bf(a0 / n0); rw[1792 + tid] = f2bf(a1 / n1);
            }
            if (tid < 128) { rw[4096 + tid] = f2bf(sigmoidf_(sv[6])); AL[((2 + (tid >> 6)) * 16 + i) * 72 + (tid & 63)] = f2bf(sv[7]); }
            else AL[(((tid - 128) >> 6) * 16 + i) * 72 + (tid & 63)] = f2bf(tanhf(sv[6]));
        }
        __syncthreads();
        {
            const int d = wave & 1, isA = wave >> 1;
            const bf16x8 a0 = *(const bf16x8*)(AL + (wave * 16 + fr) * 72 + 8 * fq), a1 = *(const bf16x8*)(AL + (wave * 16 + fr) * 72 + 32 + 8 * fq);
            const bf16_t* W = LW + (size_t)isA * 131072 + (size_t)(l * 2 + d) * 512 * 64;
            const float* bias = P.in[isA ? 27 : 25] + (l * 2 + d) * 512;
            for (int nj = 0; nj < 32; ++nj) {
                const bf16x8 b0 = *(const bf16x8*)(W + (size_t)(16 * nj + fr) * 64 + 8 * fq), b1 = *(const bf16x8*)(W + (size_t)(16 * nj + fr) * 64 + 32 + 8 * fq);
                const f32x4 acc = mfma32(a1, b1, mfma32(a0, b0, (f32x4){0.f, 0.f, 0.f, 0.f}));
                const int c = 16 * nj + fr;
                const float bs = bias[c];
#pragma unroll
                for (int r = 0; r < 4; ++r) {
                    const float sg = sigmoidf_(bs + acc[r]);
                    RW[(size_t)(r0 + 4 * fq + r) * RWW + (isA ? 2048 : 3072) + d * 512 + c] = f2bf(isA ? sg : -0.60653066f * sg);
                }
            }
        }
    }
}
__device__ __forceinline__ void phase_post2(const Params& P, int l) {
    const int tid = threadIdx.x, lane = tid & 63, wave = __builtin_amdgcn_readfirstlane(tid >> 6), fr = lane & 15, fq = lane >> 4;
    const bf16_t* Pb = (const bf16_t*)(P.ws + OFF_P);
    const bf16_t* RW = (const bf16_t*)(P.ws + OFF_RW);
    const bf16_t* YF = (const bf16_t*)(P.ws + OFF_YP);
    const bf16_t* YB = YF + (size_t)MROWS * DM;
    const bf16_t* LW = (const bf16_t*)(P.ws + OFF_LW);
    bf16_t* MIX = (bf16_t*)(P.ws + OFF_MIX);
    const f32x4 z4 = {0.f, 0.f, 0.f, 0.f};
    for (int u = blockIdx.x; u < MROWS / 16; u += gridDim.x) {
        const int r0 = u * 16;
        if (l == 1 && (r0 % LTOT) < CTX) continue;
        {
            f32x4 acc[4] = {z4, z4, z4, z4};
            const bf16_t* ap = YF + (size_t)(r0 + fr) * DM + 8 * fq;
            const bf16_t* bp = LW + (size_t)3 * 131072 + (size_t)(l * 256 + 64 * wave + fr) * 256 + 8 * fq;
#pragma unroll
            for (int ks = 0; ks < 8; ++ks) {
                const bf16x8 a = *(const bf16x8*)(ap + 32 * ks);
#pragma unroll
                for (int j = 0; j < 4; ++j) acc[j] = mfma32(a, *(const bf16x8*)(bp + (size_t)(16 * j) * 256 + 32 * ks), acc[j]);
            }
#pragma unroll
            for (int j = 0; j < 4; ++j) {
                const int n = 64 * wave + 16 * j + fr;
                const float gb = P.in[21][l * 256 + n];
#pragma unroll
                for (int r = 0; r < 4; ++r) {
                    const size_t row = (size_t)(r0 + 4 * fq + r);
                    MIX[row * DM + n] = f2bf(bf2f(YF[row * DM + n]) * sigmoidf_(acc[j][r] + gb));
                }
            }
        }
        {
            const int i = tid >> 4, c0 = (tid & 15) * 16; const size_t row = (size_t)(r0 + i);
            float o[16], ss = 0.f;
#pragma unroll
            for (int j = 0; j < 16; ++j) { o[j] = bf2f(YF[row * DM + 256 + c0 + j]) + bf2f(YB[row * DM + 256 + c0 + j]); ss += o[j] * o[j]; }
            ss += __shfl_xor(ss, 1, 64); ss += __shfl_xor(ss, 2, 64);
            const float rs = rsqrtf(ss * (1.f / 64.f) + 1e-6f);
#pragma unroll
            for (int j = 0; j < 16; ++j) {
                const float gr = bf2f(Pb[row * PIN + 1280 + c0 + j]);
                MIX[row * DM + 256 + c0 + j] = f2bf(o[j] * rs * P.in[23][l * 256 + c0 + j] * siluf_(gr));
            }
        }
#pragma unroll 1
        for (int hh = 0; hh < 2; ++hh) {
            const int h = 2 * wave + hh;
            f32x4 g[4] = {z4, z4, z4, z4};
            const bf16_t* ap = RW + (size_t)(r0 + fr) * RWW + 4096 + 8 * fq;
            const bf16_t* bp = LW + (size_t)2 * 131072 + (size_t)(l * 512 + h * 64 + fr) * 128 + 8 * fq;
#pragma unroll
            for (int ks = 0; ks < 4; ++ks) {
                const bf16x8 a = *(const bf16x8*)(ap + 32 * ks);
#pragma unroll
                for (int j = 0; j < 4; ++j) g[j] = mfma32(a, *(const bf16x8*)(bp + (size_t)(16 * j) * 128 + 32 * ks), g[j]);
            }
#pragma unroll
            for (int r = 0; r < 4; ++r) {
                const size_t row = (size_t)(r0 + 4 * fq + r);
                const bf16_t* rw = RW + row * RWW;
                float y[4], vv[4], sum = 0.f, bon = 0.f;
#pragma unroll
                for (int j = 0; j < 4; ++j) {
                    const int c = h * 64 + 16 * j + fr;
                    y[j] = bf2f(YF[row * DM + 512 + c]) + bf2f(YB[row * DM + 512 + c]);
                    sum += y[j];
                    const float rr = bf2f(rw[c]), k = bf2f(rw[512 + c]), af = bf2f(rw[2048 + c]), ab = bf2f(rw[2560 + c]);
                    const float ka = P.in[31][l * 512 + c];
                    vv[j] = bf2f(rw[1024 + c]);
                    bon += rr * P.in[32][l * 512 + c] * k * (2.f + (af + ab - 2.f) * ka);
                }
#pragma unroll
                for (int o = 1; o < 16; o <<= 1) { sum += __shfl_xor(sum, o, 64); bon += __shfl_xor(bon, o, 64); }
                const float mean = sum * (1.f / 64.f);
                float var = 0.f;
#pragma unroll
                for (int j = 0; j < 4; ++j) { const float d = y[j] - mean; var += d * d; }
#pragma unroll
                for (int o = 1; o < 16; o <<= 1) var += __shfl_xor(var, o, 64);
                const float rs = rsqrtf(var * (1.f / 64.f) + 64e-5f);
#pragma unroll
                for (int j = 0; j < 4; ++j) {
                    const int c = h * 64 + 16 * j + fr;
                    const float yn = (y[j] - mean) * rs * P.in[33][l * 512 + c] + P.in[34][l * 512 + c];
                    MIX[row * DM + 512 + c] = f2bf((yn + bon * vv[j]) * g[j][r]);
                }
            }
        }
    }
}

__device__ __forceinline__ void run_phase(const Params& P, int ph, unsigned char* smem) {
    if (ph == 0) { phase_prep(P, smem); return; }
    if (ph == 1) { phase_mkh(P); return; }
    const int l = (ph - 2) / PPL, s = (ph - 2) % PPL;
    switch (s) {
    case 0: gemm_bf16((const bf16_t*)(P.ws + OFF_H), DM, (const bf16_t*)(P.ws + OFF_WIN) + (size_t)l * PIN * DM, DM, MROWS, PIN, DM, false, EpiBf16{(bf16_t*)(P.ws + OFF_P), PIN}); break;
    case 1: phase_rwprep2(P, l, smem); s5_passA(P, l); hgrn_pass<false>(P, l, smem); break;
    case 2: rwkv_passA(P, l, smem, blockIdx.x, gridDim.x); s5_carry(P, l, gridDim.x - 1 - blockIdx.x, gridDim.x); hgrn_carry(P, (int)((2 * gridDim.x - 33 - blockIdx.x) % gridDim.x), gridDim.x); break;
    case 3: rwkv_passB(P); s5_passC(P, l); hgrn_pass<true>(P, l, smem); break;
    case 4: rwkv_passC<false>(P, l, smem); break;
    case 5: phase_post2(P, l); break;
    case 6: gemm_bf16((const bf16_t*)(P.ws + OFF_MIX), DM, (const bf16_t*)(P.ws + OFF_WOUT) + (size_t)l * DM * DM, DM, MROWS, DM, DM, l == 1, EpiF32{(float*)(P.ws + OFF_TMP), DM}); break;
    case 7: phase_ln1(P, l); break;
    case 8: gemm_bf16((const bf16_t*)(P.ws + OFF_H2), DM, (const bf16_t*)(P.ws + OFF_WQ) + (size_t)l * 2048 * DM, DM, MROWS, 2048, DM, l == 1, EpiBf16{(bf16_t*)(P.ws + OFF_Q), 2048}); break;
    case 9: phase_topk2(P, l, smem); phase_tabconv(P, l); break;
    case 10: phase_gather(P, l, smem); break;
    }
}

__global__ void __launch_bounds__(256) mega(Params P) {
    __shared__ __attribute__((aligned(16))) unsigned char smem[65536];
#if SINGLE
    cg::grid_group grid = cg::this_grid();
    if (threadIdx.x < 4) ((volatile LAS unsigned*)(smem + 65520))[threadIdx.x] = 0u;
    __syncthreads();
    XcdBarrier xb = xcd_barrier_post((unsigned*)(P.ws + OFF_BAR), (volatile LAS unsigned*)(smem + 65520));
#endif
    for (int ph = P.ph_lo; ph < P.ph_hi; ++ph) {
        run_phase(P, ph, smem);
#if SINGLE
        if (ph + 1 < P.ph_hi) {
            if (ph == 0) { asm volatile("s_waitcnt vmcnt(0)" ::: "memory"); __syncthreads(); grid.sync(); }
            else xcd_barrier(xb);
        }
#ifdef DUPMASK
        if (ph >= 2 && ((DUPMASK >> ((ph - 2) % PPL)) & 1)) { run_phase(P, ph, smem); xcd_barrier(xb); }
#endif
#ifdef EXP_T3
        if (ph >= 2 && (ph - 2) % PPL == 4) { rwkv_passC<true>(P, (ph - 2) / PPL, smem); xcd_barrier(xb); }
#endif
#ifdef EXP_OLDSCAN
        if (ph >= 2 && (ph - 2) % PPL == 4) { const int wv = threadIdx.x >> 6; for (int it = wv * gridDim.x + blockIdx.x; it < 64; it += 4 * gridDim.x) scan_rwkv(P, (ph - 2) / PPL, it); xcd_barrier(xb); }
#endif
#endif
    }
}

extern "C" void kernel_launch(void* const* d_in, const int* in_sizes, int n_in, void* d_out, int out_size, void* d_ws, size_t ws_size, hipStream_t stream) {
    static int grid = 0;
    if (grid == 0) {
        if (n_in != 39 || ws_size < OFF_END) { fprintf(stderr, "kernel_launch: unexpected n_in %d or ws_size %zu (need %zu)\n", n_in, ws_size, (size_t)OFF_END); grid = -1; return; }
        int dev = 0, cus = 0, per_cu = 0;
        hipGetDevice(&dev);
        hipDeviceGetAttribute(&cus, hipDeviceAttributeMultiprocessorCount, dev);
        hipOccupancyMaxActiveBlocksPerMultiprocessor(&per_cu, mega, 256, 0);
        if (per_cu < 1) per_cu = 1;
        if (per_cu > 2) per_cu = 2;
        grid = cus * per_cu;
    }
    if (grid < 0) return;
    hipMemsetAsync((unsigned char*)d_ws + OFF_BAR, 0, 16384, stream);
    Params p{};
    for (int i = 0; i < 39; ++i) p.in[i] = (const float*)d_in[i];
    p.out = (float*)d_out; p.ws = (unsigned char*)d_ws;
#if SINGLE
    p.ph_lo = 0; p.ph_hi = NPH;
    void* args[] = {&p};
    hipError_t e = hipLaunchCooperativeKernel((void*)mega, dim3(grid), dim3(256), args, 0, stream);
    if (e != hipSuccess) fprintf(stderr, "cooperative launch failed: %s (grid %d)\n", hipGetErrorString(e), grid);
#else
    for (int ph = 0; ph < NPH; ++ph) {
        p.ph_lo = ph; p.ph_hi = ph + 1;
        hipLaunchKernelGGL(mega, dim3(grid), dim3(256), 0, stream, p);
    }
#endif
}
```

```cpp
#include <hip/hip_runtime.h>
#include <hip/hip_cooperative_groups.h>
#include <cstdio>
namespace cg = cooperative_groups;

#ifndef SINGLE
#define SINGLE 1
#endif

typedef unsigned short bf16_t;
typedef short bf16x8 __attribute__((ext_vector_type(8)));
typedef float f32x4 __attribute__((ext_vector_type(4)));
typedef __bf16 bf16x2 __attribute__((ext_vector_type(2)));

#define DM 1024
#define NB 4
#define SEQ 4096
#define CTX 256
#define LTOT 4352
#define MROWS 17408
#define PIN 3456
#define RWW 4224
#define NPH 24
#define PPL 11
#define ALPHA 1.41421356237f

#define OFF_XS 0ull
#define OFF_P (OFF_XS + (size_t)MROWS * DM * 4)
#define OFF_RW (OFF_P + (size_t)MROWS * PIN * 2)
#define OFF_YP (OFF_RW + (size_t)MROWS * RWW * 2)
#define OFF_MIX (OFF_YP + (size_t)2 * MROWS * DM * 2)
#define OFF_MOD (OFF_MIX + (size_t)MROWS * DM * 2)
#define OFF_WIN (OFF_MOD + (size_t)2 * 5 * 6144 * 4)
#define OFF_WOUT (OFF_WIN + (size_t)2 * PIN * DM * 2)
#define OFF_WQ (OFF_WOUT + (size_t)2 * DM * DM * 2)
#define OFF_S5MS (OFF_WQ + (size_t)2 * 2048 * DM * 2)
#define OFF_S5MY (OFF_S5MS + (size_t)2 * 16 * 256 * 256 * 2)
#define OFF_S5LB (OFF_S5MY + (size_t)2 * 16 * 256 * 512 * 2)
#define OFF_S5ST (OFF_S5LB + (size_t)2 * 16 * 2 * 128 * 4)
#define OFF_BAR (OFF_S5ST + (size_t)4 * 16 * 272 * 256 * 4)
#define OFF_KEYB (OFF_BAR + 16384)
#define OFF_LW (OFF_KEYB + (size_t)2 * 8 * 2 * 128 * 128 * 2)
#define OFF_END (OFF_LW + (size_t)4 * 131072 * 2)
#define OFF_RXL OFF_MIX
#define OFF_TMP OFF_P
#define OFF_H OFF_YP
#define OFF_H2 (OFF_YP + (size_t)MROWS * DM * 2)
#define OFF_Q OFF_RW
#define OFF_IDX (OFF_RW + (size_t)MROWS * 2048 * 2)
#define OFF_GATE (OFF_IDX + (size_t)MROWS * 128 * 4)
#define OFF_TBU OFF_P
#define OFF_TBV (OFF_P + (size_t)16384 * 1024 * 2)

struct Params {
    const float* in[39];
    float* out;
    unsigned char* ws;
    int ph_lo, ph_hi;
};

__device__ __forceinline__ bf16_t f2bf(float f) {
    unsigned u = __float_as_uint(f);
    u += 0x7FFFu + ((u >> 16) & 1u);
    return (bf16_t)(u >> 16);
}
__device__ __forceinline__ float bf2f(bf16_t h) { return __uint_as_float(((unsigned)h) << 16); }
__device__ __forceinline__ float sigmoidf_(float x) { return 1.f / (1.f + __expf(-x)); }
__device__ __forceinline__ float siluf_(float x) { return x * sigmoidf_(x); }
__device__ __forceinline__ float gelu_tanh(float x) {
    const float u = 0.7978845608028654f * (x + 0.044715f * x * x * x);
    return 0.5f * x * (1.f + tanhf(u));
}
__device__ __forceinline__ float wave_sum(float v) {
#pragma unroll
    for (int o = 32; o > 0; o >>= 1) v += __shfl_xor(v, o, 64);
    return v;
}
typedef short bf16x4 __attribute__((ext_vector_type(4)));
#define RW_NCH 34
#define RW_BUF 13824
#define RW_VT0 27648
__device__ __forceinline__ f32x4 mfma32(bf16x8 a, bf16x8 b, f32x4 c) { return __builtin_amdgcn_mfma_f32_16x16x32_bf16(a, b, c, 0, 0, 0); }
__device__ __forceinline__ f32x4 mfma16(bf16x4 a, bf16x4 b, f32x4 c) {
    bf16x8 a8, b8;
    a8[0] = a[0]; a8[1] = a[1]; a8[2] = a[2]; a8[3] = a[3]; a8[4] = 0; a8[5] = 0; a8[6] = 0; a8[7] = 0;
    b8[0] = b[0]; b8[1] = b[1]; b8[2] = b[2]; b8[3] = b[3]; b8[4] = 0; b8[5] = 0; b8[6] = 0; b8[7] = 0;
    return __builtin_amdgcn_mfma_f32_16x16x32_bf16(a8, b8, c, 0, 0, 0);
}
__device__ __forceinline__ bf16x4 to4(f32x4 v) { bf16x4 o; o[0] = (short)f2bf(v[0]); o[1] = (short)f2bf(v[1]); o[2] = (short)f2bf(v[2]); o[3] = (short)f2bf(v[3]); return o; }
__device__ __forceinline__ bf16x8 cat8(bf16x4 a, bf16x4 b) { bf16x8 o; o[0] = a[0]; o[1] = a[1]; o[2] = a[2]; o[3] = a[3]; o[4] = b[0]; o[5] = b[1]; o[6] = b[2]; o[7] = b[3]; return o; }

__device__ __forceinline__ int otid() { int t = threadIdx.x; asm volatile("" : "+v"(t)); return t; }
__device__ __forceinline__ float rdlane(float v, int l) { return __int_as_float(__builtin_amdgcn_readlane(__float_as_int(v), l)); }
__device__ __forceinline__ int row_of(int b, int dir, int tau) {
    const int p = dir == 0 ? tau : (tau < CTX ? (CTX - 1 - tau) : (LTOT + CTX - 1 - tau));
    return b * LTOT + p;
}
__device__ __forceinline__ int modrow(int row) { const int p = row % LTOT; return p < CTX ? 4 : row / LTOT; }

__device__ __forceinline__ void s5_prep_unit(const Params& P, int l, int g, unsigned char* smem);

#define XB_TMO      128
#define XB_XCNT(j)  (256  + 64 * (j))
#define XB_XSUB(j)  (1280 + 64 * (j))
#define XB_XGEN(j)  (2304 + 64 * (j))
#define XB_TOP      3328
#define XB_TOPGEN   3392
#define XCD_BAR_WORDS 3456
#define XB_SPIN_CAP (1u << 22)
#define LAS __attribute__((address_space(3)))
__device__ __forceinline__ unsigned xb_ld(unsigned* p)              { return __hip_atomic_load(p, __ATOMIC_RELAXED, __HIP_MEMORY_SCOPE_AGENT); }
__device__ __forceinline__ unsigned xb_add(unsigned* p, unsigned v) { return __hip_atomic_fetch_add(p, v, __ATOMIC_RELAXED, __HIP_MEMORY_SCOPE_AGENT); }
__device__ __forceinline__ unsigned xb_xcc_id() { return (unsigned)__builtin_amdgcn_s_getreg((3 << 11) | 20) & 0xFu; }
#define XB_SPIN(cond, bar) do { unsigned _sp = 0; while (cond) { __builtin_amdgcn_s_sleep(1); \
    if ((++_sp & 255u) == 0u) { if (xb_ld(&(bar)[XB_TMO])) break; if (_sp > XB_SPIN_CAP) { atomicAdd(&(bar)[XB_TMO], 1u); break; } } } } while (0)
struct XcdBarrier { unsigned* bar; unsigned x; volatile LAS unsigned* st; };
__device__ __forceinline__ XcdBarrier xcd_barrier_post(unsigned* bar, volatile LAS unsigned* st) {
    XcdBarrier b; b.bar = bar; b.x = xb_xcc_id(); b.st = st;
    if (threadIdx.x == 0) (void)xb_add(&bar[XB_XCNT(b.x)], 1u);
    return b;
}
__device__ __forceinline__ void xcd_barrier_complete(unsigned* bar, unsigned x, unsigned& nloc, unsigned& nx) {
    const unsigned G = gridDim.x * gridDim.y * gridDim.z;
    unsigned sum, cnt, mine, sp = 0u;
    for (;;) {
        sum = 0u; cnt = 0u; mine = 0u;
#pragma unroll
        for (unsigned j = 0; j < 16; ++j) { const unsigned c = xb_ld(&bar[XB_XCNT(j)]); sum += c; cnt += (c > 0u) ? 1u : 0u; mine = (j == x) ? c : mine; }
        if (sum == G) break;
        __builtin_amdgcn_s_sleep(1);
        if ((++sp & 255u) == 0u) { if (xb_ld(&bar[XB_TMO])) break; if (sp > XB_SPIN_CAP) { atomicAdd(&bar[XB_TMO], 1u); break; } }
    }
    nloc = mine > 0u ? mine : 1u; nx = cnt > 0u ? cnt : 1u;
}
__device__ __forceinline__ void xcd_barrier(const XcdBarrier& b) {
    asm volatile("s_waitcnt vmcnt(0)" ::: "memory");
    __syncthreads();
    if (threadIdx.x == 0) {
        unsigned* bar = b.bar;
        __builtin_amdgcn_s_waitcnt(0);
        unsigned nloc = b.st[0], nx = b.st[1];
        if (nloc == 0u) { xcd_barrier_complete(bar, b.x, nloc, nx); b.st[0] = nloc; b.st[1] = nx; }
        const unsigned old = xb_add(&bar[XB_XSUB(b.x)], 1u);
        const unsigned gen = old / nloc;
        if (old + 1u == (gen + 1u) * nloc) {
            __builtin_amdgcn_fence(__ATOMIC_RELEASE, "agent");
            asm volatile("s_waitcnt vmcnt(0)" ::: "memory");
            const unsigned og = xb_add(&bar[XB_TOP], 1u);
            const unsigned tg = og / nx;
            if (og + 1u == (tg + 1u) * nx) xb_add(&bar[XB_TOPGEN], 1u);
            else XB_SPIN(xb_ld(&bar[XB_TOPGEN]) == tg, bar);
            __builtin_amdgcn_fence(__ATOMIC_ACQUIRE, "agent");
            xb_add(&bar[XB_XGEN(b.x)], 1u);
            asm volatile("s_waitcnt vmcnt(0)" ::: "memory");
        } else {
            XB_SPIN(xb_ld(&bar[XB_XGEN(b.x)]) == gen, bar);
            __builtin_amdgcn_fence(__ATOMIC_ACQUIRE, "agent");
            asm volatile("s_waitcnt vmcnt(0)" ::: "memory");
        }
    }
    __syncthreads();
}

__device__ __forceinline__ void phase_prep(const Params& P, unsigned char* smem) {
    const int tid = otid(), lane = tid & 63, wave = __builtin_amdgcn_readfirstlane(tid >> 6);
    float* MOD = (float*)(P.ws + OFF_MOD);
    float* XS = (float*)(P.ws + OFF_XS);
    const int U_MOD = 192, U_COPY = MROWS / 16, U_TIN = 2 * 16 * 54, U_TOUT = 2 * 16 * 16, U_TQ = 2 * 16 * 32;
    const int U_S5 = 32, U_KEY = 64 + 64;
    const int total = U_S5 + U_KEY + U_MOD + U_COPY + U_TIN + U_TOUT + U_TQ;
    for (int u0 = blockIdx.x; u0 < total; u0 += gridDim.x) {
        __syncthreads();
        if (u0 < U_S5) { s5_prep_unit(P, u0 >> 4, u0 & 15, smem); continue; }
        if (u0 < U_S5 + 64) {
            bf16_t* KB = (bf16_t*)(P.ws + OFF_KEYB);
            const size_t base = (size_t)(u0 - U_S5) * 8192;
            for (int i = tid; i < 8192; i += 256) KB[base + i] = f2bf(P.in[36][base + i]);
            continue;
        }
        if (u0 < U_S5 + U_KEY) {
            bf16_t* LW = (bf16_t*)(P.ws + OFF_LW);
            const int base = (u0 - U_S5 - 64) * 8192;
            for (int i = tid; i < 8192; i += 256) {
                const int o = base + i, which = o >> 17, e = o & 131071;
                float v;
                if (which < 2) { const int j = e & 63, c = (e >> 6) & 511, ld = e >> 15; v = P.in[which == 0 ? 26 : 28][((size_t)ld * 64 + j) * 512 + c]; }
                else if (which == 2) { const int j = e & 127, c = (e >> 7) & 511, ll = e >> 16; v = P.in[29][((size_t)ll * 128 + j) * 512 + c]; }
                else { const int k = e & 255, n = (e >> 8) & 255, ll = e >> 16; v = P.in[20][((size_t)ll * 256 + k) * 256 + n]; }
                LW[o] = f2bf(v);
            }
            continue;
        }
        const int u = u0 - U_S5 - U_KEY;
        if (u < U_MOD) {
            const int l = u / 96, j0 = (u % 96) * 64;
            float* sl = (float*)smem;
            for (int i = tid; i < 5 * 1024; i += 256) {
                const int r = i >> 10, k = i & 1023;
                const float cv = r < 4 ? P.in[1][r * 1024 + k] : P.in[3][k];
                sl[i] = siluf_(cv);
            }
            __syncthreads();
            float acc[5] = {0.f, 0.f, 0.f, 0.f, 0.f};
            const float* W = P.in[4] + (size_t)l * 1024 * 6144 + j0 + lane;
            for (int k = wave * 256; k < wave * 256 + 256; ++k) {
                const float w = W[(size_t)k * 6144];
#pragma unroll
                for (int r = 0; r < 5; ++r) acc[r] += sl[r * 1024 + k] * w;
            }
            float* red = (float*)(smem + 5 * 1024 * 4);
#pragma unroll
            for (int r = 0; r < 5; ++r) red[(wave * 5 + r) * 64 + lane] = acc[r];
            __syncthreads();
            for (int i = tid; i < 5 * 64; i += 256) {
                const int r = i / 64, jj = i % 64;
                float s = P.in[5][l * 6144 + j0 + jj];
                for (int w = 0; w < 4; ++w) s += red[(w * 5 + r) * 64 + jj];
                MOD[(l * 5 + r) * 6144 + j0 + jj] = s;
            }
        } else if (u < U_MOD + U_COPY) {
            const int r0 = (u - U_MOD) * 16;
            for (int i = tid; i < 16 * 256; i += 256) {
                const int row = r0 + (i >> 8), c4 = i & 255;
                const int b = row / LTOT, p = row % LTOT;
                const float4* src = p < CTX ? (const float4*)(P.in[2] + ((size_t)b * CTX + p) * DM) : (const float4*)(P.in[0] + ((size_t)b * SEQ + (p - CTX)) * DM);
                ((float4*)(XS + (size_t)row * DM))[c4] = src[c4];
            }
        } else {
            int v = u - U_MOD - U_COPY;
            const float* W; bf16_t* Wt; int N;
            if (v < U_TIN) { const int l = v / (16 * 54); v %= 16 * 54; N = PIN; W = P.in[6] + (size_t)l * 1024 * PIN; Wt = (bf16_t*)(P.ws + OFF_WIN) + (size_t)l * PIN * 1024; }
            else if (v < U_TIN + U_TOUT) { v -= U_TIN; const int l = v / 256; v %= 256; N = 1024; W = P.in[7] + (size_t)l * 1024 * 1024; Wt = (bf16_t*)(P.ws + OFF_WOUT) + (size_t)l * 1024 * 1024; }
            else { v -= U_TIN + U_TOUT; const int l = v / 512; v %= 512; N = 2048; W = P.in[35] + (size_t)l * 1024 * 2048; Wt = (bf16_t*)(P.ws + OFF_WQ) + (size_t)l * 2048 * 1024; }
            const int ntn = N / 64, kt = v / ntn, nt = v % ntn;
            float* t = (float*)smem;
            for (int i = tid; i < 64 * 64; i += 256) { const int kk = i >> 6, nn = i & 63; t[kk * 65 + nn] = W[(size_t)(kt * 64 + kk) * N + nt * 64 + nn]; }
            __syncthreads();
            for (int i = tid; i < 64 * 64; i += 256) { const int nn = i >> 6, kk = i & 63; Wt[(size_t)(nt * 64 + nn) * 1024 + kt * 64 + kk] = f2bf(t[kk * 65 + nn]); }
        }
    }
}

__device__ __forceinline__ void phase_mkh(const Params& P) {
    const int lane = otid() & 63, wave = __builtin_amdgcn_readfirstlane(otid() >> 6);
    const float* XS = (const float*)(P.ws + OFF_XS);
    const float* MOD = (const float*)(P.ws + OFF_MOD);
    bf16_t* H = (bf16_t*)(P.ws + OFF_H);
    for (int row = blockIdx.x * 4 + wave; row < MROWS; row += gridDim.x * 4) {
        const float* mod = MOD + (size_t)(0 * 5 + modrow(row)) * 6144;
#pragma unroll
        for (int j = 0; j < 4; ++j) {
            const int d = 256 * j + 4 * lane;
            const float4 x = *(const float4*)(XS + (size_t)row * DM + d);
            const float4 sh = *(const float4*)(mod + d), sc = *(const float4*)(mod + 1024 + d);
            ushort4 o;
            o.x = f2bf(x.x * (1.f + sc.x) + sh.x); o.y = f2bf(x.y * (1.f + sc.y) + sh.y);
            o.z = f2bf(x.z * (1.f + sc.z) + sh.z); o.w = f2bf(x.w * (1.f + sc.w) + sh.w);
            *(ushort4*)(H + (size_t)row * DM + d) = o;
        }
    }
}

template <class EPI>
__device__ __forceinline__ void gemm_bf16(const bf16_t* A, int lda, const bf16_t* Bt, int ldb, int M, int N, int K, bool skipctx, EPI epi) {
    const int lane = otid() & 63, wave = __builtin_amdgcn_readfirstlane(otid() >> 6);
    const int ntm = M / 128, ntn = N / 128;
    const int fr = lane & 15, fq = lane >> 4;
    for (int tile = blockIdx.x; tile < ntm * ntn; tile += gridDim.x) {
        const int tm = tile / ntn, tn = tile % ntn;
        const int m0 = tm * 128 + (wave >> 1) * 64, n0 = tn * 128 + (wave & 1) * 64;
        if (skipctx && (m0 % LTOT) < CTX) continue;
        f32x4 acc[4][4];
#pragma unroll
        for (int i = 0; i < 4; ++i)
#pragma unroll
            for (int j = 0; j < 4; ++j) acc[i][j] = (f32x4){0.f, 0.f, 0.f, 0.f};
        const bf16_t* ap = A + (size_t)(m0 + fr) * lda + 8 * fq;
        const bf16_t* bp = Bt + (size_t)(n0 + fr) * ldb + 8 * fq;
        for (int k0 = 0; k0 < K; k0 += 32) {
            bf16x8 a[4], b[4];
#pragma unroll
            for (int i = 0; i < 4; ++i) a[i] = *(const bf16x8*)(ap + (size_t)(16 * i) * lda + k0);
#pragma unroll
            for (int j = 0; j < 4; ++j) b[j] = *(const bf16x8*)(bp + (size_t)(16 * j) * ldb + k0);
#pragma unroll
            for (int i = 0; i < 4; ++i)
#pragma unroll
                for (int j = 0; j < 4; ++j) acc[i][j] = __builtin_amdgcn_mfma_f32_16x16x32_bf16(a[i], b[j], acc[i][j], 0, 0, 0);
        }
#pragma unroll
        for (int i = 0; i < 4; ++i)
#pragma unroll
            for (int j = 0; j < 4; ++j)
#pragma unroll
                for (int r = 0; r < 4; ++r) epi(m0 + 16 * i + 4 * fq + r, n0 + 16 * j + fr, acc[i][j][r]);
    }
}
struct EpiBf16 { bf16_t* C; int ldc; __device__ __forceinline__ void operator()(int r, int c, float v) const { C[(size_t)r * ldc + c] = f2bf(v); } };
struct EpiF32 { float* C; int ldc; __device__ __forceinline__ void operator()(int r, int c, float v) const { C[(size_t)r * ldc + c] = v; } };

__device__ __forceinline__ void phase_rwprep(const Params& P, int l, unsigned char* smem) {
    const int tid = otid();
    const bf16_t* Pb = (const bf16_t*)(P.ws + OFF_P);
    bf16_t* RW = (bf16_t*)(P.ws + OFF_RW);
    const float* mu = P.in[24] + l * 1920;
    const float* k_k = P.in[30] + l * 512;
    float* tw = (float*)smem;
    float* al = tw + 2 * 8 * 64;
    float* kk2 = al + 2 * 8 * 64;
    float* nrm = kk2 + 8 * 512;
    for (int u = blockIdx.x; u < MROWS / 8; u += gridDim.x) {
        const int r0 = u * 8;
        __syncthreads();
        for (int i = 0; i < 8; ++i) {
            const int row = r0 + i, p = row % LTOT;
            int nb[4]; bool ok[4];
            if (p < CTX) {
                nb[0] = row - 1; ok[0] = p > 0; nb[1] = row + 1; ok[1] = p < CTX - 1; nb[2] = nb[0]; ok[2] = ok[0]; nb[3] = nb[1]; ok[3] = ok[1];
            } else {
                const int t = p - CTX, gr = t >> 6, gc = t & 63;
                nb[0] = row - 1; ok[0] = gc > 0; nb[1] = row + 1; ok[1] = gc < 63; nb[2] = row - 64; ok[2] = gr > 0; nb[3] = row + 64; ok[3] = gr < 63;
            }
            for (int c = tid; c < 1920; c += 256) {
                const int m = c & 3;
                const float pv = bf2f(Pb[(size_t)row * PIN + 1536 + c]);
                const float nv = ok[m] ? bf2f(Pb[(size_t)nb[m] * PIN + 1536 + c]) : 0.f;
                const float s = pv + mu[c] * (nv - pv);
                bf16_t* rw = RW + (size_t)row * RWW;
                if (c < 512) rw[c] = f2bf(s);
                else if (c < 1024) { rw[c] = f2bf(s); kk2[i * 512 + (c - 512)] = s * k_k[c - 512]; }
                else if (c < 1536) rw[c] = f2bf(s);
                else if (c < 1664) rw[4096 + (c - 1536)] = f2bf(sigmoidf_(s));
                else if (c < 1728) tw[(0 * 8 + i) * 64 + (c - 1664)] = tanhf(s);
                else if (c < 1792) tw[(1 * 8 + i) * 64 + (c - 1728)] = tanhf(s);
                else if (c < 1856) al[(0 * 8 + i) * 64 + (c - 1792)] = s;
                else al[(1 * 8 + i) * 64 + (c - 1856)] = s;
            }
        }
        __syncthreads();
        {
            const int pair = tid >> 2, q = tid & 3, i = pair >> 3, hd = pair & 7;
            float s = 0.f;
            for (int j = 0; j < 16; ++j) { const float v = kk2[i * 512 + hd * 64 + q * 16 + j]; s += v * v; }
            s += __shfl_xor(s, 1, 64); s += __shfl_xor(s, 2, 64);
            if (q == 0) nrm[pair] = fmaxf(sqrtf(s), 1e-12f);
        }
        __syncthreads();
        for (int e = tid; e < 8 * 512; e += 256) {
            const int i = e >> 9, c = e & 511;
            RW[(size_t)(r0 + i) * RWW + 1536 + c] = f2bf(kk2[e] / nrm[i * 8 + (c >> 6)]);
        }
        for (int d = 0; d < 2; ++d) {
            const float* wup = P.in[26] + (size_t)(l * 2 + d) * 64 * 512;
            const float* aup = P.in[28] + (size_t)(l * 2 + d) * 64 * 512;
            const float* w0 = P.in[25] + (l * 2 + d) * 512;
            const float* a0 = P.in[27] + (l * 2 + d) * 512;
            float zw[2][8], za[2][8];
#pragma unroll
            for (int i = 0; i < 8; ++i) { zw[0][i] = zw[1][i] = za[0][i] = za[1][i] = 0.f; }
            for (int j = 0; j < 64; ++j) {
                const float w_0 = wup[j * 512 + tid], w_1 = wup[j * 512 + tid + 256];
                const float a_0 = aup[j * 512 + tid], a_1 = aup[j * 512 + tid + 256];
#pragma unroll
                for (int i = 0; i < 8; ++i) {
                    const float t = tw[(d * 8 + i) * 64 + j], a = al[(d * 8 + i) * 64 + j];
                    zw[0][i] += t * w_0; zw[1][i] += t * w_1; za[0][i] += a * a_0; za[1][i] += a * a_1;
                }
            }
#pragma unroll
            for (int i = 0; i < 8; ++i) {
                bf16_t* rw = RW + (size_t)(r0 + i) * RWW;
#pragma unroll
                for (int h = 0; h < 2; ++h) {
                    const int c = tid + 256 * h;
                    rw[2048 + d * 512 + c] = f2bf(sigmoidf_(a0[c] + za[h][i]));
                    rw[3072 + d * 512 + c] = f2bf(-0.60653066f * sigmoidf_(w0[c] + zw[h][i]));
                }
            }
        }
    }
}

__device__ __forceinline__ void scan_rwkv(const Params& P, int l, int item) {
    const int lane = otid() & 63;
    const int dir = item & 1, hd = (item >> 1) & 7, b = item >> 4;
    const bf16_t* RW = (const bf16_t*)(P.ws + OFF_RW);
    bf16_t* YP = (bf16_t*)(P.ws + OFF_YP) + (size_t)dir * MROWS * DM;
    const float ka = P.in[31][l * 512 + hd * 64 + lane];
    float S[64];
#pragma unroll
    for (int k = 0; k < 64; ++k) S[k] = 0.f;
    for (int tau = 0; tau < LTOT; ++tau) {
        const int row = row_of(b, dir, tau);
#ifdef EXP_T2
        if ((tau & 127) == 0) {
            float* RXL = (float*)(P.ws + OFF_RXL);
            const size_t itm = (size_t)item * 34 + (tau >> 7);
#pragma unroll
            for (int kk = 0; kk < 64; ++kk) RXL[((itm * 16 + (kk >> 4) * 4 + (lane >> 4)) * 64 + ((kk >> 2) & 3) * 16 + (lane & 15)) * 4 + (kk & 3)] = S[kk];
        }
#endif
        const bf16_t* rw = RW + (size_t)row * RWW + hd * 64 + lane;
        const float r = bf2f(rw[0]), k = bf2f(rw[512]), v = bf2f(rw[1024]), kap = bf2f(rw[1536]);
        const float a = bf2f(rw[2048 + dir * 512]), lw = bf2f(rw[3072 + dir * 512]);
        const float w = __expf(lw), kt = k * (1.f + (a - 1.f) * ka), beta = kap * a;
        float sk = 0.f;
#pragma unroll
        for (int kk = 0; kk < 64; ++kk) { sk += S[kk] * rdlane(kap, kk); if ((kk & 7) == 7) __builtin_amdgcn_sched_barrier(0); }
        float y = 0.f;
#pragma unroll
        for (int kk = 0; kk < 64; ++kk) {
            const float s = S[kk] * rdlane(w, kk) - sk * rdlane(beta, kk) + v * rdlane(kt, kk);
            S[kk] = s;
            y += s * rdlane(r, kk);
            if ((kk & 3) == 3) __builtin_amdgcn_sched_barrier(0);
        }
        YP[(size_t)row * DM + 512 + hd * 64 + lane] = f2bf(y);
    }
}
__device__ __forceinline__ void scan_hgrn(const Params& P, int l, int item) {
    const int lane = otid() & 63;
    const int dir = item & 1, hd = (item >> 1) & 3, b = item >> 3;
    const bf16_t* Pb = (const bf16_t*)(P.ws + OFF_P);
    bf16_t* YP = (bf16_t*)(P.ws + OFF_YP) + (size_t)dir * MROWS * DM;
    float lb = 0.f;
    if (l == 1) {
        const float a0 = P.in[22][(dir * 2 + 0) * 256 + hd * 64 + lane], a1 = P.in[22][(dir * 2 + 1) * 256 + hd * 64 + lane];
        const float m = fmaxf(a0, a1), e0 = __expf(a0 - m), e1 = __expf(a1 - m);
        lb = e1 / (e0 + e1);
    }
    float S[64];
#pragma unroll
    for (int k = 0; k < 64; ++k) S[k] = 0.f;
    for (int tau = 0; tau < LTOT; ++tau) {
        const int row = row_of(b, dir, tau);
        const bf16_t* pr = Pb + (size_t)row * PIN + 256 + hd * 64 + lane;
        const float q = siluf_(bf2f(pr[0])), v = bf2f(pr[256]);
        const float f = lb + (1.f - lb) * sigmoidf_(bf2f(pr[512 + dir * 256]));
        const float kq = 1.f - f;
        float o = 0.f;
#pragma unroll
        for (int dk = 0; dk < 64; ++dk) {
            const float s = rdlane(f, dk) * S[dk] + rdlane(kq, dk) * v;
            S[dk] = s;
            o += s * rdlane(q, dk);
            if ((dk & 7) == 7) __builtin_amdgcn_sched_barrier(0);
        }
        YP[(size_t)row * DM + 256 + hd * 64 + lane] = f2bf(o);
    }
}
__device__ __forceinline__ void scan_s5(const Params& P, int l, int item) {
    const int lane = otid() & 63;
    const int dir = item & 1, g = (item >> 1) & 15, b = item >> 5;
    const bf16_t* Pb = (const bf16_t*)(P.ws + OFF_P);
    bf16_t* YP = (bf16_t*)(P.ws + OFF_YP) + (size_t)dir * MROWS * DM;
    const int ldg = (l * 2 + dir) * 16 + g;
    const float dt = expf(P.in[14][ldg]);
    const float lre = P.in[12][ldg * 64 + lane], lim = P.in[13][ldg * 64 + lane];
    const float mag = expf(lre * dt), ang = lim * dt;
    const float lb_re = mag * cosf(ang), lb_im = mag * sinf(ang);
    const float den = lre * lre + lim * lim, nr = lb_re - 1.f, ni = lb_im;
    const float co_re = (nr * lre + ni * lim) / den, co_im = (ni * lre - nr * lim) / den;
    float bb_re[16], bb_im[16], c_re[16], c_im[16];
#pragma unroll
    for (int h = 0; h < 16; ++h) {
        const float br = P.in[15][((size_t)ldg * 64 + lane) * 16 + h], bi = P.in[16][((size_t)ldg * 64 + lane) * 16 + h];
        bb_re[h] = co_re * br - co_im * bi; bb_im[h] = co_re * bi + co_im * br;
        c_re[h] = P.in[17][((size_t)ldg * 16 + h) * 64 + lane]; c_im[h] = P.in[18][((size_t)ldg * 16 + h) * 64 + lane];
    }
    float s_re = 0.f, s_im = 0.f;
    for (int tau = 0; tau < LTOT; ++tau) {
        const int row = row_of(b, dir, tau);
        const float uv = bf2f(Pb[(size_t)row * PIN + g * 16 + (lane & 15)]);
        float bu_re = 0.f, bu_im = 0.f;
#pragma unroll
        for (int h = 0; h < 16; ++h) { const float uh = rdlane(uv, h); bu_re += bb_re[h] * uh; bu_im += bb_im[h] * uh; }
        const float n_re = lb_re * s_re - lb_im * s_im + bu_re, n_im = lb_re * s_im + lb_im * s_re + bu_im;
        s_re = n_re; s_im = n_im;
        float yo = 0.f;
#pragma unroll
        for (int h = 0; h < 16; ++h) { const float t = wave_sum(c_re[h] * s_re - c_im[h] * s_im); yo = (lane == h) ? t : yo; }
        if (lane < 16) YP[(size_t)row * DM + g * 16 + lane] = f2bf(yo);
    }
}
__device__ __forceinline__ void phase_scans(const Params& P, int l) {
    const int wave = __builtin_amdgcn_readfirstlane(otid() >> 6);
    for (int it = wave * gridDim.x + blockIdx.x; it < 32; it += 4 * gridDim.x) scan_hgrn(P, l, it);
}

__device__ __forceinline__ void phase_post(const Params& P, int l, unsigned char* smem) {
    const int tid = otid();
    const bf16_t* Pb = (const bf16_t*)(P.ws + OFF_P);
    const bf16_t* RW = (const bf16_t*)(P.ws + OFF_RW);
    const bf16_t* YF = (const bf16_t*)(P.ws + OFF_YP);
    const bf16_t* YB = YF + (size_t)MROWS * DM;
    bf16_t* MIX = (bf16_t*)(P.ws + OFF_MIX);
    float* ypre = (float*)smem;
    float* sg = ypre + 8 * 256;
    for (int u = blockIdx.x; u < MROWS / 8; u += gridDim.x) {
        const int r0 = u * 8;
        if (l == 1 && (r0 % LTOT) < CTX) continue;
        __syncthreads();
        for (int i = 0; i < 8; ++i) {
            const int row = r0 + i;
            ypre[i * 256 + tid] = bf2f(YF[(size_t)row * DM + tid]);
        }
        for (int e = tid; e < 8 * 128; e += 256) sg[e] = bf2f(RW[(size_t)(r0 + (e >> 7)) * RWW + 4096 + (e & 127)]);
        __syncthreads();
        {
            float z[8];
            const float gb = P.in[21][l * 256 + tid];
#pragma unroll
            for (int i = 0; i < 8; ++i) z[i] = gb;
            const float* gw = P.in[20] + (size_t)l * 256 * 256 + tid;
            for (int k = 0; k < 256; ++k) {
                const float w = gw[k * 256];
#pragma unroll
                for (int i = 0; i < 8; ++i) z[i] += ypre[i * 256 + k] * w;
            }
#pragma unroll
            for (int i = 0; i < 8; ++i) MIX[(size_t)(r0 + i) * DM + tid] = f2bf(ypre[i * 256 + tid] * sigmoidf_(z[i]));
        }
        {
            const int i = tid >> 5, c0 = (tid & 31) * 8, row = r0 + i;
            float o[8], ss = 0.f;
#pragma unroll
            for (int j = 0; j < 8; ++j) { o[j] = bf2f(YF[(size_t)row * DM + 256 + c0 + j]) + bf2f(YB[(size_t)row * DM + 256 + c0 + j]); ss += o[j] * o[j]; }
            ss += __shfl_xor(ss, 1, 64); ss += __shfl_xor(ss, 2, 64); ss += __shfl_xor(ss, 4, 64);
            const float rs = rsqrtf(ss * (1.f / 64.f) + 1e-6f);
#pragma unroll
            for (int j = 0; j < 8; ++j) {
                const float gr = bf2f(Pb[(size_t)row * PIN + 256 + 1024 + c0 + j]);
                MIX[(size_t)row * DM + 256 + c0 + j] = f2bf(o[j] * rs * P.in[23][l * 256 + c0 + j] * siluf_(gr));
            }
        }
        {
            const int i = tid >> 5, c0 = (tid & 31) * 16, row = r0 + i;
            const bf16_t* rw = RW + (size_t)row * RWW;
            float y[16], vv[16], sum = 0.f, bon = 0.f;
#pragma unroll
            for (int j = 0; j < 16; ++j) {
                const int c = c0 + j;
                y[j] = bf2f(YF[(size_t)row * DM + 512 + c]) + bf2f(YB[(size_t)row * DM + 512 + c]);
                sum += y[j];
                const float r = bf2f(rw[c]), k = bf2f(rw[512 + c]), af = bf2f(rw[2048 + c]), ab = bf2f(rw[2560 + c]);
                const float ka = P.in[31][l * 512 + c];
                vv[j] = bf2f(rw[1024 + c]);
                bon += r * P.in[32][l * 512 + c] * (k * (1.f + (af - 1.f) * ka) + k * (1.f + (ab - 1.f) * ka));
            }
            sum += __shfl_xor(sum, 1, 64); sum += __shfl_xor(sum, 2, 64);
            bon += __shfl_xor(bon, 1, 64); bon += __shfl_xor(bon, 2, 64);
            const float mean = sum * (1.f / 64.f);
            float var = 0.f;
#pragma unroll
            for (int j = 0; j < 16; ++j) { const float d = y[j] - mean; var += d * d; }
            var += __shfl_xor(var, 1, 64); var += __shfl_xor(var, 2, 64);
            const float rs = rsqrtf(var * (1.f / 64.f) + 64e-5f);
            float g[16];
#pragma unroll
            for (int j = 0; j < 16; ++j) g[j] = 0.f;
            const float* gup = P.in[29] + (size_t)l * 128 * 512 + c0;
            for (int jj = 0; jj < 128; ++jj) {
                const float s = sg[i * 128 + jj];
                const float4 w0 = *(const float4*)(gup + jj * 512), w1 = *(const float4*)(gup + jj * 512 + 4), w2 = *(const float4*)(gup + jj * 512 + 8), w3 = *(const float4*)(gup + jj * 512 + 12);
                g[0] += s * w0.x; g[1] += s * w0.y; g[2] += s * w0.z; g[3] += s * w0.w;
                g[4] += s * w1.x; g[5] += s * w1.y; g[6] += s * w1.z; g[7] += s * w1.w;
                g[8] += s * w2.x; g[9] += s * w2.y; g[10] += s * w2.z; g[11] += s * w2.w;
                g[12] += s * w3.x; g[13] += s * w3.y; g[14] += s * w3.z; g[15] += s * w3.w;
            }
#pragma unroll
            for (int j = 0; j < 16; ++j) {
                const int c = c0 + j;
                const float yn = (y[j] - mean) * rs * P.in[33][l * 512 + c] + P.in[34][l * 512 + c];
                MIX[(size_t)row * DM + 512 + c] = f2bf((yn + bon * vv[j]) * g[j]);
            }
        }
    }
}

__device__ __forceinline__ void phase_ln1(const Params& P, int l) {
    const int lane = otid() & 63, wave = __builtin_amdgcn_readfirstlane(otid() >> 6);
    float* XS = (float*)(P.ws + OFF_XS);
    const float* TMP = (const float*)(P.ws + OFF_TMP);
    const float* MOD = (const float*)(P.ws + OFF_MOD);
    bf16_t* H2 = (bf16_t*)(P.ws + OFF_H2);
    for (int row = blockIdx.x * 4 + wave; row < MROWS; row += gridDim.x * 4) {
        if (l == 1 && (row % LTOT) < CTX) continue;
        const float* mod = MOD + (size_t)(l * 5 + modrow(row)) * 6144;
        float v[16]; float s = 0.f;
#pragma unroll
        for (int j = 0; j < 4; ++j) {
            const int d = 256 * j + 4 * lane;
            const float4 x = *(const float4*)(XS + (size_t)row * DM + d), t = *(const float4*)(TMP + (size_t)row * DM + d), g = *(const float4*)(mod + 2048 + d);
            v[4 * j + 0] = ALPHA * x.x + g.x * t.x; v[4 * j + 1] = ALPHA * x.y + g.y * t.y; v[4 * j + 2] = ALPHA * x.z + g.z * t.z; v[4 * j + 3] = ALPHA * x.w + g.w * t.w;
            s += v[4 * j] + v[4 * j + 1] + v[4 * j + 2] + v[4 * j + 3];
        }
        const float mean = wave_sum(s) * (1.f / 1024.f);
        float q = 0.f;
#pragma unroll
        for (int j = 0; j < 16; ++j) { const float d = v[j] - mean; q += d * d; }
        const float rs = rsqrtf(wave_sum(q) * (1.f / 1024.f) + 1e-5f);
#pragma unroll
        for (int j = 0; j < 4; ++j) {
            const int d = 256 * j + 4 * lane;
            const float4 gg = *(const float4*)(P.in[8] + l * 1024 + d), bb = *(const float4*)(P.in[9] + l * 1024 + d);
            const float4 sh = *(const float4*)(mod + 3072 + d), sc = *(const float4*)(mod + 4096 + d);
            float4 o;
            o.x = (v[4 * j + 0] - mean) * rs * gg.x + bb.x; o.y = (v[4 * j + 1] - mean) * rs * gg.y + bb.y;
            o.z = (v[4 * j + 2] - mean) * rs * gg.z + bb.z; o.w = (v[4 * j + 3] - mean) * rs * gg.w + bb.w;
            *(float4*)(XS + (size_t)row * DM + d) = o;
            ushort4 h;
            h.x = f2bf(o.x * (1.f + sc.x) + sh.x); h.y = f2bf(o.y * (1.f + sc.y) + sh.y); h.z = f2bf(o.z * (1.f + sc.z) + sh.z); h.w = f2bf(o.w * (1.f + sc.w) + sh.w);
            *(ushort4*)(H2 + (size_t)row * DM + d) = h;
        }
    }
}

__device__ __forceinline__ unsigned f2ord(float f) { const unsigned u = __float_as_uint(f); return u ^ ((u >> 31) ? 0xFFFFFFFFu : 0x80000000u); }
__device__ __forceinline__ float ord2f(unsigned u) { return __uint_as_float((u >> 31) ? (u ^ 0x80000000u) : ~u); }
__device__ __forceinline__ void phase_topk(const Params& P, int l) {
    const int tid = otid();
    const bf16_t* Q = (const bf16_t*)(P.ws + OFF_Q);
    int* IDX = (int*)(P.ws + OFF_IDX);
    float* GATE = (float*)(P.ws + OFF_GATE);
    for (int u = blockIdx.x; u < 8 * (MROWS / 256); u += gridDim.x) {
        const int hd = u / (MROWS / 256), rb = u % (MROWS / 256);
        const int row = rb * 256 + tid;
        if (l == 1 && (row % LTOT) < CTX) continue;
        unsigned top[2][16];
#pragma unroll
        for (int half = 0; half < 2; ++half) {
            float q[128];
            const bf16_t* qp = Q + (size_t)row * 2048 + hd * 256 + half * 128;
#pragma unroll
            for (int d8 = 0; d8 < 16; ++d8) {
                const bf16x8 v = *(const bf16x8*)(qp + d8 * 8);
#pragma unroll
                for (int j = 0; j < 8; ++j) q[d8 * 8 + j] = bf2f((bf16_t)v[j]);
            }
#pragma unroll
            for (int j = 0; j < 16; ++j) top[half][j] = 0u;
            const float* kp = P.in[36] + ((size_t)((l * 8 + hd) * 2 + half)) * 128 * 128;
            for (int key = 0; key < 128; ++key) {
                const float* kr = kp + key * 128;
                float s0 = 0.f, s1 = 0.f, s2 = 0.f, s3 = 0.f;
#pragma unroll
                for (int d = 0; d < 128; d += 4) { s0 += q[d] * kr[d]; s1 += q[d + 1] * kr[d + 1]; s2 += q[d + 2] * kr[d + 2]; s3 += q[d + 3] * kr[d + 3]; if ((d & 31) == 28) __builtin_amdgcn_sched_barrier(0); }
                unsigned x = (f2ord((s0 + s1) + (s2 + s3)) & 0xFFFFFF80u) | (unsigned)(127 - key);
#pragma unroll
                for (int j = 0; j < 16; ++j) { const unsigned t = top[half][j]; const unsigned mx = x > t ? x : t; x = x > t ? t : x; top[half][j] = mx; }
            }
        }
        float cs[16]; int ce[16];
#pragma unroll
        for (int j = 0; j < 16; ++j) { cs[j] = -3.0e38f; ce[j] = 0; }
#pragma unroll
        for (int i = 0; i < 16; ++i) {
            const float s1v = ord2f(top[0][i] & 0xFFFFFF80u); const int i1 = 127 - (int)(top[0][i] & 127u);
#pragma unroll
            for (int j = 0; j < 16; ++j) {
                if ((i + 1) * (j + 1) <= 16) {
                    float x = s1v + ord2f(top[1][j] & 0xFFFFFF80u); int xe = i1 * 128 + (127 - (int)(top[1][j] & 127u));
#pragma unroll
                    for (int t = 0; t < 16; ++t) {
                        const bool gt = x > cs[t];
                        const float ts = cs[t]; const int te = ce[t];
                        cs[t] = gt ? x : ts; ce[t] = gt ? xe : te; x = gt ? ts : x; xe = gt ? te : xe;
                    }
                }
            }
        }
        float den = 0.f, ex[16];
#pragma unroll
        for (int t = 0; t < 16; ++t) { ex[t] = __expf(cs[t] - cs[0]); den += ex[t]; }
        const float inv = 1.f / den;
#pragma unroll
        for (int t = 0; t < 16; ++t) { IDX[(size_t)row * 128 + hd * 16 + t] = ce[t]; GATE[(size_t)row * 128 + hd * 16 + t] = ex[t] * inv; }
    }
}


__device__ __forceinline__ void ce_desc(unsigned& a, unsigned& b) { const unsigned hi = a > b ? a : b, lo = a > b ? b : a; a = hi; b = lo; }
__device__ __forceinline__ void bitonic_sort16(unsigned (&u)[16]) {
#pragma unroll
    for (int k = 2; k <= 16; k <<= 1)
#pragma unroll
        for (int j = k >> 1; j > 0; j >>= 1)
#pragma unroll
            for (int i = 0; i < 16; ++i) {
                const int p = i ^ j;
                if (p > i) { if ((i & k) == 0) ce_desc(u[i], u[p]); else ce_desc(u[p], u[i]); }
            }
}
__device__ __forceinline__ void bitonic_merge16(unsigned (&u)[16]) {
#pragma unroll
    for (int j = 8; j > 0; j >>= 1)
#pragma unroll
        for (int i = 0; i < 16; ++i) { const int p = i ^ j; if (p > i) ce_desc(u[i], u[p]); }
}
__device__ __forceinline__ void xlane_top16(unsigned (&u)[16], int xr) {
    unsigned o[16];
#pragma unroll
    for (int i = 0; i < 16; ++i) o[i] = (unsigned)__shfl_xor((int)u[15 - i], xr, 64);
#pragma unroll
    for (int i = 0; i < 16; ++i) u[i] = u[i] > o[i] ? u[i] : o[i];
    bitonic_merge16(u);
}
__device__ __forceinline__ void phase_topk2(const Params& P, int l, unsigned char* smem) {
    const int lane = otid() & 63, wave = __builtin_amdgcn_readfirstlane(otid() >> 6), fr = lane & 15, fq = lane >> 4;
    const bf16_t* Q = (const bf16_t*)(P.ws + OFF_Q);
    const bf16_t* KB = (const bf16_t*)(P.ws + OFF_KEYB);
    int* IDX = (int*)(P.ws + OFF_IDX);
    float* GATE = (float*)(P.ws + OFF_GATE);
    unsigned char* ids = smem + wave * 512;
    for (int it = blockIdx.x * 4 + wave; it < (MROWS / 16) * 8; it += gridDim.x * 4) {
        const int rt = it >> 3, hd = it & 7, row0 = rt * 16;
        if (l == 1 && (row0 % LTOT) < CTX) continue;
        unsigned top[2][16];
#pragma unroll
        for (int half = 0; half < 2; ++half) {
            f32x4 acc[8];
#pragma unroll
            for (int mi = 0; mi < 8; ++mi) acc[mi] = (f32x4){0.f, 0.f, 0.f, 0.f};
            const bf16_t* kp = KB + ((size_t)((l * 8 + hd) * 2 + half) * 128 + fr) * 128 + 8 * fq;
            const bf16_t* qp = Q + (size_t)(row0 + fr) * 2048 + hd * 256 + half * 128 + 8 * fq;
#pragma unroll
            for (int ks = 0; ks < 4; ++ks) {
                const bf16x8 qb = *(const bf16x8*)(qp + 32 * ks);
#pragma unroll
                for (int mi = 0; mi < 8; ++mi) acc[mi] = mfma32(*(const bf16x8*)(kp + (size_t)(16 * mi) * 128 + 32 * ks), qb, acc[mi]);
            }
            unsigned ua[16], ub[16];
#pragma unroll
            for (int mi = 0; mi < 4; ++mi)
#pragma unroll
                for (int r = 0; r < 4; ++r) {
                    ua[mi * 4 + r] = (f2ord(acc[mi][r]) & 0xFFFFFF80u) | (unsigned)(127 - (16 * mi + 4 * fq + r));
                    ub[mi * 4 + r] = (f2ord(acc[mi + 4][r]) & 0xFFFFFF80u) | (unsigned)(127 - (16 * (mi + 4) + 4 * fq + r));
                }
            bitonic_sort16(ua); bitonic_sort16(ub);
#pragma unroll
            for (int i = 0; i < 16; ++i) ua[i] = ua[i] > ub[15 - i] ? ua[i] : ub[15 - i];
            bitonic_merge16(ua);
            xlane_top16(ua, 16); xlane_top16(ua, 32);
#pragma unroll
            for (int i = 0; i < 16; ++i) top[half][i] = ua[i];
        }
        if (fq == 0) {
            unsigned w[8];
#pragma unroll
            for (int i = 0; i < 8; ++i) {
                const unsigned* t = i < 4 ? &top[0][4 * i] : &top[1][4 * (i - 4)];
                w[i] = (127u - (t[0] & 127u)) | ((127u - (t[1] & 127u)) << 8) | ((127u - (t[2] & 127u)) << 16) | ((127u - (t[3] & 127u)) << 24);
            }
            *(uint4*)(ids + fr * 32) = make_uint4(w[0], w[1], w[2], w[3]);
            *(uint4*)(ids + fr * 32 + 16) = make_uint4(w[4], w[5], w[6], w[7]);
        }
        float s2v[16];
#pragma unroll
        for (int j = 0; j < 16; ++j) s2v[j] = ord2f(top[1][j] & 0xFFFFFF80u);
        float s1r[4];
#pragma unroll
        for (int m = 0; m < 4; ++m) {
            const unsigned t = fq == 0 ? top[0][4 * m] : (fq == 1 ? top[0][4 * m + 1] : (fq == 2 ? top[0][4 * m + 2] : top[0][4 * m + 3]));
            s1r[m] = ord2f(t & 0xFFFFFF80u);
        }
        unsigned cu[16];
#pragma unroll
        for (int j = 0; j < 16; ++j) cu[j] = (f2ord(s1r[0] + s2v[j]) & 0xFFFFFF00u) | (unsigned)((fq << 4) | j);
        {
            unsigned ex[5];
            ex[0] = (f2ord(s1r[1] + s2v[0]) & 0xFFFFFF00u) | (unsigned)(((4 + fq) << 4) | 0);
            ex[1] = (f2ord(s1r[1] + s2v[1]) & 0xFFFFFF00u) | (unsigned)(((4 + fq) << 4) | 1);
            ex[2] = (f2ord(s1r[1] + s2v[2]) & 0xFFFFFF00u) | (unsigned)(((4 + fq) << 4) | 2);
            ex[3] = (f2ord(s1r[2] + s2v[0]) & 0xFFFFFF00u) | (unsigned)(((8 + fq) << 4) | 0);
            ex[4] = (f2ord(s1r[3] + s2v[0]) & 0xFFFFFF00u) | (unsigned)(((12 + fq) << 4) | 0);
#pragma unroll
            for (int e = 0; e < 5; ++e) {
                unsigned x = ex[e];
#pragma unroll
                for (int t = 0; t < 16; ++t) { const unsigned c = cu[t]; const unsigned mx = x > c ? x : c; x = x > c ? c : x; cu[t] = mx; }
            }
        }
        xlane_top16(cu, 16); xlane_top16(cu, 32);
        if (fq == 0) {
            float ex[16], den = 0.f; int eid[16];
            const float m0 = ord2f(cu[0] & 0xFFFFFF00u);
#pragma unroll
            for (int t = 0; t < 16; ++t) {
                ex[t] = __expf(ord2f(cu[t] & 0xFFFFFF00u) - m0); den += ex[t];
                const int i = (cu[t] >> 4) & 15, j = cu[t] & 15;
                eid[t] = (int)ids[fr * 32 + i] * 128 + (int)ids[fr * 32 + 16 + j];
            }
            const float inv = 1.f / den;
            int* ip = IDX + (size_t)(row0 + fr) * 128 + hd * 16;
            float* gp = GATE + (size_t)(row0 + fr) * 128 + hd * 16;
#pragma unroll
            for (int t = 0; t < 16; t += 4) {
                *(int4*)(ip + t) = make_int4(eid[t], eid[t + 1], eid[t + 2], eid[t + 3]);
                *(float4*)(gp + t) = make_float4(ex[t] * inv, ex[t + 1] * inv, ex[t + 2] * inv, ex[t + 3] * inv);
            }
        }
    }
}

__device__ __forceinline__ void phase_tabconv(const Params& P, int l) {
    const float4* U = (const float4*)(P.in[37] + (size_t)l * 16384 * 1024);
    const float4* V = (const float4*)(P.in[38] + (size_t)l * 16384 * 1024);
    ushort4* TU = (ushort4*)(P.ws + OFF_TBU);
    ushort4* TV = (ushort4*)(P.ws + OFF_TBV);
    const size_t n4 = (size_t)16384 * 256;
    for (size_t i = (size_t)blockIdx.x * 256 + otid(); i < n4; i += (size_t)gridDim.x * 256) {
        const float4 a = U[i], b = V[i];
        ushort4 oa, ob;
        oa.x = f2bf(a.x); oa.y = f2bf(a.y); oa.z = f2bf(a.z); oa.w = f2bf(a.w);
        ob.x = f2bf(b.x); ob.y = f2bf(b.y); ob.z = f2bf(b.z); ob.w = f2bf(b.w);
        TU[i] = oa; TV[i] = ob;
    }
}
__device__ __forceinline__ float dot2bf(unsigned a, unsigned b, float acc) { return __builtin_amdgcn_fdot2_f32_bf16(__builtin_bit_cast(bf16x2, a), __builtin_bit_cast(bf16x2, b), acc, false); }
__device__ __forceinline__ float dot8(const uint4& a, const uint4& b, float acc) { acc = dot2bf(a.x, b.x, acc); acc = dot2bf(a.y, b.y, acc); acc = dot2bf(a.z, b.z, acc); return dot2bf(a.w, b.w, acc); }
__device__ __forceinline__ void phase_gather(const Params& P, int l, unsigned char* smem) {
    const int tid = otid(), lane = tid & 63, wave = __builtin_amdgcn_readfirstlane(tid >> 6);
    float* XS = (float*)(P.ws + OFF_XS);
    const float* MOD = (const float*)(P.ws + OFF_MOD);
    const bf16_t* H2 = (const bf16_t*)(P.ws + OFF_H2);
    bf16_t* H = (bf16_t*)(P.ws + OFF_H);
    const int* IDX = (const int*)(P.ws + OFF_IDX);
    const float* GATE = (const float*)(P.ws + OFF_GATE);
    const bf16_t* TU = (const bf16_t*)(P.ws + OFF_TBU);
    const bf16_t* TV = (const bf16_t*)(P.ws + OFF_TBV);
    float* coef = (float*)smem + wave * 128;
    for (int row = blockIdx.x * 4 + wave; row < MROWS; row += gridDim.x * 4) {
        if (l == 1 && (row % LTOT) < CTX) continue;
        const uint4 h0 = *(const uint4*)(H2 + (size_t)row * DM + 8 * lane), h1 = *(const uint4*)(H2 + (size_t)row * DM + 512 + 8 * lane);
        const int e0 = IDX[(size_t)row * 128 + lane], e1 = IDX[(size_t)row * 128 + 64 + lane];
        uint4 ra[8], rb[8];
#define LOADB(T, bt) { _Pragma("unroll") for (int i = 0; i < 8; ++i) { const int k = (bt) * 8 + i; const int e = __builtin_amdgcn_readlane(k < 64 ? e0 : e1, k & 63); \
            const uint4* rp = (const uint4*)((T) + (size_t)e * 1024); ra[i] = rp[lane]; rb[i] = rp[64 + lane]; } }
        for (int bt = 0; bt < 16; ++bt) {
            LOADB(TU, bt)
            float p[8];
#pragma unroll
            for (int i = 0; i < 8; ++i) p[i] = dot8(rb[i], h1, dot8(ra[i], h0, 0.f));
            float q[4], r2[2];
#pragma unroll
            for (int i = 0; i < 4; ++i) { const float sd = (lane & 32) ? p[i] : p[i + 4]; const float rc = __shfl_xor(sd, 32, 64); q[i] = ((lane & 32) ? p[i + 4] : p[i]) + rc; }
#pragma unroll
            for (int i = 0; i < 2; ++i) { const float sd = (lane & 16) ? q[i] : q[i + 2]; const float rc = __shfl_xor(sd, 16, 64); r2[i] = ((lane & 16) ? q[i + 2] : q[i]) + rc; }
            float sv;
            { const float sd = (lane & 8) ? r2[0] : r2[1]; const float rc = __shfl_xor(sd, 8, 64); sv = ((lane & 8) ? r2[1] : r2[0]) + rc; }
            sv += __shfl_xor(sv, 4, 64); sv += __shfl_xor(sv, 2, 64); sv += __shfl_xor(sv, 1, 64);
            if ((lane & 7) == 0) { const int k = bt * 8 + ((lane >> 3) & 7); coef[k] = gelu_tanh(sv) * GATE[(size_t)row * 128 + k]; }
        }
        float acc[16];
#pragma unroll
        for (int j = 0; j < 16; ++j) acc[j] = 0.f;
        for (int bt = 0; bt < 16; ++bt) {
            LOADB(TV, bt)
#pragma unroll
            for (int i = 0; i < 8; ++i) {
                const float c = coef[bt * 8 + i];
                const unsigned w[8] = {ra[i].x, ra[i].y, ra[i].z, ra[i].w, rb[i].x, rb[i].y, rb[i].z, rb[i].w};
#pragma unroll
                for (int j = 0; j < 8; ++j) { acc[2 * j] += c * __uint_as_float(w[j] << 16); acc[2 * j + 1] += c * __uint_as_float(w[j] & 0xFFFF0000u); }
            }
        }
#undef LOADB
        const float* mod = MOD + (size_t)(l * 5 + modrow(row)) * 6144;
        float v[16]; float s = 0.f;
#pragma unroll
        for (int hh = 0; hh < 2; ++hh) {
            const int d = 512 * hh + 8 * lane;
            const float4 x0 = *(const float4*)(XS + (size_t)row * DM + d), x1 = *(const float4*)(XS + (size_t)row * DM + d + 4);
            const float4 g0 = *(const float4*)(mod + 5120 + d), g1 = *(const float4*)(mod + 5120 + d + 4);
            v[8 * hh + 0] = ALPHA * x0.x + g0.x * acc[8 * hh + 0]; v[8 * hh + 1] = ALPHA * x0.y + g0.y * acc[8 * hh + 1];
            v[8 * hh + 2] = ALPHA * x0.z + g0.z * acc[8 * hh + 2]; v[8 * hh + 3] = ALPHA * x0.w + g0.w * acc[8 * hh + 3];
            v[8 * hh + 4] = ALPHA * x1.x + g1.x * acc[8 * hh + 4]; v[8 * hh + 5] = ALPHA * x1.y + g1.y * acc[8 * hh + 5];
            v[8 * hh + 6] = ALPHA * x1.z + g1.z * acc[8 * hh + 6]; v[8 * hh + 7] = ALPHA * x1.w + g1.w * acc[8 * hh + 7];
        }
#pragma unroll
        for (int j = 0; j < 16; ++j) s += v[j];
        const float mean = wave_sum(s) * (1.f / 1024.f);
        float qq = 0.f;
#pragma unroll
        for (int j = 0; j < 16; ++j) { v[j] -= mean; qq += v[j] * v[j]; }
        const float rs = rsqrtf(wave_sum(qq) * (1.f / 1024.f) + 1e-5f);
        const float* mod1 = MOD + (size_t)(1 * 5 + modrow(row)) * 6144;
#pragma unroll
        for (int hh = 0; hh < 2; ++hh) {
            const int d = 512 * hh + 8 * lane;
            float o[8];
#pragma unroll
            for (int j = 0; j < 8; ++j) o[j] = v[8 * hh + j] * rs * P.in[10][l * 1024 + d + j] + P.in[11][l * 1024 + d + j];
            if (l == 0) {
                *(float4*)(XS + (size_t)row * DM + d) = make_float4(o[0], o[1], o[2], o[3]);
                *(float4*)(XS + (size_t)row * DM + d + 4) = make_float4(o[4], o[5], o[6], o[7]);
                bf16_t hb[8];
#pragma unroll
                for (int j = 0; j < 8; ++j) hb[j] = f2bf(o[j] * (1.f + mod1[1024 + d + j]) + mod1[d + j]);
                uint4 pk; pk.x = hb[0] | ((unsigned)hb[1] << 16); pk.y = hb[2] | ((unsigned)hb[3] << 16); pk.z = hb[4] | ((unsigned)hb[5] << 16); pk.w = hb[6] | ((unsigned)hb[7] << 16);
                *(uint4*)(H + (size_t)row * DM + d) = pk;
            } else {
                const int b = row / LTOT, t = row % LTOT - CTX;
                if (*(volatile unsigned*)(P.ws + OFF_BAR + 15360) != 0u) { o[0] = __int_as_float(0x7fc00000); }
                float* op = P.out + ((size_t)b * SEQ + t) * DM + d;
                *(float4*)op = make_float4(o[0], o[1], o[2], o[3]);
                *(float4*)(op + 4) = make_float4(o[4], o[5], o[6], o[7]);
            }
        }
    }
}

__device__ __forceinline__ void s5_prep_unit(const Params& P, int l, int g, unsigned char* smem) {
    const int tid = otid();
    float* Kt = (float*)smem;
    float* bbr = Kt + 8192; float* bbi = bbr + 1024; float* cr = bbi + 1024; float* ci = cr + 1024; float* pwr = ci + 1024; float* pwi = pwr + 17 * 64;
    bf16_t* MS = (bf16_t*)(P.ws + OFF_S5MS) + (size_t)(l * 16 + g) * 256 * 256;
    bf16_t* MY = (bf16_t*)(P.ws + OFF_S5MY) + (size_t)(l * 16 + g) * 256 * 512;
    float* LB = (float*)(P.ws + OFF_S5LB) + (size_t)(l * 16 + g) * 256;
    for (int dir = 0; dir < 2; ++dir) {
        __syncthreads();
        const int ldg = (l * 2 + dir) * 16 + g;
        if (tid < 64) {
            const int p = tid;
            const float dt = expf(P.in[14][ldg]);
            const float lre = P.in[12][ldg * 64 + p], lim = P.in[13][ldg * 64 + p];
            for (int d = 0; d <= 16; ++d) { const float mag = expf(lre * dt * (float)d), ang = lim * dt * (float)d; pwr[d * 64 + p] = mag * cosf(ang); pwi[d * 64 + p] = mag * sinf(ang); }
            const float lb_re = pwr[64 + p], lb_im = pwi[64 + p];
            const float den = lre * lre + lim * lim, nr = lb_re - 1.f, ni = lb_im;
            const float co_re = (nr * lre + ni * lim) / den, co_im = (ni * lre - nr * lim) / den;
            for (int h = 0; h < 16; ++h) {
                const float br = P.in[15][((size_t)ldg * 64 + p) * 16 + h], bi = P.in[16][((size_t)ldg * 64 + p) * 16 + h];
                bbr[p * 16 + h] = co_re * br - co_im * bi; bbi[p * 16 + h] = co_re * bi + co_im * br;
            }
            LB[dir * 128 + p] = pwr[16 * 64 + p]; LB[dir * 128 + 64 + p] = pwi[16 * 64 + p];
        }
        for (int e = tid; e < 1024; e += 256) { cr[e] = P.in[17][(size_t)ldg * 1024 + e]; ci[e] = P.in[18][(size_t)ldg * 1024 + e]; }
        __syncthreads();
        for (int e = tid; e < 4096; e += 256) {
            const int d = e >> 8, h = (e >> 4) & 15, h2 = e & 15;
            float acc = 0.f;
            for (int p = 0; p < 64; ++p) {
                const float Pr = pwr[d * 64 + p], Pi = pwi[d * 64 + p], br = bbr[p * 16 + h2], bi = bbi[p * 16 + h2];
                acc += cr[h * 64 + p] * (Pr * br - Pi * bi) - ci[h * 64 + p] * (Pr * bi + Pi * br);
            }
            Kt[dir * 4096 + e] = acc;
        }
        for (int e = tid; e < 128 * 256; e += 256) {
            const int q = e >> 8, col = e & 255, j = col >> 4, h2 = col & 15, p = q & 63;
            const int ex = dir == 0 ? 15 - j : j;
            const float Pr = pwr[ex * 64 + p], Pi = pwi[ex * 64 + p], br = bbr[p * 16 + h2], bi = bbi[p * 16 + h2];
            MS[(size_t)(dir * 128 + q) * 256 + col] = f2bf(q < 64 ? Pr * br - Pi * bi : Pr * bi + Pi * br);
        }
        for (int e = tid; e < 256 * 128; e += 256) {
            const int ri = e >> 7, q = e & 127, t = ri >> 4, h = ri & 15, p = q & 63;
            const int ex = dir == 0 ? t + 1 : 16 - t;
            const float Lr = pwr[ex * 64 + p], Li = pwi[ex * 64 + p], c_r = cr[h * 64 + p], c_i = ci[h * 64 + p];
            MY[(size_t)ri * 512 + 256 + dir * 128 + q] = f2bf(q < 64 ? c_r * Lr - c_i * Li : -(c_r * Li + c_i * Lr));
        }
    }
    __syncthreads();
    for (int e = tid; e < 256 * 256; e += 256) {
        const int ri = e >> 8, col = e & 255, t = ri >> 4, h = ri & 15, j = col >> 4, h2 = col & 15;
        float v = 0.f;
        if (j <= t) v += Kt[(t - j) * 256 + h * 16 + h2];
        if (j >= t) v += Kt[4096 + (j - t) * 256 + h * 16 + h2];
        MY[(size_t)ri * 512 + col] = f2bf(v);
    }
}
__device__ __forceinline__ void s5_passA(const Params& P, int l) {
    const int lane = otid() & 63, wave = __builtin_amdgcn_readfirstlane(otid() >> 6), fr = lane & 15, fq = lane >> 4;
    const bf16_t* Pb = (const bf16_t*)(P.ws + OFF_P);
    float* ST = (float*)(P.ws + OFF_S5ST);
    for (int it = blockIdx.x * 4 + wave; it < 16 * 17 * 4; it += gridDim.x * 4) {
        const int g = it / 68, mt = (it % 68) >> 2, nt = it & 3;
        const bf16_t* MS = (const bf16_t*)(P.ws + OFF_S5MS) + (size_t)(l * 16 + g) * 256 * 256;
        f32x4 acc[4][4];
#pragma unroll
        for (int i = 0; i < 4; ++i)
#pragma unroll
            for (int j = 0; j < 4; ++j) acc[i][j] = (f32x4){0.f, 0.f, 0.f, 0.f};
        const bf16_t* ap[4];
#pragma unroll
        for (int i = 0; i < 4; ++i) { const int m = mt * 64 + 16 * i + fr, b = m / 272, c = m % 272; ap[i] = Pb + (size_t)(b * LTOT + c * 16) * PIN + g * 16; }
        const bf16_t* bp = MS + (size_t)(nt * 64 + fr) * 256 + 8 * fq;
        for (int k0 = 0; k0 < 256; k0 += 32) {
            const int k = k0 + 8 * fq;
            bf16x8 a[4], bb[4];
#pragma unroll
            for (int i = 0; i < 4; ++i) a[i] = *(const bf16x8*)(ap[i] + (size_t)(k >> 4) * PIN + (k & 15));
#pragma unroll
            for (int j = 0; j < 4; ++j) bb[j] = *(const bf16x8*)(bp + (size_t)(16 * j) * 256 + k0);
#pragma unroll
            for (int i = 0; i < 4; ++i)
#pragma unroll
                for (int j = 0; j < 4; ++j) acc[i][j] = __builtin_amdgcn_mfma_f32_16x16x32_bf16(a[i], bb[j], acc[i][j], 0, 0, 0);
        }
#pragma unroll
        for (int i = 0; i < 4; ++i)
#pragma unroll
            for (int r = 0; r < 4; ++r) {
                const int m = mt * 64 + 16 * i + 4 * fq + r, b = m / 272, c = m % 272;
                float* dst = ST + ((size_t)(b * 16 + g) * 272 + c) * 256 + nt * 64 + fr;
#pragma unroll
                for (int j = 0; j < 4; ++j) dst[16 * j] = acc[i][j][r];
            }
    }
}
__device__ __forceinline__ void s5_carry(const Params& P, int l, int bid, int nb) {
    float* ST = (float*)(P.ws + OFF_S5ST);
    for (int u = bid; u < 32; u += nb) {
        const int gid = u * 256 + otid(), p = gid & 63, dir = (gid >> 6) & 1, g = (gid >> 7) & 15, b = gid >> 11;
        const float* LB = (const float*)(P.ws + OFF_S5LB) + (size_t)(l * 16 + g) * 256 + dir * 128;
        const float lr = LB[p], li = LB[64 + p];
        float* base = ST + (size_t)(b * 16 + g) * 272 * 256 + dir * 128 + p;
        float sr = 0.f, si = 0.f;
        for (int c0 = 0; c0 < 272; c0 += 16) {
            float tr[16], ti[16];
#pragma unroll
            for (int i = 0; i < 16; ++i) { const int cc = c0 + i, c = dir == 0 ? cc : (cc < 16 ? 15 - cc : 287 - cc); tr[i] = base[(size_t)c * 256]; ti[i] = base[(size_t)c * 256 + 64]; }
#pragma unroll
            for (int i = 0; i < 16; ++i) {
                const int cc = c0 + i, c = dir == 0 ? cc : (cc < 16 ? 15 - cc : 287 - cc);
                base[(size_t)c * 256] = sr; base[(size_t)c * 256 + 64] = si;
                const float nr = lr * sr - li * si + tr[i], ni = lr * si + li * sr + ti[i];
                sr = nr; si = ni;
            }
        }
    }
}
__device__ __forceinline__ void s5_passC(const Params& P, int l) {
    const int lane = otid() & 63, wave = __builtin_amdgcn_readfirstlane(otid() >> 6), fr = lane & 15, fq = lane >> 4;
    const bf16_t* Pb = (const bf16_t*)(P.ws + OFF_P);
    const float* ST = (const float*)(P.ws + OFF_S5ST);
    bf16_t* YA = (bf16_t*)(P.ws + OFF_YP);
    for (int it = blockIdx.x * 4 + wave; it < 16 * 17 * 4; it += gridDim.x * 4) {
        const int g = it / 68, mt = (it % 68) >> 2, nt = it & 3;
        const bf16_t* MY = (const bf16_t*)(P.ws + OFF_S5MY) + (size_t)(l * 16 + g) * 256 * 512;
        f32x4 acc[4][4];
#pragma unroll
        for (int i = 0; i < 4; ++i)
#pragma unroll
            for (int j = 0; j < 4; ++j) acc[i][j] = (f32x4){0.f, 0.f, 0.f, 0.f};
        const bf16_t* ap[4]; const float* sp[4];
#pragma unroll
        for (int i = 0; i < 4; ++i) {
            const int m = mt * 64 + 16 * i + fr, b = m / 272, c = m % 272;
            ap[i] = Pb + (size_t)(b * LTOT + c * 16) * PIN + g * 16;
            sp[i] = ST + ((size_t)(b * 16 + g) * 272 + c) * 256;
        }
        const bf16_t* bp = MY + (size_t)(nt * 64 + fr) * 512 + 8 * fq;
        for (int k0 = 0; k0 < 512; k0 += 32) {
            const int k = k0 + 8 * fq;
            bf16x8 a[4], bb[4];
            if (k0 < 256) {
#pragma unroll
                for (int i = 0; i < 4; ++i) a[i] = *(const bf16x8*)(ap[i] + (size_t)(k >> 4) * PIN + (k & 15));
            } else {
#pragma unroll
                for (int i = 0; i < 4; ++i) {
                    const float4 s0 = *(const float4*)(sp[i] + (k - 256)), s1 = *(const float4*)(sp[i] + (k - 256) + 4);
                    bf16x8 t;
                    t[0] = (short)f2bf(s0.x); t[1] = (short)f2bf(s0.y); t[2] = (short)f2bf(s0.z); t[3] = (short)f2bf(s0.w);
                    t[4] = (short)f2bf(s1.x); t[5] = (short)f2bf(s1.y); t[6] = (short)f2bf(s1.z); t[7] = (short)f2bf(s1.w);
                    a[i] = t;
                }
            }
#pragma unroll
            for (int j = 0; j < 4; ++j) bb[j] = *(const bf16x8*)(bp + (size_t)(16 * j) * 512 + k0);
#pragma unroll
            for (int i = 0; i < 4; ++i)
#pragma unroll
                for (int j = 0; j < 4; ++j) acc[i][j] = __builtin_amdgcn_mfma_f32_16x16x32_bf16(a[i], bb[j], acc[i][j], 0, 0, 0);
        }
        const float dsk = P.in[19][l * 256 + g * 16 + fr];
#pragma unroll
        for (int i = 0; i < 4; ++i)
#pragma unroll
            for (int r = 0; r < 4; ++r) {
                const int m = mt * 64 + 16 * i + 4 * fq + r, b = m / 272, c = m % 272;
#pragma unroll
                for (int j = 0; j < 4; ++j) {
                    const int t = nt * 4 + j;
                    const size_t row = (size_t)(b * LTOT + c * 16 + t);
                    const float u = bf2f(Pb[row * PIN + g * 16 + fr]);
                    YA[row * DM + g * 16 + fr] = f2bf(gelu_tanh(acc[i][j][r] + dsk * u));
                }
            }
    }
}


__device__ __forceinline__ void rwkv_prep_step(const bf16_t* RW, int b, int hd, int dir, int tau_base, unsigned char* buf, float ka, int wave, int lane) {
    bf16_t* KR = (bf16_t*)buf; bf16_t* BK = (bf16_t*)(buf + 4608); bf16_t* BbT = (bf16_t*)(buf + 9216); bf16_t* KbT = (bf16_t*)(buf + 11264); float* gT = (float*)(buf + 13312);
    const int ch = hd * 64 + lane;
    float cs[16];
    {
        float c = 0.f;
#pragma unroll
        for (int t = 0; t < 16; ++t) { const int row = row_of(b, dir, tau_base + t); c += bf2f(RW[(size_t)row * RWW + 3072 + dir * 512 + ch]); cs[t] = c; }
    }
    const float c15 = cs[15];
    if (wave == 0) gT[lane] = __expf(c15);
    bf16_t bb[4], kb[4];
#pragma unroll
    for (int t = 0; t < 16; ++t) {
        if ((t >> 2) == wave) {
            const int row = row_of(b, dir, tau_base + t);
            const bf16_t* rw = RW + (size_t)row * RWW + ch;
            const float r = bf2f(rw[0]), k = bf2f(rw[512]), kap = bf2f(rw[1536]), a = bf2f(rw[2048 + dir * 512]);
            const float cp = t > 0 ? cs[t > 0 ? t - 1 : 0] : 0.f, ct = cs[t];
            const float ep = __expf(cp), et = __expf(ct), em = __expf(-ct), eT = __expf(c15 - ct);
            const float beta = kap * a, kt = k * (1.f + (a - 1.f) * ka);
            KR[t * 72 + lane] = f2bf(kap * ep); KR[(16 + t) * 72 + lane] = f2bf(r * et);
            BK[t * 72 + lane] = f2bf(beta * em); BK[(16 + t) * 72 + lane] = f2bf(kt * em);
            bb[t & 3] = f2bf(beta * eT); kb[t & 3] = f2bf(kt * eT);
        }
    }
    uint2 pb, pk;
    pb.x = bb[0] | ((unsigned)bb[1] << 16); pb.y = bb[2] | ((unsigned)bb[3] << 16);
    pk.x = kb[0] | ((unsigned)kb[1] << 16); pk.y = kb[2] | ((unsigned)kb[3] << 16);
    *(uint2*)(BbT + lane * 16 + 4 * wave) = pb;
    *(uint2*)(KbT + lane * 16 + 4 * wave) = pk;
}
template <int NV>
__device__ __forceinline__ void rwkv_prep_vt(const bf16_t* RW, int b, int hd, int dir, int tau_base, int vbase, bf16_t* VT, int lane) {
    if (NV == 2) {
        const int vl = lane & 31, th = lane >> 5;
        bf16_t x[8];
#pragma unroll
        for (int i = 0; i < 8; ++i) { const int row = row_of(b, dir, tau_base + th * 8 + i); x[i] = RW[(size_t)row * RWW + 1024 + hd * 64 + vbase + vl]; }
        uint4 pk; pk.x = x[0] | ((unsigned)x[1] << 16); pk.y = x[2] | ((unsigned)x[3] << 16); pk.z = x[4] | ((unsigned)x[5] << 16); pk.w = x[6] | ((unsigned)x[7] << 16);
        *(uint4*)(VT + vl * 16 + th * 8) = pk;
    } else {
        const int vl = lane & 15, tq = lane >> 4;
        bf16_t x[4];
#pragma unroll
        for (int i = 0; i < 4; ++i) { const int row = row_of(b, dir, tau_base + tq * 4 + i); x[i] = RW[(size_t)row * RWW + 1024 + hd * 64 + vbase + vl]; }
        uint2 pk; pk.x = x[0] | ((unsigned)x[1] << 16); pk.y = x[2] | ((unsigned)x[3] << 16);
        *(uint2*)(VT + vl * 16 + tq * 4) = pk;
    }
}
template <int NV, bool HASV, bool OUT>
__device__ __forceinline__ void rwkv_mfma_step(f32x4 (&X)[4][NV], const unsigned char* buf, const bf16_t* VT, f32x4 (&Yout)[NV], int lane) {
    const bf16_t* KR = (const bf16_t*)buf; const bf16_t* BK = (const bf16_t*)(buf + 4608); const bf16_t* BbT = (const bf16_t*)(buf + 9216); const bf16_t* KbT = (const bf16_t*)(buf + 11264); const float* gT = (const float*)(buf + 13312);
    const int fr = lane & 15, fq = lane >> 4;
    const f32x4 z4 = {0.f, 0.f, 0.f, 0.f};
    f32x4 cA = z4, cN = z4, cAk = z4, cRb = z4, cRk = z4;
#pragma unroll
    for (int ks = 0; ks < 2; ++ks) {
        const bf16x8 kh = *(const bf16x8*)(KR + fr * 72 + 32 * ks + 8 * fq), rh = *(const bf16x8*)(KR + (16 + fr) * 72 + 32 * ks + 8 * fq);
        const bf16x8 bc = *(const bf16x8*)(BK + fr * 72 + 32 * ks + 8 * fq), kc = *(const bf16x8*)(BK + (16 + fr) * 72 + 32 * ks + 8 * fq);
        cA = mfma32(kh, bc, cA); cN = mfma32(bc, kh, cN); cAk = mfma32(kc, kh, cAk);
        if (OUT) { cRb = mfma32(bc, rh, cRb); cRk = mfma32(kc, rh, cRk); }
    }
    f32x4 dg;
#pragma unroll
    for (int r = 0; r < 4; ++r) {
        const int row = 4 * fq + r;
        dg[r] = (row == fr) ? 1.f : 0.f;
        cA[r] = (fr < row) ? cA[r] : 0.f;
        cN[r] = (row < fr) ? cN[r] : 0.f;
        cAk[r] = (row < fr) ? cAk[r] : 0.f;
        cRb[r] = (row <= fr) ? cRb[r] : 0.f;
        cRk[r] = (row <= fr) ? cRk[r] : 0.f;
    }
    const bf16x4 a4 = to4(cA), n4 = to4(cN);
    const f32x4 cA2 = mfma16(n4, a4, z4), cN2 = mfma16(a4, n4, z4);
    const bf16x4 a24 = to4(cA2), n24 = to4(cN2);
    const f32x4 cA4 = mfma16(n24, a24, z4), cN4 = mfma16(a24, n24, z4);
    const f32x4 cA8 = mfma16(to4(cN4), to4(cA4), z4);
    const f32x4 T1 = mfma16(to4(dg - cA), to4(dg + cN2), z4);
    const f32x4 T2 = mfma16(to4(dg + cA4), to4(T1), z4);
    const f32x4 WT = mfma16(to4(dg + cA8), to4(T2), z4);
    const bf16x4 wt4 = to4(WT), aak4 = to4(cAk), rab4 = to4(cRb), rak4 = to4(cRk);
    bf16x8 aK[2], aR[2];
#pragma unroll
    for (int ks = 0; ks < 2; ++ks) {
        aK[ks] = cat8(*(const bf16x4*)(KR + fr * 72 + 32 * ks + 4 * fq), *(const bf16x4*)(KR + fr * 72 + 32 * ks + 16 + 4 * fq));
        if (OUT) aR[ks] = cat8(*(const bf16x4*)(KR + (16 + fr) * 72 + 32 * ks + 4 * fq), *(const bf16x4*)(KR + (16 + fr) * 72 + 32 * ks + 16 + 4 * fq));
    }
    bf16x4 u4[NV], vt4[NV];
#pragma unroll
    for (int nj = 0; nj < NV; ++nj) {
        const bf16x8 b0 = cat8(to4(X[0][nj]), to4(X[1][nj])), b1 = cat8(to4(X[2][nj]), to4(X[3][nj]));
        f32x4 G = mfma32(aK[1], b1, mfma32(aK[0], b0, z4));
        if (HASV) { vt4[nj] = *(const bf16x4*)(VT + (16 * nj + fr) * 16 + 4 * fq); G = mfma16(aak4, vt4[nj], G); }
        const f32x4 U = mfma16(wt4, to4(G), z4);
        u4[nj] = to4(-U);
        if (OUT) {
            f32x4 Yv = mfma32(aR[1], b1, mfma32(aR[0], b0, z4));
            Yv = mfma16(rab4, u4[nj], Yv);
            if (HASV) Yv = mfma16(rak4, vt4[nj], Yv);
            Yout[nj] = Yv;
        }
    }
#pragma unroll
    for (int mi = 0; mi < 4; ++mi) {
        const f32x4 g4 = *(const f32x4*)(gT + 16 * mi + 4 * fq);
        const bf16x4 bb4 = *(const bf16x4*)(BbT + (16 * mi + fr) * 16 + 4 * fq), kb4 = *(const bf16x4*)(KbT + (16 * mi + fr) * 16 + 4 * fq);
#pragma unroll
        for (int nj = 0; nj < NV; ++nj) {
            f32x4 x = X[mi][nj] * g4;
            x = mfma16(bb4, u4[nj], x);
            if (HASV) x = mfma16(kb4, vt4[nj], x);
            X[mi][nj] = x;
        }
    }
}
__device__ __forceinline__ void rwkv_passA(const Params& P, int l, unsigned char* smem, int bid, int nb) {
    const int lane = otid() & 63, wave = __builtin_amdgcn_readfirstlane(otid() >> 6), fr = lane & 15, fq = lane >> 4;
    const bf16_t* RW = (const bf16_t*)(P.ws + OFF_RW);
    float* RXL = (float*)(P.ws + OFF_RXL);
    bf16_t* RXP = (bf16_t*)P.out;
    for (int item = bid; item < 64 * RW_NCH; item += nb) {
        const int seq = item / RW_NCH, c = item % RW_NCH, dir = seq & 1, hd = (seq >> 1) & 7, b = seq >> 4;
        const float ka = P.in[31][l * 512 + hd * 64 + lane];
        const int tau0 = c * 128;
        f32x4 X[4][2], Yd[2];
#pragma unroll
        for (int mi = 0; mi < 4; ++mi)
#pragma unroll
            for (int nj = 0; nj < 2; ++nj)
#pragma unroll
                for (int r = 0; r < 4; ++r) X[mi][nj][r] = (wave >= 2 && (16 * mi + 4 * fq + r) == (16 * (2 * (wave - 2) + nj) + fr)) ? 1.f : 0.f;
        bf16_t* VTw = (bf16_t*)(smem + RW_VT0 + wave * 2048);
        rwkv_prep_step(RW, b, hd, dir, tau0, smem, ka, wave, lane);
        if (wave < 2) rwkv_prep_vt<2>(RW, b, hd, dir, tau0, 32 * wave, VTw, lane);
        __syncthreads();
        for (int s = 0; s < 8; ++s) {
            if (s < 7) {
                rwkv_prep_step(RW, b, hd, dir, tau0 + (s + 1) * 16, smem + ((s + 1) & 1) * RW_BUF, ka, wave, lane);
                if (wave < 2) rwkv_prep_vt<2>(RW, b, hd, dir, tau0 + (s + 1) * 16, 32 * wave, VTw + ((s + 1) & 1) * 512, lane);
            }
            if (wave < 2) rwkv_mfma_step<2, true, false>(X, smem + (s & 1) * RW_BUF, VTw + (s & 1) * 512, Yd, lane);
            else rwkv_mfma_step<2, false, false>(X, smem + (s & 1) * RW_BUF, VTw, Yd, lane);
            __syncthreads();
        }
        if (wave < 2) {
#pragma unroll
            for (int mi = 0; mi < 4; ++mi)
#pragma unroll
                for (int nj = 0; nj < 2; ++nj) *(f32x4*)(RXL + (((size_t)item * 16 + mi * 4 + 2 * wave + nj) * 64 + lane) * 4) = X[mi][nj];
        } else {
#pragma unroll
            for (int mi = 0; mi < 4; ++mi)
#pragma unroll
                for (int nj = 0; nj < 2; ++nj)
#pragma unroll
                    for (int r = 0; r < 4; ++r) RXP[(size_t)item * 4096 + (16 * mi + 4 * fq + r) * 64 + 16 * (2 * (wave - 2) + nj) + fr] = f2bf(X[mi][nj][r]);
        }
    }
}
__device__ __forceinline__ void rwkv_passB(const Params& P) {
    const int lane = otid() & 63, wave = __builtin_amdgcn_readfirstlane(otid() >> 6), fr = lane & 15, fq = lane >> 4;
    float* RXL = (float*)(P.ws + OFF_RXL);
    const bf16_t* RXP = (const bf16_t*)P.out;
    for (int it = blockIdx.x * 4 + wave; it < 256; it += gridDim.x * 4) {
        const int seq = it >> 2, nj = it & 3;
        f32x4 X[4];
#pragma unroll
        for (int mi = 0; mi < 4; ++mi) X[mi] = (f32x4){0.f, 0.f, 0.f, 0.f};
        for (int c = 0; c < RW_NCH; ++c) {
            const size_t item = (size_t)seq * RW_NCH + c;
            f32x4 L[4]; bf16x8 a[4][2];
#pragma unroll
            for (int mi = 0; mi < 4; ++mi) {
                L[mi] = *(const f32x4*)(RXL + ((item * 16 + mi * 4 + nj) * 64 + lane) * 4);
                const bf16_t* xp = RXP + item * 4096 + (16 * mi + fr) * 64;
#pragma unroll
                for (int ks = 0; ks < 2; ++ks) a[mi][ks] = cat8(*(const bf16x4*)(xp + 32 * ks + 4 * fq), *(const bf16x4*)(xp + 32 * ks + 16 + 4 * fq));
            }
            const bf16x8 b0 = cat8(to4(X[0]), to4(X[1])), b1 = cat8(to4(X[2]), to4(X[3]));
#pragma unroll
            for (int mi = 0; mi < 4; ++mi) {
                *(f32x4*)(RXL + ((item * 16 + mi * 4 + nj) * 64 + lane) * 4) = X[mi];
                X[mi] = mfma32(a[mi][1], b1, mfma32(a[mi][0], b0, L[mi]));
            }
        }
    }
}
template <bool CHECK>
__device__ __forceinline__ void rwkv_passC(const Params& P, int l, unsigned char* smem) {
    const int lane = otid() & 63, wave = __builtin_amdgcn_readfirstlane(otid() >> 6), fr = lane & 15, fq = lane >> 4;
    const bf16_t* RW = (const bf16_t*)(P.ws + OFF_RW);
    const float* RXL = (const float*)(P.ws + OFF_RXL);
    for (int item = blockIdx.x; item < 64 * RW_NCH; item += gridDim.x) {
        const int seq = item / RW_NCH, c = item % RW_NCH, dir = seq & 1, hd = (seq >> 1) & 7, b = seq >> 4;
        if (l == 1 && dir == 0 && c < 2) continue;
        if (l == 1 && dir == 1 && c < 2) continue;
        bf16_t* YP = (bf16_t*)(P.ws + OFF_YP) + (size_t)dir * MROWS * DM;
        const float ka = P.in[31][l * 512 + hd * 64 + lane];
        const int tau0 = c * 128;
        f32x4 X[4][1], Yo[1];
#pragma unroll
        for (int mi = 0; mi < 4; ++mi) X[mi][0] = *(const f32x4*)(RXL + (((size_t)item * 16 + mi * 4 + wave) * 64 + lane) * 4);
        bf16_t* VTw = (bf16_t*)(smem + RW_VT0 + wave * 2048);
        rwkv_prep_step(RW, b, hd, dir, tau0, smem, ka, wave, lane);
        rwkv_prep_vt<1>(RW, b, hd, dir, tau0, 16 * wave, VTw, lane);
        __syncthreads();
        for (int s = 0; s < 8; ++s) {
            if (s < 7) {
                rwkv_prep_step(RW, b, hd, dir, tau0 + (s + 1) * 16, smem + ((s + 1) & 1) * RW_BUF, ka, wave, lane);
                rwkv_prep_vt<1>(RW, b, hd, dir, tau0 + (s + 1) * 16, 16 * wave, VTw + ((s + 1) & 1) * 512, lane);
            }
            rwkv_mfma_step<1, true, true>(X, smem + (s & 1) * RW_BUF, VTw + (s & 1) * 512, Yo, lane);
#pragma unroll
            for (int r = 0; r < 4; ++r) {
                const int row = row_of(b, dir, tau0 + s * 16 + 4 * fq + r);
                if (CHECK) { if (YP[(size_t)row * DM + 512 + hd * 64 + 16 * wave + fr] != f2bf(Yo[0][r])) atomicAdd((unsigned*)(P.ws + OFF_BAR + 15360), 1u); }
                else YP[(size_t)row * DM + 512 + hd * 64 + 16 * wave + fr] = f2bf(Yo[0][r]);
            }
            __syncthreads();
        }
    }
}


#define HG_NCH 34
#define HG_BUF 7168
#define HG_VT0 14336
#define OFF_O_RXP 0ull
#define OFF_O_HXL ((size_t)2176 * 8192)
#define OFF_O_HD (OFF_O_HXL + (size_t)1088 * 16384)
__device__ __forceinline__ float hgrn_prep_step(const bf16_t* Pb, int b, int hd, int dir, int tau_base, unsigned char* buf, float lb, int wave, int lane) {
    bf16_t* QH = (bf16_t*)buf; bf16_t* KC = (bf16_t*)(buf + 2304); bf16_t* KbT = (bf16_t*)(buf + 4608); float* gT = (float*)(buf + 6656);
    float cs[16], fv[16];
    {
        float c = 0.f;
#pragma unroll
        for (int t = 0; t < 16; ++t) {
            const int row = row_of(b, dir, tau_base + t);
            const float f = lb + (1.f - lb) * sigmoidf_(bf2f(Pb[(size_t)row * PIN + 768 + dir * 256 + hd * 64 + lane]));
            fv[t] = f; c += __logf(f); cs[t] = c;
        }
    }
    const float c15 = cs[15];
    if (wave == 0) gT[lane] = __expf(c15);
    bf16_t kb[4];
#pragma unroll
    for (int t = 0; t < 16; ++t) {
        if ((t >> 2) == wave) {
            const int row = row_of(b, dir, tau_base + t);
            const float q = siluf_(bf2f(Pb[(size_t)row * PIN + 256 + hd * 64 + lane]));
            const float ct = cs[t], k = 1.f - fv[t];
            QH[t * 72 + lane] = f2bf(q * __expf(ct));
            KC[t * 72 + lane] = f2bf(k * __expf(fminf(-ct, 80.f)));
            kb[t & 3] = f2bf(k * __expf(c15 - ct));
        }
    }
    uint2 pk; pk.x = kb[0] | ((unsigned)kb[1] << 16); pk.y = kb[2] | ((unsigned)kb[3] << 16);
    *(uint2*)(KbT + lane * 16 + 4 * wave) = pk;
    return c15;
}
__device__ __forceinline__ void hgrn_prep_vt(const bf16_t* Pb, int b, int hd, int dir, int tau_base, int vbase, bf16_t* VT, int lane) {
    const int vl = lane & 15, tq = lane >> 4;
    bf16_t x[4];
#pragma unroll
    for (int i = 0; i < 4; ++i) { const int row = row_of(b, dir, tau_base + tq * 4 + i); x[i] = Pb[(size_t)row * PIN + 512 + hd * 64 + vbase + vl]; }
    uint2 pk; pk.x = x[0] | ((unsigned)x[1] << 16); pk.y = x[2] | ((unsigned)x[3] << 16);
    *(uint2*)(VT + vl * 16 + tq * 4) = pk;
}
template <bool OUT>
__device__ __forceinline__ void hgrn_mfma_step(f32x4 (&X)[4], const unsigned char* buf, const bf16_t* VT, f32x4& Yout, int lane) {
    const bf16_t* QH = (const bf16_t*)buf; const bf16_t* KC = (const bf16_t*)(buf + 2304); const bf16_t* KbT = (const bf16_t*)(buf + 4608); const float* gT = (const float*)(buf + 6656);
    const int fr = lane & 15, fq = lane >> 4;
    const f32x4 z4 = {0.f, 0.f, 0.f, 0.f};
    const bf16x4 vt4 = *(const bf16x4*)(VT + fr * 16 + 4 * fq);
    if (OUT) {
        f32x4 cAT = z4;
#pragma unroll
        for (int ks = 0; ks < 2; ++ks) {
            const bf16x8 kc = *(const bf16x8*)(KC + fr * 72 + 32 * ks + 8 * fq), qh = *(const bf16x8*)(QH + fr * 72 + 32 * ks + 8 * fq);
            cAT = mfma32(kc, qh, cAT);
        }
#pragma unroll
        for (int r = 0; r < 4; ++r) cAT[r] = ((4 * fq + r) <= fr) ? cAT[r] : 0.f;
        const bf16x8 aQ0 = cat8(*(const bf16x4*)(QH + fr * 72 + 4 * fq), *(const bf16x4*)(QH + fr * 72 + 16 + 4 * fq));
        const bf16x8 aQ1 = cat8(*(const bf16x4*)(QH + fr * 72 + 32 + 4 * fq), *(const bf16x4*)(QH + fr * 72 + 48 + 4 * fq));
        const bf16x8 b0 = cat8(to4(X[0]), to4(X[1])), b1 = cat8(to4(X[2]), to4(X[3]));
        f32x4 O = mfma32(aQ1, b1, mfma32(aQ0, b0, z4));
        Yout = mfma16(to4(cAT), vt4, O);
    }
#pragma unroll
    for (int mi = 0; mi < 4; ++mi) {
        const f32x4 g4 = *(const f32x4*)(gT + 16 * mi + 4 * fq);
        const bf16x4 kb4 = *(const bf16x4*)(KbT + (16 * mi + fr) * 16 + 4 * fq);
        X[mi] = mfma16(kb4, vt4, X[mi] * g4);
    }
}
__device__ __forceinline__ float hgrn_lb(const Params& P, int l, int dir, int ch) {
    if (l == 0) return 0.f;
    const float a0 = P.in[22][(dir * 2 + 0) * 256 + ch], a1 = P.in[22][(dir * 2 + 1) * 256 + ch];
    const float m = fmaxf(a0, a1), e0 = __expf(a0 - m), e1 = __expf(a1 - m);
    return e1 / (e0 + e1);
}
template <bool OUT>
__device__ __forceinline__ void hgrn_pass(const Params& P, int l, unsigned char* smem) {
    const int lane = otid() & 63, wave = __builtin_amdgcn_readfirstlane(otid() >> 6), fr = lane & 15, fq = lane >> 4;
    const bf16_t* Pb = (const bf16_t*)(P.ws + OFF_P);
    float* HXL = (float*)((unsigned char*)P.out + OFF_O_HXL);
    float* HD = (float*)((unsigned char*)P.out + OFF_O_HD);
    for (int item = blockIdx.x; item < 32 * HG_NCH; item += gridDim.x) {
        const int seq = item / HG_NCH, c = item % HG_NCH, dir = seq & 1, hd = (seq >> 1) & 3, b = seq >> 3;
        if (OUT && l == 1 && c < 2) continue;
        bf16_t* YP = (bf16_t*)(P.ws + OFF_YP) + (size_t)dir * MROWS * DM;
        const float lb = hgrn_lb(P, l, dir, hd * 64 + lane);
        const int tau0 = c * 128;
        f32x4 X[4], Yo;
#pragma unroll
        for (int mi = 0; mi < 4; ++mi) X[mi] = OUT ? *(const f32x4*)(HXL + (((size_t)item * 16 + mi * 4 + wave) * 64 + lane) * 4) : (f32x4){0.f, 0.f, 0.f, 0.f};
        bf16_t* VTw = (bf16_t*)(smem + HG_VT0 + wave * 1024);
        float ctot = hgrn_prep_step(Pb, b, hd, dir, tau0, smem, lb, wave, lane);
        hgrn_prep_vt(Pb, b, hd, dir, tau0, 16 * wave, VTw, lane);
        __syncthreads();
        for (int s = 0; s < 8; ++s) {
            if (s < 7) {
                ctot += hgrn_prep_step(Pb, b, hd, dir, tau0 + (s + 1) * 16, smem + ((s + 1) & 1) * HG_BUF, lb, wave, lane);
                hgrn_prep_vt(Pb, b, hd, dir, tau0 + (s + 1) * 16, 16 * wave, VTw + ((s + 1) & 1) * 256, lane);
            }
            hgrn_mfma_step<OUT>(X, smem + (s & 1) * HG_BUF, VTw + (s & 1) * 256, Yo, lane);
            if (OUT) {
#pragma unroll
                for (int r = 0; r < 4; ++r) {
                    const int row = row_of(b, dir, tau0 + s * 16 + 4 * fq + r);
                    YP[(size_t)row * DM + 256 + hd * 64 + 16 * wave + fr] = f2bf(Yo[r]);
                }
            }
            __syncthreads();
        }
        if (!OUT) {
#pragma unroll
            for (int mi = 0; mi < 4; ++mi) *(f32x4*)(HXL + (((size_t)item * 16 + mi * 4 + wave) * 64 + lane) * 4) = X[mi];
            if (wave == 0) HD[(size_t)item * 64 + lane] = __expf(ctot);
        }
    }
}
__device__ __forceinline__ void hgrn_carry(const Params& P, int bid, int nb) {
    float* HXL = (float*)((unsigned char*)P.out + OFF_O_HXL);
    const float* HD = (const float*)((unsigned char*)P.out + OFF_O_HD);
    for (int u = bid; u < 128; u += nb) {
        const int gid = u * 256 + otid(), ln = gid & 63, tile = (gid >> 6) & 15, seq = gid >> 10;
        const int mi = tile >> 2, fq = ln >> 4;
        f32x4 x = {0.f, 0.f, 0.f, 0.f};
        for (int c0 = 0; c0 < HG_NCH; c0 += 17) {
            f32x4 L[17];
#pragma unroll
            for (int i = 0; i < 17; ++i) {
                const size_t item = (size_t)seq * HG_NCH + c0 + i;
                L[i] = *(const f32x4*)(HXL + ((item * 16 + tile) * 64 + ln) * 4);
            }
#pragma unroll
            for (int i = 0; i < 17; ++i) {
                const size_t item = (size_t)seq * HG_NCH + c0 + i;
                const f32x4 D = *(const f32x4*)(HD + item * 64 + 16 * mi + 4 * fq);
                *(f32x4*)(HXL + ((item * 16 + tile) * 64 + ln) * 4) = x;
                x = D * x + L[i];
            }
        }
    }
}


__device__ __forceinline__ void phase_rwprep2(const Params& P, int l, unsigned char* smem) {
    const int tid = otid(), lane = tid & 63, wave = __builtin_amdgcn_readfirstlane(tid >> 6), fr = lane & 15, fq = lane >> 4;
    const bf16_t* Pb = (const bf16_t*)(P.ws + OFF_P);
    bf16_t* RW = (bf16_t*)(P.ws + OFF_RW);
    const bf16_t* LW = (const bf16_t*)(P.ws + OFF_LW);
    const float* mu = P.in[24] + l * 1920;
    bf16_t* AL = (bf16_t*)smem;
    float muv[8];
#pragma unroll
    for (int jj = 0; jj < 8; ++jj) muv[jj] = (tid + 256 * jj) < 1920 ? mu[tid + 256 * jj] : 0.f;
    const float kk0 = P.in[30][l * 512 + tid], kk1 = P.in[30][l * 512 + 256 + tid];
    for (int u = blockIdx.x; u < MROWS / 16; u += gridDim.x) {
        const int r0 = u * 16;
        __syncthreads();
        for (int i = 0; i < 16; ++i) {
            const int row = r0 + i, p = row % LTOT;
            int nbr; bool okk;
            {
                const int m = tid & 3;
                if (p < CTX) { nbr = (m & 1) ? row + 1 : row - 1; okk = (m & 1) ? (p < CTX - 1) : (p > 0); }
                else {
                    const int t = p - CTX, gr = t >> 6, gc = t & 63;
                    nbr = m == 0 ? row - 1 : (m == 1 ? row + 1 : (m == 2 ? row - 64 : row + 64));
                    okk = m == 0 ? (gc > 0) : (m == 1 ? (gc < 63) : (m == 2 ? (gr > 0) : (gr < 63)));
                }
            }
            const bf16_t* pp = Pb + (size_t)row * PIN + 1536 + tid;
            const bf16_t* pn = Pb + (size_t)nbr * PIN + 1536 + tid;
            bf16_t* rw = RW + (size_t)row * RWW;
            float sv[8];
#pragma unroll
            for (int jj = 0; jj < 8; ++jj) {
                if (jj < 7 || tid < 128) {
                    const float pv = bf2f(pp[256 * jj]);
                    const float nv = okk ? bf2f(pn[256 * jj]) : 0.f;
                    sv[jj] = pv + muv[jj] * (nv - pv);
                } else sv[jj] = 0.f;
            }
            rw[tid] = f2bf(sv[0]); rw[256 + tid] = f2bf(sv[1]);
            rw[512 + tid] = f2bf(sv[2]); rw[768 + tid] = f2bf(sv[3]);
            rw[1024 + tid] = f2bf(sv[4]); rw[1280 + tid] = f2bf(sv[5]);
            {
                const float a0 = sv[2] * kk0, a1 = sv[3] * kk1;
                const float n0 = fmaxf(sqrtf(wave_sum(a0 * a0)), 1e-12f), n1 = fmaxf(sqrtf(wave_sum(a1 * a1)), 1e-12f);
                rw[1536 + tid] = f2bf(a0 / n0); rw[1792 + tid] = f2bf(a1 / n1);
            }
            if (tid < 128) { rw[4096 + tid] = f2bf(sigmoidf_(sv[6])); AL[((2 + (tid >> 6)) * 16 + i) * 72 + (tid & 63)] = f2bf(sv[7]); }
            else AL[(((tid - 128) >> 6) * 16 + i) * 72 + (tid & 63)] = f2bf(tanhf(sv[6]));
        }
        __syncthreads();
        {
            const int d = wave & 1, isA = wave >> 1;
            const bf16x8 a0 = *(const bf16x8*)(AL + (wave * 16 + fr) * 72 + 8 * fq), a1 = *(const bf16x8*)(AL + (wave * 16 + fr) * 72 + 32 + 8 * fq);
            const bf16_t* W = LW + (size_t)isA * 131072 + (size_t)(l * 2 + d) * 512 * 64;
            const float* bias = P.in[isA ? 27 : 25] + (l * 2 + d) * 512;
            for (int nj = 0; nj < 32; ++nj) {
                const bf16x8 b0 = *(const bf16x8*)(W + (size_t)(16 * nj + fr) * 64 + 8 * fq), b1 = *(const bf16x8*)(W + (size_t)(16 * nj + fr) * 64 + 32 + 8 * fq);
                const f32x4 acc = mfma32(a1, b1, mfma32(a0, b0, (f32x4){0.f, 0.f, 0.f, 0.f}));
                const int c = 16 * nj + fr;
                const float bs = bias[c];
#pragma unroll
                for (int r = 0; r < 4; ++r) {
                    const float sg = sigmoidf_(bs + acc[r]);
                    RW[(size_t)(r0 + 4 * fq + r) * RWW + (isA ? 2048 : 3072) + d * 512 + c] = f2bf(isA ? sg : -0.60653066f * sg);
                }
            }
        }
    }
}
__device__ __forceinline__ void phase_post2(const Params& P, int l) {
    const int tid = otid(), lane = tid & 63, wave = __builtin_amdgcn_readfirstlane(tid >> 6), fr = lane & 15, fq = lane >> 4;
    const bf16_t* Pb = (const bf16_t*)(P.ws + OFF_P);
    const bf16_t* RW = (const bf16_t*)(P.ws + OFF_RW);
    const bf16_t* YF = (const bf16_t*)(P.ws + OFF_YP);
    const bf16_t* YB = YF + (size_t)MROWS * DM;
    const bf16_t* LW = (const bf16_t*)(P.ws + OFF_LW);
    bf16_t* MIX = (bf16_t*)(P.ws + OFF_MIX);
    const f32x4 z4 = {0.f, 0.f, 0.f, 0.f};
    for (int u = blockIdx.x; u < MROWS / 16; u += gridDim.x) {
        const int r0 = u * 16;
        if (l == 1 && (r0 % LTOT) < CTX) continue;
        {
            f32x4 acc[4] = {z4, z4, z4, z4};
            const bf16_t* ap = YF + (size_t)(r0 + fr) * DM + 8 * fq;
            const bf16_t* bp = LW + (size_t)3 * 131072 + (size_t)(l * 256 + 64 * wave + fr) * 256 + 8 * fq;
#pragma unroll
            for (int ks = 0; ks < 8; ++ks) {
                const bf16x8 a = *(const bf16x8*)(ap + 32 * ks);
#pragma unroll
                for (int j = 0; j < 4; ++j) acc[j] = mfma32(a, *(const bf16x8*)(bp + (size_t)(16 * j) * 256 + 32 * ks), acc[j]);
            }
#pragma unroll
            for (int j = 0; j < 4; ++j) {
                const int n = 64 * wave + 16 * j + fr;
                const float gb = P.in[21][l * 256 + n];
#pragma unroll
                for (int r = 0; r < 4; ++r) {
                    const size_t row = (size_t)(r0 + 4 * fq + r);
                    MIX[row * DM + n] = f2bf(bf2f(YF[row * DM + n]) * sigmoidf_(acc[j][r] + gb));
                }
            }
        }
        {
            const int i = tid >> 4, c0 = (tid & 15) * 16; const size_t row = (size_t)(r0 + i);
            float o[16], ss = 0.f;
#pragma unroll
            for (int j = 0; j < 16; ++j) { o[j] = bf2f(YF[row * DM + 256 + c0 + j]) + bf2f(YB[row * DM + 256 + c0 + j]); ss += o[j] * o[j]; }
            ss += __shfl_xor(ss, 1, 64); ss += __shfl_xor(ss, 2, 64);
            const float rs = rsqrtf(ss * (1.f / 64.f) + 1e-6f);
#pragma unroll
            for (int j = 0; j < 16; ++j) {
                const float gr = bf2f(Pb[row * PIN + 1280 + c0 + j]);
                MIX[row * DM + 256 + c0 + j] = f2bf(o[j] * rs * P.in[23][l * 256 + c0 + j] * siluf_(gr));
            }
        }
#pragma unroll 1
        for (int hh = 0; hh < 2; ++hh) {
            const int h = 2 * wave + hh;
            f32x4 g[4] = {z4, z4, z4, z4};
            const bf16_t* ap = RW + (size_t)(r0 + fr) * RWW + 4096 + 8 * fq;
            const bf16_t* bp = LW + (size_t)2 * 131072 + (size_t)(l * 512 + h * 64 + fr) * 128 + 8 * fq;
#pragma unroll
            for (int ks = 0; ks < 4; ++ks) {
                const bf16x8 a = *(const bf16x8*)(ap + 32 * ks);
#pragma unroll
                for (int j = 0; j < 4; ++j) g[j] = mfma32(a, *(const bf16x8*)(bp + (size_t)(16 * j) * 128 + 32 * ks), g[j]);
            }
#pragma unroll
            for (int r = 0; r < 4; ++r) {
                const size_t row = (size_t)(r0 + 4 * fq + r);
                const bf16_t* rw = RW + row * RWW;
                float y[4], vv[4], sum = 0.f, bon = 0.f;
#pragma unroll
                for (int j = 0; j < 4; ++j) {
                    const int c = h * 64 + 16 * j + fr;
                    y[j] = bf2f(YF[row * DM + 512 + c]) + bf2f(YB[row * DM + 512 + c]);
                    sum += y[j];
                    const float rr = bf2f(rw[c]), k = bf2f(rw[512 + c]), af = bf2f(rw[2048 + c]), ab = bf2f(rw[2560 + c]);
                    const float ka = P.in[31][l * 512 + c];
                    vv[j] = bf2f(rw[1024 + c]);
                    bon += rr * P.in[32][l * 512 + c] * k * (2.f + (af + ab - 2.f) * ka);
                }
#pragma unroll
                for (int o = 1; o < 16; o <<= 1) { sum += __shfl_xor(sum, o, 64); bon += __shfl_xor(bon, o, 64); }
                const float mean = sum * (1.f / 64.f);
                float var = 0.f;
#pragma unroll
                for (int j = 0; j < 4; ++j) { const float d = y[j] - mean; var += d * d; }
#pragma unroll
                for (int o = 1; o < 16; o <<= 1) var += __shfl_xor(var, o, 64);
                const float rs = rsqrtf(var * (1.f / 64.f) + 64e-5f);
#pragma unroll
                for (int j = 0; j < 4; ++j) {
                    const int c = h * 64 + 16 * j + fr;
                    const float yn = (y[j] - mean) * rs * P.in[33][l * 512 + c] + P.in[34][l * 512 + c];
                    MIX[row * DM + 512 + c] = f2bf((yn + bon * vv[j]) * g[j][r]);
                }
            }
        }
    }
}

__device__ __forceinline__ void run_phase(const Params& P, int ph, unsigned char* smem) {
#ifndef ONLY
    if (ph == 0) { phase_prep(P, smem); return; }
    if (ph == 1) { phase_mkh(P); return; }
#else
    if (ph < 2) return;
#endif
    const int l = (ph - 2) / PPL, s = (ph - 2) % PPL;
#ifdef ONLY
    if (s != ONLY) return;
#endif
    switch (s) {
    case 0: gemm_bf16((const bf16_t*)(P.ws + OFF_H), DM, (const bf16_t*)(P.ws + OFF_WIN) + (size_t)l * PIN * DM, DM, MROWS, PIN, DM, false, EpiBf16{(bf16_t*)(P.ws + OFF_P), PIN}); break;
    case 1: phase_rwprep2(P, l, smem); s5_passA(P, l); hgrn_pass<false>(P, l, smem); break;
    case 2: rwkv_passA(P, l, smem, blockIdx.x, gridDim.x); s5_carry(P, l, gridDim.x - 1 - blockIdx.x, gridDim.x); hgrn_carry(P, (int)((2 * gridDim.x - 33 - blockIdx.x) % gridDim.x), gridDim.x); break;
    case 3: rwkv_passB(P); s5_passC(P, l); hgrn_pass<true>(P, l, smem); break;
    case 4: rwkv_passC<false>(P, l, smem); break;
    case 5: phase_post2(P, l); break;
    case 6: gemm_bf16((const bf16_t*)(P.ws + OFF_MIX), DM, (const bf16_t*)(P.ws + OFF_WOUT) + (size_t)l * DM * DM, DM, MROWS, DM, DM, l == 1, EpiF32{(float*)(P.ws + OFF_TMP), DM}); break;
    case 7: phase_ln1(P, l); break;
    case 8: gemm_bf16((const bf16_t*)(P.ws + OFF_H2), DM, (const bf16_t*)(P.ws + OFF_WQ) + (size_t)l * 2048 * DM, DM, MROWS, 2048, DM, l == 1, EpiBf16{(bf16_t*)(P.ws + OFF_Q), 2048}); break;
    case 9: phase_topk2(P, l, smem); phase_tabconv(P, l); break;
    case 10: phase_gather(P, l, smem); break;
    }
}

__global__ void __launch_bounds__(256, 2) mega(Params P) {
    __shared__ __attribute__((aligned(16))) unsigned char smem[65536];
#if SINGLE
    cg::grid_group grid = cg::this_grid();
    if (threadIdx.x < 4) ((volatile LAS unsigned*)(smem + 65520))[threadIdx.x] = 0u;
    __syncthreads();
    XcdBarrier xb = xcd_barrier_post((unsigned*)(P.ws + OFF_BAR), (volatile LAS unsigned*)(smem + 65520));
#endif
    for (int ph = P.ph_lo; ph < P.ph_hi; ++ph) {
        run_phase(P, ph, smem);
#if SINGLE
        if (ph + 1 < P.ph_hi) {
            if (ph == 0) { asm volatile("s_waitcnt vmcnt(0)" ::: "memory"); __syncthreads(); grid.sync(); }
            else xcd_barrier(xb);
        }
#ifdef DUPMASK
        if (ph >= 2 && ((DUPMASK >> ((ph - 2) % PPL)) & 1)) { run_phase(P, ph, smem); xcd_barrier(xb); }
#endif
#ifdef EXP_T3
        if (ph >= 2 && (ph - 2) % PPL == 4) { rwkv_passC<true>(P, (ph - 2) / PPL, smem); xcd_barrier(xb); }
#endif
#ifdef EXP_OLDSCAN
        if (ph >= 2 && (ph - 2) % PPL == 4) { const int wv = threadIdx.x >> 6; for (int it = wv * gridDim.x + blockIdx.x; it < 64; it += 4 * gridDim.x) scan_rwkv(P, (ph - 2) / PPL, it); xcd_barrier(xb); }
#endif
#endif
    }
}

extern "C" void kernel_launch(void* const* d_in, const int* in_sizes, int n_in, void* d_out, int out_size, void* d_ws, size_t ws_size, hipStream_t stream) {
    static int grid = 0;
    if (grid == 0) {
        if (n_in != 39 || ws_size < OFF_END) { fprintf(stderr, "kernel_launch: unexpected n_in %d or ws_size %zu (need %zu)\n", n_in, ws_size, (size_t)OFF_END); grid = -1; return; }
        int dev = 0, cus = 0, per_cu = 0;
        hipGetDevice(&dev);
        hipDeviceGetAttribute(&cus, hipDeviceAttributeMultiprocessorCount, dev);
        hipOccupancyMaxActiveBlocksPerMultiprocessor(&per_cu, mega, 256, 0);
        if (per_cu < 1) per_cu = 1;
        if (per_cu > 2) per_cu = 2;
        grid = cus * per_cu;
    }
    if (grid < 0) return;
    hipMemsetAsync((unsigned char*)d_ws + OFF_BAR, 0, 16384, stream);
    Params p{};
    for (int i = 0; i < 39; ++i) p.in[i] = (const float*)d_in[i];
    p.out = (float*)d_out; p.ws = (unsigned char*)d_ws;
#if SINGLE
    p.ph_lo = 0; p.ph_hi = NPH;
    void* args[] = {&p};
    hipError_t e = hipLaunchCooperativeKernel((void*)mega, dim3(grid), dim3(256), args, 0, stream);
    if (e != hipSuccess) fprintf(stderr, "cooperative launch failed: %s (grid %d)\n", hipGetErrorString(e), grid);
#else
    for (int ph = 0; ph < NPH; ++ph) {
        p.ph_lo = ph; p.ph_hi = ph + 1;
        hipLaunchKernelGGL(mega, dim3(grid), dim3(256), 0, stream, p);
    }
#endif
}
```

```cpp
#include <hip/hip_runtime.h>
#include <hip/hip_cooperative_groups.h>
#include <cstdio>
namespace cg = cooperative_groups;

#ifndef SINGLE
#define SINGLE 1
#endif

typedef unsigned short bf16_t;
typedef short bf16x8 __attribute__((ext_vector_type(8)));
typedef float f32x4 __attribute__((ext_vector_type(4)));
typedef __bf16 bf16x2 __attribute__((ext_vector_type(2)));

#define DM 1024
#define NB 4
#define SEQ 4096
#define CTX 256
#define LTOT 4352
#define MROWS 17408
#define PIN 3456
#define RWW 4224
#define NPH 24
#define PPL 11
#define ALPHA 1.41421356237f

#define OFF_XS 0ull
#define OFF_P (OFF_XS + (size_t)MROWS * DM * 4)
#define OFF_RW (OFF_P + (size_t)MROWS * PIN * 2)
#define OFF_YP (OFF_RW + (size_t)MROWS * RWW * 2)
#define OFF_MIX (OFF_YP + (size_t)2 * MROWS * DM * 2)
#define OFF_MOD (OFF_MIX + (size_t)MROWS * DM * 2)
#define OFF_WIN (OFF_MOD + (size_t)2 * 5 * 6144 * 4)
#define OFF_WOUT (OFF_WIN + (size_t)2 * PIN * DM * 2)
#define OFF_WQ (OFF_WOUT + (size_t)2 * DM * DM * 2)
#define OFF_S5MS (OFF_WQ + (size_t)2 * 2048 * DM * 2)
#define OFF_S5MY (OFF_S5MS + (size_t)2 * 16 * 256 * 256 * 2)
#define OFF_S5LB (OFF_S5MY + (size_t)2 * 16 * 256 * 512 * 2)
#define OFF_S5ST (OFF_S5LB + (size_t)2 * 16 * 2 * 128 * 4)
#define OFF_BAR (OFF_S5ST + (size_t)4 * 16 * 272 * 256 * 4)
#define OFF_KEYB (OFF_BAR + 16384)
#define OFF_LW (OFF_KEYB + (size_t)2 * 8 * 2 * 128 * 128 * 2)
#define OFF_END (OFF_LW + (size_t)4 * 131072 * 2)
#define OFF_RXL OFF_MIX
#define OFF_TMP OFF_P
#define OFF_H OFF_YP
#define OFF_H2 (OFF_YP + (size_t)MROWS * DM * 2)
#define OFF_Q OFF_RW
#define OFF_IDX (OFF_RW + (size_t)MROWS * 2048 * 2)
#define OFF_GATE (OFF_IDX + (size_t)MROWS * 128 * 4)
#define OFF_TBU OFF_P
#define OFF_TBV (OFF_P + (size_t)16384 * 1024 * 2)

struct Params {
    const float* in[39];
    float* out;
    unsigned char* ws;
    int ph_lo, ph_hi;
};

__device__ __forceinline__ bf16_t f2bf(float f) {
    unsigned u = __float_as_uint(f);
    u += 0x7FFFu + ((u >> 16) & 1u);
    return (bf16_t)(u >> 16);
}
__device__ __forceinline__ float bf2f(bf16_t h) { return __uint_as_float(((unsigned)h) << 16); }
__device__ __forceinline__ float sigmoidf_(float x) { return 1.f / (1.f + __expf(-x)); }
__device__ __forceinline__ float siluf_(float x) { return x * sigmoidf_(x); }
__device__ __forceinline__ float gelu_tanh(float x) {
    const float u = 0.7978845608028654f * (x + 0.044715f * x * x * x);
    return 0.5f * x * (1.f + tanhf(u));
}
__device__ __forceinline__ float wave_sum(float v) {
#pragma unroll
    for (int o = 32; o > 0; o >>= 1) v += __shfl_xor(v, o, 64);
    return v;
}
typedef short bf16x4 __attribute__((ext_vector_type(4)));
#define RW_NCH 34
#define RW_BUF 13824
#define RW_VT0 27648
__device__ __forceinline__ f32x4 mfma32(bf16x8 a, bf16x8 b, f32x4 c) { return __builtin_amdgcn_mfma_f32_16x16x32_bf16(a, b, c, 0, 0, 0); }
__device__ __forceinline__ f32x4 mfma16(bf16x4 a, bf16x4 b, f32x4 c) {
    bf16x8 a8, b8;
    a8[0] = a[0]; a8[1] = a[1]; a8[2] = a[2]; a8[3] = a[3]; a8[4] = 0; a8[5] = 0; a8[6] = 0; a8[7] = 0;
    b8[0] = b[0]; b8[1] = b[1]; b8[2] = b[2]; b8[3] = b[3]; b8[4] = 0; b8[5] = 0; b8[6] = 0; b8[7] = 0;
    return __builtin_amdgcn_mfma_f32_16x16x32_bf16(a8, b8, c, 0, 0, 0);
}
__device__ __forceinline__ bf16x4 to4(f32x4 v) { bf16x4 o; o[0] = (short)f2bf(v[0]); o[1] = (short)f2bf(v[1]); o[2] = (short)f2bf(v[2]); o[3] = (short)f2bf(v[3]); return o; }
__device__ __forceinline__ bf16x8 cat8(bf16x4 a, bf16x4 b) { bf16x8 o; o[0] = a[0]; o[1] = a[1]; o[2] = a[2]; o[3] = a[3]; o[4] = b[0]; o[5] = b[1]; o[6] = b[2]; o[7] = b[3]; return o; }

__device__ __forceinline__ int otid() { int t = threadIdx.x; asm volatile("" : "+v"(t)); return t; }
__device__ __forceinline__ float rdlane(float v, int l) { return __int_as_float(__builtin_amdgcn_readlane(__float_as_int(v), l)); }
__device__ __forceinline__ int row_of(int b, int dir, int tau) {
    const int p = dir == 0 ? tau : (tau < CTX ? (CTX - 1 - tau) : (LTOT + CTX - 1 - tau));
    return b * LTOT + p;
}
__device__ __forceinline__ int modrow(int row) { const int p = row % LTOT; return p < CTX ? 4 : row / LTOT; }

__device__ __forceinline__ void s5_prep_unit(const Params& P, int l, int g, unsigned char* smem);

#define XB_TMO      128
#define XB_XCNT(j)  (256  + 64 * (j))
#define XB_XSUB(j)  (1280 + 64 * (j))
#define XB_XGEN(j)  (2304 + 64 * (j))
#define XB_TOP      3328
#define XB_TOPGEN   3392
#define XCD_BAR_WORDS 3456
#define XB_SPIN_CAP (1u << 22)
#define LAS __attribute__((address_space(3)))
__device__ __forceinline__ unsigned xb_ld(unsigned* p)              { return __hip_atomic_load(p, __ATOMIC_RELAXED, __HIP_MEMORY_SCOPE_AGENT); }
__device__ __forceinline__ unsigned xb_add(unsigned* p, unsigned v) { return __hip_atomic_fetch_add(p, v, __ATOMIC_RELAXED, __HIP_MEMORY_SCOPE_AGENT); }
__device__ __forceinline__ unsigned xb_xcc_id() { return (unsigned)__builtin_amdgcn_s_getreg((3 << 11) | 20) & 0xFu; }
#define XB_SPIN(cond, bar) do { unsigned _sp = 0; while (cond) { __builtin_amdgcn_s_sleep(1); \
    if ((++_sp & 255u) == 0u) { if (xb_ld(&(bar)[XB_TMO])) break; if (_sp > XB_SPIN_CAP) { atomicAdd(&(bar)[XB_TMO], 1u); break; } } } } while (0)
struct XcdBarrier { unsigned* bar; unsigned x; volatile LAS unsigned* st; };
__device__ __forceinline__ XcdBarrier xcd_barrier_post(unsigned* bar, volatile LAS unsigned* st) {
    XcdBarrier b; b.bar = bar; b.x = xb_xcc_id(); b.st = st;
    if (threadIdx.x == 0) (void)xb_add(&bar[XB_XCNT(b.x)], 1u);
    return b;
}
__device__ __forceinline__ void xcd_barrier_complete(unsigned* bar, unsigned x, unsigned& nloc, unsigned& nx) {
    const unsigned G = gridDim.x * gridDim.y * gridDim.z;
    unsigned sum, cnt, mine, sp = 0u;
    for (;;) {
        sum = 0u; cnt = 0u; mine = 0u;
#pragma unroll
        for (unsigned j = 0; j < 16; ++j) { const unsigned c = xb_ld(&bar[XB_XCNT(j)]); sum += c; cnt += (c > 0u) ? 1u : 0u; mine = (j == x) ? c : mine; }
        if (sum == G) break;
        __builtin_amdgcn_s_sleep(1);
        if ((++sp & 255u) == 0u) { if (xb_ld(&bar[XB_TMO])) break; if (sp > XB_SPIN_CAP) { atomicAdd(&bar[XB_TMO], 1u); break; } }
    }
    nloc = mine > 0u ? mine : 1u; nx = cnt > 0u ? cnt : 1u;
}
__device__ __forceinline__ void xcd_barrier(const XcdBarrier& b) {
    asm volatile("s_waitcnt vmcnt(0)" ::: "memory");
    __syncthreads();
    if (threadIdx.x == 0) {
        unsigned* bar = b.bar;
        __builtin_amdgcn_s_waitcnt(0);
        unsigned nloc = b.st[0], nx = b.st[1];
        if (nloc == 0u) { xcd_barrier_complete(bar, b.x, nloc, nx); b.st[0] = nloc; b.st[1] = nx; }
        const unsigned old = xb_add(&bar[XB_XSUB(b.x)], 1u);
        const unsigned gen = old / nloc;
        if (old + 1u == (gen + 1u) * nloc) {
            __builtin_amdgcn_fence(__ATOMIC_RELEASE, "agent");
            asm volatile("s_waitcnt vmcnt(0)" ::: "memory");
            const unsigned og = xb_add(&bar[XB_TOP], 1u);
            const unsigned tg = og / nx;
            if (og + 1u == (tg + 1u) * nx) xb_add(&bar[XB_TOPGEN], 1u);
            else XB_SPIN(xb_ld(&bar[XB_TOPGEN]) == tg, bar);
            __builtin_amdgcn_fence(__ATOMIC_ACQUIRE, "agent");
            xb_add(&bar[XB_XGEN(b.x)], 1u);
            asm volatile("s_waitcnt vmcnt(0)" ::: "memory");
        } else {
            XB_SPIN(xb_ld(&bar[XB_XGEN(b.x)]) == gen, bar);
            __builtin_amdgcn_fence(__ATOMIC_ACQUIRE, "agent");
            asm volatile("s_waitcnt vmcnt(0)" ::: "memory");
        }
    }
    __syncthreads();
}

__device__ __forceinline__ void phase_prep(const Params& P, unsigned char* smem) {
    const int tid = otid(), lane = tid & 63, wave = __builtin_amdgcn_readfirstlane(tid >> 6);
    float* MOD = (float*)(P.ws + OFF_MOD);
    float* XS = (float*)(P.ws + OFF_XS);
    const int U_MOD = 192, U_COPY = MROWS / 16, U_TIN = 2 * 16 * 54, U_TOUT = 2 * 16 * 16, U_TQ = 2 * 16 * 32;
    const int U_S5 = 32, U_KEY = 64 + 64;
    const int total = U_S5 + U_KEY + U_MOD + U_COPY + U_TIN + U_TOUT + U_TQ;
    for (int u0 = blockIdx.x; u0 < total; u0 += gridDim.x) {
        __syncthreads();
        if (u0 < U_S5) { s5_prep_unit(P, u0 >> 4, u0 & 15, smem); continue; }
        if (u0 < U_S5 + 64) {
            bf16_t* KB = (bf16_t*)(P.ws + OFF_KEYB);
            const size_t base = (size_t)(u0 - U_S5) * 8192;
            for (int i = tid; i < 8192; i += 256) KB[base + i] = f2bf(P.in[36][base + i]);
            continue;
        }
        if (u0 < U_S5 + U_KEY) {
            bf16_t* LW = (bf16_t*)(P.ws + OFF_LW);
            const int base = (u0 - U_S5 - 64) * 8192;
            for (int i = tid; i < 8192; i += 256) {
                const int o = base + i, which = o >> 17, e = o & 131071;
                float v;
                if (which < 2) { const int j = e & 63, c = (e >> 6) & 511, ld = e >> 15; v = P.in[which == 0 ? 26 : 28][((size_t)ld * 64 + j) * 512 + c]; }
                else if (which == 2) { const int j = e & 127, c = (e >> 7) & 511, ll = e >> 16; v = P.in[29][((size_t)ll * 128 + j) * 512 + c]; }
                else { const int k = e & 255, n = (e >> 8) & 255, ll = e >> 16; v = P.in[20][((size_t)ll * 256 + k) * 256 + n]; }
                LW[o] = f2bf(v);
            }
            continue;
        }
        const int u = u0 - U_S5 - U_KEY;
        if (u < U_MOD) {
            const int l = u / 96, j0 = (u % 96) * 64;
            float* sl = (float*)smem;
            for (int i = tid; i < 5 * 1024; i += 256) {
                const int r = i >> 10, k = i & 1023;
                const float cv = r < 4 ? P.in[1][r * 1024 + k] : P.in[3][k];
                sl[i] = siluf_(cv);
            }
            __syncthreads();
            float acc[5] = {0.f, 0.f, 0.f, 0.f, 0.f};
            const float* W = P.in[4] + (size_t)l * 1024 * 6144 + j0 + lane;
            for (int k = wave * 256; k < wave * 256 + 256; ++k) {
                const float w = W[(size_t)k * 6144];
#pragma unroll
                for (int r = 0; r < 5; ++r) acc[r] += sl[r * 1024 + k] * w;
            }
            float* red = (float*)(smem + 5 * 1024 * 4);
#pragma unroll
            for (int r = 0; r < 5; ++r) red[(wave * 5 + r) * 64 + lane] = acc[r];
            __syncthreads();
            for (int i = tid; i < 5 * 64; i += 256) {
                const int r = i / 64, jj = i % 64;
                float s = P.in[5][l * 6144 + j0 + jj];
                for (int w = 0; w < 4; ++w) s += red[(w * 5 + r) * 64 + jj];
                MOD[(l * 5 + r) * 6144 + j0 + jj] = s;
            }
        } else if (u < U_MOD + U_COPY) {
            const int r0 = (u - U_MOD) * 16;
            for (int i = tid; i < 16 * 256; i += 256) {
                const int row = r0 + (i >> 8), c4 = i & 255;
                const int b = row / LTOT, p = row % LTOT;
                const float4* src = p < CTX ? (const float4*)(P.in[2] + ((size_t)b * CTX + p) * DM) : (const float4*)(P.in[0] + ((size_t)b * SEQ + (p - CTX)) * DM);
                ((float4*)(XS + (size_t)row * DM))[c4] = src[c4];
            }
        } else {
            int v = u - U_MOD - U_COPY;
            const float* W; bf16_t* Wt; int N;
            if (v < U_TIN) { const int l = v / (16 * 54); v %= 16 * 54; N = PIN; W = P.in[6] + (size_t)l * 1024 * PIN; Wt = (bf16_t*)(P.ws + OFF_WIN) + (size_t)l * PIN * 1024; }
            else if (v < U_TIN + U_TOUT) { v -= U_TIN; const int l = v / 256; v %= 256; N = 1024; W = P.in[7] + (size_t)l * 1024 * 1024; Wt = (bf16_t*)(P.ws + OFF_WOUT) + (size_t)l * 1024 * 1024; }
            else { v -= U_TIN + U_TOUT; const int l = v / 512; v %= 512; N = 2048; W = P.in[35] + (size_t)l * 1024 * 2048; Wt = (bf16_t*)(P.ws + OFF_WQ) + (size_t)l * 2048 * 1024; }
            const int ntn = N / 64, kt = v / ntn, nt = v % ntn;
            float* t = (float*)smem;
            for (int i = tid; i < 64 * 64; i += 256) { const int kk = i >> 6, nn = i & 63; t[kk * 65 + nn] = W[(size_t)(kt * 64 + kk) * N + nt * 64 + nn]; }
            __syncthreads();
            for (int i = tid; i < 64 * 64; i += 256) { const int nn = i >> 6, kk = i & 63; Wt[(size_t)(nt * 64 + nn) * 1024 + kt * 64 + kk] = f2bf(t[kk * 65 + nn]); }
        }
    }
}

__device__ __forceinline__ void phase_mkh(const Params& P) {
    const int lane = otid() & 63, wave = __builtin_amdgcn_readfirstlane(otid() >> 6);
    const float* XS = (const float*)(P.ws + OFF_XS);
    const float* MOD = (const float*)(P.ws + OFF_MOD);
    bf16_t* H = (bf16_t*)(P.ws + OFF_H);
    for (int row = blockIdx.x * 4 + wave; row < MROWS; row += gridDim.x * 4) {
        const float* mod = MOD + (size_t)(0 * 5 + modrow(row)) * 6144;
#pragma unroll
        for (int j = 0; j < 4; ++j) {
            const int d = 256 * j + 4 * lane;
            const float4 x = *(const float4*)(XS + (size_t)row * DM + d);
            const float4 sh = *(const float4*)(mod + d), sc = *(const float4*)(mod + 1024 + d);
            ushort4 o;
            o.x = f2bf(x.x * (1.f + sc.x) + sh.x); o.y = f2bf(x.y * (1.f + sc.y) + sh.y);
            o.z = f2bf(x.z * (1.f + sc.z) + sh.z); o.w = f2bf(x.w * (1.f + sc.w) + sh.w);
            *(ushort4*)(H + (size_t)row * DM + d) = o;
        }
    }
}

template <class EPI>
__device__ __forceinline__ void gemm_bf16(const bf16_t* A, int lda, const bf16_t* Bt, int ldb, int M, int N, int K, bool skipctx, EPI epi) {
    const int lane = otid() & 63, wave = __builtin_amdgcn_readfirstlane(otid() >> 6);
    const int ntm = M / 128, ntn = N / 128;
    const int fr = lane & 15, fq = lane >> 4;
    for (int tile = blockIdx.x; tile < ntm * ntn; tile += gridDim.x) {
        const int tm = tile / ntn, tn = tile % ntn;
        const int m0 = tm * 128 + (wave >> 1) * 64, n0 = tn * 128 + (wave & 1) * 64;
        if (skipctx && (m0 % LTOT) < CTX) continue;
        f32x4 acc[4][4];
#pragma unroll
        for (int i = 0; i < 4; ++i)
#pragma unroll
            for (int j = 0; j < 4; ++j) acc[i][j] = (f32x4){0.f, 0.f, 0.f, 0.f};
        const bf16_t* ap = A + (size_t)(m0 + fr) * lda + 8 * fq;
        const bf16_t* bp = Bt + (size_t)(n0 + fr) * ldb + 8 * fq;
        for (int k0 = 0; k0 < K; k0 += 32) {
            bf16x8 a[4], b[4];
#pragma unroll
            for (int i = 0; i < 4; ++i) a[i] = *(const bf16x8*)(ap + (size_t)(16 * i) * lda + k0);
#pragma unroll
            for (int j = 0; j < 4; ++j) b[j] = *(const bf16x8*)(bp + (size_t)(16 * j) * ldb + k0);
#pragma unroll
            for (int i = 0; i < 4; ++i)
#pragma unroll
                for (int j = 0; j < 4; ++j) acc[i][j] = __builtin_amdgcn_mfma_f32_16x16x32_bf16(a[i], b[j], acc[i][j], 0, 0, 0);
        }
#pragma unroll
        for (int i = 0; i < 4; ++i)
#pragma unroll
            for (int j = 0; j < 4; ++j)
#pragma unroll
                for (int r = 0; r < 4; ++r) epi(m0 + 16 * i + 4 * fq + r, n0 + 16 * j + fr, acc[i][j][r]);
    }
}

typedef float f32x16 __attribute__((ext_vector_type(16)));
typedef unsigned u32x4 __attribute__((ext_vector_type(4)));
#define G2_LD 72
template <class EPI>
__device__ __forceinline__ void gemm2_bf16(const bf16_t* A, int lda, const bf16_t* Bt, int ldb, int M, int N, int K, bool skipctx, EPI epi, unsigned char* smem) {
    const int tid = otid(), lane = tid & 63, wave = __builtin_amdgcn_readfirstlane(tid >> 6);
    const int ntm = M / 128, ntn = N / 128;
    bf16_t* As = (bf16_t*)smem;
    bf16_t* Bs = As + 128 * G2_LD;
    const int lr = tid >> 3, lc = (tid & 7) * 8;
    const int wm = (wave >> 1) * 64, wn = (wave & 1) * 64;
    const int fr = lane & 31, fh = lane >> 5;
    for (int tile = blockIdx.x; tile < ntm * ntn; tile += gridDim.x) {
        const int tm = tile / ntn, tn = tile % ntn;
        if (skipctx && ((tm * 128) % LTOT) < CTX) continue;
        const bf16_t* ag = A + (size_t)(tm * 128 + lr) * lda + lc;
        const bf16_t* bg = Bt + (size_t)(tn * 128 + lr) * ldb + lc;
        f32x16 acc[2][2];
        {
            const f32x16 z16 = {0.f, 0.f, 0.f, 0.f, 0.f, 0.f, 0.f, 0.f, 0.f, 0.f, 0.f, 0.f, 0.f, 0.f, 0.f, 0.f};
            acc[0][0] = z16; acc[0][1] = z16; acc[1][0] = z16; acc[1][1] = z16;
        }
        u32x4 ra[4], rb[4];
#pragma unroll
        for (int i = 0; i < 4; ++i) { ra[i] = *(const u32x4*)(ag + (size_t)(32 * i) * lda); rb[i] = *(const u32x4*)(bg + (size_t)(32 * i) * ldb); }
        for (int k0 = 0; k0 < K; k0 += 64) {
            __syncthreads();
#pragma unroll
            for (int i = 0; i < 4; ++i) { *(u32x4*)(As + (lr + 32 * i) * G2_LD + lc) = ra[i]; *(u32x4*)(Bs + (lr + 32 * i) * G2_LD + lc) = rb[i]; }
            __syncthreads();
            {
                const int kn = (k0 + 64 < K) ? k0 + 64 : 0;
#pragma unroll
                for (int i = 0; i < 4; ++i) { ra[i] = *(const u32x4*)(ag + (size_t)(32 * i) * lda + kn); rb[i] = *(const u32x4*)(bg + (size_t)(32 * i) * ldb + kn); }
            }
#pragma unroll
            for (int kk = 0; kk < 4; ++kk) {
                bf16x8 a[2], b[2];
#pragma unroll
                for (int i = 0; i < 2; ++i) a[i] = *(const bf16x8*)(As + (wm + 32 * i + fr) * G2_LD + 16 * kk + 8 * fh);
#pragma unroll
                for (int j = 0; j < 2; ++j) b[j] = *(const bf16x8*)(Bs + (wn + 32 * j + fr) * G2_LD + 16 * kk + 8 * fh);
#pragma unroll
                for (int i = 0; i < 2; ++i)
#pragma unroll
                    for (int j = 0; j < 2; ++j) acc[i][j] = __builtin_amdgcn_mfma_f32_32x32x16_bf16(a[i], b[j], acc[i][j], 0, 0, 0);
            }
        }
#pragma unroll
        for (int i = 0; i < 2; ++i)
#pragma unroll
            for (int j = 0; j < 2; ++j)
#pragma unroll
                for (int q = 0; q < 16; ++q) epi(tm * 128 + wm + 32 * i + (q & 3) + 8 * (q >> 2) + 4 * fh, tn * 128 + wn + 32 * j + fr, acc[i][j][q]);
    }
}
struct EpiBf16 { bf16_t* C; int ldc; __device__ __forceinline__ void operator()(int r, int c, float v) const { C[(size_t)r * ldc + c] = f2bf(v); } };
struct EpiF32 { float* C; int ldc; __device__ __forceinline__ void operator()(int r, int c, float v) const { C[(size_t)r * ldc + c] = v; } };

__device__ __forceinline__ void phase_rwprep(const Params& P, int l, unsigned char* smem) {
    const int tid = otid();
    const bf16_t* Pb = (const bf16_t*)(P.ws + OFF_P);
    bf16_t* RW = (bf16_t*)(P.ws + OFF_RW);
    const float* mu = P.in[24] + l * 1920;
    const float* k_k = P.in[30] + l * 512;
    float* tw = (float*)smem;
    float* al = tw + 2 * 8 * 64;
    float* kk2 = al + 2 * 8 * 64;
    float* nrm = kk2 + 8 * 512;
    for (int u = blockIdx.x; u < MROWS / 8; u += gridDim.x) {
        const int r0 = u * 8;
        __syncthreads();
        for (int i = 0; i < 8; ++i) {
            const int row = r0 + i, p = row % LTOT;
            int nb[4]; bool ok[4];
            if (p < CTX) {
                nb[0] = row - 1; ok[0] = p > 0; nb[1] = row + 1; ok[1] = p < CTX - 1; nb[2] = nb[0]; ok[2] = ok[0]; nb[3] = nb[1]; ok[3] = ok[1];
            } else {
                const int t = p - CTX, gr = t >> 6, gc = t & 63;
                nb[0] = row - 1; ok[0] = gc > 0; nb[1] = row + 1; ok[1] = gc < 63; nb[2] = row - 64; ok[2] = gr > 0; nb[3] = row + 64; ok[3] = gr < 63;
            }
            for (int c = tid; c < 1920; c += 256) {
                const int m = c & 3;
                const float pv = bf2f(Pb[(size_t)row * PIN + 1536 + c]);
                const float nv = ok[m] ? bf2f(Pb[(size_t)nb[m] * PIN + 1536 + c]) : 0.f;
                const float s = pv + mu[c] * (nv - pv);
                bf16_t* rw = RW + (size_t)row * RWW;
                if (c < 512) rw[c] = f2bf(s);
                else if (c < 1024) { rw[c] = f2bf(s); kk2[i * 512 + (c - 512)] = s * k_k[c - 512]; }
                else if (c < 1536) rw[c] = f2bf(s);
                else if (c < 1664) rw[4096 + (c - 1536)] = f2bf(sigmoidf_(s));
                else if (c < 1728) tw[(0 * 8 + i) * 64 + (c - 1664)] = tanhf(s);
                else if (c < 1792) tw[(1 * 8 + i) * 64 + (c - 1728)] = tanhf(s);
                else if (c < 1856) al[(0 * 8 + i) * 64 + (c - 1792)] = s;
                else al[(1 * 8 + i) * 64 + (c - 1856)] = s;
            }
        }
        __syncthreads();
        {
            const int pair = tid >> 2, q = tid & 3, i = pair >> 3, hd = pair & 7;
            float s = 0.f;
            for (int j = 0; j < 16; ++j) { const float v = kk2[i * 512 + hd * 64 + q * 16 + j]; s += v * v; }
            s += __shfl_xor(s, 1, 64); s += __shfl_xor(s, 2, 64);
            if (q == 0) nrm[pair] = fmaxf(sqrtf(s), 1e-12f);
        }
        __syncthreads();
        for (int e = tid; e < 8 * 512; e += 256) {
            const int i = e >> 9, c = e & 511;
            RW[(size_t)(r0 + i) * RWW + 1536 + c] = f2bf(kk2[e] / nrm[i * 8 + (c >> 6)]);
        }
        for (int d = 0; d < 2; ++d) {
            const float* wup = P.in[26] + (size_t)(l * 2 + d) * 64 * 512;
            const float* aup = P.in[28] + (size_t)(l * 2 + d) * 64 * 512;
            const float* w0 = P.in[25] + (l * 2 + d) * 512;
            const float* a0 = P.in[27] + (l * 2 + d) * 512;
            float zw[2][8], za[2][8];
#pragma unroll
            for (int i = 0; i < 8; ++i) { zw[0][i] = zw[1][i] = za[0][i] = za[1][i] = 0.f; }
            for (int j = 0; j < 64; ++j) {
                const float w_0 = wup[j * 512 + tid], w_1 = wup[j * 512 + tid + 256];
                const float a_0 = aup[j * 512 + tid], a_1 = aup[j * 512 + tid + 256];
#pragma unroll
                for (int i = 0; i < 8; ++i) {
                    const float t = tw[(d * 8 + i) * 64 + j], a = al[(d * 8 + i) * 64 + j];
                    zw[0][i] += t * w_0; zw[1][i] += t * w_1; za[0][i] += a * a_0; za[1][i] += a * a_1;
                }
            }
#pragma unroll
            for (int i = 0; i < 8; ++i) {
                bf16_t* rw = RW + (size_t)(r0 + i) * RWW;
#pragma unroll
                for (int h = 0; h < 2; ++h) {
                    const int c = tid + 256 * h;
                    rw[2048 + d * 512 + c] = f2bf(sigmoidf_(a0[c] + za[h][i]));
                    rw[3072 + d * 512 + c] = f2bf(-0.60653066f * sigmoidf_(w0[c] + zw[h][i]));
                }
            }
        }
    }
}

__device__ __forceinline__ void scan_rwkv(const Params& P, int l, int item) {
    const int lane = otid() & 63;
    const int dir = item & 1, hd = (item >> 1) & 7, b = item >> 4;
    const bf16_t* RW = (const bf16_t*)(P.ws + OFF_RW);
    bf16_t* YP = (bf16_t*)(P.ws + OFF_YP) + (size_t)dir * MROWS * DM;
    const float ka = P.in[31][l * 512 + hd * 64 + lane];
    float S[64];
#pragma unroll
    for (int k = 0; k < 64; ++k) S[k] = 0.f;
    for (int tau = 0; tau < LTOT; ++tau) {
        const int row = row_of(b, dir, tau);
#ifdef EXP_T2
        if ((tau & 127) == 0) {
            float* RXL = (float*)(P.ws + OFF_RXL);
            const size_t itm = (size_t)item * 34 + (tau >> 7);
#pragma unroll
            for (int kk = 0; kk < 64; ++kk) RXL[((itm * 16 + (kk >> 4) * 4 + (lane >> 4)) * 64 + ((kk >> 2) & 3) * 16 + (lane & 15)) * 4 + (kk & 3)] = S[kk];
        }
#endif
        const bf16_t* rw = RW + (size_t)row * RWW + hd * 64 + lane;
        const float r = bf2f(rw[0]), k = bf2f(rw[512]), v = bf2f(rw[1024]), kap = bf2f(rw[1536]);
        const float a = bf2f(rw[2048 + dir * 512]), lw = bf2f(rw[3072 + dir * 512]);
        const float w = __expf(lw), kt = k * (1.f + (a - 1.f) * ka), beta = kap * a;
        float sk = 0.f;
#pragma unroll
        for (int kk = 0; kk < 64; ++kk) { sk += S[kk] * rdlane(kap, kk); if ((kk & 7) == 7) __builtin_amdgcn_sched_barrier(0); }
        float y = 0.f;
#pragma unroll
        for (int kk = 0; kk < 64; ++kk) {
            const float s = S[kk] * rdlane(w, kk) - sk * rdlane(beta, kk) + v * rdlane(kt, kk);
            S[kk] = s;
            y += s * rdlane(r, kk);
            if ((kk & 3) == 3) __builtin_amdgcn_sched_barrier(0);
        }
        YP[(size_t)row * DM + 512 + hd * 64 + lane] = f2bf(y);
    }
}
__device__ __forceinline__ void scan_hgrn(const Params& P, int l, int item) {
    const int lane = otid() & 63;
    const int dir = item & 1, hd = (item >> 1) & 3, b = item >> 3;
    const bf16_t* Pb = (const bf16_t*)(P.ws + OFF_P);
    bf16_t* YP = (bf16_t*)(P.ws + OFF_YP) + (size_t)dir * MROWS * DM;
    float lb = 0.f;
    if (l == 1) {
        const float a0 = P.in[22][(dir * 2 + 0) * 256 + hd * 64 + lane], a1 = P.in[22][(dir * 2 + 1) * 256 + hd * 64 + lane];
        const float m = fmaxf(a0, a1), e0 = __expf(a0 - m), e1 = __expf(a1 - m);
        lb = e1 / (e0 + e1);
    }
    float S[64];
#pragma unroll
    for (int k = 0; k < 64; ++k) S[k] = 0.f;
    for (int tau = 0; tau < LTOT; ++tau) {
        const int row = row_of(b, dir, tau);
        const bf16_t* pr = Pb + (size_t)row * PIN + 256 + hd * 64 + lane;
        const float q = siluf_(bf2f(pr[0])), v = bf2f(pr[256]);
        const float f = lb + (1.f - lb) * sigmoidf_(bf2f(pr[512 + dir * 256]));
        const float kq = 1.f - f;
        float o = 0.f;
#pragma unroll
        for (int dk = 0; dk < 64; ++dk) {
            const float s = rdlane(f, dk) * S[dk] + rdlane(kq, dk) * v;
            S[dk] = s;
            o += s * rdlane(q, dk);
            if ((dk & 7) == 7) __builtin_amdgcn_sched_barrier(0);
        }
        YP[(size_t)row * DM + 256 + hd * 64 + lane] = f2bf(o);
    }
}
__device__ __forceinline__ void scan_s5(const Params& P, int l, int item) {
    const int lane = otid() & 63;
    const int dir = item & 1, g = (item >> 1) & 15, b = item >> 5;
    const bf16_t* Pb = (const bf16_t*)(P.ws + OFF_P);
    bf16_t* YP = (bf16_t*)(P.ws + OFF_YP) + (size_t)dir * MROWS * DM;
    const int ldg = (l * 2 + dir) * 16 + g;
    const float dt = expf(P.in[14][ldg]);
    const float lre = P.in[12][ldg * 64 + lane], lim = P.in[13][ldg * 64 + lane];
    const float mag = expf(lre * dt), ang = lim * dt;
    const float lb_re = mag * cosf(ang), lb_im = mag * sinf(ang);
    const float den = lre * lre + lim * lim, nr = lb_re - 1.f, ni = lb_im;
    const float co_re = (nr * lre + ni * lim) / den, co_im = (ni * lre - nr * lim) / den;
    float bb_re[16], bb_im[16], c_re[16], c_im[16];
#pragma unroll
    for (int h = 0; h < 16; ++h) {
        const float br = P.in[15][((size_t)ldg * 64 + lane) * 16 + h], bi = P.in[16][((size_t)ldg * 64 + lane) * 16 + h];
        bb_re[h] = co_re * br - co_im * bi; bb_im[h] = co_re * bi + co_im * br;
        c_re[h] = P.in[17][((size_t)ldg * 16 + h) * 64 + lane]; c_im[h] = P.in[18][((size_t)ldg * 16 + h) * 64 + lane];
    }
    float s_re = 0.f, s_im = 0.f;
    for (int tau = 0; tau < LTOT; ++tau) {
        const int row = row_of(b, dir, tau);
        const float uv = bf2f(Pb[(size_t)row * PIN + g * 16 + (lane & 15)]);
        float bu_re = 0.f, bu_im = 0.f;
#pragma unroll
        for (int h = 0; h < 16; ++h) { const float uh = rdlane(uv, h); bu_re += bb_re[h] * uh; bu_im += bb_im[h] * uh; }
        const float n_re = lb_re * s_re - lb_im * s_im + bu_re, n_im = lb_re * s_im + lb_im * s_re + bu_im;
        s_re = n_re; s_im = n_im;
        float yo = 0.f;
#pragma unroll
        for (int h = 0; h < 16; ++h) { const float t = wave_sum(c_re[h] * s_re - c_im[h] * s_im); yo = (lane == h) ? t : yo; }
        if (lane < 16) YP[(size_t)row * DM + g * 16 + lane] = f2bf(yo);
    }
}
__device__ __forceinline__ void phase_scans(const Params& P, int l) {
    const int wave = __builtin_amdgcn_readfirstlane(otid() >> 6);
    for (int it = wave * gridDim.x + blockIdx.x; it < 32; it += 4 * gridDim.x) scan_hgrn(P, l, it);
}

__device__ __forceinline__ void phase_post(const Params& P, int l, unsigned char* smem) {
    const int tid = otid();
    const bf16_t* Pb = (const bf16_t*)(P.ws + OFF_P);
    const bf16_t* RW = (const bf16_t*)(P.ws + OFF_RW);
    const bf16_t* YF = (const bf16_t*)(P.ws + OFF_YP);
    const bf16_t* YB = YF + (size_t)MROWS * DM;
    bf16_t* MIX = (bf16_t*)(P.ws + OFF_MIX);
    float* ypre = (float*)smem;
    float* sg = ypre + 8 * 256;
    for (int u = blockIdx.x; u < MROWS / 8; u += gridDim.x) {
        const int r0 = u * 8;
        if (l == 1 && (r0 % LTOT) < CTX) continue;
        __syncthreads();
        for (int i = 0; i < 8; ++i) {
            const int row = r0 + i;
            ypre[i * 256 + tid] = bf2f(YF[(size_t)row * DM + tid]);
        }
        for (int e = tid; e < 8 * 128; e += 256) sg[e] = bf2f(RW[(size_t)(r0 + (e >> 7)) * RWW + 4096 + (e & 127)]);
        __syncthreads();
        {
            float z[8];
            const float gb = P.in[21][l * 256 + tid];
#pragma unroll
            for (int i = 0; i < 8; ++i) z[i] = gb;
            const float* gw = P.in[20] + (size_t)l * 256 * 256 + tid;
            for (int k = 0; k < 256; ++k) {
                const float w = gw[k * 256];
#pragma unroll
                for (int i = 0; i < 8; ++i) z[i] += ypre[i * 256 + k] * w;
            }
#pragma unroll
            for (int i = 0; i < 8; ++i) MIX[(size_t)(r0 + i) * DM + tid] = f2bf(ypre[i * 256 + tid] * sigmoidf_(z[i]));
        }
        {
            const int i = tid >> 5, c0 = (tid & 31) * 8, row = r0 + i;
            float o[8], ss = 0.f;
#pragma unroll
            for (int j = 0; j < 8; ++j) { o[j] = bf2f(YF[(size_t)row * DM + 256 + c0 + j]) + bf2f(YB[(size_t)row * DM + 256 + c0 + j]); ss += o[j] * o[j]; }
            ss += __shfl_xor(ss, 1, 64); ss += __shfl_xor(ss, 2, 64); ss += __shfl_xor(ss, 4, 64);
            const float rs = rsqrtf(ss * (1.f / 64.f) + 1e-6f);
#pragma unroll
            for (int j = 0; j < 8; ++j) {
                const float gr = bf2f(Pb[(size_t)row * PIN + 256 + 1024 + c0 + j]);
                MIX[(size_t)row * DM + 256 + c0 + j] = f2bf(o[j] * rs * P.in[23][l * 256 + c0 + j] * siluf_(gr));
            }
        }
        {
            const int i = tid >> 5, c0 = (tid & 31) * 16, row = r0 + i;
            const bf16_t* rw = RW + (size_t)row * RWW;
            float y[16], vv[16], sum = 0.f, bon = 0.f;
#pragma unroll
            for (int j = 0; j < 16; ++j) {
                const int c = c0 + j;
                y[j] = bf2f(YF[(size_t)row * DM + 512 + c]) + bf2f(YB[(size_t)row * DM + 512 + c]);
                sum += y[j];
                const float r = bf2f(rw[c]), k = bf2f(rw[512 + c]), af = bf2f(rw[2048 + c]), ab = bf2f(rw[2560 + c]);
                const float ka = P.in[31][l * 512 + c];
                vv[j] = bf2f(rw[1024 + c]);
                bon += r * P.in[32][l * 512 + c] * (k * (1.f + (af - 1.f) * ka) + k * (1.f + (ab - 1.f) * ka));
            }
            sum += __shfl_xor(sum, 1, 64); sum += __shfl_xor(sum, 2, 64);
            bon += __shfl_xor(bon, 1, 64); bon += __shfl_xor(bon, 2, 64);
            const float mean = sum * (1.f / 64.f);
            float var = 0.f;
#pragma unroll
            for (int j = 0; j < 16; ++j) { const float d = y[j] - mean; var += d * d; }
            var += __shfl_xor(var, 1, 64); var += __shfl_xor(var, 2, 64);
            const float rs = rsqrtf(var * (1.f / 64.f) + 64e-5f);
            float g[16];
#pragma unroll
            for (int j = 0; j < 16; ++j) g[j] = 0.f;
            const float* gup = P.in[29] + (size_t)l * 128 * 512 + c0;
            for (int jj = 0; jj < 128; ++jj) {
                const float s = sg[i * 128 + jj];
                const float4 w0 = *(const float4*)(gup + jj * 512), w1 = *(const float4*)(gup + jj * 512 + 4), w2 = *(const float4*)(gup + jj * 512 + 8), w3 = *(const float4*)(gup + jj * 512 + 12);
                g[0] += s * w0.x; g[1] += s * w0.y; g[2] += s * w0.z; g[3] += s * w0.w;
                g[4] += s * w1.x; g[5] += s * w1.y; g[6] += s * w1.z; g[7] += s * w1.w;
                g[8] += s * w2.x; g[9] += s * w2.y; g[10] += s * w2.z; g[11] += s * w2.w;
                g[12] += s * w3.x; g[13] += s * w3.y; g[14] += s * w3.z; g[15] += s * w3.w;
            }
#pragma unroll
            for (int j = 0; j < 16; ++j) {
                const int c = c0 + j;
                const float yn = (y[j] - mean) * rs * P.in[33][l * 512 + c] + P.in[34][l * 512 + c];
                MIX[(size_t)row * DM + 512 + c] = f2bf((yn + bon * vv[j]) * g[j]);
            }
        }
    }
}

__device__ __forceinline__ void phase_ln1(const Params& P, int l) {
    const int lane = otid() & 63, wave = __builtin_amdgcn_readfirstlane(otid() >> 6);
    float* XS = (float*)(P.ws + OFF_XS);
    const float* TMP = (const float*)(P.ws + OFF_TMP);
    const float* MOD = (const float*)(P.ws + OFF_MOD);
    bf16_t* H2 = (bf16_t*)(P.ws + OFF_H2);
    for (int row = blockIdx.x * 4 + wave; row < MROWS; row += gridDim.x * 4) {
        if (l == 1 && (row % LTOT) < CTX) continue;
        const float* mod = MOD + (size_t)(l * 5 + modrow(row)) * 6144;
        float v[16]; float s = 0.f;
#pragma unroll
        for (int j = 0; j < 4; ++j) {
            const int d = 256 * j + 4 * lane;
            const float4 x = *(const float4*)(XS + (size_t)row * DM + d), t = *(const float4*)(TMP + (size_t)row * DM + d), g = *(const float4*)(mod + 2048 + d);
            v[4 * j + 0] = ALPHA * x.x + g.x * t.x; v[4 * j + 1] = ALPHA * x.y + g.y * t.y; v[4 * j + 2] = ALPHA * x.z + g.z * t.z; v[4 * j + 3] = ALPHA * x.w + g.w * t.w;
            s += v[4 * j] + v[4 * j + 1] + v[4 * j + 2] + v[4 * j + 3];
        }
        const float mean = wave_sum(s) * (1.f / 1024.f);
        float q = 0.f;
#pragma unroll
        for (int j = 0; j < 16; ++j) { const float d = v[j] - mean; q += d * d; }
        const float rs = rsqrtf(wave_sum(q) * (1.f / 1024.f) + 1e-5f);
#pragma unroll
        for (int j = 0; j < 4; ++j) {
            const int d = 256 * j + 4 * lane;
            const float4 gg = *(const float4*)(P.in[8] + l * 1024 + d), bb = *(const float4*)(P.in[9] + l * 1024 + d);
            const float4 sh = *(const float4*)(mod + 3072 + d), sc = *(const float4*)(mod + 4096 + d);
            float4 o;
            o.x = (v[4 * j + 0] - mean) * rs * gg.x + bb.x; o.y = (v[4 * j + 1] - mean) * rs * gg.y + bb.y;
            o.z = (v[4 * j + 2] - mean) * rs * gg.z + bb.z; o.w = (v[4 * j + 3] - mean) * rs * gg.w + bb.w;
            *(float4*)(XS + (size_t)row * DM + d) = o;
            ushort4 h;
            h.x = f2bf(o.x * (1.f + sc.x) + sh.x); h.y = f2bf(o.y * (1.f + sc.y) + sh.y); h.z = f2bf(o.z * (1.f + sc.z) + sh.z); h.w = f2bf(o.w * (1.f + sc.w) + sh.w);
            *(ushort4*)(H2 + (size_t)row * DM + d) = h;
        }
    }
}

__device__ __forceinline__ unsigned f2ord(float f) { const unsigned u = __float_as_uint(f); return u ^ ((u >> 31) ? 0xFFFFFFFFu : 0x80000000u); }
__device__ __forceinline__ float ord2f(unsigned u) { return __uint_as_float((u >> 31) ? (u ^ 0x80000000u) : ~u); }
__device__ __forceinline__ void phase_topk(const Params& P, int l) {
    const int tid = otid();
    const bf16_t* Q = (const bf16_t*)(P.ws + OFF_Q);
    int* IDX = (int*)(P.ws + OFF_IDX);
    float* GATE = (float*)(P.ws + OFF_GATE);
    for (int u = blockIdx.x; u < 8 * (MROWS / 256); u += gridDim.x) {
        const int hd = u / (MROWS / 256), rb = u % (MROWS / 256);
        const int row = rb * 256 + tid;
        if (l == 1 && (row % LTOT) < CTX) continue;
        unsigned top[2][16];
#pragma unroll
        for (int half = 0; half < 2; ++half) {
            float q[128];
            const bf16_t* qp = Q + (size_t)row * 2048 + hd * 256 + half * 128;
#pragma unroll
            for (int d8 = 0; d8 < 16; ++d8) {
                const bf16x8 v = *(const bf16x8*)(qp + d8 * 8);
#pragma unroll
                for (int j = 0; j < 8; ++j) q[d8 * 8 + j] = bf2f((bf16_t)v[j]);
            }
#pragma unroll
            for (int j = 0; j < 16; ++j) top[half][j] = 0u;
            const float* kp = P.in[36] + ((size_t)((l * 8 + hd) * 2 + half)) * 128 * 128;
            for (int key = 0; key < 128; ++key) {
                const float* kr = kp + key * 128;
                float s0 = 0.f, s1 = 0.f, s2 = 0.f, s3 = 0.f;
#pragma unroll
                for (int d = 0; d < 128; d += 4) { s0 += q[d] * kr[d]; s1 += q[d + 1] * kr[d + 1]; s2 += q[d + 2] * kr[d + 2]; s3 += q[d + 3] * kr[d + 3]; if ((d & 31) == 28) __builtin_amdgcn_sched_barrier(0); }
                unsigned x = (f2ord((s0 + s1) + (s2 + s3)) & 0xFFFFFF80u) | (unsigned)(127 - key);
#pragma unroll
                for (int j = 0; j < 16; ++j) { const unsigned t = top[half][j]; const unsigned mx = x > t ? x : t; x = x > t ? t : x; top[half][j] = mx; }
            }
        }
        float cs[16]; int ce[16];
#pragma unroll
        for (int j = 0; j < 16; ++j) { cs[j] = -3.0e38f; ce[j] = 0; }
#pragma unroll
        for (int i = 0; i < 16; ++i) {
            const float s1v = ord2f(top[0][i] & 0xFFFFFF80u); const int i1 = 127 - (int)(top[0][i] & 127u);
#pragma unroll
            for (int j = 0; j < 16; ++j) {
                if ((i + 1) * (j + 1) <= 16) {
                    float x = s1v + ord2f(top[1][j] & 0xFFFFFF80u); int xe = i1 * 128 + (127 - (int)(top[1][j] & 127u));
#pragma unroll
                    for (int t = 0; t < 16; ++t) {
                        const bool gt = x > cs[t];
                        const float ts = cs[t]; const int te = ce[t];
                        cs[t] = gt ? x : ts; ce[t] = gt ? xe : te; x = gt ? ts : x; xe = gt ? te : xe;
                    }
                }
            }
        }
        float den = 0.f, ex[16];
#pragma unroll
        for (int t = 0; t < 16; ++t) { ex[t] = __expf(cs[t] - cs[0]); den += ex[t]; }
        const float inv = 1.f / den;
#pragma unroll
        for (int t = 0; t < 16; ++t) { IDX[(size_t)row * 128 + hd * 16 + t] = ce[t]; GATE[(size_t)row * 128 + hd * 16 + t] = ex[t] * inv; }
    }
}


__device__ __forceinline__ void ce_desc(unsigned& a, unsigned& b) { const unsigned hi = a > b ? a : b, lo = a > b ? b : a; a = hi; b = lo; }
__device__ __forceinline__ void bitonic_sort16(unsigned (&u)[16]) {
#pragma unroll
    for (int k = 2; k <= 16; k <<= 1)
#pragma unroll
        for (int j = k >> 1; j > 0; j >>= 1)
#pragma unroll
            for (int i = 0; i < 16; ++i) {
                const int p = i ^ j;
                if (p > i) { if ((i & k) == 0) ce_desc(u[i], u[p]); else ce_desc(u[p], u[i]); }
            }
}
__device__ __forceinline__ void bitonic_merge16(unsigned (&u)[16]) {
#pragma unroll
    for (int j = 8; j > 0; j >>= 1)
#pragma unroll
        for (int i = 0; i < 16; ++i) { const int p = i ^ j; if (p > i) ce_desc(u[i], u[p]); }
}
__device__ __forceinline__ void xlane_top16(unsigned (&u)[16], int xr) {
    unsigned o[16];
#pragma unroll
    for (int i = 0; i < 16; ++i) o[i] = (unsigned)__shfl_xor((int)u[15 - i], xr, 64);
#pragma unroll
    for (int i = 0; i < 16; ++i) u[i] = u[i] > o[i] ? u[i] : o[i];
    bitonic_merge16(u);
}
__device__ __forceinline__ void phase_topk2(const Params& P, int l, unsigned char* smem) {
    const int lane = otid() & 63, wave = __builtin_amdgcn_readfirstlane(otid() >> 6), fr = lane & 15, fq = lane >> 4;
    const bf16_t* Q = (const bf16_t*)(P.ws + OFF_Q);
    const bf16_t* KB = (const bf16_t*)(P.ws + OFF_KEYB);
    int* IDX = (int*)(P.ws + OFF_IDX);
    float* GATE = (float*)(P.ws + OFF_GATE);
    unsigned char* ids = smem + wave * 512;
    for (int it = blockIdx.x * 4 + wave; it < (MROWS / 16) * 8; it += gridDim.x * 4) {
        const int rt = it >> 3, hd = it & 7, row0 = rt * 16;
        if (l == 1 && (row0 % LTOT) < CTX) continue;
        unsigned top[2][16];
#pragma unroll
        for (int half = 0; half < 2; ++half) {
            f32x4 acc[8];
#pragma unroll
            for (int mi = 0; mi < 8; ++mi) acc[mi] = (f32x4){0.f, 0.f, 0.f, 0.f};
            const bf16_t* kp = KB + ((size_t)((l * 8 + hd) * 2 + half) * 128 + fr) * 128 + 8 * fq;
            const bf16_t* qp = Q + (size_t)(row0 + fr) * 2048 + hd * 256 + half * 128 + 8 * fq;
#pragma unroll
            for (int ks = 0; ks < 4; ++ks) {
                const bf16x8 qb = *(const bf16x8*)(qp + 32 * ks);
#pragma unroll
                for (int mi = 0; mi < 8; ++mi) acc[mi] = mfma32(*(const bf16x8*)(kp + (size_t)(16 * mi) * 128 + 32 * ks), qb, acc[mi]);
            }
            unsigned ua[16], ub[16];
#pragma unroll
            for (int mi = 0; mi < 4; ++mi)
#pragma unroll
                for (int r = 0; r < 4; ++r) {
                    ua[mi * 4 + r] = (f2ord(acc[mi][r]) & 0xFFFFFF80u) | (unsigned)(127 - (16 * mi + 4 * fq + r));
                    ub[mi * 4 + r] = (f2ord(acc[mi + 4][r]) & 0xFFFFFF80u) | (unsigned)(127 - (16 * (mi + 4) + 4 * fq + r));
                }
            bitonic_sort16(ua); bitonic_sort16(ub);
#pragma unroll
            for (int i = 0; i < 16; ++i) ua[i] = ua[i] > ub[15 - i] ? ua[i] : ub[15 - i];
            bitonic_merge16(ua);
            xlane_top16(ua, 16); xlane_top16(ua, 32);
#pragma unroll
            for (int i = 0; i < 16; ++i) top[half][i] = ua[i];
        }
        if (fq == 0) {
            unsigned w[8];
#pragma unroll
            for (int i = 0; i < 8; ++i) {
                const unsigned* t = i < 4 ? &top[0][4 * i] : &top[1][4 * (i - 4)];
                w[i] = (127u - (t[0] & 127u)) | ((127u - (t[1] & 127u)) << 8) | ((127u - (t[2] & 127u)) << 16) | ((127u - (t[3] & 127u)) << 24);
            }
            *(uint4*)(ids + fr * 32) = make_uint4(w[0], w[1], w[2], w[3]);
            *(uint4*)(ids + fr * 32 + 16) = make_uint4(w[4], w[5], w[6], w[7]);
        }
        float s2v[16];
#pragma unroll
        for (int j = 0; j < 16; ++j) s2v[j] = ord2f(top[1][j] & 0xFFFFFF80u);
        float s1r[4];
#pragma unroll
        for (int m = 0; m < 4; ++m) {
            const unsigned t = fq == 0 ? top[0][4 * m] : (fq == 1 ? top[0][4 * m + 1] : (fq == 2 ? top[0][4 * m + 2] : top[0][4 * m + 3]));
            s1r[m] = ord2f(t & 0xFFFFFF80u);
        }
        unsigned cu[16];
#pragma unroll
        for (int j = 0; j < 16; ++j) cu[j] = (f2ord(s1r[0] + s2v[j]) & 0xFFFFFF00u) | (unsigned)((fq << 4) | j);
        {
            unsigned ex[5];
            ex[0] = (f2ord(s1r[1] + s2v[0]) & 0xFFFFFF00u) | (unsigned)(((4 + fq) << 4) | 0);
            ex[1] = (f2ord(s1r[1] + s2v[1]) & 0xFFFFFF00u) | (unsigned)(((4 + fq) << 4) | 1);
            ex[2] = (f2ord(s1r[1] + s2v[2]) & 0xFFFFFF00u) | (unsigned)(((4 + fq) << 4) | 2);
            ex[3] = (f2ord(s1r[2] + s2v[0]) & 0xFFFFFF00u) | (unsigned)(((8 + fq) << 4) | 0);
            ex[4] = (f2ord(s1r[3] + s2v[0]) & 0xFFFFFF00u) | (unsigned)(((12 + fq) << 4) | 0);
#pragma unroll
            for (int e = 0; e < 5; ++e) {
                unsigned x = ex[e];
#pragma unroll
                for (int t = 0; t < 16; ++t) { const unsigned c = cu[t]; const unsigned mx = x > c ? x : c; x = x > c ? c : x; cu[t] = mx; }
            }
        }
        xlane_top16(cu, 16); xlane_top16(cu, 32);
        if (fq == 0) {
            float ex[16], den = 0.f; int eid[16];
            const float m0 = ord2f(cu[0] & 0xFFFFFF00u);
#pragma unroll
            for (int t = 0; t < 16; ++t) {
                ex[t] = __expf(ord2f(cu[t] & 0xFFFFFF00u) - m0); den += ex[t];
                const int i = (cu[t] >> 4) & 15, j = cu[t] & 15;
                eid[t] = (int)ids[fr * 32 + i] * 128 + (int)ids[fr * 32 + 16 + j];
            }
            const float inv = 1.f / den;
            int* ip = IDX + (size_t)(row0 + fr) * 128 + hd * 16;
            float* gp = GATE + (size_t)(row0 + fr) * 128 + hd * 16;
#pragma unroll
            for (int t = 0; t < 16; t += 4) {
                *(int4*)(ip + t) = make_int4(eid[t], eid[t + 1], eid[t + 2], eid[t + 3]);
                *(float4*)(gp + t) = make_float4(ex[t] * inv, ex[t + 1] * inv, ex[t + 2] * inv, ex[t + 3] * inv);
            }
        }
    }
}

__device__ __forceinline__ void phase_tabconv(const Params& P, int l) {
    const float4* U = (const float4*)(P.in[37] + (size_t)l * 16384 * 1024);
    const float4* V = (const float4*)(P.in[38] + (size_t)l * 16384 * 1024);
    ushort4* TU = (ushort4*)(P.ws + OFF_TBU);
    ushort4* TV = (ushort4*)(P.ws + OFF_TBV);
    const size_t n4 = (size_t)16384 * 256;
    for (size_t i = (size_t)blockIdx.x * 256 + otid(); i < n4; i += (size_t)gridDim.x * 256) {
        const float4 a = U[i], b = V[i];
        ushort4 oa, ob;
        oa.x = f2bf(a.x); oa.y = f2bf(a.y); oa.z = f2bf(a.z); oa.w = f2bf(a.w);
        ob.x = f2bf(b.x); ob.y = f2bf(b.y); ob.z = f2bf(b.z); ob.w = f2bf(b.w);
        TU[i] = oa; TV[i] = ob;
    }
}
__device__ __forceinline__ float dot2bf(unsigned a, unsigned b, float acc) { return __builtin_amdgcn_fdot2_f32_bf16(__builtin_bit_cast(bf16x2, a), __builtin_bit_cast(bf16x2, b), acc, false); }
__device__ __forceinline__ float dot8(const uint4& a, const uint4& b, float acc) { acc = dot2bf(a.x, b.x, acc); acc = dot2bf(a.y, b.y, acc); acc = dot2bf(a.z, b.z, acc); return dot2bf(a.w, b.w, acc); }
__device__ __forceinline__ void phase_gather(const Params& P, int l, unsigned char* smem) {
    const int tid = otid(), lane = tid & 63, wave = __builtin_amdgcn_readfirstlane(tid >> 6);
    float* XS = (float*)(P.ws + OFF_XS);
    const float* MOD = (const float*)(P.ws + OFF_MOD);
    const bf16_t* H2 = (const bf16_t*)(P.ws + OFF_H2);
    bf16_t* H = (bf16_t*)(P.ws + OFF_H);
    const int* IDX = (const int*)(P.ws + OFF_IDX);
    const float* GATE = (const float*)(P.ws + OFF_GATE);
    const bf16_t* TU = (const bf16_t*)(P.ws + OFF_TBU);
    const bf16_t* TV = (const bf16_t*)(P.ws + OFF_TBV);
    float* coef = (float*)smem + wave * 128;
    for (int row = blockIdx.x * 4 + wave; row < MROWS; row += gridDim.x * 4) {
        if (l == 1 && (row % LTOT) < CTX) continue;
        const uint4 h0 = *(const uint4*)(H2 + (size_t)row * DM + 8 * lane), h1 = *(const uint4*)(H2 + (size_t)row * DM + 512 + 8 * lane);
        const int e0 = IDX[(size_t)row * 128 + lane], e1 = IDX[(size_t)row * 128 + 64 + lane];
        uint4 ra[8], rb[8];
#define LOADB(T, bt) { _Pragma("unroll") for (int i = 0; i < 8; ++i) { const int k = (bt) * 8 + i; const int e = __builtin_amdgcn_readlane(k < 64 ? e0 : e1, k & 63); \
            const uint4* rp = (const uint4*)((T) + (size_t)e * 1024); ra[i] = rp[lane]; rb[i] = rp[64 + lane]; } }
        for (int bt = 0; bt < 16; ++bt) {
            LOADB(TU, bt)
            float p[8];
#pragma unroll
            for (int i = 0; i < 8; ++i) p[i] = dot8(rb[i], h1, dot8(ra[i], h0, 0.f));
            float q[4], r2[2];
#pragma unroll
            for (int i = 0; i < 4; ++i) { const float sd = (lane & 32) ? p[i] : p[i + 4]; const float rc = __shfl_xor(sd, 32, 64); q[i] = ((lane & 32) ? p[i + 4] : p[i]) + rc; }
#pragma unroll
            for (int i = 0; i < 2; ++i) { const float sd = (lane & 16) ? q[i] : q[i + 2]; const float rc = __shfl_xor(sd, 16, 64); r2[i] = ((lane & 16) ? q[i + 2] : q[i]) + rc; }
            float sv;
            { const float sd = (lane & 8) ? r2[0] : r2[1]; const float rc = __shfl_xor(sd, 8, 64); sv = ((lane & 8) ? r2[1] : r2[0]) + rc; }
            sv += __shfl_xor(sv, 4, 64); sv += __shfl_xor(sv, 2, 64); sv += __shfl_xor(sv, 1, 64);
            if ((lane & 7) == 0) { const int k = bt * 8 + ((lane >> 3) & 7); coef[k] = gelu_tanh(sv) * GATE[(size_t)row * 128 + k]; }
        }
        float acc[16];
#pragma unroll
        for (int j = 0; j < 16; ++j) acc[j] = 0.f;
        for (int bt = 0; bt < 16; ++bt) {
            LOADB(TV, bt)
#pragma unroll
            for (int i = 0; i < 8; ++i) {
                const float c = coef[bt * 8 + i];
                const unsigned w[8] = {ra[i].x, ra[i].y, ra[i].z, ra[i].w, rb[i].x, rb[i].y, rb[i].z, rb[i].w};
#pragma unroll
                for (int j = 0; j < 8; ++j) { acc[2 * j] += c * __uint_as_float(w[j] << 16); acc[2 * j + 1] += c * __uint_as_float(w[j] & 0xFFFF0000u); }
            }
        }
#undef LOADB
        const float* mod = MOD + (size_t)(l * 5 + modrow(row)) * 6144;
        float v[16]; float s = 0.f;
#pragma unroll
        for (int hh = 0; hh < 2; ++hh) {
            const int d = 512 * hh + 8 * lane;
            const float4 x0 = *(const float4*)(XS + (size_t)row * DM + d), x1 = *(const float4*)(XS + (size_t)row * DM + d + 4);
            const float4 g0 = *(const float4*)(mod + 5120 + d), g1 = *(const float4*)(mod + 5120 + d + 4);
            v[8 * hh + 0] = ALPHA * x0.x + g0.x * acc[8 * hh + 0]; v[8 * hh + 1] = ALPHA * x0.y + g0.y * acc[8 * hh + 1];
            v[8 * hh + 2] = ALPHA * x0.z + g0.z * acc[8 * hh + 2]; v[8 * hh + 3] = ALPHA * x0.w + g0.w * acc[8 * hh + 3];
            v[8 * hh + 4] = ALPHA * x1.x + g1.x * acc[8 * hh + 4]; v[8 * hh + 5] = ALPHA * x1.y + g1.y * acc[8 * hh + 5];
            v[8 * hh + 6] = ALPHA * x1.z + g1.z * acc[8 * hh + 6]; v[8 * hh + 7] = ALPHA * x1.w + g1.w * acc[8 * hh + 7];
        }
#pragma unroll
        for (int j = 0; j < 16; ++j) s += v[j];
        const float mean = wave_sum(s) * (1.f / 1024.f);
        float qq = 0.f;
#pragma unroll
        for (int j = 0; j < 16; ++j) { v[j] -= mean; qq += v[j] * v[j]; }
        const float rs = rsqrtf(wave_sum(qq) * (1.f / 1024.f) + 1e-5f);
        const float* mod1 = MOD + (size_t)(1 * 5 + modrow(row)) * 6144;
#pragma unroll
        for (int hh = 0; hh < 2; ++hh) {
            const int d = 512 * hh + 8 * lane;
            float o[8];
#pragma unroll
            for (int j = 0; j < 8; ++j) o[j] = v[8 * hh + j] * rs * P.in[10][l * 1024 + d + j] + P.in[11][l * 1024 + d + j];
            if (l == 0) {
                *(float4*)(XS + (size_t)row * DM + d) = make_float4(o[0], o[1], o[2], o[3]);
                *(float4*)(XS + (size_t)row * DM + d + 4) = make_float4(o[4], o[5], o[6], o[7]);
                bf16_t hb[8];
#pragma unroll
                for (int j = 0; j < 8; ++j) hb[j] = f2bf(o[j] * (1.f + mod1[1024 + d + j]) + mod1[d + j]);
                uint4 pk; pk.x = hb[0] | ((unsigned)hb[1] << 16); pk.y = hb[2] | ((unsigned)hb[3] << 16); pk.z = hb[4] | ((unsigned)hb[5] << 16); pk.w = hb[6] | ((unsigned)hb[7] << 16);
                *(uint4*)(H + (size_t)row * DM + d) = pk;
            } else {
                const int b = row / LTOT, t = row % LTOT - CTX;
                if (*(volatile unsigned*)(P.ws + OFF_BAR + 15360) != 0u) { o[0] = __int_as_float(0x7fc00000); }
                float* op = P.out + ((size_t)b * SEQ + t) * DM + d;
                *(float4*)op = make_float4(o[0], o[1], o[2], o[3]);
                *(float4*)(op + 4) = make_float4(o[4], o[5], o[6], o[7]);
            }
        }
    }
}

__device__ __forceinline__ void s5_prep_unit(const Params& P, int l, int g, unsigned char* smem) {
    const int tid = otid();
    float* Kt = (float*)smem;
    float* bbr = Kt + 8192; float* bbi = bbr + 1024; float* cr = bbi + 1024; float* ci = cr + 1024; float* pwr = ci + 1024; float* pwi = pwr + 17 * 64;
    bf16_t* MS = (bf16_t*)(P.ws + OFF_S5MS) + (size_t)(l * 16 + g) * 256 * 256;
    bf16_t* MY = (bf16_t*)(P.ws + OFF_S5MY) + (size_t)(l * 16 + g) * 256 * 512;
    float* LB = (float*)(P.ws + OFF_S5LB) + (size_t)(l * 16 + g) * 256;
    for (int dir = 0; dir < 2; ++dir) {
        __syncthreads();
        const int ldg = (l * 2 + dir) * 16 + g;
        if (tid < 64) {
            const int p = tid;
            const float dt = expf(P.in[14][ldg]);
            const float lre = P.in[12][ldg * 64 + p], lim = P.in[13][ldg * 64 + p];
            for (int d = 0; d <= 16; ++d) { const float mag = expf(lre * dt * (float)d), ang = lim * dt * (float)d; pwr[d * 64 + p] = mag * cosf(ang); pwi[d * 64 + p] = mag * sinf(ang); }
            const float lb_re = pwr[64 + p], lb_im = pwi[64 + p];
            const float den = lre * lre + lim * lim, nr = lb_re - 1.f, ni = lb_im;
            const float co_re = (nr * lre + ni * lim) / den, co_im = (ni * lre - nr * lim) / den;
            for (int h = 0; h < 16; ++h) {
                const float br = P.in[15][((size_t)ldg * 64 + p) * 16 + h], bi = P.in[16][((size_t)ldg * 64 + p) * 16 + h];
                bbr[p * 16 + h] = co_re * br - co_im * bi; bbi[p * 16 + h] = co_re * bi + co_im * br;
            }
            LB[dir * 128 + p] = pwr[16 * 64 + p]; LB[dir * 128 + 64 + p] = pwi[16 * 64 + p];
        }
        for (int e = tid; e < 1024; e += 256) { cr[e] = P.in[17][(size_t)ldg * 1024 + e]; ci[e] = P.in[18][(size_t)ldg * 1024 + e]; }
        __syncthreads();
        for (int e = tid; e < 4096; e += 256) {
            const int d = e >> 8, h = (e >> 4) & 15, h2 = e & 15;
            float acc = 0.f;
            for (int p = 0; p < 64; ++p) {
                const float Pr = pwr[d * 64 + p], Pi = pwi[d * 64 + p], br = bbr[p * 16 + h2], bi = bbi[p * 16 + h2];
                acc += cr[h * 64 + p] * (Pr * br - Pi * bi) - ci[h * 64 + p] * (Pr * bi + Pi * br);
            }
            Kt[dir * 4096 + e] = acc;
        }
        for (int e = tid; e < 128 * 256; e += 256) {
            const int q = e >> 8, col = e & 255, j = col >> 4, h2 = col & 15, p = q & 63;
            const int ex = dir == 0 ? 15 - j : j;
            const float Pr = pwr[ex * 64 + p], Pi = pwi[ex * 64 + p], br = bbr[p * 16 + h2], bi = bbi[p * 16 + h2];
            MS[(size_t)(dir * 128 + q) * 256 + col] = f2bf(q < 64 ? Pr * br - Pi * bi : Pr * bi + Pi * br);
        }
        for (int e = tid; e < 256 * 128; e += 256) {
            const int ri = e >> 7, q = e & 127, t = ri >> 4, h = ri & 15, p = q & 63;
            const int ex = dir == 0 ? t + 1 : 16 - t;
            const float Lr = pwr[ex * 64 + p], Li = pwi[ex * 64 + p], c_r = cr[h * 64 + p], c_i = ci[h * 64 + p];
            MY[(size_t)ri * 512 + 256 + dir * 128 + q] = f2bf(q < 64 ? c_r * Lr - c_i * Li : -(c_r * Li + c_i * Lr));
        }
    }
    __syncthreads();
    for (int e = tid; e < 256 * 256; e += 256) {
        const int ri = e >> 8, col = e & 255, t = ri >> 4, h = ri & 15, j = col >> 4, h2 = col & 15;
        float v = 0.f;
        if (j <= t) v += Kt[(t - j) * 256 + h * 16 + h2];
        if (j >= t) v += Kt[4096 + (j - t) * 256 + h * 16 + h2];
        MY[(size_t)ri * 512 + col] = f2bf(v);
    }
}
__device__ __forceinline__ void s5_passA(const Params& P, int l) {
    const int lane = otid() & 63, wave = __builtin_amdgcn_readfirstlane(otid() >> 6), fr = lane & 15, fq = lane >> 4;
    const bf16_t* Pb = (const bf16_t*)(P.ws + OFF_P);
    float* ST = (float*)(P.ws + OFF_S5ST);
    for (int it = blockIdx.x * 4 + wave; it < 16 * 17 * 4; it += gridDim.x * 4) {
        const int g = it / 68, mt = (it % 68) >> 2, nt = it & 3;
        const bf16_t* MS = (const bf16_t*)(P.ws + OFF_S5MS) + (size_t)(l * 16 + g) * 256 * 256;
        f32x4 acc[4][4];
#pragma unroll
        for (int i = 0; i < 4; ++i)
#pragma unroll
            for (int j = 0; j < 4; ++j) acc[i][j] = (f32x4){0.f, 0.f, 0.f, 0.f};
        const bf16_t* ap[4];
#pragma unroll
        for (int i = 0; i < 4; ++i) { const int m = mt * 64 + 16 * i + fr, b = m / 272, c = m % 272; ap[i] = Pb + (size_t)(b * LTOT + c * 16) * PIN + g * 16; }
        const bf16_t* bp = MS + (size_t)(nt * 64 + fr) * 256 + 8 * fq;
        for (int k0 = 0; k0 < 256; k0 += 32) {
            const int k = k0 + 8 * fq;
            bf16x8 a[4], bb[4];
#pragma unroll
            for (int i = 0; i < 4; ++i) a[i] = *(const bf16x8*)(ap[i] + (size_t)(k >> 4) * PIN + (k & 15));
#pragma unroll
            for (int j = 0; j < 4; ++j) bb[j] = *(const bf16x8*)(bp + (size_t)(16 * j) * 256 + k0);
#pragma unroll
            for (int i = 0; i < 4; ++i)
#pragma unroll
                for (int j = 0; j < 4; ++j) acc[i][j] = __builtin_amdgcn_mfma_f32_16x16x32_bf16(a[i], bb[j], acc[i][j], 0, 0, 0);
        }
#pragma unroll
        for (int i = 0; i < 4; ++i)
#pragma unroll
            for (int r = 0; r < 4; ++r) {
                const int m = mt * 64 + 16 * i + 4 * fq + r, b = m / 272, c = m % 272;
                float* dst = ST + ((size_t)(b * 16 + g) * 272 + c) * 256 + nt * 64 + fr;
#pragma unroll
                for (int j = 0; j < 4; ++j) dst[16 * j] = acc[i][j][r];
            }
    }
}
__device__ __forceinline__ void s5_carry(const Params& P, int l, int bid, int nb) {
    float* ST = (float*)(P.ws + OFF_S5ST);
    for (int u = bid; u < 32; u += nb) {
        const int gid = u * 256 + otid(), p = gid & 63, dir = (gid >> 6) & 1, g = (gid >> 7) & 15, b = gid >> 11;
        const float* LB = (const float*)(P.ws + OFF_S5LB) + (size_t)(l * 16 + g) * 256 + dir * 128;
        const float lr = LB[p], li = LB[64 + p];
        float* base = ST + (size_t)(b * 16 + g) * 272 * 256 + dir * 128 + p;
        float sr = 0.f, si = 0.f;
        for (int c0 = 0; c0 < 272; c0 += 16) {
            float tr[16], ti[16];
#pragma unroll
            for (int i = 0; i < 16; ++i) { const int cc = c0 + i, c = dir == 0 ? cc : (cc < 16 ? 15 - cc : 287 - cc); tr[i] = base[(size_t)c * 256]; ti[i] = base[(size_t)c * 256 + 64]; }
#pragma unroll
            for (int i = 0; i < 16; ++i) {
                const int cc = c0 + i, c = dir == 0 ? cc : (cc < 16 ? 15 - cc : 287 - cc);
                base[(size_t)c * 256] = sr; base[(size_t)c * 256 + 64] = si;
                const float nr = lr * sr - li * si + tr[i], ni = lr * si + li * sr + ti[i];
                sr = nr; si = ni;
            }
        }
    }
}
__device__ __forceinline__ void s5_passC(const Params& P, int l) {
    const int lane = otid() & 63, wave = __builtin_amdgcn_readfirstlane(otid() >> 6), fr = lane & 15, fq = lane >> 4;
    const bf16_t* Pb = (const bf16_t*)(P.ws + OFF_P);
    const float* ST = (const float*)(P.ws + OFF_S5ST);
    bf16_t* YA = (bf16_t*)(P.ws + OFF_YP);
    for (int it = blockIdx.x * 4 + wave; it < 16 * 17 * 4; it += gridDim.x * 4) {
        const int g = it / 68, mt = (it % 68) >> 2, nt = it & 3;
        const bf16_t* MY = (const bf16_t*)(P.ws + OFF_S5MY) + (size_t)(l * 16 + g) * 256 * 512;
        f32x4 acc[4][4];
#pragma unroll
        for (int i = 0; i < 4; ++i)
#pragma unroll
            for (int j = 0; j < 4; ++j) acc[i][j] = (f32x4){0.f, 0.f, 0.f, 0.f};
        const bf16_t* ap[4]; const float* sp[4];
#pragma unroll
        for (int i = 0; i < 4; ++i) {
            const int m = mt * 64 + 16 * i + fr, b = m / 272, c = m % 272;
            ap[i] = Pb + (size_t)(b * LTOT + c * 16) * PIN + g * 16;
            sp[i] = ST + ((size_t)(b * 16 + g) * 272 + c) * 256;
        }
        const bf16_t* bp = MY + (size_t)(nt * 64 + fr) * 512 + 8 * fq;
        for (int k0 = 0; k0 < 512; k0 += 32) {
            const int k = k0 + 8 * fq;
            bf16x8 a[4], bb[4];
            if (k0 < 256) {
#pragma unroll
                for (int i = 0; i < 4; ++i) a[i] = *(const bf16x8*)(ap[i] + (size_t)(k >> 4) * PIN + (k & 15));
            } else {
#pragma unroll
                for (int i = 0; i < 4; ++i) {
                    const float4 s0 = *(const float4*)(sp[i] + (k - 256)), s1 = *(const float4*)(sp[i] + (k - 256) + 4);
                    bf16x8 t;
                    t[0] = (short)f2bf(s0.x); t[1] = (short)f2bf(s0.y); t[2] = (short)f2bf(s0.z); t[3] = (short)f2bf(s0.w);
                    t[4] = (short)f2bf(s1.x); t[5] = (short)f2bf(s1.y); t[6] = (short)f2bf(s1.z); t[7] = (short)f2bf(s1.w);
                    a[i] = t;
                }
            }
#pragma unroll
            for (int j = 0; j < 4; ++j) bb[j] = *(const bf16x8*)(bp + (size_t)(16 * j) * 512 + k0);
#pragma unroll
            for (int i = 0; i < 4; ++i)
#pragma unroll
                for (int j = 0; j < 4; ++j) acc[i][j] = __builtin_amdgcn_mfma_f32_16x16x32_bf16(a[i], bb[j], acc[i][j], 0, 0, 0);
        }
        const float dsk = P.in[19][l * 256 + g * 16 + fr];
#pragma unroll
        for (int i = 0; i < 4; ++i)
#pragma unroll
            for (int r = 0; r < 4; ++r) {
                const int m = mt * 64 + 16 * i + 4 * fq + r, b = m / 272, c = m % 272;
#pragma unroll
                for (int j = 0; j < 4; ++j) {
                    const int t = nt * 4 + j;
                    const size_t row = (size_t)(b * LTOT + c * 16 + t);
                    const float u = bf2f(Pb[row * PIN + g * 16 + fr]);
                    YA[row * DM + g * 16 + fr] = f2bf(gelu_tanh(acc[i][j][r] + dsk * u));
                }
            }
    }
}


__device__ __forceinline__ void rwkv_prep_step(const bf16_t* RW, int b, int hd, int dir, int tau_base, unsigned char* buf, float ka, int wave, int lane) {
    bf16_t* KR = (bf16_t*)buf; bf16_t* BK = (bf16_t*)(buf + 4608); bf16_t* BbT = (bf16_t*)(buf + 9216); bf16_t* KbT = (bf16_t*)(buf + 11264); float* gT = (float*)(buf + 13312);
    const int ch = hd * 64 + lane;
    float cs[16];
    {
        float c = 0.f;
#pragma unroll
        for (int t = 0; t < 16; ++t) { const int row = row_of(b, dir, tau_base + t); c += bf2f(RW[(size_t)row * RWW + 3072 + dir * 512 + ch]); cs[t] = c; }
    }
    const float c15 = cs[15];
    if (wave == 0) gT[lane] = __expf(c15);
    bf16_t bb[4], kb[4];
#pragma unroll
    for (int t = 0; t < 16; ++t) {
        if ((t >> 2) == wave) {
            const int row = row_of(b, dir, tau_base + t);
            const bf16_t* rw = RW + (size_t)row * RWW + ch;
            const float r = bf2f(rw[0]), k = bf2f(rw[512]), kap = bf2f(rw[1536]), a = bf2f(rw[2048 + dir * 512]);
            const float cp = t > 0 ? cs[t > 0 ? t - 1 : 0] : 0.f, ct = cs[t];
            const float ep = __expf(cp), et = __expf(ct), em = __expf(-ct), eT = __expf(c15 - ct);
            const float beta = kap * a, kt = k * (1.f + (a - 1.f) * ka);
            KR[t * 72 + lane] = f2bf(kap * ep); KR[(16 + t) * 72 + lane] = f2bf(r * et);
            BK[t * 72 + lane] = f2bf(beta * em); BK[(16 + t) * 72 + lane] = f2bf(kt * em);
            bb[t & 3] = f2bf(beta * eT); kb[t & 3] = f2bf(kt * eT);
        }
    }
    uint2 pb, pk;
    pb.x = bb[0] | ((unsigned)bb[1] << 16); pb.y = bb[2] | ((unsigned)bb[3] << 16);
    pk.x = kb[0] | ((unsigned)kb[1] << 16); pk.y = kb[2] | ((unsigned)kb[3] << 16);
    *(uint2*)(BbT + lane * 16 + 4 * wave) = pb;
    *(uint2*)(KbT + lane * 16 + 4 * wave) = pk;
}
template <int NV>
__device__ __forceinline__ void rwkv_prep_vt(const bf16_t* RW, int b, int hd, int dir, int tau_base, int vbase, bf16_t* VT, int lane) {
    if (NV == 2) {
        const int vl = lane & 31, th = lane >> 5;
        bf16_t x[8];
#pragma unroll
        for (int i = 0; i < 8; ++i) { const int row = row_of(b, dir, tau_base + th * 8 + i); x[i] = RW[(size_t)row * RWW + 1024 + hd * 64 + vbase + vl]; }
        uint4 pk; pk.x = x[0] | ((unsigned)x[1] << 16); pk.y = x[2] | ((unsigned)x[3] << 16); pk.z = x[4] | ((unsigned)x[5] << 16); pk.w = x[6] | ((unsigned)x[7] << 16);
        *(uint4*)(VT + vl * 16 + th * 8) = pk;
    } else {
        const int vl = lane & 15, tq = lane >> 4;
        bf16_t x[4];
#pragma unroll
        for (int i = 0; i < 4; ++i) { const int row = row_of(b, dir, tau_base + tq * 4 + i); x[i] = RW[(size_t)row * RWW + 1024 + hd * 64 + vbase + vl]; }
        uint2 pk; pk.x = x[0] | ((unsigned)x[1] << 16); pk.y = x[2] | ((unsigned)x[3] << 16);
        *(uint2*)(VT + vl * 16 + tq * 4) = pk;
    }
}
template <int NV, bool HASV, bool OUT>
__device__ __forceinline__ void rwkv_mfma_step(f32x4 (&X)[4][NV], const unsigned char* buf, const bf16_t* VT, f32x4 (&Yout)[NV], int lane) {
    const bf16_t* KR = (const bf16_t*)buf; const bf16_t* BK = (const bf16_t*)(buf + 4608); const bf16_t* BbT = (const bf16_t*)(buf + 9216); const bf16_t* KbT = (const bf16_t*)(buf + 11264); const float* gT = (const float*)(buf + 13312);
    const int fr = lane & 15, fq = lane >> 4;
    const f32x4 z4 = {0.f, 0.f, 0.f, 0.f};
    f32x4 cA = z4, cN = z4, cAk = z4, cRb = z4, cRk = z4;
#pragma unroll
    for (int ks = 0; ks < 2; ++ks) {
        const bf16x8 kh = *(const bf16x8*)(KR + fr * 72 + 32 * ks + 8 * fq), rh = *(const bf16x8*)(KR + (16 + fr) * 72 + 32 * ks + 8 * fq);
        const bf16x8 bc = *(const bf16x8*)(BK + fr * 72 + 32 * ks + 8 * fq), kc = *(const bf16x8*)(BK + (16 + fr) * 72 + 32 * ks + 8 * fq);
        cA = mfma32(kh, bc, cA); cN = mfma32(bc, kh, cN); cAk = mfma32(kc, kh, cAk);
        if (OUT) { cRb = mfma32(bc, rh, cRb); cRk = mfma32(kc, rh, cRk); }
    }
    f32x4 dg;
#pragma unroll
    for (int r = 0; r < 4; ++r) {
        const int row = 4 * fq + r;
        dg[r] = (row == fr) ? 1.f : 0.f;
        cA[r] = (fr < row) ? cA[r] : 0.f;
        cN[r] = (row < fr) ? cN[r] : 0.f;
        cAk[r] = (row < fr) ? cAk[r] : 0.f;
        cRb[r] = (row <= fr) ? cRb[r] : 0.f;
        cRk[r] = (row <= fr) ? cRk[r] : 0.f;
    }
    const bf16x4 a4 = to4(cA), n4 = to4(cN);
    const f32x4 cA2 = mfma16(n4, a4, z4), cN2 = mfma16(a4, n4, z4);
    const bf16x4 a24 = to4(cA2), n24 = to4(cN2);
    const f32x4 cA4 = mfma16(n24, a24, z4), cN4 = mfma16(a24, n24, z4);
    const f32x4 cA8 = mfma16(to4(cN4), to4(cA4), z4);
    const f32x4 T1 = mfma16(to4(dg - cA), to4(dg + cN2), z4);
    const f32x4 T2 = mfma16(to4(dg + cA4), to4(T1), z4);
    const f32x4 WT = mfma16(to4(dg + cA8), to4(T2), z4);
    const bf16x4 wt4 = to4(WT), aak4 = to4(cAk), rab4 = to4(cRb), rak4 = to4(cRk);
    bf16x8 aK[2], aR[2];
#pragma unroll
    for (int ks = 0; ks < 2; ++ks) {
        aK[ks] = cat8(*(const bf16x4*)(KR + fr * 72 + 32 * ks + 4 * fq), *(const bf16x4*)(KR + fr * 72 + 32 * ks + 16 + 4 * fq));
        if (OUT) aR[ks] = cat8(*(const bf16x4*)(KR + (16 + fr) * 72 + 32 * ks + 4 * fq), *(const bf16x4*)(KR + (16 + fr) * 72 + 32 * ks + 16 + 4 * fq));
    }
    bf16x4 u4[NV], vt4[NV];
#pragma unroll
    for (int nj = 0; nj < NV; ++nj) {
        const bf16x8 b0 = cat8(to4(X[0][nj]), to4(X[1][nj])), b1 = cat8(to4(X[2][nj]), to4(X[3][nj]));
        f32x4 G = mfma32(aK[1], b1, mfma32(aK[0], b0, z4));
        if (HASV) { vt4[nj] = *(const bf16x4*)(VT + (16 * nj + fr) * 16 + 4 * fq); G = mfma16(aak4, vt4[nj], G); }
        const f32x4 U = mfma16(wt4, to4(G), z4);
        u4[nj] = to4(-U);
        if (OUT) {
            f32x4 Yv = mfma32(aR[1], b1, mfma32(aR[0], b0, z4));
            Yv = mfma16(rab4, u4[nj], Yv);
            if (HASV) Yv = mfma16(rak4, vt4[nj], Yv);
            Yout[nj] = Yv;
        }
    }
#pragma unroll
    for (int mi = 0; mi < 4; ++mi) {
        const f32x4 g4 = *(const f32x4*)(gT + 16 * mi + 4 * fq);
        const bf16x4 bb4 = *(const bf16x4*)(BbT + (16 * mi + fr) * 16 + 4 * fq), kb4 = *(const bf16x4*)(KbT + (16 * mi + fr) * 16 + 4 * fq);
#pragma unroll
        for (int nj = 0; nj < NV; ++nj) {
            f32x4 x = X[mi][nj] * g4;
            x = mfma16(bb4, u4[nj], x);
            if (HASV) x = mfma16(kb4, vt4[nj], x);
            X[mi][nj] = x;
        }
    }
}
__device__ __forceinline__ void rwkv_passA(const Params& P, int l, unsigned char* smem, int bid, int nb) {
    const int lane = otid() & 63, wave = __builtin_amdgcn_readfirstlane(otid() >> 6), fr = lane & 15, fq = lane >> 4;
    const bf16_t* RW = (const bf16_t*)(P.ws + OFF_RW);
    float* RXL = (float*)(P.ws + OFF_RXL);
    bf16_t* RXP = (bf16_t*)P.out;
    for (int item = bid; item < 64 * RW_NCH; item += nb) {
        const int seq = item / RW_NCH, c = item % RW_NCH, dir = seq & 1, hd = (seq >> 1) & 7, b = seq >> 4;
        const float ka = P.in[31][l * 512 + hd * 64 + lane];
        const int tau0 = c * 128;
        f32x4 X[4][2], Yd[2];
#pragma unroll
        for (int mi = 0; mi < 4; ++mi)
#pragma unroll
            for (int nj = 0; nj < 2; ++nj)
#pragma unroll
                for (int r = 0; r < 4; ++r) X[mi][nj][r] = (wave >= 2 && (16 * mi + 4 * fq + r) == (16 * (2 * (wave - 2) + nj) + fr)) ? 1.f : 0.f;
        bf16_t* VTw = (bf16_t*)(smem + RW_VT0 + wave * 2048);
        rwkv_prep_step(RW, b, hd, dir, tau0, smem, ka, wave, lane);
        if (wave < 2) rwkv_prep_vt<2>(RW, b, hd, dir, tau0, 32 * wave, VTw, lane);
        __syncthreads();
        for (int s = 0; s < 8; ++s) {
            if (s < 7) {
                rwkv_prep_step(RW, b, hd, dir, tau0 + (s + 1) * 16, smem + ((s + 1) & 1) * RW_BUF, ka, wave, lane);
                if (wave < 2) rwkv_prep_vt<2>(RW, b, hd, dir, tau0 + (s + 1) * 16, 32 * wave, VTw + ((s + 1) & 1) * 512, lane);
            }
            if (wave < 2) rwkv_mfma_step<2, true, false>(X, smem + (s & 1) * RW_BUF, VTw + (s & 1) * 512, Yd, lane);
            else rwkv_mfma_step<2, false, false>(X, smem + (s & 1) * RW_BUF, VTw, Yd, lane);
            __syncthreads();
        }
        if (wave < 2) {
#pragma unroll
            for (int mi = 0; mi < 4; ++mi)
#pragma unroll
                for (int nj = 0; nj < 2; ++nj) *(f32x4*)(RXL + (((size_t)item * 16 + mi * 4 + 2 * wave + nj) * 64 + lane) * 4) = X[mi][nj];
        } else {
#pragma unroll
            for (int mi = 0; mi < 4; ++mi)
#pragma unroll
                for (int nj = 0; nj < 2; ++nj)
#pragma unroll
                    for (int r = 0; r < 4; ++r) RXP[(size_t)item * 4096 + (16 * mi + 4 * fq + r) * 64 + 16 * (2 * (wave - 2) + nj) + fr] = f2bf(X[mi][nj][r]);
        }
    }
}
__device__ __forceinline__ void rwkv_passB(const Params& P) {
    const int lane = otid() & 63, wave = __builtin_amdgcn_readfirstlane(otid() >> 6), fr = lane & 15, fq = lane >> 4;
    float* RXL = (float*)(P.ws + OFF_RXL);
    const bf16_t* RXP = (const bf16_t*)P.out;
    for (int it = blockIdx.x * 4 + wave; it < 256; it += gridDim.x * 4) {
        const int seq = it >> 2, nj = it & 3;
        f32x4 X[4];
#pragma unroll
        for (int mi = 0; mi < 4; ++mi) X[mi] = (f32x4){0.f, 0.f, 0.f, 0.f};
        for (int c = 0; c < RW_NCH; ++c) {
            const size_t item = (size_t)seq * RW_NCH + c;
            f32x4 L[4]; bf16x8 a[4][2];
#pragma unroll
            for (int mi = 0; mi < 4; ++mi) {
                L[mi] = *(const f32x4*)(RXL + ((item * 16 + mi * 4 + nj) * 64 + lane) * 4);
                const bf16_t* xp = RXP + item * 4096 + (16 * mi + fr) * 64;
#pragma unroll
                for (int ks = 0; ks < 2; ++ks) a[mi][ks] = cat8(*(const bf16x4*)(xp + 32 * ks + 4 * fq), *(const bf16x4*)(xp + 32 * ks + 16 + 4 * fq));
            }
            const bf16x8 b0 = cat8(to4(X[0]), to4(X[1])), b1 = cat8(to4(X[2]), to4(X[3]));
#pragma unroll
            for (int mi = 0; mi < 4; ++mi) {
                *(f32x4*)(RXL + ((item * 16 + mi * 4 + nj) * 64 + lane) * 4) = X[mi];
                X[mi] = mfma32(a[mi][1], b1, mfma32(a[mi][0], b0, L[mi]));
            }
        }
    }
}
template <bool CHECK>
__device__ __forceinline__ void rwkv_passC(const Params& P, int l, unsigned char* smem) {
    const int lane = otid() & 63, wave = __builtin_amdgcn_readfirstlane(otid() >> 6), fr = lane & 15, fq = lane >> 4;
    const bf16_t* RW = (const bf16_t*)(P.ws + OFF_RW);
    const float* RXL = (const float*)(P.ws + OFF_RXL);
    for (int item = blockIdx.x; item < 64 * RW_NCH; item += gridDim.x) {
        const int seq = item / RW_NCH, c = item % RW_NCH, dir = seq & 1, hd = (seq >> 1) & 7, b = seq >> 4;
        if (l == 1 && dir == 0 && c < 2) continue;
        if (l == 1 && dir == 1 && c < 2) continue;
        bf16_t* YP = (bf16_t*)(P.ws + OFF_YP) + (size_t)dir * MROWS * DM;
        const float ka = P.in[31][l * 512 + hd * 64 + lane];
        const int tau0 = c * 128;
        f32x4 X[4][1], Yo[1];
#pragma unroll
        for (int mi = 0; mi < 4; ++mi) X[mi][0] = *(const f32x4*)(RXL + (((size_t)item * 16 + mi * 4 + wave) * 64 + lane) * 4);
        bf16_t* VTw = (bf16_t*)(smem + RW_VT0 + wave * 2048);
        rwkv_prep_step(RW, b, hd, dir, tau0, smem, ka, wave, lane);
        rwkv_prep_vt<1>(RW, b, hd, dir, tau0, 16 * wave, VTw, lane);
        __syncthreads();
        for (int s = 0; s < 8; ++s) {
            if (s < 7) {
                rwkv_prep_step(RW, b, hd, dir, tau0 + (s + 1) * 16, smem + ((s + 1) & 1) * RW_BUF, ka, wave, lane);
                rwkv_prep_vt<1>(RW, b, hd, dir, tau0 + (s + 1) * 16, 16 * wave, VTw + ((s + 1) & 1) * 512, lane);
            }
            rwkv_mfma_step<1, true, true>(X, smem + (s & 1) * RW_BUF, VTw + (s & 1) * 512, Yo, lane);
#pragma unroll
            for (int r = 0; r < 4; ++r) {
                const int row = row_of(b, dir, tau0 + s * 16 + 4 * fq + r);
                if (CHECK) { if (YP[(size_t)row * DM + 512 + hd * 64 + 16 * wave + fr] != f2bf(Yo[0][r])) atomicAdd((unsigned*)(P.ws + OFF_BAR + 15360), 1u); }
                else YP[(size_t)row * DM + 512 + hd * 64 + 16 * wave + fr] = f2bf(Yo[0][r]);
            }
            __syncthreads();
        }
    }
}


#define HG_NCH 34
#define HG_BUF 7168
#define HG_VT0 14336
#define OFF_O_RXP 0ull
#define OFF_O_HXL ((size_t)2176 * 8192)
#define OFF_O_HD (OFF_O_HXL + (size_t)1088 * 16384)
__device__ __forceinline__ float hgrn_prep_step(const bf16_t* Pb, int b, int hd, int dir, int tau_base, unsigned char* buf, float lb, int wave, int lane) {
    bf16_t* QH = (bf16_t*)buf; bf16_t* KC = (bf16_t*)(buf + 2304); bf16_t* KbT = (bf16_t*)(buf + 4608); float* gT = (float*)(buf + 6656);
    float cs[16], fv[16];
    {
        float c = 0.f;
#pragma unroll
        for (int t = 0; t < 16; ++t) {
            const int row = row_of(b, dir, tau_base + t);
            const float f = lb + (1.f - lb) * sigmoidf_(bf2f(Pb[(size_t)row * PIN + 768 + dir * 256 + hd * 64 + lane]));
            fv[t] = f; c += __logf(f); cs[t] = c;
        }
    }
    const float c15 = cs[15];
    if (wave == 0) gT[lane] = __expf(c15);
    bf16_t kb[4];
#pragma unroll
    for (int t = 0; t < 16; ++t) {
        if ((t >> 2) == wave) {
            const int row = row_of(b, dir, tau_base + t);
            const float q = siluf_(bf2f(Pb[(size_t)row * PIN + 256 + hd * 64 + lane]));
            const float ct = cs[t], k = 1.f - fv[t];
            QH[t * 72 + lane] = f2bf(q * __expf(ct));
            KC[t * 72 + lane] = f2bf(k * __expf(fminf(-ct, 80.f)));
            kb[t & 3] = f2bf(k * __expf(c15 - ct));
        }
    }
    uint2 pk; pk.x = kb[0] | ((unsigned)kb[1] << 16); pk.y = kb[2] | ((unsigned)kb[3] << 16);
    *(uint2*)(KbT + lane * 16 + 4 * wave) = pk;
    return c15;
}
__device__ __forceinline__ void hgrn_prep_vt(const bf16_t* Pb, int b, int hd, int dir, int tau_base, int vbase, bf16_t* VT, int lane) {
    const int vl = lane & 15, tq = lane >> 4;
    bf16_t x[4];
#pragma unroll
    for (int i = 0; i < 4; ++i) { const int row = row_of(b, dir, tau_base + tq * 4 + i); x[i] = Pb[(size_t)row * PIN + 512 + hd * 64 + vbase + vl]; }
    uint2 pk; pk.x = x[0] | ((unsigned)x[1] << 16); pk.y = x[2] | ((unsigned)x[3] << 16);
    *(uint2*)(VT + vl * 16 + tq * 4) = pk;
}
template <bool OUT>
__device__ __forceinline__ void hgrn_mfma_step(f32x4 (&X)[4], const unsigned char* buf, const bf16_t* VT, f32x4& Yout, int lane) {
    const bf16_t* QH = (const bf16_t*)buf; const bf16_t* KC = (const bf16_t*)(buf + 2304); const bf16_t* KbT = (const bf16_t*)(buf + 4608); const float* gT = (const float*)(buf + 6656);
    const int fr = lane & 15, fq = lane >> 4;
    const f32x4 z4 = {0.f, 0.f, 0.f, 0.f};
    const bf16x4 vt4 = *(const bf16x4*)(VT + fr * 16 + 4 * fq);
    if (OUT) {
        f32x4 cAT = z4;
#pragma unroll
        for (int ks = 0; ks < 2; ++ks) {
            const bf16x8 kc = *(const bf16x8*)(KC + fr * 72 + 32 * ks + 8 * fq), qh = *(const bf16x8*)(QH + fr * 72 + 32 * ks + 8 * fq);
            cAT = mfma32(kc, qh, cAT);
        }
#pragma unroll
        for (int r = 0; r < 4; ++r) cAT[r] = ((4 * fq + r) <= fr) ? cAT[r] : 0.f;
        const bf16x8 aQ0 = cat8(*(const bf16x4*)(QH + fr * 72 + 4 * fq), *(const bf16x4*)(QH + fr * 72 + 16 + 4 * fq));
        const bf16x8 aQ1 = cat8(*(const bf16x4*)(QH + fr * 72 + 32 + 4 * fq), *(const bf16x4*)(QH + fr * 72 + 48 + 4 * fq));
        const bf16x8 b0 = cat8(to4(X[0]), to4(X[1])), b1 = cat8(to4(X[2]), to4(X[3]));
        f32x4 O = mfma32(aQ1, b1, mfma32(aQ0, b0, z4));
        Yout = mfma16(to4(cAT), vt4, O);
    }
#pragma unroll
    for (int mi = 0; mi < 4; ++mi) {
        const f32x4 g4 = *(const f32x4*)(gT + 16 * mi + 4 * fq);
        const bf16x4 kb4 = *(const bf16x4*)(KbT + (16 * mi + fr) * 16 + 4 * fq);
        X[mi] = mfma16(kb4, vt4, X[mi] * g4);
    }
}
__device__ __forceinline__ float hgrn_lb(const Params& P, int l, int dir, int ch) {
    if (l == 0) return 0.f;
    const float a0 = P.in[22][(dir * 2 + 0) * 256 + ch], a1 = P.in[22][(dir * 2 + 1) * 256 + ch];
    const float m = fmaxf(a0, a1), e0 = __expf(a0 - m), e1 = __expf(a1 - m);
    return e1 / (e0 + e1);
}
template <bool OUT>
__device__ __forceinline__ void hgrn_pass(const Params& P, int l, unsigned char* smem) {
    const int lane = otid() & 63, wave = __builtin_amdgcn_readfirstlane(otid() >> 6), fr = lane & 15, fq = lane >> 4;
    const bf16_t* Pb = (const bf16_t*)(P.ws + OFF_P);
    float* HXL = (float*)((unsigned char*)P.out + OFF_O_HXL);
    float* HD = (float*)((unsigned char*)P.out + OFF_O_HD);
    for (int item = blockIdx.x; item < 32 * HG_NCH; item += gridDim.x) {
        const int seq = item / HG_NCH, c = item % HG_NCH, dir = seq & 1, hd = (seq >> 1) & 3, b = seq >> 3;
        if (OUT && l == 1 && c < 2) continue;
        bf16_t* YP = (bf16_t*)(P.ws + OFF_YP) + (size_t)dir * MROWS * DM;
        const float lb = hgrn_lb(P, l, dir, hd * 64 + lane);
        const int tau0 = c * 128;
        f32x4 X[4], Yo;
#pragma unroll
        for (int mi = 0; mi < 4; ++mi) X[mi] = OUT ? *(const f32x4*)(HXL + (((size_t)item * 16 + mi * 4 + wave) * 64 + lane) * 4) : (f32x4){0.f, 0.f, 0.f, 0.f};
        bf16_t* VTw = (bf16_t*)(smem + HG_VT0 + wave * 1024);
        float ctot = hgrn_prep_step(Pb, b, hd, dir, tau0, smem, lb, wave, lane);
        hgrn_prep_vt(Pb, b, hd, dir, tau0, 16 * wave, VTw, lane);
        __syncthreads();
        for (int s = 0; s < 8; ++s) {
            if (s < 7) {
                ctot += hgrn_prep_step(Pb, b, hd, dir, tau0 + (s + 1) * 16, smem + ((s + 1) & 1) * HG_BUF, lb, wave, lane);
                hgrn_prep_vt(Pb, b, hd, dir, tau0 + (s + 1) * 16, 16 * wave, VTw + ((s + 1) & 1) * 256, lane);
            }
            hgrn_mfma_step<OUT>(X, smem + (s & 1) * HG_BUF, VTw + (s & 1) * 256, Yo, lane);
            if (OUT) {
#pragma unroll
                for (int r = 0; r < 4; ++r) {
                    const int row = row_of(b, dir, tau0 + s * 16 + 4 * fq + r);
                    YP[(size_t)row * DM + 256 + hd * 64 + 16 * wave + fr] = f2bf(Yo[r]);
                }
            }
            __syncthreads();
        }
        if (!OUT) {
#pragma unroll
            for (int mi = 0; mi < 4; ++mi) *(f32x4*)(HXL + (((size_t)item * 16 + mi * 4 + wave) * 64 + lane) * 4) = X[mi];
            if (wave == 0) HD[(size_t)item * 64 + lane] = __expf(ctot);
        }
    }
}
__device__ __forceinline__ void hgrn_carry(const Params& P, int bid, int nb) {
    float* HXL = (float*)((unsigned char*)P.out + OFF_O_HXL);
    const float* HD = (const float*)((unsigned char*)P.out + OFF_O_HD);
    for (int u = bid; u < 128; u += nb) {
        const int gid = u * 256 + otid(), ln = gid & 63, tile = (gid >> 6) & 15, seq = gid >> 10;
        const int mi = tile >> 2, fq = ln >> 4;
        f32x4 x = {0.f, 0.f, 0.f, 0.f};
        for (int c0 = 0; c0 < HG_NCH; c0 += 17) {
            f32x4 L[17];
#pragma unroll
            for (int i = 0; i < 17; ++i) {
                const size_t item = (size_t)seq * HG_NCH + c0 + i;
                L[i] = *(const f32x4*)(HXL + ((item * 16 + tile) * 64 + ln) * 4);
            }
#pragma unroll
            for (int i = 0; i < 17; ++i) {
                const size_t item = (size_t)seq * HG_NCH + c0 + i;
                const f32x4 D = *(const f32x4*)(HD + item * 64 + 16 * mi + 4 * fq);
                *(f32x4*)(HXL + ((item * 16 + tile) * 64 + ln) * 4) = x;
                x = D * x + L[i];
            }
        }
    }
}


__device__ __forceinline__ void phase_rwprep2(const Params& P, int l, unsigned char* smem) {
    const int tid = otid(), lane = tid & 63, wave = __builtin_amdgcn_readfirstlane(tid >> 6), fr = lane & 15, fq = lane >> 4;
    const bf16_t* Pb = (const bf16_t*)(P.ws + OFF_P);
    bf16_t* RW = (bf16_t*)(P.ws + OFF_RW);
    const bf16_t* LW = (const bf16_t*)(P.ws + OFF_LW);
    const float* mu = P.in[24] + l * 1920;
    bf16_t* AL = (bf16_t*)smem;
    float muv[8];
#pragma unroll
    for (int jj = 0; jj < 8; ++jj) muv[jj] = (tid + 256 * jj) < 1920 ? mu[tid + 256 * jj] : 0.f;
    const float kk0 = P.in[30][l * 512 + tid], kk1 = P.in[30][l * 512 + 256 + tid];
    for (int u = blockIdx.x; u < MROWS / 16; u += gridDim.x) {
        const int r0 = u * 16;
        __syncthreads();
        for (int i = 0; i < 16; ++i) {
            const int row = r0 + i, p = row % LTOT;
            int nbr; bool okk;
            {
                const int m = tid & 3;
                if (p < CTX) { nbr = (m & 1) ? row + 1 : row - 1; okk = (m & 1) ? (p < CTX - 1) : (p > 0); }
                else {
                    const int t = p - CTX, gr = t >> 6, gc = t & 63;
                    nbr = m == 0 ? row - 1 : (m == 1 ? row + 1 : (m == 2 ? row - 64 : row + 64));
                    okk = m == 0 ? (gc > 0) : (m == 1 ? (gc < 63) : (m == 2 ? (gr > 0) : (gr < 63)));
                }
            }
            const bf16_t* pp = Pb + (size_t)row * PIN + 1536 + tid;
            const bf16_t* pn = Pb + (size_t)nbr * PIN + 1536 + tid;
            bf16_t* rw = RW + (size_t)row * RWW;
            float sv[8];
#pragma unroll
            for (int jj = 0; jj < 8; ++jj) {
                if (jj < 7 || tid < 128) {
                    const float pv = bf2f(pp[256 * jj]);
                    const float nv = okk ? bf2f(pn[256 * jj]) : 0.f;
                    sv[jj] = pv + muv[jj] * (nv - pv);
                } else sv[jj] = 0.f;
            }
            rw[tid] = f2bf(sv[0]); rw[256 + tid] = f2bf(sv[1]);
            rw[512 + tid] = f2bf(sv[2]); rw[768 + tid] = f2bf(sv[3]);
            rw[1024 + tid] = f2bf(sv[4]); rw[1280 + tid] = f2bf(sv[5]);
            {
                const float a0 = sv[2] * kk0, a1 = sv[3] * kk1;
                const float n0 = fmaxf(sqrtf(wave_sum(a0 * a0)), 1e-12f), n1 = fmaxf(sqrtf(wave_sum(a1 * a1)), 1e-12f);
                rw[1536 + tid] = f2bf(a0 / n0); rw[1792 + tid] = f2bf(a1 / n1);
            }
            if (tid < 128) { rw[4096 + tid] = f2bf(sigmoidf_(sv[6])); AL[((2 + (tid >> 6)) * 16 + i) * 72 + (tid & 63)] = f2bf(sv[7]); }
            else AL[(((tid - 128) >> 6) * 16 + i) * 72 + (tid & 63)] = f2bf(tanhf(sv[6]));
        }
        __syncthreads();
        {
            const int d = wave & 1, isA = wave >> 1;
            const bf16x8 a0 = *(const bf16x8*)(AL + (wave * 16 + fr) * 72 + 8 * fq), a1 = *(const bf16x8*)(AL + (wave * 16 + fr) * 72 + 32 + 8 * fq);
            const bf16_t* W = LW + (size_t)isA * 131072 + (size_t)(l * 2 + d) * 512 * 64;
            const float* bias = P.in[isA ? 27 : 25] + (l * 2 + d) * 512;
            for (int nj = 0; nj < 32; ++nj) {
                const bf16x8 b0 = *(const bf16x8*)(W + (size_t)(16 * nj + fr) * 64 + 8 * fq), b1 = *(const bf16x8*)(W + (size_t)(16 * nj + fr) * 64 + 32 + 8 * fq);
                const f32x4 acc = mfma32(a1, b1, mfma32(a0, b0, (f32x4){0.f, 0.f, 0.f, 0.f}));
                const int c = 16 * nj + fr;
                const float bs = bias[c];
#pragma unroll
                for (int r = 0; r < 4; ++r) {
                    const float sg = sigmoidf_(bs + acc[r]);
                    RW[(size_t)(r0 + 4 * fq + r) * RWW + (isA ? 2048 : 3072) + d * 512 + c] = f2bf(isA ? sg : -0.60653066f * sg);
                }
            }
        }
    }
}
__device__ __forceinline__ void phase_post2(const Params& P, int l) {
    const int tid = otid(), lane = tid & 63, wave = __builtin_amdgcn_readfirstlane(tid >> 6), fr = lane & 15, fq = lane >> 4;
    const bf16_t* Pb = (const bf16_t*)(P.ws + OFF_P);
    const bf16_t* RW = (const bf16_t*)(P.ws + OFF_RW);
    const bf16_t* YF = (const bf16_t*)(P.ws + OFF_YP);
    const bf16_t* YB = YF + (size_t)MROWS * DM;
    const bf16_t* LW = (const bf16_t*)(P.ws + OFF_LW);
    bf16_t* MIX = (bf16_t*)(P.ws + OFF_MIX);
    const f32x4 z4 = {0.f, 0.f, 0.f, 0.f};
    for (int u = blockIdx.x; u < MROWS / 16; u += gridDim.x) {
        const int r0 = u * 16;
        if (l == 1 && (r0 % LTOT) < CTX) continue;
        {
            f32x4 acc[4] = {z4, z4, z4, z4};
            const bf16_t* ap = YF + (size_t)(r0 + fr) * DM + 8 * fq;
            const bf16_t* bp = LW + (size_t)3 * 131072 + (size_t)(l * 256 + 64 * wave + fr) * 256 + 8 * fq;
#pragma unroll
            for (int ks = 0; ks < 8; ++ks) {
                const bf16x8 a = *(const bf16x8*)(ap + 32 * ks);
#pragma unroll
                for (int j = 0; j < 4; ++j) acc[j] = mfma32(a, *(const bf16x8*)(bp + (size_t)(16 * j) * 256 + 32 * ks), acc[j]);
            }
#pragma unroll
            for (int j = 0; j < 4; ++j) {
                const int n = 64 * wave + 16 * j + fr;
                const float gb = P.in[21][l * 256 + n];
#pragma unroll
                for (int r = 0; r < 4; ++r) {
                    const size_t row = (size_t)(r0 + 4 * fq + r);
                    MIX[row * DM + n] = f2bf(bf2f(YF[row * DM + n]) * sigmoidf_(acc[j][r] + gb));
                }
            }
        }
        {
            const int i = tid >> 4, c0 = (tid & 15) * 16; const size_t row = (size_t)(r0 + i);
            float o[16], ss = 0.f;
#pragma unroll
            for (int j = 0; j < 16; ++j) { o[j] = bf2f(YF[row * DM + 256 + c0 + j]) + bf2f(YB[row * DM + 256 + c0 + j]); ss += o[j] * o[j]; }
            ss += __shfl_xor(ss, 1, 64); ss += __shfl_xor(ss, 2, 64);
            const float rs = rsqrtf(ss * (1.f / 64.f) + 1e-6f);
#pragma unroll
            for (int j = 0; j < 16; ++j) {
                const float gr = bf2f(Pb[row * PIN + 1280 + c0 + j]);
                MIX[row * DM + 256 + c0 + j] = f2bf(o[j] * rs * P.in[23][l * 256 + c0 + j] * siluf_(gr));
            }
        }
#pragma unroll 1
        for (int hh = 0; hh < 2; ++hh) {
            const int h = 2 * wave + hh;
            f32x4 g[4] = {z4, z4, z4, z4};
            const bf16_t* ap = RW + (size_t)(r0 + fr) * RWW + 4096 + 8 * fq;
            const bf16_t* bp = LW + (size_t)2 * 131072 + (size_t)(l * 512 + h * 64 + fr) * 128 + 8 * fq;
#pragma unroll
            for (int ks = 0; ks < 4; ++ks) {
                const bf16x8 a = *(const bf16x8*)(ap + 32 * ks);
#pragma unroll
                for (int j = 0; j < 4; ++j) g[j] = mfma32(a, *(const bf16x8*)(bp + (size_t)(16 * j) * 128 + 32 * ks), g[j]);
            }
#pragma unroll
            for (int r = 0; r < 4; ++r) {
                const size_t row = (size_t)(r0 + 4 * fq + r);
                const bf16_t* rw = RW + row * RWW;
                float y[4], vv[4], sum = 0.f, bon = 0.f;
#pragma unroll
                for (int j = 0; j < 4; ++j) {
                    const int c = h * 64 + 16 * j + fr;
                    y[j] = bf2f(YF[row * DM + 512 + c]) + bf2f(YB[row * DM + 512 + c]);
                    sum += y[j];
                    const float rr = bf2f(rw[c]), k = bf2f(rw[512 + c]), af = bf2f(rw[2048 + c]), ab = bf2f(rw[2560 + c]);
                    const float ka = P.in[31][l * 512 + c];
                    vv[j] = bf2f(rw[1024 + c]);
                    bon += rr * P.in[32][l * 512 + c] * k * (2.f + (af + ab - 2.f) * ka);
                }
#pragma unroll
                for (int o = 1; o < 16; o <<= 1) { sum += __shfl_xor(sum, o, 64); bon += __shfl_xor(bon, o, 64); }
                const float mean = sum * (1.f / 64.f);
                float var = 0.f;
#pragma unroll
                for (int j = 0; j < 4; ++j) { const float d = y[j] - mean; var += d * d; }
#pragma unroll
                for (int o = 1; o < 16; o <<= 1) var += __shfl_xor(var, o, 64);
                const float rs = rsqrtf(var * (1.f / 64.f) + 64e-5f);
#pragma unroll
                for (int j = 0; j < 4; ++j) {
                    const int c = h * 64 + 16 * j + fr;
                    const float yn = (y[j] - mean) * rs * P.in[33][l * 512 + c] + P.in[34][l * 512 + c];
                    MIX[row * DM + 512 + c] = f2bf((yn + bon * vv[j]) * g[j][r]);
                }
            }
        }
    }
}

__device__ __forceinline__ void run_phase(const Params& P, int ph, unsigned char* smem) {
#ifndef ONLY
    if (ph == 0) { phase_prep(P, smem); return; }
    if (ph == 1) { phase_mkh(P); return; }
#else
    if (ph < 2) return;
#endif
    const int l = (ph - 2) / PPL, s = (ph - 2) % PPL;
#ifdef ONLY
    if (s != ONLY) return;
#endif
    switch (s) {
    case 0: gemm2_bf16((const bf16_t*)(P.ws + OFF_H), DM, (const bf16_t*)(P.ws + OFF_WIN) + (size_t)l * PIN * DM, DM, MROWS, PIN, DM, false, EpiBf16{(bf16_t*)(P.ws + OFF_P), PIN}, smem); break;
    case 1: phase_rwprep2(P, l, smem); s5_passA(P, l); hgrn_pass<false>(P, l, smem); break;
    case 2: rwkv_passA(P, l, smem, blockIdx.x, gridDim.x); s5_carry(P, l, gridDim.x - 1 - blockIdx.x, gridDim.x); hgrn_carry(P, (int)((2 * gridDim.x - 33 - blockIdx.x) % gridDim.x), gridDim.x); break;
    case 3: rwkv_passB(P); s5_passC(P, l); hgrn_pass<true>(P, l, smem); break;
    case 4: rwkv_passC<false>(P, l, smem); break;
    case 5: phase_post2(P, l); break;
    case 6: gemm2_bf16((const bf16_t*)(P.ws + OFF_MIX), DM, (const bf16_t*)(P.ws + OFF_WOUT) + (size_t)l * DM * DM, DM, MROWS, DM, DM, l == 1, EpiF32{(float*)(P.ws + OFF_TMP), DM}, smem); break;
    case 7: phase_ln1(P, l); break;
    case 8: gemm2_bf16((const bf16_t*)(P.ws + OFF_H2), DM, (const bf16_t*)(P.ws + OFF_WQ) + (size_t)l * 2048 * DM, DM, MROWS, 2048, DM, l == 1, EpiBf16{(bf16_t*)(P.ws + OFF_Q), 2048}, smem); break;
    case 9: phase_topk2(P, l, smem); phase_tabconv(P, l); break;
    case 10: phase_gather(P, l, smem); break;
    }
}

__global__ void __launch_bounds__(256, 2) mega(Params P) {
    __shared__ __attribute__((aligned(16))) unsigned char smem[65536];
#if SINGLE
    cg::grid_group grid = cg::this_grid();
    if (threadIdx.x < 4) ((volatile LAS unsigned*)(smem + 65520))[threadIdx.x] = 0u;
    __syncthreads();
    XcdBarrier xb = xcd_barrier_post((unsigned*)(P.ws + OFF_BAR), (volatile LAS unsigned*)(smem + 65520));
#endif
    for (int ph = P.ph_lo; ph < P.ph_hi; ++ph) {
        run_phase(P, ph, smem);
#if SINGLE
        if (ph + 1 < P.ph_hi) {
            if (ph == 0) { asm volatile("s_waitcnt vmcnt(0)" ::: "memory"); __syncthreads(); grid.sync(); }
            else xcd_barrier(xb);
        }
#ifdef DUPMASK
        if (ph >= 2 && ((DUPMASK >> ((ph - 2) % PPL)) & 1)) { run_phase(P, ph, smem); xcd_barrier(xb); }
#endif
#ifdef EXP_T3
        if (ph >= 2 && (ph - 2) % PPL == 4) { rwkv_passC<true>(P, (ph - 2) / PPL, smem); xcd_barrier(xb); }
#endif
#ifdef EXP_OLDSCAN
        if (ph >= 2 && (ph - 2) % PPL == 4) { const int wv = threadIdx.x >> 6; for (int it = wv * gridDim.x + blockIdx.x; it < 64; it += 4 * gridDim.x) scan_rwkv(P, (ph - 2) / PPL, it); xcd_barrier(xb); }
#endif
#endif
    }
}

extern "C" void kernel_launch(void* const* d_in, const int* in_sizes, int n_in, void* d_out, int out_size, void* d_ws, size_t ws_size, hipStream_t stream) {
    static int grid = 0;
    if (grid == 0) {
        if (n_in != 39 || ws_size < OFF_END) { fprintf(stderr, "kernel_launch: unexpected n_in %d or ws_size %zu (need %zu)\n", n_in, ws_size, (size_t)OFF_END); grid = -1; return; }
        int dev = 0, cus = 0, per_cu = 0;
        hipGetDevice(&dev);
        hipDeviceGetAttribute(&cus, hipDeviceAttributeMultiprocessorCount, dev);
        hipOccupancyMaxActiveBlocksPerMultiprocessor(&per_cu, mega, 256, 0);
        if (per_cu < 1) per_cu = 1;
        if (per_cu > 2) per_cu = 2;
        grid = cus * per_cu;
    }
    if (grid < 0) return;
    hipMemsetAsync((unsigned char*)d_ws + OFF_BAR, 0, 16384, stream);
    Params p{};
    for (int i = 0; i < 39; ++i) p.in[i] = (const float*)d_in[i];
    p.out = (float*)d_out; p.ws = (unsigned char*)d_ws;
#if SINGLE
    p.ph_lo = 0; p.ph_hi = NPH;
    void* args[] = {&p};
    hipError_t e = hipLaunchCooperativeKernel((void*)mega, dim3(grid), dim3(256), args, 0, stream);
    if (e != hipSuccess) fprintf(stderr, "cooperative launch failed: %s (grid %d)\n", hipGetErrorString(e), grid);
#else
    for (int ph = 0; ph < NPH; ++ph) {
        p.ph_lo = ph; p.ph_hi = ph + 1;
        hipLaunchKernelGGL(mega, dim3(grid), dim3(256), 0, stream, p);
    }
#endif
}
```

```cpp
#include <hip/hip_runtime.h>
#include <hip/hip_cooperative_groups.h>
#include <cstdio>
namespace cg = cooperative_groups;

#ifndef SINGLE
#define SINGLE 1
#endif

typedef unsigned short bf16_t;
typedef short bf16x8 __attribute__((ext_vector_type(8)));
typedef float f32x4 __attribute__((ext_vector_type(4)));
typedef __bf16 bf16x2 __attribute__((ext_vector_type(2)));

#define DM 1024
#define NB 4
#define SEQ 4096
#define CTX 256
#define LTOT 4352
#define MROWS 17408
#define PIN 3456
#define RWW 4224
#define NPH 24
#define PPL 11
#define ALPHA 1.41421356237f

#define OFF_XS 0ull
#define OFF_P (OFF_XS + (size_t)MROWS * DM * 4)
#define OFF_RW (OFF_P + (size_t)MROWS * PIN * 2)
#define OFF_YP (OFF_RW + (size_t)MROWS * RWW * 2)
#define OFF_MIX (OFF_YP + (size_t)2 * MROWS * DM * 2)
#define OFF_MOD (OFF_MIX + (size_t)MROWS * DM * 2)
#define OFF_WIN (OFF_MOD + (size_t)2 * 5 * 6144 * 4)
#define OFF_WOUT (OFF_WIN + (size_t)2 * PIN * DM * 2)
#define OFF_WQ (OFF_WOUT + (size_t)2 * DM * DM * 2)
#define OFF_S5MS (OFF_WQ + (size_t)2 * 2048 * DM * 2)
#define OFF_S5MY (OFF_S5MS + (size_t)2 * 16 * 256 * 256 * 2)
#define OFF_S5LB (OFF_S5MY + (size_t)2 * 16 * 256 * 512 * 2)
#define OFF_S5ST (OFF_S5LB + (size_t)2 * 16 * 2 * 128 * 4)
#define OFF_BAR (OFF_S5ST + (size_t)4 * 16 * 272 * 256 * 4)
#define OFF_KEYB (OFF_BAR + 16384)
#define OFF_LW (OFF_KEYB + (size_t)2 * 8 * 2 * 128 * 128 * 2)
#define OFF_END (OFF_LW + (size_t)4 * 131072 * 2)
#define OFF_RXL OFF_MIX
#define OFF_TMP OFF_P
#define OFF_H OFF_YP
#define OFF_H2 (OFF_YP + (size_t)MROWS * DM * 2)
#define OFF_Q OFF_RW
#define OFF_IDX (OFF_RW + (size_t)MROWS * 2048 * 2)
#define OFF_GATE (OFF_IDX + (size_t)MROWS * 128 * 4)
#define OFF_TBU OFF_P
#define OFF_TBV (OFF_P + (size_t)16384 * 1024 * 2)

struct Params {
    const float* in[39];
    float* out;
    unsigned char* ws;
    int ph_lo, ph_hi;
};

__device__ __forceinline__ bf16_t f2bf(float f) {
    unsigned u = __float_as_uint(f);
    u += 0x7FFFu + ((u >> 16) & 1u);
    return (bf16_t)(u >> 16);
}
__device__ __forceinline__ float bf2f(bf16_t h) { return __uint_as_float(((unsigned)h) << 16); }
__device__ __forceinline__ float sigmoidf_(float x) { return 1.f / (1.f + __expf(-x)); }
__device__ __forceinline__ float siluf_(float x) { return x * sigmoidf_(x); }
__device__ __forceinline__ float gelu_tanh(float x) {
    const float u = 0.7978845608028654f * (x + 0.044715f * x * x * x);
    return 0.5f * x * (1.f + tanhf(u));
}
__device__ __forceinline__ float wave_sum(float v) {
#pragma unroll
    for (int o = 32; o > 0; o >>= 1) v += __shfl_xor(v, o, 64);
    return v;
}
typedef short bf16x4 __attribute__((ext_vector_type(4)));
#define RW_NCH 34
#define RW_BUF 13824
#define RW_VT0 27648
__device__ __forceinline__ f32x4 mfma32(bf16x8 a, bf16x8 b, f32x4 c) { return __builtin_amdgcn_mfma_f32_16x16x32_bf16(a, b, c, 0, 0, 0); }
__device__ __forceinline__ f32x4 mfma16(bf16x4 a, bf16x4 b, f32x4 c) {
    bf16x8 a8, b8;
    a8[0] = a[0]; a8[1] = a[1]; a8[2] = a[2]; a8[3] = a[3]; a8[4] = 0; a8[5] = 0; a8[6] = 0; a8[7] = 0;
    b8[0] = b[0]; b8[1] = b[1]; b8[2] = b[2]; b8[3] = b[3]; b8[4] = 0; b8[5] = 0; b8[6] = 0; b8[7] = 0;
    return __builtin_amdgcn_mfma_f32_16x16x32_bf16(a8, b8, c, 0, 0, 0);
}
__device__ __forceinline__ bf16x4 to4(f32x4 v) { bf16x4 o; o[0] = (short)f2bf(v[0]); o[1] = (short)f2bf(v[1]); o[2] = (short)f2bf(v[2]); o[3] = (short)f2bf(v[3]); return o; }
__device__ __forceinline__ bf16x8 cat8(bf16x4 a, bf16x4 b) { bf16x8 o; o[0] = a[0]; o[1] = a[1]; o[2] = a[2]; o[3] = a[3]; o[4] = b[0]; o[5] = b[1]; o[6] = b[2]; o[7] = b[3]; return o; }

__device__ __forceinline__ int otid() { int t = threadIdx.x; asm volatile("" : "+v"(t)); return t; }
__device__ __forceinline__ float rdlane(float v, int l) { return __int_as_float(__builtin_amdgcn_readlane(__float_as_int(v), l)); }
__device__ __forceinline__ int row_of(int b, int dir, int tau) {
    const int p = dir == 0 ? tau : (tau < CTX ? (CTX - 1 - tau) : (LTOT + CTX - 1 - tau));
    return b * LTOT + p;
}
__device__ __forceinline__ int modrow(int row) { const int p = row % LTOT; return p < CTX ? 4 : row / LTOT; }

__device__ __forceinline__ void s5_prep_unit(const Params& P, int l, int g, unsigned char* smem);

#define XB_TMO      128
#define XB_XCNT(j)  (256  + 64 * (j))
#define XB_XSUB(j)  (1280 + 64 * (j))
#define XB_XGEN(j)  (2304 + 64 * (j))
#define XB_TOP      3328
#define XB_TOPGEN   3392
#define XCD_BAR_WORDS 3456
#define XB_SPIN_CAP (1u << 22)
#define LAS __attribute__((address_space(3)))
__device__ __forceinline__ unsigned xb_ld(unsigned* p)              { return __hip_atomic_load(p, __ATOMIC_RELAXED, __HIP_MEMORY_SCOPE_AGENT); }
__device__ __forceinline__ unsigned xb_add(unsigned* p, unsigned v) { return __hip_atomic_fetch_add(p, v, __ATOMIC_RELAXED, __HIP_MEMORY_SCOPE_AGENT); }
__device__ __forceinline__ unsigned xb_xcc_id() { return (unsigned)__builtin_amdgcn_s_getreg((3 << 11) | 20) & 0xFu; }
#define XB_SPIN(cond, bar) do { unsigned _sp = 0; while (cond) { __builtin_amdgcn_s_sleep(1); \
    if ((++_sp & 255u) == 0u) { if (xb_ld(&(bar)[XB_TMO])) break; if (_sp > XB_SPIN_CAP) { atomicAdd(&(bar)[XB_TMO], 1u); break; } } } } while (0)
struct XcdBarrier { unsigned* bar; unsigned x; volatile LAS unsigned* st; };
__device__ __forceinline__ XcdBarrier xcd_barrier_post(unsigned* bar, volatile LAS unsigned* st) {
    XcdBarrier b; b.bar = bar; b.x = xb_xcc_id(); b.st = st;
    if (threadIdx.x == 0) (void)xb_add(&bar[XB_XCNT(b.x)], 1u);
    return b;
}
__device__ __forceinline__ void xcd_barrier_complete(unsigned* bar, unsigned x, unsigned& nloc, unsigned& nx) {
    const unsigned G = gridDim.x * gridDim.y * gridDim.z;
    unsigned sum, cnt, mine, sp = 0u;
    for (;;) {
        sum = 0u; cnt = 0u; mine = 0u;
#pragma unroll
        for (unsigned j = 0; j < 16; ++j) { const unsigned c = xb_ld(&bar[XB_XCNT(j)]); sum += c; cnt += (c > 0u) ? 1u : 0u; mine = (j == x) ? c : mine; }
        if (sum == G) break;
        __builtin_amdgcn_s_sleep(1);
        if ((++sp & 255u) == 0u) { if (xb_ld(&bar[XB_TMO])) break; if (sp > XB_SPIN_CAP) { atomicAdd(&bar[XB_TMO], 1u); break; } }
    }
    nloc = mine > 0u ? mine : 1u; nx = cnt > 0u ? cnt : 1u;
}
__device__ __forceinline__ void xcd_barrier(const XcdBarrier& b) {
    asm volatile("s_waitcnt vmcnt(0)" ::: "memory");
    __syncthreads();
    if (threadIdx.x == 0) {
        unsigned* bar = b.bar;
        __builtin_amdgcn_s_waitcnt(0);
        unsigned nloc = b.st[0], nx = b.st[1];
        if (nloc == 0u) { xcd_barrier_complete(bar, b.x, nloc, nx); b.st[0] = nloc; b.st[1] = nx; }
        const unsigned old = xb_add(&bar[XB_XSUB(b.x)], 1u);
        const unsigned gen = old / nloc;
        if (old + 1u == (gen + 1u) * nloc) {
            __builtin_amdgcn_fence(__ATOMIC_RELEASE, "agent");
            asm volatile("s_waitcnt vmcnt(0)" ::: "memory");
            const unsigned og = xb_add(&bar[XB_TOP], 1u);
            const unsigned tg = og / nx;
            if (og + 1u == (tg + 1u) * nx) xb_add(&bar[XB_TOPGEN], 1u);
            else XB_SPIN(xb_ld(&bar[XB_TOPGEN]) == tg, bar);
            __builtin_amdgcn_fence(__ATOMIC_ACQUIRE, "agent");
            xb_add(&bar[XB_XGEN(b.x)], 1u);
            asm volatile("s_waitcnt vmcnt(0)" ::: "memory");
        } else {
            XB_SPIN(xb_ld(&bar[XB_XGEN(b.x)]) == gen, bar);
            __builtin_amdgcn_fence(__ATOMIC_ACQUIRE, "agent");
            asm volatile("s_waitcnt vmcnt(0)" ::: "memory");
        }
    }
    __syncthreads();
}

__device__ __forceinline__ void phase_prep(const Params& P, unsigned char* smem) {
    const int tid = otid(), lane = tid & 63, wave = __builtin_amdgcn_readfirstlane(tid >> 6);
    float* MOD = (float*)(P.ws + OFF_MOD);
    float* XS = (float*)(P.ws + OFF_XS);
    const int U_MOD = 192, U_COPY = MROWS / 16, U_TIN = 2 * 16 * 54, U_TOUT = 2 * 16 * 16, U_TQ = 2 * 16 * 32;
    const int U_S5 = 32, U_KEY = 64 + 64;
    const int total = U_S5 + U_KEY + U_MOD + U_COPY + U_TIN + U_TOUT + U_TQ;
    for (int u0 = blockIdx.x; u0 < total; u0 += gridDim.x) {
        __syncthreads();
        if (u0 < U_S5) { s5_prep_unit(P, u0 >> 4, u0 & 15, smem); continue; }
        if (u0 < U_S5 + 64) {
            bf16_t* KB = (bf16_t*)(P.ws + OFF_KEYB);
            const size_t base = (size_t)(u0 - U_S5) * 8192;
            for (int i = tid; i < 8192; i += 256) KB[base + i] = f2bf(P.in[36][base + i]);
            continue;
        }
        if (u0 < U_S5 + U_KEY) {
            bf16_t* LW = (bf16_t*)(P.ws + OFF_LW);
            const int base = (u0 - U_S5 - 64) * 8192;
            for (int i = tid; i < 8192; i += 256) {
                const int o = base + i, which = o >> 17, e = o & 131071;
                float v;
                if (which < 2) { const int j = e & 63, c = (e >> 6) & 511, ld = e >> 15; v = P.in[which == 0 ? 26 : 28][((size_t)ld * 64 + j) * 512 + c]; }
                else if (which == 2) { const int j = e & 127, c = (e >> 7) & 511, ll = e >> 16; v = P.in[29][((size_t)ll * 128 + j) * 512 + c]; }
                else { const int k = e & 255, n = (e >> 8) & 255, ll = e >> 16; v = P.in[20][((size_t)ll * 256 + k) * 256 + n]; }
                LW[o] = f2bf(v);
            }
            continue;
        }
        const int u = u0 - U_S5 - U_KEY;
        if (u < U_MOD) {
            const int l = u / 96, j0 = (u % 96) * 64;
            float* sl = (float*)smem;
            for (int i = tid; i < 5 * 1024; i += 256) {
                const int r = i >> 10, k = i & 1023;
                const float cv = r < 4 ? P.in[1][r * 1024 + k] : P.in[3][k];
                sl[i] = siluf_(cv);
            }
            __syncthreads();
            float acc[5] = {0.f, 0.f, 0.f, 0.f, 0.f};
            const float* W = P.in[4] + (size_t)l * 1024 * 6144 + j0 + lane;
            for (int k = wave * 256; k < wave * 256 + 256; ++k) {
                const float w = W[(size_t)k * 6144];
#pragma unroll
                for (int r = 0; r < 5; ++r) acc[r] += sl[r * 1024 + k] * w;
            }
            float* red = (float*)(smem + 5 * 1024 * 4);
#pragma unroll
            for (int r = 0; r < 5; ++r) red[(wave * 5 + r) * 64 + lane] = acc[r];
            __syncthreads();
            for (int i = tid; i < 5 * 64; i += 256) {
                const int r = i / 64, jj = i % 64;
                float s = P.in[5][l * 6144 + j0 + jj];
                for (int w = 0; w < 4; ++w) s += red[(w * 5 + r) * 64 + jj];
                MOD[(l * 5 + r) * 6144 + j0 + jj] = s;
            }
        } else if (u < U_MOD + U_COPY) {
            const int r0 = (u - U_MOD) * 16;
            for (int i = tid; i < 16 * 256; i += 256) {
                const int row = r0 + (i >> 8), c4 = i & 255;
                const int b = row / LTOT, p = row % LTOT;
                const float4* src = p < CTX ? (const float4*)(P.in[2] + ((size_t)b * CTX + p) * DM) : (const float4*)(P.in[0] + ((size_t)b * SEQ + (p - CTX)) * DM);
                ((float4*)(XS + (size_t)row * DM))[c4] = src[c4];
            }
        } else {
            int v = u - U_MOD - U_COPY;
            const float* W; bf16_t* Wt; int N;
            if (v < U_TIN) { const int l = v / (16 * 54); v %= 16 * 54; N = PIN; W = P.in[6] + (size_t)l * 1024 * PIN; Wt = (bf16_t*)(P.ws + OFF_WIN) + (size_t)l * PIN * 1024; }
            else if (v < U_TIN + U_TOUT) { v -= U_TIN; const int l = v / 256; v %= 256; N = 1024; W = P.in[7] + (size_t)l * 1024 * 1024; Wt = (bf16_t*)(P.ws + OFF_WOUT) + (size_t)l * 1024 * 1024; }
            else { v -= U_TIN + U_TOUT; const int l = v / 512; v %= 512; N = 2048; W = P.in[35] + (size_t)l * 1024 * 2048; Wt = (bf16_t*)(P.ws + OFF_WQ) + (size_t)l * 2048 * 1024; }
            const int ntn = N / 64, kt = v / ntn, nt = v % ntn;
            float* t = (float*)smem;
            for (int i = tid; i < 64 * 64; i += 256) { const int kk = i >> 6, nn = i & 63; t[kk * 65 + nn] = W[(size_t)(kt * 64 + kk) * N + nt * 64 + nn]; }
            __syncthreads();
            for (int i = tid; i < 64 * 64; i += 256) { const int nn = i >> 6, kk = i & 63; Wt[(size_t)(nt * 64 + nn) * 1024 + kt * 64 + kk] = f2bf(t[kk * 65 + nn]); }
        }
    }
}

__device__ __forceinline__ void phase_mkh(const Params& P) {
    const int lane = otid() & 63, wave = __builtin_amdgcn_readfirstlane(otid() >> 6);
    const float* XS = (const float*)(P.ws + OFF_XS);
    const float* MOD = (const float*)(P.ws + OFF_MOD);
    bf16_t* H = (bf16_t*)(P.ws + OFF_H);
    for (int row = blockIdx.x * 4 + wave; row < MROWS; row += gridDim.x * 4) {
        const float* mod = MOD + (size_t)(0 * 5 + modrow(row)) * 6144;
#pragma unroll
        for (int j = 0; j < 4; ++j) {
            const int d = 256 * j + 4 * lane;
            const float4 x = *(const float4*)(XS + (size_t)row * DM + d);
            const float4 sh = *(const float4*)(mod + d), sc = *(const float4*)(mod + 1024 + d);
            ushort4 o;
            o.x = f2bf(x.x * (1.f + sc.x) + sh.x); o.y = f2bf(x.y * (1.f + sc.y) + sh.y);
            o.z = f2bf(x.z * (1.f + sc.z) + sh.z); o.w = f2bf(x.w * (1.f + sc.w) + sh.w);
            *(ushort4*)(H + (size_t)row * DM + d) = o;
        }
    }
}

template <class EPI>
__device__ __forceinline__ void gemm_bf16(const bf16_t* A, int lda, const bf16_t* Bt, int ldb, int M, int N, int K, bool skipctx, EPI epi) {
    const int lane = otid() & 63, wave = __builtin_amdgcn_readfirstlane(otid() >> 6);
    const int ntm = M / 128, ntn = N / 128;
    const int fr = lane & 15, fq = lane >> 4;
    for (int tile = blockIdx.x; tile < ntm * ntn; tile += gridDim.x) {
        const int tm = tile / ntn, tn = tile % ntn;
        const int m0 = tm * 128 + (wave >> 1) * 64, n0 = tn * 128 + (wave & 1) * 64;
        if (skipctx && (m0 % LTOT) < CTX) continue;
        f32x4 acc[4][4];
#pragma unroll
        for (int i = 0; i < 4; ++i)
#pragma unroll
            for (int j = 0; j < 4; ++j) acc[i][j] = (f32x4){0.f, 0.f, 0.f, 0.f};
        const bf16_t* ap = A + (size_t)(m0 + fr) * lda + 8 * fq;
        const bf16_t* bp = Bt + (size_t)(n0 + fr) * ldb + 8 * fq;
        for (int k0 = 0; k0 < K; k0 += 32) {
            bf16x8 a[4], b[4];
#pragma unroll
            for (int i = 0; i < 4; ++i) a[i] = *(const bf16x8*)(ap + (size_t)(16 * i) * lda + k0);
#pragma unroll
            for (int j = 0; j < 4; ++j) b[j] = *(const bf16x8*)(bp + (size_t)(16 * j) * ldb + k0);
#pragma unroll
            for (int i = 0; i < 4; ++i)
#pragma unroll
                for (int j = 0; j < 4; ++j) acc[i][j] = __builtin_amdgcn_mfma_f32_16x16x32_bf16(a[i], b[j], acc[i][j], 0, 0, 0);
        }
#pragma unroll
        for (int i = 0; i < 4; ++i)
#pragma unroll
            for (int j = 0; j < 4; ++j)
#pragma unroll
                for (int r = 0; r < 4; ++r) epi(m0 + 16 * i + 4 * fq + r, n0 + 16 * j + fr, acc[i][j][r]);
    }
}

typedef float f32x16 __attribute__((ext_vector_type(16)));
typedef unsigned u32x4 __attribute__((ext_vector_type(4)));
#define G2_LD 72
template <class EPI>
__device__ __forceinline__ void gemm2_bf16(const bf16_t* A, int lda, const bf16_t* Bt, int ldb, int M, int N, int K, bool skipctx, EPI epi, unsigned char* smem) {
    const int tid = otid(), lane = tid & 63, wave = __builtin_amdgcn_readfirstlane(tid >> 6);
    const int ntm = M / 128, ntn = N / 128;
    bf16_t* As = (bf16_t*)smem;
    bf16_t* Bs = As + 128 * G2_LD;
    const int lr = tid >> 3, lc = (tid & 7) * 8;
    const int wm = (wave >> 1) * 64, wn = (wave & 1) * 64;
    const int fr = lane & 31, fh = lane >> 5;
    for (int tile = blockIdx.x; tile < ntm * ntn; tile += gridDim.x) {
        const int tm = tile / ntn, tn = tile % ntn;
        if (skipctx && ((tm * 128) % LTOT) < CTX) continue;
        const bf16_t* ag = A + (size_t)(tm * 128 + lr) * lda + lc;
        const bf16_t* bg = Bt + (size_t)(tn * 128 + lr) * ldb + lc;
        f32x16 acc[2][2];
        {
            const f32x16 z16 = {0.f, 0.f, 0.f, 0.f, 0.f, 0.f, 0.f, 0.f, 0.f, 0.f, 0.f, 0.f, 0.f, 0.f, 0.f, 0.f};
            acc[0][0] = z16; acc[0][1] = z16; acc[1][0] = z16; acc[1][1] = z16;
        }
        u32x4 ra[4], rb[4];
#pragma unroll
        for (int i = 0; i < 4; ++i) { ra[i] = *(const u32x4*)(ag + (size_t)(32 * i) * lda); rb[i] = *(const u32x4*)(bg + (size_t)(32 * i) * ldb); }
        for (int k0 = 0; k0 < K; k0 += 64) {
            __syncthreads();
#pragma unroll
            for (int i = 0; i < 4; ++i) { *(u32x4*)(As + (lr + 32 * i) * G2_LD + lc) = ra[i]; *(u32x4*)(Bs + (lr + 32 * i) * G2_LD + lc) = rb[i]; }
            __syncthreads();
            {
                const int kn = (k0 + 64 < K) ? k0 + 64 : 0;
#pragma unroll
                for (int i = 0; i < 4; ++i) { ra[i] = *(const u32x4*)(ag + (size_t)(32 * i) * lda + kn); rb[i] = *(const u32x4*)(bg + (size_t)(32 * i) * ldb + kn); }
            }
#pragma unroll
            for (int kk = 0; kk < 4; ++kk) {
                bf16x8 a[2], b[2];
#pragma unroll
                for (int i = 0; i < 2; ++i) a[i] = *(const bf16x8*)(As + (wm + 32 * i + fr) * G2_LD + 16 * kk + 8 * fh);
#pragma unroll
                for (int j = 0; j < 2; ++j) b[j] = *(const bf16x8*)(Bs + (wn + 32 * j + fr) * G2_LD + 16 * kk + 8 * fh);
#pragma unroll
                for (int i = 0; i < 2; ++i)
#pragma unroll
                    for (int j = 0; j < 2; ++j) acc[i][j] = __builtin_amdgcn_mfma_f32_32x32x16_bf16(a[i], b[j], acc[i][j], 0, 0, 0);
            }
        }
#pragma unroll
        for (int i = 0; i < 2; ++i)
#pragma unroll
            for (int j = 0; j < 2; ++j)
#pragma unroll
                for (int q = 0; q < 16; ++q) epi(tm * 128 + wm + 32 * i + (q & 3) + 8 * (q >> 2) + 4 * fh, tn * 128 + wn + 32 * j + fr, acc[i][j][q]);
    }
}
struct EpiBf16 { bf16_t* C; int ldc; __device__ __forceinline__ void operator()(int r, int c, float v) const { C[(size_t)r * ldc + c] = f2bf(v); } };
struct EpiF32 { float* C; int ldc; __device__ __forceinline__ void operator()(int r, int c, float v) const { C[(size_t)r * ldc + c] = v; } };

__device__ __forceinline__ void phase_rwprep(const Params& P, int l, unsigned char* smem) {
    const int tid = otid();
    const bf16_t* Pb = (const bf16_t*)(P.ws + OFF_P);
    bf16_t* RW = (bf16_t*)(P.ws + OFF_RW);
    const float* mu = P.in[24] + l * 1920;
    const float* k_k = P.in[30] + l * 512;
    float* tw = (float*)smem;
    float* al = tw + 2 * 8 * 64;
    float* kk2 = al + 2 * 8 * 64;
    float* nrm = kk2 + 8 * 512;
    for (int u = blockIdx.x; u < MROWS / 8; u += gridDim.x) {
        const int r0 = u * 8;
        __syncthreads();
        for (int i = 0; i < 8; ++i) {
            const int row = r0 + i, p = row % LTOT;
            int nb[4]; bool ok[4];
            if (p < CTX) {
                nb[0] = row - 1; ok[0] = p > 0; nb[1] = row + 1; ok[1] = p < CTX - 1; nb[2] = nb[0]; ok[2] = ok[0]; nb[3] = nb[1]; ok[3] = ok[1];
            } else {
                const int t = p - CTX, gr = t >> 6, gc = t & 63;
                nb[0] = row - 1; ok[0] = gc > 0; nb[1] = row + 1; ok[1] = gc < 63; nb[2] = row - 64; ok[2] = gr > 0; nb[3] = row + 64; ok[3] = gr < 63;
            }
            for (int c = tid; c < 1920; c += 256) {
                const int m = c & 3;
                const float pv = bf2f(Pb[(size_t)row * PIN + 1536 + c]);
                const float nv = ok[m] ? bf2f(Pb[(size_t)nb[m] * PIN + 1536 + c]) : 0.f;
                const float s = pv + mu[c] * (nv - pv);
                bf16_t* rw = RW + (size_t)row * RWW;
                if (c < 512) rw[c] = f2bf(s);
                else if (c < 1024) { rw[c] = f2bf(s); kk2[i * 512 + (c - 512)] = s * k_k[c - 512]; }
                else if (c < 1536) rw[c] = f2bf(s);
                else if (c < 1664) rw[4096 + (c - 1536)] = f2bf(sigmoidf_(s));
                else if (c < 1728) tw[(0 * 8 + i) * 64 + (c - 1664)] = tanhf(s);
                else if (c < 1792) tw[(1 * 8 + i) * 64 + (c - 1728)] = tanhf(s);
                else if (c < 1856) al[(0 * 8 + i) * 64 + (c - 1792)] = s;
                else al[(1 * 8 + i) * 64 + (c - 1856)] = s;
            }
        }
        __syncthreads();
        {
            const int pair = tid >> 2, q = tid & 3, i = pair >> 3, hd = pair & 7;
            float s = 0.f;
            for (int j = 0; j < 16; ++j) { const float v = kk2[i * 512 + hd * 64 + q * 16 + j]; s += v * v; }
            s += __shfl_xor(s, 1, 64); s += __shfl_xor(s, 2, 64);
            if (q == 0) nrm[pair] = fmaxf(sqrtf(s), 1e-12f);
        }
        __syncthreads();
        for (int e = tid; e < 8 * 512; e += 256) {
            const int i = e >> 9, c = e & 511;
            RW[(size_t)(r0 + i) * RWW + 1536 + c] = f2bf(kk2[e] / nrm[i * 8 + (c >> 6)]);
        }
        for (int d = 0; d < 2; ++d) {
            const float* wup = P.in[26] + (size_t)(l * 2 + d) * 64 * 512;
            const float* aup = P.in[28] + (size_t)(l * 2 + d) * 64 * 512;
            const float* w0 = P.in[25] + (l * 2 + d) * 512;
            const float* a0 = P.in[27] + (l * 2 + d) * 512;
            float zw[2][8], za[2][8];
#pragma unroll
            for (int i = 0; i < 8; ++i) { zw[0][i] = zw[1][i] = za[0][i] = za[1][i] = 0.f; }
            for (int j = 0; j < 64; ++j) {
                const float w_0 = wup[j * 512 + tid], w_1 = wup[j * 512 + tid + 256];
                const float a_0 = aup[j * 512 + tid], a_1 = aup[j * 512 + tid + 256];
#pragma unroll
                for (int i = 0; i < 8; ++i) {
                    const float t = tw[(d * 8 + i) * 64 + j], a = al[(d * 8 + i) * 64 + j];
                    zw[0][i] += t * w_0; zw[1][i] += t * w_1; za[0][i] += a * a_0; za[1][i] += a * a_1;
                }
            }
#pragma unroll
            for (int i = 0; i < 8; ++i) {
                bf16_t* rw = RW + (size_t)(r0 + i) * RWW;
#pragma unroll
                for (int h = 0; h < 2; ++h) {
                    const int c = tid + 256 * h;
                    rw[2048 + d * 512 + c] = f2bf(sigmoidf_(a0[c] + za[h][i]));
                    rw[3072 + d * 512 + c] = f2bf(-0.60653066f * sigmoidf_(w0[c] + zw[h][i]));
                }
            }
        }
    }
}

__device__ __forceinline__ void scan_rwkv(const Params& P, int l, int item) {
    const int lane = otid() & 63;
    const int dir = item & 1, hd = (item >> 1) & 7, b = item >> 4;
    const bf16_t* RW = (const bf16_t*)(P.ws + OFF_RW);
    bf16_t* YP = (bf16_t*)(P.ws + OFF_YP) + (size_t)dir * MROWS * DM;
    const float ka = P.in[31][l * 512 + hd * 64 + lane];
    float S[64];
#pragma unroll
    for (int k = 0; k < 64; ++k) S[k] = 0.f;
    for (int tau = 0; tau < LTOT; ++tau) {
        const int row = row_of(b, dir, tau);
#ifdef EXP_T2
        if ((tau & 127) == 0) {
            float* RXL = (float*)(P.ws + OFF_RXL);
            const size_t itm = (size_t)item * 34 + (tau >> 7);
#pragma unroll
            for (int kk = 0; kk < 64; ++kk) RXL[((itm * 16 + (kk >> 4) * 4 + (lane >> 4)) * 64 + ((kk >> 2) & 3) * 16 + (lane & 15)) * 4 + (kk & 3)] = S[kk];
        }
#endif
        const bf16_t* rw = RW + (size_t)row * RWW + hd * 64 + lane;
        const float r = bf2f(rw[0]), k = bf2f(rw[512]), v = bf2f(rw[1024]), kap = bf2f(rw[1536]);
        const float a = bf2f(rw[2048 + dir * 512]), lw = bf2f(rw[3072 + dir * 512]);
        const float w = __expf(lw), kt = k * (1.f + (a - 1.f) * ka), beta = kap * a;
        float sk = 0.f;
#pragma unroll
        for (int kk = 0; kk < 64; ++kk) { sk += S[kk] * rdlane(kap, kk); if ((kk & 7) == 7) __builtin_amdgcn_sched_barrier(0); }
        float y = 0.f;
#pragma unroll
        for (int kk = 0; kk < 64; ++kk) {
            const float s = S[kk] * rdlane(w, kk) - sk * rdlane(beta, kk) + v * rdlane(kt, kk);
            S[kk] = s;
            y += s * rdlane(r, kk);
            if ((kk & 3) == 3) __builtin_amdgcn_sched_barrier(0);
        }
        YP[(size_t)row * DM + 512 + hd * 64 + lane] = f2bf(y);
    }
}
__device__ __forceinline__ void scan_hgrn(const Params& P, int l, int item) {
    const int lane = otid() & 63;
    const int dir = item & 1, hd = (item >> 1) & 3, b = item >> 3;
    const bf16_t* Pb = (const bf16_t*)(P.ws + OFF_P);
    bf16_t* YP = (bf16_t*)(P.ws + OFF_YP) + (size_t)dir * MROWS * DM;
    float lb = 0.f;
    if (l == 1) {
        const float a0 = P.in[22][(dir * 2 + 0) * 256 + hd * 64 + lane], a1 = P.in[22][(dir * 2 + 1) * 256 + hd * 64 + lane];
        const float m = fmaxf(a0, a1), e0 = __expf(a0 - m), e1 = __expf(a1 - m);
        lb = e1 / (e0 + e1);
    }
    float S[64];
#pragma unroll
    for (int k = 0; k < 64; ++k) S[k] = 0.f;
    for (int tau = 0; tau < LTOT; ++tau) {
        const int row = row_of(b, dir, tau);
        const bf16_t* pr = Pb + (size_t)row * PIN + 256 + hd * 64 + lane;
        const float q = siluf_(bf2f(pr[0])), v = bf2f(pr[256]);
        const float f = lb + (1.f - lb) * sigmoidf_(bf2f(pr[512 + dir * 256]));
        const float kq = 1.f - f;
        float o = 0.f;
#pragma unroll
        for (int dk = 0; dk < 64; ++dk) {
            const float s = rdlane(f, dk) * S[dk] + rdlane(kq, dk) * v;
            S[dk] = s;
            o += s * rdlane(q, dk);
            if ((dk & 7) == 7) __builtin_amdgcn_sched_barrier(0);
        }
        YP[(size_t)row * DM + 256 + hd * 64 + lane] = f2bf(o);
    }
}
__device__ __forceinline__ void scan_s5(const Params& P, int l, int item) {
    const int lane = otid() & 63;
    const int dir = item & 1, g = (item >> 1) & 15, b = item >> 5;
    const bf16_t* Pb = (const bf16_t*)(P.ws + OFF_P);
    bf16_t* YP = (bf16_t*)(P.ws + OFF_YP) + (size_t)dir * MROWS * DM;
    const int ldg = (l * 2 + dir) * 16 + g;
    const float dt = expf(P.in[14][ldg]);
    const float lre = P.in[12][ldg * 64 + lane], lim = P.in[13][ldg * 64 + lane];
    const float mag = expf(lre * dt), ang = lim * dt;
    const float lb_re = mag * cosf(ang), lb_im = mag * sinf(ang);
    const float den = lre * lre + lim * lim, nr = lb_re - 1.f, ni = lb_im;
    const float co_re = (nr * lre + ni * lim) / den, co_im = (ni * lre - nr * lim) / den;
    float bb_re[16], bb_im[16], c_re[16], c_im[16];
#pragma unroll
    for (int h = 0; h < 16; ++h) {
        const float br = P.in[15][((size_t)ldg * 64 + lane) * 16 + h], bi = P.in[16][((size_t)ldg * 64 + lane) * 16 + h];
        bb_re[h] = co_re * br - co_im * bi; bb_im[h] = co_re * bi + co_im * br;
        c_re[h] = P.in[17][((size_t)ldg * 16 + h) * 64 + lane]; c_im[h] = P.in[18][((size_t)ldg * 16 + h) * 64 + lane];
    }
    float s_re = 0.f, s_im = 0.f;
    for (int tau = 0; tau < LTOT; ++tau) {
        const int row = row_of(b, dir, tau);
        const float uv = bf2f(Pb[(size_t)row * PIN + g * 16 + (lane & 15)]);
        float bu_re = 0.f, bu_im = 0.f;
#pragma unroll
        for (int h = 0; h < 16; ++h) { const float uh = rdlane(uv, h); bu_re += bb_re[h] * uh; bu_im += bb_im[h] * uh; }
        const float n_re = lb_re * s_re - lb_im * s_im + bu_re, n_im = lb_re * s_im + lb_im * s_re + bu_im;
        s_re = n_re; s_im = n_im;
        float yo = 0.f;
#pragma unroll
        for (int h = 0; h < 16; ++h) { const float t = wave_sum(c_re[h] * s_re - c_im[h] * s_im); yo = (lane == h) ? t : yo; }
        if (lane < 16) YP[(size_t)row * DM + g * 16 + lane] = f2bf(yo);
    }
}
__device__ __forceinline__ void phase_scans(const Params& P, int l) {
    const int wave = __builtin_amdgcn_readfirstlane(otid() >> 6);
    for (int it = wave * gridDim.x + blockIdx.x; it < 32; it += 4 * gridDim.x) scan_hgrn(P, l, it);
}

__device__ __forceinline__ void phase_post(const Params& P, int l, unsigned char* smem) {
    const int tid = otid();
    const bf16_t* Pb = (const bf16_t*)(P.ws + OFF_P);
    const bf16_t* RW = (const bf16_t*)(P.ws + OFF_RW);
    const bf16_t* YF = (const bf16_t*)(P.ws + OFF_YP);
    const bf16_t* YB = YF + (size_t)MROWS * DM;
    bf16_t* MIX = (bf16_t*)(P.ws + OFF_MIX);
    float* ypre = (float*)smem;
    float* sg = ypre + 8 * 256;
    for (int u = blockIdx.x; u < MROWS / 8; u += gridDim.x) {
        const int r0 = u * 8;
        if (l == 1 && (r0 % LTOT) < CTX) continue;
        __syncthreads();
        for (int i = 0; i < 8; ++i) {
            const int row = r0 + i;
            ypre[i * 256 + tid] = bf2f(YF[(size_t)row * DM + tid]);
        }
        for (int e = tid; e < 8 * 128; e += 256) sg[e] = bf2f(RW[(size_t)(r0 + (e >> 7)) * RWW + 4096 + (e & 127)]);
        __syncthreads();
        {
            float z[8];
            const float gb = P.in[21][l * 256 + tid];
#pragma unroll
            for (int i = 0; i < 8; ++i) z[i] = gb;
            const float* gw = P.in[20] + (size_t)l * 256 * 256 + tid;
            for (int k = 0; k < 256; ++k) {
                const float w = gw[k * 256];
#pragma unroll
                for (int i = 0; i < 8; ++i) z[i] += ypre[i * 256 + k] * w;
            }
#pragma unroll
            for (int i = 0; i < 8; ++i) MIX[(size_t)(r0 + i) * DM + tid] = f2bf(ypre[i * 256 + tid] * sigmoidf_(z[i]));
        }
        {
            const int i = tid >> 5, c0 = (tid & 31) * 8, row = r0 + i;
            float o[8], ss = 0.f;
#pragma unroll
            for (int j = 0; j < 8; ++j) { o[j] = bf2f(YF[(size_t)row * DM + 256 + c0 + j]) + bf2f(YB[(size_t)row * DM + 256 + c0 + j]); ss += o[j] * o[j]; }
            ss += __shfl_xor(ss, 1, 64); ss += __shfl_xor(ss, 2, 64); ss += __shfl_xor(ss, 4, 64);
            const float rs = rsqrtf(ss * (1.f / 64.f) + 1e-6f);
#pragma unroll
            for (int j = 0; j < 8; ++j) {
                const float gr = bf2f(Pb[(size_t)row * PIN + 256 + 1024 + c0 + j]);
                MIX[(size_t)row * DM + 256 + c0 + j] = f2bf(o[j] * rs * P.in[23][l * 256 + c0 + j] * siluf_(gr));
            }
        }
        {
            const int i = tid >> 5, c0 = (tid & 31) * 16, row = r0 + i;
            const bf16_t* rw = RW + (size_t)row * RWW;
            float y[16], vv[16], sum = 0.f, bon = 0.f;
#pragma unroll
            for (int j = 0; j < 16; ++j) {
                const int c = c0 + j;
                y[j] = bf2f(YF[(size_t)row * DM + 512 + c]) + bf2f(YB[(size_t)row * DM + 512 + c]);
                sum += y[j];
                const float r = bf2f(rw[c]), k = bf2f(rw[512 + c]), af = bf2f(rw[2048 + c]), ab = bf2f(rw[2560 + c]);
                const float ka = P.in[31][l * 512 + c];
                vv[j] = bf2f(rw[1024 + c]);
                bon += r * P.in[32][l * 512 + c] * (k * (1.f + (af - 1.f) * ka) + k * (1.f + (ab - 1.f) * ka));
            }
            sum += __shfl_xor(sum, 1, 64); sum += __shfl_xor(sum, 2, 64);
            bon += __shfl_xor(bon, 1, 64); bon += __shfl_xor(bon, 2, 64);
            const float mean = sum * (1.f / 64.f);
            float var = 0.f;
#pragma unroll
            for (int j = 0; j < 16; ++j) { const float d = y[j] - mean; var += d * d; }
            var += __shfl_xor(var, 1, 64); var += __shfl_xor(var, 2, 64);
            const float rs = rsqrtf(var * (1.f / 64.f) + 64e-5f);
            float g[16];
#pragma unroll
            for (int j = 0; j < 16; ++j) g[j] = 0.f;
            const float* gup = P.in[29] + (size_t)l * 128 * 512 + c0;
            for (int jj = 0; jj < 128; ++jj) {
                const float s = sg[i * 128 + jj];
                const float4 w0 = *(const float4*)(gup + jj * 512), w1 = *(const float4*)(gup + jj * 512 + 4), w2 = *(const float4*)(gup + jj * 512 + 8), w3 = *(const float4*)(gup + jj * 512 + 12);
                g[0] += s * w0.x; g[1] += s * w0.y; g[2] += s * w0.z; g[3] += s * w0.w;
                g[4] += s * w1.x; g[5] += s * w1.y; g[6] += s * w1.z; g[7] += s * w1.w;
                g[8] += s * w2.x; g[9] += s * w2.y; g[10] += s * w2.z; g[11] += s * w2.w;
                g[12] += s * w3.x; g[13] += s * w3.y; g[14] += s * w3.z; g[15] += s * w3.w;
            }
#pragma unroll
            for (int j = 0; j < 16; ++j) {
                const int c = c0 + j;
                const float yn = (y[j] - mean) * rs * P.in[33][l * 512 + c] + P.in[34][l * 512 + c];
                MIX[(size_t)row * DM + 512 + c] = f2bf((yn + bon * vv[j]) * g[j]);
            }
        }
    }
}

__device__ __forceinline__ void phase_ln1(const Params& P, int l) {
    const int lane = otid() & 63, wave = __builtin_amdgcn_readfirstlane(otid() >> 6);
    float* XS = (float*)(P.ws + OFF_XS);
    const float* TMP = (const float*)(P.ws + OFF_TMP);
    const float* MOD = (const float*)(P.ws + OFF_MOD);
    bf16_t* H2 = (bf16_t*)(P.ws + OFF_H2);
    for (int row = blockIdx.x * 4 + wave; row < MROWS; row += gridDim.x * 4) {
        if (l == 1 && (row % LTOT) < CTX) continue;
        const float* mod = MOD + (size_t)(l * 5 + modrow(row)) * 6144;
        float v[16]; float s = 0.f;
#pragma unroll
        for (int j = 0; j < 4; ++j) {
            const int d = 256 * j + 4 * lane;
            const float4 x = *(const float4*)(XS + (size_t)row * DM + d), t = *(const float4*)(TMP + (size_t)row * DM + d), g = *(const float4*)(mod + 2048 + d);
            v[4 * j + 0] = ALPHA * x.x + g.x * t.x; v[4 * j + 1] = ALPHA * x.y + g.y * t.y; v[4 * j + 2] = ALPHA * x.z + g.z * t.z; v[4 * j + 3] = ALPHA * x.w + g.w * t.w;
            s += v[4 * j] + v[4 * j + 1] + v[4 * j + 2] + v[4 * j + 3];
        }
        const float mean = wave_sum(s) * (1.f / 1024.f);
        float q = 0.f;
#pragma unroll
        for (int j = 0; j < 16; ++j) { const float d = v[j] - mean; q += d * d; }
        const float rs = rsqrtf(wave_sum(q) * (1.f / 1024.f) + 1e-5f);
#pragma unroll
        for (int j = 0; j < 4; ++j) {
            const int d = 256 * j + 4 * lane;
            const float4 gg = *(const float4*)(P.in[8] + l * 1024 + d), bb = *(const float4*)(P.in[9] + l * 1024 + d);
            const float4 sh = *(const float4*)(mod + 3072 + d), sc = *(const float4*)(mod + 4096 + d);
            float4 o;
            o.x = (v[4 * j + 0] - mean) * rs * gg.x + bb.x; o.y = (v[4 * j + 1] - mean) * rs * gg.y + bb.y;
            o.z = (v[4 * j + 2] - mean) * rs * gg.z + bb.z; o.w = (v[4 * j + 3] - mean) * rs * gg.w + bb.w;
            *(float4*)(XS + (size_t)row * DM + d) = o;
            ushort4 h;
            h.x = f2bf(o.x * (1.f + sc.x) + sh.x); h.y = f2bf(o.y * (1.f + sc.y) + sh.y); h.z = f2bf(o.z * (1.f + sc.z) + sh.z); h.w = f2bf(o.w * (1.f + sc.w) + sh.w);
            *(ushort4*)(H2 + (size_t)row * DM + d) = h;
        }
    }
}

__device__ __forceinline__ unsigned f2ord(float f) { const unsigned u = __float_as_uint(f); return u ^ ((u >> 31) ? 0xFFFFFFFFu : 0x80000000u); }
__device__ __forceinline__ float ord2f(unsigned u) { return __uint_as_float((u >> 31) ? (u ^ 0x80000000u) : ~u); }
__device__ __forceinline__ void phase_topk(const Params& P, int l) {
    const int tid = otid();
    const bf16_t* Q = (const bf16_t*)(P.ws + OFF_Q);
    int* IDX = (int*)(P.ws + OFF_IDX);
    float* GATE = (float*)(P.ws + OFF_GATE);
    for (int u = blockIdx.x; u < 8 * (MROWS / 256); u += gridDim.x) {
        const int hd = u / (MROWS / 256), rb = u % (MROWS / 256);
        const int row = rb * 256 + tid;
        if (l == 1 && (row % LTOT) < CTX) continue;
        unsigned top[2][16];
#pragma unroll
        for (int half = 0; half < 2; ++half) {
            float q[128];
            const bf16_t* qp = Q + (size_t)row * 2048 + hd * 256 + half * 128;
#pragma unroll
            for (int d8 = 0; d8 < 16; ++d8) {
                const bf16x8 v = *(const bf16x8*)(qp + d8 * 8);
#pragma unroll
                for (int j = 0; j < 8; ++j) q[d8 * 8 + j] = bf2f((bf16_t)v[j]);
            }
#pragma unroll
            for (int j = 0; j < 16; ++j) top[half][j] = 0u;
            const float* kp = P.in[36] + ((size_t)((l * 8 + hd) * 2 + half)) * 128 * 128;
            for (int key = 0; key < 128; ++key) {
                const float* kr = kp + key * 128;
                float s0 = 0.f, s1 = 0.f, s2 = 0.f, s3 = 0.f;
#pragma unroll
                for (int d = 0; d < 128; d += 4) { s0 += q[d] * kr[d]; s1 += q[d + 1] * kr[d + 1]; s2 += q[d + 2] * kr[d + 2]; s3 += q[d + 3] * kr[d + 3]; if ((d & 31) == 28) __builtin_amdgcn_sched_barrier(0); }
                unsigned x = (f2ord((s0 + s1) + (s2 + s3)) & 0xFFFFFF80u) | (unsigned)(127 - key);
#pragma unroll
                for (int j = 0; j < 16; ++j) { const unsigned t = top[half][j]; const unsigned mx = x > t ? x : t; x = x > t ? t : x; top[half][j] = mx; }
            }
        }
        float cs[16]; int ce[16];
#pragma unroll
        for (int j = 0; j < 16; ++j) { cs[j] = -3.0e38f; ce[j] = 0; }
#pragma unroll
        for (int i = 0; i < 16; ++i) {
            const float s1v = ord2f(top[0][i] & 0xFFFFFF80u); const int i1 = 127 - (int)(top[0][i] & 127u);
#pragma unroll
            for (int j = 0; j < 16; ++j) {
                if ((i + 1) * (j + 1) <= 16) {
                    float x = s1v + ord2f(top[1][j] & 0xFFFFFF80u); int xe = i1 * 128 + (127 - (int)(top[1][j] & 127u));
#pragma unroll
                    for (int t = 0; t < 16; ++t) {
                        const bool gt = x > cs[t];
                        const float ts = cs[t]; const int te = ce[t];
                        cs[t] = gt ? x : ts; ce[t] = gt ? xe : te; x = gt ? ts : x; xe = gt ? te : xe;
                    }
                }
            }
        }
        float den = 0.f, ex[16];
#pragma unroll
        for (int t = 0; t < 16; ++t) { ex[t] = __expf(cs[t] - cs[0]); den += ex[t]; }
        const float inv = 1.f / den;
#pragma unroll
        for (int t = 0; t < 16; ++t) { IDX[(size_t)row * 128 + hd * 16 + t] = ce[t]; GATE[(size_t)row * 128 + hd * 16 + t] = ex[t] * inv; }
    }
}


__device__ __forceinline__ void ce_desc(unsigned& a, unsigned& b) { const unsigned hi = a > b ? a : b, lo = a > b ? b : a; a = hi; b = lo; }
__device__ __forceinline__ void bitonic_sort16(unsigned (&u)[16]) {
#pragma unroll
    for (int k = 2; k <= 16; k <<= 1)
#pragma unroll
        for (int j = k >> 1; j > 0; j >>= 1)
#pragma unroll
            for (int i = 0; i < 16; ++i) {
                const int p = i ^ j;
                if (p > i) { if ((i & k) == 0) ce_desc(u[i], u[p]); else ce_desc(u[p], u[i]); }
            }
}
__device__ __forceinline__ void bitonic_merge16(unsigned (&u)[16]) {
#pragma unroll
    for (int j = 8; j > 0; j >>= 1)
#pragma unroll
        for (int i = 0; i < 16; ++i) { const int p = i ^ j; if (p > i) ce_desc(u[i], u[p]); }
}
__device__ __forceinline__ void xlane_top16(unsigned (&u)[16], int xr) {
    unsigned o[16];
#pragma unroll
    for (int i = 0; i < 16; ++i) o[i] = (unsigned)__shfl_xor((int)u[15 - i], xr, 64);
#pragma unroll
    for (int i = 0; i < 16; ++i) u[i] = u[i] > o[i] ? u[i] : o[i];
    bitonic_merge16(u);
}
__device__ __forceinline__ void phase_topk2(const Params& P, int l, unsigned char* smem) {
    const int lane = otid() & 63, wave = __builtin_amdgcn_readfirstlane(otid() >> 6), fr = lane & 15, fq = lane >> 4;
    const bf16_t* Q = (const bf16_t*)(P.ws + OFF_Q);
    const bf16_t* KB = (const bf16_t*)(P.ws + OFF_KEYB);
    int* IDX = (int*)(P.ws + OFF_IDX);
    float* GATE = (float*)(P.ws + OFF_GATE);
    unsigned char* ids = smem + wave * 512;
    for (int it = blockIdx.x * 4 + wave; it < (MROWS / 16) * 8; it += gridDim.x * 4) {
        const int rt = it >> 3, hd = it & 7, row0 = rt * 16;
        if (l == 1 && (row0 % LTOT) < CTX) continue;
        unsigned top[2][16];
#pragma unroll
        for (int half = 0; half < 2; ++half) {
            f32x4 acc[8];
#pragma unroll
            for (int mi = 0; mi < 8; ++mi) acc[mi] = (f32x4){0.f, 0.f, 0.f, 0.f};
            const bf16_t* kp = KB + ((size_t)((l * 8 + hd) * 2 + half) * 128 + fr) * 128 + 8 * fq;
            const bf16_t* qp = Q + (size_t)(row0 + fr) * 2048 + hd * 256 + half * 128 + 8 * fq;
#pragma unroll
            for (int ks = 0; ks < 4; ++ks) {
                const bf16x8 qb = *(const bf16x8*)(qp + 32 * ks);
#pragma unroll
                for (int mi = 0; mi < 8; ++mi) acc[mi] = mfma32(*(const bf16x8*)(kp + (size_t)(16 * mi) * 128 + 32 * ks), qb, acc[mi]);
            }
            unsigned ua[16], ub[16];
#pragma unroll
            for (int mi = 0; mi < 4; ++mi)
#pragma unroll
                for (int r = 0; r < 4; ++r) {
                    ua[mi * 4 + r] = (f2ord(acc[mi][r]) & 0xFFFFFF80u) | (unsigned)(127 - (16 * mi + 4 * fq + r));
                    ub[mi * 4 + r] = (f2ord(acc[mi + 4][r]) & 0xFFFFFF80u) | (unsigned)(127 - (16 * (mi + 4) + 4 * fq + r));
                }
            bitonic_sort16(ua); bitonic_sort16(ub);
#pragma unroll
            for (int i = 0; i < 16; ++i) ua[i] = ua[i] > ub[15 - i] ? ua[i] : ub[15 - i];
            bitonic_merge16(ua);
            xlane_top16(ua, 16); xlane_top16(ua, 32);
#pragma unroll
            for (int i = 0; i < 16; ++i) top[half][i] = ua[i];
        }
        if (fq == 0) {
            unsigned w[8];
#pragma unroll
            for (int i = 0; i < 8; ++i) {
                const unsigned* t = i < 4 ? &top[0][4 * i] : &top[1][4 * (i - 4)];
                w[i] = (127u - (t[0] & 127u)) | ((127u - (t[1] & 127u)) << 8) | ((127u - (t[2] & 127u)) << 16) | ((127u - (t[3] & 127u)) << 24);
            }
            *(uint4*)(ids + fr * 32) = make_uint4(w[0], w[1], w[2], w[3]);
            *(uint4*)(ids + fr * 32 + 16) = make_uint4(w[4], w[5], w[6], w[7]);
        }
        float s2v[16];
#pragma unroll
        for (int j = 0; j < 16; ++j) s2v[j] = ord2f(top[1][j] & 0xFFFFFF80u);
        float s1r[4];
#pragma unroll
        for (int m = 0; m < 4; ++m) {
            const unsigned t = fq == 0 ? top[0][4 * m] : (fq == 1 ? top[0][4 * m + 1] : (fq == 2 ? top[0][4 * m + 2] : top[0][4 * m + 3]));
            s1r[m] = ord2f(t & 0xFFFFFF80u);
        }
        unsigned cu[16];
#pragma unroll
        for (int j = 0; j < 16; ++j) cu[j] = (f2ord(s1r[0] + s2v[j]) & 0xFFFFFF00u) | (unsigned)((fq << 4) | j);
        {
            unsigned ex[5];
            ex[0] = (f2ord(s1r[1] + s2v[0]) & 0xFFFFFF00u) | (unsigned)(((4 + fq) << 4) | 0);
            ex[1] = (f2ord(s1r[1] + s2v[1]) & 0xFFFFFF00u) | (unsigned)(((4 + fq) << 4) | 1);
            ex[2] = (f2ord(s1r[1] + s2v[2]) & 0xFFFFFF00u) | (unsigned)(((4 + fq) << 4) | 2);
            ex[3] = (f2ord(s1r[2] + s2v[0]) & 0xFFFFFF00u) | (unsigned)(((8 + fq) << 4) | 0);
            ex[4] = (f2ord(s1r[3] + s2v[0]) & 0xFFFFFF00u) | (unsigned)(((12 + fq) << 4) | 0);
#pragma unroll
            for (int e = 0; e < 5; ++e) {
                unsigned x = ex[e];
#pragma unroll
                for (int t = 0; t < 16; ++t) { const unsigned c = cu[t]; const unsigned mx = x > c ? x : c; x = x > c ? c : x; cu[t] = mx; }
            }
        }
        xlane_top16(cu, 16); xlane_top16(cu, 32);
        if (fq == 0) {
            float ex[16], den = 0.f; int eid[16];
            const float m0 = ord2f(cu[0] & 0xFFFFFF00u);
#pragma unroll
            for (int t = 0; t < 16; ++t) {
                ex[t] = __expf(ord2f(cu[t] & 0xFFFFFF00u) - m0); den += ex[t];
                const int i = (cu[t] >> 4) & 15, j = cu[t] & 15;
                eid[t] = (int)ids[fr * 32 + i] * 128 + (int)ids[fr * 32 + 16 + j];
            }
            const float inv = 1.f / den;
            int* ip = IDX + (size_t)(row0 + fr) * 128 + hd * 16;
            float* gp = GATE + (size_t)(row0 + fr) * 128 + hd * 16;
#pragma unroll
            for (int t = 0; t < 16; t += 4) {
                *(int4*)(ip + t) = make_int4(eid[t], eid[t + 1], eid[t + 2], eid[t + 3]);
                *(float4*)(gp + t) = make_float4(ex[t] * inv, ex[t + 1] * inv, ex[t + 2] * inv, ex[t + 3] * inv);
            }
        }
    }
}

__device__ __forceinline__ void phase_tabconv(const Params& P, int l) {
    const float4* U = (const float4*)(P.in[37] + (size_t)l * 16384 * 1024);
    const float4* V = (const float4*)(P.in[38] + (size_t)l * 16384 * 1024);
    ushort4* TU = (ushort4*)(P.ws + OFF_TBU);
    ushort4* TV = (ushort4*)(P.ws + OFF_TBV);
    const size_t n4 = (size_t)16384 * 256;
    for (size_t i = (size_t)blockIdx.x * 256 + otid(); i < n4; i += (size_t)gridDim.x * 256) {
        const float4 a = U[i], b = V[i];
        ushort4 oa, ob;
        oa.x = f2bf(a.x); oa.y = f2bf(a.y); oa.z = f2bf(a.z); oa.w = f2bf(a.w);
        ob.x = f2bf(b.x); ob.y = f2bf(b.y); ob.z = f2bf(b.z); ob.w = f2bf(b.w);
        TU[i] = oa; TV[i] = ob;
    }
}
__device__ __forceinline__ float dot2bf(unsigned a, unsigned b, float acc) { return __builtin_amdgcn_fdot2_f32_bf16(__builtin_bit_cast(bf16x2, a), __builtin_bit_cast(bf16x2, b), acc, false); }
__device__ __forceinline__ float dot8(const uint4& a, const uint4& b, float acc) { acc = dot2bf(a.x, b.x, acc); acc = dot2bf(a.y, b.y, acc); acc = dot2bf(a.z, b.z, acc); return dot2bf(a.w, b.w, acc); }
__device__ __forceinline__ void phase_gather(const Params& P, int l, unsigned char* smem) {
    const int tid = otid(), lane = tid & 63, wave = __builtin_amdgcn_readfirstlane(tid >> 6);
    float* XS = (float*)(P.ws + OFF_XS);
    const float* MOD = (const float*)(P.ws + OFF_MOD);
    const bf16_t* H2 = (const bf16_t*)(P.ws + OFF_H2);
    bf16_t* H = (bf16_t*)(P.ws + OFF_H);
    const int* IDX = (const int*)(P.ws + OFF_IDX);
    const float* GATE = (const float*)(P.ws + OFF_GATE);
    const bf16_t* TU = (const bf16_t*)(P.ws + OFF_TBU);
    const bf16_t* TV = (const bf16_t*)(P.ws + OFF_TBV);
    float* coef = (float*)smem + wave * 128;
    for (int row = blockIdx.x * 4 + wave; row < MROWS; row += gridDim.x * 4) {
        if (l == 1 && (row % LTOT) < CTX) continue;
        const uint4 h0 = *(const uint4*)(H2 + (size_t)row * DM + 8 * lane), h1 = *(const uint4*)(H2 + (size_t)row * DM + 512 + 8 * lane);
        const int e0 = IDX[(size_t)row * 128 + lane], e1 = IDX[(size_t)row * 128 + 64 + lane];
        uint4 ra[8], rb[8];
#define LOADB(T, bt) { _Pragma("unroll") for (int i = 0; i < 8; ++i) { const int k = (bt) * 8 + i; const int e = __builtin_amdgcn_readlane(k < 64 ? e0 : e1, k & 63); \
            const uint4* rp = (const uint4*)((T) + (size_t)e * 1024); ra[i] = rp[lane]; rb[i] = rp[64 + lane]; } }
        for (int bt = 0; bt < 16; ++bt) {
            LOADB(TU, bt)
            float p[8];
#pragma unroll
            for (int i = 0; i < 8; ++i) p[i] = dot8(rb[i], h1, dot8(ra[i], h0, 0.f));
            float q[4], r2[2];
#pragma unroll
            for (int i = 0; i < 4; ++i) { const float sd = (lane & 32) ? p[i] : p[i + 4]; const float rc = __shfl_xor(sd, 32, 64); q[i] = ((lane & 32) ? p[i + 4] : p[i]) + rc; }
#pragma unroll
            for (int i = 0; i < 2; ++i) { const float sd = (lane & 16) ? q[i] : q[i + 2]; const float rc = __shfl_xor(sd, 16, 64); r2[i] = ((lane & 16) ? q[i + 2] : q[i]) + rc; }
            float sv;
            { const float sd = (lane & 8) ? r2[0] : r2[1]; const float rc = __shfl_xor(sd, 8, 64); sv = ((lane & 8) ? r2[1] : r2[0]) + rc; }
            sv += __shfl_xor(sv, 4, 64); sv += __shfl_xor(sv, 2, 64); sv += __shfl_xor(sv, 1, 64);
            if ((lane & 7) == 0) { const int k = bt * 8 + ((lane >> 3) & 7); coef[k] = gelu_tanh(sv) * GATE[(size_t)row * 128 + k]; }
        }
        float acc[16];
#pragma unroll
        for (int j = 0; j < 16; ++j) acc[j] = 0.f;
        for (int bt = 0; bt < 16; ++bt) {
            LOADB(TV, bt)
#pragma unroll
            for (int i = 0; i < 8; ++i) {
                const float c = coef[bt * 8 + i];
                const unsigned w[8] = {ra[i].x, ra[i].y, ra[i].z, ra[i].w, rb[i].x, rb[i].y, rb[i].z, rb[i].w};
#pragma unroll
                for (int j = 0; j < 8; ++j) { acc[2 * j] += c * __uint_as_float(w[j] << 16); acc[2 * j + 1] += c * __uint_as_float(w[j] & 0xFFFF0000u); }
            }
        }
#undef LOADB
        const float* mod = MOD + (size_t)(l * 5 + modrow(row)) * 6144;
        float v[16]; float s = 0.f;
#pragma unroll
        for (int hh = 0; hh < 2; ++hh) {
            const int d = 512 * hh + 8 * lane;
            const float4 x0 = *(const float4*)(XS + (size_t)row * DM + d), x1 = *(const float4*)(XS + (size_t)row * DM + d + 4);
            const float4 g0 = *(const float4*)(mod + 5120 + d), g1 = *(const float4*)(mod + 5120 + d + 4);
            v[8 * hh + 0] = ALPHA * x0.x + g0.x * acc[8 * hh + 0]; v[8 * hh + 1] = ALPHA * x0.y + g0.y * acc[8 * hh + 1];
            v[8 * hh + 2] = ALPHA * x0.z + g0.z * acc[8 * hh + 2]; v[8 * hh + 3] = ALPHA * x0.w + g0.w * acc[8 * hh + 3];
            v[8 * hh + 4] = ALPHA * x1.x + g1.x * acc[8 * hh + 4]; v[8 * hh + 5] = ALPHA * x1.y + g1.y * acc[8 * hh + 5];
            v[8 * hh + 6] = ALPHA * x1.z + g1.z * acc[8 * hh + 6]; v[8 * hh + 7] = ALPHA * x1.w + g1.w * acc[8 * hh + 7];
        }
#pragma unroll
        for (int j = 0; j < 16; ++j) s += v[j];
        const float mean = wave_sum(s) * (1.f / 1024.f);
        float qq = 0.f;
#pragma unroll
        for (int j = 0; j < 16; ++j) { v[j] -= mean; qq += v[j] * v[j]; }
        const float rs = rsqrtf(wave_sum(qq) * (1.f / 1024.f) + 1e-5f);
        const float* mod1 = MOD + (size_t)(1 * 5 + modrow(row)) * 6144;
#pragma unroll
        for (int hh = 0; hh < 2; ++hh) {
            const int d = 512 * hh + 8 * lane;
            float o[8];
#pragma unroll
            for (int j = 0; j < 8; ++j) o[j] = v[8 * hh + j] * rs * P.in[10][l * 1024 + d + j] + P.in[11][l * 1024 + d + j];
            if (l == 0) {
                *(float4*)(XS + (size_t)row * DM + d) = make_float4(o[0], o[1], o[2], o[3]);
                *(float4*)(XS + (size_t)row * DM + d + 4) = make_float4(o[4], o[5], o[6], o[7]);
                bf16_t hb[8];
#pragma unroll
                for (int j = 0; j < 8; ++j) hb[j] = f2bf(o[j] * (1.f + mod1[1024 + d + j]) + mod1[d + j]);
                uint4 pk; pk.x = hb[0] | ((unsigned)hb[1] << 16); pk.y = hb[2] | ((unsigned)hb[3] << 16); pk.z = hb[4] | ((unsigned)hb[5] << 16); pk.w = hb[6] | ((unsigned)hb[7] << 16);
                *(uint4*)(H + (size_t)row * DM + d) = pk;
            } else {
                const int b = row / LTOT, t = row % LTOT - CTX;
                if (*(volatile unsigned*)(P.ws + OFF_BAR + 15360) != 0u) { o[0] = __int_as_float(0x7fc00000); }
                float* op = P.out + ((size_t)b * SEQ + t) * DM + d;
                *(float4*)op = make_float4(o[0], o[1], o[2], o[3]);
                *(float4*)(op + 4) = make_float4(o[4], o[5], o[6], o[7]);
            }
        }
    }
}

__device__ __forceinline__ void s5_prep_unit(const Params& P, int l, int g, unsigned char* smem) {
    const int tid = otid();
    float* Kt = (float*)smem;
    float* bbr = Kt + 8192; float* bbi = bbr + 1024; float* cr = bbi + 1024; float* ci = cr + 1024; float* pwr = ci + 1024; float* pwi = pwr + 17 * 64;
    bf16_t* MS = (bf16_t*)(P.ws + OFF_S5MS) + (size_t)(l * 16 + g) * 256 * 256;
    bf16_t* MY = (bf16_t*)(P.ws + OFF_S5MY) + (size_t)(l * 16 + g) * 256 * 512;
    float* LB = (float*)(P.ws + OFF_S5LB) + (size_t)(l * 16 + g) * 256;
    for (int dir = 0; dir < 2; ++dir) {
        __syncthreads();
        const int ldg = (l * 2 + dir) * 16 + g;
        if (tid < 64) {
            const int p = tid;
            const float dt = expf(P.in[14][ldg]);
            const float lre = P.in[12][ldg * 64 + p], lim = P.in[13][ldg * 64 + p];
            for (int d = 0; d <= 16; ++d) { const float mag = expf(lre * dt * (float)d), ang = lim * dt * (float)d; pwr[d * 64 + p] = mag * cosf(ang); pwi[d * 64 + p] = mag * sinf(ang); }
            const float lb_re = pwr[64 + p], lb_im = pwi[64 + p];
            const float den = lre * lre + lim * lim, nr = lb_re - 1.f, ni = lb_im;
            const float co_re = (nr * lre + ni * lim) / den, co_im = (ni * lre - nr * lim) / den;
            for (int h = 0; h < 16; ++h) {
                const float br = P.in[15][((size_t)ldg * 64 + p) * 16 + h], bi = P.in[16][((size_t)ldg * 64 + p) * 16 + h];
                bbr[p * 16 + h] = co_re * br - co_im * bi; bbi[p * 16 + h] = co_re * bi + co_im * br;
            }
            LB[dir * 128 + p] = pwr[16 * 64 + p]; LB[dir * 128 + 64 + p] = pwi[16 * 64 + p];
        }
        for (int e = tid; e < 1024; e += 256) { cr[e] = P.in[17][(size_t)ldg * 1024 + e]; ci[e] = P.in[18][(size_t)ldg * 1024 + e]; }
        __syncthreads();
        for (int e = tid; e < 4096; e += 256) {
            const int d = e >> 8, h = (e >> 4) & 15, h2 = e & 15;
            float acc = 0.f;
            for (int p = 0; p < 64; ++p) {
                const float Pr = pwr[d * 64 + p], Pi = pwi[d * 64 + p], br = bbr[p * 16 + h2], bi = bbi[p * 16 + h2];
                acc += cr[h * 64 + p] * (Pr * br - Pi * bi) - ci[h * 64 + p] * (Pr * bi + Pi * br);
            }
            Kt[dir * 4096 + e] = acc;
        }
        for (int e = tid; e < 128 * 256; e += 256) {
            const int q = e >> 8, col = e & 255, j = col >> 4, h2 = col & 15, p = q & 63;
            const int ex = dir == 0 ? 15 - j : j;
            const float Pr = pwr[ex * 64 + p], Pi = pwi[ex * 64 + p], br = bbr[p * 16 + h2], bi = bbi[p * 16 + h2];
            MS[(size_t)(dir * 128 + q) * 256 + col] = f2bf(q < 64 ? Pr * br - Pi * bi : Pr * bi + Pi * br);
        }
        for (int e = tid; e < 256 * 128; e += 256) {
            const int ri = e >> 7, q = e & 127, t = ri >> 4, h = ri & 15, p = q & 63;
            const int ex = dir == 0 ? t + 1 : 16 - t;
            const float Lr = pwr[ex * 64 + p], Li = pwi[ex * 64 + p], c_r = cr[h * 64 + p], c_i = ci[h * 64 + p];
            MY[(size_t)ri * 512 + 256 + dir * 128 + q] = f2bf(q < 64 ? c_r * Lr - c_i * Li : -(c_r * Li + c_i * Lr));
        }
    }
    __syncthreads();
    for (int e = tid; e < 256 * 256; e += 256) {
        const int ri = e >> 8, col = e & 255, t = ri >> 4, h = ri & 15, j = col >> 4, h2 = col & 15;
        float v = 0.f;
        if (j <= t) v += Kt[(t - j) * 256 + h * 16 + h2];
        if (j >= t) v += Kt[4096 + (j - t) * 256 + h * 16 + h2];
        MY[(size_t)ri * 512 + col] = f2bf(v);
    }
}
__device__ __forceinline__ void s5_passA(const Params& P, int l) {
    const int lane = otid() & 63, wave = __builtin_amdgcn_readfirstlane(otid() >> 6), fr = lane & 15, fq = lane >> 4;
    const bf16_t* Pb = (const bf16_t*)(P.ws + OFF_P);
    float* ST = (float*)(P.ws + OFF_S5ST);
    for (int it = blockIdx.x * 4 + wave; it < 16 * 17 * 4; it += gridDim.x * 4) {
        const int g = it / 68, mt = (it % 68) >> 2, nt = it & 3;
        const bf16_t* MS = (const bf16_t*)(P.ws + OFF_S5MS) + (size_t)(l * 16 + g) * 256 * 256;
        f32x4 acc[4][4];
#pragma unroll
        for (int i = 0; i < 4; ++i)
#pragma unroll
            for (int j = 0; j < 4; ++j) acc[i][j] = (f32x4){0.f, 0.f, 0.f, 0.f};
        const bf16_t* ap[4];
#pragma unroll
        for (int i = 0; i < 4; ++i) { const int m = mt * 64 + 16 * i + fr, b = m / 272, c = m % 272; ap[i] = Pb + (size_t)(b * LTOT + c * 16) * PIN + g * 16; }
        const bf16_t* bp = MS + (size_t)(nt * 64 + fr) * 256 + 8 * fq;
        for (int k0 = 0; k0 < 256; k0 += 32) {
            const int k = k0 + 8 * fq;
            bf16x8 a[4], bb[4];
#pragma unroll
            for (int i = 0; i < 4; ++i) a[i] = *(const bf16x8*)(ap[i] + (size_t)(k >> 4) * PIN + (k & 15));
#pragma unroll
            for (int j = 0; j < 4; ++j) bb[j] = *(const bf16x8*)(bp + (size_t)(16 * j) * 256 + k0);
#pragma unroll
            for (int i = 0; i < 4; ++i)
#pragma unroll
                for (int j = 0; j < 4; ++j) acc[i][j] = __builtin_amdgcn_mfma_f32_16x16x32_bf16(a[i], bb[j], acc[i][j], 0, 0, 0);
        }
#pragma unroll
        for (int i = 0; i < 4; ++i)
#pragma unroll
            for (int r = 0; r < 4; ++r) {
                const int m = mt * 64 + 16 * i + 4 * fq + r, b = m / 272, c = m % 272;
                float* dst = ST + ((size_t)(b * 16 + g) * 272 + c) * 256 + nt * 64 + fr;
#pragma unroll
                for (int j = 0; j < 4; ++j) dst[16 * j] = acc[i][j][r];
            }
    }
}
__device__ __forceinline__ void s5_carry(const Params& P, int l, int bid, int nb) {
    float* ST = (float*)(P.ws + OFF_S5ST);
    for (int u = bid; u < 32; u += nb) {
        const int gid = u * 256 + otid(), p = gid & 63, dir = (gid >> 6) & 1, g = (gid >> 7) & 15, b = gid >> 11;
        const float* LB = (const float*)(P.ws + OFF_S5LB) + (size_t)(l * 16 + g) * 256 + dir * 128;
        const float lr = LB[p], li = LB[64 + p];
        float* base = ST + (size_t)(b * 16 + g) * 272 * 256 + dir * 128 + p;
        float sr = 0.f, si = 0.f;
        for (int c0 = 0; c0 < 272; c0 += 16) {
            float tr[16], ti[16];
#pragma unroll
            for (int i = 0; i < 16; ++i) { const int cc = c0 + i, c = dir == 0 ? cc : (cc < 16 ? 15 - cc : 287 - cc); tr[i] = base[(size_t)c * 256]; ti[i] = base[(size_t)c * 256 + 64]; }
#pragma unroll
            for (int i = 0; i < 16; ++i) {
                const int cc = c0 + i, c = dir == 0 ? cc : (cc < 16 ? 15 - cc : 287 - cc);
                base[(size_t)c * 256] = sr; base[(size_t)c * 256 + 64] = si;
                const float nr = lr * sr - li * si + tr[i], ni = lr * si + li * sr + ti[i];
                sr = nr; si = ni;
            }
        }
    }
}
__device__ __forceinline__ void s5_passC(const Params& P, int l) {
    const int lane = otid() & 63, wave = __builtin_amdgcn_readfirstlane(otid() >> 6), fr = lane & 15, fq = lane >> 4;
    const bf16_t* Pb = (const bf16_t*)(P.ws + OFF_P);
    const float* ST = (const float*)(P.ws + OFF_S5ST);
    bf16_t* YA = (bf16_t*)(P.ws + OFF_YP);
    for (int it = blockIdx.x * 4 + wave; it < 16 * 17 * 4; it += gridDim.x * 4) {
        const int g = it / 68, mt = (it % 68) >> 2, nt = it & 3;
        const bf16_t* MY = (const bf16_t*)(P.ws + OFF_S5MY) + (size_t)(l * 16 + g) * 256 * 512;
        f32x4 acc[4][4];
#pragma unroll
        for (int i = 0; i < 4; ++i)
#pragma unroll
            for (int j = 0; j < 4; ++j) acc[i][j] = (f32x4){0.f, 0.f, 0.f, 0.f};
        const bf16_t* ap[4]; const float* sp[4];
#pragma unroll
        for (int i = 0; i < 4; ++i) {
            const int m = mt * 64 + 16 * i + fr, b = m / 272, c = m % 272;
            ap[i] = Pb + (size_t)(b * LTOT + c * 16) * PIN + g * 16;
            sp[i] = ST + ((size_t)(b * 16 + g) * 272 + c) * 256;
        }
        const bf16_t* bp = MY + (size_t)(nt * 64 + fr) * 512 + 8 * fq;
        for (int k0 = 0; k0 < 512; k0 += 32) {
            const int k = k0 + 8 * fq;
            bf16x8 a[4], bb[4];
            if (k0 < 256) {
#pragma unroll
                for (int i = 0; i < 4; ++i) a[i] = *(const bf16x8*)(ap[i] + (size_t)(k >> 4) * PIN + (k & 15));
            } else {
#pragma unroll
                for (int i = 0; i < 4; ++i) {
                    const float4 s0 = *(const float4*)(sp[i] + (k - 256)), s1 = *(const float4*)(sp[i] + (k - 256) + 4);
                    bf16x8 t;
                    t[0] = (short)f2bf(s0.x); t[1] = (short)f2bf(s0.y); t[2] = (short)f2bf(s0.z); t[3] = (short)f2bf(s0.w);
                    t[4] = (short)f2bf(s1.x); t[5] = (short)f2bf(s1.y); t[6] = (short)f2bf(s1.z); t[7] = (short)f2bf(s1.w);
                    a[i] = t;
                }
            }
#pragma unroll
            for (int j = 0; j < 4; ++j) bb[j] = *(const bf16x8*)(bp + (size_t)(16 * j) * 512 + k0);
#pragma unroll
            for (int i = 0; i < 4; ++i)
#pragma unroll
                for (int j = 0; j < 4; ++j) acc[i][j] = __builtin_amdgcn_mfma_f32_16x16x32_bf16(a[i], bb[j], acc[i][j], 0, 0, 0);
        }
        const float dsk = P.in[19][l * 256 + g * 16 + fr];
#pragma unroll
        for (int i = 0; i < 4; ++i)
#pragma unroll
            for (int r = 0; r < 4; ++r) {
                const int m = mt * 64 + 16 * i + 4 * fq + r, b = m / 272, c = m % 272;
#pragma unroll
                for (int j = 0; j < 4; ++j) {
                    const int t = nt * 4 + j;
                    const size_t row = (size_t)(b * LTOT + c * 16 + t);
                    const float u = bf2f(Pb[row * PIN + g * 16 + fr]);
                    YA[row * DM + g * 16 + fr] = f2bf(gelu_tanh(acc[i][j][r] + dsk * u));
                }
            }
    }
}


#define OFF_T8 OFF_P
#define OFF_T8S (OFF_P + (size_t)2 * 16384 * 1024)
typedef float f32x2 __attribute__((ext_vector_type(2)));
__device__ __forceinline__ void phase_tabconv8(const Params& P, int l) {
    const int lane = otid() & 63, wave = __builtin_amdgcn_readfirstlane(otid() >> 6);
    unsigned char* T8 = P.ws + OFF_T8;
    float* T8S = (float*)(P.ws + OFF_T8S);
    for (int row = blockIdx.x * 4 + wave; row < 32768; row += gridDim.x * 4) {
        const float* src = P.in[37 + (row >> 14)] + ((size_t)l * 16384 + (row & 16383)) * 1024 + 16 * lane;
        f32x4 x[4];
        float am = 0.f;
#pragma unroll
        for (int j = 0; j < 4; ++j) { x[j] = *(const f32x4*)(src + 4 * j); am = fmaxf(am, fmaxf(fmaxf(fabsf(x[j][0]), fabsf(x[j][1])), fmaxf(fabsf(x[j][2]), fabsf(x[j][3])))); }
#pragma unroll
        for (int o = 32; o > 0; o >>= 1) am = fmaxf(am, __shfl_xor(am, o, 64));
        const float sc = am > 0.f ? 224.f / am : 1.f;
        u32x4 pk;
#pragma unroll
        for (int j = 0; j < 4; ++j) {
            int p = __builtin_amdgcn_cvt_pk_fp8_f32(x[j][0] * sc, x[j][1] * sc, 0, false);
            p = __builtin_amdgcn_cvt_pk_fp8_f32(x[j][2] * sc, x[j][3] * sc, p, true);
            pk[j] = (unsigned)p;
        }
        *(u32x4*)(T8 + (size_t)row * 1024 + 16 * lane) = pk;
        if (lane == 0) T8S[row] = am * (1.f / 224.f);
    }
}
__device__ __forceinline__ void phase_gather8(const Params& P, int l, unsigned char* smem) {
    const int tid = otid(), lane = tid & 63, wave = __builtin_amdgcn_readfirstlane(tid >> 6);
    float* XS = (float*)(P.ws + OFF_XS);
    const float* MOD = (const float*)(P.ws + OFF_MOD);
    const bf16_t* H2 = (const bf16_t*)(P.ws + OFF_H2);
    bf16_t* H = (bf16_t*)(P.ws + OFF_H);
    const int* IDX = (const int*)(P.ws + OFF_IDX);
    const float* GATE = (const float*)(P.ws + OFF_GATE);
    const unsigned char* TU = P.ws + OFF_T8;
    const unsigned char* TV = TU + (size_t)16384 * 1024;
    const float* SU = (const float*)(P.ws + OFF_T8S);
    const float* SV = SU + 16384;
    float* coef = (float*)smem + wave * 128;
    for (int row = blockIdx.x * 4 + wave; row < MROWS; row += gridDim.x * 4) {
        if (l == 1 && (row % LTOT) < CTX) continue;
        float hv[16];
        {
            const u32x4 h0 = *(const u32x4*)(H2 + (size_t)row * DM + 16 * lane), h1 = *(const u32x4*)(H2 + (size_t)row * DM + 16 * lane + 8);
#pragma unroll
            for (int j = 0; j < 4; ++j) { hv[2 * j] = __uint_as_float(h0[j] << 16); hv[2 * j + 1] = __uint_as_float(h0[j] & 0xFFFF0000u); hv[8 + 2 * j] = __uint_as_float(h1[j] << 16); hv[9 + 2 * j] = __uint_as_float(h1[j] & 0xFFFF0000u); }
        }
        const int e0 = IDX[(size_t)row * 128 + lane], e1 = IDX[(size_t)row * 128 + 64 + lane];
        const float g0 = GATE[(size_t)row * 128 + lane], g1 = GATE[(size_t)row * 128 + 64 + lane];
        const float su0 = SU[e0], su1 = SU[e1], sv0 = SV[e0], sv1 = SV[e1];
        u32x4 rr[8];
#define LOAD8(T, bt) { _Pragma("unroll") for (int i = 0; i < 8; ++i) { const int k = (bt) * 8 + i; const int e = __builtin_amdgcn_readlane(k < 64 ? e0 : e1, k & 63); \
            rr[i] = *(const u32x4*)((T) + (size_t)e * 1024 + 16 * lane); } }
        for (int bt = 0; bt < 16; ++bt) {
            LOAD8(TU, bt)
            float p[8];
#pragma unroll
            for (int i = 0; i < 8; ++i) {
                float a = 0.f;
#pragma unroll
                for (int j = 0; j < 4; ++j) {
                    const f32x2 lo = __builtin_amdgcn_cvt_pk_f32_fp8((int)rr[i][j], false), hi = __builtin_amdgcn_cvt_pk_f32_fp8((int)rr[i][j], true);
                    a += lo[0] * hv[4 * j] + lo[1] * hv[4 * j + 1] + hi[0] * hv[4 * j + 2] + hi[1] * hv[4 * j + 3];
                }
                p[i] = a;
            }
            float q[4], r2[2];
#pragma unroll
            for (int i = 0; i < 4; ++i) { const float sd = (lane & 32) ? p[i] : p[i + 4]; const float rc = __shfl_xor(sd, 32, 64); q[i] = ((lane & 32) ? p[i + 4] : p[i]) + rc; }
#pragma unroll
            for (int i = 0; i < 2; ++i) { const float sd = (lane & 16) ? q[i] : q[i + 2]; const float rc = __shfl_xor(sd, 16, 64); r2[i] = ((lane & 16) ? q[i + 2] : q[i]) + rc; }
            float sv;
            { const float sd = (lane & 8) ? r2[0] : r2[1]; const float rc = __shfl_xor(sd, 8, 64); sv = ((lane & 8) ? r2[1] : r2[0]) + rc; }
            sv += __shfl_xor(sv, 4, 64); sv += __shfl_xor(sv, 2, 64); sv += __shfl_xor(sv, 1, 64);
            const int k = bt * 8 + ((lane >> 3) & 7);
            const float suk = __shfl(k < 64 ? su0 : su1, k & 63, 64), svk = __shfl(k < 64 ? sv0 : sv1, k & 63, 64), gk = __shfl(k < 64 ? g0 : g1, k & 63, 64);
            if ((lane & 7) == 0) coef[k] = gelu_tanh(sv * suk) * gk * svk;
        }
        float acc[16];
#pragma unroll
        for (int j = 0; j < 16; ++j) acc[j] = 0.f;
        for (int bt = 0; bt < 16; ++bt) {
            LOAD8(TV, bt)
#pragma unroll
            for (int i = 0; i < 8; ++i) {
                const float c = coef[bt * 8 + i];
#pragma unroll
                for (int j = 0; j < 4; ++j) {
                    const f32x2 lo = __builtin_amdgcn_cvt_pk_f32_fp8((int)rr[i][j], false), hi = __builtin_amdgcn_cvt_pk_f32_fp8((int)rr[i][j], true);
                    acc[4 * j] += c * lo[0]; acc[4 * j + 1] += c * lo[1]; acc[4 * j + 2] += c * hi[0]; acc[4 * j + 3] += c * hi[1];
                }
            }
        }
#undef LOAD8
        const float* mod = MOD + (size_t)(l * 5 + modrow(row)) * 6144;
        const int d0 = 16 * lane;
        float v[16]; float s = 0.f;
#pragma unroll
        for (int j = 0; j < 4; ++j) {
            const f32x4 x = *(const f32x4*)(XS + (size_t)row * DM + d0 + 4 * j), g = *(const f32x4*)(mod + 5120 + d0 + 4 * j);
#pragma unroll
            for (int e = 0; e < 4; ++e) { v[4 * j + e] = ALPHA * x[e] + g[e] * acc[4 * j + e]; s += v[4 * j + e]; }
        }
        const float mean = wave_sum(s) * (1.f / 1024.f);
        float qq = 0.f;
#pragma unroll
        for (int j = 0; j < 16; ++j) { v[j] -= mean; qq += v[j] * v[j]; }
        const float rs = rsqrtf(wave_sum(qq) * (1.f / 1024.f) + 1e-5f);
        const float* mod1 = MOD + (size_t)(1 * 5 + modrow(row)) * 6144;
#pragma unroll
        for (int j = 0; j < 4; ++j) {
            const int d = d0 + 4 * j;
            const f32x4 gg = *(const f32x4*)(P.in[10] + l * 1024 + d), bb = *(const f32x4*)(P.in[11] + l * 1024 + d);
            f32x4 o;
#pragma unroll
            for (int e = 0; e < 4; ++e) o[e] = v[4 * j + e] * rs * gg[e] + bb[e];
            if (l == 0) {
                *(f32x4*)(XS + (size_t)row * DM + d) = o;
                const f32x4 sh = *(const f32x4*)(mod1 + d), sc = *(const f32x4*)(mod1 + 1024 + d);
                const unsigned w0 = f2bf(o[0] * (1.f + sc[0]) + sh[0]) | ((unsigned)f2bf(o[1] * (1.f + sc[1]) + sh[1]) << 16);
                const unsigned w1 = f2bf(o[2] * (1.f + sc[2]) + sh[2]) | ((unsigned)f2bf(o[3] * (1.f + sc[3]) + sh[3]) << 16);
                *(uint2*)(H + (size_t)row * DM + d) = make_uint2(w0, w1);
            } else {
                const int b = row / LTOT, t = row % LTOT - CTX;
                *(f32x4*)(P.out + ((size_t)b * SEQ + t) * DM + d) = o;
            }
        }
    }
}

__device__ __forceinline__ void rwkv_prep_step(const bf16_t* RW, int b, int hd, int dir, int tau_base, unsigned char* buf, float ka, int wave, int lane) {
    bf16_t* KR = (bf16_t*)buf; bf16_t* BK = (bf16_t*)(buf + 4608); bf16_t* BbT = (bf16_t*)(buf + 9216); bf16_t* KbT = (bf16_t*)(buf + 11264); float* gT = (float*)(buf + 13312);
    const int ch = hd * 64 + lane;
    float cs[16];
    {
        float c = 0.f;
#pragma unroll
        for (int t = 0; t < 16; ++t) { const int row = row_of(b, dir, tau_base + t); c += bf2f(RW[(size_t)row * RWW + 3072 + dir * 512 + ch]); cs[t] = c; }
    }
    const float c15 = cs[15];
    if (wave == 0) gT[lane] = __expf(c15);
    bf16_t bb[4], kb[4];
#pragma unroll
    for (int t = 0; t < 16; ++t) {
        if ((t >> 2) == wave) {
            const int row = row_of(b, dir, tau_base + t);
            const bf16_t* rw = RW + (size_t)row * RWW + ch;
            const float r = bf2f(rw[0]), k = bf2f(rw[512]), kap = bf2f(rw[1536]), a = bf2f(rw[2048 + dir * 512]);
            const float cp = t > 0 ? cs[t > 0 ? t - 1 : 0] : 0.f, ct = cs[t];
            const float ep = __expf(cp), et = __expf(ct), em = __expf(-ct), eT = __expf(c15 - ct);
            const float beta = kap * a, kt = k * (1.f + (a - 1.f) * ka);
            KR[t * 72 + lane] = f2bf(kap * ep); KR[(16 + t) * 72 + lane] = f2bf(r * et);
            BK[t * 72 + lane] = f2bf(beta * em); BK[(16 + t) * 72 + lane] = f2bf(kt * em);
            bb[t & 3] = f2bf(beta * eT); kb[t & 3] = f2bf(kt * eT);
        }
    }
    uint2 pb, pk;
    pb.x = bb[0] | ((unsigned)bb[1] << 16); pb.y = bb[2] | ((unsigned)bb[3] << 16);
    pk.x = kb[0] | ((unsigned)kb[1] << 16); pk.y = kb[2] | ((unsigned)kb[3] << 16);
    *(uint2*)(BbT + lane * 16 + 4 * wave) = pb;
    *(uint2*)(KbT + lane * 16 + 4 * wave) = pk;
}
template <int NV>
__device__ __forceinline__ void rwkv_prep_vt(const bf16_t* RW, int b, int hd, int dir, int tau_base, int vbase, bf16_t* VT, int lane) {
    if (NV == 2) {
        const int vl = lane & 31, th = lane >> 5;
        bf16_t x[8];
#pragma unroll
        for (int i = 0; i < 8; ++i) { const int row = row_of(b, dir, tau_base + th * 8 + i); x[i] = RW[(size_t)row * RWW + 1024 + hd * 64 + vbase + vl]; }
        uint4 pk; pk.x = x[0] | ((unsigned)x[1] << 16); pk.y = x[2] | ((unsigned)x[3] << 16); pk.z = x[4] | ((unsigned)x[5] << 16); pk.w = x[6] | ((unsigned)x[7] << 16);
        *(uint4*)(VT + vl * 16 + th * 8) = pk;
    } else {
        const int vl = lane & 15, tq = lane >> 4;
        bf16_t x[4];
#pragma unroll
        for (int i = 0; i < 4; ++i) { const int row = row_of(b, dir, tau_base + tq * 4 + i); x[i] = RW[(size_t)row * RWW + 1024 + hd * 64 + vbase + vl]; }
        uint2 pk; pk.x = x[0] | ((unsigned)x[1] << 16); pk.y = x[2] | ((unsigned)x[3] << 16);
        *(uint2*)(VT + vl * 16 + tq * 4) = pk;
    }
}
template <int NV, bool HASV, bool OUT>
__device__ __forceinline__ void rwkv_mfma_step(f32x4 (&X)[4][NV], const unsigned char* buf, const bf16_t* VT, f32x4 (&Yout)[NV], int lane) {
    const bf16_t* KR = (const bf16_t*)buf; const bf16_t* BK = (const bf16_t*)(buf + 4608); const bf16_t* BbT = (const bf16_t*)(buf + 9216); const bf16_t* KbT = (const bf16_t*)(buf + 11264); const float* gT = (const float*)(buf + 13312);
    const int fr = lane & 15, fq = lane >> 4;
    const f32x4 z4 = {0.f, 0.f, 0.f, 0.f};
    f32x4 cA = z4, cN = z4, cAk = z4, cRb = z4, cRk = z4;
#pragma unroll
    for (int ks = 0; ks < 2; ++ks) {
        const bf16x8 kh = *(const bf16x8*)(KR + fr * 72 + 32 * ks + 8 * fq), rh = *(const bf16x8*)(KR + (16 + fr) * 72 + 32 * ks + 8 * fq);
        const bf16x8 bc = *(const bf16x8*)(BK + fr * 72 + 32 * ks + 8 * fq), kc = *(const bf16x8*)(BK + (16 + fr) * 72 + 32 * ks + 8 * fq);
        cA = mfma32(kh, bc, cA); cN = mfma32(bc, kh, cN); cAk = mfma32(kc, kh, cAk);
        if (OUT) { cRb = mfma32(bc, rh, cRb); cRk = mfma32(kc, rh, cRk); }
    }
    f32x4 dg;
#pragma unroll
    for (int r = 0; r < 4; ++r) {
        const int row = 4 * fq + r;
        dg[r] = (row == fr) ? 1.f : 0.f;
        cA[r] = (fr < row) ? cA[r] : 0.f;
        cN[r] = (row < fr) ? cN[r] : 0.f;
        cAk[r] = (row < fr) ? cAk[r] : 0.f;
        cRb[r] = (row <= fr) ? cRb[r] : 0.f;
        cRk[r] = (row <= fr) ? cRk[r] : 0.f;
    }
    const bf16x4 a4 = to4(cA), n4 = to4(cN);
    const f32x4 cA2 = mfma16(n4, a4, z4), cN2 = mfma16(a4, n4, z4);
    const bf16x4 a24 = to4(cA2), n24 = to4(cN2);
    const f32x4 cA4 = mfma16(n24, a24, z4), cN4 = mfma16(a24, n24, z4);
    const f32x4 cA8 = mfma16(to4(cN4), to4(cA4), z4);
    const f32x4 T1 = mfma16(to4(dg - cA), to4(dg + cN2), z4);
    const f32x4 T2 = mfma16(to4(dg + cA4), to4(T1), z4);
    const f32x4 WT = mfma16(to4(dg + cA8), to4(T2), z4);
    const bf16x4 wt4 = to4(WT), aak4 = to4(cAk), rab4 = to4(cRb), rak4 = to4(cRk);
    bf16x8 aK[2], aR[2];
#pragma unroll
    for (int ks = 0; ks < 2; ++ks) {
        aK[ks] = cat8(*(const bf16x4*)(KR + fr * 72 + 32 * ks + 4 * fq), *(const bf16x4*)(KR + fr * 72 + 32 * ks + 16 + 4 * fq));
        if (OUT) aR[ks] = cat8(*(const bf16x4*)(KR + (16 + fr) * 72 + 32 * ks + 4 * fq), *(const bf16x4*)(KR + (16 + fr) * 72 + 32 * ks + 16 + 4 * fq));
    }
    bf16x4 u4[NV], vt4[NV];
#pragma unroll
    for (int nj = 0; nj < NV; ++nj) {
        const bf16x8 b0 = cat8(to4(X[0][nj]), to4(X[1][nj])), b1 = cat8(to4(X[2][nj]), to4(X[3][nj]));
        f32x4 G = mfma32(aK[1], b1, mfma32(aK[0], b0, z4));
        if (HASV) { vt4[nj] = *(const bf16x4*)(VT + (16 * nj + fr) * 16 + 4 * fq); G = mfma16(aak4, vt4[nj], G); }
        const f32x4 U = mfma16(wt4, to4(G), z4);
        u4[nj] = to4(-U);
        if (OUT) {
            f32x4 Yv = mfma32(aR[1], b1, mfma32(aR[0], b0, z4));
            Yv = mfma16(rab4, u4[nj], Yv);
            if (HASV) Yv = mfma16(rak4, vt4[nj], Yv);
            Yout[nj] = Yv;
        }
    }
#pragma unroll
    for (int mi = 0; mi < 4; ++mi) {
        const f32x4 g4 = *(const f32x4*)(gT + 16 * mi + 4 * fq);
        const bf16x4 bb4 = *(const bf16x4*)(BbT + (16 * mi + fr) * 16 + 4 * fq), kb4 = *(const bf16x4*)(KbT + (16 * mi + fr) * 16 + 4 * fq);
#pragma unroll
        for (int nj = 0; nj < NV; ++nj) {
            f32x4 x = X[mi][nj] * g4;
            x = mfma16(bb4, u4[nj], x);
            if (HASV) x = mfma16(kb4, vt4[nj], x);
            X[mi][nj] = x;
        }
    }
}
__device__ __forceinline__ void rwkv_passA(const Params& P, int l, unsigned char* smem, int bid, int nb) {
    const int lane = otid() & 63, wave = __builtin_amdgcn_readfirstlane(otid() >> 6), fr = lane & 15, fq = lane >> 4;
    const bf16_t* RW = (const bf16_t*)(P.ws + OFF_RW);
    float* RXL = (float*)(P.ws + OFF_RXL);
    bf16_t* RXP = (bf16_t*)P.out;
    for (int item = bid; item < 64 * RW_NCH; item += nb) {
        const int seq = item / RW_NCH, c = item % RW_NCH, dir = seq & 1, hd = (seq >> 1) & 7, b = seq >> 4;
        const float ka = P.in[31][l * 512 + hd * 64 + lane];
        const int tau0 = c * 128;
        f32x4 X[4][2], Yd[2];
#pragma unroll
        for (int mi = 0; mi < 4; ++mi)
#pragma unroll
            for (int nj = 0; nj < 2; ++nj)
#pragma unroll
                for (int r = 0; r < 4; ++r) X[mi][nj][r] = (wave >= 2 && (16 * mi + 4 * fq + r) == (16 * (2 * (wave - 2) + nj) + fr)) ? 1.f : 0.f;
        bf16_t* VTw = (bf16_t*)(smem + RW_VT0 + wave * 2048);
        rwkv_prep_step(RW, b, hd, dir, tau0, smem, ka, wave, lane);
        if (wave < 2) rwkv_prep_vt<2>(RW, b, hd, dir, tau0, 32 * wave, VTw, lane);
        __syncthreads();
        for (int s = 0; s < 8; ++s) {
            if (s < 7) {
                rwkv_prep_step(RW, b, hd, dir, tau0 + (s + 1) * 16, smem + ((s + 1) & 1) * RW_BUF, ka, wave, lane);
                if (wave < 2) rwkv_prep_vt<2>(RW, b, hd, dir, tau0 + (s + 1) * 16, 32 * wave, VTw + ((s + 1) & 1) * 512, lane);
            }
            if (wave < 2) rwkv_mfma_step<2, true, false>(X, smem + (s & 1) * RW_BUF, VTw + (s & 1) * 512, Yd, lane);
            else rwkv_mfma_step<2, false, false>(X, smem + (s & 1) * RW_BUF, VTw, Yd, lane);
            __syncthreads();
        }
        if (wave < 2) {
#pragma unroll
            for (int mi = 0; mi < 4; ++mi)
#pragma unroll
                for (int nj = 0; nj < 2; ++nj) *(f32x4*)(RXL + (((size_t)item * 16 + mi * 4 + 2 * wave + nj) * 64 + lane) * 4) = X[mi][nj];
        } else {
#pragma unroll
            for (int mi = 0; mi < 4; ++mi)
#pragma unroll
                for (int nj = 0; nj < 2; ++nj)
#pragma unroll
                    for (int r = 0; r < 4; ++r) RXP[(size_t)item * 4096 + (16 * mi + 4 * fq + r) * 64 + 16 * (2 * (wave - 2) + nj) + fr] = f2bf(X[mi][nj][r]);
        }
    }
}
__device__ __forceinline__ void rwkv_passB(const Params& P) {
    const int lane = otid() & 63, wave = __builtin_amdgcn_readfirstlane(otid() >> 6), fr = lane & 15, fq = lane >> 4;
    float* RXL = (float*)(P.ws + OFF_RXL);
    const bf16_t* RXP = (const bf16_t*)P.out;
    for (int it = blockIdx.x * 4 + wave; it < 256; it += gridDim.x * 4) {
        const int seq = it >> 2, nj = it & 3;
        f32x4 X[4];
#pragma unroll
        for (int mi = 0; mi < 4; ++mi) X[mi] = (f32x4){0.f, 0.f, 0.f, 0.f};
        for (int c = 0; c < RW_NCH; ++c) {
            const size_t item = (size_t)seq * RW_NCH + c;
            f32x4 L[4]; bf16x8 a[4][2];
#pragma unroll
            for (int mi = 0; mi < 4; ++mi) {
                L[mi] = *(const f32x4*)(RXL + ((item * 16 + mi * 4 + nj) * 64 + lane) * 4);
                const bf16_t* xp = RXP + item * 4096 + (16 * mi + fr) * 64;
#pragma unroll
                for (int ks = 0; ks < 2; ++ks) a[mi][ks] = cat8(*(const bf16x4*)(xp + 32 * ks + 4 * fq), *(const bf16x4*)(xp + 32 * ks + 16 + 4 * fq));
            }
            const bf16x8 b0 = cat8(to4(X[0]), to4(X[1])), b1 = cat8(to4(X[2]), to4(X[3]));
#pragma unroll
            for (int mi = 0; mi < 4; ++mi) {
                *(f32x4*)(RXL + ((item * 16 + mi * 4 + nj) * 64 + lane) * 4) = X[mi];
                X[mi] = mfma32(a[mi][1], b1, mfma32(a[mi][0], b0, L[mi]));
            }
        }
    }
}
template <bool CHECK>
__device__ __forceinline__ void rwkv_passC(const Params& P, int l, unsigned char* smem) {
    const int lane = otid() & 63, wave = __builtin_amdgcn_readfirstlane(otid() >> 6), fr = lane & 15, fq = lane >> 4;
    const bf16_t* RW = (const bf16_t*)(P.ws + OFF_RW);
    const float* RXL = (const float*)(P.ws + OFF_RXL);
    for (int item = blockIdx.x; item < 64 * RW_NCH; item += gridDim.x) {
        const int seq = item / RW_NCH, c = item % RW_NCH, dir = seq & 1, hd = (seq >> 1) & 7, b = seq >> 4;
        if (l == 1 && dir == 0 && c < 2) continue;
        if (l == 1 && dir == 1 && c < 2) continue;
        bf16_t* YP = (bf16_t*)(P.ws + OFF_YP) + (size_t)dir * MROWS * DM;
        const float ka = P.in[31][l * 512 + hd * 64 + lane];
        const int tau0 = c * 128;
        f32x4 X[4][1], Yo[1];
#pragma unroll
        for (int mi = 0; mi < 4; ++mi) X[mi][0] = *(const f32x4*)(RXL + (((size_t)item * 16 + mi * 4 + wave) * 64 + lane) * 4);
        bf16_t* VTw = (bf16_t*)(smem + RW_VT0 + wave * 2048);
        rwkv_prep_step(RW, b, hd, dir, tau0, smem, ka, wave, lane);
        rwkv_prep_vt<1>(RW, b, hd, dir, tau0, 16 * wave, VTw, lane);
        __syncthreads();
        for (int s = 0; s < 8; ++s) {
            if (s < 7) {
                rwkv_prep_step(RW, b, hd, dir, tau0 + (s + 1) * 16, smem + ((s + 1) & 1) * RW_BUF, ka, wave, lane);
                rwkv_prep_vt<1>(RW, b, hd, dir, tau0 + (s + 1) * 16, 16 * wave, VTw + ((s + 1) & 1) * 512, lane);
            }
            rwkv_mfma_step<1, true, true>(X, smem + (s & 1) * RW_BUF, VTw + (s & 1) * 512, Yo, lane);
#pragma unroll
            for (int r = 0; r < 4; ++r) {
                const int row = row_of(b, dir, tau0 + s * 16 + 4 * fq + r);
                if (CHECK) { if (YP[(size_t)row * DM + 512 + hd * 64 + 16 * wave + fr] != f2bf(Yo[0][r])) atomicAdd((unsigned*)(P.ws + OFF_BAR + 15360), 1u); }
                else YP[(size_t)row * DM + 512 + hd * 64 + 16 * wave + fr] = f2bf(Yo[0][r]);
            }
            __syncthreads();
        }
    }
}


#define HG_NCH 34
#define HG_BUF 7168
#define HG_VT0 14336
#define OFF_O_RXP 0ull
#define OFF_O_HXL ((size_t)2176 * 8192)
#define OFF_O_HD (OFF_O_HXL + (size_t)1088 * 16384)
__device__ __forceinline__ float hgrn_prep_step(const bf16_t* Pb, int b, int hd, int dir, int tau_base, unsigned char* buf, float lb, int wave, int lane) {
    bf16_t* QH = (bf16_t*)buf; bf16_t* KC = (bf16_t*)(buf + 2304); bf16_t* KbT = (bf16_t*)(buf + 4608); float* gT = (float*)(buf + 6656);
    float cs[16], fv[16];
    {
        float c = 0.f;
#pragma unroll
        for (int t = 0; t < 16; ++t) {
            const int row = row_of(b, dir, tau_base + t);
            const float f = lb + (1.f - lb) * sigmoidf_(bf2f(Pb[(size_t)row * PIN + 768 + dir * 256 + hd * 64 + lane]));
            fv[t] = f; c += __logf(f); cs[t] = c;
        }
    }
    const float c15 = cs[15];
    if (wave == 0) gT[lane] = __expf(c15);
    bf16_t kb[4];
#pragma unroll
    for (int t = 0; t < 16; ++t) {
        if ((t >> 2) == wave) {
            const int row = row_of(b, dir, tau_base + t);
            const float q = siluf_(bf2f(Pb[(size_t)row * PIN + 256 + hd * 64 + lane]));
            const float ct = cs[t], k = 1.f - fv[t];
            QH[t * 72 + lane] = f2bf(q * __expf(ct));
            KC[t * 72 + lane] = f2bf(k * __expf(fminf(-ct, 80.f)));
            kb[t & 3] = f2bf(k * __expf(c15 - ct));
        }
    }
    uint2 pk; pk.x = kb[0] | ((unsigned)kb[1] << 16); pk.y = kb[2] | ((unsigned)kb[3] << 16);
    *(uint2*)(KbT + lane * 16 + 4 * wave) = pk;
    return c15;
}
__device__ __forceinline__ void hgrn_prep_vt(const bf16_t* Pb, int b, int hd, int dir, int tau_base, int vbase, bf16_t* VT, int lane) {
    const int vl = lane & 15, tq = lane >> 4;
    bf16_t x[4];
#pragma unroll
    for (int i = 0; i < 4; ++i) { const int row = row_of(b, dir, tau_base + tq * 4 + i); x[i] = Pb[(size_t)row * PIN + 512 + hd * 64 + vbase + vl]; }
    uint2 pk; pk.x = x[0] | ((unsigned)x[1] << 16); pk.y = x[2] | ((unsigned)x[3] << 16);
    *(uint2*)(VT + vl * 16 + tq * 4) = pk;
}
template <bool OUT>
__device__ __forceinline__ void hgrn_mfma_step(f32x4 (&X)[4], const unsigned char* buf, const bf16_t* VT, f32x4& Yout, int lane) {
    const bf16_t* QH = (const bf16_t*)buf; const bf16_t* KC = (const bf16_t*)(buf + 2304); const bf16_t* KbT = (const bf16_t*)(buf + 4608); const float* gT = (const float*)(buf + 6656);
    const int fr = lane & 15, fq = lane >> 4;
    const f32x4 z4 = {0.f, 0.f, 0.f, 0.f};
    const bf16x4 vt4 = *(const bf16x4*)(VT + fr * 16 + 4 * fq);
    if (OUT) {
        f32x4 cAT = z4;
#pragma unroll
        for (int ks = 0; ks < 2; ++ks) {
            const bf16x8 kc = *(const bf16x8*)(KC + fr * 72 + 32 * ks + 8 * fq), qh = *(const bf16x8*)(QH + fr * 72 + 32 * ks + 8 * fq);
            cAT = mfma32(kc, qh, cAT);
        }
#pragma unroll
        for (int r = 0; r < 4; ++r) cAT[r] = ((4 * fq + r) <= fr) ? cAT[r] : 0.f;
        const bf16x8 aQ0 = cat8(*(const bf16x4*)(QH + fr * 72 + 4 * fq), *(const bf16x4*)(QH + fr * 72 + 16 + 4 * fq));
        const bf16x8 aQ1 = cat8(*(const bf16x4*)(QH + fr * 72 + 32 + 4 * fq), *(const bf16x4*)(QH + fr * 72 + 48 + 4 * fq));
        const bf16x8 b0 = cat8(to4(X[0]), to4(X[1])), b1 = cat8(to4(X[2]), to4(X[3]));
        f32x4 O = mfma32(aQ1, b1, mfma32(aQ0, b0, z4));
        Yout = mfma16(to4(cAT), vt4, O);
    }
#pragma unroll
    for (int mi = 0; mi < 4; ++mi) {
        const f32x4 g4 = *(const f32x4*)(gT + 16 * mi + 4 * fq);
        const bf16x4 kb4 = *(const bf16x4*)(KbT + (16 * mi + fr) * 16 + 4 * fq);
        X[mi] = mfma16(kb4, vt4, X[mi] * g4);
    }
}
__device__ __forceinline__ float hgrn_lb(const Params& P, int l, int dir, int ch) {
    if (l == 0) return 0.f;
    const float a0 = P.in[22][(dir * 2 + 0) * 256 + ch], a1 = P.in[22][(dir * 2 + 1) * 256 + ch];
    const float m = fmaxf(a0, a1), e0 = __expf(a0 - m), e1 = __expf(a1 - m);
    return e1 / (e0 + e1);
}
template <bool OUT>
__device__ __forceinline__ void hgrn_pass(const Params& P, int l, unsigned char* smem) {
    const int lane = otid() & 63, wave = __builtin_amdgcn_readfirstlane(otid() >> 6), fr = lane & 15, fq = lane >> 4;
    const bf16_t* Pb = (const bf16_t*)(P.ws + OFF_P);
    float* HXL = (float*)((unsigned char*)P.out + OFF_O_HXL);
    float* HD = (float*)((unsigned char*)P.out + OFF_O_HD);
    for (int item = blockIdx.x; item < 32 * HG_NCH; item += gridDim.x) {
        const int seq = item / HG_NCH, c = item % HG_NCH, dir = seq & 1, hd = (seq >> 1) & 3, b = seq >> 3;
        if (OUT && l == 1 && c < 2) continue;
        bf16_t* YP = (bf16_t*)(P.ws + OFF_YP) + (size_t)dir * MROWS * DM;
        const float lb = hgrn_lb(P, l, dir, hd * 64 + lane);
        const int tau0 = c * 128;
        f32x4 X[4], Yo;
#pragma unroll
        for (int mi = 0; mi < 4; ++mi) X[mi] = OUT ? *(const f32x4*)(HXL + (((size_t)item * 16 + mi * 4 + wave) * 64 + lane) * 4) : (f32x4){0.f, 0.f, 0.f, 0.f};
        bf16_t* VTw = (bf16_t*)(smem + HG_VT0 + wave * 1024);
        float ctot = hgrn_prep_step(Pb, b, hd, dir, tau0, smem, lb, wave, lane);
        hgrn_prep_vt(Pb, b, hd, dir, tau0, 16 * wave, VTw, lane);
        __syncthreads();
        for (int s = 0; s < 8; ++s) {
            if (s < 7) {
                ctot += hgrn_prep_step(Pb, b, hd, dir, tau0 + (s + 1) * 16, smem + ((s + 1) & 1) * HG_BUF, lb, wave, lane);
                hgrn_prep_vt(Pb, b, hd, dir, tau0 + (s + 1) * 16, 16 * wave, VTw + ((s + 1) & 1) * 256, lane);
            }
            hgrn_mfma_step<OUT>(X, smem + (s & 1) * HG_BUF, VTw + (s & 1) * 256, Yo, lane);
            if (OUT) {
#pragma unroll
                for (int r = 0; r < 4; ++r) {
                    const int row = row_of(b, dir, tau0 + s * 16 + 4 * fq + r);
                    YP[(size_t)row * DM + 256 + hd * 64 + 16 * wave + fr] = f2bf(Yo[r]);
                }
            }
            __syncthreads();
        }
        if (!OUT) {
#pragma unroll
            for (int mi = 0; mi < 4; ++mi) *(f32x4*)(HXL + (((size_t)item * 16 + mi * 4 + wave) * 64 + lane) * 4) = X[mi];
            if (wave == 0) HD[(size_t)item * 64 + lane] = __expf(ctot);
        }
    }
}
__device__ __forceinline__ void hgrn_carry(const Params& P, int bid, int nb) {
    float* HXL = (float*)((unsigned char*)P.out + OFF_O_HXL);
    const float* HD = (const float*)((unsigned char*)P.out + OFF_O_HD);
    for (int u = bid; u < 128; u += nb) {
        const int gid = u * 256 + otid(), ln = gid & 63, tile = (gid >> 6) & 15, seq = gid >> 10;
        const int mi = tile >> 2, fq = ln >> 4;
        f32x4 x = {0.f, 0.f, 0.f, 0.f};
        for (int c0 = 0; c0 < HG_NCH; c0 += 17) {
            f32x4 L[17];
#pragma unroll
            for (int i = 0; i < 17; ++i) {
                const size_t item = (size_t)seq * HG_NCH + c0 + i;
                L[i] = *(const f32x4*)(HXL + ((item * 16 + tile) * 64 + ln) * 4);
            }
#pragma unroll
            for (int i = 0; i < 17; ++i) {
                const size_t item = (size_t)seq * HG_NCH + c0 + i;
                const f32x4 D = *(const f32x4*)(HD + item * 64 + 16 * mi + 4 * fq);
                *(f32x4*)(HXL + ((item * 16 + tile) * 64 + ln) * 4) = x;
                x = D * x + L[i];
            }
        }
    }
}


__device__ __forceinline__ void phase_rwprep2(const Params& P, int l, unsigned char* smem) {
    const int tid = otid(), lane = tid & 63, wave = __builtin_amdgcn_readfirstlane(tid >> 6), fr = lane & 15, fq = lane >> 4;
    const bf16_t* Pb = (const bf16_t*)(P.ws + OFF_P);
    bf16_t* RW = (bf16_t*)(P.ws + OFF_RW);
    const bf16_t* LW = (const bf16_t*)(P.ws + OFF_LW);
    const float* mu = P.in[24] + l * 1920;
    bf16_t* AL = (bf16_t*)smem;
    float muv[8];
#pragma unroll
    for (int jj = 0; jj < 8; ++jj) muv[jj] = (tid + 256 * jj) < 1920 ? mu[tid + 256 * jj] : 0.f;
    const float kk0 = P.in[30][l * 512 + tid], kk1 = P.in[30][l * 512 + 256 + tid];
    for (int u = blockIdx.x; u < MROWS / 16; u += gridDim.x) {
        const int r0 = u * 16;
        __syncthreads();
        for (int i = 0; i < 16; ++i) {
            const int row = r0 + i, p = row % LTOT;
            int nbr; bool okk;
            {
                const int m = tid & 3;
                if (p < CTX) { nbr = (m & 1) ? row + 1 : row - 1; okk = (m & 1) ? (p < CTX - 1) : (p > 0); }
                else {
                    const int t = p - CTX, gr = t >> 6, gc = t & 63;
                    nbr = m == 0 ? row - 1 : (m == 1 ? row + 1 : (m == 2 ? row - 64 : row + 64));
                    okk = m == 0 ? (gc > 0) : (m == 1 ? (gc < 63) : (m == 2 ? (gr > 0) : (gr < 63)));
                }
            }
            const bf16_t* pp = Pb + (size_t)row * PIN + 1536 + tid;
            const bf16_t* pn = Pb + (size_t)nbr * PIN + 1536 + tid;
            bf16_t* rw = RW + (size_t)row * RWW;
            float sv[8];
#pragma unroll
            for (int jj = 0; jj < 8; ++jj) {
                if (jj < 7 || tid < 128) {
                    const float pv = bf2f(pp[256 * jj]);
                    const float nv = okk ? bf2f(pn[256 * jj]) : 0.f;
                    sv[jj] = pv + muv[jj] * (nv - pv);
                } else sv[jj] = 0.f;
            }
            rw[tid] = f2bf(sv[0]); rw[256 + tid] = f2bf(sv[1]);
            rw[512 + tid] = f2bf(sv[2]); rw[768 + tid] = f2bf(sv[3]);
            rw[1024 + tid] = f2bf(sv[4]); rw[1280 + tid] = f2bf(sv[5]);
            {
                const float a0 = sv[2] * kk0, a1 = sv[3] * kk1;
                const float n0 = fmaxf(sqrtf(wave_sum(a0 * a0)), 1e-12f), n1 = fmaxf(sqrtf(wave_sum(a1 * a1)), 1e-12f);
                rw[1536 + tid] = f2bf(a0 / n0); rw[1792 + tid] = f2bf(a1 / n1);
            }
            if (tid < 128) { rw[4096 + tid] = f2bf(sigmoidf_(sv[6])); AL[((2 + (tid >> 6)) * 16 + i) * 72 + (tid & 63)] = f2bf(sv[7]); }
            else AL[(((tid - 128) >> 6) * 16 + i) * 72 + (tid & 63)] = f2bf(tanhf(sv[6]));
        }
        __syncthreads();
        {
            const int d = wave & 1, isA = wave >> 1;
            const bf16x8 a0 = *(const bf16x8*)(AL + (wave * 16 + fr) * 72 + 8 * fq), a1 = *(const bf16x8*)(AL + (wave * 16 + fr) * 72 + 32 + 8 * fq);
            const bf16_t* W = LW + (size_t)isA * 131072 + (size_t)(l * 2 + d) * 512 * 64;
            const float* bias = P.in[isA ? 27 : 25] + (l * 2 + d) * 512;
            for (int nj = 0; nj < 32; ++nj) {
                const bf16x8 b0 = *(const bf16x8*)(W + (size_t)(16 * nj + fr) * 64 + 8 * fq), b1 = *(const bf16x8*)(W + (size_t)(16 * nj + fr) * 64 + 32 + 8 * fq);
                const f32x4 acc = mfma32(a1, b1, mfma32(a0, b0, (f32x4){0.f, 0.f, 0.f, 0.f}));
                const int c = 16 * nj + fr;
                const float bs = bias[c];
#pragma unroll
                for (int r = 0; r < 4; ++r) {
                    const float sg = sigmoidf_(bs + acc[r]);
                    RW[(size_t)(r0 + 4 * fq + r) * RWW + (isA ? 2048 : 3072) + d * 512 + c] = f2bf(isA ? sg : -0.60653066f * sg);
                }
            }
        }
    }
}
__device__ __forceinline__ void phase_post2(const Params& P, int l) {
    const int tid = otid(), lane = tid & 63, wave = __builtin_amdgcn_readfirstlane(tid >> 6), fr = lane & 15, fq = lane >> 4;
    const bf16_t* Pb = (const bf16_t*)(P.ws + OFF_P);
    const bf16_t* RW = (const bf16_t*)(P.ws + OFF_RW);
    const bf16_t* YF = (const bf16_t*)(P.ws + OFF_YP);
    const bf16_t* YB = YF + (size_t)MROWS * DM;
    const bf16_t* LW = (const bf16_t*)(P.ws + OFF_LW);
    bf16_t* MIX = (bf16_t*)(P.ws + OFF_MIX);
    const f32x4 z4 = {0.f, 0.f, 0.f, 0.f};
    for (int u = blockIdx.x; u < MROWS / 16; u += gridDim.x) {
        const int r0 = u * 16;
        if (l == 1 && (r0 % LTOT) < CTX) continue;
        {
            f32x4 acc[4] = {z4, z4, z4, z4};
            const bf16_t* ap = YF + (size_t)(r0 + fr) * DM + 8 * fq;
            const bf16_t* bp = LW + (size_t)3 * 131072 + (size_t)(l * 256 + 64 * wave + fr) * 256 + 8 * fq;
#pragma unroll
            for (int ks = 0; ks < 8; ++ks) {
                const bf16x8 a = *(const bf16x8*)(ap + 32 * ks);
#pragma unroll
                for (int j = 0; j < 4; ++j) acc[j] = mfma32(a, *(const bf16x8*)(bp + (size_t)(16 * j) * 256 + 32 * ks), acc[j]);
            }
#pragma unroll
            for (int j = 0; j < 4; ++j) {
                const int n = 64 * wave + 16 * j + fr;
                const float gb = P.in[21][l * 256 + n];
#pragma unroll
                for (int r = 0; r < 4; ++r) {
                    const size_t row = (size_t)(r0 + 4 * fq + r);
                    MIX[row * DM + n] = f2bf(bf2f(YF[row * DM + n]) * sigmoidf_(acc[j][r] + gb));
                }
            }
        }
        {
            const int i = tid >> 4, c0 = (tid & 15) * 16; const size_t row = (size_t)(r0 + i);
            float o[16], ss = 0.f;
#pragma unroll
            for (int j = 0; j < 16; ++j) { o[j] = bf2f(YF[row * DM + 256 + c0 + j]) + bf2f(YB[row * DM + 256 + c0 + j]); ss += o[j] * o[j]; }
            ss += __shfl_xor(ss, 1, 64); ss += __shfl_xor(ss, 2, 64);
            const float rs = rsqrtf(ss * (1.f / 64.f) + 1e-6f);
#pragma unroll
            for (int j = 0; j < 16; ++j) {
                const float gr = bf2f(Pb[row * PIN + 1280 + c0 + j]);
                MIX[row * DM + 256 + c0 + j] = f2bf(o[j] * rs * P.in[23][l * 256 + c0 + j] * siluf_(gr));
            }
        }
#pragma unroll 1
        for (int hh = 0; hh < 2; ++hh) {
            const int h = 2 * wave + hh;
            f32x4 g[4] = {z4, z4, z4, z4};
            const bf16_t* ap = RW + (size_t)(r0 + fr) * RWW + 4096 + 8 * fq;
            const bf16_t* bp = LW + (size_t)2 * 131072 + (size_t)(l * 512 + h * 64 + fr) * 128 + 8 * fq;
#pragma unroll
            for (int ks = 0; ks < 4; ++ks) {
                const bf16x8 a = *(const bf16x8*)(ap + 32 * ks);
#pragma unroll
                for (int j = 0; j < 4; ++j) g[j] = mfma32(a, *(const bf16x8*)(bp + (size_t)(16 * j) * 128 + 32 * ks), g[j]);
            }
#pragma unroll
            for (int r = 0; r < 4; ++r) {
                const size_t row = (size_t)(r0 + 4 * fq + r);
                const bf16_t* rw = RW + row * RWW;
                float y[4], vv[4], sum = 0.f, bon = 0.f;
#pragma unroll
                for (int j = 0; j < 4; ++j) {
                    const int c = h * 64 + 16 * j + fr;
                    y[j] = bf2f(YF[row * DM + 512 + c]) + bf2f(YB[row * DM + 512 + c]);
                    sum += y[j];
                    const float rr = bf2f(rw[c]), k = bf2f(rw[512 + c]), af = bf2f(rw[2048 + c]), ab = bf2f(rw[2560 + c]);
                    const float ka = P.in[31][l * 512 + c];
                    vv[j] = bf2f(rw[1024 + c]);
                    bon += rr * P.in[32][l * 512 + c] * k * (2.f + (af + ab - 2.f) * ka);
                }
#pragma unroll
                for (int o = 1; o < 16; o <<= 1) { sum += __shfl_xor(sum, o, 64); bon += __shfl_xor(bon, o, 64); }
                const float mean = sum * (1.f / 64.f);
                float var = 0.f;
#pragma unroll
                for (int j = 0; j < 4; ++j) { const float d = y[j] - mean; var += d * d; }
#pragma unroll
                for (int o = 1; o < 16; o <<= 1) var += __shfl_xor(var, o, 64);
                const float rs = rsqrtf(var * (1.f / 64.f) + 64e-5f);
#pragma unroll
                for (int j = 0; j < 4; ++j) {
                    const int c = h * 64 + 16 * j + fr;
                    const float yn = (y[j] - mean) * rs * P.in[33][l * 512 + c] + P.in[34][l * 512 + c];
                    MIX[row * DM + 512 + c] = f2bf((yn + bon * vv[j]) * g[j][r]);
                }
            }
        }
    }
}

__device__ __forceinline__ void run_phase(const Params& P, int ph, unsigned char* smem) {
#ifndef ONLY
    if (ph == 0) { phase_prep(P, smem); return; }
    if (ph == 1) { phase_mkh(P); return; }
#else
    if (ph < 2) return;
#endif
    const int l = (ph - 2) / PPL, s = (ph - 2) % PPL;
#ifdef ONLY
    if (s != ONLY) return;
#endif
    switch (s) {
    case 0: gemm2_bf16((const bf16_t*)(P.ws + OFF_H), DM, (const bf16_t*)(P.ws + OFF_WIN) + (size_t)l * PIN * DM, DM, MROWS, PIN, DM, false, EpiBf16{(bf16_t*)(P.ws + OFF_P), PIN}, smem); break;
    case 1: phase_rwprep2(P, l, smem); s5_passA(P, l); hgrn_pass<false>(P, l, smem); break;
    case 2: rwkv_passA(P, l, smem, blockIdx.x, gridDim.x); s5_carry(P, l, gridDim.x - 1 - blockIdx.x, gridDim.x); hgrn_carry(P, (int)((2 * gridDim.x - 33 - blockIdx.x) % gridDim.x), gridDim.x); break;
    case 3: rwkv_passB(P); s5_passC(P, l); hgrn_pass<true>(P, l, smem); break;
    case 4: rwkv_passC<false>(P, l, smem); break;
    case 5: phase_post2(P, l); break;
    case 6: gemm2_bf16((const bf16_t*)(P.ws + OFF_MIX), DM, (const bf16_t*)(P.ws + OFF_WOUT) + (size_t)l * DM * DM, DM, MROWS, DM, DM, l == 1, EpiF32{(float*)(P.ws + OFF_TMP), DM}, smem); break;
    case 7: phase_ln1(P, l); break;
    case 8: gemm2_bf16((const bf16_t*)(P.ws + OFF_H2), DM, (const bf16_t*)(P.ws + OFF_WQ) + (size_t)l * 2048 * DM, DM, MROWS, 2048, DM, l == 1, EpiBf16{(bf16_t*)(P.ws + OFF_Q), 2048}, smem); break;
    case 9: phase_topk2(P, l, smem); phase_tabconv8(P, l); break;
    case 10: phase_gather8(P, l, smem); break;
    }
}

__global__ void __launch_bounds__(256, 2) mega(Params P) {
    __shared__ __attribute__((aligned(16))) unsigned char smem[65536];
#if SINGLE
    cg::grid_group grid = cg::this_grid();
    if (threadIdx.x < 4) ((volatile LAS unsigned*)(smem + 65520))[threadIdx.x] = 0u;
    __syncthreads();
    XcdBarrier xb = xcd_barrier_post((unsigned*)(P.ws + OFF_BAR), (volatile LAS unsigned*)(smem + 65520));
#endif
    for (int ph = P.ph_lo; ph < P.ph_hi; ++ph) {
        run_phase(P, ph, smem);
#if SINGLE
        if (ph + 1 < P.ph_hi) {
            if (ph == 0) { asm volatile("s_waitcnt vmcnt(0)" ::: "memory"); __syncthreads(); grid.sync(); }
            else xcd_barrier(xb);
        }
#ifdef DUPMASK
        if (ph >= 2 && ((DUPMASK >> ((ph - 2) % PPL)) & 1)) { run_phase(P, ph, smem); xcd_barrier(xb); }
#endif
#ifdef DUP1MASK
        if (ph >= 2 + PPL && ((DUP1MASK >> ((ph - 2) % PPL)) & 1)) { run_phase(P, ph, smem); xcd_barrier(xb); }
#endif
#ifdef EXP_T3
        if (ph >= 2 && (ph - 2) % PPL == 4) { rwkv_passC<true>(P, (ph - 2) / PPL, smem); xcd_barrier(xb); }
#endif
#ifdef EXP_OLDSCAN
        if (ph >= 2 && (ph - 2) % PPL == 4) { const int wv = threadIdx.x >> 6; for (int it = wv * gridDim.x + blockIdx.x; it < 64; it += 4 * gridDim.x) scan_rwkv(P, (ph - 2) / PPL, it); xcd_barrier(xb); }
#endif
#endif
    }
}

extern "C" void kernel_launch(void* const* d_in, const int* in_sizes, int n_in, void* d_out, int out_size, void* d_ws, size_t ws_size, hipStream_t stream) {
    static int grid = 0;
    if (grid == 0) {
        if (n_in != 39 || ws_size < OFF_END) { fprintf(stderr, "kernel_launch: unexpected n_in %d or ws_size %zu (need %zu)\n", n_in, ws_size, (size_t)OFF_END); grid = -1; return; }
        int dev = 0, cus = 0, per_cu = 0;
        hipGetDevice(&dev);
        hipDeviceGetAttribute(&cus, hipDeviceAttributeMultiprocessorCount, dev);
        hipOccupancyMaxActiveBlocksPerMultiprocessor(&per_cu, mega, 256, 0);
        if (per_cu < 1) per_cu = 1;
        if (per_cu > 2) per_cu = 2;
        grid = cus * per_cu;
    }
    if (grid < 0) return;
    hipMemsetAsync((unsigned char*)d_ws + OFF_BAR, 0, 16384, stream);
    Params p{};
    for (int i = 0; i < 39; ++i) p.in[i] = (const float*)d_in[i];
    p.out = (float*)d_out; p.ws = (unsigned char*)d_ws;
#if SINGLE
    p.ph_lo = 0; p.ph_hi = NPH;
    void* args[] = {&p};
    hipError_t e = hipLaunchCooperativeKernel((void*)mega, dim3(grid), dim3(256), args, 0, stream);
    if (e != hipSuccess) fprintf(stderr, "cooperative launch failed: %s (grid %d)\n", hipGetErrorString(e), grid);
#else
    for (int ph = 0; ph < NPH; ++ph) {
        p.ph_lo = ph; p.ph_hi = ph + 1;
        hipLaunchKernelGGL(mega, dim3(grid), dim3(256), 0, stream, p);
    }
#endif
}
```

```cpp
#include <hip/hip_runtime.h>
#include <hip/hip_cooperative_groups.h>
#include <cstdio>
namespace cg = cooperative_groups;

#ifndef SINGLE
#define SINGLE 1
#endif

typedef unsigned short bf16_t;
typedef short bf16x8 __attribute__((ext_vector_type(8)));
typedef float f32x4 __attribute__((ext_vector_type(4)));
typedef __bf16 bf16x2 __attribute__((ext_vector_type(2)));

#define DM 1024
#define NB 4
#define SEQ 4096
#define CTX 256
#define LTOT 4352
#define MROWS 17408
#define PIN 3456
#define RWW 4224
#define NPH 24
#define PPL 11
#define ALPHA 1.41421356237f

#define OFF_XS 0ull
#define OFF_P (OFF_XS + (size_t)MROWS * DM * 4)
#define OFF_RW (OFF_P + (size_t)MROWS * PIN * 2)
#define OFF_YP (OFF_RW + (size_t)MROWS * RWW * 2)
#define OFF_MIX (OFF_YP + (size_t)2 * MROWS * DM * 2)
#define OFF_MOD (OFF_MIX + (size_t)MROWS * DM * 2)
#define OFF_WIN (OFF_MOD + (size_t)2 * 5 * 6144 * 4)
#define OFF_WOUT (OFF_WIN + (size_t)2 * PIN * DM * 2)
#define OFF_WQ (OFF_WOUT + (size_t)2 * DM * DM * 2)
#define OFF_S5MS (OFF_WQ + (size_t)2 * 2048 * DM * 2)
#define OFF_S5MY (OFF_S5MS + (size_t)2 * 16 * 256 * 256 * 2)
#define OFF_S5LB (OFF_S5MY + (size_t)2 * 16 * 256 * 512 * 2)
#define OFF_S5ST (OFF_S5LB + (size_t)2 * 16 * 2 * 128 * 4)
#define OFF_BAR (OFF_S5ST + (size_t)4 * 16 * 272 * 256 * 4)
#define OFF_KEYB (OFF_BAR + 16384)
#define OFF_LW (OFF_KEYB + (size_t)2 * 8 * 2 * 128 * 128 * 2)
#define OFF_LBT (OFF_LW + (size_t)4 * 131072 * 2)
#define OFF_END (OFF_LBT + 4096)
#define OFF_RXL OFF_MIX
#define OFF_TMP OFF_P
#define OFF_H OFF_YP
#define OFF_H2 (OFF_YP + (size_t)MROWS * DM * 2)
#define OFF_Q OFF_RW
#define OFF_IDX (OFF_RW + (size_t)MROWS * 2048 * 2)
#define OFF_GATE (OFF_IDX + (size_t)MROWS * 128 * 4)
#define OFF_TBU OFF_P
#define OFF_TBV (OFF_P + (size_t)16384 * 1024 * 2)

struct Params {
    const float* in[39];
    float* out;
    unsigned char* ws;
    int ph_lo, ph_hi;
};

__device__ __forceinline__ bf16_t f2bf(float f) {
    unsigned u = __float_as_uint(f);
    u += 0x7FFFu + ((u >> 16) & 1u);
    return (bf16_t)(u >> 16);
}
__device__ __forceinline__ float bf2f(bf16_t h) { return __uint_as_float(((unsigned)h) << 16); }
__device__ __forceinline__ float sigmoidf_(float x) { return 1.f / (1.f + __expf(-x)); }
__device__ __forceinline__ float siluf_(float x) { return x * sigmoidf_(x); }
__device__ __forceinline__ float gelu_tanh(float x) {
    const float u = 0.7978845608028654f * (x + 0.044715f * x * x * x);
    return 0.5f * x * (1.f + tanhf(u));
}
__device__ __forceinline__ float wave_sum(float v) {
#pragma unroll
    for (int o = 32; o > 0; o >>= 1) v += __shfl_xor(v, o, 64);
    return v;
}
typedef short bf16x4 __attribute__((ext_vector_type(4)));
#define RW_NCH 34
#define RW_BUF 13824
#define RW_VT0 27648
__device__ __forceinline__ f32x4 mfma32(bf16x8 a, bf16x8 b, f32x4 c) { return __builtin_amdgcn_mfma_f32_16x16x32_bf16(a, b, c, 0, 0, 0); }
__device__ __forceinline__ f32x4 mfma16(bf16x4 a, bf16x4 b, f32x4 c) {
    bf16x8 a8, b8;
    a8[0] = a[0]; a8[1] = a[1]; a8[2] = a[2]; a8[3] = a[3]; a8[4] = 0; a8[5] = 0; a8[6] = 0; a8[7] = 0;
    b8[0] = b[0]; b8[1] = b[1]; b8[2] = b[2]; b8[3] = b[3]; b8[4] = 0; b8[5] = 0; b8[6] = 0; b8[7] = 0;
    return __builtin_amdgcn_mfma_f32_16x16x32_bf16(a8, b8, c, 0, 0, 0);
}
__device__ __forceinline__ bf16x4 to4(f32x4 v) { bf16x4 o; o[0] = (short)f2bf(v[0]); o[1] = (short)f2bf(v[1]); o[2] = (short)f2bf(v[2]); o[3] = (short)f2bf(v[3]); return o; }
__device__ __forceinline__ bf16x8 cat8(bf16x4 a, bf16x4 b) { bf16x8 o; o[0] = a[0]; o[1] = a[1]; o[2] = a[2]; o[3] = a[3]; o[4] = b[0]; o[5] = b[1]; o[6] = b[2]; o[7] = b[3]; return o; }

__device__ __forceinline__ int otid() { int t = threadIdx.x; asm volatile("" : "+v"(t)); return t; }
__device__ __forceinline__ float rdlane(float v, int l) { return __int_as_float(__builtin_amdgcn_readlane(__float_as_int(v), l)); }
__device__ __forceinline__ int row_of(int b, int dir, int tau) {
    const int p = dir == 0 ? tau : (tau < CTX ? (CTX - 1 - tau) : (LTOT + CTX - 1 - tau));
    return b * LTOT + p;
}
__device__ __forceinline__ int modrow(int row) { const int p = row % LTOT; return p < CTX ? 4 : row / LTOT; }

__device__ __forceinline__ void s5_prep_unit(const Params& P, int l, int g, unsigned char* smem);

#define XB_TMO      128
#define XB_XCNT(j)  (256  + 64 * (j))
#define XB_XSUB(j)  (1280 + 64 * (j))
#define XB_XGEN(j)  (2304 + 64 * (j))
#define XB_TOP      3328
#define XB_TOPGEN   3392
#define XCD_BAR_WORDS 3456
#define XB_SPIN_CAP (1u << 22)
#define LAS __attribute__((address_space(3)))
__device__ __forceinline__ unsigned xb_ld(unsigned* p)              { return __hip_atomic_load(p, __ATOMIC_RELAXED, __HIP_MEMORY_SCOPE_AGENT); }
__device__ __forceinline__ unsigned xb_add(unsigned* p, unsigned v) { return __hip_atomic_fetch_add(p, v, __ATOMIC_RELAXED, __HIP_MEMORY_SCOPE_AGENT); }
__device__ __forceinline__ unsigned xb_xcc_id() { return (unsigned)__builtin_amdgcn_s_getreg((3 << 11) | 20) & 0xFu; }
#define XB_SPIN(cond, bar) do { unsigned _sp = 0; while (cond) { __builtin_amdgcn_s_sleep(1); \
    if ((++_sp & 255u) == 0u) { if (xb_ld(&(bar)[XB_TMO])) break; if (_sp > XB_SPIN_CAP) { atomicAdd(&(bar)[XB_TMO], 1u); break; } } } } while (0)
struct XcdBarrier { unsigned* bar; unsigned x; volatile LAS unsigned* st; };
__device__ __forceinline__ XcdBarrier xcd_barrier_post(unsigned* bar, volatile LAS unsigned* st) {
    XcdBarrier b; b.bar = bar; b.x = xb_xcc_id(); b.st = st;
    if (threadIdx.x == 0) (void)xb_add(&bar[XB_XCNT(b.x)], 1u);
    return b;
}
__device__ __forceinline__ void xcd_barrier_complete(unsigned* bar, unsigned x, unsigned& nloc, unsigned& nx) {
    const unsigned G = gridDim.x * gridDim.y * gridDim.z;
    unsigned sum, cnt, mine, sp = 0u;
    for (;;) {
        sum = 0u; cnt = 0u; mine = 0u;
#pragma unroll
        for (unsigned j = 0; j < 16; ++j) { const unsigned c = xb_ld(&bar[XB_XCNT(j)]); sum += c; cnt += (c > 0u) ? 1u : 0u; mine = (j == x) ? c : mine; }
        if (sum == G) break;
        __builtin_amdgcn_s_sleep(1);
        if ((++sp & 255u) == 0u) { if (xb_ld(&bar[XB_TMO])) break; if (sp > XB_SPIN_CAP) { atomicAdd(&bar[XB_TMO], 1u); break; } }
    }
    nloc = mine > 0u ? mine : 1u; nx = cnt > 0u ? cnt : 1u;
}
__device__ __forceinline__ void xcd_barrier(const XcdBarrier& b) {
    asm volatile("s_waitcnt vmcnt(0)" ::: "memory");
    __syncthreads();
    if (threadIdx.x == 0) {
        unsigned* bar = b.bar;
        __builtin_amdgcn_s_waitcnt(0);
        unsigned nloc = b.st[0], nx = b.st[1];
        if (nloc == 0u) { xcd_barrier_complete(bar, b.x, nloc, nx); b.st[0] = nloc; b.st[1] = nx; }
        const unsigned old = xb_add(&bar[XB_XSUB(b.x)], 1u);
        const unsigned gen = old / nloc;
        if (old + 1u == (gen + 1u) * nloc) {
            __builtin_amdgcn_fence(__ATOMIC_RELEASE, "agent");
            asm volatile("s_waitcnt vmcnt(0)" ::: "memory");
            const unsigned og = xb_add(&bar[XB_TOP], 1u);
            const unsigned tg = og / nx;
            if (og + 1u == (tg + 1u) * nx) xb_add(&bar[XB_TOPGEN], 1u);
            else XB_SPIN(xb_ld(&bar[XB_TOPGEN]) == tg, bar);
            __builtin_amdgcn_fence(__ATOMIC_ACQUIRE, "agent");
            xb_add(&bar[XB_XGEN(b.x)], 1u);
            asm volatile("s_waitcnt vmcnt(0)" ::: "memory");
        } else {
            XB_SPIN(xb_ld(&bar[XB_XGEN(b.x)]) == gen, bar);
            __builtin_amdgcn_fence(__ATOMIC_ACQUIRE, "agent");
            asm volatile("s_waitcnt vmcnt(0)" ::: "memory");
        }
    }
    __syncthreads();
}

__device__ __forceinline__ void phase_prep(const Params& P, unsigned char* smem) {
    const int tid = otid(), lane = tid & 63, wave = __builtin_amdgcn_readfirstlane(tid >> 6);
    float* MOD = (float*)(P.ws + OFF_MOD);
    float* XS = (float*)(P.ws + OFF_XS);
    const int U_MOD = 192, U_COPY = MROWS / 16, U_TIN = 2 * 16 * 54, U_TOUT = 2 * 16 * 16, U_TQ = 2 * 16 * 32;
    const int U_S5 = 32, U_KEY = 64 + 64;
    const int total = U_S5 + U_KEY + U_MOD + U_COPY + U_TIN + U_TOUT + U_TQ;
    for (int u0 = blockIdx.x; u0 < total; u0 += gridDim.x) {
        __syncthreads();
        if (u0 < U_S5) {
            if (u0 == 0) {
                float* LBT = (float*)(P.ws + OFF_LBT);
                for (int i = tid; i < 1024; i += 256) {
                    const int ll = i >> 9, dir = (i >> 8) & 1, ch = i & 255;
                    float lbv = 0.f;
                    if (ll == 1) { const float a0 = P.in[22][(dir * 2 + 0) * 256 + ch], a1 = P.in[22][(dir * 2 + 1) * 256 + ch]; const float m = fmaxf(a0, a1), e0 = __expf(a0 - m), e1 = __expf(a1 - m); lbv = e1 / (e0 + e1); }
                    LBT[i] = lbv;
                }
            }
            s5_prep_unit(P, u0 >> 4, u0 & 15, smem); continue;
        }
        if (u0 < U_S5 + 64) {
            bf16_t* KB = (bf16_t*)(P.ws + OFF_KEYB);
            const size_t base = (size_t)(u0 - U_S5) * 8192;
            for (int i = tid; i < 8192; i += 256) KB[base + i] = f2bf(P.in[36][base + i]);
            continue;
        }
        if (u0 < U_S5 + U_KEY) {
            bf16_t* LW = (bf16_t*)(P.ws + OFF_LW);
            const int base = (u0 - U_S5 - 64) * 8192;
            for (int i = tid; i < 8192; i += 256) {
                const int o = base + i, which = o >> 17, e = o & 131071;
                float v;
                if (which < 2) { const int j = e & 63, c = (e >> 6) & 511, ld = e >> 15; v = P.in[which == 0 ? 26 : 28][((size_t)ld * 64 + j) * 512 + c]; }
                else if (which == 2) { const int j = e & 127, c = (e >> 7) & 511, ll = e >> 16; v = P.in[29][((size_t)ll * 128 + j) * 512 + c]; }
                else { const int k = e & 255, n = (e >> 8) & 255, ll = e >> 16; v = P.in[20][((size_t)ll * 256 + k) * 256 + n]; }
                LW[o] = f2bf(v);
            }
            continue;
        }
        const int u = u0 - U_S5 - U_KEY;
        if (u < U_MOD) {
            const int l = u / 96, j0 = (u % 96) * 64;
            float* sl = (float*)smem;
            for (int i = tid; i < 5 * 1024; i += 256) {
                const int r = i >> 10, k = i & 1023;
                const float cv = r < 4 ? P.in[1][r * 1024 + k] : P.in[3][k];
                sl[i] = siluf_(cv);
            }
            __syncthreads();
            float acc[5] = {0.f, 0.f, 0.f, 0.f, 0.f};
            const float* W = P.in[4] + (size_t)l * 1024 * 6144 + j0 + lane;
            for (int k = wave * 256; k < wave * 256 + 256; ++k) {
                const float w = W[(size_t)k * 6144];
#pragma unroll
                for (int r = 0; r < 5; ++r) acc[r] += sl[r * 1024 + k] * w;
            }
            float* red = (float*)(smem + 5 * 1024 * 4);
#pragma unroll
            for (int r = 0; r < 5; ++r) red[(wave * 5 + r) * 64 + lane] = acc[r];
            __syncthreads();
            for (int i = tid; i < 5 * 64; i += 256) {
                const int r = i / 64, jj = i % 64;
                float s = P.in[5][l * 6144 + j0 + jj];
                for (int w = 0; w < 4; ++w) s += red[(w * 5 + r) * 64 + jj];
                MOD[(l * 5 + r) * 6144 + j0 + jj] = s;
            }
        } else if (u < U_MOD + U_COPY) {
            const int r0 = (u - U_MOD) * 16;
            for (int i = tid; i < 16 * 256; i += 256) {
                const int row = r0 + (i >> 8), c4 = i & 255;
                const int b = row / LTOT, p = row % LTOT;
                const float4* src = p < CTX ? (const float4*)(P.in[2] + ((size_t)b * CTX + p) * DM) : (const float4*)(P.in[0] + ((size_t)b * SEQ + (p - CTX)) * DM);
                ((float4*)(XS + (size_t)row * DM))[c4] = src[c4];
            }
        } else {
            int v = u - U_MOD - U_COPY;
            const float* W; bf16_t* Wt; int N;
            if (v < U_TIN) { const int l = v / (16 * 54); v %= 16 * 54; N = PIN; W = P.in[6] + (size_t)l * 1024 * PIN; Wt = (bf16_t*)(P.ws + OFF_WIN) + (size_t)l * PIN * 1024; }
            else if (v < U_TIN + U_TOUT) { v -= U_TIN; const int l = v / 256; v %= 256; N = 1024; W = P.in[7] + (size_t)l * 1024 * 1024; Wt = (bf16_t*)(P.ws + OFF_WOUT) + (size_t)l * 1024 * 1024; }
            else { v -= U_TIN + U_TOUT; const int l = v / 512; v %= 512; N = 2048; W = P.in[35] + (size_t)l * 1024 * 2048; Wt = (bf16_t*)(P.ws + OFF_WQ) + (size_t)l * 2048 * 1024; }
            const int ntn = N / 64, kt = v / ntn, nt = v % ntn;
            float* t = (float*)smem;
            for (int i = tid; i < 64 * 64; i += 256) { const int kk = i >> 6, nn = i & 63; t[kk * 65 + nn] = W[(size_t)(kt * 64 + kk) * N + nt * 64 + nn]; }
            __syncthreads();
            for (int i = tid; i < 64 * 64; i += 256) { const int nn = i >> 6, kk = i & 63; Wt[(size_t)(nt * 64 + nn) * 1024 + kt * 64 + kk] = f2bf(t[kk * 65 + nn]); }
        }
    }
}

__device__ __forceinline__ void phase_mkh(const Params& P) {
    const int lane = otid() & 63, wave = __builtin_amdgcn_readfirstlane(otid() >> 6);
    const float* XS = (const float*)(P.ws + OFF_XS);
    const float* MOD = (const float*)(P.ws + OFF_MOD);
    bf16_t* H = (bf16_t*)(P.ws + OFF_H);
    for (int row = blockIdx.x * 4 + wave; row < MROWS; row += gridDim.x * 4) {
        const float* mod = MOD + (size_t)(0 * 5 + modrow(row)) * 6144;
#pragma unroll
        for (int j = 0; j < 4; ++j) {
            const int d = 256 * j + 4 * lane;
            const float4 x = *(const float4*)(XS + (size_t)row * DM + d);
            const float4 sh = *(const float4*)(mod + d), sc = *(const float4*)(mod + 1024 + d);
            ushort4 o;
            o.x = f2bf(x.x * (1.f + sc.x) + sh.x); o.y = f2bf(x.y * (1.f + sc.y) + sh.y);
            o.z = f2bf(x.z * (1.f + sc.z) + sh.z); o.w = f2bf(x.w * (1.f + sc.w) + sh.w);
            *(ushort4*)(H + (size_t)row * DM + d) = o;
        }
    }
}

template <class EPI>
__device__ __forceinline__ void gemm_bf16(const bf16_t* A, int lda, const bf16_t* Bt, int ldb, int M, int N, int K, bool skipctx, EPI epi) {
    const int lane = otid() & 63, wave = __builtin_amdgcn_readfirstlane(otid() >> 6);
    const int ntm = M / 128, ntn = N / 128;
    const int fr = lane & 15, fq = lane >> 4;
    for (int tile = blockIdx.x; tile < ntm * ntn; tile += gridDim.x) {
        const int tm = tile / ntn, tn = tile % ntn;
        const int m0 = tm * 128 + (wave >> 1) * 64, n0 = tn * 128 + (wave & 1) * 64;
        if (skipctx && (m0 % LTOT) < CTX) continue;
        f32x4 acc[4][4];
#pragma unroll
        for (int i = 0; i < 4; ++i)
#pragma unroll
            for (int j = 0; j < 4; ++j) acc[i][j] = (f32x4){0.f, 0.f, 0.f, 0.f};
        const bf16_t* ap = A + (size_t)(m0 + fr) * lda + 8 * fq;
        const bf16_t* bp = Bt + (size_t)(n0 + fr) * ldb + 8 * fq;
        for (int k0 = 0; k0 < K; k0 += 32) {
            bf16x8 a[4], b[4];
#pragma unroll
            for (int i = 0; i < 4; ++i) a[i] = *(const bf16x8*)(ap + (size_t)(16 * i) * lda + k0);
#pragma unroll
            for (int j = 0; j < 4; ++j) b[j] = *(const bf16x8*)(bp + (size_t)(16 * j) * ldb + k0);
#pragma unroll
            for (int i = 0; i < 4; ++i)
#pragma unroll
                for (int j = 0; j < 4; ++j) acc[i][j] = __builtin_amdgcn_mfma_f32_16x16x32_bf16(a[i], b[j], acc[i][j], 0, 0, 0);
        }
#pragma unroll
        for (int i = 0; i < 4; ++i)
#pragma unroll
            for (int j = 0; j < 4; ++j)
#pragma unroll
                for (int r = 0; r < 4; ++r) epi(m0 + 16 * i + 4 * fq + r, n0 + 16 * j + fr, acc[i][j][r]);
    }
}

typedef float f32x16 __attribute__((ext_vector_type(16)));
typedef unsigned u32x4 __attribute__((ext_vector_type(4)));
#define G2_LD 72
template <class EPI>
__device__ __forceinline__ void gemm2_bf16(const bf16_t* A, int lda, const bf16_t* Bt, int ldb, int M, int N, int K, bool skipctx, EPI epi, unsigned char* smem) {
    const int tid = otid(), lane = tid & 63, wave = __builtin_amdgcn_readfirstlane(tid >> 6);
    const int ntm = M / 128, ntn = N / 128;
    bf16_t* As = (bf16_t*)smem;
    bf16_t* Bs = As + 128 * G2_LD;
    const int lr = tid >> 3, lc = (tid & 7) * 8;
    const int wm = (wave >> 1) * 64, wn = (wave & 1) * 64;
    const int fr = lane & 31, fh = lane >> 5;
    for (int tile = blockIdx.x; tile < ntm * ntn; tile += gridDim.x) {
        const int tm = tile / ntn, tn = tile % ntn;
        if (skipctx && ((tm * 128) % LTOT) < CTX) continue;
        const bf16_t* ag = A + (size_t)(tm * 128 + lr) * lda + lc;
        const bf16_t* bg = Bt + (size_t)(tn * 128 + lr) * ldb + lc;
        f32x16 acc[2][2];
        {
            const f32x16 z16 = {0.f, 0.f, 0.f, 0.f, 0.f, 0.f, 0.f, 0.f, 0.f, 0.f, 0.f, 0.f, 0.f, 0.f, 0.f, 0.f};
            acc[0][0] = z16; acc[0][1] = z16; acc[1][0] = z16; acc[1][1] = z16;
        }
        u32x4 ra[4], rb[4];
#pragma unroll
        for (int i = 0; i < 4; ++i) { ra[i] = *(const u32x4*)(ag + (size_t)(32 * i) * lda); rb[i] = *(const u32x4*)(bg + (size_t)(32 * i) * ldb); }
        for (int k0 = 0; k0 < K; k0 += 64) {
            __syncthreads();
#pragma unroll
            for (int i = 0; i < 4; ++i) { *(u32x4*)(As + (lr + 32 * i) * G2_LD + lc) = ra[i]; *(u32x4*)(Bs + (lr + 32 * i) * G2_LD + lc) = rb[i]; }
            __syncthreads();
            {
                const int kn = (k0 + 64 < K) ? k0 + 64 : 0;
#pragma unroll
                for (int i = 0; i < 4; ++i) { ra[i] = *(const u32x4*)(ag + (size_t)(32 * i) * lda + kn); rb[i] = *(const u32x4*)(bg + (size_t)(32 * i) * ldb + kn); }
            }
#pragma unroll
            for (int kk = 0; kk < 4; ++kk) {
                bf16x8 a[2], b[2];
#pragma unroll
                for (int i = 0; i < 2; ++i) a[i] = *(const bf16x8*)(As + (wm + 32 * i + fr) * G2_LD + 16 * kk + 8 * fh);
#pragma unroll
                for (int j = 0; j < 2; ++j) b[j] = *(const bf16x8*)(Bs + (wn + 32 * j + fr) * G2_LD + 16 * kk + 8 * fh);
#pragma unroll
                for (int i = 0; i < 2; ++i)
#pragma unroll
                    for (int j = 0; j < 2; ++j) acc[i][j] = __builtin_amdgcn_mfma_f32_32x32x16_bf16(a[i], b[j], acc[i][j], 0, 0, 0);
            }
        }
#pragma unroll
        for (int i = 0; i < 2; ++i)
#pragma unroll
            for (int j = 0; j < 2; ++j)
#pragma unroll
                for (int q = 0; q < 16; ++q) epi(tm * 128 + wm + 32 * i + (q & 3) + 8 * (q >> 2) + 4 * fh, tn * 128 + wn + 32 * j + fr, acc[i][j][q]);
    }
}
struct EpiInproj {
    bf16_t* C; const float* lbt;
    __device__ __forceinline__ void operator()(int r, int c, float v) const {
        if (c >= 256 && c < 1536) {
            if (c < 512 || c >= 1280) v = siluf_(v);
            else if (c >= 768) { const float lb = lbt[c - 768]; v = __logf(lb + (1.f - lb) * sigmoidf_(v)); }
        }
        C[(size_t)r * PIN + c] = f2bf(v);
    }
};
struct EpiBf16 { bf16_t* C; int ldc; __device__ __forceinline__ void operator()(int r, int c, float v) const { C[(size_t)r * ldc + c] = f2bf(v); } };
struct EpiF32 { float* C; int ldc; __device__ __forceinline__ void operator()(int r, int c, float v) const { C[(size_t)r * ldc + c] = v; } };

__device__ __forceinline__ void phase_rwprep(const Params& P, int l, unsigned char* smem) {
    const int tid = otid();
    const bf16_t* Pb = (const bf16_t*)(P.ws + OFF_P);
    bf16_t* RW = (bf16_t*)(P.ws + OFF_RW);
    const float* mu = P.in[24] + l * 1920;
    const float* k_k = P.in[30] + l * 512;
    float* tw = (float*)smem;
    float* al = tw + 2 * 8 * 64;
    float* kk2 = al + 2 * 8 * 64;
    float* nrm = kk2 + 8 * 512;
    for (int u = blockIdx.x; u < MROWS / 8; u += gridDim.x) {
        const int r0 = u * 8;
        __syncthreads();
        for (int i = 0; i < 8; ++i) {
            const int row = r0 + i, p = row % LTOT;
            int nb[4]; bool ok[4];
            if (p < CTX) {
                nb[0] = row - 1; ok[0] = p > 0; nb[1] = row + 1; ok[1] = p < CTX - 1; nb[2] = nb[0]; ok[2] = ok[0]; nb[3] = nb[1]; ok[3] = ok[1];
            } else {
                const int t = p - CTX, gr = t >> 6, gc = t & 63;
                nb[0] = row - 1; ok[0] = gc > 0; nb[1] = row + 1; ok[1] = gc < 63; nb[2] = row - 64; ok[2] = gr > 0; nb[3] = row + 64; ok[3] = gr < 63;
            }
            for (int c = tid; c < 1920; c += 256) {
                const int m = c & 3;
                const float pv = bf2f(Pb[(size_t)row * PIN + 1536 + c]);
                const float nv = ok[m] ? bf2f(Pb[(size_t)nb[m] * PIN + 1536 + c]) : 0.f;
                const float s = pv + mu[c] * (nv - pv);
                bf16_t* rw = RW + (size_t)row * RWW;
                if (c < 512) rw[c] = f2bf(s);
                else if (c < 1024) { rw[c] = f2bf(s); kk2[i * 512 + (c - 512)] = s * k_k[c - 512]; }
                else if (c < 1536) rw[c] = f2bf(s);
                else if (c < 1664) rw[4096 + (c - 1536)] = f2bf(sigmoidf_(s));
                else if (c < 1728) tw[(0 * 8 + i) * 64 + (c - 1664)] = tanhf(s);
                else if (c < 1792) tw[(1 * 8 + i) * 64 + (c - 1728)] = tanhf(s);
                else if (c < 1856) al[(0 * 8 + i) * 64 + (c - 1792)] = s;
                else al[(1 * 8 + i) * 64 + (c - 1856)] = s;
            }
        }
        __syncthreads();
        {
            const int pair = tid >> 2, q = tid & 3, i = pair >> 3, hd = pair & 7;
            float s = 0.f;
            for (int j = 0; j < 16; ++j) { const float v = kk2[i * 512 + hd * 64 + q * 16 + j]; s += v * v; }
            s += __shfl_xor(s, 1, 64); s += __shfl_xor(s, 2, 64);
            if (q == 0) nrm[pair] = fmaxf(sqrtf(s), 1e-12f);
        }
        __syncthreads();
        for (int e = tid; e < 8 * 512; e += 256) {
            const int i = e >> 9, c = e & 511;
            RW[(size_t)(r0 + i) * RWW + 1536 + c] = f2bf(kk2[e] / nrm[i * 8 + (c >> 6)]);
        }
        for (int d = 0; d < 2; ++d) {
            const float* wup = P.in[26] + (size_t)(l * 2 + d) * 64 * 512;
            const float* aup = P.in[28] + (size_t)(l * 2 + d) * 64 * 512;
            const float* w0 = P.in[25] + (l * 2 + d) * 512;
            const float* a0 = P.in[27] + (l * 2 + d) * 512;
            float zw[2][8], za[2][8];
#pragma unroll
            for (int i = 0; i < 8; ++i) { zw[0][i] = zw[1][i] = za[0][i] = za[1][i] = 0.f; }
            for (int j = 0; j < 64; ++j) {
                const float w_0 = wup[j * 512 + tid], w_1 = wup[j * 512 + tid + 256];
                const float a_0 = aup[j * 512 + tid], a_1 = aup[j * 512 + tid + 256];
#pragma unroll
                for (int i = 0; i < 8; ++i) {
                    const float t = tw[(d * 8 + i) * 64 + j], a = al[(d * 8 + i) * 64 + j];
                    zw[0][i] += t * w_0; zw[1][i] += t * w_1; za[0][i] += a * a_0; za[1][i] += a * a_1;
                }
            }
#pragma unroll
            for (int i = 0; i < 8; ++i) {
                bf16_t* rw = RW + (size_t)(r0 + i) * RWW;
#pragma unroll
                for (int h = 0; h < 2; ++h) {
                    const int c = tid + 256 * h;
                    rw[2048 + d * 512 + c] = f2bf(sigmoidf_(a0[c] + za[h][i]));
                    rw[3072 + d * 512 + c] = f2bf(-0.60653066f * sigmoidf_(w0[c] + zw[h][i]));
                }
            }
        }
    }
}

__device__ __forceinline__ void scan_rwkv(const Params& P, int l, int item) {
    const int lane = otid() & 63;
    const int dir = item & 1, hd = (item >> 1) & 7, b = item >> 4;
    const bf16_t* RW = (const bf16_t*)(P.ws + OFF_RW);
    bf16_t* YP = (bf16_t*)(P.ws + OFF_YP) + (size_t)dir * MROWS * DM;
    const float ka = P.in[31][l * 512 + hd * 64 + lane];
    float S[64];
#pragma unroll
    for (int k = 0; k < 64; ++k) S[k] = 0.f;
    for (int tau = 0; tau < LTOT; ++tau) {
        const int row = row_of(b, dir, tau);
#ifdef EXP_T2
        if ((tau & 127) == 0) {
            float* RXL = (float*)(P.ws + OFF_RXL);
            const size_t itm = (size_t)item * 34 + (tau >> 7);
#pragma unroll
            for (int kk = 0; kk < 64; ++kk) RXL[((itm * 16 + (kk >> 4) * 4 + (lane >> 4)) * 64 + ((kk >> 2) & 3) * 16 + (lane & 15)) * 4 + (kk & 3)] = S[kk];
        }
#endif
        const bf16_t* rw = RW + (size_t)row * RWW + hd * 64 + lane;
        const float r = bf2f(rw[0]), k = bf2f(rw[512]), v = bf2f(rw[1024]), kap = bf2f(rw[1536]);
        const float a = bf2f(rw[2048 + dir * 512]), lw = bf2f(rw[3072 + dir * 512]);
        const float w = __expf(lw), kt = k * (1.f + (a - 1.f) * ka), beta = kap * a;
        float sk = 0.f;
#pragma unroll
        for (int kk = 0; kk < 64; ++kk) { sk += S[kk] * rdlane(kap, kk); if ((kk & 7) == 7) __builtin_amdgcn_sched_barrier(0); }
        float y = 0.f;
#pragma unroll
        for (int kk = 0; kk < 64; ++kk) {
            const float s = S[kk] * rdlane(w, kk) - sk * rdlane(beta, kk) + v * rdlane(kt, kk);
            S[kk] = s;
            y += s * rdlane(r, kk);
            if ((kk & 3) == 3) __builtin_amdgcn_sched_barrier(0);
        }
        YP[(size_t)row * DM + 512 + hd * 64 + lane] = f2bf(y);
    }
}
__device__ __forceinline__ void scan_hgrn(const Params& P, int l, int item) {
    const int lane = otid() & 63;
    const int dir = item & 1, hd = (item >> 1) & 3, b = item >> 3;
    const bf16_t* Pb = (const bf16_t*)(P.ws + OFF_P);
    bf16_t* YP = (bf16_t*)(P.ws + OFF_YP) + (size_t)dir * MROWS * DM;
    float lb = 0.f;
    if (l == 1) {
        const float a0 = P.in[22][(dir * 2 + 0) * 256 + hd * 64 + lane], a1 = P.in[22][(dir * 2 + 1) * 256 + hd * 64 + lane];
        const float m = fmaxf(a0, a1), e0 = __expf(a0 - m), e1 = __expf(a1 - m);
        lb = e1 / (e0 + e1);
    }
    float S[64];
#pragma unroll
    for (int k = 0; k < 64; ++k) S[k] = 0.f;
    for (int tau = 0; tau < LTOT; ++tau) {
        const int row = row_of(b, dir, tau);
        const bf16_t* pr = Pb + (size_t)row * PIN + 256 + hd * 64 + lane;
        const float q = siluf_(bf2f(pr[0])), v = bf2f(pr[256]);
        const float f = lb + (1.f - lb) * sigmoidf_(bf2f(pr[512 + dir * 256]));
        const float kq = 1.f - f;
        float o = 0.f;
#pragma unroll
        for (int dk = 0; dk < 64; ++dk) {
            const float s = rdlane(f, dk) * S[dk] + rdlane(kq, dk) * v;
            S[dk] = s;
            o += s * rdlane(q, dk);
            if ((dk & 7) == 7) __builtin_amdgcn_sched_barrier(0);
        }
        YP[(size_t)row * DM + 256 + hd * 64 + lane] = f2bf(o);
    }
}
__device__ __forceinline__ void scan_s5(const Params& P, int l, int item) {
    const int lane = otid() & 63;
    const int dir = item & 1, g = (item >> 1) & 15, b = item >> 5;
    const bf16_t* Pb = (const bf16_t*)(P.ws + OFF_P);
    bf16_t* YP = (bf16_t*)(P.ws + OFF_YP) + (size_t)dir * MROWS * DM;
    const int ldg = (l * 2 + dir) * 16 + g;
    const float dt = expf(P.in[14][ldg]);
    const float lre = P.in[12][ldg * 64 + lane], lim = P.in[13][ldg * 64 + lane];
    const float mag = expf(lre * dt), ang = lim * dt;
    const float lb_re = mag * cosf(ang), lb_im = mag * sinf(ang);
    const float den = lre * lre + lim * lim, nr = lb_re - 1.f, ni = lb_im;
    const float co_re = (nr * lre + ni * lim) / den, co_im = (ni * lre - nr * lim) / den;
    float bb_re[16], bb_im[16], c_re[16], c_im[16];
#pragma unroll
    for (int h = 0; h < 16; ++h) {
        const float br = P.in[15][((size_t)ldg * 64 + lane) * 16 + h], bi = P.in[16][((size_t)ldg * 64 + lane) * 16 + h];
        bb_re[h] = co_re * br - co_im * bi; bb_im[h] = co_re * bi + co_im * br;
        c_re[h] = P.in[17][((size_t)ldg * 16 + h) * 64 + lane]; c_im[h] = P.in[18][((size_t)ldg * 16 + h) * 64 + lane];
    }
    float s_re = 0.f, s_im = 0.f;
    for (int tau = 0; tau < LTOT; ++tau) {
        const int row = row_of(b, dir, tau);
        const float uv = bf2f(Pb[(size_t)row * PIN + g * 16 + (lane & 15)]);
        float bu_re = 0.f, bu_im = 0.f;
#pragma unroll
        for (int h = 0; h < 16; ++h) { const float uh = rdlane(uv, h); bu_re += bb_re[h] * uh; bu_im += bb_im[h] * uh; }
        const float n_re = lb_re * s_re - lb_im * s_im + bu_re, n_im = lb_re * s_im + lb_im * s_re + bu_im;
        s_re = n_re; s_im = n_im;
        float yo = 0.f;
#pragma unroll
        for (int h = 0; h < 16; ++h) { const float t = wave_sum(c_re[h] * s_re - c_im[h] * s_im); yo = (lane == h) ? t : yo; }
        if (lane < 16) YP[(size_t)row * DM + g * 16 + lane] = f2bf(yo);
    }
}
__device__ __forceinline__ void phase_scans(const Params& P, int l) {
    const int wave = __builtin_amdgcn_readfirstlane(otid() >> 6);
    for (int it = wave * gridDim.x + blockIdx.x; it < 32; it += 4 * gridDim.x) scan_hgrn(P, l, it);
}

__device__ __forceinline__ void phase_post(const Params& P, int l, unsigned char* smem) {
    const int tid = otid();
    const bf16_t* Pb = (const bf16_t*)(P.ws + OFF_P);
    const bf16_t* RW = (const bf16_t*)(P.ws + OFF_RW);
    const bf16_t* YF = (const bf16_t*)(P.ws + OFF_YP);
    const bf16_t* YB = YF + (size_t)MROWS * DM;
    bf16_t* MIX = (bf16_t*)(P.ws + OFF_MIX);
    float* ypre = (float*)smem;
    float* sg = ypre + 8 * 256;
    for (int u = blockIdx.x; u < MROWS / 8; u += gridDim.x) {
        const int r0 = u * 8;
        if (l == 1 && (r0 % LTOT) < CTX) continue;
        __syncthreads();
        for (int i = 0; i < 8; ++i) {
            const int row = r0 + i;
            ypre[i * 256 + tid] = bf2f(YF[(size_t)row * DM + tid]);
        }
        for (int e = tid; e < 8 * 128; e += 256) sg[e] = bf2f(RW[(size_t)(r0 + (e >> 7)) * RWW + 4096 + (e & 127)]);
        __syncthreads();
        {
            float z[8];
            const float gb = P.in[21][l * 256 + tid];
#pragma unroll
            for (int i = 0; i < 8; ++i) z[i] = gb;
            const float* gw = P.in[20] + (size_t)l * 256 * 256 + tid;
            for (int k = 0; k < 256; ++k) {
                const float w = gw[k * 256];
#pragma unroll
                for (int i = 0; i < 8; ++i) z[i] += ypre[i * 256 + k] * w;
            }
#pragma unroll
            for (int i = 0; i < 8; ++i) MIX[(size_t)(r0 + i) * DM + tid] = f2bf(ypre[i * 256 + tid] * sigmoidf_(z[i]));
        }
        {
            const int i = tid >> 5, c0 = (tid & 31) * 8, row = r0 + i;
            float o[8], ss = 0.f;
#pragma unroll
            for (int j = 0; j < 8; ++j) { o[j] = bf2f(YF[(size_t)row * DM + 256 + c0 + j]) + bf2f(YB[(size_t)row * DM + 256 + c0 + j]); ss += o[j] * o[j]; }
            ss += __shfl_xor(ss, 1, 64); ss += __shfl_xor(ss, 2, 64); ss += __shfl_xor(ss, 4, 64);
            const float rs = rsqrtf(ss * (1.f / 64.f) + 1e-6f);
#pragma unroll
            for (int j = 0; j < 8; ++j) {
                const float gr = bf2f(Pb[(size_t)row * PIN + 256 + 1024 + c0 + j]);
                MIX[(size_t)row * DM + 256 + c0 + j] = f2bf(o[j] * rs * P.in[23][l * 256 + c0 + j] * siluf_(gr));
            }
        }
        {
            const int i = tid >> 5, c0 = (tid & 31) * 16, row = r0 + i;
            const bf16_t* rw = RW + (size_t)row * RWW;
            float y[16], vv[16], sum = 0.f, bon = 0.f;
#pragma unroll
            for (int j = 0; j < 16; ++j) {
                const int c = c0 + j;
                y[j] = bf2f(YF[(size_t)row * DM + 512 + c]) + bf2f(YB[(size_t)row * DM + 512 + c]);
                sum += y[j];
                const float r = bf2f(rw[c]), k = bf2f(rw[512 + c]), af = bf2f(rw[2048 + c]), ab = bf2f(rw[2560 + c]);
                const float ka = P.in[31][l * 512 + c];
                vv[j] = bf2f(rw[1024 + c]);
                bon += r * P.in[32][l * 512 + c] * (k * (1.f + (af - 1.f) * ka) + k * (1.f + (ab - 1.f) * ka));
            }
            sum += __shfl_xor(sum, 1, 64); sum += __shfl_xor(sum, 2, 64);
            bon += __shfl_xor(bon, 1, 64); bon += __shfl_xor(bon, 2, 64);
            const float mean = sum * (1.f / 64.f);
            float var = 0.f;
#pragma unroll
            for (int j = 0; j < 16; ++j) { const float d = y[j] - mean; var += d * d; }
            var += __shfl_xor(var, 1, 64); var += __shfl_xor(var, 2, 64);
            const float rs = rsqrtf(var * (1.f / 64.f) + 64e-5f);
            float g[16];
#pragma unroll
            for (int j = 0; j < 16; ++j) g[j] = 0.f;
            const float* gup = P.in[29] + (size_t)l * 128 * 512 + c0;
            for (int jj = 0; jj < 128; ++jj) {
                const float s = sg[i * 128 + jj];
                const float4 w0 = *(const float4*)(gup + jj * 512), w1 = *(const float4*)(gup + jj * 512 + 4), w2 = *(const float4*)(gup + jj * 512 + 8), w3 = *(const float4*)(gup + jj * 512 + 12);
                g[0] += s * w0.x; g[1] += s * w0.y; g[2] += s * w0.z; g[3] += s * w0.w;
                g[4] += s * w1.x; g[5] += s * w1.y; g[6] += s * w1.z; g[7] += s * w1.w;
                g[8] += s * w2.x; g[9] += s * w2.y; g[10] += s * w2.z; g[11] += s * w2.w;
                g[12] += s * w3.x; g[13] += s * w3.y; g[14] += s * w3.z; g[15] += s * w3.w;
            }
#pragma unroll
            for (int j = 0; j < 16; ++j) {
                const int c = c0 + j;
                const float yn = (y[j] - mean) * rs * P.in[33][l * 512 + c] + P.in[34][l * 512 + c];
                MIX[(size_t)row * DM + 512 + c] = f2bf((yn + bon * vv[j]) * g[j]);
            }
        }
    }
}

__device__ __forceinline__ void phase_ln1(const Params& P, int l) {
    const int lane = otid() & 63, wave = __builtin_amdgcn_readfirstlane(otid() >> 6);
    float* XS = (float*)(P.ws + OFF_XS);
    const float* TMP = (const float*)(P.ws + OFF_TMP);
    const float* MOD = (const float*)(P.ws + OFF_MOD);
    bf16_t* H2 = (bf16_t*)(P.ws + OFF_H2);
    for (int row = blockIdx.x * 4 + wave; row < MROWS; row += gridDim.x * 4) {
        if (l == 1 && (row % LTOT) < CTX) continue;
        const float* mod = MOD + (size_t)(l * 5 + modrow(row)) * 6144;
        float v[16]; float s = 0.f;
#pragma unroll
        for (int j = 0; j < 4; ++j) {
            const int d = 256 * j + 4 * lane;
            const float4 x = *(const float4*)(XS + (size_t)row * DM + d), t = *(const float4*)(TMP + (size_t)row * DM + d), g = *(const float4*)(mod + 2048 + d);
            v[4 * j + 0] = ALPHA * x.x + g.x * t.x; v[4 * j + 1] = ALPHA * x.y + g.y * t.y; v[4 * j + 2] = ALPHA * x.z + g.z * t.z; v[4 * j + 3] = ALPHA * x.w + g.w * t.w;
            s += v[4 * j] + v[4 * j + 1] + v[4 * j + 2] + v[4 * j + 3];
        }
        const float mean = wave_sum(s) * (1.f / 1024.f);
        float q = 0.f;
#pragma unroll
        for (int j = 0; j < 16; ++j) { const float d = v[j] - mean; q += d * d; }
        const float rs = rsqrtf(wave_sum(q) * (1.f / 1024.f) + 1e-5f);
#pragma unroll
        for (int j = 0; j < 4; ++j) {
            const int d = 256 * j + 4 * lane;
            const float4 gg = *(const float4*)(P.in[8] + l * 1024 + d), bb = *(const float4*)(P.in[9] + l * 1024 + d);
            const float4 sh = *(const float4*)(mod + 3072 + d), sc = *(const float4*)(mod + 4096 + d);
            float4 o;
            o.x = (v[4 * j + 0] - mean) * rs * gg.x + bb.x; o.y = (v[4 * j + 1] - mean) * rs * gg.y + bb.y;
            o.z = (v[4 * j + 2] - mean) * rs * gg.z + bb.z; o.w = (v[4 * j + 3] - mean) * rs * gg.w + bb.w;
            *(float4*)(XS + (size_t)row * DM + d) = o;
            ushort4 h;
            h.x = f2bf(o.x * (1.f + sc.x) + sh.x); h.y = f2bf(o.y * (1.f + sc.y) + sh.y); h.z = f2bf(o.z * (1.f + sc.z) + sh.z); h.w = f2bf(o.w * (1.f + sc.w) + sh.w);
            *(ushort4*)(H2 + (size_t)row * DM + d) = h;
        }
    }
}

__device__ __forceinline__ unsigned f2ord(float f) { const unsigned u = __float_as_uint(f); return u ^ ((u >> 31) ? 0xFFFFFFFFu : 0x80000000u); }
__device__ __forceinline__ float ord2f(unsigned u) { return __uint_as_float((u >> 31) ? (u ^ 0x80000000u) : ~u); }
__device__ __forceinline__ void phase_topk(const Params& P, int l) {
    const int tid = otid();
    const bf16_t* Q = (const bf16_t*)(P.ws + OFF_Q);
    int* IDX = (int*)(P.ws + OFF_IDX);
    float* GATE = (float*)(P.ws + OFF_GATE);
    for (int u = blockIdx.x; u < 8 * (MROWS / 256); u += gridDim.x) {
        const int hd = u / (MROWS / 256), rb = u % (MROWS / 256);
        const int row = rb * 256 + tid;
        if (l == 1 && (row % LTOT) < CTX) continue;
        unsigned top[2][16];
#pragma unroll
        for (int half = 0; half < 2; ++half) {
            float q[128];
            const bf16_t* qp = Q + (size_t)row * 2048 + hd * 256 + half * 128;
#pragma unroll
            for (int d8 = 0; d8 < 16; ++d8) {
                const bf16x8 v = *(const bf16x8*)(qp + d8 * 8);
#pragma unroll
                for (int j = 0; j < 8; ++j) q[d8 * 8 + j] = bf2f((bf16_t)v[j]);
            }
#pragma unroll
            for (int j = 0; j < 16; ++j) top[half][j] = 0u;
            const float* kp = P.in[36] + ((size_t)((l * 8 + hd) * 2 + half)) * 128 * 128;
            for (int key = 0; key < 128; ++key) {
                const float* kr = kp + key * 128;
                float s0 = 0.f, s1 = 0.f, s2 = 0.f, s3 = 0.f;
#pragma unroll
                for (int d = 0; d < 128; d += 4) { s0 += q[d] * kr[d]; s1 += q[d + 1] * kr[d + 1]; s2 += q[d + 2] * kr[d + 2]; s3 += q[d + 3] * kr[d + 3]; if ((d & 31) == 28) __builtin_amdgcn_sched_barrier(0); }
                unsigned x = (f2ord((s0 + s1) + (s2 + s3)) & 0xFFFFFF80u) | (unsigned)(127 - key);
#pragma unroll
                for (int j = 0; j < 16; ++j) { const unsigned t = top[half][j]; const unsigned mx = x > t ? x : t; x = x > t ? t : x; top[half][j] = mx; }
            }
        }
        float cs[16]; int ce[16];
#pragma unroll
        for (int j = 0; j < 16; ++j) { cs[j] = -3.0e38f; ce[j] = 0; }
#pragma unroll
        for (int i = 0; i < 16; ++i) {
            const float s1v = ord2f(top[0][i] & 0xFFFFFF80u); const int i1 = 127 - (int)(top[0][i] & 127u);
#pragma unroll
            for (int j = 0; j < 16; ++j) {
                if ((i + 1) * (j + 1) <= 16) {
                    float x = s1v + ord2f(top[1][j] & 0xFFFFFF80u); int xe = i1 * 128 + (127 - (int)(top[1][j] & 127u));
#pragma unroll
                    for (int t = 0; t < 16; ++t) {
                        const bool gt = x > cs[t];
                        const float ts = cs[t]; const int te = ce[t];
                        cs[t] = gt ? x : ts; ce[t] = gt ? xe : te; x = gt ? ts : x; xe = gt ? te : xe;
                    }
                }
            }
        }
        float den = 0.f, ex[16];
#pragma unroll
        for (int t = 0; t < 16; ++t) { ex[t] = __expf(cs[t] - cs[0]); den += ex[t]; }
        const float inv = 1.f / den;
#pragma unroll
        for (int t = 0; t < 16; ++t) { IDX[(size_t)row * 128 + hd * 16 + t] = ce[t]; GATE[(size_t)row * 128 + hd * 16 + t] = ex[t] * inv; }
    }
}


__device__ __forceinline__ void ce_desc(unsigned& a, unsigned& b) { const unsigned hi = a > b ? a : b, lo = a > b ? b : a; a = hi; b = lo; }
__device__ __forceinline__ void bitonic_sort16(unsigned (&u)[16]) {
#pragma unroll
    for (int k = 2; k <= 16; k <<= 1)
#pragma unroll
        for (int j = k >> 1; j > 0; j >>= 1)
#pragma unroll
            for (int i = 0; i < 16; ++i) {
                const int p = i ^ j;
                if (p > i) { if ((i & k) == 0) ce_desc(u[i], u[p]); else ce_desc(u[p], u[i]); }
            }
}
__device__ __forceinline__ void bitonic_merge16(unsigned (&u)[16]) {
#pragma unroll
    for (int j = 8; j > 0; j >>= 1)
#pragma unroll
        for (int i = 0; i < 16; ++i) { const int p = i ^ j; if (p > i) ce_desc(u[i], u[p]); }
}
__device__ __forceinline__ void xlane_top16(unsigned (&u)[16], int xr) {
    unsigned o[16];
#pragma unroll
    for (int i = 0; i < 16; ++i) o[i] = (unsigned)__shfl_xor((int)u[15 - i], xr, 64);
#pragma unroll
    for (int i = 0; i < 16; ++i) u[i] = u[i] > o[i] ? u[i] : o[i];
    bitonic_merge16(u);
}
__device__ __forceinline__ void phase_topk2(const Params& P, int l, unsigned char* smem) {
    const int lane = otid() & 63, wave = __builtin_amdgcn_readfirstlane(otid() >> 6), fr = lane & 15, fq = lane >> 4;
    const bf16_t* Q = (const bf16_t*)(P.ws + OFF_Q);
    const bf16_t* KB = (const bf16_t*)(P.ws + OFF_KEYB);
    int* IDX = (int*)(P.ws + OFF_IDX);
    float* GATE = (float*)(P.ws + OFF_GATE);
    unsigned char* ids = smem + wave * 512;
    for (int it = blockIdx.x * 4 + wave; it < (MROWS / 16) * 8; it += gridDim.x * 4) {
        const int rt = it >> 3, hd = it & 7, row0 = rt * 16;
        if (l == 1 && (row0 % LTOT) < CTX) continue;
        unsigned top[2][16];
#pragma unroll
        for (int half = 0; half < 2; ++half) {
            f32x4 acc[8];
#pragma unroll
            for (int mi = 0; mi < 8; ++mi) acc[mi] = (f32x4){0.f, 0.f, 0.f, 0.f};
            const bf16_t* kp = KB + ((size_t)((l * 8 + hd) * 2 + half) * 128 + fr) * 128 + 8 * fq;
            const bf16_t* qp = Q + (size_t)(row0 + fr) * 2048 + hd * 256 + half * 128 + 8 * fq;
#pragma unroll
            for (int ks = 0; ks < 4; ++ks) {
                const bf16x8 qb = *(const bf16x8*)(qp + 32 * ks);
#pragma unroll
                for (int mi = 0; mi < 8; ++mi) acc[mi] = mfma32(*(const bf16x8*)(kp + (size_t)(16 * mi) * 128 + 32 * ks), qb, acc[mi]);
            }
            unsigned ua[16], ub[16];
#pragma unroll
            for (int mi = 0; mi < 4; ++mi)
#pragma unroll
                for (int r = 0; r < 4; ++r) {
                    ua[mi * 4 + r] = (f2ord(acc[mi][r]) & 0xFFFFFF80u) | (unsigned)(127 - (16 * mi + 4 * fq + r));
                    ub[mi * 4 + r] = (f2ord(acc[mi + 4][r]) & 0xFFFFFF80u) | (unsigned)(127 - (16 * (mi + 4) + 4 * fq + r));
                }
            bitonic_sort16(ua); bitonic_sort16(ub);
#pragma unroll
            for (int i = 0; i < 16; ++i) ua[i] = ua[i] > ub[15 - i] ? ua[i] : ub[15 - i];
            bitonic_merge16(ua);
            xlane_top16(ua, 16); xlane_top16(ua, 32);
#pragma unroll
            for (int i = 0; i < 16; ++i) top[half][i] = ua[i];
        }
        if (fq == 0) {
            unsigned w[8];
#pragma unroll
            for (int i = 0; i < 8; ++i) {
                const unsigned* t = i < 4 ? &top[0][4 * i] : &top[1][4 * (i - 4)];
                w[i] = (127u - (t[0] & 127u)) | ((127u - (t[1] & 127u)) << 8) | ((127u - (t[2] & 127u)) << 16) | ((127u - (t[3] & 127u)) << 24);
            }
            *(uint4*)(ids + fr * 32) = make_uint4(w[0], w[1], w[2], w[3]);
            *(uint4*)(ids + fr * 32 + 16) = make_uint4(w[4], w[5], w[6], w[7]);
        }
        float s2v[16];
#pragma unroll
        for (int j = 0; j < 16; ++j) s2v[j] = ord2f(top[1][j] & 0xFFFFFF80u);
        float s1r[4];
#pragma unroll
        for (int m = 0; m < 4; ++m) {
            const unsigned t = fq == 0 ? top[0][4 * m] : (fq == 1 ? top[0][4 * m + 1] : (fq == 2 ? top[0][4 * m + 2] : top[0][4 * m + 3]));
            s1r[m] = ord2f(t & 0xFFFFFF80u);
        }
        unsigned cu[16];
#pragma unroll
        for (int j = 0; j < 16; ++j) cu[j] = (f2ord(s1r[0] + s2v[j]) & 0xFFFFFF00u) | (unsigned)((fq << 4) | j);
        {
            unsigned ex[5];
            ex[0] = (f2ord(s1r[1] + s2v[0]) & 0xFFFFFF00u) | (unsigned)(((4 + fq) << 4) | 0);
            ex[1] = (f2ord(s1r[1] + s2v[1]) & 0xFFFFFF00u) | (unsigned)(((4 + fq) << 4) | 1);
            ex[2] = (f2ord(s1r[1] + s2v[2]) & 0xFFFFFF00u) | (unsigned)(((4 + fq) << 4) | 2);
            ex[3] = (f2ord(s1r[2] + s2v[0]) & 0xFFFFFF00u) | (unsigned)(((8 + fq) << 4) | 0);
            ex[4] = (f2ord(s1r[3] + s2v[0]) & 0xFFFFFF00u) | (unsigned)(((12 + fq) << 4) | 0);
#pragma unroll
            for (int e = 0; e < 5; ++e) {
                unsigned x = ex[e];
#pragma unroll
                for (int t = 0; t < 16; ++t) { const unsigned c = cu[t]; const unsigned mx = x > c ? x : c; x = x > c ? c : x; cu[t] = mx; }
            }
        }
        xlane_top16(cu, 16); xlane_top16(cu, 32);
        if (fq == 0) {
            float ex[16], den = 0.f; int eid[16];
            const float m0 = ord2f(cu[0] & 0xFFFFFF00u);
#pragma unroll
            for (int t = 0; t < 16; ++t) {
                ex[t] = __expf(ord2f(cu[t] & 0xFFFFFF00u) - m0); den += ex[t];
                const int i = (cu[t] >> 4) & 15, j = cu[t] & 15;
                eid[t] = (int)ids[fr * 32 + i] * 128 + (int)ids[fr * 32 + 16 + j];
            }
            const float inv = 1.f / den;
            int* ip = IDX + (size_t)(row0 + fr) * 128 + hd * 16;
            float* gp = GATE + (size_t)(row0 + fr) * 128 + hd * 16;
#pragma unroll
            for (int t = 0; t < 16; t += 4) {
                *(int4*)(ip + t) = make_int4(eid[t], eid[t + 1], eid[t + 2], eid[t + 3]);
                *(float4*)(gp + t) = make_float4(ex[t] * inv, ex[t + 1] * inv, ex[t + 2] * inv, ex[t + 3] * inv);
            }
        }
    }
}

__device__ __forceinline__ void phase_tabconv(const Params& P, int l) {
    const float4* U = (const float4*)(P.in[37] + (size_t)l * 16384 * 1024);
    const float4* V = (const float4*)(P.in[38] + (size_t)l * 16384 * 1024);
    ushort4* TU = (ushort4*)(P.ws + OFF_TBU);
    ushort4* TV = (ushort4*)(P.ws + OFF_TBV);
    const size_t n4 = (size_t)16384 * 256;
    for (size_t i = (size_t)blockIdx.x * 256 + otid(); i < n4; i += (size_t)gridDim.x * 256) {
        const float4 a = U[i], b = V[i];
        ushort4 oa, ob;
        oa.x = f2bf(a.x); oa.y = f2bf(a.y); oa.z = f2bf(a.z); oa.w = f2bf(a.w);
        ob.x = f2bf(b.x); ob.y = f2bf(b.y); ob.z = f2bf(b.z); ob.w = f2bf(b.w);
        TU[i] = oa; TV[i] = ob;
    }
}
__device__ __forceinline__ float dot2bf(unsigned a, unsigned b, float acc) { return __builtin_amdgcn_fdot2_f32_bf16(__builtin_bit_cast(bf16x2, a), __builtin_bit_cast(bf16x2, b), acc, false); }
__device__ __forceinline__ float dot8(const uint4& a, const uint4& b, float acc) { acc = dot2bf(a.x, b.x, acc); acc = dot2bf(a.y, b.y, acc); acc = dot2bf(a.z, b.z, acc); return dot2bf(a.w, b.w, acc); }
__device__ __forceinline__ void phase_gather(const Params& P, int l, unsigned char* smem) {
    const int tid = otid(), lane = tid & 63, wave = __builtin_amdgcn_readfirstlane(tid >> 6);
    float* XS = (float*)(P.ws + OFF_XS);
    const float* MOD = (const float*)(P.ws + OFF_MOD);
    const bf16_t* H2 = (const bf16_t*)(P.ws + OFF_H2);
    bf16_t* H = (bf16_t*)(P.ws + OFF_H);
    const int* IDX = (const int*)(P.ws + OFF_IDX);
    const float* GATE = (const float*)(P.ws + OFF_GATE);
    const bf16_t* TU = (const bf16_t*)(P.ws + OFF_TBU);
    const bf16_t* TV = (const bf16_t*)(P.ws + OFF_TBV);
    float* coef = (float*)smem + wave * 128;
    for (int row = blockIdx.x * 4 + wave; row < MROWS; row += gridDim.x * 4) {
        if (l == 1 && (row % LTOT) < CTX) continue;
        const uint4 h0 = *(const uint4*)(H2 + (size_t)row * DM + 8 * lane), h1 = *(const uint4*)(H2 + (size_t)row * DM + 512 + 8 * lane);
        const int e0 = IDX[(size_t)row * 128 + lane], e1 = IDX[(size_t)row * 128 + 64 + lane];
        uint4 ra[8], rb[8];
#define LOADB(T, bt) { _Pragma("unroll") for (int i = 0; i < 8; ++i) { const int k = (bt) * 8 + i; const int e = __builtin_amdgcn_readlane(k < 64 ? e0 : e1, k & 63); \
            const uint4* rp = (const uint4*)((T) + (size_t)e * 1024); ra[i] = rp[lane]; rb[i] = rp[64 + lane]; } }
        for (int bt = 0; bt < 16; ++bt) {
            LOADB(TU, bt)
            float p[8];
#pragma unroll
            for (int i = 0; i < 8; ++i) p[i] = dot8(rb[i], h1, dot8(ra[i], h0, 0.f));
            float q[4], r2[2];
#pragma unroll
            for (int i = 0; i < 4; ++i) { const float sd = (lane & 32) ? p[i] : p[i + 4]; const float rc = __shfl_xor(sd, 32, 64); q[i] = ((lane & 32) ? p[i + 4] : p[i]) + rc; }
#pragma unroll
            for (int i = 0; i < 2; ++i) { const float sd = (lane & 16) ? q[i] : q[i + 2]; const float rc = __shfl_xor(sd, 16, 64); r2[i] = ((lane & 16) ? q[i + 2] : q[i]) + rc; }
            float sv;
            { const float sd = (lane & 8) ? r2[0] : r2[1]; const float rc = __shfl_xor(sd, 8, 64); sv = ((lane & 8) ? r2[1] : r2[0]) + rc; }
            sv += __shfl_xor(sv, 4, 64); sv += __shfl_xor(sv, 2, 64); sv += __shfl_xor(sv, 1, 64);
            if ((lane & 7) == 0) { const int k = bt * 8 + ((lane >> 3) & 7); coef[k] = gelu_tanh(sv) * GATE[(size_t)row * 128 + k]; }
        }
        float acc[16];
#pragma unroll
        for (int j = 0; j < 16; ++j) acc[j] = 0.f;
        for (int bt = 0; bt < 16; ++bt) {
            LOADB(TV, bt)
#pragma unroll
            for (int i = 0; i < 8; ++i) {
                const float c = coef[bt * 8 + i];
                const unsigned w[8] = {ra[i].x, ra[i].y, ra[i].z, ra[i].w, rb[i].x, rb[i].y, rb[i].z, rb[i].w};
#pragma unroll
                for (int j = 0; j < 8; ++j) { acc[2 * j] += c * __uint_as_float(w[j] << 16); acc[2 * j + 1] += c * __uint_as_float(w[j] & 0xFFFF0000u); }
            }
        }
#undef LOADB
        const float* mod = MOD + (size_t)(l * 5 + modrow(row)) * 6144;
        float v[16]; float s = 0.f;
#pragma unroll
        for (int hh = 0; hh < 2; ++hh) {
            const int d = 512 * hh + 8 * lane;
            const float4 x0 = *(const float4*)(XS + (size_t)row * DM + d), x1 = *(const float4*)(XS + (size_t)row * DM + d + 4);
            const float4 g0 = *(const float4*)(mod + 5120 + d), g1 = *(const float4*)(mod + 5120 + d + 4);
            v[8 * hh + 0] = ALPHA * x0.x + g0.x * acc[8 * hh + 0]; v[8 * hh + 1] = ALPHA * x0.y + g0.y * acc[8 * hh + 1];
            v[8 * hh + 2] = ALPHA * x0.z + g0.z * acc[8 * hh + 2]; v[8 * hh + 3] = ALPHA * x0.w + g0.w * acc[8 * hh + 3];
            v[8 * hh + 4] = ALPHA * x1.x + g1.x * acc[8 * hh + 4]; v[8 * hh + 5] = ALPHA * x1.y + g1.y * acc[8 * hh + 5];
            v[8 * hh + 6] = ALPHA * x1.z + g1.z * acc[8 * hh + 6]; v[8 * hh + 7] = ALPHA * x1.w + g1.w * acc[8 * hh + 7];
        }
#pragma unroll
        for (int j = 0; j < 16; ++j) s += v[j];
        const float mean = wave_sum(s) * (1.f / 1024.f);
        float qq = 0.f;
#pragma unroll
        for (int j = 0; j < 16; ++j) { v[j] -= mean; qq += v[j] * v[j]; }
        const float rs = rsqrtf(wave_sum(qq) * (1.f / 1024.f) + 1e-5f);
        const float* mod1 = MOD + (size_t)(1 * 5 + modrow(row)) * 6144;
#pragma unroll
        for (int hh = 0; hh < 2; ++hh) {
            const int d = 512 * hh + 8 * lane;
            float o[8];
#pragma unroll
            for (int j = 0; j < 8; ++j) o[j] = v[8 * hh + j] * rs * P.in[10][l * 1024 + d + j] + P.in[11][l * 1024 + d + j];
            if (l == 0) {
                *(float4*)(XS + (size_t)row * DM + d) = make_float4(o[0], o[1], o[2], o[3]);
                *(float4*)(XS + (size_t)row * DM + d + 4) = make_float4(o[4], o[5], o[6], o[7]);
                bf16_t hb[8];
#pragma unroll
                for (int j = 0; j < 8; ++j) hb[j] = f2bf(o[j] * (1.f + mod1[1024 + d + j]) + mod1[d + j]);
                uint4 pk; pk.x = hb[0] | ((unsigned)hb[1] << 16); pk.y = hb[2] | ((unsigned)hb[3] << 16); pk.z = hb[4] | ((unsigned)hb[5] << 16); pk.w = hb[6] | ((unsigned)hb[7] << 16);
                *(uint4*)(H + (size_t)row * DM + d) = pk;
            } else {
                const int b = row / LTOT, t = row % LTOT - CTX;
                if (*(volatile unsigned*)(P.ws + OFF_BAR + 15360) != 0u) { o[0] = __int_as_float(0x7fc00000); }
                float* op = P.out + ((size_t)b * SEQ + t) * DM + d;
                *(float4*)op = make_float4(o[0], o[1], o[2], o[3]);
                *(float4*)(op + 4) = make_float4(o[4], o[5], o[6], o[7]);
            }
        }
    }
}

__device__ __forceinline__ void s5_prep_unit(const Params& P, int l, int g, unsigned char* smem) {
    const int tid = otid();
    float* Kt = (float*)smem;
    float* bbr = Kt + 8192; float* bbi = bbr + 1024; float* cr = bbi + 1024; float* ci = cr + 1024; float* pwr = ci + 1024; float* pwi = pwr + 17 * 64;
    bf16_t* MS = (bf16_t*)(P.ws + OFF_S5MS) + (size_t)(l * 16 + g) * 256 * 256;
    bf16_t* MY = (bf16_t*)(P.ws + OFF_S5MY) + (size_t)(l * 16 + g) * 256 * 512;
    float* LB = (float*)(P.ws + OFF_S5LB) + (size_t)(l * 16 + g) * 256;
    for (int dir = 0; dir < 2; ++dir) {
        __syncthreads();
        const int ldg = (l * 2 + dir) * 16 + g;
        if (tid < 64) {
            const int p = tid;
            const float dt = expf(P.in[14][ldg]);
            const float lre = P.in[12][ldg * 64 + p], lim = P.in[13][ldg * 64 + p];
            for (int d = 0; d <= 16; ++d) { const float mag = expf(lre * dt * (float)d), ang = lim * dt * (float)d; pwr[d * 64 + p] = mag * cosf(ang); pwi[d * 64 + p] = mag * sinf(ang); }
            const float lb_re = pwr[64 + p], lb_im = pwi[64 + p];
            const float den = lre * lre + lim * lim, nr = lb_re - 1.f, ni = lb_im;
            const float co_re = (nr * lre + ni * lim) / den, co_im = (ni * lre - nr * lim) / den;
            for (int h = 0; h < 16; ++h) {
                const float br = P.in[15][((size_t)ldg * 64 + p) * 16 + h], bi = P.in[16][((size_t)ldg * 64 + p) * 16 + h];
                bbr[p * 16 + h] = co_re * br - co_im * bi; bbi[p * 16 + h] = co_re * bi + co_im * br;
            }
            LB[dir * 128 + p] = pwr[16 * 64 + p]; LB[dir * 128 + 64 + p] = pwi[16 * 64 + p];
        }
        for (int e = tid; e < 1024; e += 256) { cr[e] = P.in[17][(size_t)ldg * 1024 + e]; ci[e] = P.in[18][(size_t)ldg * 1024 + e]; }
        __syncthreads();
        for (int e = tid; e < 4096; e += 256) {
            const int d = e >> 8, h = (e >> 4) & 15, h2 = e & 15;
            float acc = 0.f;
            for (int p = 0; p < 64; ++p) {
                const float Pr = pwr[d * 64 + p], Pi = pwi[d * 64 + p], br = bbr[p * 16 + h2], bi = bbi[p * 16 + h2];
                acc += cr[h * 64 + p] * (Pr * br - Pi * bi) - ci[h * 64 + p] * (Pr * bi + Pi * br);
            }
            Kt[dir * 4096 + e] = acc;
        }
        for (int e = tid; e < 128 * 256; e += 256) {
            const int q = e >> 8, col = e & 255, j = col >> 4, h2 = col & 15, p = q & 63;
            const int ex = dir == 0 ? 15 - j : j;
            const float Pr = pwr[ex * 64 + p], Pi = pwi[ex * 64 + p], br = bbr[p * 16 + h2], bi = bbi[p * 16 + h2];
            MS[(size_t)(dir * 128 + q) * 256 + col] = f2bf(q < 64 ? Pr * br - Pi * bi : Pr * bi + Pi * br);
        }
        for (int e = tid; e < 256 * 128; e += 256) {
            const int ri = e >> 7, q = e & 127, t = ri >> 4, h = ri & 15, p = q & 63;
            const int ex = dir == 0 ? t + 1 : 16 - t;
            const float Lr = pwr[ex * 64 + p], Li = pwi[ex * 64 + p], c_r = cr[h * 64 + p], c_i = ci[h * 64 + p];
            MY[(size_t)ri * 512 + 256 + dir * 128 + q] = f2bf(q < 64 ? c_r * Lr - c_i * Li : -(c_r * Li + c_i * Lr));
        }
    }
    __syncthreads();
    for (int e = tid; e < 256 * 256; e += 256) {
        const int ri = e >> 8, col = e & 255, t = ri >> 4, h = ri & 15, j = col >> 4, h2 = col & 15;
        float v = 0.f;
        if (j <= t) v += Kt[(t - j) * 256 + h * 16 + h2];
        if (j >= t) v += Kt[4096 + (j - t) * 256 + h * 16 + h2];
        MY[(size_t)ri * 512 + col] = f2bf(v);
    }
}
__device__ __forceinline__ void s5_passA(const Params& P, int l) {
    const int lane = otid() & 63, wave = __builtin_amdgcn_readfirstlane(otid() >> 6), fr = lane & 15, fq = lane >> 4;
    const bf16_t* Pb = (const bf16_t*)(P.ws + OFF_P);
    float* ST = (float*)(P.ws + OFF_S5ST);
    for (int it = blockIdx.x * 4 + wave; it < 16 * 17 * 4; it += gridDim.x * 4) {
        const int g = it / 68, mt = (it % 68) >> 2, nt = it & 3;
        const bf16_t* MS = (const bf16_t*)(P.ws + OFF_S5MS) + (size_t)(l * 16 + g) * 256 * 256;
        f32x4 acc[4][4];
#pragma unroll
        for (int i = 0; i < 4; ++i)
#pragma unroll
            for (int j = 0; j < 4; ++j) acc[i][j] = (f32x4){0.f, 0.f, 0.f, 0.f};
        const bf16_t* ap[4];
#pragma unroll
        for (int i = 0; i < 4; ++i) { const int m = mt * 64 + 16 * i + fr, b = m / 272, c = m % 272; ap[i] = Pb + (size_t)(b * LTOT + c * 16) * PIN + g * 16; }
        const bf16_t* bp = MS + (size_t)(nt * 64 + fr) * 256 + 8 * fq;
        for (int k0 = 0; k0 < 256; k0 += 32) {
            const int k = k0 + 8 * fq;
            bf16x8 a[4], bb[4];
#pragma unroll
            for (int i = 0; i < 4; ++i) a[i] = *(const bf16x8*)(ap[i] + (size_t)(k >> 4) * PIN + (k & 15));
#pragma unroll
            for (int j = 0; j < 4; ++j) bb[j] = *(const bf16x8*)(bp + (size_t)(16 * j) * 256 + k0);
#pragma unroll
            for (int i = 0; i < 4; ++i)
#pragma unroll
                for (int j = 0; j < 4; ++j) acc[i][j] = __builtin_amdgcn_mfma_f32_16x16x32_bf16(a[i], bb[j], acc[i][j], 0, 0, 0);
        }
#pragma unroll
        for (int i = 0; i < 4; ++i)
#pragma unroll
            for (int r = 0; r < 4; ++r) {
                const int m = mt * 64 + 16 * i + 4 * fq + r, b = m / 272, c = m % 272;
                float* dst = ST + ((size_t)(b * 16 + g) * 272 + c) * 256 + nt * 64 + fr;
#pragma unroll
                for (int j = 0; j < 4; ++j) dst[16 * j] = acc[i][j][r];
            }
    }
}
__device__ __forceinline__ void s5_carry(const Params& P, int l, int bid, int nb) {
    float* ST = (float*)(P.ws + OFF_S5ST);
    for (int u = bid; u < 32; u += nb) {
        const int gid = u * 256 + otid(), p = gid & 63, dir = (gid >> 6) & 1, g = (gid >> 7) & 15, b = gid >> 11;
        const float* LB = (const float*)(P.ws + OFF_S5LB) + (size_t)(l * 16 + g) * 256 + dir * 128;
        const float lr = LB[p], li = LB[64 + p];
        float* base = ST + (size_t)(b * 16 + g) * 272 * 256 + dir * 128 + p;
        float sr = 0.f, si = 0.f;
        for (int c0 = 0; c0 < 272; c0 += 16) {
            float tr[16], ti[16];
#pragma unroll
            for (int i = 0; i < 16; ++i) { const int cc = c0 + i, c = dir == 0 ? cc : (cc < 16 ? 15 - cc : 287 - cc); tr[i] = base[(size_t)c * 256]; ti[i] = base[(size_t)c * 256 + 64]; }
#pragma unroll
            for (int i = 0; i < 16; ++i) {
                const int cc = c0 + i, c = dir == 0 ? cc : (cc < 16 ? 15 - cc : 287 - cc);
                base[(size_t)c * 256] = sr; base[(size_t)c * 256 + 64] = si;
                const float nr = lr * sr - li * si + tr[i], ni = lr * si + li * sr + ti[i];
                sr = nr; si = ni;
            }
        }
    }
}
__device__ __forceinline__ void s5_passC(const Params& P, int l) {
    const int lane = otid() & 63, wave = __builtin_amdgcn_readfirstlane(otid() >> 6), fr = lane & 15, fq = lane >> 4;
    const bf16_t* Pb = (const bf16_t*)(P.ws + OFF_P);
    const float* ST = (const float*)(P.ws + OFF_S5ST);
    bf16_t* YA = (bf16_t*)(P.ws + OFF_YP);
    for (int it = blockIdx.x * 4 + wave; it < 16 * 17 * 4; it += gridDim.x * 4) {
        const int g = it / 68, mt = (it % 68) >> 2, nt = it & 3;
        const bf16_t* MY = (const bf16_t*)(P.ws + OFF_S5MY) + (size_t)(l * 16 + g) * 256 * 512;
        f32x4 acc[4][4];
#pragma unroll
        for (int i = 0; i < 4; ++i)
#pragma unroll
            for (int j = 0; j < 4; ++j) acc[i][j] = (f32x4){0.f, 0.f, 0.f, 0.f};
        const bf16_t* ap[4]; const float* sp[4];
#pragma unroll
        for (int i = 0; i < 4; ++i) {
            const int m = mt * 64 + 16 * i + fr, b = m / 272, c = m % 272;
            ap[i] = Pb + (size_t)(b * LTOT + c * 16) * PIN + g * 16;
            sp[i] = ST + ((size_t)(b * 16 + g) * 272 + c) * 256;
        }
        const bf16_t* bp = MY + (size_t)(nt * 64 + fr) * 512 + 8 * fq;
        for (int k0 = 0; k0 < 512; k0 += 32) {
            const int k = k0 + 8 * fq;
            bf16x8 a[4], bb[4];
            if (k0 < 256) {
#pragma unroll
                for (int i = 0; i < 4; ++i) a[i] = *(const bf16x8*)(ap[i] + (size_t)(k >> 4) * PIN + (k & 15));
            } else {
#pragma unroll
                for (int i = 0; i < 4; ++i) {
                    const float4 s0 = *(const float4*)(sp[i] + (k - 256)), s1 = *(const float4*)(sp[i] + (k - 256) + 4);
                    bf16x8 t;
                    t[0] = (short)f2bf(s0.x); t[1] = (short)f2bf(s0.y); t[2] = (short)f2bf(s0.z); t[3] = (short)f2bf(s0.w);
                    t[4] = (short)f2bf(s1.x); t[5] = (short)f2bf(s1.y); t[6] = (short)f2bf(s1.z); t[7] = (short)f2bf(s1.w);
                    a[i] = t;
                }
            }
#pragma unroll
            for (int j = 0; j < 4; ++j) bb[j] = *(const bf16x8*)(bp + (size_t)(16 * j) * 512 + k0);
#pragma unroll
            for (int i = 0; i < 4; ++i)
#pragma unroll
                for (int j = 0; j < 4; ++j) acc[i][j] = __builtin_amdgcn_mfma_f32_16x16x32_bf16(a[i], bb[j], acc[i][j], 0, 0, 0);
        }
        const float dsk = P.in[19][l * 256 + g * 16 + fr];
#pragma unroll
        for (int i = 0; i < 4; ++i)
#pragma unroll
            for (int r = 0; r < 4; ++r) {
                const int m = mt * 64 + 16 * i + 4 * fq + r, b = m / 272, c = m % 272;
#pragma unroll
                for (int j = 0; j < 4; ++j) {
                    const int t = nt * 4 + j;
                    const size_t row = (size_t)(b * LTOT + c * 16 + t);
                    const float u = bf2f(Pb[row * PIN + g * 16 + fr]);
                    YA[row * DM + g * 16 + fr] = f2bf(gelu_tanh(acc[i][j][r] + dsk * u));
                }
            }
    }
}


#define OFF_T8 OFF_P
#define OFF_T8S (OFF_P + (size_t)2 * 16384 * 1024)
typedef float f32x2 __attribute__((ext_vector_type(2)));
__device__ __forceinline__ void phase_tabconv8(const Params& P, int l) {
    const int lane = otid() & 63, wave = __builtin_amdgcn_readfirstlane(otid() >> 6);
    unsigned char* T8 = P.ws + OFF_T8;
    float* T8S = (float*)(P.ws + OFF_T8S);
    for (int row = blockIdx.x * 4 + wave; row < 32768; row += gridDim.x * 4) {
        const float* src = P.in[37 + (row >> 14)] + ((size_t)l * 16384 + (row & 16383)) * 1024 + 16 * lane;
        f32x4 x[4];
        float am = 0.f;
#pragma unroll
        for (int j = 0; j < 4; ++j) { x[j] = *(const f32x4*)(src + 4 * j); am = fmaxf(am, fmaxf(fmaxf(fabsf(x[j][0]), fabsf(x[j][1])), fmaxf(fabsf(x[j][2]), fabsf(x[j][3])))); }
#pragma unroll
        for (int o = 32; o > 0; o >>= 1) am = fmaxf(am, __shfl_xor(am, o, 64));
        const float sc = am > 0.f ? 224.f / am : 1.f;
        u32x4 pk;
#pragma unroll
        for (int j = 0; j < 4; ++j) {
            int p = __builtin_amdgcn_cvt_pk_fp8_f32(x[j][0] * sc, x[j][1] * sc, 0, false);
            p = __builtin_amdgcn_cvt_pk_fp8_f32(x[j][2] * sc, x[j][3] * sc, p, true);
            pk[j] = (unsigned)p;
        }
        *(u32x4*)(T8 + (size_t)row * 1024 + 16 * lane) = pk;
        if (lane == 0) T8S[row] = am * (1.f / 224.f);
    }
}
__device__ __forceinline__ void phase_gather8(const Params& P, int l, unsigned char* smem) {
    const int tid = otid(), lane = tid & 63, wave = __builtin_amdgcn_readfirstlane(tid >> 6);
    float* XS = (float*)(P.ws + OFF_XS);
    const float* MOD = (const float*)(P.ws + OFF_MOD);
    const bf16_t* H2 = (const bf16_t*)(P.ws + OFF_H2);
    bf16_t* H = (bf16_t*)(P.ws + OFF_H);
    const int* IDX = (const int*)(P.ws + OFF_IDX);
    const float* GATE = (const float*)(P.ws + OFF_GATE);
    const unsigned char* TU = P.ws + OFF_T8;
    const unsigned char* TV = TU + (size_t)16384 * 1024;
    const float* SU = (const float*)(P.ws + OFF_T8S);
    const float* SV = SU + 16384;
    float* coef = (float*)smem + wave * 128;
    for (int row = blockIdx.x * 4 + wave; row < MROWS; row += gridDim.x * 4) {
        if (l == 1 && (row % LTOT) < CTX) continue;
        float hv[16];
        {
            const u32x4 h0 = *(const u32x4*)(H2 + (size_t)row * DM + 16 * lane), h1 = *(const u32x4*)(H2 + (size_t)row * DM + 16 * lane + 8);
#pragma unroll
            for (int j = 0; j < 4; ++j) { hv[2 * j] = __uint_as_float(h0[j] << 16); hv[2 * j + 1] = __uint_as_float(h0[j] & 0xFFFF0000u); hv[8 + 2 * j] = __uint_as_float(h1[j] << 16); hv[9 + 2 * j] = __uint_as_float(h1[j] & 0xFFFF0000u); }
        }
        const int e0 = IDX[(size_t)row * 128 + lane], e1 = IDX[(size_t)row * 128 + 64 + lane];
        const float g0 = GATE[(size_t)row * 128 + lane], g1 = GATE[(size_t)row * 128 + 64 + lane];
        const float su0 = SU[e0], su1 = SU[e1], sv0 = SV[e0], sv1 = SV[e1];
        u32x4 rr[8];
#define LOAD8(T, bt) { _Pragma("unroll") for (int i = 0; i < 8; ++i) { const int k = (bt) * 8 + i; const int e = __builtin_amdgcn_readlane(k < 64 ? e0 : e1, k & 63); \
            rr[i] = *(const u32x4*)((T) + (size_t)e * 1024 + 16 * lane); } }
        for (int bt = 0; bt < 16; ++bt) {
            LOAD8(TU, bt)
            float p[8];
#pragma unroll
            for (int i = 0; i < 8; ++i) {
                float a = 0.f;
#pragma unroll
                for (int j = 0; j < 4; ++j) {
                    const f32x2 lo = __builtin_amdgcn_cvt_pk_f32_fp8((int)rr[i][j], false), hi = __builtin_amdgcn_cvt_pk_f32_fp8((int)rr[i][j], true);
                    a += lo[0] * hv[4 * j] + lo[1] * hv[4 * j + 1] + hi[0] * hv[4 * j + 2] + hi[1] * hv[4 * j + 3];
                }
                p[i] = a;
            }
            float q[4], r2[2];
#pragma unroll
            for (int i = 0; i < 4; ++i) { const float sd = (lane & 32) ? p[i] : p[i + 4]; const float rc = __shfl_xor(sd, 32, 64); q[i] = ((lane & 32) ? p[i + 4] : p[i]) + rc; }
#pragma unroll
            for (int i = 0; i < 2; ++i) { const float sd = (lane & 16) ? q[i] : q[i + 2]; const float rc = __shfl_xor(sd, 16, 64); r2[i] = ((lane & 16) ? q[i + 2] : q[i]) + rc; }
            float sv;
            { const float sd = (lane & 8) ? r2[0] : r2[1]; const float rc = __shfl_xor(sd, 8, 64); sv = ((lane & 8) ? r2[1] : r2[0]) + rc; }
            sv += __shfl_xor(sv, 4, 64); sv += __shfl_xor(sv, 2, 64); sv += __shfl_xor(sv, 1, 64);
            const int k = bt * 8 + ((lane >> 3) & 7);
            const float suk = __shfl(k < 64 ? su0 : su1, k & 63, 64), svk = __shfl(k < 64 ? sv0 : sv1, k & 63, 64), gk = __shfl(k < 64 ? g0 : g1, k & 63, 64);
            if ((lane & 7) == 0) coef[k] = gelu_tanh(sv * suk) * gk * svk;
        }
        float acc[16];
#pragma unroll
        for (int j = 0; j < 16; ++j) acc[j] = 0.f;
        for (int bt = 0; bt < 16; ++bt) {
            LOAD8(TV, bt)
#pragma unroll
            for (int i = 0; i < 8; ++i) {
                const float c = coef[bt * 8 + i];
#pragma unroll
                for (int j = 0; j < 4; ++j) {
                    const f32x2 lo = __builtin_amdgcn_cvt_pk_f32_fp8((int)rr[i][j], false), hi = __builtin_amdgcn_cvt_pk_f32_fp8((int)rr[i][j], true);
                    acc[4 * j] += c * lo[0]; acc[4 * j + 1] += c * lo[1]; acc[4 * j + 2] += c * hi[0]; acc[4 * j + 3] += c * hi[1];
                }
            }
        }
#undef LOAD8
        const float* mod = MOD + (size_t)(l * 5 + modrow(row)) * 6144;
        const int d0 = 16 * lane;
        float v[16]; float s = 0.f;
#pragma unroll
        for (int j = 0; j < 4; ++j) {
            const f32x4 x = *(const f32x4*)(XS + (size_t)row * DM + d0 + 4 * j), g = *(const f32x4*)(mod + 5120 + d0 + 4 * j);
#pragma unroll
            for (int e = 0; e < 4; ++e) { v[4 * j + e] = ALPHA * x[e] + g[e] * acc[4 * j + e]; s += v[4 * j + e]; }
        }
        const float mean = wave_sum(s) * (1.f / 1024.f);
        float qq = 0.f;
#pragma unroll
        for (int j = 0; j < 16; ++j) { v[j] -= mean; qq += v[j] * v[j]; }
        const float rs = rsqrtf(wave_sum(qq) * (1.f / 1024.f) + 1e-5f);
        const float* mod1 = MOD + (size_t)(1 * 5 + modrow(row)) * 6144;
#pragma unroll
        for (int j = 0; j < 4; ++j) {
            const int d = d0 + 4 * j;
            const f32x4 gg = *(const f32x4*)(P.in[10] + l * 1024 + d), bb = *(const f32x4*)(P.in[11] + l * 1024 + d);
            f32x4 o;
#pragma unroll
            for (int e = 0; e < 4; ++e) o[e] = v[4 * j + e] * rs * gg[e] + bb[e];
            if (l == 0) {
                *(f32x4*)(XS + (size_t)row * DM + d) = o;
                const f32x4 sh = *(const f32x4*)(mod1 + d), sc = *(const f32x4*)(mod1 + 1024 + d);
                const unsigned w0 = f2bf(o[0] * (1.f + sc[0]) + sh[0]) | ((unsigned)f2bf(o[1] * (1.f + sc[1]) + sh[1]) << 16);
                const unsigned w1 = f2bf(o[2] * (1.f + sc[2]) + sh[2]) | ((unsigned)f2bf(o[3] * (1.f + sc[3]) + sh[3]) << 16);
                *(uint2*)(H + (size_t)row * DM + d) = make_uint2(w0, w1);
            } else {
                const int b = row / LTOT, t = row % LTOT - CTX;
                *(f32x4*)(P.out + ((size_t)b * SEQ + t) * DM + d) = o;
            }
        }
    }
}

struct RwPrep { bf16_t lw[16]; bf16_t r[4], k[4], kap[4], a[4]; };
__device__ __forceinline__ void rwkv_prep_load(const bf16_t* RW, int b, int hd, int dir, int tau_base, int wave, int lane, RwPrep& R) {
    const int ch = hd * 64 + lane;
    const int row0 = row_of(b, dir, tau_base);
    const long rstep = dir ? -(long)RWW : (long)RWW;
    const bf16_t* base = RW + (size_t)row0 * RWW + ch;
#pragma unroll
    for (int t = 0; t < 16; ++t) R.lw[t] = base[t * rstep + 3072 + dir * 512];
#pragma unroll
    for (int tt = 0; tt < 4; ++tt) {
        const bf16_t* rw = base + (4 * wave + tt) * rstep;
        R.r[tt] = rw[0]; R.k[tt] = rw[512]; R.kap[tt] = rw[1536]; R.a[tt] = rw[2048 + dir * 512];
    }
}
__device__ __forceinline__ void rwkv_prep_finish(const RwPrep& R, unsigned char* buf, float ka, int wave, int lane) {
    bf16_t* KR = (bf16_t*)buf; bf16_t* BK = (bf16_t*)(buf + 4608); bf16_t* BbT = (bf16_t*)(buf + 9216); bf16_t* KbT = (bf16_t*)(buf + 11264); float* gT = (float*)(buf + 13312);
    float cs[16];
    {
        float c = 0.f;
#pragma unroll
        for (int t = 0; t < 16; ++t) { c += bf2f(R.lw[t]); cs[t] = c; }
    }
    const float c15 = cs[15];
    if (wave == 0) gT[lane] = __expf(c15);
    float cpw[4], ctw[4];
#pragma unroll
    for (int tt = 0; tt < 4; ++tt) {
        cpw[tt] = wave == 0 ? (tt == 0 ? 0.f : cs[tt - 1 < 0 ? 0 : tt - 1]) : (wave == 1 ? cs[3 + tt] : (wave == 2 ? cs[7 + tt] : cs[11 + tt]));
        ctw[tt] = wave == 0 ? cs[tt] : (wave == 1 ? cs[4 + tt] : (wave == 2 ? cs[8 + tt] : cs[12 + tt]));
    }
    bf16_t bb[4], kb[4];
#pragma unroll
    for (int tt = 0; tt < 4; ++tt) {
        const int t = 4 * wave + tt;
        const float r = bf2f(R.r[tt]), k = bf2f(R.k[tt]), kap = bf2f(R.kap[tt]), a = bf2f(R.a[tt]);
        const float ep = __expf(cpw[tt]), et = __expf(ctw[tt]), em = __expf(-ctw[tt]), eT = __expf(c15 - ctw[tt]);
        const float beta = kap * a, kt = k * (1.f + (a - 1.f) * ka);
        KR[t * 72 + lane] = f2bf(kap * ep); KR[(16 + t) * 72 + lane] = f2bf(r * et);
        BK[t * 72 + lane] = f2bf(beta * em); BK[(16 + t) * 72 + lane] = f2bf(kt * em);
        bb[tt] = f2bf(beta * eT); kb[tt] = f2bf(kt * eT);
    }
    uint2 pb, pk;
    pb.x = bb[0] | ((unsigned)bb[1] << 16); pb.y = bb[2] | ((unsigned)bb[3] << 16);
    pk.x = kb[0] | ((unsigned)kb[1] << 16); pk.y = kb[2] | ((unsigned)kb[3] << 16);
    *(uint2*)(BbT + lane * 16 + 4 * wave) = pb;
    *(uint2*)(KbT + lane * 16 + 4 * wave) = pk;
}
template <int NV>
__device__ __forceinline__ void rwkv_vt_load(const bf16_t* RW, int b, int hd, int dir, int tau_base, int vbase, int lane, bf16_t (&x)[8]) {
    const int row0 = row_of(b, dir, tau_base);
    const long rstep = dir ? -(long)RWW : (long)RWW;
    if (NV == 2) {
        const int vl = lane & 31, th = lane >> 5;
#pragma unroll
        for (int i = 0; i < 8; ++i) x[i] = RW[(size_t)row0 * RWW + (th * 8 + i) * rstep + 1024 + hd * 64 + vbase + vl];
    } else {
        const int vl = lane & 15, tq = lane >> 4;
#pragma unroll
        for (int i = 0; i < 4; ++i) x[i] = RW[(size_t)row0 * RWW + (tq * 4 + i) * rstep + 1024 + hd * 64 + vbase + vl];
    }
}
template <int NV>
__device__ __forceinline__ void rwkv_vt_store(const bf16_t (&x)[8], bf16_t* VT, int lane) {
    if (NV == 2) {
        const int vl = lane & 31, th = lane >> 5;
        u32x4 pk; pk[0] = x[0] | ((unsigned)x[1] << 16); pk[1] = x[2] | ((unsigned)x[3] << 16); pk[2] = x[4] | ((unsigned)x[5] << 16); pk[3] = x[6] | ((unsigned)x[7] << 16);
        *(u32x4*)(VT + vl * 16 + th * 8) = pk;
    } else {
        const int vl = lane & 15, tq = lane >> 4;
        uint2 pk; pk.x = x[0] | ((unsigned)x[1] << 16); pk.y = x[2] | ((unsigned)x[3] << 16);
        *(uint2*)(VT + vl * 16 + tq * 4) = pk;
    }
}
template <int NV, bool HASV, bool OUT>
__device__ __forceinline__ void rwkv_mfma_step(f32x4 (&X)[4][NV], const unsigned char* buf, const bf16_t* VT, f32x4 (&Yout)[NV], int lane) {
    const bf16_t* KR = (const bf16_t*)buf; const bf16_t* BK = (const bf16_t*)(buf + 4608); const bf16_t* BbT = (const bf16_t*)(buf + 9216); const bf16_t* KbT = (const bf16_t*)(buf + 11264); const float* gT = (const float*)(buf + 13312);
    const int fr = lane & 15, fq = lane >> 4;
    const f32x4 z4 = {0.f, 0.f, 0.f, 0.f};
    f32x4 cA = z4, cN = z4, cAk = z4, cRb = z4, cRk = z4;
#pragma unroll
    for (int ks = 0; ks < 2; ++ks) {
        const bf16x8 kh = *(const bf16x8*)(KR + fr * 72 + 32 * ks + 8 * fq), rh = *(const bf16x8*)(KR + (16 + fr) * 72 + 32 * ks + 8 * fq);
        const bf16x8 bc = *(const bf16x8*)(BK + fr * 72 + 32 * ks + 8 * fq), kc = *(const bf16x8*)(BK + (16 + fr) * 72 + 32 * ks + 8 * fq);
        cA = mfma32(kh, bc, cA); cN = mfma32(bc, kh, cN); cAk = mfma32(kc, kh, cAk);
        if (OUT) { cRb = mfma32(bc, rh, cRb); cRk = mfma32(kc, rh, cRk); }
    }
    f32x4 dg;
#pragma unroll
    for (int r = 0; r < 4; ++r) {
        const int row = 4 * fq + r;
        dg[r] = (row == fr) ? 1.f : 0.f;
        cA[r] = (fr < row) ? cA[r] : 0.f;
        cN[r] = (row < fr) ? cN[r] : 0.f;
        cAk[r] = (row < fr) ? cAk[r] : 0.f;
        cRb[r] = (row <= fr) ? cRb[r] : 0.f;
        cRk[r] = (row <= fr) ? cRk[r] : 0.f;
    }
    const bf16x4 a4 = to4(cA), n4 = to4(cN);
    const f32x4 cA2 = mfma16(n4, a4, z4), cN2 = mfma16(a4, n4, z4);
    const bf16x4 a24 = to4(cA2), n24 = to4(cN2);
    const f32x4 cA4 = mfma16(n24, a24, z4), cN4 = mfma16(a24, n24, z4);
    const f32x4 cA8 = mfma16(to4(cN4), to4(cA4), z4);
    const f32x4 T1 = mfma16(to4(dg - cA), to4(dg + cN2), z4);
    const f32x4 T2 = mfma16(to4(dg + cA4), to4(T1), z4);
    const f32x4 WT = mfma16(to4(dg + cA8), to4(T2), z4);
    const bf16x4 wt4 = to4(WT), aak4 = to4(cAk), rab4 = to4(cRb), rak4 = to4(cRk);
    bf16x8 aK[2], aR[2];
#pragma unroll
    for (int ks = 0; ks < 2; ++ks) {
        aK[ks] = cat8(*(const bf16x4*)(KR + fr * 72 + 32 * ks + 4 * fq), *(const bf16x4*)(KR + fr * 72 + 32 * ks + 16 + 4 * fq));
        if (OUT) aR[ks] = cat8(*(const bf16x4*)(KR + (16 + fr) * 72 + 32 * ks + 4 * fq), *(const bf16x4*)(KR + (16 + fr) * 72 + 32 * ks + 16 + 4 * fq));
    }
    bf16x4 u4[NV], vt4[NV];
#pragma unroll
    for (int nj = 0; nj < NV; ++nj) {
        const bf16x8 b0 = cat8(to4(X[0][nj]), to4(X[1][nj])), b1 = cat8(to4(X[2][nj]), to4(X[3][nj]));
        f32x4 G = mfma32(aK[1], b1, mfma32(aK[0], b0, z4));
        if (HASV) { vt4[nj] = *(const bf16x4*)(VT + (16 * nj + fr) * 16 + 4 * fq); G = mfma16(aak4, vt4[nj], G); }
        const f32x4 U = mfma16(wt4, to4(G), z4);
        u4[nj] = to4(-U);
        if (OUT) {
            f32x4 Yv = mfma32(aR[1], b1, mfma32(aR[0], b0, z4));
            Yv = mfma16(rab4, u4[nj], Yv);
            if (HASV) Yv = mfma16(rak4, vt4[nj], Yv);
            Yout[nj] = Yv;
        }
    }
#pragma unroll
    for (int mi = 0; mi < 4; ++mi) {
        const f32x4 g4 = *(const f32x4*)(gT + 16 * mi + 4 * fq);
        const bf16x4 bb4 = *(const bf16x4*)(BbT + (16 * mi + fr) * 16 + 4 * fq), kb4 = *(const bf16x4*)(KbT + (16 * mi + fr) * 16 + 4 * fq);
#pragma unroll
        for (int nj = 0; nj < NV; ++nj) {
            f32x4 x = X[mi][nj] * g4;
            x = mfma16(bb4, u4[nj], x);
            if (HASV) x = mfma16(kb4, vt4[nj], x);
            X[mi][nj] = x;
        }
    }
}
__device__ __forceinline__ void rwkv_passA(const Params& P, int l, unsigned char* smem, int bid, int nb) {
    const int lane = otid() & 63, wave = __builtin_amdgcn_readfirstlane(otid() >> 6), fr = lane & 15, fq = lane >> 4;
    const bf16_t* RW = (const bf16_t*)(P.ws + OFF_RW);
    float* RXL = (float*)(P.ws + OFF_RXL);
    bf16_t* RXP = (bf16_t*)P.out;
    for (int item = bid; item < 64 * RW_NCH; item += nb) {
        const int seq = item / RW_NCH, c = item % RW_NCH, dir = seq & 1, hd = (seq >> 1) & 7, b = seq >> 4;
        const float ka = P.in[31][l * 512 + hd * 64 + lane];
        const int tau0 = c * 128;
        f32x4 X[4][2], Yd[2];
#pragma unroll
        for (int mi = 0; mi < 4; ++mi)
#pragma unroll
            for (int nj = 0; nj < 2; ++nj)
#pragma unroll
                for (int r = 0; r < 4; ++r) X[mi][nj][r] = (wave >= 2 && (16 * mi + 4 * fq + r) == (16 * (2 * (wave - 2) + nj) + fr)) ? 1.f : 0.f;
        bf16_t* VTw = (bf16_t*)(smem + RW_VT0 + wave * 2048);
        RwPrep R; bf16_t vx[8];
        rwkv_prep_load(RW, b, hd, dir, tau0, wave, lane, R);
        if (wave < 2) rwkv_vt_load<2>(RW, b, hd, dir, tau0, 32 * wave, lane, vx);
        rwkv_prep_finish(R, smem, ka, wave, lane);
        if (wave < 2) rwkv_vt_store<2>(vx, VTw, lane);
        __syncthreads();
        for (int s = 0; s < 8; ++s) {
            if (s < 7) rwkv_prep_load(RW, b, hd, dir, tau0 + (s + 1) * 16, wave, lane, R);
            if (wave < 2) rwkv_mfma_step<2, true, false>(X, smem + (s & 1) * RW_BUF, VTw + (s & 1) * 512, Yd, lane);
            else rwkv_mfma_step<2, false, false>(X, smem + (s & 1) * RW_BUF, VTw, Yd, lane);
            if (s < 7) {
                if (wave < 2) rwkv_vt_load<2>(RW, b, hd, dir, tau0 + (s + 1) * 16, 32 * wave, lane, vx);
                rwkv_prep_finish(R, smem + ((s + 1) & 1) * RW_BUF, ka, wave, lane);
                if (wave < 2) rwkv_vt_store<2>(vx, VTw + ((s + 1) & 1) * 512, lane);
            }
            __syncthreads();
        }
        if (wave < 2) {
#pragma unroll
            for (int mi = 0; mi < 4; ++mi)
#pragma unroll
                for (int nj = 0; nj < 2; ++nj) *(f32x4*)(RXL + (((size_t)item * 16 + mi * 4 + 2 * wave + nj) * 64 + lane) * 4) = X[mi][nj];
        } else {
#pragma unroll
            for (int mi = 0; mi < 4; ++mi)
#pragma unroll
                for (int nj = 0; nj < 2; ++nj)
#pragma unroll
                    for (int r = 0; r < 4; ++r) RXP[(size_t)item * 4096 + (16 * mi + 4 * fq + r) * 64 + 16 * (2 * (wave - 2) + nj) + fr] = f2bf(X[mi][nj][r]);
        }
    }
}
__device__ __forceinline__ void rwkv_passB(const Params& P) {
    const int lane = otid() & 63, wave = __builtin_amdgcn_readfirstlane(otid() >> 6), fr = lane & 15, fq = lane >> 4;
    float* RXL = (float*)(P.ws + OFF_RXL);
    const bf16_t* RXP = (const bf16_t*)P.out;
    for (int it = blockIdx.x * 4 + wave; it < 256; it += gridDim.x * 4) {
        const int seq = it >> 2, nj = it & 3;
        f32x4 X[4];
#pragma unroll
        for (int mi = 0; mi < 4; ++mi) X[mi] = (f32x4){0.f, 0.f, 0.f, 0.f};
        for (int c = 0; c < RW_NCH; ++c) {
            const size_t item = (size_t)seq * RW_NCH + c;
            f32x4 L[4]; bf16x8 a[4][2];
#pragma unroll
            for (int mi = 0; mi < 4; ++mi) {
                L[mi] = *(const f32x4*)(RXL + ((item * 16 + mi * 4 + nj) * 64 + lane) * 4);
                const bf16_t* xp = RXP + item * 4096 + (16 * mi + fr) * 64;
#pragma unroll
                for (int ks = 0; ks < 2; ++ks) a[mi][ks] = cat8(*(const bf16x4*)(xp + 32 * ks + 4 * fq), *(const bf16x4*)(xp + 32 * ks + 16 + 4 * fq));
            }
            const bf16x8 b0 = cat8(to4(X[0]), to4(X[1])), b1 = cat8(to4(X[2]), to4(X[3]));
#pragma unroll
            for (int mi = 0; mi < 4; ++mi) {
                *(f32x4*)(RXL + ((item * 16 + mi * 4 + nj) * 64 + lane) * 4) = X[mi];
                X[mi] = mfma32(a[mi][1], b1, mfma32(a[mi][0], b0, L[mi]));
            }
        }
    }
}
template <bool CHECK>
__device__ __forceinline__ void rwkv_passC(const Params& P, int l, unsigned char* smem) {
    const int lane = otid() & 63, wave = __builtin_amdgcn_readfirstlane(otid() >> 6), fr = lane & 15, fq = lane >> 4;
    const bf16_t* RW = (const bf16_t*)(P.ws + OFF_RW);
    const float* RXL = (const float*)(P.ws + OFF_RXL);
    for (int item = blockIdx.x; item < 64 * RW_NCH; item += gridDim.x) {
        const int seq = item / RW_NCH, c = item % RW_NCH, dir = seq & 1, hd = (seq >> 1) & 7, b = seq >> 4;
        if (l == 1 && dir == 0 && c < 2) continue;
        if (l == 1 && dir == 1 && c < 2) continue;
        bf16_t* YP = (bf16_t*)(P.ws + OFF_YP) + (size_t)dir * MROWS * DM;
        const float ka = P.in[31][l * 512 + hd * 64 + lane];
        const int tau0 = c * 128;
        f32x4 X[4][1], Yo[1];
#pragma unroll
        for (int mi = 0; mi < 4; ++mi) X[mi][0] = *(const f32x4*)(RXL + (((size_t)item * 16 + mi * 4 + wave) * 64 + lane) * 4);
        bf16_t* VTw = (bf16_t*)(smem + RW_VT0 + wave * 2048);
        RwPrep R; bf16_t vx[8];
        rwkv_prep_load(RW, b, hd, dir, tau0, wave, lane, R);
        rwkv_vt_load<1>(RW, b, hd, dir, tau0, 16 * wave, lane, vx);
        rwkv_prep_finish(R, smem, ka, wave, lane);
        rwkv_vt_store<1>(vx, VTw, lane);
        __syncthreads();
        for (int s = 0; s < 8; ++s) {
            if (s < 7) {
                rwkv_prep_load(RW, b, hd, dir, tau0 + (s + 1) * 16, wave, lane, R);
                rwkv_vt_load<1>(RW, b, hd, dir, tau0 + (s + 1) * 16, 16 * wave, lane, vx);
            }
            rwkv_mfma_step<1, true, true>(X, smem + (s & 1) * RW_BUF, VTw + (s & 1) * 512, Yo, lane);
            if (s < 7) {
                rwkv_prep_finish(R, smem + ((s + 1) & 1) * RW_BUF, ka, wave, lane);
                rwkv_vt_store<1>(vx, VTw + ((s + 1) & 1) * 512, lane);
            }
#pragma unroll
            for (int r = 0; r < 4; ++r) {
                const int row = row_of(b, dir, tau0 + s * 16 + 4 * fq + r);
                if (CHECK) { if (YP[(size_t)row * DM + 512 + hd * 64 + 16 * wave + fr] != f2bf(Yo[0][r])) atomicAdd((unsigned*)(P.ws + OFF_BAR + 15360), 1u); }
                else YP[(size_t)row * DM + 512 + hd * 64 + 16 * wave + fr] = f2bf(Yo[0][r]);
            }
            __syncthreads();
        }
    }
}


#define HG_NCH 34
#define HG_BUF 7168
#define HG_VT0 14336
#define OFF_O_RXP 0ull
#define OFF_O_HXL ((size_t)2176 * 8192)
#define OFF_O_HD (OFF_O_HXL + (size_t)1088 * 16384)
struct HgPrep { bf16_t lf[16]; bf16_t q[4]; bf16_t v[4]; };
__device__ __forceinline__ void hgrn_prep_load(const bf16_t* Pb, int b, int hd, int dir, int tau_base, int vbase, int wave, int lane, HgPrep& R) {
    const int row0 = row_of(b, dir, tau_base);
    const long rstep = dir ? -(long)PIN : (long)PIN;
    const bf16_t* base = Pb + (size_t)row0 * PIN + hd * 64;
#pragma unroll
    for (int t = 0; t < 16; ++t) R.lf[t] = base[t * rstep + 768 + dir * 256 + lane];
#pragma unroll
    for (int tt = 0; tt < 4; ++tt) R.q[tt] = base[(4 * wave + tt) * rstep + 256 + lane];
    const int vl = lane & 15, tq = lane >> 4;
#pragma unroll
    for (int i = 0; i < 4; ++i) R.v[i] = base[(tq * 4 + i) * rstep + 512 + vbase + vl];
}
__device__ __forceinline__ float hgrn_prep_finish(const HgPrep& R, unsigned char* buf, bf16_t* VT, int wave, int lane) {
    bf16_t* QH = (bf16_t*)buf; bf16_t* KC = (bf16_t*)(buf + 2304); bf16_t* KbT = (bf16_t*)(buf + 4608); float* gT = (float*)(buf + 6656);
    float cs[16];
    {
        float c = 0.f;
#pragma unroll
        for (int t = 0; t < 16; ++t) { c += bf2f(R.lf[t]); cs[t] = c; }
    }
    const float c15 = cs[15];
    if (wave == 0) gT[lane] = __expf(c15);
    bf16_t kb[4];
#pragma unroll
    for (int tt = 0; tt < 4; ++tt) {
        const int t = 4 * wave + tt;
        const float ct = wave == 0 ? cs[tt] : (wave == 1 ? cs[4 + tt] : (wave == 2 ? cs[8 + tt] : cs[12 + tt]));
        const float lft = wave == 0 ? bf2f(R.lf[tt]) : (wave == 1 ? bf2f(R.lf[4 + tt]) : (wave == 2 ? bf2f(R.lf[8 + tt]) : bf2f(R.lf[12 + tt])));
        const float k = 1.f - __expf(lft);
        QH[t * 72 + lane] = f2bf(bf2f(R.q[tt]) * __expf(ct));
        KC[t * 72 + lane] = f2bf(k * __expf(fminf(-ct, 80.f)));
        kb[tt] = f2bf(k * __expf(c15 - ct));
    }
    uint2 pk; pk.x = kb[0] | ((unsigned)kb[1] << 16); pk.y = kb[2] | ((unsigned)kb[3] << 16);
    *(uint2*)(KbT + lane * 16 + 4 * wave) = pk;
    {
        const int vl = lane & 15, tq = lane >> 4;
        uint2 pv; pv.x = R.v[0] | ((unsigned)R.v[1] << 16); pv.y = R.v[2] | ((unsigned)R.v[3] << 16);
        *(uint2*)(VT + vl * 16 + tq * 4) = pv;
    }
    return c15;
}
template <bool OUT>
__device__ __forceinline__ void hgrn_mfma_step(f32x4 (&X)[4], const unsigned char* buf, const bf16_t* VT, f32x4& Yout, int lane) {
    const bf16_t* QH = (const bf16_t*)buf; const bf16_t* KC = (const bf16_t*)(buf + 2304); const bf16_t* KbT = (const bf16_t*)(buf + 4608); const float* gT = (const float*)(buf + 6656);
    const int fr = lane & 15, fq = lane >> 4;
    const f32x4 z4 = {0.f, 0.f, 0.f, 0.f};
    const bf16x4 vt4 = *(const bf16x4*)(VT + fr * 16 + 4 * fq);
    if (OUT) {
        f32x4 cAT = z4;
#pragma unroll
        for (int ks = 0; ks < 2; ++ks) {
            const bf16x8 kc = *(const bf16x8*)(KC + fr * 72 + 32 * ks + 8 * fq), qh = *(const bf16x8*)(QH + fr * 72 + 32 * ks + 8 * fq);
            cAT = mfma32(kc, qh, cAT);
        }
#pragma unroll
        for (int r = 0; r < 4; ++r) cAT[r] = ((4 * fq + r) <= fr) ? cAT[r] : 0.f;
        const bf16x8 aQ0 = cat8(*(const bf16x4*)(QH + fr * 72 + 4 * fq), *(const bf16x4*)(QH + fr * 72 + 16 + 4 * fq));
        const bf16x8 aQ1 = cat8(*(const bf16x4*)(QH + fr * 72 + 32 + 4 * fq), *(const bf16x4*)(QH + fr * 72 + 48 + 4 * fq));
        const bf16x8 b0 = cat8(to4(X[0]), to4(X[1])), b1 = cat8(to4(X[2]), to4(X[3]));
        f32x4 O = mfma32(aQ1, b1, mfma32(aQ0, b0, z4));
        Yout = mfma16(to4(cAT), vt4, O);
    }
#pragma unroll
    for (int mi = 0; mi < 4; ++mi) {
        const f32x4 g4 = *(const f32x4*)(gT + 16 * mi + 4 * fq);
        const bf16x4 kb4 = *(const bf16x4*)(KbT + (16 * mi + fr) * 16 + 4 * fq);
        X[mi] = mfma16(kb4, vt4, X[mi] * g4);
    }
}
__device__ __forceinline__ float hgrn_lb(const Params& P, int l, int dir, int ch) {
    if (l == 0) return 0.f;
    const float a0 = P.in[22][(dir * 2 + 0) * 256 + ch], a1 = P.in[22][(dir * 2 + 1) * 256 + ch];
    const float m = fmaxf(a0, a1), e0 = __expf(a0 - m), e1 = __expf(a1 - m);
    return e1 / (e0 + e1);
}
template <bool OUT>
__device__ __forceinline__ void hgrn_pass(const Params& P, int l, unsigned char* smem) {
    const int lane = otid() & 63, wave = __builtin_amdgcn_readfirstlane(otid() >> 6), fr = lane & 15, fq = lane >> 4;
    const bf16_t* Pb = (const bf16_t*)(P.ws + OFF_P);
    float* HXL = (float*)((unsigned char*)P.out + OFF_O_HXL);
    float* HD = (float*)((unsigned char*)P.out + OFF_O_HD);
    for (int item = blockIdx.x; item < 32 * HG_NCH; item += gridDim.x) {
        const int seq = item / HG_NCH, c = item % HG_NCH, dir = seq & 1, hd = (seq >> 1) & 3, b = seq >> 3;
        if (OUT && l == 1 && c < 2) continue;
        bf16_t* YP = (bf16_t*)(P.ws + OFF_YP) + (size_t)dir * MROWS * DM;
        const int tau0 = c * 128;
        f32x4 X[4], Yo;
#pragma unroll
        for (int mi = 0; mi < 4; ++mi) X[mi] = OUT ? *(const f32x4*)(HXL + (((size_t)item * 16 + mi * 4 + wave) * 64 + lane) * 4) : (f32x4){0.f, 0.f, 0.f, 0.f};
        bf16_t* VTw = (bf16_t*)(smem + HG_VT0 + wave * 1024);
        HgPrep R;
        hgrn_prep_load(Pb, b, hd, dir, tau0, 16 * wave, wave, lane, R);
        float ctot = hgrn_prep_finish(R, smem, VTw, wave, lane);
        __syncthreads();
        for (int s = 0; s < 8; ++s) {
            if (s < 7) hgrn_prep_load(Pb, b, hd, dir, tau0 + (s + 1) * 16, 16 * wave, wave, lane, R);
            hgrn_mfma_step<OUT>(X, smem + (s & 1) * HG_BUF, VTw + (s & 1) * 256, Yo, lane);
            if (s < 7) ctot += hgrn_prep_finish(R, smem + ((s + 1) & 1) * HG_BUF, VTw + ((s + 1) & 1) * 256, wave, lane);
            if (OUT) {
#pragma unroll
                for (int r = 0; r < 4; ++r) {
                    const int row = row_of(b, dir, tau0 + s * 16 + 4 * fq + r);
                    YP[(size_t)row * DM + 256 + hd * 64 + 16 * wave + fr] = f2bf(Yo[r]);
                }
            }
            __syncthreads();
        }
        if (!OUT) {
#pragma unroll
            for (int mi = 0; mi < 4; ++mi) *(f32x4*)(HXL + (((size_t)item * 16 + mi * 4 + wave) * 64 + lane) * 4) = X[mi];
            if (wave == 0) HD[(size_t)item * 64 + lane] = __expf(ctot);
        }
    }
}
__device__ __forceinline__ void hgrn_carry(const Params& P, int bid, int nb) {
    float* HXL = (float*)((unsigned char*)P.out + OFF_O_HXL);
    const float* HD = (const float*)((unsigned char*)P.out + OFF_O_HD);
    for (int u = bid; u < 128; u += nb) {
        const int gid = u * 256 + otid(), ln = gid & 63, tile = (gid >> 6) & 15, seq = gid >> 10;
        const int mi = tile >> 2, fq = ln >> 4;
        f32x4 x = {0.f, 0.f, 0.f, 0.f};
        for (int c0 = 0; c0 < HG_NCH; c0 += 17) {
            f32x4 L[17];
#pragma unroll
            for (int i = 0; i < 17; ++i) {
                const size_t item = (size_t)seq * HG_NCH + c0 + i;
                L[i] = *(const f32x4*)(HXL + ((item * 16 + tile) * 64 + ln) * 4);
            }
#pragma unroll
            for (int i = 0; i < 17; ++i) {
                const size_t item = (size_t)seq * HG_NCH + c0 + i;
                const f32x4 D = *(const f32x4*)(HD + item * 64 + 16 * mi + 4 * fq);
                *(f32x4*)(HXL + ((item * 16 + tile) * 64 + ln) * 4) = x;
                x = D * x + L[i];
            }
        }
    }
}


__device__ __forceinline__ void phase_rwprep2(const Params& P, int l, unsigned char* smem) {
    const int tid = otid(), lane = tid & 63, wave = __builtin_amdgcn_readfirstlane(tid >> 6), fr = lane & 15, fq = lane >> 4;
    const bf16_t* Pb = (const bf16_t*)(P.ws + OFF_P);
    bf16_t* RW = (bf16_t*)(P.ws + OFF_RW);
    const bf16_t* LW = (const bf16_t*)(P.ws + OFF_LW);
    const float* mu = P.in[24] + l * 1920;
    bf16_t* AL = (bf16_t*)smem;
    float muv[8];
#pragma unroll
    for (int jj = 0; jj < 8; ++jj) muv[jj] = (tid + 256 * jj) < 1920 ? mu[tid + 256 * jj] : 0.f;
    const float kk0 = P.in[30][l * 512 + tid], kk1 = P.in[30][l * 512 + 256 + tid];
    for (int u = blockIdx.x; u < MROWS / 16; u += gridDim.x) {
        const int r0 = u * 16;
        __syncthreads();
        for (int i = 0; i < 16; ++i) {
            const int row = r0 + i, p = row % LTOT;
            int nbr; bool okk;
            {
                const int m = tid & 3;
                if (p < CTX) { nbr = (m & 1) ? row + 1 : row - 1; okk = (m & 1) ? (p < CTX - 1) : (p > 0); }
                else {
                    const int t = p - CTX, gr = t >> 6, gc = t & 63;
                    nbr = m == 0 ? row - 1 : (m == 1 ? row + 1 : (m == 2 ? row - 64 : row + 64));
                    okk = m == 0 ? (gc > 0) : (m == 1 ? (gc < 63) : (m == 2 ? (gr > 0) : (gr < 63)));
                }
            }
            const bf16_t* pp = Pb + (size_t)row * PIN + 1536 + tid;
            const bf16_t* pn = Pb + (size_t)nbr * PIN + 1536 + tid;
            bf16_t* rw = RW + (size_t)row * RWW;
            float sv[8];
#pragma unroll
            for (int jj = 0; jj < 8; ++jj) {
                if (jj < 7 || tid < 128) {
                    const float pv = bf2f(pp[256 * jj]);
                    const float nv = okk ? bf2f(pn[256 * jj]) : 0.f;
                    sv[jj] = pv + muv[jj] * (nv - pv);
                } else sv[jj] = 0.f;
            }
            rw[tid] = f2bf(sv[0]); rw[256 + tid] = f2bf(sv[1]);
            rw[512 + tid] = f2bf(sv[2]); rw[768 + tid] = f2bf(sv[3]);
            rw[1024 + tid] = f2bf(sv[4]); rw[1280 + tid] = f2bf(sv[5]);
            {
                const float a0 = sv[2] * kk0, a1 = sv[3] * kk1;
                const float n0 = fmaxf(sqrtf(wave_sum(a0 * a0)), 1e-12f), n1 = fmaxf(sqrtf(wave_sum(a1 * a1)), 1e-12f);
                rw[1536 + tid] = f2bf(a0 / n0); rw[1792 + tid] = f2bf(a1 / n1);
            }
            if (tid < 128) { rw[4096 + tid] = f2bf(sigmoidf_(sv[6])); AL[((2 + (tid >> 6)) * 16 + i) * 72 + (tid & 63)] = f2bf(sv[7]); }
            else AL[(((tid - 128) >> 6) * 16 + i) * 72 + (tid & 63)] = f2bf(tanhf(sv[6]));
        }
        __syncthreads();
        {
            const int d = wave & 1, isA = wave >> 1;
            const bf16x8 a0 = *(const bf16x8*)(AL + (wave * 16 + fr) * 72 + 8 * fq), a1 = *(const bf16x8*)(AL + (wave * 16 + fr) * 72 + 32 + 8 * fq);
            const bf16_t* W = LW + (size_t)isA * 131072 + (size_t)(l * 2 + d) * 512 * 64;
            const float* bias = P.in[isA ? 27 : 25] + (l * 2 + d) * 512;
            for (int nj = 0; nj < 32; ++nj) {
                const bf16x8 b0 = *(const bf16x8*)(W + (size_t)(16 * nj + fr) * 64 + 8 * fq), b1 = *(const bf16x8*)(W + (size_t)(16 * nj + fr) * 64 + 32 + 8 * fq);
                const f32x4 acc = mfma32(a1, b1, mfma32(a0, b0, (f32x4){0.f, 0.f, 0.f, 0.f}));
                const int c = 16 * nj + fr;
                const float bs = bias[c];
#pragma unroll
                for (int r = 0; r < 4; ++r) {
                    const float sg = sigmoidf_(bs + acc[r]);
                    RW[(size_t)(r0 + 4 * fq + r) * RWW + (isA ? 2048 : 3072) + d * 512 + c] = f2bf(isA ? sg : -0.60653066f * sg);
                }
            }
        }
    }
}
__device__ __forceinline__ void phase_post2(const Params& P, int l) {
    const int tid = otid(), lane = tid & 63, wave = __builtin_amdgcn_readfirstlane(tid >> 6), fr = lane & 15, fq = lane >> 4;
    const bf16_t* Pb = (const bf16_t*)(P.ws + OFF_P);
    const bf16_t* RW = (const bf16_t*)(P.ws + OFF_RW);
    const bf16_t* YF = (const bf16_t*)(P.ws + OFF_YP);
    const bf16_t* YB = YF + (size_t)MROWS * DM;
    const bf16_t* LW = (const bf16_t*)(P.ws + OFF_LW);
    bf16_t* MIX = (bf16_t*)(P.ws + OFF_MIX);
    const f32x4 z4 = {0.f, 0.f, 0.f, 0.f};
    for (int u = blockIdx.x; u < MROWS / 16; u += gridDim.x) {
        const int r0 = u * 16;
        if (l == 1 && (r0 % LTOT) < CTX) continue;
        {
            f32x4 acc[4] = {z4, z4, z4, z4};
            const bf16_t* ap = YF + (size_t)(r0 + fr) * DM + 8 * fq;
            const bf16_t* bp = LW + (size_t)3 * 131072 + (size_t)(l * 256 + 64 * wave + fr) * 256 + 8 * fq;
#pragma unroll
            for (int ks = 0; ks < 8; ++ks) {
                const bf16x8 a = *(const bf16x8*)(ap + 32 * ks);
#pragma unroll
                for (int j = 0; j < 4; ++j) acc[j] = mfma32(a, *(const bf16x8*)(bp + (size_t)(16 * j) * 256 + 32 * ks), acc[j]);
            }
#pragma unroll
            for (int j = 0; j < 4; ++j) {
                const int n = 64 * wave + 16 * j + fr;
                const float gb = P.in[21][l * 256 + n];
#pragma unroll
                for (int r = 0; r < 4; ++r) {
                    const size_t row = (size_t)(r0 + 4 * fq + r);
                    MIX[row * DM + n] = f2bf(bf2f(YF[row * DM + n]) * sigmoidf_(acc[j][r] + gb));
                }
            }
        }
        {
            const int i = tid >> 4, c0 = (tid & 15) * 16; const size_t row = (size_t)(r0 + i);
            float o[16], ss = 0.f;
#pragma unroll
            for (int j = 0; j < 16; ++j) { o[j] = bf2f(YF[row * DM + 256 + c0 + j]) + bf2f(YB[row * DM + 256 + c0 + j]); ss += o[j] * o[j]; }
            ss += __shfl_xor(ss, 1, 64); ss += __shfl_xor(ss, 2, 64);
            const float rs = rsqrtf(ss * (1.f / 64.f) + 1e-6f);
#pragma unroll
            for (int j = 0; j < 16; ++j) {
                const float gr = bf2f(Pb[row * PIN + 1280 + c0 + j]);
                MIX[row * DM + 256 + c0 + j] = f2bf(o[j] * rs * P.in[23][l * 256 + c0 + j] * gr);
            }
        }
#pragma unroll 1
        for (int hh = 0; hh < 2; ++hh) {
            const int h = 2 * wave + hh;
            f32x4 g[4] = {z4, z4, z4, z4};
            const bf16_t* ap = RW + (size_t)(r0 + fr) * RWW + 4096 + 8 * fq;
            const bf16_t* bp = LW + (size_t)2 * 131072 + (size_t)(l * 512 + h * 64 + fr) * 128 + 8 * fq;
#pragma unroll
            for (int ks = 0; ks < 4; ++ks) {
                const bf16x8 a = *(const bf16x8*)(ap + 32 * ks);
#pragma unroll
                for (int j = 0; j < 4; ++j) g[j] = mfma32(a, *(const bf16x8*)(bp + (size_t)(16 * j) * 128 + 32 * ks), g[j]);
            }
#pragma unroll
            for (int r = 0; r < 4; ++r) {
                const size_t row = (size_t)(r0 + 4 * fq + r);
                const bf16_t* rw = RW + row * RWW;
                float y[4], vv[4], sum = 0.f, bon = 0.f;
#pragma unroll
                for (int j = 0; j < 4; ++j) {
                    const int c = h * 64 + 16 * j + fr;
                    y[j] = bf2f(YF[row * DM + 512 + c]) + bf2f(YB[row * DM + 512 + c]);
                    sum += y[j];
                    const float rr = bf2f(rw[c]), k = bf2f(rw[512 + c]), af = bf2f(rw[2048 + c]), ab = bf2f(rw[2560 + c]);
                    const float ka = P.in[31][l * 512 + c];
                    vv[j] = bf2f(rw[1024 + c]);
                    bon += rr * P.in[32][l * 512 + c] * k * (2.f + (af + ab - 2.f) * ka);
                }
#pragma unroll
                for (int o = 1; o < 16; o <<= 1) { sum += __shfl_xor(sum, o, 64); bon += __shfl_xor(bon, o, 64); }
                const float mean = sum * (1.f / 64.f);
                float var = 0.f;
#pragma unroll
                for (int j = 0; j < 4; ++j) { const float d = y[j] - mean; var += d * d; }
#pragma unroll
                for (int o = 1; o < 16; o <<= 1) var += __shfl_xor(var, o, 64);
                const float rs = rsqrtf(var * (1.f / 64.f) + 64e-5f);
#pragma unroll
                for (int j = 0; j < 4; ++j) {
                    const int c = h * 64 + 16 * j + fr;
                    const float yn = (y[j] - mean) * rs * P.in[33][l * 512 + c] + P.in[34][l * 512 + c];
                    MIX[row * DM + 512 + c] = f2bf((yn + bon * vv[j]) * g[j][r]);
                }
            }
        }
    }
}

__device__ __forceinline__ void run_phase(const Params& P, int ph, unsigned char* smem) {
#ifndef ONLY
    if (ph == 0) { phase_prep(P, smem); return; }
    if (ph == 1) { phase_mkh(P); return; }
#else
    if (ph < 2) return;
#endif
    const int l = (ph - 2) / PPL, s = (ph - 2) % PPL;
#ifdef ONLY
    if (s != ONLY) return;
#endif
    switch (s) {
    case 0: gemm2_bf16((const bf16_t*)(P.ws + OFF_H), DM, (const bf16_t*)(P.ws + OFF_WIN) + (size_t)l * PIN * DM, DM, MROWS, PIN, DM, false, EpiInproj{(bf16_t*)(P.ws + OFF_P), (const float*)(P.ws + OFF_LBT) + l * 512}, smem); break;
    case 1: phase_rwprep2(P, l, smem); s5_passA(P, l); hgrn_pass<false>(P, l, smem); break;
    case 2: rwkv_passA(P, l, smem, blockIdx.x, gridDim.x); s5_carry(P, l, gridDim.x - 1 - blockIdx.x, gridDim.x); hgrn_carry(P, (int)((2 * gridDim.x - 33 - blockIdx.x) % gridDim.x), gridDim.x); break;
    case 3: rwkv_passB(P); s5_passC(P, l); hgrn_pass<true>(P, l, smem); break;
    case 4: rwkv_passC<false>(P, l, smem); break;
    case 5: phase_post2(P, l); break;
    case 6: gemm2_bf16((const bf16_t*)(P.ws + OFF_MIX), DM, (const bf16_t*)(P.ws + OFF_WOUT) + (size_t)l * DM * DM, DM, MROWS, DM, DM, l == 1, EpiF32{(float*)(P.ws + OFF_TMP), DM}, smem); break;
    case 7: phase_ln1(P, l); break;
    case 8: gemm2_bf16((const bf16_t*)(P.ws + OFF_H2), DM, (const bf16_t*)(P.ws + OFF_WQ) + (size_t)l * 2048 * DM, DM, MROWS, 2048, DM, l == 1, EpiBf16{(bf16_t*)(P.ws + OFF_Q), 2048}, smem); break;
    case 9: phase_topk2(P, l, smem); phase_tabconv8(P, l); break;
    case 10: phase_gather8(P, l, smem); break;
    }
}

__global__ void __launch_bounds__(256, 2) mega(Params P) {
    __shared__ __attribute__((aligned(16))) unsigned char smem[65536];
#if SINGLE
    cg::grid_group grid = cg::this_grid();
    if (threadIdx.x < 4) ((volatile LAS unsigned*)(smem + 65520))[threadIdx.x] = 0u;
    __syncthreads();
    XcdBarrier xb = xcd_barrier_post((unsigned*)(P.ws + OFF_BAR), (volatile LAS unsigned*)(smem + 65520));
#endif
    for (int ph = P.ph_lo; ph < P.ph_hi; ++ph) {
        run_phase(P, ph, smem);
#if SINGLE
        if (ph + 1 < P.ph_hi) {
            if (ph == 0) { asm volatile("s_waitcnt vmcnt(0)" ::: "memory"); __syncthreads(); grid.sync(); }
            else xcd_barrier(xb);
        }
#ifdef DUPMASK
        if (ph >= 2 && ((DUPMASK >> ((ph - 2) % PPL)) & 1)) { run_phase(P, ph, smem); xcd_barrier(xb); }
#endif
#ifdef PROBE_A
        if (ph >= 2 && (ph - 2) % PPL == 2) { rwkv_passA(P, (ph - 2) / PPL, smem, blockIdx.x, gridDim.x); xcd_barrier(xb); }
#endif
#ifdef PROBE_B
        if (ph >= 2 && (ph - 2) % PPL == 3) { s5_passC(P, (ph - 2) / PPL); hgrn_pass<true>(P, (ph - 2) / PPL, smem); xcd_barrier(xb); }
#endif
#ifdef PROBE_P
        if (ph == 0) { phase_prep(P, smem); xcd_barrier(xb); }
#endif
#ifdef DUP1MASK
        if (ph >= 2 + PPL && ((DUP1MASK >> ((ph - 2) % PPL)) & 1)) { run_phase(P, ph, smem); xcd_barrier(xb); }
#endif
#ifdef EXP_T3
        if (ph >= 2 && (ph - 2) % PPL == 4) { rwkv_passC<true>(P, (ph - 2) / PPL, smem); xcd_barrier(xb); }
#endif
#ifdef EXP_OLDSCAN
        if (ph >= 2 && (ph - 2) % PPL == 4) { const int wv = threadIdx.x >> 6; for (int it = wv * gridDim.x + blockIdx.x; it < 64; it += 4 * gridDim.x) scan_rwkv(P, (ph - 2) / PPL, it); xcd_barrier(xb); }
#endif
#endif
    }
}

extern "C" void kernel_launch(void* const* d_in, const int* in_sizes, int n_in, void* d_out, int out_size, void* d_ws, size_t ws_size, hipStream_t stream) {
    static int grid = 0;
    if (grid == 0) {
        if (n_in != 39 || ws_size < OFF_END) { fprintf(stderr, "kernel_launch: unexpected n_in %d or ws_size %zu (need %zu)\n", n_in, ws_size, (size_t)OFF_END); grid = -1; return; }
        int dev = 0, cus = 0, per_cu = 0;
        hipGetDevice(&dev);
        hipDeviceGetAttribute(&cus, hipDeviceAttributeMultiprocessorCount, dev);
        hipOccupancyMaxActiveBlocksPerMultiprocessor(&per_cu, mega, 256, 0);
        if (per_cu < 1) per_cu = 1;
        if (per_cu > 2) per_cu = 2;
        grid = cus * per_cu;
    }
    if (grid < 0) return;
    hipMemsetAsync((unsigned char*)d_ws + OFF_BAR, 0, 16384, stream);
    Params p{};
    for (int i = 0; i < 39; ++i) p.in[i] = (const float*)d_in[i];
    p.out = (float*)d_out; p.ws = (unsigned char*)d_ws;
#if SINGLE
    p.ph_lo = 0; p.ph_hi = NPH;
    void* args[] = {&p};
    hipError_t e = hipLaunchCooperativeKernel((void*)mega, dim3(grid), dim3(256), args, 0, stream);
    if (e != hipSuccess) fprintf(stderr, "cooperative launch failed: %s (grid %d)\n", hipGetErrorString(e), grid);
#else
    for (int ph = 0; ph < NPH; ++ph) {
        p.ph_lo = ph; p.ph_hi = ph + 1;
        hipLaunchKernelGGL(mega, dim3(grid), dim3(256), 0, stream, p);
    }
#endif
}
```

```cpp
#include <hip/hip_runtime.h>
#include <hip/hip_cooperative_groups.h>
#include <cstdio>
namespace cg = cooperative_groups;

#ifndef SINGLE
#define SINGLE 1
#endif

typedef unsigned short bf16_t;
typedef short bf16x8 __attribute__((ext_vector_type(8)));
typedef float f32x4 __attribute__((ext_vector_type(4)));
typedef __bf16 bf16x2 __attribute__((ext_vector_type(2)));

#define DM 1024
#define NB 4
#define SEQ 4096
#define CTX 256
#define LTOT 4352
#define MROWS 17408
#define PIN 3456
#define RWW 4224
#define NPH 24
#define PPL 11
#define ALPHA 1.41421356237f

#define OFF_XS 0ull
#define OFF_P (OFF_XS + (size_t)MROWS * DM * 4)
#define OFF_RW (OFF_P + (size_t)MROWS * PIN * 2)
#define OFF_YP (OFF_RW + (size_t)MROWS * RWW * 2)
#define OFF_MIX (OFF_YP + (size_t)2 * MROWS * DM * 2)
#define OFF_MOD (OFF_MIX + (size_t)MROWS * DM * 2)
#define OFF_WIN (OFF_MOD + (size_t)2 * 5 * 6144 * 4)
#define OFF_WOUT (OFF_WIN + (size_t)2 * PIN * DM * 2)
#define OFF_WQ (OFF_WOUT + (size_t)2 * DM * DM * 2)
#define OFF_S5MS (OFF_WQ + (size_t)2 * 2048 * DM * 2)
#define OFF_S5MY (OFF_S5MS + (size_t)2 * 16 * 256 * 256 * 2)
#define OFF_S5LB (OFF_S5MY + (size_t)2 * 16 * 256 * 512 * 2)
#define OFF_S5ST (OFF_S5LB + (size_t)2 * 16 * 2 * 128 * 4)
#define OFF_BAR (OFF_S5ST + (size_t)4 * 16 * 272 * 256 * 4)
#define OFF_KEYB (OFF_BAR + 16384)
#define OFF_LW (OFF_KEYB + (size_t)2 * 8 * 2 * 128 * 128 * 2)
#define OFF_LBT (OFF_LW + (size_t)4 * 131072 * 2)
#define OFF_END (OFF_LBT + 4096)
#define OFF_RXL OFF_MIX
#define OFF_TMP OFF_P
#define OFF_H OFF_YP
#define OFF_H2 (OFF_YP + (size_t)MROWS * DM * 2)
#define OFF_Q OFF_RW
#define OFF_IDX (OFF_RW + (size_t)MROWS * 2048 * 2)
#define OFF_GATE (OFF_IDX + (size_t)MROWS * 128 * 4)
#define OFF_TBU OFF_P
#define OFF_TBV (OFF_P + (size_t)16384 * 1024 * 2)

struct Params {
    const float* in[39];
    float* out;
    unsigned char* ws;
    int ph_lo, ph_hi;
};

__device__ __forceinline__ bf16_t f2bf(float f) {
    unsigned u = __float_as_uint(f);
    u += 0x7FFFu + ((u >> 16) & 1u);
    return (bf16_t)(u >> 16);
}
__device__ __forceinline__ float bf2f(bf16_t h) { return __uint_as_float(((unsigned)h) << 16); }
__device__ __forceinline__ float sigmoidf_(float x) { return 1.f / (1.f + __expf(-x)); }
__device__ __forceinline__ float siluf_(float x) { return x * sigmoidf_(x); }
__device__ __forceinline__ float gelu_tanh(float x) {
    const float u = 0.7978845608028654f * (x + 0.044715f * x * x * x);
    return 0.5f * x * (1.f + tanhf(u));
}
__device__ __forceinline__ float wave_sum(float v) {
#pragma unroll
    for (int o = 32; o > 0; o >>= 1) v += __shfl_xor(v, o, 64);
    return v;
}
typedef short bf16x4 __attribute__((ext_vector_type(4)));
#define RW_NCH 34
#define RW_BUF 13824
#define RW_VT0 27648
__device__ __forceinline__ f32x4 mfma32(bf16x8 a, bf16x8 b, f32x4 c) { return __builtin_amdgcn_mfma_f32_16x16x32_bf16(a, b, c, 0, 0, 0); }
__device__ __forceinline__ f32x4 mfma16(bf16x4 a, bf16x4 b, f32x4 c) {
    bf16x8 a8, b8;
    a8[0] = a[0]; a8[1] = a[1]; a8[2] = a[2]; a8[3] = a[3]; a8[4] = 0; a8[5] = 0; a8[6] = 0; a8[7] = 0;
    b8[0] = b[0]; b8[1] = b[1]; b8[2] = b[2]; b8[3] = b[3]; b8[4] = 0; b8[5] = 0; b8[6] = 0; b8[7] = 0;
    return __builtin_amdgcn_mfma_f32_16x16x32_bf16(a8, b8, c, 0, 0, 0);
}
__device__ __forceinline__ bf16x4 to4(f32x4 v) { bf16x4 o; o[0] = (short)f2bf(v[0]); o[1] = (short)f2bf(v[1]); o[2] = (short)f2bf(v[2]); o[3] = (short)f2bf(v[3]); return o; }
__device__ __forceinline__ bf16x8 cat8(bf16x4 a, bf16x4 b) { bf16x8 o; o[0] = a[0]; o[1] = a[1]; o[2] = a[2]; o[3] = a[3]; o[4] = b[0]; o[5] = b[1]; o[6] = b[2]; o[7] = b[3]; return o; }

__device__ __forceinline__ int otid() { int t = threadIdx.x; asm volatile("" : "+v"(t)); return t; }
__device__ __forceinline__ float rdlane(float v, int l) { return __int_as_float(__builtin_amdgcn_readlane(__float_as_int(v), l)); }
__device__ __forceinline__ int row_of(int b, int dir, int tau) {
    const int p = dir == 0 ? tau : (tau < CTX ? (CTX - 1 - tau) : (LTOT + CTX - 1 - tau));
    return b * LTOT + p;
}
__device__ __forceinline__ int modrow(int row) { const int p = row % LTOT; return p < CTX ? 4 : row / LTOT; }

__device__ __forceinline__ void s5_prep_unit(const Params& P, int l, int g, unsigned char* smem);

#define XB_TMO      128
#define XB_XCNT(j)  (256  + 64 * (j))
#define XB_XSUB(j)  (1280 + 64 * (j))
#define XB_XGEN(j)  (2304 + 64 * (j))
#define XB_TOP      3328
#define XB_TOPGEN   3392
#define XCD_BAR_WORDS 3456
#define XB_SPIN_CAP (1u << 22)
#define LAS __attribute__((address_space(3)))
__device__ __forceinline__ unsigned xb_ld(unsigned* p)              { return __hip_atomic_load(p, __ATOMIC_RELAXED, __HIP_MEMORY_SCOPE_AGENT); }
__device__ __forceinline__ unsigned xb_add(unsigned* p, unsigned v) { return __hip_atomic_fetch_add(p, v, __ATOMIC_RELAXED, __HIP_MEMORY_SCOPE_AGENT); }
__device__ __forceinline__ unsigned xb_xcc_id() { return (unsigned)__builtin_amdgcn_s_getreg((3 << 11) | 20) & 0xFu; }
#define XB_SPIN(cond, bar) do { unsigned _sp = 0; while (cond) { __builtin_amdgcn_s_sleep(1); \
    if ((++_sp & 255u) == 0u) { if (xb_ld(&(bar)[XB_TMO])) break; if (_sp > XB_SPIN_CAP) { atomicAdd(&(bar)[XB_TMO], 1u); break; } } } } while (0)
struct XcdBarrier { unsigned* bar; unsigned x; volatile LAS unsigned* st; };
__device__ __forceinline__ XcdBarrier xcd_barrier_post(unsigned* bar, volatile LAS unsigned* st) {
    XcdBarrier b; b.bar = bar; b.x = xb_xcc_id(); b.st = st;
    if (threadIdx.x == 0) (void)xb_add(&bar[XB_XCNT(b.x)], 1u);
    return b;
}
__device__ __forceinline__ void xcd_barrier_complete(unsigned* bar, unsigned x, unsigned& nloc, unsigned& nx) {
    const unsigned G = gridDim.x * gridDim.y * gridDim.z;
    unsigned sum, cnt, mine, sp = 0u;
    for (;;) {
        sum = 0u; cnt = 0u; mine = 0u;
#pragma unroll
        for (unsigned j = 0; j < 16; ++j) { const unsigned c = xb_ld(&bar[XB_XCNT(j)]); sum += c; cnt += (c > 0u) ? 1u : 0u; mine = (j == x) ? c : mine; }
        if (sum == G) break;
        __builtin_amdgcn_s_sleep(1);
        if ((++sp & 255u) == 0u) { if (xb_ld(&bar[XB_TMO])) break; if (sp > XB_SPIN_CAP) { atomicAdd(&bar[XB_TMO], 1u); break; } }
    }
    nloc = mine > 0u ? mine : 1u; nx = cnt > 0u ? cnt : 1u;
}
__device__ __forceinline__ void xcd_barrier(const XcdBarrier& b) {
    asm volatile("s_waitcnt vmcnt(0)" ::: "memory");
    __syncthreads();
    if (threadIdx.x == 0) {
        unsigned* bar = b.bar;
        __builtin_amdgcn_s_waitcnt(0);
        unsigned nloc = b.st[0], nx = b.st[1];
        if (nloc == 0u) { xcd_barrier_complete(bar, b.x, nloc, nx); b.st[0] = nloc; b.st[1] = nx; }
        const unsigned old = xb_add(&bar[XB_XSUB(b.x)], 1u);
        const unsigned gen = old / nloc;
        if (old + 1u == (gen + 1u) * nloc) {
            __builtin_amdgcn_fence(__ATOMIC_RELEASE, "agent");
            asm volatile("s_waitcnt vmcnt(0)" ::: "memory");
            const unsigned og = xb_add(&bar[XB_TOP], 1u);
            const unsigned tg = og / nx;
            if (og + 1u == (tg + 1u) * nx) xb_add(&bar[XB_TOPGEN], 1u);
            else XB_SPIN(xb_ld(&bar[XB_TOPGEN]) == tg, bar);
            __builtin_amdgcn_fence(__ATOMIC_ACQUIRE, "agent");
            xb_add(&bar[XB_XGEN(b.x)], 1u);
            asm volatile("s_waitcnt vmcnt(0)" ::: "memory");
        } else {
            XB_SPIN(xb_ld(&bar[XB_XGEN(b.x)]) == gen, bar);
            __builtin_amdgcn_fence(__ATOMIC_ACQUIRE, "agent");
            asm volatile("s_waitcnt vmcnt(0)" ::: "memory");
        }
    }
    __syncthreads();
}

__device__ __forceinline__ void phase_prep(const Params& P, unsigned char* smem) {
    const int tid = otid(), lane = tid & 63, wave = __builtin_amdgcn_readfirstlane(tid >> 6);
    float* MOD = (float*)(P.ws + OFF_MOD);
    float* XS = (float*)(P.ws + OFF_XS);
    const int U_MOD = 192, U_COPY = MROWS / 16, U_TIN = 2 * 16 * 54, U_TOUT = 2 * 16 * 16, U_TQ = 2 * 16 * 32;
    const int U_S5 = 32, U_KEY = 64 + 64;
    const int total = U_S5 + U_KEY + U_MOD + U_COPY + U_TIN + U_TOUT + U_TQ;
    for (int u0 = blockIdx.x; u0 < total; u0 += gridDim.x) {
        __syncthreads();
        if (u0 < U_S5) {
            if (u0 == 0) {
                float* LBT = (float*)(P.ws + OFF_LBT);
                for (int i = tid; i < 1024; i += 256) {
                    const int ll = i >> 9, dir = (i >> 8) & 1, ch = i & 255;
                    float lbv = 0.f;
                    if (ll == 1) { const float a0 = P.in[22][(dir * 2 + 0) * 256 + ch], a1 = P.in[22][(dir * 2 + 1) * 256 + ch]; const float m = fmaxf(a0, a1), e0 = __expf(a0 - m), e1 = __expf(a1 - m); lbv = e1 / (e0 + e1); }
                    LBT[i] = lbv;
                }
            }
            s5_prep_unit(P, u0 >> 4, u0 & 15, smem); continue;
        }
        if (u0 < U_S5 + 64) {
            bf16_t* KB = (bf16_t*)(P.ws + OFF_KEYB);
            const size_t base = (size_t)(u0 - U_S5) * 8192;
            for (int i = tid; i < 8192; i += 256) KB[base + i] = f2bf(P.in[36][base + i]);
            continue;
        }
        if (u0 < U_S5 + U_KEY) {
            bf16_t* LW = (bf16_t*)(P.ws + OFF_LW);
            const int base = (u0 - U_S5 - 64) * 8192;
            for (int i = tid; i < 8192; i += 256) {
                const int o = base + i, which = o >> 17, e = o & 131071;
                float v;
                if (which < 2) { const int j = e & 63, c = (e >> 6) & 511, ld = e >> 15; v = P.in[which == 0 ? 26 : 28][((size_t)ld * 64 + j) * 512 + c]; }
                else if (which == 2) { const int j = e & 127, c = (e >> 7) & 511, ll = e >> 16; v = P.in[29][((size_t)ll * 128 + j) * 512 + c]; }
                else { const int k = e & 255, n = (e >> 8) & 255, ll = e >> 16; v = P.in[20][((size_t)ll * 256 + k) * 256 + n]; }
                LW[o] = f2bf(v);
            }
            continue;
        }
        const int u = u0 - U_S5 - U_KEY;
        if (u < U_MOD) {
            const int l = u / 96, j0 = (u % 96) * 64;
            float* sl = (float*)smem;
            for (int i = tid; i < 5 * 1024; i += 256) {
                const int r = i >> 10, k = i & 1023;
                const float cv = r < 4 ? P.in[1][r * 1024 + k] : P.in[3][k];
                sl[i] = siluf_(cv);
            }
            __syncthreads();
            float acc[5] = {0.f, 0.f, 0.f, 0.f, 0.f};
            const float* W = P.in[4] + (size_t)l * 1024 * 6144 + j0 + lane;
            for (int k = wave * 256; k < wave * 256 + 256; ++k) {
                const float w = W[(size_t)k * 6144];
#pragma unroll
                for (int r = 0; r < 5; ++r) acc[r] += sl[r * 1024 + k] * w;
            }
            float* red = (float*)(smem + 5 * 1024 * 4);
#pragma unroll
            for (int r = 0; r < 5; ++r) red[(wave * 5 + r) * 64 + lane] = acc[r];
            __syncthreads();
            for (int i = tid; i < 5 * 64; i += 256) {
                const int r = i / 64, jj = i % 64;
                float s = P.in[5][l * 6144 + j0 + jj];
                for (int w = 0; w < 4; ++w) s += red[(w * 5 + r) * 64 + jj];
                MOD[(l * 5 + r) * 6144 + j0 + jj] = s;
            }
        } else if (u < U_MOD + U_COPY) {
            const int r0 = (u - U_MOD) * 16;
            for (int i = tid; i < 16 * 256; i += 256) {
                const int row = r0 + (i >> 8), c4 = i & 255;
                const int b = row / LTOT, p = row % LTOT;
                const float4* src = p < CTX ? (const float4*)(P.in[2] + ((size_t)b * CTX + p) * DM) : (const float4*)(P.in[0] + ((size_t)b * SEQ + (p - CTX)) * DM);
                ((float4*)(XS + (size_t)row * DM))[c4] = src[c4];
            }
        } else {
            int v = u - U_MOD - U_COPY;
            const float* W; bf16_t* Wt; int N;
            if (v < U_TIN) { const int l = v / (16 * 54); v %= 16 * 54; N = PIN; W = P.in[6] + (size_t)l * 1024 * PIN; Wt = (bf16_t*)(P.ws + OFF_WIN) + (size_t)l * PIN * 1024; }
            else if (v < U_TIN + U_TOUT) { v -= U_TIN; const int l = v / 256; v %= 256; N = 1024; W = P.in[7] + (size_t)l * 1024 * 1024; Wt = (bf16_t*)(P.ws + OFF_WOUT) + (size_t)l * 1024 * 1024; }
            else { v -= U_TIN + U_TOUT; const int l = v / 512; v %= 512; N = 2048; W = P.in[35] + (size_t)l * 1024 * 2048; Wt = (bf16_t*)(P.ws + OFF_WQ) + (size_t)l * 2048 * 1024; }
            const int ntn = N / 64, kt = v / ntn, nt = v % ntn;
            float* t = (float*)smem;
            for (int i = tid; i < 64 * 64; i += 256) { const int kk = i >> 6, nn = i & 63; t[kk * 65 + nn] = W[(size_t)(kt * 64 + kk) * N + nt * 64 + nn]; }
            __syncthreads();
            for (int i = tid; i < 64 * 64; i += 256) { const int nn = i >> 6, kk = i & 63; Wt[(size_t)(nt * 64 + nn) * 1024 + kt * 64 + kk] = f2bf(t[kk * 65 + nn]); }
        }
    }
}

__device__ __forceinline__ void phase_mkh(const Params& P) {
    const int lane = otid() & 63, wave = __builtin_amdgcn_readfirstlane(otid() >> 6);
    const float* XS = (const float*)(P.ws + OFF_XS);
    const float* MOD = (const float*)(P.ws + OFF_MOD);
    bf16_t* H = (bf16_t*)(P.ws + OFF_H);
    for (int row = blockIdx.x * 4 + wave; row < MROWS; row += gridDim.x * 4) {
        const float* mod = MOD + (size_t)(0 * 5 + modrow(row)) * 6144;
#pragma unroll
        for (int j = 0; j < 4; ++j) {
            const int d = 256 * j + 4 * lane;
            const float4 x = *(const float4*)(XS + (size_t)row * DM + d);
            const float4 sh = *(const float4*)(mod + d), sc = *(const float4*)(mod + 1024 + d);
            ushort4 o;
            o.x = f2bf(x.x * (1.f + sc.x) + sh.x); o.y = f2bf(x.y * (1.f + sc.y) + sh.y);
            o.z = f2bf(x.z * (1.f + sc.z) + sh.z); o.w = f2bf(x.w * (1.f + sc.w) + sh.w);
            *(ushort4*)(H + (size_t)row * DM + d) = o;
        }
    }
}

template <class EPI>
__device__ __forceinline__ void gemm_bf16(const bf16_t* A, int lda, const bf16_t* Bt, int ldb, int M, int N, int K, bool skipctx, EPI epi) {
    const int lane = otid() & 63, wave = __builtin_amdgcn_readfirstlane(otid() >> 6);
    const int ntm = M / 128, ntn = N / 128;
    const int fr = lane & 15, fq = lane >> 4;
    for (int tile = blockIdx.x; tile < ntm * ntn; tile += gridDim.x) {
        const int tm = tile / ntn, tn = tile % ntn;
        const int m0 = tm * 128 + (wave >> 1) * 64, n0 = tn * 128 + (wave & 1) * 64;
        if (skipctx && (m0 % LTOT) < CTX) continue;
        f32x4 acc[4][4];
#pragma unroll
        for (int i = 0; i < 4; ++i)
#pragma unroll
            for (int j = 0; j < 4; ++j) acc[i][j] = (f32x4){0.f, 0.f, 0.f, 0.f};
        const bf16_t* ap = A + (size_t)(m0 + fr) * lda + 8 * fq;
        const bf16_t* bp = Bt + (size_t)(n0 + fr) * ldb + 8 * fq;
        for (int k0 = 0; k0 < K; k0 += 32) {
            bf16x8 a[4], b[4];
#pragma unroll
            for (int i = 0; i < 4; ++i) a[i] = *(const bf16x8*)(ap + (size_t)(16 * i) * lda + k0);
#pragma unroll
            for (int j = 0; j < 4; ++j) b[j] = *(const bf16x8*)(bp + (size_t)(16 * j) * ldb + k0);
#pragma unroll
            for (int i = 0; i < 4; ++i)
#pragma unroll
                for (int j = 0; j < 4; ++j) acc[i][j] = __builtin_amdgcn_mfma_f32_16x16x32_bf16(a[i], b[j], acc[i][j], 0, 0, 0);
        }
#pragma unroll
        for (int i = 0; i < 4; ++i)
#pragma unroll
            for (int j = 0; j < 4; ++j)
#pragma unroll
                for (int r = 0; r < 4; ++r) epi(m0 + 16 * i + 4 * fq + r, n0 + 16 * j + fr, acc[i][j][r]);
    }
}

typedef float f32x16 __attribute__((ext_vector_type(16)));
typedef unsigned u32x4 __attribute__((ext_vector_type(4)));
#define G2_LD 72
template <class EPI>
__device__ __forceinline__ void gemm2_bf16(const bf16_t* A, int lda, const bf16_t* Bt, int ldb, int M, int N, int K, bool skipctx, EPI epi, unsigned char* smem) {
    const int tid = otid(), lane = tid & 63, wave = __builtin_amdgcn_readfirstlane(tid >> 6);
    const int ntm = M / 128, ntn = N / 128;
    bf16_t* As = (bf16_t*)smem;
    bf16_t* Bs = As + 128 * G2_LD;
    const int lr = tid >> 3, lc = (tid & 7) * 8;
    const int wm = (wave >> 1) * 64, wn = (wave & 1) * 64;
    const int fr = lane & 31, fh = lane >> 5;
    for (int tile = blockIdx.x; tile < ntm * ntn; tile += gridDim.x) {
        const int tm = tile / ntn, tn = tile % ntn;
        if (skipctx && ((tm * 128) % LTOT) < CTX) continue;
        const bf16_t* ag = A + (size_t)(tm * 128 + lr) * lda + lc;
        const bf16_t* bg = Bt + (size_t)(tn * 128 + lr) * ldb + lc;
        f32x16 acc[2][2];
        {
            const f32x16 z16 = {0.f, 0.f, 0.f, 0.f, 0.f, 0.f, 0.f, 0.f, 0.f, 0.f, 0.f, 0.f, 0.f, 0.f, 0.f, 0.f};
            acc[0][0] = z16; acc[0][1] = z16; acc[1][0] = z16; acc[1][1] = z16;
        }
        u32x4 ra0[4], rb0[4], ra1[4], rb1[4];
#define G2_LOAD(RA, RB, kk_) { const int kq = (kk_) < K ? (kk_) : 0; _Pragma("unroll") for (int i = 0; i < 4; ++i) { RA[i] = *(const u32x4*)(ag + (size_t)(32 * i) * lda + kq); RB[i] = *(const u32x4*)(bg + (size_t)(32 * i) * ldb + kq); } }
#define G2_STORE(RA, RB) { _Pragma("unroll") for (int i = 0; i < 4; ++i) { *(u32x4*)(As + (lr + 32 * i) * G2_LD + lc) = RA[i]; *(u32x4*)(Bs + (lr + 32 * i) * G2_LD + lc) = RB[i]; } }
#define G2_COMPUTE() { _Pragma("unroll") for (int kk = 0; kk < 4; ++kk) { bf16x8 a[2], b[2]; \
            _Pragma("unroll") for (int i = 0; i < 2; ++i) a[i] = *(const bf16x8*)(As + (wm + 32 * i + fr) * G2_LD + 16 * kk + 8 * fh); \
            _Pragma("unroll") for (int j = 0; j < 2; ++j) b[j] = *(const bf16x8*)(Bs + (wn + 32 * j + fr) * G2_LD + 16 * kk + 8 * fh); \
            _Pragma("unroll") for (int i = 0; i < 2; ++i) _Pragma("unroll") for (int j = 0; j < 2; ++j) acc[i][j] = __builtin_amdgcn_mfma_f32_32x32x16_bf16(a[i], b[j], acc[i][j], 0, 0, 0); } }
        G2_LOAD(ra0, rb0, 0)
        G2_LOAD(ra1, rb1, 64)
        __syncthreads();
        G2_STORE(ra0, rb0)
        __syncthreads();
        G2_LOAD(ra0, rb0, 128)
        for (int k0 = 0; k0 < K; k0 += 128) {
            G2_COMPUTE()
            __syncthreads();
            G2_STORE(ra1, rb1)
            __syncthreads();
            G2_LOAD(ra1, rb1, k0 + 192)
            G2_COMPUTE()
            if (k0 + 128 < K) {
                __syncthreads();
                G2_STORE(ra0, rb0)
                __syncthreads();
                G2_LOAD(ra0, rb0, k0 + 256)
            }
        }
#undef G2_LOAD
#undef G2_STORE
#undef G2_COMPUTE
#pragma unroll
        for (int i = 0; i < 2; ++i)
#pragma unroll
            for (int j = 0; j < 2; ++j)
#pragma unroll
                for (int q = 0; q < 16; ++q) epi(tm * 128 + wm + 32 * i + (q & 3) + 8 * (q >> 2) + 4 * fh, tn * 128 + wn + 32 * j + fr, acc[i][j][q]);
    }
}

template <class EPI>
__device__ __forceinline__ void gemm3_bf16(const bf16_t* A, int lda, const bf16_t* Bt, int ldb, int M, int N, int K, bool skipctx, EPI epi, unsigned char* smem, int TMS, int TNS) {
    const int tid = otid(), lane = tid & 63, wave = __builtin_amdgcn_readfirstlane(tid >> 6);
    const int ntm = M / 128, ntn = N / 128, nkt = K / 64;
    const int wm = (wave >> 1) * 64, wn = (wave & 1) * 64;
    const int fr = lane & 31, fh = lane >> 5;
    const int rr = lane >> 3, cc = lane & 7;
    const int gcol = (cc ^ rr) * 8;
    const int nSm = (ntm + TMS - 1) / TMS, nSn = (ntn + TNS - 1) / TNS, S = TMS * TNS;
    const int xg = blockIdx.x & 7, lb = blockIdx.x >> 3, nlb = gridDim.x >> 3;
    for (int st = xg; st < nSm * nSn; st += 8)
    for (int t = lb; t < S; t += nlb) {
        const int tm = (st / nSn) * TMS + t % TMS, tn = (st % nSn) * TNS + t / TMS;
        if (tm >= ntm || tn >= ntn) continue;
        if (skipctx && ((tm * 128) % LTOT) < CTX) continue;
        const bf16_t* ag = A + (size_t)(tm * 128 + 32 * wave + rr) * lda + gcol;
        const bf16_t* bg = Bt + (size_t)(tn * 128 + 32 * wave + rr) * ldb + gcol;
        f32x16 acc[2][2];
        {
            const f32x16 z16 = {0.f, 0.f, 0.f, 0.f, 0.f, 0.f, 0.f, 0.f, 0.f, 0.f, 0.f, 0.f, 0.f, 0.f, 0.f, 0.f};
            acc[0][0] = z16; acc[0][1] = z16; acc[1][0] = z16; acc[1][1] = z16;
        }
#define G3_ISSUE(kt_, b_) { unsigned char* la_ = smem + (b_) * 32768 + (32 * wave) * 128; unsigned char* lb_ = la_ + 16384; \
            _Pragma("unroll") for (int q = 0; q < 4; ++q) { \
                __builtin_amdgcn_global_load_lds((const unsigned*)(ag + (size_t)(8 * q) * lda + (kt_) * 64), (LAS unsigned*)(la_ + q * 1024), 16, 0, 0); \
                __builtin_amdgcn_global_load_lds((const unsigned*)(bg + (size_t)(8 * q) * ldb + (kt_) * 64), (LAS unsigned*)(lb_ + q * 1024), 16, 0, 0); } }
        __syncthreads();
        G3_ISSUE(0, 0)
        asm volatile("s_waitcnt vmcnt(0)" ::: "memory");
        __syncthreads();
        for (int kt = 0; kt < nkt; ++kt) {
            if (kt + 1 < nkt) G3_ISSUE(kt + 1, (kt + 1) & 1)
            const unsigned char* As = smem + (kt & 1) * 32768;
            const unsigned char* Bs = As + 16384;
#pragma unroll
            for (int kk = 0; kk < 4; ++kk) {
                bf16x8 a[2], b[2];
#pragma unroll
                for (int i = 0; i < 2; ++i) { const int r = wm + 32 * i + fr; a[i] = *(const bf16x8*)(As + r * 128 + (((2 * kk + fh) ^ (r & 7)) << 4)); }
#pragma unroll
                for (int j = 0; j < 2; ++j) { const int r = wn + 32 * j + fr; b[j] = *(const bf16x8*)(Bs + r * 128 + (((2 * kk + fh) ^ (r & 7)) << 4)); }
#pragma unroll
                for (int i = 0; i < 2; ++i)
#pragma unroll
                    for (int j = 0; j < 2; ++j) acc[i][j] = __builtin_amdgcn_mfma_f32_32x32x16_bf16(b[j], a[i], acc[i][j], 0, 0, 0);
            }
            asm volatile("s_waitcnt vmcnt(0)" ::: "memory");
            __syncthreads();
        }
#undef G3_ISSUE
#pragma unroll
        for (int i = 0; i < 2; ++i)
#pragma unroll
            for (int j = 0; j < 2; ++j)
#pragma unroll
                for (int g = 0; g < 4; ++g)
                    epi.store4(tm * 128 + wm + 32 * i + fr, tn * 128 + wn + 32 * j + 8 * g + 4 * fh, acc[i][j][4 * g], acc[i][j][4 * g + 1], acc[i][j][4 * g + 2], acc[i][j][4 * g + 3]);
    }
}
struct Epi4Bf16 { bf16_t* C; int ldc;
    __device__ __forceinline__ void store4(int r, int c, float v0, float v1, float v2, float v3) const {
        *(uint2*)(C + (size_t)r * ldc + c) = make_uint2(f2bf(v0) | ((unsigned)f2bf(v1) << 16), f2bf(v2) | ((unsigned)f2bf(v3) << 16)); } };
struct Epi4F32 { float* C; int ldc;
    __device__ __forceinline__ void store4(int r, int c, float v0, float v1, float v2, float v3) const { *(f32x4*)(C + (size_t)r * ldc + c) = (f32x4){v0, v1, v2, v3}; } };
struct Epi4Inproj { bf16_t* C; const float* lbt;
    __device__ __forceinline__ float tr(int c, float v) const {
        if (c >= 256 && c < 1536) {
            if (c < 512 || c >= 1280) v = siluf_(v);
            else if (c >= 768) { const float lb = lbt[c - 768]; v = __logf(lb + (1.f - lb) * sigmoidf_(v)); }
        }
        return v;
    }
    __device__ __forceinline__ void store4(int r, int c, float v0, float v1, float v2, float v3) const {
        v0 = tr(c, v0); v1 = tr(c + 1, v1); v2 = tr(c + 2, v2); v3 = tr(c + 3, v3);
        *(uint2*)(C + (size_t)r * PIN + c) = make_uint2(f2bf(v0) | ((unsigned)f2bf(v1) << 16), f2bf(v2) | ((unsigned)f2bf(v3) << 16)); } };
struct EpiInproj {
    bf16_t* C; const float* lbt;
    __device__ __forceinline__ void operator()(int r, int c, float v) const {
        if (c >= 256 && c < 1536) {
            if (c < 512 || c >= 1280) v = siluf_(v);
            else if (c >= 768) { const float lb = lbt[c - 768]; v = __logf(lb + (1.f - lb) * sigmoidf_(v)); }
        }
        C[(size_t)r * PIN + c] = f2bf(v);
    }
};
struct EpiBf16 { bf16_t* C; int ldc; __device__ __forceinline__ void operator()(int r, int c, float v) const { C[(size_t)r * ldc + c] = f2bf(v); } };
struct EpiF32 { float* C; int ldc; __device__ __forceinline__ void operator()(int r, int c, float v) const { C[(size_t)r * ldc + c] = v; } };

__device__ __forceinline__ void phase_rwprep(const Params& P, int l, unsigned char* smem) {
    const int tid = otid();
    const bf16_t* Pb = (const bf16_t*)(P.ws + OFF_P);
    bf16_t* RW = (bf16_t*)(P.ws + OFF_RW);
    const float* mu = P.in[24] + l * 1920;
    const float* k_k = P.in[30] + l * 512;
    float* tw = (float*)smem;
    float* al = tw + 2 * 8 * 64;
    float* kk2 = al + 2 * 8 * 64;
    float* nrm = kk2 + 8 * 512;
    for (int u = blockIdx.x; u < MROWS / 8; u += gridDim.x) {
        const int r0 = u * 8;
        __syncthreads();
        for (int i = 0; i < 8; ++i) {
            const int row = r0 + i, p = row % LTOT;
            int nb[4]; bool ok[4];
            if (p < CTX) {
                nb[0] = row - 1; ok[0] = p > 0; nb[1] = row + 1; ok[1] = p < CTX - 1; nb[2] = nb[0]; ok[2] = ok[0]; nb[3] = nb[1]; ok[3] = ok[1];
            } else {
                const int t = p - CTX, gr = t >> 6, gc = t & 63;
                nb[0] = row - 1; ok[0] = gc > 0; nb[1] = row + 1; ok[1] = gc < 63; nb[2] = row - 64; ok[2] = gr > 0; nb[3] = row + 64; ok[3] = gr < 63;
            }
            for (int c = tid; c < 1920; c += 256) {
                const int m = c & 3;
                const float pv = bf2f(Pb[(size_t)row * PIN + 1536 + c]);
                const float nv = ok[m] ? bf2f(Pb[(size_t)nb[m] * PIN + 1536 + c]) : 0.f;
                const float s = pv + mu[c] * (nv - pv);
                bf16_t* rw = RW + (size_t)row * RWW;
                if (c < 512) rw[c] = f2bf(s);
                else if (c < 1024) { rw[c] = f2bf(s); kk2[i * 512 + (c - 512)] = s * k_k[c - 512]; }
                else if (c < 1536) rw[c] = f2bf(s);
                else if (c < 1664) rw[4096 + (c - 1536)] = f2bf(sigmoidf_(s));
                else if (c < 1728) tw[(0 * 8 + i) * 64 + (c - 1664)] = tanhf(s);
                else if (c < 1792) tw[(1 * 8 + i) * 64 + (c - 1728)] = tanhf(s);
                else if (c < 1856) al[(0 * 8 + i) * 64 + (c - 1792)] = s;
                else al[(1 * 8 + i) * 64 + (c - 1856)] = s;
            }
        }
        __syncthreads();
        {
            const int pair = tid >> 2, q = tid & 3, i = pair >> 3, hd = pair & 7;
            float s = 0.f;
            for (int j = 0; j < 16; ++j) { const float v = kk2[i * 512 + hd * 64 + q * 16 + j]; s += v * v; }
            s += __shfl_xor(s, 1, 64); s += __shfl_xor(s, 2, 64);
            if (q == 0) nrm[pair] = fmaxf(sqrtf(s), 1e-12f);
        }
        __syncthreads();
        for (int e = tid; e < 8 * 512; e += 256) {
            const int i = e >> 9, c = e & 511;
            RW[(size_t)(r0 + i) * RWW + 1536 + c] = f2bf(kk2[e] / nrm[i * 8 + (c >> 6)]);
        }
        for (int d = 0; d < 2; ++d) {
            const float* wup = P.in[26] + (size_t)(l * 2 + d) * 64 * 512;
            const float* aup = P.in[28] + (size_t)(l * 2 + d) * 64 * 512;
            const float* w0 = P.in[25] + (l * 2 + d) * 512;
            const float* a0 = P.in[27] + (l * 2 + d) * 512;
            float zw[2][8], za[2][8];
#pragma unroll
            for (int i = 0; i < 8; ++i) { zw[0][i] = zw[1][i] = za[0][i] = za[1][i] = 0.f; }
            for (int j = 0; j < 64; ++j) {
                const float w_0 = wup[j * 512 + tid], w_1 = wup[j * 512 + tid + 256];
                const float a_0 = aup[j * 512 + tid], a_1 = aup[j * 512 + tid + 256];
#pragma unroll
                for (int i = 0; i < 8; ++i) {
                    const float t = tw[(d * 8 + i) * 64 + j], a = al[(d * 8 + i) * 64 + j];
                    zw[0][i] += t * w_0; zw[1][i] += t * w_1; za[0][i] += a * a_0; za[1][i] += a * a_1;
                }
            }
#pragma unroll
            for (int i = 0; i < 8; ++i) {
                bf16_t* rw = RW + (size_t)(r0 + i) * RWW;
#pragma unroll
                for (int h = 0; h < 2; ++h) {
                    const int c = tid + 256 * h;
                    rw[2048 + d * 512 + c] = f2bf(sigmoidf_(a0[c] + za[h][i]));
                    rw[3072 + d * 512 + c] = f2bf(-0.60653066f * sigmoidf_(w0[c] + zw[h][i]));
                }
            }
        }
    }
}

__device__ __forceinline__ void scan_rwkv(const Params& P, int l, int item) {
    const int lane = otid() & 63;
    const int dir = item & 1, hd = (item >> 1) & 7, b = item >> 4;
    const bf16_t* RW = (const bf16_t*)(P.ws + OFF_RW);
    bf16_t* YP = (bf16_t*)(P.ws + OFF_YP) + (size_t)dir * MROWS * DM;
    const float ka = P.in[31][l * 512 + hd * 64 + lane];
    float S[64];
#pragma unroll
    for (int k = 0; k < 64; ++k) S[k] = 0.f;
    for (int tau = 0; tau < LTOT; ++tau) {
        const int row = row_of(b, dir, tau);
#ifdef EXP_T2
        if ((tau & 127) == 0) {
            float* RXL = (float*)(P.ws + OFF_RXL);
            const size_t itm = (size_t)item * 34 + (tau >> 7);
#pragma unroll
            for (int kk = 0; kk < 64; ++kk) RXL[((itm * 16 + (kk >> 4) * 4 + (lane >> 4)) * 64 + ((kk >> 2) & 3) * 16 + (lane & 15)) * 4 + (kk & 3)] = S[kk];
        }
#endif
        const bf16_t* rw = RW + (size_t)row * RWW + hd * 64 + lane;
        const float r = bf2f(rw[0]), k = bf2f(rw[512]), v = bf2f(rw[1024]), kap = bf2f(rw[1536]);
        const float a = bf2f(rw[2048 + dir * 512]), lw = bf2f(rw[3072 + dir * 512]);
        const float w = __expf(lw), kt = k * (1.f + (a - 1.f) * ka), beta = kap * a;
        float sk = 0.f;
#pragma unroll
        for (int kk = 0; kk < 64; ++kk) { sk += S[kk] * rdlane(kap, kk); if ((kk & 7) == 7) __builtin_amdgcn_sched_barrier(0); }
        float y = 0.f;
#pragma unroll
        for (int kk = 0; kk < 64; ++kk) {
            const float s = S[kk] * rdlane(w, kk) - sk * rdlane(beta, kk) + v * rdlane(kt, kk);
            S[kk] = s;
            y += s * rdlane(r, kk);
            if ((kk & 3) == 3) __builtin_amdgcn_sched_barrier(0);
        }
        YP[(size_t)row * DM + 512 + hd * 64 + lane] = f2bf(y);
    }
}
__device__ __forceinline__ void scan_hgrn(const Params& P, int l, int item) {
    const int lane = otid() & 63;
    const int dir = item & 1, hd = (item >> 1) & 3, b = item >> 3;
    const bf16_t* Pb = (const bf16_t*)(P.ws + OFF_P);
    bf16_t* YP = (bf16_t*)(P.ws + OFF_YP) + (size_t)dir * MROWS * DM;
    float lb = 0.f;
    if (l == 1) {
        const float a0 = P.in[22][(dir * 2 + 0) * 256 + hd * 64 + lane], a1 = P.in[22][(dir * 2 + 1) * 256 + hd * 64 + lane];
        const float m = fmaxf(a0, a1), e0 = __expf(a0 - m), e1 = __expf(a1 - m);
        lb = e1 / (e0 + e1);
    }
    float S[64];
#pragma unroll
    for (int k = 0; k < 64; ++k) S[k] = 0.f;
    for (int tau = 0; tau < LTOT; ++tau) {
        const int row = row_of(b, dir, tau);
        const bf16_t* pr = Pb + (size_t)row * PIN + 256 + hd * 64 + lane;
        const float q = siluf_(bf2f(pr[0])), v = bf2f(pr[256]);
        const float f = lb + (1.f - lb) * sigmoidf_(bf2f(pr[512 + dir * 256]));
        const float kq = 1.f - f;
        float o = 0.f;
#pragma unroll
        for (int dk = 0; dk < 64; ++dk) {
            const float s = rdlane(f, dk) * S[dk] + rdlane(kq, dk) * v;
            S[dk] = s;
            o += s * rdlane(q, dk);
            if ((dk & 7) == 7) __builtin_amdgcn_sched_barrier(0);
        }
        YP[(size_t)row * DM + 256 + hd * 64 + lane] = f2bf(o);
    }
}
__device__ __forceinline__ void scan_s5(const Params& P, int l, int item) {
    const int lane = otid() & 63;
    const int dir = item & 1, g = (item >> 1) & 15, b = item >> 5;
    const bf16_t* Pb = (const bf16_t*)(P.ws + OFF_P);
    bf16_t* YP = (bf16_t*)(P.ws + OFF_YP) + (size_t)dir * MROWS * DM;
    const int ldg = (l * 2 + dir) * 16 + g;
    const float dt = expf(P.in[14][ldg]);
    const float lre = P.in[12][ldg * 64 + lane], lim = P.in[13][ldg * 64 + lane];
    const float mag = expf(lre * dt), ang = lim * dt;
    const float lb_re = mag * cosf(ang), lb_im = mag * sinf(ang);
    const float den = lre * lre + lim * lim, nr = lb_re - 1.f, ni = lb_im;
    const float co_re = (nr * lre + ni * lim) / den, co_im = (ni * lre - nr * lim) / den;
    float bb_re[16], bb_im[16], c_re[16], c_im[16];
#pragma unroll
    for (int h = 0; h < 16; ++h) {
        const float br = P.in[15][((size_t)ldg * 64 + lane) * 16 + h], bi = P.in[16][((size_t)ldg * 64 + lane) * 16 + h];
        bb_re[h] = co_re * br - co_im * bi; bb_im[h] = co_re * bi + co_im * br;
        c_re[h] = P.in[17][((size_t)ldg * 16 + h) * 64 + lane]; c_im[h] = P.in[18][((size_t)ldg * 16 + h) * 64 + lane];
    }
    float s_re = 0.f, s_im = 0.f;
    for (int tau = 0; tau < LTOT; ++tau) {
        const int row = row_of(b, dir, tau);
        const float uv = bf2f(Pb[(size_t)row * PIN + g * 16 + (lane & 15)]);
        float bu_re = 0.f, bu_im = 0.f;
#pragma unroll
        for (int h = 0; h < 16; ++h) { const float uh = rdlane(uv, h); bu_re += bb_re[h] * uh; bu_im += bb_im[h] * uh; }
        const float n_re = lb_re * s_re - lb_im * s_im + bu_re, n_im = lb_re * s_im + lb_im * s_re + bu_im;
        s_re = n_re; s_im = n_im;
        float yo = 0.f;
#pragma unroll
        for (int h = 0; h < 16; ++h) { const float t = wave_sum(c_re[h] * s_re - c_im[h] * s_im); yo = (lane == h) ? t : yo; }
        if (lane < 16) YP[(size_t)row * DM + g * 16 + lane] = f2bf(yo);
    }
}
__device__ __forceinline__ void phase_scans(const Params& P, int l) {
    const int wave = __builtin_amdgcn_readfirstlane(otid() >> 6);
    for (int it = wave * gridDim.x + blockIdx.x; it < 32; it += 4 * gridDim.x) scan_hgrn(P, l, it);
}

__device__ __forceinline__ void phase_post(const Params& P, int l, unsigned char* smem) {
    const int tid = otid();
    const bf16_t* Pb = (const bf16_t*)(P.ws + OFF_P);
    const bf16_t* RW = (const bf16_t*)(P.ws + OFF_RW);
    const bf16_t* YF = (const bf16_t*)(P.ws + OFF_YP);
    const bf16_t* YB = YF + (size_t)MROWS * DM;
    bf16_t* MIX = (bf16_t*)(P.ws + OFF_MIX);
    float* ypre = (float*)smem;
    float* sg = ypre + 8 * 256;
    for (int u = blockIdx.x; u < MROWS / 8; u += gridDim.x) {
        const int r0 = u * 8;
        if (l == 1 && (r0 % LTOT) < CTX) continue;
        __syncthreads();
        for (int i = 0; i < 8; ++i) {
            const int row = r0 + i;
            ypre[i * 256 + tid] = bf2f(YF[(size_t)row * DM + tid]);
        }
        for (int e = tid; e < 8 * 128; e += 256) sg[e] = bf2f(RW[(size_t)(r0 + (e >> 7)) * RWW + 4096 + (e & 127)]);
        __syncthreads();
        {
            float z[8];
            const float gb = P.in[21][l * 256 + tid];
#pragma unroll
            for (int i = 0; i < 8; ++i) z[i] = gb;
            const float* gw = P.in[20] + (size_t)l * 256 * 256 + tid;
            for (int k = 0; k < 256; ++k) {
                const float w = gw[k * 256];
#pragma unroll
                for (int i = 0; i < 8; ++i) z[i] += ypre[i * 256 + k] * w;
            }
#pragma unroll
            for (int i = 0; i < 8; ++i) MIX[(size_t)(r0 + i) * DM + tid] = f2bf(ypre[i * 256 + tid] * sigmoidf_(z[i]));
        }
        {
            const int i = tid >> 5, c0 = (tid & 31) * 8, row = r0 + i;
            float o[8], ss = 0.f;
#pragma unroll
            for (int j = 0; j < 8; ++j) { o[j] = bf2f(YF[(size_t)row * DM + 256 + c0 + j]) + bf2f(YB[(size_t)row * DM + 256 + c0 + j]); ss += o[j] * o[j]; }
            ss += __shfl_xor(ss, 1, 64); ss += __shfl_xor(ss, 2, 64); ss += __shfl_xor(ss, 4, 64);
            const float rs = rsqrtf(ss * (1.f / 64.f) + 1e-6f);
#pragma unroll
            for (int j = 0; j < 8; ++j) {
                const float gr = bf2f(Pb[(size_t)row * PIN + 256 + 1024 + c0 + j]);
                MIX[(size_t)row * DM + 256 + c0 + j] = f2bf(o[j] * rs * P.in[23][l * 256 + c0 + j] * siluf_(gr));
            }
        }
        {
            const int i = tid >> 5, c0 = (tid & 31) * 16, row = r0 + i;
            const bf16_t* rw = RW + (size_t)row * RWW;
            float y[16], vv[16], sum = 0.f, bon = 0.f;
#pragma unroll
            for (int j = 0; j < 16; ++j) {
                const int c = c0 + j;
                y[j] = bf2f(YF[(size_t)row * DM + 512 + c]) + bf2f(YB[(size_t)row * DM + 512 + c]);
                sum += y[j];
                const float r = bf2f(rw[c]), k = bf2f(rw[512 + c]), af = bf2f(rw[2048 + c]), ab = bf2f(rw[2560 + c]);
                const float ka = P.in[31][l * 512 + c];
                vv[j] = bf2f(rw[1024 + c]);
                bon += r * P.in[32][l * 512 + c] * (k * (1.f + (af - 1.f) * ka) + k * (1.f + (ab - 1.f) * ka));
            }
            sum += __shfl_xor(sum, 1, 64); sum += __shfl_xor(sum, 2, 64);
            bon += __shfl_xor(bon, 1, 64); bon += __shfl_xor(bon, 2, 64);
            const float mean = sum * (1.f / 64.f);
            float var = 0.f;
#pragma unroll
            for (int j = 0; j < 16; ++j) { const float d = y[j] - mean; var += d * d; }
            var += __shfl_xor(var, 1, 64); var += __shfl_xor(var, 2, 64);
            const float rs = rsqrtf(var * (1.f / 64.f) + 64e-5f);
            float g[16];
#pragma unroll
            for (int j = 0; j < 16; ++j) g[j] = 0.f;
            const float* gup = P.in[29] + (size_t)l * 128 * 512 + c0;
            for (int jj = 0; jj < 128; ++jj) {
                const float s = sg[i * 128 + jj];
                const float4 w0 = *(const float4*)(gup + jj * 512), w1 = *(const float4*)(gup + jj * 512 + 4), w2 = *(const float4*)(gup + jj * 512 + 8), w3 = *(const float4*)(gup + jj * 512 + 12);
                g[0] += s * w0.x; g[1] += s * w0.y; g[2] += s * w0.z; g[3] += s * w0.w;
                g[4] += s * w1.x; g[5] += s * w1.y; g[6] += s * w1.z; g[7] += s * w1.w;
                g[8] += s * w2.x; g[9] += s * w2.y; g[10] += s * w2.z; g[11] += s * w2.w;
                g[12] += s * w3.x; g[13] += s * w3.y; g[14] += s * w3.z; g[15] += s * w3.w;
            }
#pragma unroll
            for (int j = 0; j < 16; ++j) {
                const int c = c0 + j;
                const float yn = (y[j] - mean) * rs * P.in[33][l * 512 + c] + P.in[34][l * 512 + c];
                MIX[(size_t)row * DM + 512 + c] = f2bf((yn + bon * vv[j]) * g[j]);
            }
        }
    }
}

__device__ __forceinline__ void phase_ln1(const Params& P, int l) {
    const int lane = otid() & 63, wave = __builtin_amdgcn_readfirstlane(otid() >> 6);
    float* XS = (float*)(P.ws + OFF_XS);
    const float* TMP = (const float*)(P.ws + OFF_TMP);
    const float* MOD = (const float*)(P.ws + OFF_MOD);
    bf16_t* H2 = (bf16_t*)(P.ws + OFF_H2);
    for (int row = blockIdx.x * 4 + wave; row < MROWS; row += gridDim.x * 4) {
        if (l == 1 && (row % LTOT) < CTX) continue;
        const float* mod = MOD + (size_t)(l * 5 + modrow(row)) * 6144;
        float v[16]; float s = 0.f;
#pragma unroll
        for (int j = 0; j < 4; ++j) {
            const int d = 256 * j + 4 * lane;
            const float4 x = *(const float4*)(XS + (size_t)row * DM + d), t = *(const float4*)(TMP + (size_t)row * DM + d), g = *(const float4*)(mod + 2048 + d);
            v[4 * j + 0] = ALPHA * x.x + g.x * t.x; v[4 * j + 1] = ALPHA * x.y + g.y * t.y; v[4 * j + 2] = ALPHA * x.z + g.z * t.z; v[4 * j + 3] = ALPHA * x.w + g.w * t.w;
            s += v[4 * j] + v[4 * j + 1] + v[4 * j + 2] + v[4 * j + 3];
        }
        const float mean = wave_sum(s) * (1.f / 1024.f);
        float q = 0.f;
#pragma unroll
        for (int j = 0; j < 16; ++j) { const float d = v[j] - mean; q += d * d; }
        const float rs = rsqrtf(wave_sum(q) * (1.f / 1024.f) + 1e-5f);
#pragma unroll
        for (int j = 0; j < 4; ++j) {
            const int d = 256 * j + 4 * lane;
            const float4 gg = *(const float4*)(P.in[8] + l * 1024 + d), bb = *(const float4*)(P.in[9] + l * 1024 + d);
            const float4 sh = *(const float4*)(mod + 3072 + d), sc = *(const float4*)(mod + 4096 + d);
            float4 o;
            o.x = (v[4 * j + 0] - mean) * rs * gg.x + bb.x; o.y = (v[4 * j + 1] - mean) * rs * gg.y + bb.y;
            o.z = (v[4 * j + 2] - mean) * rs * gg.z + bb.z; o.w = (v[4 * j + 3] - mean) * rs * gg.w + bb.w;
            *(float4*)(XS + (size_t)row * DM + d) = o;
            ushort4 h;
            h.x = f2bf(o.x * (1.f + sc.x) + sh.x); h.y = f2bf(o.y * (1.f + sc.y) + sh.y); h.z = f2bf(o.z * (1.f + sc.z) + sh.z); h.w = f2bf(o.w * (1.f + sc.w) + sh.w);
            *(ushort4*)(H2 + (size_t)row * DM + d) = h;
        }
    }
}

__device__ __forceinline__ unsigned f2ord(float f) { const unsigned u = __float_as_uint(f); return u ^ ((u >> 31) ? 0xFFFFFFFFu : 0x80000000u); }
__device__ __forceinline__ float ord2f(unsigned u) { return __uint_as_float((u >> 31) ? (u ^ 0x80000000u) : ~u); }
__device__ __forceinline__ void phase_topk(const Params& P, int l) {
    const int tid = otid();
    const bf16_t* Q = (const bf16_t*)(P.ws + OFF_Q);
    int* IDX = (int*)(P.ws + OFF_IDX);
    float* GATE = (float*)(P.ws + OFF_GATE);
    for (int u = blockIdx.x; u < 8 * (MROWS / 256); u += gridDim.x) {
        const int hd = u / (MROWS / 256), rb = u % (MROWS / 256);
        const int row = rb * 256 + tid;
        if (l == 1 && (row % LTOT) < CTX) continue;
        unsigned top[2][16];
#pragma unroll
        for (int half = 0; half < 2; ++half) {
            float q[128];
            const bf16_t* qp = Q + (size_t)row * 2048 + hd * 256 + half * 128;
#pragma unroll
            for (int d8 = 0; d8 < 16; ++d8) {
                const bf16x8 v = *(const bf16x8*)(qp + d8 * 8);
#pragma unroll
                for (int j = 0; j < 8; ++j) q[d8 * 8 + j] = bf2f((bf16_t)v[j]);
            }
#pragma unroll
            for (int j = 0; j < 16; ++j) top[half][j] = 0u;
            const float* kp = P.in[36] + ((size_t)((l * 8 + hd) * 2 + half)) * 128 * 128;
            for (int key = 0; key < 128; ++key) {
                const float* kr = kp + key * 128;
                float s0 = 0.f, s1 = 0.f, s2 = 0.f, s3 = 0.f;
#pragma unroll
                for (int d = 0; d < 128; d += 4) { s0 += q[d] * kr[d]; s1 += q[d + 1] * kr[d + 1]; s2 += q[d + 2] * kr[d + 2]; s3 += q[d + 3] * kr[d + 3]; if ((d & 31) == 28) __builtin_amdgcn_sched_barrier(0); }
                unsigned x = (f2ord((s0 + s1) + (s2 + s3)) & 0xFFFFFF80u) | (unsigned)(127 - key);
#pragma unroll
                for (int j = 0; j < 16; ++j) { const unsigned t = top[half][j]; const unsigned mx = x > t ? x : t; x = x > t ? t : x; top[half][j] = mx; }
            }
        }
        float cs[16]; int ce[16];
#pragma unroll
        for (int j = 0; j < 16; ++j) { cs[j] = -3.0e38f; ce[j] = 0; }
#pragma unroll
        for (int i = 0; i < 16; ++i) {
            const float s1v = ord2f(top[0][i] & 0xFFFFFF80u); const int i1 = 127 - (int)(top[0][i] & 127u);
#pragma unroll
            for (int j = 0; j < 16; ++j) {
                if ((i + 1) * (j + 1) <= 16) {
                    float x = s1v + ord2f(top[1][j] & 0xFFFFFF80u); int xe = i1 * 128 + (127 - (int)(top[1][j] & 127u));
#pragma unroll
                    for (int t = 0; t < 16; ++t) {
                        const bool gt = x > cs[t];
                        const float ts = cs[t]; const int te = ce[t];
                        cs[t] = gt ? x : ts; ce[t] = gt ? xe : te; x = gt ? ts : x; xe = gt ? te : xe;
                    }
                }
            }
        }
        float den = 0.f, ex[16];
#pragma unroll
        for (int t = 0; t < 16; ++t) { ex[t] = __expf(cs[t] - cs[0]); den += ex[t]; }
        const float inv = 1.f / den;
#pragma unroll
        for (int t = 0; t < 16; ++t) { IDX[(size_t)row * 128 + hd * 16 + t] = ce[t]; GATE[(size_t)row * 128 + hd * 16 + t] = ex[t] * inv; }
    }
}


__device__ __forceinline__ void ce_desc(unsigned& a, unsigned& b) { const unsigned hi = a > b ? a : b, lo = a > b ? b : a; a = hi; b = lo; }
__device__ __forceinline__ void bitonic_sort16(unsigned (&u)[16]) {
#pragma unroll
    for (int k = 2; k <= 16; k <<= 1)
#pragma unroll
        for (int j = k >> 1; j > 0; j >>= 1)
#pragma unroll
            for (int i = 0; i < 16; ++i) {
                const int p = i ^ j;
                if (p > i) { if ((i & k) == 0) ce_desc(u[i], u[p]); else ce_desc(u[p], u[i]); }
            }
}
__device__ __forceinline__ void bitonic_merge16(unsigned (&u)[16]) {
#pragma unroll
    for (int j = 8; j > 0; j >>= 1)
#pragma unroll
        for (int i = 0; i < 16; ++i) { const int p = i ^ j; if (p > i) ce_desc(u[i], u[p]); }
}
__device__ __forceinline__ void xlane_top16(unsigned (&u)[16], int xr) {
    unsigned o[16];
#pragma unroll
    for (int i = 0; i < 16; ++i) o[i] = (unsigned)__shfl_xor((int)u[15 - i], xr, 64);
#pragma unroll
    for (int i = 0; i < 16; ++i) u[i] = u[i] > o[i] ? u[i] : o[i];
    bitonic_merge16(u);
}
__device__ __forceinline__ void phase_topk2(const Params& P, int l, unsigned char* smem) {
    const int lane = otid() & 63, wave = __builtin_amdgcn_readfirstlane(otid() >> 6), fr = lane & 15, fq = lane >> 4;
    const bf16_t* Q = (const bf16_t*)(P.ws + OFF_Q);
    const bf16_t* KB = (const bf16_t*)(P.ws + OFF_KEYB);
    int* IDX = (int*)(P.ws + OFF_IDX);
    float* GATE = (float*)(P.ws + OFF_GATE);
    unsigned char* ids = smem + wave * 512;
    for (int it = blockIdx.x * 4 + wave; it < (MROWS / 16) * 8; it += gridDim.x * 4) {
        const int rt = it >> 3, hd = it & 7, row0 = rt * 16;
        if (l == 1 && (row0 % LTOT) < CTX) continue;
        unsigned top[2][16];
#pragma unroll
        for (int half = 0; half < 2; ++half) {
            f32x4 acc[8];
#pragma unroll
            for (int mi = 0; mi < 8; ++mi) acc[mi] = (f32x4){0.f, 0.f, 0.f, 0.f};
            const bf16_t* kp = KB + ((size_t)((l * 8 + hd) * 2 + half) * 128 + fr) * 128 + 8 * fq;
            const bf16_t* qp = Q + (size_t)(row0 + fr) * 2048 + hd * 256 + half * 128 + 8 * fq;
#pragma unroll
            for (int ks = 0; ks < 4; ++ks) {
                const bf16x8 qb = *(const bf16x8*)(qp + 32 * ks);
#pragma unroll
                for (int mi = 0; mi < 8; ++mi) acc[mi] = mfma32(*(const bf16x8*)(kp + (size_t)(16 * mi) * 128 + 32 * ks), qb, acc[mi]);
            }
            unsigned ua[16], ub[16];
#pragma unroll
            for (int mi = 0; mi < 4; ++mi)
#pragma unroll
                for (int r = 0; r < 4; ++r) {
                    ua[mi * 4 + r] = (f2ord(acc[mi][r]) & 0xFFFFFF80u) | (unsigned)(127 - (16 * mi + 4 * fq + r));
                    ub[mi * 4 + r] = (f2ord(acc[mi + 4][r]) & 0xFFFFFF80u) | (unsigned)(127 - (16 * (mi + 4) + 4 * fq + r));
                }
            bitonic_sort16(ua); bitonic_sort16(ub);
#pragma unroll
            for (int i = 0; i < 16; ++i) ua[i] = ua[i] > ub[15 - i] ? ua[i] : ub[15 - i];
            bitonic_merge16(ua);
            xlane_top16(ua, 16); xlane_top16(ua, 32);
#pragma unroll
            for (int i = 0; i < 16; ++i) top[half][i] = ua[i];
        }
        if (fq == 0) {
            unsigned w[8];
#pragma unroll
            for (int i = 0; i < 8; ++i) {
                const unsigned* t = i < 4 ? &top[0][4 * i] : &top[1][4 * (i - 4)];
                w[i] = (127u - (t[0] & 127u)) | ((127u - (t[1] & 127u)) << 8) | ((127u - (t[2] & 127u)) << 16) | ((127u - (t[3] & 127u)) << 24);
            }
            *(uint4*)(ids + fr * 32) = make_uint4(w[0], w[1], w[2], w[3]);
            *(uint4*)(ids + fr * 32 + 16) = make_uint4(w[4], w[5], w[6], w[7]);
        }
        float s2v[16];
#pragma unroll
        for (int j = 0; j < 16; ++j) s2v[j] = ord2f(top[1][j] & 0xFFFFFF80u);
        float s1r[4];
#pragma unroll
        for (int m = 0; m < 4; ++m) {
            const unsigned t = fq == 0 ? top[0][4 * m] : (fq == 1 ? top[0][4 * m + 1] : (fq == 2 ? top[0][4 * m + 2] : top[0][4 * m + 3]));
            s1r[m] = ord2f(t & 0xFFFFFF80u);
        }
        unsigned cu[16];
#pragma unroll
        for (int j = 0; j < 16; ++j) cu[j] = (f2ord(s1r[0] + s2v[j]) & 0xFFFFFF00u) | (unsigned)((fq << 4) | j);
        {
            unsigned ex[5];
            ex[0] = (f2ord(s1r[1] + s2v[0]) & 0xFFFFFF00u) | (unsigned)(((4 + fq) << 4) | 0);
            ex[1] = (f2ord(s1r[1] + s2v[1]) & 0xFFFFFF00u) | (unsigned)(((4 + fq) << 4) | 1);
            ex[2] = (f2ord(s1r[1] + s2v[2]) & 0xFFFFFF00u) | (unsigned)(((4 + fq) << 4) | 2);
            ex[3] = (f2ord(s1r[2] + s2v[0]) & 0xFFFFFF00u) | (unsigned)(((8 + fq) << 4) | 0);
            ex[4] = (f2ord(s1r[3] + s2v[0]) & 0xFFFFFF00u) | (unsigned)(((12 + fq) << 4) | 0);
#pragma unroll
            for (int e = 0; e < 5; ++e) {
                unsigned x = ex[e];
#pragma unroll
                for (int t = 0; t < 16; ++t) { const unsigned c = cu[t]; const unsigned mx = x > c ? x : c; x = x > c ? c : x; cu[t] = mx; }
            }
        }
        xlane_top16(cu, 16); xlane_top16(cu, 32);
        if (fq == 0) {
            float ex[16], den = 0.f; int eid[16];
            const float m0 = ord2f(cu[0] & 0xFFFFFF00u);
#pragma unroll
            for (int t = 0; t < 16; ++t) {
                ex[t] = __expf(ord2f(cu[t] & 0xFFFFFF00u) - m0); den += ex[t];
                const int i = (cu[t] >> 4) & 15, j = cu[t] & 15;
                eid[t] = (int)ids[fr * 32 + i] * 128 + (int)ids[fr * 32 + 16 + j];
            }
            const float inv = 1.f / den;
            int* ip = IDX + (size_t)(row0 + fr) * 128 + hd * 16;
            float* gp = GATE + (size_t)(row0 + fr) * 128 + hd * 16;
#pragma unroll
            for (int t = 0; t < 16; t += 4) {
                *(int4*)(ip + t) = make_int4(eid[t], eid[t + 1], eid[t + 2], eid[t + 3]);
                *(float4*)(gp + t) = make_float4(ex[t] * inv, ex[t + 1] * inv, ex[t + 2] * inv, ex[t + 3] * inv);
            }
        }
    }
}

__device__ __forceinline__ void phase_tabconv(const Params& P, int l) {
    const float4* U = (const float4*)(P.in[37] + (size_t)l * 16384 * 1024);
    const float4* V = (const float4*)(P.in[38] + (size_t)l * 16384 * 1024);
    ushort4* TU = (ushort4*)(P.ws + OFF_TBU);
    ushort4* TV = (ushort4*)(P.ws + OFF_TBV);
    const size_t n4 = (size_t)16384 * 256;
    for (size_t i = (size_t)blockIdx.x * 256 + otid(); i < n4; i += (size_t)gridDim.x * 256) {
        const float4 a = U[i], b = V[i];
        ushort4 oa, ob;
        oa.x = f2bf(a.x); oa.y = f2bf(a.y); oa.z = f2bf(a.z); oa.w = f2bf(a.w);
        ob.x = f2bf(b.x); ob.y = f2bf(b.y); ob.z = f2bf(b.z); ob.w = f2bf(b.w);
        TU[i] = oa; TV[i] = ob;
    }
}
__device__ __forceinline__ float dot2bf(unsigned a, unsigned b, float acc) { return __builtin_amdgcn_fdot2_f32_bf16(__builtin_bit_cast(bf16x2, a), __builtin_bit_cast(bf16x2, b), acc, false); }
__device__ __forceinline__ float dot8(const uint4& a, const uint4& b, float acc) { acc = dot2bf(a.x, b.x, acc); acc = dot2bf(a.y, b.y, acc); acc = dot2bf(a.z, b.z, acc); return dot2bf(a.w, b.w, acc); }
__device__ __forceinline__ void phase_gather(const Params& P, int l, unsigned char* smem) {
    const int tid = otid(), lane = tid & 63, wave = __builtin_amdgcn_readfirstlane(tid >> 6);
    float* XS = (float*)(P.ws + OFF_XS);
    const float* MOD = (const float*)(P.ws + OFF_MOD);
    const bf16_t* H2 = (const bf16_t*)(P.ws + OFF_H2);
    bf16_t* H = (bf16_t*)(P.ws + OFF_H);
    const int* IDX = (const int*)(P.ws + OFF_IDX);
    const float* GATE = (const float*)(P.ws + OFF_GATE);
    const bf16_t* TU = (const bf16_t*)(P.ws + OFF_TBU);
    const bf16_t* TV = (const bf16_t*)(P.ws + OFF_TBV);
    float* coef = (float*)smem + wave * 128;
    for (int row = blockIdx.x * 4 + wave; row < MROWS; row += gridDim.x * 4) {
        if (l == 1 && (row % LTOT) < CTX) continue;
        const uint4 h0 = *(const uint4*)(H2 + (size_t)row * DM + 8 * lane), h1 = *(const uint4*)(H2 + (size_t)row * DM + 512 + 8 * lane);
        const int e0 = IDX[(size_t)row * 128 + lane], e1 = IDX[(size_t)row * 128 + 64 + lane];
        uint4 ra[8], rb[8];
#define LOADB(T, bt) { _Pragma("unroll") for (int i = 0; i < 8; ++i) { const int k = (bt) * 8 + i; const int e = __builtin_amdgcn_readlane(k < 64 ? e0 : e1, k & 63); \
            const uint4* rp = (const uint4*)((T) + (size_t)e * 1024); ra[i] = rp[lane]; rb[i] = rp[64 + lane]; } }
        for (int bt = 0; bt < 16; ++bt) {
            LOADB(TU, bt)
            float p[8];
#pragma unroll
            for (int i = 0; i < 8; ++i) p[i] = dot8(rb[i], h1, dot8(ra[i], h0, 0.f));
            float q[4], r2[2];
#pragma unroll
            for (int i = 0; i < 4; ++i) { const float sd = (lane & 32) ? p[i] : p[i + 4]; const float rc = __shfl_xor(sd, 32, 64); q[i] = ((lane & 32) ? p[i + 4] : p[i]) + rc; }
#pragma unroll
            for (int i = 0; i < 2; ++i) { const float sd = (lane & 16) ? q[i] : q[i + 2]; const float rc = __shfl_xor(sd, 16, 64); r2[i] = ((lane & 16) ? q[i + 2] : q[i]) + rc; }
            float sv;
            { const float sd = (lane & 8) ? r2[0] : r2[1]; const float rc = __shfl_xor(sd, 8, 64); sv = ((lane & 8) ? r2[1] : r2[0]) + rc; }
            sv += __shfl_xor(sv, 4, 64); sv += __shfl_xor(sv, 2, 64); sv += __shfl_xor(sv, 1, 64);
            if ((lane & 7) == 0) { const int k = bt * 8 + ((lane >> 3) & 7); coef[k] = gelu_tanh(sv) * GATE[(size_t)row * 128 + k]; }
        }
        float acc[16];
#pragma unroll
        for (int j = 0; j < 16; ++j) acc[j] = 0.f;
        for (int bt = 0; bt < 16; ++bt) {
            LOADB(TV, bt)
#pragma unroll
            for (int i = 0; i < 8; ++i) {
                const float c = coef[bt * 8 + i];
                const unsigned w[8] = {ra[i].x, ra[i].y, ra[i].z, ra[i].w, rb[i].x, rb[i].y, rb[i].z, rb[i].w};
#pragma unroll
                for (int j = 0; j < 8; ++j) { acc[2 * j] += c * __uint_as_float(w[j] << 16); acc[2 * j + 1] += c * __uint_as_float(w[j] & 0xFFFF0000u); }
            }
        }
#undef LOADB
        const float* mod = MOD + (size_t)(l * 5 + modrow(row)) * 6144;
        float v[16]; float s = 0.f;
#pragma unroll
        for (int hh = 0; hh < 2; ++hh) {
            const int d = 512 * hh + 8 * lane;
            const float4 x0 = *(const float4*)(XS + (size_t)row * DM + d), x1 = *(const float4*)(XS + (size_t)row * DM + d + 4);
            const float4 g0 = *(const float4*)(mod + 5120 + d), g1 = *(const float4*)(mod + 5120 + d + 4);
            v[8 * hh + 0] = ALPHA * x0.x + g0.x * acc[8 * hh + 0]; v[8 * hh + 1] = ALPHA * x0.y + g0.y * acc[8 * hh + 1];
            v[8 * hh + 2] = ALPHA * x0.z + g0.z * acc[8 * hh + 2]; v[8 * hh + 3] = ALPHA * x0.w + g0.w * acc[8 * hh + 3];
            v[8 * hh + 4] = ALPHA * x1.x + g1.x * acc[8 * hh + 4]; v[8 * hh + 5] = ALPHA * x1.y + g1.y * acc[8 * hh + 5];
            v[8 * hh + 6] = ALPHA * x1.z + g1.z * acc[8 * hh + 6]; v[8 * hh + 7] = ALPHA * x1.w + g1.w * acc[8 * hh + 7];
        }
#pragma unroll
        for (int j = 0; j < 16; ++j) s += v[j];
        const float mean = wave_sum(s) * (1.f / 1024.f);
        float qq = 0.f;
#pragma unroll
        for (int j = 0; j < 16; ++j) { v[j] -= mean; qq += v[j] * v[j]; }
        const float rs = rsqrtf(wave_sum(qq) * (1.f / 1024.f) + 1e-5f);
        const float* mod1 = MOD + (size_t)(1 * 5 + modrow(row)) * 6144;
#pragma unroll
        for (int hh = 0; hh < 2; ++hh) {
            const int d = 512 * hh + 8 * lane;
            float o[8];
#pragma unroll
            for (int j = 0; j < 8; ++j) o[j] = v[8 * hh + j] * rs * P.in[10][l * 1024 + d + j] + P.in[11][l * 1024 + d + j];
            if (l == 0) {
                *(float4*)(XS + (size_t)row * DM + d) = make_float4(o[0], o[1], o[2], o[3]);
                *(float4*)(XS + (size_t)row * DM + d + 4) = make_float4(o[4], o[5], o[6], o[7]);
                bf16_t hb[8];
#pragma unroll
                for (int j = 0; j < 8; ++j) hb[j] = f2bf(o[j] * (1.f + mod1[1024 + d + j]) + mod1[d + j]);
                uint4 pk; pk.x = hb[0] | ((unsigned)hb[1] << 16); pk.y = hb[2] | ((unsigned)hb[3] << 16); pk.z = hb[4] | ((unsigned)hb[5] << 16); pk.w = hb[6] | ((unsigned)hb[7] << 16);
                *(uint4*)(H + (size_t)row * DM + d) = pk;
            } else {
                const int b = row / LTOT, t = row % LTOT - CTX;
                if (*(volatile unsigned*)(P.ws + OFF_BAR + 15360) != 0u) { o[0] = __int_as_float(0x7fc00000); }
                float* op = P.out + ((size_t)b * SEQ + t) * DM + d;
                *(float4*)op = make_float4(o[0], o[1], o[2], o[3]);
                *(float4*)(op + 4) = make_float4(o[4], o[5], o[6], o[7]);
            }
        }
    }
}

__device__ __forceinline__ void s5_prep_unit(const Params& P, int l, int g, unsigned char* smem) {
    const int tid = otid();
    float* Kt = (float*)smem;
    float* bbr = Kt + 8192; float* bbi = bbr + 1024; float* cr = bbi + 1024; float* ci = cr + 1024; float* pwr = ci + 1024; float* pwi = pwr + 17 * 64;
    bf16_t* MS = (bf16_t*)(P.ws + OFF_S5MS) + (size_t)(l * 16 + g) * 256 * 256;
    bf16_t* MY = (bf16_t*)(P.ws + OFF_S5MY) + (size_t)(l * 16 + g) * 256 * 512;
    float* LB = (float*)(P.ws + OFF_S5LB) + (size_t)(l * 16 + g) * 256;
    for (int dir = 0; dir < 2; ++dir) {
        __syncthreads();
        const int ldg = (l * 2 + dir) * 16 + g;
        if (tid < 64) {
            const int p = tid;
            const float dt = expf(P.in[14][ldg]);
            const float lre = P.in[12][ldg * 64 + p], lim = P.in[13][ldg * 64 + p];
            for (int d = 0; d <= 16; ++d) { const float mag = expf(lre * dt * (float)d), ang = lim * dt * (float)d; pwr[d * 64 + p] = mag * cosf(ang); pwi[d * 64 + p] = mag * sinf(ang); }
            const float lb_re = pwr[64 + p], lb_im = pwi[64 + p];
            const float den = lre * lre + lim * lim, nr = lb_re - 1.f, ni = lb_im;
            const float co_re = (nr * lre + ni * lim) / den, co_im = (ni * lre - nr * lim) / den;
            for (int h = 0; h < 16; ++h) {
                const float br = P.in[15][((size_t)ldg * 64 + p) * 16 + h], bi = P.in[16][((size_t)ldg * 64 + p) * 16 + h];
                bbr[p * 16 + h] = co_re * br - co_im * bi; bbi[p * 16 + h] = co_re * bi + co_im * br;
            }
            LB[dir * 128 + p] = pwr[16 * 64 + p]; LB[dir * 128 + 64 + p] = pwi[16 * 64 + p];
        }
        for (int e = tid; e < 1024; e += 256) { cr[e] = P.in[17][(size_t)ldg * 1024 + e]; ci[e] = P.in[18][(size_t)ldg * 1024 + e]; }
        __syncthreads();
        for (int e = tid; e < 4096; e += 256) {
            const int d = e >> 8, h = (e >> 4) & 15, h2 = e & 15;
            float acc = 0.f;
            for (int p = 0; p < 64; ++p) {
                const float Pr = pwr[d * 64 + p], Pi = pwi[d * 64 + p], br = bbr[p * 16 + h2], bi = bbi[p * 16 + h2];
                acc += cr[h * 64 + p] * (Pr * br - Pi * bi) - ci[h * 64 + p] * (Pr * bi + Pi * br);
            }
            Kt[dir * 4096 + e] = acc;
        }
        for (int e = tid; e < 128 * 256; e += 256) {
            const int q = e >> 8, col = e & 255, j = col >> 4, h2 = col & 15, p = q & 63;
            const int ex = dir == 0 ? 15 - j : j;
            const float Pr = pwr[ex * 64 + p], Pi = pwi[ex * 64 + p], br = bbr[p * 16 + h2], bi = bbi[p * 16 + h2];
            MS[(size_t)(dir * 128 + q) * 256 + col] = f2bf(q < 64 ? Pr * br - Pi * bi : Pr * bi + Pi * br);
        }
        for (int e = tid; e < 256 * 128; e += 256) {
            const int ri = e >> 7, q = e & 127, t = ri >> 4, h = ri & 15, p = q & 63;
            const int ex = dir == 0 ? t + 1 : 16 - t;
            const float Lr = pwr[ex * 64 + p], Li = pwi[ex * 64 + p], c_r = cr[h * 64 + p], c_i = ci[h * 64 + p];
            MY[(size_t)ri * 512 + 256 + dir * 128 + q] = f2bf(q < 64 ? c_r * Lr - c_i * Li : -(c_r * Li + c_i * Lr));
        }
    }
    __syncthreads();
    for (int e = tid; e < 256 * 256; e += 256) {
        const int ri = e >> 8, col = e & 255, t = ri >> 4, h = ri & 15, j = col >> 4, h2 = col & 15;
        float v = 0.f;
        if (j <= t) v += Kt[(t - j) * 256 + h * 16 + h2];
        if (j >= t) v += Kt[4096 + (j - t) * 256 + h * 16 + h2];
        MY[(size_t)ri * 512 + col] = f2bf(v);
    }
}
__device__ __forceinline__ void s5_passA(const Params& P, int l, int bid, int nb) {
    const int lane = otid() & 63, wave = __builtin_amdgcn_readfirstlane(otid() >> 6), fr = lane & 15, fq = lane >> 4;
    const bf16_t* Pb = (const bf16_t*)(P.ws + OFF_P);
    float* ST = (float*)(P.ws + OFF_S5ST);
    for (int it = bid * 4 + wave; it < 16 * 17 * 4; it += nb * 4) {
        const int g = it / 68, mt = (it % 68) >> 2, nt = it & 3;
        const bf16_t* MS = (const bf16_t*)(P.ws + OFF_S5MS) + (size_t)(l * 16 + g) * 256 * 256;
        f32x4 acc[4][4];
#pragma unroll
        for (int i = 0; i < 4; ++i)
#pragma unroll
            for (int j = 0; j < 4; ++j) acc[i][j] = (f32x4){0.f, 0.f, 0.f, 0.f};
        const bf16_t* ap[4];
#pragma unroll
        for (int i = 0; i < 4; ++i) { const int m = mt * 64 + 16 * i + fr, b = m / 272, c = m % 272; ap[i] = Pb + (size_t)(b * LTOT + c * 16) * PIN + g * 16; }
        const bf16_t* bp = MS + (size_t)(nt * 64 + fr) * 256 + 8 * fq;
        for (int k0 = 0; k0 < 256; k0 += 32) {
            const int k = k0 + 8 * fq;
            bf16x8 a[4], bb[4];
#pragma unroll
            for (int i = 0; i < 4; ++i) a[i] = *(const bf16x8*)(ap[i] + (size_t)(k >> 4) * PIN + (k & 15));
#pragma unroll
            for (int j = 0; j < 4; ++j) bb[j] = *(const bf16x8*)(bp + (size_t)(16 * j) * 256 + k0);
#pragma unroll
            for (int i = 0; i < 4; ++i)
#pragma unroll
                for (int j = 0; j < 4; ++j) acc[i][j] = __builtin_amdgcn_mfma_f32_16x16x32_bf16(a[i], bb[j], acc[i][j], 0, 0, 0);
        }
#pragma unroll
        for (int i = 0; i < 4; ++i)
#pragma unroll
            for (int r = 0; r < 4; ++r) {
                const int m = mt * 64 + 16 * i + 4 * fq + r, b = m / 272, c = m % 272;
                float* dst = ST + ((size_t)(b * 16 + g) * 272 + c) * 256 + nt * 64 + fr;
#pragma unroll
                for (int j = 0; j < 4; ++j) dst[16 * j] = acc[i][j][r];
            }
    }
}
__device__ __forceinline__ void s5_carry(const Params& P, int l, int bid, int nb) {
    float* ST = (float*)(P.ws + OFF_S5ST);
    for (int u = bid; u < 32; u += nb) {
        const int gid = u * 256 + otid(), p = gid & 63, dir = (gid >> 6) & 1, g = (gid >> 7) & 15, b = gid >> 11;
        const float* LB = (const float*)(P.ws + OFF_S5LB) + (size_t)(l * 16 + g) * 256 + dir * 128;
        const float lr = LB[p], li = LB[64 + p];
        float* base = ST + (size_t)(b * 16 + g) * 272 * 256 + dir * 128 + p;
        float sr = 0.f, si = 0.f;
        for (int c0 = 0; c0 < 272; c0 += 16) {
            float tr[16], ti[16];
#pragma unroll
            for (int i = 0; i < 16; ++i) { const int cc = c0 + i, c = dir == 0 ? cc : (cc < 16 ? 15 - cc : 287 - cc); tr[i] = base[(size_t)c * 256]; ti[i] = base[(size_t)c * 256 + 64]; }
#pragma unroll
            for (int i = 0; i < 16; ++i) {
                const int cc = c0 + i, c = dir == 0 ? cc : (cc < 16 ? 15 - cc : 287 - cc);
                base[(size_t)c * 256] = sr; base[(size_t)c * 256 + 64] = si;
                const float nr = lr * sr - li * si + tr[i], ni = lr * si + li * sr + ti[i];
                sr = nr; si = ni;
            }
        }
    }
}
__device__ __forceinline__ void s5_passC(const Params& P, int l, int bid, int nb) {
    const int lane = otid() & 63, wave = __builtin_amdgcn_readfirstlane(otid() >> 6), fr = lane & 15, fq = lane >> 4;
    const bf16_t* Pb = (const bf16_t*)(P.ws + OFF_P);
    const float* ST = (const float*)(P.ws + OFF_S5ST);
    bf16_t* YA = (bf16_t*)(P.ws + OFF_YP);
    for (int it = bid * 4 + wave; it < 16 * 17 * 4; it += nb * 4) {
        const int g = it / 68, mt = (it % 68) >> 2, nt = it & 3;
        const bf16_t* MY = (const bf16_t*)(P.ws + OFF_S5MY) + (size_t)(l * 16 + g) * 256 * 512;
        f32x4 acc[4][4];
#pragma unroll
        for (int i = 0; i < 4; ++i)
#pragma unroll
            for (int j = 0; j < 4; ++j) acc[i][j] = (f32x4){0.f, 0.f, 0.f, 0.f};
        const bf16_t* ap[4]; const float* sp[4];
#pragma unroll
        for (int i = 0; i < 4; ++i) {
            const int m = mt * 64 + 16 * i + fr, b = m / 272, c = m % 272;
            ap[i] = Pb + (size_t)(b * LTOT + c * 16) * PIN + g * 16;
            sp[i] = ST + ((size_t)(b * 16 + g) * 272 + c) * 256;
        }
        const bf16_t* bp = MY + (size_t)(nt * 64 + fr) * 512 + 8 * fq;
        for (int k0 = 0; k0 < 512; k0 += 32) {
            const int k = k0 + 8 * fq;
            bf16x8 a[4], bb[4];
            if (k0 < 256) {
#pragma unroll
                for (int i = 0; i < 4; ++i) a[i] = *(const bf16x8*)(ap[i] + (size_t)(k >> 4) * PIN + (k & 15));
            } else {
#pragma unroll
                for (int i = 0; i < 4; ++i) {
                    const float4 s0 = *(const float4*)(sp[i] + (k - 256)), s1 = *(const float4*)(sp[i] + (k - 256) + 4);
                    bf16x8 t;
                    t[0] = (short)f2bf(s0.x); t[1] = (short)f2bf(s0.y); t[2] = (short)f2bf(s0.z); t[3] = (short)f2bf(s0.w);
                    t[4] = (short)f2bf(s1.x); t[5] = (short)f2bf(s1.y); t[6] = (short)f2bf(s1.z); t[7] = (short)f2bf(s1.w);
                    a[i] = t;
                }
            }
#pragma unroll
            for (int j = 0; j < 4; ++j) bb[j] = *(const bf16x8*)(bp + (size_t)(16 * j) * 512 + k0);
#pragma unroll
            for (int i = 0; i < 4; ++i)
#pragma unroll
                for (int j = 0; j < 4; ++j) acc[i][j] = __builtin_amdgcn_mfma_f32_16x16x32_bf16(a[i], bb[j], acc[i][j], 0, 0, 0);
        }
        const float dsk = P.in[19][l * 256 + g * 16 + fr];
#pragma unroll
        for (int i = 0; i < 4; ++i)
#pragma unroll
            for (int r = 0; r < 4; ++r) {
                const int m = mt * 64 + 16 * i + 4 * fq + r, b = m / 272, c = m % 272;
#pragma unroll
                for (int j = 0; j < 4; ++j) {
                    const int t = nt * 4 + j;
                    const size_t row = (size_t)(b * LTOT + c * 16 + t);
                    const float u = bf2f(Pb[row * PIN + g * 16 + fr]);
                    YA[row * DM + g * 16 + fr] = f2bf(gelu_tanh(acc[i][j][r] + dsk * u));
                }
            }
    }
}


#define OFF_T8 OFF_P
#define OFF_T8S (OFF_P + (size_t)2 * 16384 * 1024)
typedef float f32x2 __attribute__((ext_vector_type(2)));
__device__ __forceinline__ void phase_tabconv8(const Params& P, int l) {
    const int lane = otid() & 63, wave = __builtin_amdgcn_readfirstlane(otid() >> 6);
    unsigned char* T8 = P.ws + OFF_T8;
    float* T8S = (float*)(P.ws + OFF_T8S);
    for (int row = blockIdx.x * 4 + wave; row < 32768; row += gridDim.x * 4) {
        const float* src = P.in[37 + (row >> 14)] + ((size_t)l * 16384 + (row & 16383)) * 1024 + 16 * lane;
        f32x4 x[4];
        float am = 0.f;
#pragma unroll
        for (int j = 0; j < 4; ++j) { x[j] = *(const f32x4*)(src + 4 * j); am = fmaxf(am, fmaxf(fmaxf(fabsf(x[j][0]), fabsf(x[j][1])), fmaxf(fabsf(x[j][2]), fabsf(x[j][3])))); }
#pragma unroll
        for (int o = 32; o > 0; o >>= 1) am = fmaxf(am, __shfl_xor(am, o, 64));
        const float sc = am > 0.f ? 224.f / am : 1.f;
        u32x4 pk;
#pragma unroll
        for (int j = 0; j < 4; ++j) {
            int p = __builtin_amdgcn_cvt_pk_fp8_f32(x[j][0] * sc, x[j][1] * sc, 0, false);
            p = __builtin_amdgcn_cvt_pk_fp8_f32(x[j][2] * sc, x[j][3] * sc, p, true);
            pk[j] = (unsigned)p;
        }
        *(u32x4*)(T8 + (size_t)row * 1024 + 16 * lane) = pk;
        if (lane == 0) T8S[row] = am * (1.f / 224.f);
    }
}
__device__ __forceinline__ void phase_gather8(const Params& P, int l, unsigned char* smem) {
    const int tid = otid(), lane = tid & 63, wave = __builtin_amdgcn_readfirstlane(tid >> 6);
    float* XS = (float*)(P.ws + OFF_XS);
    const float* MOD = (const float*)(P.ws + OFF_MOD);
    const bf16_t* H2 = (const bf16_t*)(P.ws + OFF_H2);
    bf16_t* H = (bf16_t*)(P.ws + OFF_H);
    const int* IDX = (const int*)(P.ws + OFF_IDX);
    const float* GATE = (const float*)(P.ws + OFF_GATE);
    const unsigned char* TU = P.ws + OFF_T8;
    const unsigned char* TV = TU + (size_t)16384 * 1024;
    const float* SU = (const float*)(P.ws + OFF_T8S);
    const float* SV = SU + 16384;
    float* coef = (float*)smem + wave * 128;
    for (int row = blockIdx.x * 4 + wave; row < MROWS; row += gridDim.x * 4) {
        if (l == 1 && (row % LTOT) < CTX) continue;
        float hv[16];
        {
            const u32x4 h0 = *(const u32x4*)(H2 + (size_t)row * DM + 16 * lane), h1 = *(const u32x4*)(H2 + (size_t)row * DM + 16 * lane + 8);
#pragma unroll
            for (int j = 0; j < 4; ++j) { hv[2 * j] = __uint_as_float(h0[j] << 16); hv[2 * j + 1] = __uint_as_float(h0[j] & 0xFFFF0000u); hv[8 + 2 * j] = __uint_as_float(h1[j] << 16); hv[9 + 2 * j] = __uint_as_float(h1[j] & 0xFFFF0000u); }
        }
        const int e0 = IDX[(size_t)row * 128 + lane], e1 = IDX[(size_t)row * 128 + 64 + lane];
        const float g0 = GATE[(size_t)row * 128 + lane], g1 = GATE[(size_t)row * 128 + 64 + lane];
        const float su0 = SU[e0], su1 = SU[e1], sv0 = SV[e0], sv1 = SV[e1];
        u32x4 rr[8];
#define LOAD8(T, bt) { _Pragma("unroll") for (int i = 0; i < 8; ++i) { const int k = (bt) * 8 + i; const int e = __builtin_amdgcn_readlane(k < 64 ? e0 : e1, k & 63); \
            rr[i] = *(const u32x4*)((T) + (size_t)e * 1024 + 16 * lane); } }
        for (int bt = 0; bt < 16; ++bt) {
            LOAD8(TU, bt)
            float p[8];
#pragma unroll
            for (int i = 0; i < 8; ++i) {
                float a = 0.f;
#pragma unroll
                for (int j = 0; j < 4; ++j) {
                    const f32x2 lo = __builtin_amdgcn_cvt_pk_f32_fp8((int)rr[i][j], false), hi = __builtin_amdgcn_cvt_pk_f32_fp8((int)rr[i][j], true);
                    a += lo[0] * hv[4 * j] + lo[1] * hv[4 * j + 1] + hi[0] * hv[4 * j + 2] + hi[1] * hv[4 * j + 3];
                }
                p[i] = a;
            }
            float q[4], r2[2];
#pragma unroll
            for (int i = 0; i < 4; ++i) { const float sd = (lane & 32) ? p[i] : p[i + 4]; const float rc = __shfl_xor(sd, 32, 64); q[i] = ((lane & 32) ? p[i + 4] : p[i]) + rc; }
#pragma unroll
            for (int i = 0; i < 2; ++i) { const float sd = (lane & 16) ? q[i] : q[i + 2]; const float rc = __shfl_xor(sd, 16, 64); r2[i] = ((lane & 16) ? q[i + 2] : q[i]) + rc; }
            float sv;
            { const float sd = (lane & 8) ? r2[0] : r2[1]; const float rc = __shfl_xor(sd, 8, 64); sv = ((lane & 8) ? r2[1] : r2[0]) + rc; }
            sv += __shfl_xor(sv, 4, 64); sv += __shfl_xor(sv, 2, 64); sv += __shfl_xor(sv, 1, 64);
            const int k = bt * 8 + ((lane >> 3) & 7);
            const float suk = __shfl(k < 64 ? su0 : su1, k & 63, 64), svk = __shfl(k < 64 ? sv0 : sv1, k & 63, 64), gk = __shfl(k < 64 ? g0 : g1, k & 63, 64);
            if ((lane & 7) == 0) coef[k] = gelu_tanh(sv * suk) * gk * svk;
        }
        float acc[16];
#pragma unroll
        for (int j = 0; j < 16; ++j) acc[j] = 0.f;
        for (int bt = 0; bt < 16; ++bt) {
            LOAD8(TV, bt)
#pragma unroll
            for (int i = 0; i < 8; ++i) {
                const float c = coef[bt * 8 + i];
#pragma unroll
                for (int j = 0; j < 4; ++j) {
                    const f32x2 lo = __builtin_amdgcn_cvt_pk_f32_fp8((int)rr[i][j], false), hi = __builtin_amdgcn_cvt_pk_f32_fp8((int)rr[i][j], true);
                    acc[4 * j] += c * lo[0]; acc[4 * j + 1] += c * lo[1]; acc[4 * j + 2] += c * hi[0]; acc[4 * j + 3] += c * hi[1];
                }
            }
        }
#undef LOAD8
        const float* mod = MOD + (size_t)(l * 5 + modrow(row)) * 6144;
        const int d0 = 16 * lane;
        float v[16]; float s = 0.f;
#pragma unroll
        for (int j = 0; j < 4; ++j) {
            const f32x4 x = *(const f32x4*)(XS + (size_t)row * DM + d0 + 4 * j), g = *(const f32x4*)(mod + 5120 + d0 + 4 * j);
#pragma unroll
            for (int e = 0; e < 4; ++e) { v[4 * j + e] = ALPHA * x[e] + g[e] * acc[4 * j + e]; s += v[4 * j + e]; }
        }
        const float mean = wave_sum(s) * (1.f / 1024.f);
        float qq = 0.f;
#pragma unroll
        for (int j = 0; j < 16; ++j) { v[j] -= mean; qq += v[j] * v[j]; }
        const float rs = rsqrtf(wave_sum(qq) * (1.f / 1024.f) + 1e-5f);
        const float* mod1 = MOD + (size_t)(1 * 5 + modrow(row)) * 6144;
#pragma unroll
        for (int j = 0; j < 4; ++j) {
            const int d = d0 + 4 * j;
            const f32x4 gg = *(const f32x4*)(P.in[10] + l * 1024 + d), bb = *(const f32x4*)(P.in[11] + l * 1024 + d);
            f32x4 o;
#pragma unroll
            for (int e = 0; e < 4; ++e) o[e] = v[4 * j + e] * rs * gg[e] + bb[e];
            if (l == 0) {
                *(f32x4*)(XS + (size_t)row * DM + d) = o;
                const f32x4 sh = *(const f32x4*)(mod1 + d), sc = *(const f32x4*)(mod1 + 1024 + d);
                const unsigned w0 = f2bf(o[0] * (1.f + sc[0]) + sh[0]) | ((unsigned)f2bf(o[1] * (1.f + sc[1]) + sh[1]) << 16);
                const unsigned w1 = f2bf(o[2] * (1.f + sc[2]) + sh[2]) | ((unsigned)f2bf(o[3] * (1.f + sc[3]) + sh[3]) << 16);
                *(uint2*)(H + (size_t)row * DM + d) = make_uint2(w0, w1);
            } else {
                const int b = row / LTOT, t = row % LTOT - CTX;
                *(f32x4*)(P.out + ((size_t)b * SEQ + t) * DM + d) = o;
            }
        }
    }
}

struct RwPrep { bf16_t lw[16]; bf16_t r[4], k[4], kap[4], a[4]; };
__device__ __forceinline__ void rwkv_prep_load(const bf16_t* RW, int b, int hd, int dir, int tau_base, int wave, int lane, RwPrep& R) {
    const int ch = hd * 64 + lane;
    const int row0 = row_of(b, dir, tau_base);
    const long rstep = dir ? -(long)RWW : (long)RWW;
    const bf16_t* base = RW + (size_t)row0 * RWW + ch;
#pragma unroll
    for (int t = 0; t < 16; ++t) R.lw[t] = base[t * rstep + 3072 + dir * 512];
#pragma unroll
    for (int tt = 0; tt < 4; ++tt) {
        const bf16_t* rw = base + (4 * wave + tt) * rstep;
        R.r[tt] = rw[0]; R.k[tt] = rw[512];
    }
}
__device__ __forceinline__ void rwkv_prep_load2(const bf16_t* RW, int b, int hd, int dir, int tau_base, int wave, int lane, RwPrep& R) {
    const int ch = hd * 64 + lane;
    const int row0 = row_of(b, dir, tau_base);
    const long rstep = dir ? -(long)RWW : (long)RWW;
    const bf16_t* base = RW + (size_t)row0 * RWW + ch;
#pragma unroll
    for (int tt = 0; tt < 4; ++tt) {
        const bf16_t* rw = base + (4 * wave + tt) * rstep;
        R.kap[tt] = rw[1536]; R.a[tt] = rw[2048 + dir * 512];
    }
}
__device__ __forceinline__ void rwkv_prep_finish(const RwPrep& R, unsigned char* buf, float ka, int wave, int lane) {
    bf16_t* KR = (bf16_t*)buf; bf16_t* BK = (bf16_t*)(buf + 4608); bf16_t* BbT = (bf16_t*)(buf + 9216); bf16_t* KbT = (bf16_t*)(buf + 11264); float* gT = (float*)(buf + 13312);
    float cs[16];
    {
        float c = 0.f;
#pragma unroll
        for (int t = 0; t < 16; ++t) { c += bf2f(R.lw[t]); cs[t] = c; }
    }
    const float c15 = cs[15];
    if (wave == 0) gT[lane] = __expf(c15);
    float cpw[4], ctw[4];
#pragma unroll
    for (int tt = 0; tt < 4; ++tt) {
        cpw[tt] = wave == 0 ? (tt == 0 ? 0.f : cs[tt - 1 < 0 ? 0 : tt - 1]) : (wave == 1 ? cs[3 + tt] : (wave == 2 ? cs[7 + tt] : cs[11 + tt]));
        ctw[tt] = wave == 0 ? cs[tt] : (wave == 1 ? cs[4 + tt] : (wave == 2 ? cs[8 + tt] : cs[12 + tt]));
    }
    bf16_t bb[4], kb[4];
#pragma unroll
    for (int tt = 0; tt < 4; ++tt) {
        const int t = 4 * wave + tt;
        const float r = bf2f(R.r[tt]), k = bf2f(R.k[tt]), kap = bf2f(R.kap[tt]), a = bf2f(R.a[tt]);
        const float ep = __expf(cpw[tt]), et = __expf(ctw[tt]), em = __expf(-ctw[tt]), eT = __expf(c15 - ctw[tt]);
        const float beta = kap * a, kt = k * (1.f + (a - 1.f) * ka);
        KR[t * 72 + lane] = f2bf(kap * ep); KR[(16 + t) * 72 + lane] = f2bf(r * et);
        BK[t * 72 + lane] = f2bf(beta * em); BK[(16 + t) * 72 + lane] = f2bf(kt * em);
        bb[tt] = f2bf(beta * eT); kb[tt] = f2bf(kt * eT);
    }
    uint2 pb, pk;
    pb.x = bb[0] | ((unsigned)bb[1] << 16); pb.y = bb[2] | ((unsigned)bb[3] << 16);
    pk.x = kb[0] | ((unsigned)kb[1] << 16); pk.y = kb[2] | ((unsigned)kb[3] << 16);
    *(uint2*)(BbT + lane * 16 + 4 * wave) = pb;
    *(uint2*)(KbT + lane * 16 + 4 * wave) = pk;
}
template <int NV>
__device__ __forceinline__ void rwkv_vt_load(const bf16_t* RW, int b, int hd, int dir, int tau_base, int vbase, int lane, bf16_t (&x)[8]) {
    const int row0 = row_of(b, dir, tau_base);
    const long rstep = dir ? -(long)RWW : (long)RWW;
    if (NV == 2) {
        const int vl = lane & 31, th = lane >> 5;
#pragma unroll
        for (int i = 0; i < 8; ++i) x[i] = RW[(size_t)row0 * RWW + (th * 8 + i) * rstep + 1024 + hd * 64 + vbase + vl];
    } else {
        const int vl = lane & 15, tq = lane >> 4;
#pragma unroll
        for (int i = 0; i < 4; ++i) x[i] = RW[(size_t)row0 * RWW + (tq * 4 + i) * rstep + 1024 + hd * 64 + vbase + vl];
    }
}
template <int NV>
__device__ __forceinline__ void rwkv_vt_store(const bf16_t (&x)[8], bf16_t* VT, int lane) {
    if (NV == 2) {
        const int vl = lane & 31, th = lane >> 5;
        u32x4 pk; pk[0] = x[0] | ((unsigned)x[1] << 16); pk[1] = x[2] | ((unsigned)x[3] << 16); pk[2] = x[4] | ((unsigned)x[5] << 16); pk[3] = x[6] | ((unsigned)x[7] << 16);
        *(u32x4*)(VT + vl * 16 + th * 8) = pk;
    } else {
        const int vl = lane & 15, tq = lane >> 4;
        uint2 pk; pk.x = x[0] | ((unsigned)x[1] << 16); pk.y = x[2] | ((unsigned)x[3] << 16);
        *(uint2*)(VT + vl * 16 + tq * 4) = pk;
    }
}
template <int NV, bool HASV, bool OUT>
__device__ __forceinline__ void rwkv_mfma_step(f32x4 (&X)[4][NV], const unsigned char* buf, const bf16_t* VT, f32x4 (&Yout)[NV], int lane) {
    const bf16_t* KR = (const bf16_t*)buf; const bf16_t* BK = (const bf16_t*)(buf + 4608); const bf16_t* BbT = (const bf16_t*)(buf + 9216); const bf16_t* KbT = (const bf16_t*)(buf + 11264); const float* gT = (const float*)(buf + 13312);
    const int fr = lane & 15, fq = lane >> 4;
    const f32x4 z4 = {0.f, 0.f, 0.f, 0.f};
    f32x4 cA = z4, cN = z4, cAk = z4, cRb = z4, cRk = z4;
#pragma unroll
    for (int ks = 0; ks < 2; ++ks) {
        const bf16x8 kh = *(const bf16x8*)(KR + fr * 72 + 32 * ks + 8 * fq), rh = *(const bf16x8*)(KR + (16 + fr) * 72 + 32 * ks + 8 * fq);
        const bf16x8 bc = *(const bf16x8*)(BK + fr * 72 + 32 * ks + 8 * fq), kc = *(const bf16x8*)(BK + (16 + fr) * 72 + 32 * ks + 8 * fq);
        cA = mfma32(kh, bc, cA); cN = mfma32(bc, kh, cN); cAk = mfma32(kc, kh, cAk);
        if (OUT) { cRb = mfma32(bc, rh, cRb); cRk = mfma32(kc, rh, cRk); }
    }
    f32x4 dg;
#pragma unroll
    for (int r = 0; r < 4; ++r) {
        const int row = 4 * fq + r;
        dg[r] = (row == fr) ? 1.f : 0.f;
        cA[r] = (fr < row) ? cA[r] : 0.f;
        cN[r] = (row < fr) ? cN[r] : 0.f;
        cAk[r] = (row < fr) ? cAk[r] : 0.f;
        cRb[r] = (row <= fr) ? cRb[r] : 0.f;
        cRk[r] = (row <= fr) ? cRk[r] : 0.f;
    }
    const bf16x4 a4 = to4(cA), n4 = to4(cN);
    const f32x4 cA2 = mfma16(n4, a4, z4), cN2 = mfma16(a4, n4, z4);
    const bf16x4 a24 = to4(cA2), n24 = to4(cN2);
    const f32x4 cA4 = mfma16(n24, a24, z4), cN4 = mfma16(a24, n24, z4);
    const f32x4 cA8 = mfma16(to4(cN4), to4(cA4), z4);
    const f32x4 T1 = mfma16(to4(dg - cA), to4(dg + cN2), z4);
    const f32x4 T2 = mfma16(to4(dg + cA4), to4(T1), z4);
    const f32x4 WT = mfma16(to4(dg + cA8), to4(T2), z4);
    const bf16x4 wt4 = to4(WT), aak4 = to4(cAk), rab4 = to4(cRb), rak4 = to4(cRk);
    bf16x8 aK[2], aR[2];
#pragma unroll
    for (int ks = 0; ks < 2; ++ks) {
        aK[ks] = cat8(*(const bf16x4*)(KR + fr * 72 + 32 * ks + 4 * fq), *(const bf16x4*)(KR + fr * 72 + 32 * ks + 16 + 4 * fq));
        if (OUT) aR[ks] = cat8(*(const bf16x4*)(KR + (16 + fr) * 72 + 32 * ks + 4 * fq), *(const bf16x4*)(KR + (16 + fr) * 72 + 32 * ks + 16 + 4 * fq));
    }
    bf16x4 u4[NV], vt4[NV];
#pragma unroll
    for (int nj = 0; nj < NV; ++nj) {
        const bf16x8 b0 = cat8(to4(X[0][nj]), to4(X[1][nj])), b1 = cat8(to4(X[2][nj]), to4(X[3][nj]));
        f32x4 G = mfma32(aK[1], b1, mfma32(aK[0], b0, z4));
        if (HASV) { vt4[nj] = *(const bf16x4*)(VT + (16 * nj + fr) * 16 + 4 * fq); G = mfma16(aak4, vt4[nj], G); }
        const f32x4 U = mfma16(wt4, to4(G), z4);
        u4[nj] = to4(-U);
        if (OUT) {
            f32x4 Yv = mfma32(aR[1], b1, mfma32(aR[0], b0, z4));
            Yv = mfma16(rab4, u4[nj], Yv);
            if (HASV) Yv = mfma16(rak4, vt4[nj], Yv);
            Yout[nj] = Yv;
        }
    }
#pragma unroll
    for (int mi = 0; mi < 4; ++mi) {
        const f32x4 g4 = *(const f32x4*)(gT + 16 * mi + 4 * fq);
        const bf16x4 bb4 = *(const bf16x4*)(BbT + (16 * mi + fr) * 16 + 4 * fq), kb4 = *(const bf16x4*)(KbT + (16 * mi + fr) * 16 + 4 * fq);
#pragma unroll
        for (int nj = 0; nj < NV; ++nj) {
            f32x4 x = X[mi][nj] * g4;
            x = mfma16(bb4, u4[nj], x);
            if (HASV) x = mfma16(kb4, vt4[nj], x);
            X[mi][nj] = x;
        }
    }
}
__device__ __forceinline__ void rwkv_passA(const Params& P, int l, unsigned char* smem, int bid, int nb) {
    const int lane = otid() & 63, wave = __builtin_amdgcn_readfirstlane(otid() >> 6), fr = lane & 15, fq = lane >> 4;
    const bf16_t* RW = (const bf16_t*)(P.ws + OFF_RW);
    float* RXL = (float*)(P.ws + OFF_RXL);
    bf16_t* RXP = (bf16_t*)P.out;
    for (int item = bid; item < 64 * RW_NCH; item += nb) {
        const int seq = item / RW_NCH, c = item % RW_NCH, dir = seq & 1, hd = (seq >> 1) & 7, b = seq >> 4;
        const float ka = P.in[31][l * 512 + hd * 64 + lane];
        const int tau0 = c * 128;
        f32x4 X[4][2], Yd[2];
#pragma unroll
        for (int mi = 0; mi < 4; ++mi)
#pragma unroll
            for (int nj = 0; nj < 2; ++nj)
#pragma unroll
                for (int r = 0; r < 4; ++r) X[mi][nj][r] = (wave >= 2 && (16 * mi + 4 * fq + r) == (16 * (2 * (wave - 2) + nj) + fr)) ? 1.f : 0.f;
        bf16_t* VTw = (bf16_t*)(smem + RW_VT0 + wave * 2048);
        RwPrep R; bf16_t vx[8];
        rwkv_prep_load(RW, b, hd, dir, tau0, wave, lane, R);
        if (wave < 2) rwkv_vt_load<2>(RW, b, hd, dir, tau0, 32 * wave, lane, vx);
        rwkv_prep_load2(RW, b, hd, dir, tau0, wave, lane, R);
        rwkv_prep_finish(R, smem, ka, wave, lane);
        if (wave < 2) rwkv_vt_store<2>(vx, VTw, lane);
        __syncthreads();
        for (int s = 0; s < 8; ++s) {
            if (s < 7) rwkv_prep_load(RW, b, hd, dir, tau0 + (s + 1) * 16, wave, lane, R);
            if (wave < 2) rwkv_mfma_step<2, true, false>(X, smem + (s & 1) * RW_BUF, VTw + (s & 1) * 512, Yd, lane);
            else rwkv_mfma_step<2, false, false>(X, smem + (s & 1) * RW_BUF, VTw, Yd, lane);
            if (s < 7) {
                if (wave < 2) rwkv_vt_load<2>(RW, b, hd, dir, tau0 + (s + 1) * 16, 32 * wave, lane, vx);
                rwkv_prep_load2(RW, b, hd, dir, tau0 + (s + 1) * 16, wave, lane, R);
                rwkv_prep_finish(R, smem + ((s + 1) & 1) * RW_BUF, ka, wave, lane);
                if (wave < 2) rwkv_vt_store<2>(vx, VTw + ((s + 1) & 1) * 512, lane);
            }
            __syncthreads();
        }
        if (wave < 2) {
#pragma unroll
            for (int mi = 0; mi < 4; ++mi)
#pragma unroll
                for (int nj = 0; nj < 2; ++nj) *(f32x4*)(RXL + (((size_t)item * 16 + mi * 4 + 2 * wave + nj) * 64 + lane) * 4) = X[mi][nj];
        } else {
#pragma unroll
            for (int mi = 0; mi < 4; ++mi)
#pragma unroll
                for (int nj = 0; nj < 2; ++nj)
#pragma unroll
                    for (int r = 0; r < 4; ++r) RXP[(size_t)item * 4096 + (16 * mi + 4 * fq + r) * 64 + 16 * (2 * (wave - 2) + nj) + fr] = f2bf(X[mi][nj][r]);
        }
    }
}
__device__ __forceinline__ void rwkv_passB(const Params& P, int bid, int nb) {
    const int lane = otid() & 63, wave = __builtin_amdgcn_readfirstlane(otid() >> 6), fr = lane & 15, fq = lane >> 4;
    float* RXL = (float*)(P.ws + OFF_RXL);
    const bf16_t* RXP = (const bf16_t*)P.out;
    for (int it = bid * 4 + wave; it < 256; it += nb * 4) {
        const int seq = it >> 2, nj = it & 3;
        f32x4 X[4];
#pragma unroll
        for (int mi = 0; mi < 4; ++mi) X[mi] = (f32x4){0.f, 0.f, 0.f, 0.f};
        for (int c = 0; c < RW_NCH; ++c) {
            const size_t item = (size_t)seq * RW_NCH + c;
            f32x4 L[4]; bf16x8 a[4][2];
#pragma unroll
            for (int mi = 0; mi < 4; ++mi) {
                L[mi] = *(const f32x4*)(RXL + ((item * 16 + mi * 4 + nj) * 64 + lane) * 4);
                const bf16_t* xp = RXP + item * 4096 + (16 * mi + fr) * 64;
#pragma unroll
                for (int ks = 0; ks < 2; ++ks) a[mi][ks] = cat8(*(const bf16x4*)(xp + 32 * ks + 4 * fq), *(const bf16x4*)(xp + 32 * ks + 16 + 4 * fq));
            }
            const bf16x8 b0 = cat8(to4(X[0]), to4(X[1])), b1 = cat8(to4(X[2]), to4(X[3]));
#pragma unroll
            for (int mi = 0; mi < 4; ++mi) {
                *(f32x4*)(RXL + ((item * 16 + mi * 4 + nj) * 64 + lane) * 4) = X[mi];
                X[mi] = mfma32(a[mi][1], b1, mfma32(a[mi][0], b0, L[mi]));
            }
        }
    }
}
template <bool CHECK>
__device__ __forceinline__ void rwkv_passC(const Params& P, int l, unsigned char* smem, int bid, int nb) {
    const int lane = otid() & 63, wave = __builtin_amdgcn_readfirstlane(otid() >> 6), fr = lane & 15, fq = lane >> 4;
    const bf16_t* RW = (const bf16_t*)(P.ws + OFF_RW);
    const float* RXL = (const float*)(P.ws + OFF_RXL);
    for (int item = bid; item < 64 * RW_NCH; item += nb) {
        const int seq = item / RW_NCH, c = item % RW_NCH, dir = seq & 1, hd = (seq >> 1) & 7, b = seq >> 4;
        if (l == 1 && dir == 0 && c < 2) continue;
        if (l == 1 && dir == 1 && c < 2) continue;
        bf16_t* YP = (bf16_t*)(P.ws + OFF_YP) + (size_t)dir * MROWS * DM;
        const float ka = P.in[31][l * 512 + hd * 64 + lane];
        const int tau0 = c * 128;
        f32x4 X[4][1], Yo[1];
#pragma unroll
        for (int mi = 0; mi < 4; ++mi) X[mi][0] = *(const f32x4*)(RXL + (((size_t)item * 16 + mi * 4 + wave) * 64 + lane) * 4);
        bf16_t* VTw = (bf16_t*)(smem + RW_VT0 + wave * 2048);
        RwPrep R; bf16_t vx[8];
        rwkv_prep_load(RW, b, hd, dir, tau0, wave, lane, R);
        rwkv_vt_load<1>(RW, b, hd, dir, tau0, 16 * wave, lane, vx);
        rwkv_prep_load2(RW, b, hd, dir, tau0, wave, lane, R);
        rwkv_prep_finish(R, smem, ka, wave, lane);
        rwkv_vt_store<1>(vx, VTw, lane);
        __syncthreads();
        for (int s = 0; s < 8; ++s) {
            if (s < 7) {
                rwkv_prep_load(RW, b, hd, dir, tau0 + (s + 1) * 16, wave, lane, R);
                rwkv_vt_load<1>(RW, b, hd, dir, tau0 + (s + 1) * 16, 16 * wave, lane, vx);
            }
            rwkv_mfma_step<1, true, true>(X, smem + (s & 1) * RW_BUF, VTw + (s & 1) * 512, Yo, lane);
            if (s < 7) {
                rwkv_prep_load2(RW, b, hd, dir, tau0 + (s + 1) * 16, wave, lane, R);
                rwkv_prep_finish(R, smem + ((s + 1) & 1) * RW_BUF, ka, wave, lane);
                rwkv_vt_store<1>(vx, VTw + ((s + 1) & 1) * 512, lane);
            }
#pragma unroll
            for (int r = 0; r < 4; ++r) {
                const int row = row_of(b, dir, tau0 + s * 16 + 4 * fq + r);
                if (CHECK) { if (YP[(size_t)row * DM + 512 + hd * 64 + 16 * wave + fr] != f2bf(Yo[0][r])) atomicAdd((unsigned*)(P.ws + OFF_BAR + 15360), 1u); }
                else YP[(size_t)row * DM + 512 + hd * 64 + 16 * wave + fr] = f2bf(Yo[0][r]);
            }
            __syncthreads();
        }
    }
}


#define HG_NCH 34
#define HG_BUF 7168
#define HG_VT0 14336
#define OFF_O_RXP 0ull
#define OFF_O_HXL ((size_t)2176 * 8192)
#define OFF_O_HD (OFF_O_HXL + (size_t)1088 * 16384)
struct HgPrep { bf16_t lf[16]; bf16_t q[4]; bf16_t v[4]; };
__device__ __forceinline__ void hgrn_prep_load(const bf16_t* Pb, int b, int hd, int dir, int tau_base, int vbase, int wave, int lane, HgPrep& R) {
    const int row0 = row_of(b, dir, tau_base);
    const long rstep = dir ? -(long)PIN : (long)PIN;
    const bf16_t* base = Pb + (size_t)row0 * PIN + hd * 64;
#pragma unroll
    for (int t = 0; t < 16; ++t) R.lf[t] = base[t * rstep + 768 + dir * 256 + lane];
#pragma unroll
    for (int tt = 0; tt < 4; ++tt) R.q[tt] = base[(4 * wave + tt) * rstep + 256 + lane];
    const int vl = lane & 15, tq = lane >> 4;
#pragma unroll
    for (int i = 0; i < 4; ++i) R.v[i] = base[(tq * 4 + i) * rstep + 512 + vbase + vl];
}
__device__ __forceinline__ float hgrn_prep_finish(const HgPrep& R, unsigned char* buf, bf16_t* VT, int wave, int lane) {
    bf16_t* QH = (bf16_t*)buf; bf16_t* KC = (bf16_t*)(buf + 2304); bf16_t* KbT = (bf16_t*)(buf + 4608); float* gT = (float*)(buf + 6656);
    float cs[16];
    {
        float c = 0.f;
#pragma unroll
        for (int t = 0; t < 16; ++t) { c += bf2f(R.lf[t]); cs[t] = c; }
    }
    const float c15 = cs[15];
    if (wave == 0) gT[lane] = __expf(c15);
    bf16_t kb[4];
#pragma unroll
    for (int tt = 0; tt < 4; ++tt) {
        const int t = 4 * wave + tt;
        const float ct = wave == 0 ? cs[tt] : (wave == 1 ? cs[4 + tt] : (wave == 2 ? cs[8 + tt] : cs[12 + tt]));
        const float lft = wave == 0 ? bf2f(R.lf[tt]) : (wave == 1 ? bf2f(R.lf[4 + tt]) : (wave == 2 ? bf2f(R.lf[8 + tt]) : bf2f(R.lf[12 + tt])));
        const float k = 1.f - __expf(lft);
        QH[t * 72 + lane] = f2bf(bf2f(R.q[tt]) * __expf(ct));
        KC[t * 72 + lane] = f2bf(k * __expf(fminf(-ct, 80.f)));
        kb[tt] = f2bf(k * __expf(c15 - ct));
    }
    uint2 pk; pk.x = kb[0] | ((unsigned)kb[1] << 16); pk.y = kb[2] | ((unsigned)kb[3] << 16);
    *(uint2*)(KbT + lane * 16 + 4 * wave) = pk;
    {
        const int vl = lane & 15, tq = lane >> 4;
        uint2 pv; pv.x = R.v[0] | ((unsigned)R.v[1] << 16); pv.y = R.v[2] | ((unsigned)R.v[3] << 16);
        *(uint2*)(VT + vl * 16 + tq * 4) = pv;
    }
    return c15;
}
template <bool OUT>
__device__ __forceinline__ void hgrn_mfma_step(f32x4 (&X)[4], const unsigned char* buf, const bf16_t* VT, f32x4& Yout, int lane) {
    const bf16_t* QH = (const bf16_t*)buf; const bf16_t* KC = (const bf16_t*)(buf + 2304); const bf16_t* KbT = (const bf16_t*)(buf + 4608); const float* gT = (const float*)(buf + 6656);
    const int fr = lane & 15, fq = lane >> 4;
    const f32x4 z4 = {0.f, 0.f, 0.f, 0.f};
    const bf16x4 vt4 = *(const bf16x4*)(VT + fr * 16 + 4 * fq);
    if (OUT) {
        f32x4 cAT = z4;
#pragma unroll
        for (int ks = 0; ks < 2; ++ks) {
            const bf16x8 kc = *(const bf16x8*)(KC + fr * 72 + 32 * ks + 8 * fq), qh = *(const bf16x8*)(QH + fr * 72 + 32 * ks + 8 * fq);
            cAT = mfma32(kc, qh, cAT);
        }
#pragma unroll
        for (int r = 0; r < 4; ++r) cAT[r] = ((4 * fq + r) <= fr) ? cAT[r] : 0.f;
        const bf16x8 aQ0 = cat8(*(const bf16x4*)(QH + fr * 72 + 4 * fq), *(const bf16x4*)(QH + fr * 72 + 16 + 4 * fq));
        const bf16x8 aQ1 = cat8(*(const bf16x4*)(QH + fr * 72 + 32 + 4 * fq), *(const bf16x4*)(QH + fr * 72 + 48 + 4 * fq));
        const bf16x8 b0 = cat8(to4(X[0]), to4(X[1])), b1 = cat8(to4(X[2]), to4(X[3]));
        f32x4 O = mfma32(aQ1, b1, mfma32(aQ0, b0, z4));
        Yout = mfma16(to4(cAT), vt4, O);
    }
#pragma unroll
    for (int mi = 0; mi < 4; ++mi) {
        const f32x4 g4 = *(const f32x4*)(gT + 16 * mi + 4 * fq);
        const bf16x4 kb4 = *(const bf16x4*)(KbT + (16 * mi + fr) * 16 + 4 * fq);
        X[mi] = mfma16(kb4, vt4, X[mi] * g4);
    }
}
__device__ __forceinline__ float hgrn_lb(const Params& P, int l, int dir, int ch) {
    if (l == 0) return 0.f;
    const float a0 = P.in[22][(dir * 2 + 0) * 256 + ch], a1 = P.in[22][(dir * 2 + 1) * 256 + ch];
    const float m = fmaxf(a0, a1), e0 = __expf(a0 - m), e1 = __expf(a1 - m);
    return e1 / (e0 + e1);
}
template <bool OUT>
__device__ __forceinline__ void hgrn_pass(const Params& P, int l, unsigned char* smem, int bid, int nb) {
    const int lane = otid() & 63, wave = __builtin_amdgcn_readfirstlane(otid() >> 6), fr = lane & 15, fq = lane >> 4;
    const bf16_t* Pb = (const bf16_t*)(P.ws + OFF_P);
    float* HXL = (float*)((unsigned char*)P.out + OFF_O_HXL);
    float* HD = (float*)((unsigned char*)P.out + OFF_O_HD);
    for (int item = bid; item < 32 * HG_NCH; item += nb) {
        const int seq = item / HG_NCH, c = item % HG_NCH, dir = seq & 1, hd = (seq >> 1) & 3, b = seq >> 3;
        if (OUT && l == 1 && c < 2) continue;
        bf16_t* YP = (bf16_t*)(P.ws + OFF_YP) + (size_t)dir * MROWS * DM;
        const int tau0 = c * 128;
        f32x4 X[4], Yo;
#pragma unroll
        for (int mi = 0; mi < 4; ++mi) X[mi] = OUT ? *(const f32x4*)(HXL + (((size_t)item * 16 + mi * 4 + wave) * 64 + lane) * 4) : (f32x4){0.f, 0.f, 0.f, 0.f};
        bf16_t* VTw = (bf16_t*)(smem + HG_VT0 + wave * 1024);
        HgPrep R;
        hgrn_prep_load(Pb, b, hd, dir, tau0, 16 * wave, wave, lane, R);
        float ctot = hgrn_prep_finish(R, smem, VTw, wave, lane);
        __syncthreads();
        for (int s = 0; s < 8; ++s) {
            if (s < 7) hgrn_prep_load(Pb, b, hd, dir, tau0 + (s + 1) * 16, 16 * wave, wave, lane, R);
            hgrn_mfma_step<OUT>(X, smem + (s & 1) * HG_BUF, VTw + (s & 1) * 256, Yo, lane);
            if (s < 7) ctot += hgrn_prep_finish(R, smem + ((s + 1) & 1) * HG_BUF, VTw + ((s + 1) & 1) * 256, wave, lane);
            if (OUT) {
#pragma unroll
                for (int r = 0; r < 4; ++r) {
                    const int row = row_of(b, dir, tau0 + s * 16 + 4 * fq + r);
                    YP[(size_t)row * DM + 256 + hd * 64 + 16 * wave + fr] = f2bf(Yo[r]);
                }
            }
            __syncthreads();
        }
        if (!OUT) {
#pragma unroll
            for (int mi = 0; mi < 4; ++mi) *(f32x4*)(HXL + (((size_t)item * 16 + mi * 4 + wave) * 64 + lane) * 4) = X[mi];
            if (wave == 0) HD[(size_t)item * 64 + lane] = __expf(ctot);
        }
    }
}
__device__ __forceinline__ void hgrn_carry(const Params& P, int bid, int nb) {
    float* HXL = (float*)((unsigned char*)P.out + OFF_O_HXL);
    const float* HD = (const float*)((unsigned char*)P.out + OFF_O_HD);
    for (int u = bid; u < 128; u += nb) {
        const int gid = u * 256 + otid(), ln = gid & 63, tile = (gid >> 6) & 15, seq = gid >> 10;
        const int mi = tile >> 2, fq = ln >> 4;
        f32x4 x = {0.f, 0.f, 0.f, 0.f};
        for (int c0 = 0; c0 < HG_NCH; c0 += 17) {
            f32x4 L[17];
#pragma unroll
            for (int i = 0; i < 17; ++i) {
                const size_t item = (size_t)seq * HG_NCH + c0 + i;
                L[i] = *(const f32x4*)(HXL + ((item * 16 + tile) * 64 + ln) * 4);
            }
#pragma unroll
            for (int i = 0; i < 17; ++i) {
                const size_t item = (size_t)seq * HG_NCH + c0 + i;
                const f32x4 D = *(const f32x4*)(HD + item * 64 + 16 * mi + 4 * fq);
                *(f32x4*)(HXL + ((item * 16 + tile) * 64 + ln) * 4) = x;
                x = D * x + L[i];
            }
        }
    }
}


__device__ __forceinline__ void phase_rwprep2(const Params& P, int l, unsigned char* smem, int bid, int nb) {
    const int tid = otid(), lane = tid & 63, wave = __builtin_amdgcn_readfirstlane(tid >> 6), fr = lane & 15, fq = lane >> 4;
    const bf16_t* Pb = (const bf16_t*)(P.ws + OFF_P);
    bf16_t* RW = (bf16_t*)(P.ws + OFF_RW);
    const bf16_t* LW = (const bf16_t*)(P.ws + OFF_LW);
    const float* mu = P.in[24] + l * 1920;
    bf16_t* AL = (bf16_t*)smem;
    float muv[8];
#pragma unroll
    for (int jj = 0; jj < 8; ++jj) muv[jj] = (tid + 256 * jj) < 1920 ? mu[tid + 256 * jj] : 0.f;
    const float kk0 = P.in[30][l * 512 + tid], kk1 = P.in[30][l * 512 + 256 + tid];
    for (int u = bid; u < MROWS / 16; u += nb) {
        const int r0 = u * 16;
        __syncthreads();
        bf16_t pvc[8], nvc[8], pvn[8], nvn[8]; bool okc, okn;
#define RWP_LOAD(ii, PV, NV, OK) { \
            const int row_ = r0 + (ii), p_ = row_ % LTOT; int nbr_; \
            { const int m = tid & 3; \
              if (p_ < CTX) { nbr_ = (m & 1) ? row_ + 1 : row_ - 1; OK = (m & 1) ? (p_ < CTX - 1) : (p_ > 0); } \
              else { const int t_ = p_ - CTX, gr = t_ >> 6, gc = t_ & 63; \
                     nbr_ = m == 0 ? row_ - 1 : (m == 1 ? row_ + 1 : (m == 2 ? row_ - 64 : row_ + 64)); \
                     OK = m == 0 ? (gc > 0) : (m == 1 ? (gc < 63) : (m == 2 ? (gr > 0) : (gr < 63))); } } \
            if (!OK) nbr_ = row_; \
            const bf16_t* pp_ = Pb + (size_t)row_ * PIN + 1536 + tid; const bf16_t* pn_ = Pb + (size_t)nbr_ * PIN + 1536 + tid; \
            _Pragma("unroll") for (int jj = 0; jj < 8; ++jj) { if (jj < 7 || tid < 128) { PV[jj] = pp_[256 * jj]; NV[jj] = pn_[256 * jj]; } else { PV[jj] = 0; NV[jj] = 0; } } }
        RWP_LOAD(0, pvc, nvc, okc)
        for (int i = 0; i < 16; ++i) {
            const int row = r0 + i;
            if (i + 1 < 16) RWP_LOAD(i + 1, pvn, nvn, okn)
            bf16_t* rw = RW + (size_t)row * RWW;
            float sv[8];
#pragma unroll
            for (int jj = 0; jj < 8; ++jj) {
                const float pv = bf2f(pvc[jj]);
                const float nv = okc ? bf2f(nvc[jj]) : 0.f;
                sv[jj] = pv + muv[jj] * (nv - pv);
            }
            rw[tid] = f2bf(sv[0]); rw[256 + tid] = f2bf(sv[1]);
            rw[512 + tid] = f2bf(sv[2]); rw[768 + tid] = f2bf(sv[3]);
            rw[1024 + tid] = f2bf(sv[4]); rw[1280 + tid] = f2bf(sv[5]);
            {
                const float a0 = sv[2] * kk0, a1 = sv[3] * kk1;
                const float n0 = fmaxf(sqrtf(wave_sum(a0 * a0)), 1e-12f), n1 = fmaxf(sqrtf(wave_sum(a1 * a1)), 1e-12f);
                rw[1536 + tid] = f2bf(a0 / n0); rw[1792 + tid] = f2bf(a1 / n1);
            }
            if (tid < 128) { rw[4096 + tid] = f2bf(sigmoidf_(sv[6])); AL[((2 + (tid >> 6)) * 16 + i) * 72 + (tid & 63)] = f2bf(sv[7]); }
            else AL[(((tid - 128) >> 6) * 16 + i) * 72 + (tid & 63)] = f2bf(tanhf(sv[6]));
#pragma unroll
            for (int jj = 0; jj < 8; ++jj) { pvc[jj] = pvn[jj]; nvc[jj] = nvn[jj]; }
            okc = okn;
        }
#undef RWP_LOAD
        __syncthreads();
        {
            const int d = wave & 1, isA = wave >> 1;
            const bf16x8 a0 = *(const bf16x8*)(AL + (wave * 16 + fr) * 72 + 8 * fq), a1 = *(const bf16x8*)(AL + (wave * 16 + fr) * 72 + 32 + 8 * fq);
            const bf16_t* W = LW + (size_t)isA * 131072 + (size_t)(l * 2 + d) * 512 * 64;
            const float* bias = P.in[isA ? 27 : 25] + (l * 2 + d) * 512;
            for (int nj = 0; nj < 32; ++nj) {
                const bf16x8 b0 = *(const bf16x8*)(W + (size_t)(16 * nj + fr) * 64 + 8 * fq), b1 = *(const bf16x8*)(W + (size_t)(16 * nj + fr) * 64 + 32 + 8 * fq);
                const f32x4 acc = mfma32(a1, b1, mfma32(a0, b0, (f32x4){0.f, 0.f, 0.f, 0.f}));
                const int c = 16 * nj + fr;
                const float bs = bias[c];
#pragma unroll
                for (int r = 0; r < 4; ++r) {
                    const float sg = sigmoidf_(bs + acc[r]);
                    RW[(size_t)(r0 + 4 * fq + r) * RWW + (isA ? 2048 : 3072) + d * 512 + c] = f2bf(isA ? sg : -0.60653066f * sg);
                }
            }
        }
    }
}
__device__ __forceinline__ void phase_post2(const Params& P, int l) {
    const int tid = otid(), lane = tid & 63, wave = __builtin_amdgcn_readfirstlane(tid >> 6), fr = lane & 15, fq = lane >> 4;
    const bf16_t* Pb = (const bf16_t*)(P.ws + OFF_P);
    const bf16_t* RW = (const bf16_t*)(P.ws + OFF_RW);
    const bf16_t* YF = (const bf16_t*)(P.ws + OFF_YP);
    const bf16_t* YB = YF + (size_t)MROWS * DM;
    const bf16_t* LW = (const bf16_t*)(P.ws + OFF_LW);
    bf16_t* MIX = (bf16_t*)(P.ws + OFF_MIX);
    const f32x4 z4 = {0.f, 0.f, 0.f, 0.f};
    for (int u = blockIdx.x; u < MROWS / 16; u += gridDim.x) {
        const int r0 = u * 16;
        if (l == 1 && (r0 % LTOT) < CTX) continue;
        {
            f32x4 acc[4] = {z4, z4, z4, z4};
            const bf16_t* ap = YF + (size_t)(r0 + fr) * DM + 8 * fq;
            const bf16_t* bp = LW + (size_t)3 * 131072 + (size_t)(l * 256 + 64 * wave + fr) * 256 + 8 * fq;
#pragma unroll
            for (int ks = 0; ks < 8; ++ks) {
                const bf16x8 a = *(const bf16x8*)(ap + 32 * ks);
#pragma unroll
                for (int j = 0; j < 4; ++j) acc[j] = mfma32(a, *(const bf16x8*)(bp + (size_t)(16 * j) * 256 + 32 * ks), acc[j]);
            }
#pragma unroll
            for (int j = 0; j < 4; ++j) {
                const int n = 64 * wave + 16 * j + fr;
                const float gb = P.in[21][l * 256 + n];
#pragma unroll
                for (int r = 0; r < 4; ++r) {
                    const size_t row = (size_t)(r0 + 4 * fq + r);
                    MIX[row * DM + n] = f2bf(bf2f(YF[row * DM + n]) * sigmoidf_(acc[j][r] + gb));
                }
            }
        }
        {
            const int i = tid >> 4, c0 = (tid & 15) * 16; const size_t row = (size_t)(r0 + i);
            float o[16], ss = 0.f;
#pragma unroll
            for (int j = 0; j < 16; ++j) { o[j] = bf2f(YF[row * DM + 256 + c0 + j]) + bf2f(YB[row * DM + 256 + c0 + j]); ss += o[j] * o[j]; }
            ss += __shfl_xor(ss, 1, 64); ss += __shfl_xor(ss, 2, 64);
            const float rs = rsqrtf(ss * (1.f / 64.f) + 1e-6f);
#pragma unroll
            for (int j = 0; j < 16; ++j) {
                const float gr = bf2f(Pb[row * PIN + 1280 + c0 + j]);
                MIX[row * DM + 256 + c0 + j] = f2bf(o[j] * rs * P.in[23][l * 256 + c0 + j] * gr);
            }
        }
#pragma unroll 1
        for (int hh = 0; hh < 2; ++hh) {
            const int h = 2 * wave + hh;
            f32x4 g[4] = {z4, z4, z4, z4};
            const bf16_t* ap = RW + (size_t)(r0 + fr) * RWW + 4096 + 8 * fq;
            const bf16_t* bp = LW + (size_t)2 * 131072 + (size_t)(l * 512 + h * 64 + fr) * 128 + 8 * fq;
#pragma unroll
            for (int ks = 0; ks < 4; ++ks) {
                const bf16x8 a = *(const bf16x8*)(ap + 32 * ks);
#pragma unroll
                for (int j = 0; j < 4; ++j) g[j] = mfma32(a, *(const bf16x8*)(bp + (size_t)(16 * j) * 128 + 32 * ks), g[j]);
            }
#pragma unroll
            for (int r = 0; r < 4; ++r) {
                const size_t row = (size_t)(r0 + 4 * fq + r);
                const bf16_t* rw = RW + row * RWW;
                float y[4], vv[4], sum = 0.f, bon = 0.f;
#pragma unroll
                for (int j = 0; j < 4; ++j) {
                    const int c = h * 64 + 16 * j + fr;
                    y[j] = bf2f(YF[row * DM + 512 + c]) + bf2f(YB[row * DM + 512 + c]);
                    sum += y[j];
                    const float rr = bf2f(rw[c]), k = bf2f(rw[512 + c]), af = bf2f(rw[2048 + c]), ab = bf2f(rw[2560 + c]);
                    const float ka = P.in[31][l * 512 + c];
                    vv[j] = bf2f(rw[1024 + c]);
                    bon += rr * P.in[32][l * 512 + c] * k * (2.f + (af + ab - 2.f) * ka);
                }
#pragma unroll
                for (int o = 1; o < 16; o <<= 1) { sum += __shfl_xor(sum, o, 64); bon += __shfl_xor(bon, o, 64); }
                const float mean = sum * (1.f / 64.f);
                float var = 0.f;
#pragma unroll
                for (int j = 0; j < 4; ++j) { const float d = y[j] - mean; var += d * d; }
#pragma unroll
                for (int o = 1; o < 16; o <<= 1) var += __shfl_xor(var, o, 64);
                const float rs = rsqrtf(var * (1.f / 64.f) + 64e-5f);
#pragma unroll
                for (int j = 0; j < 4; ++j) {
                    const int c = h * 64 + 16 * j + fr;
                    const float yn = (y[j] - mean) * rs * P.in[33][l * 512 + c] + P.in[34][l * 512 + c];
                    MIX[row * DM + 512 + c] = f2bf((yn + bon * vv[j]) * g[j][r]);
                }
            }
        }
    }
}

#define OFF_CTR (OFF_BAR + 14336)
#define ONE (1 << 20)
__device__ __forceinline__ int next_item(const Params& P, int ph, unsigned char* smem) {
    volatile LAS int* slot = (volatile LAS int*)(smem + 65552);
    __syncthreads();
    if (threadIdx.x == 0) *slot = (int)atomicAdd((unsigned*)(P.ws + OFF_CTR) + ph, 1u);
    __syncthreads();
    return __builtin_amdgcn_readfirstlane(*slot);
}
__device__ __forceinline__ void run_phase(const Params& P, int ph, unsigned char* smem, int rep) {
#ifndef ONLY
    if (ph == 0) { phase_prep(P, smem); return; }
    if (ph == 1) { phase_mkh(P); return; }
#else
    if (ph < 2) return;
#endif
    const int l = (ph - 2) / PPL, s = (ph - 2) % PPL;
#ifdef ONLY
    if (s != ONLY) return;
#endif
    switch (s) {
    case 0: gemm3_bf16((const bf16_t*)(P.ws + OFF_H), DM, (const bf16_t*)(P.ws + OFF_WIN) + (size_t)l * PIN * DM, DM, MROWS, PIN, DM, false, Epi4Inproj{(bf16_t*)(P.ws + OFF_P), (const float*)(P.ws + OFF_LBT) + l * 512}, smem, 7, 9); break;
    case 1:
        for (;;) {
            int i = next_item(P, ph, smem);
#ifdef PROBE_P1
            if (i >= 2448 && i < 2448 + (PROBE_P1 == 1 ? 1088 : (PROBE_P1 == 2 ? 1088 : 272))) i = i - 2448 + (PROBE_P1 == 1 ? 0 : (PROBE_P1 == 2 ? 1088 : 2176));
            else
#endif
            if (i >= 1088 + 1088 + 272) break;
            if (i < 1088) hgrn_pass<false>(P, l, smem, i, ONE);
            else if (i < 2176) phase_rwprep2(P, l, smem, i - 1088, ONE);
            else s5_passA(P, l, i - 2176, ONE);
        }
        break;
    case 2:
        for (;;) {
            const int i = next_item(P, ph, smem);
            if (i >= 2176 + 128 + 32) break;
            if (i < 2176) rwkv_passA(P, l, smem, i, ONE);
            else if (i < 2176 + 128) hgrn_carry(P, i - 2176, ONE);
            else s5_carry(P, l, i - 2176 - 128, ONE);
        }
        break;
    case 3:
        for (;;) {
            const int i = next_item(P, ph, smem);
            if (i >= 1088 + 272 + 64) break;
            if (i < 1088) hgrn_pass<true>(P, l, smem, i, ONE);
            else if (i < 1088 + 272) s5_passC(P, l, i - 1088, ONE);
            else rwkv_passB(P, i - 1088 - 272, ONE);
        }
        break;
    case 4:
        for (;;) {
            const int i = next_item(P, ph, smem);
            if (i >= 2176) break;
            rwkv_passC<false>(P, l, smem, i, ONE);
        }
        break;
    case 5: phase_post2(P, l); break;
    case 6: gemm3_bf16((const bf16_t*)(P.ws + OFF_MIX), DM, (const bf16_t*)(P.ws + OFF_WOUT) + (size_t)l * DM * DM, DM, MROWS, DM, DM, l == 1, Epi4F32{(float*)(P.ws + OFF_TMP), DM}, smem, 8, 8); break;
    case 7: phase_ln1(P, l); break;
    case 8: gemm3_bf16((const bf16_t*)(P.ws + OFF_H2), DM, (const bf16_t*)(P.ws + OFF_WQ) + (size_t)l * 2048 * DM, DM, MROWS, 2048, DM, l == 1, Epi4Bf16{(bf16_t*)(P.ws + OFF_Q), 2048}, smem, 8, 8); break;
    case 9: phase_topk2(P, l, smem); phase_tabconv8(P, l); break;
    case 10: phase_gather8(P, l, smem); break;
    }
}

__global__ void __launch_bounds__(256, 2) mega(Params P) {
    __shared__ __attribute__((aligned(16))) unsigned char smem[66048];
#if SINGLE
    cg::grid_group grid = cg::this_grid();
    if (threadIdx.x < 4) ((volatile LAS unsigned*)(smem + 65536))[threadIdx.x] = 0u;
    __syncthreads();
    XcdBarrier xb = xcd_barrier_post((unsigned*)(P.ws + OFF_BAR), (volatile LAS unsigned*)(smem + 65536));
#endif
    for (int ph = P.ph_lo; ph < P.ph_hi; ++ph) {
        int nrep = 1;
#ifdef DUPMASK
        if (ph >= 2 && ((DUPMASK >> ((ph - 2) % PPL)) & 1)) nrep = 2;
#endif
#ifdef DUP1MASK
        if (ph >= 2 + PPL && ((DUP1MASK >> ((ph - 2) % PPL)) & 1)) nrep = 2;
#endif
#ifdef PROBE_P
        if (ph == 0) nrep = 2;
#endif
        for (int rep = 0; rep < nrep; ++rep) {
            run_phase(P, ph, smem, rep);
#if SINGLE
            if (ph + 1 < P.ph_hi || rep + 1 < nrep) {
                if (ph == 0 && rep == 0) { asm volatile("s_waitcnt vmcnt(0)" ::: "memory"); __syncthreads(); grid.sync(); }
                else xcd_barrier(xb);
            }
#endif
        }
    }
}

extern "C" void kernel_launch(void* const* d_in, const int* in_sizes, int n_in, void* d_out, int out_size, void* d_ws, size_t ws_size, hipStream_t stream) {
    static int grid = 0;
    if (grid == 0) {
        if (n_in != 39 || ws_size < OFF_END) { fprintf(stderr, "kernel_launch: unexpected n_in %d or ws_size %zu (need %zu)\n", n_in, ws_size, (size_t)OFF_END); grid = -1; return; }
        int dev = 0, cus = 0, per_cu = 0;
        hipGetDevice(&dev);
        hipDeviceGetAttribute(&cus, hipDeviceAttributeMultiprocessorCount, dev);
        hipOccupancyMaxActiveBlocksPerMultiprocessor(&per_cu, mega, 256, 0);
        if (per_cu < 1) per_cu = 1;
        if (per_cu > 2) per_cu = 2;
        grid = cus * per_cu;
    }
    if (grid < 0) return;
    hipMemsetAsync((unsigned char*)d_ws + OFF_BAR, 0, 16384, stream);
    Params p{};
    for (int i = 0; i < 39; ++i) p.in[i] = (const float*)d_in[i];
    p.out = (float*)d_out; p.ws = (unsigned char*)d_ws;
#if SINGLE
    p.ph_lo = 0; p.ph_hi = NPH;
    void* args[] = {&p};
    hipError_t e = hipLaunchCooperativeKernel((void*)mega, dim3(grid), dim3(256), args, 0, stream);
    if (e != hipSuccess) fprintf(stderr, "cooperative launch failed: %s (grid %d)\n", hipGetErrorString(e), grid);
#else
    for (int ph = 0; ph < NPH; ++ph) {
        p.ph_lo = ph; p.ph_hi = ph + 1;
        hipLaunchKernelGGL(mega, dim3(grid), dim3(256), 0, stream, p);
    }
#endif
}
```

```cpp
#include <hip/hip_runtime.h>
#include <hip/hip_cooperative_groups.h>
#include <cstdio>
namespace cg = cooperative_groups;

#ifndef SINGLE
#define SINGLE 1
#endif

typedef unsigned short bf16_t;
typedef __bf16 bf16x2 __attribute__((ext_vector_type(2)));
typedef short bf16x8 __attribute__((ext_vector_type(8)));
typedef float f32x4 __attribute__((ext_vector_type(4)));

#define DM 1024
#define NB 4
#define SEQ 4096
#define CTX 256
#define LTOT 4352
#define MROWS 17408
#define PIN 3456
#define RWW 4224
#define NPH 24
#define PPL 11
#define ALPHA 1.41421356237f

#define OFF_XS 0ull
#define OFF_P (OFF_XS + (size_t)MROWS * DM * 4)
#define OFF_RW (OFF_P + (size_t)MROWS * PIN * 2)
#define OFF_YP (OFF_RW + (size_t)MROWS * RWW * 2)
#define OFF_MIX (OFF_YP + (size_t)2 * MROWS * DM * 2)
#define OFF_MOD (OFF_MIX + (size_t)MROWS * DM * 2)
#define OFF_WIN (OFF_MOD + (size_t)2 * 5 * 6144 * 4)
#define OFF_WOUT (OFF_WIN + (size_t)2 * PIN * DM * 2)
#define OFF_WQ (OFF_WOUT + (size_t)2 * DM * DM * 2)
#define OFF_S5MS (OFF_WQ + (size_t)2 * 2048 * DM * 2)
#define OFF_S5MY (OFF_S5MS + (size_t)2 * 16 * 256 * 256 * 2)
#define OFF_S5LB (OFF_S5MY + (size_t)2 * 16 * 256 * 512 * 2)
#define OFF_S5ST (OFF_S5LB + (size_t)2 * 16 * 2 * 128 * 4)
#define OFF_BAR (OFF_S5ST + (size_t)4 * 16 * 272 * 256 * 4)
#define OFF_KEYB (OFF_BAR + 16384)
#define OFF_LW (OFF_KEYB + (size_t)2 * 8 * 2 * 128 * 128 * 2)
#define OFF_LBT (OFF_LW + (size_t)4 * 131072 * 2)
#define OFF_END (OFF_LBT + 4096)
#define OFF_RXL OFF_MIX
#define OFF_TMP OFF_P
#define OFF_H OFF_YP
#define OFF_H2 (OFF_YP + (size_t)MROWS * DM * 2)
#define OFF_Q OFF_RW
#define OFF_IDX (OFF_RW + (size_t)MROWS * 2048 * 2)
#define OFF_GATE (OFF_IDX + (size_t)MROWS * 128 * 4)
#define OFF_TBU OFF_P
#define OFF_TBV (OFF_P + (size_t)16384 * 1024 * 2)

#define OFF_O_HGT ((size_t)2176 * 8192 + (size_t)1088 * 8192 + (size_t)1088 * 256)
struct Params {
    const float* in[39];
    float* out;
    unsigned char* ws;
    int ph_lo, ph_hi;
};

__device__ __forceinline__ bf16_t f2bf(float f) { const __bf16 h = (__bf16)f; return __builtin_bit_cast(bf16_t, h); }
typedef float f32x2_ __attribute__((ext_vector_type(2)));
__device__ __forceinline__ unsigned pk2bf(float a, float b) { const f32x2_ v = {a, b}; return __builtin_bit_cast(unsigned, __builtin_convertvector(v, bf16x2)); }
__device__ __forceinline__ float bf2f(bf16_t h) { return __uint_as_float(((unsigned)h) << 16); }
__device__ __forceinline__ float sigmoidf_(float x) { return 1.f / (1.f + __expf(-x)); }
__device__ __forceinline__ float siluf_(float x) { return x * sigmoidf_(x); }
__device__ __forceinline__ float gelu_tanh(float x) {
    const float u = 0.7978845608028654f * (x + 0.044715f * x * x * x);
    return 0.5f * x * (1.f + tanhf(u));
}
__device__ __forceinline__ float wave_sum(float v) {
#pragma unroll
    for (int o = 32; o > 0; o >>= 1) v += __shfl_xor(v, o, 64);
    return v;
}
typedef short bf16x4 __attribute__((ext_vector_type(4)));
#define RW_NCH 34
#define RW_BUF 13824
#define RW_VT0 27648
__device__ __forceinline__ f32x4 mfma32(bf16x8 a, bf16x8 b, f32x4 c) { return __builtin_amdgcn_mfma_f32_16x16x32_bf16(a, b, c, 0, 0, 0); }
__device__ __forceinline__ f32x4 mfma16(bf16x4 a, bf16x4 b, f32x4 c) {
    bf16x8 a8, b8;
    a8[0] = a[0]; a8[1] = a[1]; a8[2] = a[2]; a8[3] = a[3]; a8[4] = 0; a8[5] = 0; a8[6] = 0; a8[7] = 0;
    b8[0] = b[0]; b8[1] = b[1]; b8[2] = b[2]; b8[3] = b[3]; b8[4] = 0; b8[5] = 0; b8[6] = 0; b8[7] = 0;
    return __builtin_amdgcn_mfma_f32_16x16x32_bf16(a8, b8, c, 0, 0, 0);
}
typedef unsigned u32x2_ __attribute__((ext_vector_type(2)));
__device__ __forceinline__ bf16x4 to4(f32x4 v) { const u32x2_ p = {pk2bf(v[0], v[1]), pk2bf(v[2], v[3])}; return __builtin_bit_cast(bf16x4, p); }
__device__ __forceinline__ bf16x8 cat8(bf16x4 a, bf16x4 b) { bf16x8 o; o[0] = a[0]; o[1] = a[1]; o[2] = a[2]; o[3] = a[3]; o[4] = b[0]; o[5] = b[1]; o[6] = b[2]; o[7] = b[3]; return o; }

__device__ __forceinline__ int otid() { int t = threadIdx.x; asm volatile("" : "+v"(t)); return t; }
__device__ __forceinline__ float rdlane(float v, int l) { return __int_as_float(__builtin_amdgcn_readlane(__float_as_int(v), l)); }
__device__ __forceinline__ int row_of(int b, int dir, int tau) {
    const int p = dir == 0 ? tau : (tau < CTX ? (CTX - 1 - tau) : (LTOT + CTX - 1 - tau));
    return b * LTOT + p;
}
__device__ __forceinline__ int modrow(int row) { const int p = row % LTOT; return p < CTX ? 4 : row / LTOT; }

__device__ __forceinline__ void s5_prep_unit(const Params& P, int l, int g, unsigned char* smem);

#define XB_TMO      128
#define XB_XCNT(j)  (256  + 64 * (j))
#define XB_XSUB(j)  (1280 + 64 * (j))
#define XB_XGEN(j)  (2304 + 64 * (j))
#define XB_TOP      3328
#define XB_TOPGEN   3392
#define XCD_BAR_WORDS 3456
#define XB_SPIN_CAP (1u << 22)
#define LAS __attribute__((address_space(3)))
__device__ __forceinline__ unsigned xb_ld(unsigned* p)              { return __hip_atomic_load(p, __ATOMIC_RELAXED, __HIP_MEMORY_SCOPE_AGENT); }
__device__ __forceinline__ unsigned xb_add(unsigned* p, unsigned v) { return __hip_atomic_fetch_add(p, v, __ATOMIC_RELAXED, __HIP_MEMORY_SCOPE_AGENT); }
__device__ __forceinline__ unsigned xb_xcc_id() { return (unsigned)__builtin_amdgcn_s_getreg((3 << 11) | 20) & 0xFu; }
#define XB_SPIN(cond, bar) do { unsigned _sp = 0; while (cond) { __builtin_amdgcn_s_sleep(1); \
    if ((++_sp & 255u) == 0u) { if (xb_ld(&(bar)[XB_TMO])) break; if (_sp > XB_SPIN_CAP) { atomicAdd(&(bar)[XB_TMO], 1u); break; } } } } while (0)
struct XcdBarrier { unsigned* bar; unsigned x; volatile LAS unsigned* st; };
__device__ __forceinline__ XcdBarrier xcd_barrier_post(unsigned* bar, volatile LAS unsigned* st) {
    XcdBarrier b; b.bar = bar; b.x = xb_xcc_id(); b.st = st;
    if (threadIdx.x == 0) (void)xb_add(&bar[XB_XCNT(b.x)], 1u);
    return b;
}
__device__ __forceinline__ void xcd_barrier_complete(unsigned* bar, unsigned x, unsigned& nloc, unsigned& nx) {
    const unsigned G = gridDim.x * gridDim.y * gridDim.z;
    unsigned sum, cnt, mine, sp = 0u;
    for (;;) {
        sum = 0u; cnt = 0u; mine = 0u;
#pragma unroll
        for (unsigned j = 0; j < 16; ++j) { const unsigned c = xb_ld(&bar[XB_XCNT(j)]); sum += c; cnt += (c > 0u) ? 1u : 0u; mine = (j == x) ? c : mine; }
        if (sum == G) break;
        __builtin_amdgcn_s_sleep(1);
        if ((++sp & 255u) == 0u) { if (xb_ld(&bar[XB_TMO])) break; if (sp > XB_SPIN_CAP) { atomicAdd(&bar[XB_TMO], 1u); break; } }
    }
    nloc = mine > 0u ? mine : 1u; nx = cnt > 0u ? cnt : 1u;
}
__device__ __forceinline__ void xcd_barrier(const XcdBarrier& b) {
    asm volatile("s_waitcnt vmcnt(0)" ::: "memory");
    __syncthreads();
    if (threadIdx.x == 0) {
        unsigned* bar = b.bar;
        __builtin_amdgcn_s_waitcnt(0);
        unsigned nloc = b.st[0], nx = b.st[1];
        if (nloc == 0u) { xcd_barrier_complete(bar, b.x, nloc, nx); b.st[0] = nloc; b.st[1] = nx; }
        const unsigned old = xb_add(&bar[XB_XSUB(b.x)], 1u);
        const unsigned gen = old / nloc;
        if (old + 1u == (gen + 1u) * nloc) {
            __builtin_amdgcn_fence(__ATOMIC_RELEASE, "agent");
            asm volatile("s_waitcnt vmcnt(0)" ::: "memory");
            const unsigned og = xb_add(&bar[XB_TOP], 1u);
            const unsigned tg = og / nx;
            if (og + 1u == (tg + 1u) * nx) xb_add(&bar[XB_TOPGEN], 1u);
            else XB_SPIN(xb_ld(&bar[XB_TOPGEN]) == tg, bar);
            __builtin_amdgcn_fence(__ATOMIC_ACQUIRE, "agent");
            xb_add(&bar[XB_XGEN(b.x)], 1u);
            asm volatile("s_waitcnt vmcnt(0)" ::: "memory");
        } else {
            XB_SPIN(xb_ld(&bar[XB_XGEN(b.x)]) == gen, bar);
            __builtin_amdgcn_fence(__ATOMIC_ACQUIRE, "agent");
            asm volatile("s_waitcnt vmcnt(0)" ::: "memory");
        }
    }
    __syncthreads();
}

__device__ __forceinline__ void phase_prep(const Params& P, unsigned char* smem) {
    const int tid = otid(), lane = tid & 63, wave = __builtin_amdgcn_readfirstlane(tid >> 6);
    float* MOD = (float*)(P.ws + OFF_MOD);
    float* XS = (float*)(P.ws + OFF_XS);
    const int U_MOD = 192, U_COPY = MROWS / 16, U_TIN = 2 * 16 * 54, U_TOUT = 2 * 16 * 16, U_TQ = 2 * 16 * 32;
    const int U_S5 = 32, U_KEY = 64 + 64;
    const int total = U_S5 + U_KEY + U_MOD + U_COPY + U_TIN + U_TOUT + U_TQ;
    for (int u0 = blockIdx.x; u0 < total; u0 += gridDim.x) {
        __syncthreads();
        if (u0 < U_S5) {
            if (u0 == 0) {
                float* LBT = (float*)(P.ws + OFF_LBT);
                for (int i = tid; i < 1024; i += 256) {
                    const int ll = i >> 9, dir = (i >> 8) & 1, ch = i & 255;
                    float lbv = 0.f;
                    if (ll == 1) { const float a0 = P.in[22][(dir * 2 + 0) * 256 + ch], a1 = P.in[22][(dir * 2 + 1) * 256 + ch]; const float m = fmaxf(a0, a1), e0 = __expf(a0 - m), e1 = __expf(a1 - m); lbv = e1 / (e0 + e1); }
                    LBT[i] = lbv;
                }
            }
            s5_prep_unit(P, u0 >> 4, u0 & 15, smem); continue;
        }
        if (u0 < U_S5 + 64) {
            bf16_t* KB = (bf16_t*)(P.ws + OFF_KEYB);
            const size_t base = (size_t)(u0 - U_S5) * 8192;
            for (int i = tid; i < 8192; i += 256) KB[base + i] = f2bf(P.in[36][base + i]);
            continue;
        }
        if (u0 < U_S5 + U_KEY) {
            bf16_t* LW = (bf16_t*)(P.ws + OFF_LW);
            const int base = (u0 - U_S5 - 64) * 8192;
            for (int i = tid; i < 8192; i += 256) {
                const int o = base + i, which = o >> 17, e = o & 131071;
                float v;
                if (which < 2) { const int j = e & 63, c = (e >> 6) & 511, ld = e >> 15; v = P.in[which == 0 ? 26 : 28][((size_t)ld * 64 + j) * 512 + c]; }
                else if (which == 2) { const int j = e & 127, c = (e >> 7) & 511, ll = e >> 16; v = P.in[29][((size_t)ll * 128 + j) * 512 + c]; }
                else { const int k = e & 255, n = (e >> 8) & 255, ll = e >> 16; v = P.in[20][((size_t)ll * 256 + k) * 256 + n]; }
                LW[o] = f2bf(v);
            }
            continue;
        }
        const int u = u0 - U_S5 - U_KEY;
        if (u < U_MOD) {
            const int l = u / 96, j0 = (u % 96) * 64;
            float* sl = (float*)smem;
            for (int i = tid; i < 5 * 1024; i += 256) {
                const int r = i >> 10, k = i & 1023;
                const float cv = r < 4 ? P.in[1][r * 1024 + k] : P.in[3][k];
                sl[i] = siluf_(cv);
            }
            __syncthreads();
            float acc[5] = {0.f, 0.f, 0.f, 0.f, 0.f};
            const float* W = P.in[4] + (size_t)l * 1024 * 6144 + j0 + lane;
            for (int k = wave * 256; k < wave * 256 + 256; ++k) {
                const float w = W[(size_t)k * 6144];
#pragma unroll
                for (int r = 0; r < 5; ++r) acc[r] += sl[r * 1024 + k] * w;
            }
            float* red = (float*)(smem + 5 * 1024 * 4);
#pragma unroll
            for (int r = 0; r < 5; ++r) red[(wave * 5 + r) * 64 + lane] = acc[r];
            __syncthreads();
            for (int i = tid; i < 5 * 64; i += 256) {
                const int r = i / 64, jj = i % 64;
                float s = P.in[5][l * 6144 + j0 + jj];
                for (int w = 0; w < 4; ++w) s += red[(w * 5 + r) * 64 + jj];
                MOD[(l * 5 + r) * 6144 + j0 + jj] = s;
            }
        } else if (u < U_MOD + U_COPY) {
            const int r0 = (u - U_MOD) * 16;
            for (int i = tid; i < 16 * 256; i += 256) {
                const int row = r0 + (i >> 8), c4 = i & 255;
                const int b = row / LTOT, p = row % LTOT;
                const float4* src = p < CTX ? (const float4*)(P.in[2] + ((size_t)b * CTX + p) * DM) : (const float4*)(P.in[0] + ((size_t)b * SEQ + (p - CTX)) * DM);
                ((float4*)(XS + (size_t)row * DM))[c4] = src[c4];
            }
        } else {
            int v = u - U_MOD - U_COPY;
            const float* W; bf16_t* Wt; int N;
            if (v < U_TIN) { const int l = v / (16 * 54); v %= 16 * 54; N = PIN; W = P.in[6] + (size_t)l * 1024 * PIN; Wt = (bf16_t*)(P.ws + OFF_WIN) + (size_t)l * PIN * 1024; }
            else if (v < U_TIN + U_TOUT) { v -= U_TIN; const int l = v / 256; v %= 256; N = 1024; W = P.in[7] + (size_t)l * 1024 * 1024; Wt = (bf16_t*)(P.ws + OFF_WOUT) + (size_t)l * 1024 * 1024; }
            else { v -= U_TIN + U_TOUT; const int l = v / 512; v %= 512; N = 2048; W = P.in[35] + (size_t)l * 1024 * 2048; Wt = (bf16_t*)(P.ws + OFF_WQ) + (size_t)l * 2048 * 1024; }
            const int ntn = N / 64, kt = v / ntn, nt = v % ntn;
            float* t = (float*)smem;
            for (int i = tid; i < 64 * 64; i += 256) { const int kk = i >> 6, nn = i & 63; t[kk * 65 + nn] = W[(size_t)(kt * 64 + kk) * N + nt * 64 + nn]; }
            __syncthreads();
            for (int i = tid; i < 64 * 64; i += 256) { const int nn = i >> 6, kk = i & 63; Wt[(size_t)(nt * 64 + nn) * 1024 + kt * 64 + kk] = f2bf(t[kk * 65 + nn]); }
        }
    }
}

__device__ __forceinline__ void phase_mkh(const Params& P) {
    const int lane = otid() & 63, wave = __builtin_amdgcn_readfirstlane(otid() >> 6);
    const float* XS = (const float*)(P.ws + OFF_XS);
    const float* MOD = (const float*)(P.ws + OFF_MOD);
    bf16_t* H = (bf16_t*)(P.ws + OFF_H);
    for (int row = blockIdx.x * 4 + wave; row < MROWS; row += gridDim.x * 4) {
        const float* mod = MOD + (size_t)(0 * 5 + modrow(row)) * 6144;
#pragma unroll
        for (int j = 0; j < 4; ++j) {
            const int d = 256 * j + 4 * lane;
            const float4 x = *(const float4*)(XS + (size_t)row * DM + d);
            const float4 sh = *(const float4*)(mod + d), sc = *(const float4*)(mod + 1024 + d);
            ushort4 o;
            o.x = f2bf(x.x * (1.f + sc.x) + sh.x); o.y = f2bf(x.y * (1.f + sc.y) + sh.y);
            o.z = f2bf(x.z * (1.f + sc.z) + sh.z); o.w = f2bf(x.w * (1.f + sc.w) + sh.w);
            *(ushort4*)(H + (size_t)row * DM + d) = o;
        }
    }
}

template <class EPI>
__device__ __forceinline__ void gemm_bf16(const bf16_t* A, int lda, const bf16_t* Bt, int ldb, int M, int N, int K, bool skipctx, EPI epi) {
    const int lane = otid() & 63, wave = __builtin_amdgcn_readfirstlane(otid() >> 6);
    const int ntm = M / 128, ntn = N / 128;
    const int fr = lane & 15, fq = lane >> 4;
    for (int tile = blockIdx.x; tile < ntm * ntn; tile += gridDim.x) {
        const int tm = tile / ntn, tn = tile % ntn;
        const int m0 = tm * 128 + (wave >> 1) * 64, n0 = tn * 128 + (wave & 1) * 64;
        if (skipctx && (m0 % LTOT) < CTX) continue;
        f32x4 acc[4][4];
#pragma unroll
        for (int i = 0; i < 4; ++i)
#pragma unroll
            for (int j = 0; j < 4; ++j) acc[i][j] = (f32x4){0.f, 0.f, 0.f, 0.f};
        const bf16_t* ap = A + (size_t)(m0 + fr) * lda + 8 * fq;
        const bf16_t* bp = Bt + (size_t)(n0 + fr) * ldb + 8 * fq;
        for (int k0 = 0; k0 < K; k0 += 32) {
            bf16x8 a[4], b[4];
#pragma unroll
            for (int i = 0; i < 4; ++i) a[i] = *(const bf16x8*)(ap + (size_t)(16 * i) * lda + k0);
#pragma unroll
            for (int j = 0; j < 4; ++j) b[j] = *(const bf16x8*)(bp + (size_t)(16 * j) * ldb + k0);
#pragma unroll
            for (int i = 0; i < 4; ++i)
#pragma unroll
                for (int j = 0; j < 4; ++j) acc[i][j] = __builtin_amdgcn_mfma_f32_16x16x32_bf16(a[i], b[j], acc[i][j], 0, 0, 0);
        }
#pragma unroll
        for (int i = 0; i < 4; ++i)
#pragma unroll
            for (int j = 0; j < 4; ++j)
#pragma unroll
                for (int r = 0; r < 4; ++r) epi(m0 + 16 * i + 4 * fq + r, n0 + 16 * j + fr, acc[i][j][r]);
    }
}

typedef float f32x16 __attribute__((ext_vector_type(16)));
typedef unsigned u32x4 __attribute__((ext_vector_type(4)));
#define G2_LD 72
template <class EPI>
__device__ __forceinline__ void gemm2_bf16(const bf16_t* A, int lda, const bf16_t* Bt, int ldb, int M, int N, int K, bool skipctx, EPI epi, unsigned char* smem) {
    const int tid = otid(), lane = tid & 63, wave = __builtin_amdgcn_readfirstlane(tid >> 6);
    const int ntm = M / 128, ntn = N / 128;
    bf16_t* As = (bf16_t*)smem;
    bf16_t* Bs = As + 128 * G2_LD;
    const int lr = tid >> 3, lc = (tid & 7) * 8;
    const int wm = (wave >> 1) * 64, wn = (wave & 1) * 64;
    const int fr = lane & 31, fh = lane >> 5;
    for (int tile = blockIdx.x; tile < ntm * ntn; tile += gridDim.x) {
        const int tm = tile / ntn, tn = tile % ntn;
        if (skipctx && ((tm * 128) % LTOT) < CTX) continue;
        const bf16_t* ag = A + (size_t)(tm * 128 + lr) * lda + lc;
        const bf16_t* bg = Bt + (size_t)(tn * 128 + lr) * ldb + lc;
        f32x16 acc[2][2];
        {
            const f32x16 z16 = {0.f, 0.f, 0.f, 0.f, 0.f, 0.f, 0.f, 0.f, 0.f, 0.f, 0.f, 0.f, 0.f, 0.f, 0.f, 0.f};
            acc[0][0] = z16; acc[0][1] = z16; acc[1][0] = z16; acc[1][1] = z16;
        }
        u32x4 ra0[4], rb0[4], ra1[4], rb1[4];
#define G2_LOAD(RA, RB, kk_) { const int kq = (kk_) < K ? (kk_) : 0; _Pragma("unroll") for (int i = 0; i < 4; ++i) { RA[i] = *(const u32x4*)(ag + (size_t)(32 * i) * lda + kq); RB[i] = *(const u32x4*)(bg + (size_t)(32 * i) * ldb + kq); } }
#define G2_STORE(RA, RB) { _Pragma("unroll") for (int i = 0; i < 4; ++i) { *(u32x4*)(As + (lr + 32 * i) * G2_LD + lc) = RA[i]; *(u32x4*)(Bs + (lr + 32 * i) * G2_LD + lc) = RB[i]; } }
#define G2_COMPUTE() { _Pragma("unroll") for (int kk = 0; kk < 4; ++kk) { bf16x8 a[2], b[2]; \
            _Pragma("unroll") for (int i = 0; i < 2; ++i) a[i] = *(const bf16x8*)(As + (wm + 32 * i + fr) * G2_LD + 16 * kk + 8 * fh); \
            _Pragma("unroll") for (int j = 0; j < 2; ++j) b[j] = *(const bf16x8*)(Bs + (wn + 32 * j + fr) * G2_LD + 16 * kk + 8 * fh); \
            _Pragma("unroll") for (int i = 0; i < 2; ++i) _Pragma("unroll") for (int j = 0; j < 2; ++j) acc[i][j] = __builtin_amdgcn_mfma_f32_32x32x16_bf16(a[i], b[j], acc[i][j], 0, 0, 0); } }
        G2_LOAD(ra0, rb0, 0)
        G2_LOAD(ra1, rb1, 64)
        __syncthreads();
        G2_STORE(ra0, rb0)
        __syncthreads();
        G2_LOAD(ra0, rb0, 128)
        for (int k0 = 0; k0 < K; k0 += 128) {
            G2_COMPUTE()
            __syncthreads();
            G2_STORE(ra1, rb1)
            __syncthreads();
            G2_LOAD(ra1, rb1, k0 + 192)
            G2_COMPUTE()
            if (k0 + 128 < K) {
                __syncthreads();
                G2_STORE(ra0, rb0)
                __syncthreads();
                G2_LOAD(ra0, rb0, k0 + 256)
            }
        }
#undef G2_LOAD
#undef G2_STORE
#undef G2_COMPUTE
#pragma unroll
        for (int i = 0; i < 2; ++i)
#pragma unroll
            for (int j = 0; j < 2; ++j)
#pragma unroll
                for (int q = 0; q < 16; ++q) epi(tm * 128 + wm + 32 * i + (q & 3) + 8 * (q >> 2) + 4 * fh, tn * 128 + wn + 32 * j + fr, acc[i][j][q]);
    }
}

template <class EPI>
__device__ __forceinline__ void gemm3_bf16(const bf16_t* A, int lda, const bf16_t* Bt, int ldb, int M, int N, int K, bool skipctx, EPI epi, unsigned char* smem, int TMS, int TNS) {
    const int tid = otid(), lane = tid & 63, wave = __builtin_amdgcn_readfirstlane(tid >> 6);
    const int ntm = M / 128, ntn = N / 128, nkt = K / 64;
    const int wm = (wave >> 1) * 64, wn = (wave & 1) * 64;
    const int fr = lane & 31, fh = lane >> 5;
    const int rr = lane >> 3, cc = lane & 7;
    const int gcol = (cc ^ rr) * 8;
    const int nSm = (ntm + TMS - 1) / TMS, nSn = (ntn + TNS - 1) / TNS, S = TMS * TNS;
    const int xg = blockIdx.x & 7, lb = blockIdx.x >> 3, nlb = gridDim.x >> 3;
    for (int st = xg; st < nSm * nSn; st += 8)
    for (int t = lb; t < S; t += nlb) {
        const int tm = (st / nSn) * TMS + t % TMS, tn = (st % nSn) * TNS + t / TMS;
        if (tm >= ntm || tn >= ntn) continue;
        if (skipctx && ((tm * 128) % LTOT) < CTX) continue;
        const bf16_t* ag = A + (size_t)(tm * 128 + 32 * wave + rr) * lda + gcol;
        const bf16_t* bg = Bt + (size_t)(tn * 128 + 32 * wave + rr) * ldb + gcol;
        f32x16 acc[2][2];
        {
            const f32x16 z16 = {0.f, 0.f, 0.f, 0.f, 0.f, 0.f, 0.f, 0.f, 0.f, 0.f, 0.f, 0.f, 0.f, 0.f, 0.f, 0.f};
            acc[0][0] = z16; acc[0][1] = z16; acc[1][0] = z16; acc[1][1] = z16;
        }
#define G3_ISSUE(kt_, b_) { unsigned char* la_ = smem + (b_) * 32768 + (32 * wave) * 128; unsigned char* lb_ = la_ + 16384; \
            _Pragma("unroll") for (int q = 0; q < 4; ++q) { \
                __builtin_amdgcn_global_load_lds((const unsigned*)(ag + (size_t)(8 * q) * lda + (kt_) * 64), (LAS unsigned*)(la_ + q * 1024), 16, 0, 0); \
                __builtin_amdgcn_global_load_lds((const unsigned*)(bg + (size_t)(8 * q) * ldb + (kt_) * 64), (LAS unsigned*)(lb_ + q * 1024), 16, 0, 0); } }
        __syncthreads();
        G3_ISSUE(0, 0)
        asm volatile("s_waitcnt vmcnt(0)" ::: "memory");
        __syncthreads();
        for (int kt = 0; kt < nkt; ++kt) {
            if (kt + 1 < nkt) G3_ISSUE(kt + 1, (kt + 1) & 1)
            const unsigned char* As = smem + (kt & 1) * 32768;
            const unsigned char* Bs = As + 16384;
#pragma unroll
            for (int kk = 0; kk < 4; ++kk) {
                bf16x8 a[2], b[2];
#pragma unroll
                for (int i = 0; i < 2; ++i) { const int r = wm + 32 * i + fr; a[i] = *(const bf16x8*)(As + r * 128 + (((2 * kk + fh) ^ (r & 7)) << 4)); }
#pragma unroll
                for (int j = 0; j < 2; ++j) { const int r = wn + 32 * j + fr; b[j] = *(const bf16x8*)(Bs + r * 128 + (((2 * kk + fh) ^ (r & 7)) << 4)); }
#pragma unroll
                for (int i = 0; i < 2; ++i)
#pragma unroll
                    for (int j = 0; j < 2; ++j) acc[i][j] = __builtin_amdgcn_mfma_f32_32x32x16_bf16(b[j], a[i], acc[i][j], 0, 0, 0);
            }
            asm volatile("s_waitcnt vmcnt(0)" ::: "memory");
            __syncthreads();
        }
#undef G3_ISSUE
#pragma unroll
        for (int i = 0; i < 2; ++i)
#pragma unroll
            for (int j = 0; j < 2; ++j)
#pragma unroll
                for (int g = 0; g < 4; ++g)
                    epi.store4(tm * 128 + wm + 32 * i + fr, tn * 128 + wn + 32 * j + 8 * g + 4 * fh, acc[i][j][4 * g], acc[i][j][4 * g + 1], acc[i][j][4 * g + 2], acc[i][j][4 * g + 3]);
    }
}
struct Epi4Bf16 { bf16_t* C; int ldc;
    __device__ __forceinline__ void store4(int r, int c, float v0, float v1, float v2, float v3) const {
        *(uint2*)(C + (size_t)r * ldc + c) = make_uint2(f2bf(v0) | ((unsigned)f2bf(v1) << 16), f2bf(v2) | ((unsigned)f2bf(v3) << 16)); } };
struct Epi4F32 { float* C; int ldc;
    __device__ __forceinline__ void store4(int r, int c, float v0, float v1, float v2, float v3) const { *(f32x4*)(C + (size_t)r * ldc + c) = (f32x4){v0, v1, v2, v3}; } };
struct Epi4Inproj { bf16_t* C; const float* lbt; bf16_t* hgt;
    __device__ __forceinline__ float tr(int c, float v) const {
        if (c >= 256 && c < 1536) {
            if (c < 512 || c >= 1280) v = siluf_(v);
            else if (c >= 768) { const float lb = lbt[c - 768]; v = __logf(lb + (1.f - lb) * sigmoidf_(v)); }
        }
        return v;
    }
    __device__ __forceinline__ void store4(int r, int c, float v0, float v1, float v2, float v3) const {
        v0 = tr(c, v0); v1 = tr(c + 1, v1); v2 = tr(c + 2, v2); v3 = tr(c + 3, v3);
        if (c >= 256 && c < 1280) {
            const int e = c - 256, f = e >> 8, hd = (e >> 6) & 3, ch = e & 63;
            bf16_t* d = hgt + ((((size_t)(r >> 4) * 4 + hd) * 4 + f) * 64 + ch) * 16 + (r & 15);
            d[0] = f2bf(v0); d[16] = f2bf(v1); d[32] = f2bf(v2); d[48] = f2bf(v3);
        } else
            *(uint2*)(C + (size_t)r * PIN + c) = make_uint2(pk2bf(v0, v1), pk2bf(v2, v3));
    } };
struct EpiInproj {
    bf16_t* C; const float* lbt;
    __device__ __forceinline__ void operator()(int r, int c, float v) const {
        if (c >= 256 && c < 1536) {
            if (c < 512 || c >= 1280) v = siluf_(v);
            else if (c >= 768) { const float lb = lbt[c - 768]; v = __logf(lb + (1.f - lb) * sigmoidf_(v)); }
        }
        C[(size_t)r * PIN + c] = f2bf(v);
    }
};
struct EpiBf16 { bf16_t* C; int ldc; __device__ __forceinline__ void operator()(int r, int c, float v) const { C[(size_t)r * ldc + c] = f2bf(v); } };
struct EpiF32 { float* C; int ldc; __device__ __forceinline__ void operator()(int r, int c, float v) const { C[(size_t)r * ldc + c] = v; } };

__device__ __forceinline__ void phase_rwprep(const Params& P, int l, unsigned char* smem) {
    const int tid = otid();
    const bf16_t* Pb = (const bf16_t*)(P.ws + OFF_P);
    bf16_t* RW = (bf16_t*)(P.ws + OFF_RW);
    const float* mu = P.in[24] + l * 1920;
    const float* k_k = P.in[30] + l * 512;
    float* tw = (float*)smem;
    float* al = tw + 2 * 8 * 64;
    float* kk2 = al + 2 * 8 * 64;
    float* nrm = kk2 + 8 * 512;
    for (int u = blockIdx.x; u < MROWS / 8; u += gridDim.x) {
        const int r0 = u * 8;
        __syncthreads();
        for (int i = 0; i < 8; ++i) {
            const int row = r0 + i, p = row % LTOT;
            int nb[4]; bool ok[4];
            if (p < CTX) {
                nb[0] = row - 1; ok[0] = p > 0; nb[1] = row + 1; ok[1] = p < CTX - 1; nb[2] = nb[0]; ok[2] = ok[0]; nb[3] = nb[1]; ok[3] = ok[1];
            } else {
                const int t = p - CTX, gr = t >> 6, gc = t & 63;
                nb[0] = row - 1; ok[0] = gc > 0; nb[1] = row + 1; ok[1] = gc < 63; nb[2] = row - 64; ok[2] = gr > 0; nb[3] = row + 64; ok[3] = gr < 63;
            }
            for (int c = tid; c < 1920; c += 256) {
                const int m = c & 3;
                const float pv = bf2f(Pb[(size_t)row * PIN + 1536 + c]);
                const float nv = ok[m] ? bf2f(Pb[(size_t)nb[m] * PIN + 1536 + c]) : 0.f;
                const float s = pv + mu[c] * (nv - pv);
                bf16_t* rw = RW + (size_t)row * RWW;
                if (c < 512) rw[c] = f2bf(s);
                else if (c < 1024) { rw[c] = f2bf(s); kk2[i * 512 + (c - 512)] = s * k_k[c - 512]; }
                else if (c < 1536) rw[c] = f2bf(s);
                else if (c < 1664) rw[4096 + (c - 1536)] = f2bf(sigmoidf_(s));
                else if (c < 1728) tw[(0 * 8 + i) * 64 + (c - 1664)] = tanhf(s);
                else if (c < 1792) tw[(1 * 8 + i) * 64 + (c - 1728)] = tanhf(s);
                else if (c < 1856) al[(0 * 8 + i) * 64 + (c - 1792)] = s;
                else al[(1 * 8 + i) * 64 + (c - 1856)] = s;
            }
        }
        __syncthreads();
        {
            const int pair = tid >> 2, q = tid & 3, i = pair >> 3, hd = pair & 7;
            float s = 0.f;
            for (int j = 0; j < 16; ++j) { const float v = kk2[i * 512 + hd * 64 + q * 16 + j]; s += v * v; }
            s += __shfl_xor(s, 1, 64); s += __shfl_xor(s, 2, 64);
            if (q == 0) nrm[pair] = fmaxf(sqrtf(s), 1e-12f);
        }
        __syncthreads();
        for (int e = tid; e < 8 * 512; e += 256) {
            const int i = e >> 9, c = e & 511;
            RW[(size_t)(r0 + i) * RWW + 1536 + c] = f2bf(kk2[e] / nrm[i * 8 + (c >> 6)]);
        }
        for (int d = 0; d < 2; ++d) {
            const float* wup = P.in[26] + (size_t)(l * 2 + d) * 64 * 512;
            const float* aup = P.in[28] + (size_t)(l * 2 + d) * 64 * 512;
            const float* w0 = P.in[25] + (l * 2 + d) * 512;
            const float* a0 = P.in[27] + (l * 2 + d) * 512;
            float zw[2][8], za[2][8];
#pragma unroll
            for (int i = 0; i < 8; ++i) { zw[0][i] = zw[1][i] = za[0][i] = za[1][i] = 0.f; }
            for (int j = 0; j < 64; ++j) {
                const float w_0 = wup[j * 512 + tid], w_1 = wup[j * 512 + tid + 256];
                const float a_0 = aup[j * 512 + tid], a_1 = aup[j * 512 + tid + 256];
#pragma unroll
                for (int i = 0; i < 8; ++i) {
                    const float t = tw[(d * 8 + i) * 64 + j], a = al[(d * 8 + i) * 64 + j];
                    zw[0][i] += t * w_0; zw[1][i] += t * w_1; za[0][i] += a * a_0; za[1][i] += a * a_1;
                }
            }
#pragma unroll
            for (int i = 0; i < 8; ++i) {
                bf16_t* rw = RW + (size_t)(r0 + i) * RWW;
#pragma unroll
                for (int h = 0; h < 2; ++h) {
                    const int c = tid + 256 * h;
                    rw[2048 + d * 512 + c] = f2bf(sigmoidf_(a0[c] + za[h][i]));
                    rw[3072 + d * 512 + c] = f2bf(-0.60653066f * sigmoidf_(w0[c] + zw[h][i]));
                }
            }
        }
    }
}

__device__ __forceinline__ void scan_rwkv(const Params& P, int l, int item) {
    const int lane = otid() & 63;
    const int dir = item & 1, hd = (item >> 1) & 7, b = item >> 4;
    const bf16_t* RW = (const bf16_t*)(P.ws + OFF_RW);
    bf16_t* YP = (bf16_t*)(P.ws + OFF_YP) + (size_t)dir * MROWS * DM;
    const float ka = P.in[31][l * 512 + hd * 64 + lane];
    float S[64];
#pragma unroll
    for (int k = 0; k < 64; ++k) S[k] = 0.f;
    for (int tau = 0; tau < LTOT; ++tau) {
        const int row = row_of(b, dir, tau);
#ifdef EXP_T2
        if ((tau & 127) == 0) {
            float* RXL = (float*)(P.ws + OFF_RXL);
            const size_t itm = (size_t)item * 34 + (tau >> 7);
#pragma unroll
            for (int kk = 0; kk < 64; ++kk) RXL[((itm * 16 + (kk >> 4) * 4 + (lane >> 4)) * 64 + ((kk >> 2) & 3) * 16 + (lane & 15)) * 4 + (kk & 3)] = S[kk];
        }
#endif
        const bf16_t* rw = RW + (size_t)row * RWW + hd * 64 + lane;
        const float r = bf2f(rw[0]), k = bf2f(rw[512]), v = bf2f(rw[1024]), kap = bf2f(rw[1536]);
        const float a = bf2f(rw[2048 + dir * 512]), lw = bf2f(rw[3072 + dir * 512]);
        const float w = __expf(lw), kt = k * (1.f + (a - 1.f) * ka), beta = kap * a;
        float sk = 0.f;
#pragma unroll
        for (int kk = 0; kk < 64; ++kk) { sk += S[kk] * rdlane(kap, kk); if ((kk & 7) == 7) __builtin_amdgcn_sched_barrier(0); }
        float y = 0.f;
#pragma unroll
        for (int kk = 0; kk < 64; ++kk) {
            const float s = S[kk] * rdlane(w, kk) - sk * rdlane(beta, kk) + v * rdlane(kt, kk);
            S[kk] = s;
            y += s * rdlane(r, kk);
            if ((kk & 3) == 3) __builtin_amdgcn_sched_barrier(0);
        }
        YP[(size_t)row * DM + 512 + hd * 64 + lane] = f2bf(y);
    }
}
__device__ __forceinline__ void scan_hgrn(const Params& P, int l, int item) {
    const int lane = otid() & 63;
    const int dir = item & 1, hd = (item >> 1) & 3, b = item >> 3;
    const bf16_t* Pb = (const bf16_t*)(P.ws + OFF_P);
    bf16_t* YP = (bf16_t*)(P.ws + OFF_YP) + (size_t)dir * MROWS * DM;
    float lb = 0.f;
    if (l == 1) {
        const float a0 = P.in[22][(dir * 2 + 0) * 256 + hd * 64 + lane], a1 = P.in[22][(dir * 2 + 1) * 256 + hd * 64 + lane];
        const float m = fmaxf(a0, a1), e0 = __expf(a0 - m), e1 = __expf(a1 - m);
        lb = e1 / (e0 + e1);
    }
    float S[64];
#pragma unroll
    for (int k = 0; k < 64; ++k) S[k] = 0.f;
    for (int tau = 0; tau < LTOT; ++tau) {
        const int row = row_of(b, dir, tau);
        const bf16_t* pr = Pb + (size_t)row * PIN + 256 + hd * 64 + lane;
        const float q = siluf_(bf2f(pr[0])), v = bf2f(pr[256]);
        const float f = lb + (1.f - lb) * sigmoidf_(bf2f(pr[512 + dir * 256]));
        const float kq = 1.f - f;
        float o = 0.f;
#pragma unroll
        for (int dk = 0; dk < 64; ++dk) {
            const float s = rdlane(f, dk) * S[dk] + rdlane(kq, dk) * v;
            S[dk] = s;
            o += s * rdlane(q, dk);
            if ((dk & 7) == 7) __builtin_amdgcn_sched_barrier(0);
        }
        YP[(size_t)row * DM + 256 + hd * 64 + lane] = f2bf(o);
    }
}
__device__ __forceinline__ void scan_s5(const Params& P, int l, int item) {
    const int lane = otid() & 63;
    const int dir = item & 1, g = (item >> 1) & 15, b = item >> 5;
    const bf16_t* Pb = (const bf16_t*)(P.ws + OFF_P);
    bf16_t* YP = (bf16_t*)(P.ws + OFF_YP) + (size_t)dir * MROWS * DM;
    const int ldg = (l * 2 + dir) * 16 + g;
    const float dt = expf(P.in[14][ldg]);
    const float lre = P.in[12][ldg * 64 + lane], lim = P.in[13][ldg * 64 + lane];
    const float mag = expf(lre * dt), ang = lim * dt;
    const float lb_re = mag * cosf(ang), lb_im = mag * sinf(ang);
    const float den = lre * lre + lim * lim, nr = lb_re - 1.f, ni = lb_im;
    const float co_re = (nr * lre + ni * lim) / den, co_im = (ni * lre - nr * lim) / den;
    float bb_re[16], bb_im[16], c_re[16], c_im[16];
#pragma unroll
    for (int h = 0; h < 16; ++h) {
        const float br = P.in[15][((size_t)ldg * 64 + lane) * 16 + h], bi = P.in[16][((size_t)ldg * 64 + lane) * 16 + h];
        bb_re[h] = co_re * br - co_im * bi; bb_im[h] = co_re * bi + co_im * br;
        c_re[h] = P.in[17][((size_t)ldg * 16 + h) * 64 + lane]; c_im[h] = P.in[18][((size_t)ldg * 16 + h) * 64 + lane];
    }
    float s_re = 0.f, s_im = 0.f;
    for (int tau = 0; tau < LTOT; ++tau) {
        const int row = row_of(b, dir, tau);
        const float uv = bf2f(Pb[(size_t)row * PIN + g * 16 + (lane & 15)]);
        float bu_re = 0.f, bu_im = 0.f;
#pragma unroll
        for (int h = 0; h < 16; ++h) { const float uh = rdlane(uv, h); bu_re += bb_re[h] * uh; bu_im += bb_im[h] * uh; }
        const float n_re = lb_re * s_re - lb_im * s_im + bu_re, n_im = lb_re * s_im + lb_im * s_re + bu_im;
        s_re = n_re; s_im = n_im;
        float yo = 0.f;
#pragma unroll
        for (int h = 0; h < 16; ++h) { const float t = wave_sum(c_re[h] * s_re - c_im[h] * s_im); yo = (lane == h) ? t : yo; }
        if (lane < 16) YP[(size_t)row * DM + g * 16 + lane] = f2bf(yo);
    }
}
__device__ __forceinline__ void phase_scans(const Params& P, int l) {
    const int wave = __builtin_amdgcn_readfirstlane(otid() >> 6);
    for (int it = wave * gridDim.x + blockIdx.x; it < 32; it += 4 * gridDim.x) scan_hgrn(P, l, it);
}

__device__ __forceinline__ void phase_post(const Params& P, int l, unsigned char* smem) {
    const int tid = otid();
    const bf16_t* Pb = (const bf16_t*)(P.ws + OFF_P);
    const bf16_t* RW = (const bf16_t*)(P.ws + OFF_RW);
    const bf16_t* YF = (const bf16_t*)(P.ws + OFF_YP);
    const bf16_t* YB = YF + (size_t)MROWS * DM;
    bf16_t* MIX = (bf16_t*)(P.ws + OFF_MIX);
    float* ypre = (float*)smem;
    float* sg = ypre + 8 * 256;
    for (int u = blockIdx.x; u < MROWS / 8; u += gridDim.x) {
        const int r0 = u * 8;
        if (l == 1 && (r0 % LTOT) < CTX) continue;
        __syncthreads();
        for (int i = 0; i < 8; ++i) {
            const int row = r0 + i;
            ypre[i * 256 + tid] = bf2f(YF[(size_t)row * DM + tid]);
        }
        for (int e = tid; e < 8 * 128; e += 256) sg[e] = bf2f(RW[(size_t)(r0 + (e >> 7)) * RWW + 4096 + (e & 127)]);
        __syncthreads();
        {
            float z[8];
            const float gb = P.in[21][l * 256 + tid];
#pragma unroll
            for (int i = 0; i < 8; ++i) z[i] = gb;
            const float* gw = P.in[20] + (size_t)l * 256 * 256 + tid;
            for (int k = 0; k < 256; ++k) {
                const float w = gw[k * 256];
#pragma unroll
                for (int i = 0; i < 8; ++i) z[i] += ypre[i * 256 + k] * w;
            }
#pragma unroll
            for (int i = 0; i < 8; ++i) MIX[(size_t)(r0 + i) * DM + tid] = f2bf(ypre[i * 256 + tid] * sigmoidf_(z[i]));
        }
        {
            const int i = tid >> 5, c0 = (tid & 31) * 8, row = r0 + i;
            float o[8], ss = 0.f;
#pragma unroll
            for (int j = 0; j < 8; ++j) { o[j] = bf2f(YF[(size_t)row * DM + 256 + c0 + j]) + bf2f(YB[(size_t)row * DM + 256 + c0 + j]); ss += o[j] * o[j]; }
            ss += __shfl_xor(ss, 1, 64); ss += __shfl_xor(ss, 2, 64); ss += __shfl_xor(ss, 4, 64);
            const float rs = rsqrtf(ss * (1.f / 64.f) + 1e-6f);
#pragma unroll
            for (int j = 0; j < 8; ++j) {
                const float gr = bf2f(Pb[(size_t)row * PIN + 256 + 1024 + c0 + j]);
                MIX[(size_t)row * DM + 256 + c0 + j] = f2bf(o[j] * rs * P.in[23][l * 256 + c0 + j] * siluf_(gr));
            }
        }
        {
            const int i = tid >> 5, c0 = (tid & 31) * 16, row = r0 + i;
            const bf16_t* rw = RW + (size_t)row * RWW;
            float y[16], vv[16], sum = 0.f, bon = 0.f;
#pragma unroll
            for (int j = 0; j < 16; ++j) {
                const int c = c0 + j;
                y[j] = bf2f(YF[(size_t)row * DM + 512 + c]) + bf2f(YB[(size_t)row * DM + 512 + c]);
                sum += y[j];
                const float r = bf2f(rw[c]), k = bf2f(rw[512 + c]), af = bf2f(rw[2048 + c]), ab = bf2f(rw[2560 + c]);
                const float ka = P.in[31][l * 512 + c];
                vv[j] = bf2f(rw[1024 + c]);
                bon += r * P.in[32][l * 512 + c] * (k * (1.f + (af - 1.f) * ka) + k * (1.f + (ab - 1.f) * ka));
            }
            sum += __shfl_xor(sum, 1, 64); sum += __shfl_xor(sum, 2, 64);
            bon += __shfl_xor(bon, 1, 64); bon += __shfl_xor(bon, 2, 64);
            const float mean = sum * (1.f / 64.f);
            float var = 0.f;
#pragma unroll
            for (int j = 0; j < 16; ++j) { const float d = y[j] - mean; var += d * d; }
            var += __shfl_xor(var, 1, 64); var += __shfl_xor(var, 2, 64);
            const float rs = rsqrtf(var * (1.f / 64.f) + 64e-5f);
            float g[16];
#pragma unroll
            for (int j = 0; j < 16; ++j) g[j] = 0.f;
            const float* gup = P.in[29] + (size_t)l * 128 * 512 + c0;
            for (int jj = 0; jj < 128; ++jj) {
                const float s = sg[i * 128 + jj];
                const float4 w0 = *(const float4*)(gup + jj * 512), w1 = *(const float4*)(gup + jj * 512 + 4), w2 = *(const float4*)(gup + jj * 512 + 8), w3 = *(const float4*)(gup + jj * 512 + 12);
                g[0] += s * w0.x; g[1] += s * w0.y; g[2] += s * w0.z; g[3] += s * w0.w;
                g[4] += s * w1.x; g[5] += s * w1.y; g[6] += s * w1.z; g[7] += s * w1.w;
                g[8] += s * w2.x; g[9] += s * w2.y; g[10] += s * w2.z; g[11] += s * w2.w;
                g[12] += s * w3.x; g[13] += s * w3.y; g[14] += s * w3.z; g[15] += s * w3.w;
            }
#pragma unroll
            for (int j = 0; j < 16; ++j) {
                const int c = c0 + j;
                const float yn = (y[j] - mean) * rs * P.in[33][l * 512 + c] + P.in[34][l * 512 + c];
                MIX[(size_t)row * DM + 512 + c] = f2bf((yn + bon * vv[j]) * g[j]);
            }
        }
    }
}

__device__ __forceinline__ void phase_ln1(const Params& P, int l) {
    const int lane = otid() & 63, wave = __builtin_amdgcn_readfirstlane(otid() >> 6);
    float* XS = (float*)(P.ws + OFF_XS);
    const float* TMP = (const float*)(P.ws + OFF_TMP);
    const float* MOD = (const float*)(P.ws + OFF_MOD);
    bf16_t* H2 = (bf16_t*)(P.ws + OFF_H2);
    for (int row = blockIdx.x * 4 + wave; row < MROWS; row += gridDim.x * 4) {
        if (l == 1 && (row % LTOT) < CTX) continue;
        const float* mod = MOD + (size_t)(l * 5 + modrow(row)) * 6144;
        float v[16]; float s = 0.f;
#pragma unroll
        for (int j = 0; j < 4; ++j) {
            const int d = 256 * j + 4 * lane;
            const float4 x = *(const float4*)(XS + (size_t)row * DM + d), t = *(const float4*)(TMP + (size_t)row * DM + d), g = *(const float4*)(mod + 2048 + d);
            v[4 * j + 0] = ALPHA * x.x + g.x * t.x; v[4 * j + 1] = ALPHA * x.y + g.y * t.y; v[4 * j + 2] = ALPHA * x.z + g.z * t.z; v[4 * j + 3] = ALPHA * x.w + g.w * t.w;
            s += v[4 * j] + v[4 * j + 1] + v[4 * j + 2] + v[4 * j + 3];
        }
        const float mean = wave_sum(s) * (1.f / 1024.f);
        float q = 0.f;
#pragma unroll
        for (int j = 0; j < 16; ++j) { const float d = v[j] - mean; q += d * d; }
        const float rs = rsqrtf(wave_sum(q) * (1.f / 1024.f) + 1e-5f);
#pragma unroll
        for (int j = 0; j < 4; ++j) {
            const int d = 256 * j + 4 * lane;
            const float4 gg = *(const float4*)(P.in[8] + l * 1024 + d), bb = *(const float4*)(P.in[9] + l * 1024 + d);
            const float4 sh = *(const float4*)(mod + 3072 + d), sc = *(const float4*)(mod + 4096 + d);
            float4 o;
            o.x = (v[4 * j + 0] - mean) * rs * gg.x + bb.x; o.y = (v[4 * j + 1] - mean) * rs * gg.y + bb.y;
            o.z = (v[4 * j + 2] - mean) * rs * gg.z + bb.z; o.w = (v[4 * j + 3] - mean) * rs * gg.w + bb.w;
            *(float4*)(XS + (size_t)row * DM + d) = o;
            ushort4 h;
            h.x = f2bf(o.x * (1.f + sc.x) + sh.x); h.y = f2bf(o.y * (1.f + sc.y) + sh.y); h.z = f2bf(o.z * (1.f + sc.z) + sh.z); h.w = f2bf(o.w * (1.f + sc.w) + sh.w);
            *(ushort4*)(H2 + (size_t)row * DM + d) = h;
        }
    }
}

__device__ __forceinline__ unsigned f2ord(float f) { const unsigned u = __float_as_uint(f); return u ^ ((u >> 31) ? 0xFFFFFFFFu : 0x80000000u); }
__device__ __forceinline__ float ord2f(unsigned u) { return __uint_as_float((u >> 31) ? (u ^ 0x80000000u) : ~u); }
__device__ __forceinline__ void phase_topk(const Params& P, int l) {
    const int tid = otid();
    const bf16_t* Q = (const bf16_t*)(P.ws + OFF_Q);
    int* IDX = (int*)(P.ws + OFF_IDX);
    float* GATE = (float*)(P.ws + OFF_GATE);
    for (int u = blockIdx.x; u < 8 * (MROWS / 256); u += gridDim.x) {
        const int hd = u / (MROWS / 256), rb = u % (MROWS / 256);
        const int row = rb * 256 + tid;
        if (l == 1 && (row % LTOT) < CTX) continue;
        unsigned top[2][16];
#pragma unroll
        for (int half = 0; half < 2; ++half) {
            float q[128];
            const bf16_t* qp = Q + (size_t)row * 2048 + hd * 256 + half * 128;
#pragma unroll
            for (int d8 = 0; d8 < 16; ++d8) {
                const bf16x8 v = *(const bf16x8*)(qp + d8 * 8);
#pragma unroll
                for (int j = 0; j < 8; ++j) q[d8 * 8 + j] = bf2f((bf16_t)v[j]);
            }
#pragma unroll
            for (int j = 0; j < 16; ++j) top[half][j] = 0u;
            const float* kp = P.in[36] + ((size_t)((l * 8 + hd) * 2 + half)) * 128 * 128;
            for (int key = 0; key < 128; ++key) {
                const float* kr = kp + key * 128;
                float s0 = 0.f, s1 = 0.f, s2 = 0.f, s3 = 0.f;
#pragma unroll
                for (int d = 0; d < 128; d += 4) { s0 += q[d] * kr[d]; s1 += q[d + 1] * kr[d + 1]; s2 += q[d + 2] * kr[d + 2]; s3 += q[d + 3] * kr[d + 3]; if ((d & 31) == 28) __builtin_amdgcn_sched_barrier(0); }
                unsigned x = (f2ord((s0 + s1) + (s2 + s3)) & 0xFFFFFF80u) | (unsigned)(127 - key);
#pragma unroll
                for (int j = 0; j < 16; ++j) { const unsigned t = top[half][j]; const unsigned mx = x > t ? x : t; x = x > t ? t : x; top[half][j] = mx; }
            }
        }
        float cs[16]; int ce[16];
#pragma unroll
        for (int j = 0; j < 16; ++j) { cs[j] = -3.0e38f; ce[j] = 0; }
#pragma unroll
        for (int i = 0; i < 16; ++i) {
            const float s1v = ord2f(top[0][i] & 0xFFFFFF80u); const int i1 = 127 - (int)(top[0][i] & 127u);
#pragma unroll
            for (int j = 0; j < 16; ++j) {
                if ((i + 1) * (j + 1) <= 16) {
                    float x = s1v + ord2f(top[1][j] & 0xFFFFFF80u); int xe = i1 * 128 + (127 - (int)(top[1][j] & 127u));
#pragma unroll
                    for (int t = 0; t < 16; ++t) {
                        const bool gt = x > cs[t];
                        const float ts = cs[t]; const int te = ce[t];
                        cs[t] = gt ? x : ts; ce[t] = gt ? xe : te; x = gt ? ts : x; xe = gt ? te : xe;
                    }
                }
            }
        }
        float den = 0.f, ex[16];
#pragma unroll
        for (int t = 0; t < 16; ++t) { ex[t] = __expf(cs[t] - cs[0]); den += ex[t]; }
        const float inv = 1.f / den;
#pragma unroll
        for (int t = 0; t < 16; ++t) { IDX[(size_t)row * 128 + hd * 16 + t] = ce[t]; GATE[(size_t)row * 128 + hd * 16 + t] = ex[t] * inv; }
    }
}


__device__ __forceinline__ void ce_desc(unsigned& a, unsigned& b) { const unsigned hi = a > b ? a : b, lo = a > b ? b : a; a = hi; b = lo; }
__device__ __forceinline__ void bitonic_sort16(unsigned (&u)[16]) {
#pragma unroll
    for (int k = 2; k <= 16; k <<= 1)
#pragma unroll
        for (int j = k >> 1; j > 0; j >>= 1)
#pragma unroll
            for (int i = 0; i < 16; ++i) {
                const int p = i ^ j;
                if (p > i) { if ((i & k) == 0) ce_desc(u[i], u[p]); else ce_desc(u[p], u[i]); }
            }
}
__device__ __forceinline__ void bitonic_merge16(unsigned (&u)[16]) {
#pragma unroll
    for (int j = 8; j > 0; j >>= 1)
#pragma unroll
        for (int i = 0; i < 16; ++i) { const int p = i ^ j; if (p > i) ce_desc(u[i], u[p]); }
}
__device__ __forceinline__ void xlane_top16(unsigned (&u)[16], int xr) {
    unsigned o[16];
#pragma unroll
    for (int i = 0; i < 16; ++i) o[i] = (unsigned)__shfl_xor((int)u[15 - i], xr, 64);
#pragma unroll
    for (int i = 0; i < 16; ++i) u[i] = u[i] > o[i] ? u[i] : o[i];
    bitonic_merge16(u);
}
__device__ __forceinline__ void phase_topk2(const Params& P, int l, unsigned char* smem) {
    const int lane = otid() & 63, wave = __builtin_amdgcn_readfirstlane(otid() >> 6), fr = lane & 15, fq = lane >> 4;
    const bf16_t* Q = (const bf16_t*)(P.ws + OFF_Q);
    const bf16_t* KB = (const bf16_t*)(P.ws + OFF_KEYB);
    int* IDX = (int*)(P.ws + OFF_IDX);
    float* GATE = (float*)(P.ws + OFF_GATE);
    unsigned char* ids = smem + wave * 512;
    for (int it = blockIdx.x * 4 + wave; it < (MROWS / 16) * 8; it += gridDim.x * 4) {
        const int rt = it >> 3, hd = it & 7, row0 = rt * 16;
        if (l == 1 && (row0 % LTOT) < CTX) continue;
        unsigned top[2][16];
#pragma unroll
        for (int half = 0; half < 2; ++half) {
            f32x4 acc[8];
#pragma unroll
            for (int mi = 0; mi < 8; ++mi) acc[mi] = (f32x4){0.f, 0.f, 0.f, 0.f};
            const bf16_t* kp = KB + ((size_t)((l * 8 + hd) * 2 + half) * 128 + fr) * 128 + 8 * fq;
            const bf16_t* qp = Q + (size_t)(row0 + fr) * 2048 + hd * 256 + half * 128 + 8 * fq;
#pragma unroll
            for (int ks = 0; ks < 4; ++ks) {
                const bf16x8 qb = *(const bf16x8*)(qp + 32 * ks);
#pragma unroll
                for (int mi = 0; mi < 8; ++mi) acc[mi] = mfma32(*(const bf16x8*)(kp + (size_t)(16 * mi) * 128 + 32 * ks), qb, acc[mi]);
            }
            unsigned ua[16], ub[16];
#pragma unroll
            for (int mi = 0; mi < 4; ++mi)
#pragma unroll
                for (int r = 0; r < 4; ++r) {
                    ua[mi * 4 + r] = (f2ord(acc[mi][r]) & 0xFFFFFF80u) | (unsigned)(127 - (16 * mi + 4 * fq + r));
                    ub[mi * 4 + r] = (f2ord(acc[mi + 4][r]) & 0xFFFFFF80u) | (unsigned)(127 - (16 * (mi + 4) + 4 * fq + r));
                }
            bitonic_sort16(ua); bitonic_sort16(ub);
#pragma unroll
            for (int i = 0; i < 16; ++i) ua[i] = ua[i] > ub[15 - i] ? ua[i] : ub[15 - i];
            bitonic_merge16(ua);
            xlane_top16(ua, 16); xlane_top16(ua, 32);
#pragma unroll
            for (int i = 0; i < 16; ++i) top[half][i] = ua[i];
        }
        if (fq == 0) {
            unsigned w[8];
#pragma unroll
            for (int i = 0; i < 8; ++i) {
                const unsigned* t = i < 4 ? &top[0][4 * i] : &top[1][4 * (i - 4)];
                w[i] = (127u - (t[0] & 127u)) | ((127u - (t[1] & 127u)) << 8) | ((127u - (t[2] & 127u)) << 16) | ((127u - (t[3] & 127u)) << 24);
            }
            *(uint4*)(ids + fr * 32) = make_uint4(w[0], w[1], w[2], w[3]);
            *(uint4*)(ids + fr * 32 + 16) = make_uint4(w[4], w[5], w[6], w[7]);
        }
        float s2v[16];
#pragma unroll
        for (int j = 0; j < 16; ++j) s2v[j] = ord2f(top[1][j] & 0xFFFFFF80u);
        float s1r[4];
#pragma unroll
        for (int m = 0; m < 4; ++m) {
            const unsigned t = fq == 0 ? top[0][4 * m] : (fq == 1 ? top[0][4 * m + 1] : (fq == 2 ? top[0][4 * m + 2] : top[0][4 * m + 3]));
            s1r[m] = ord2f(t & 0xFFFFFF80u);
        }
        unsigned cu[16];
#pragma unroll
        for (int j = 0; j < 16; ++j) cu[j] = (f2ord(s1r[0] + s2v[j]) & 0xFFFFFF00u) | (unsigned)((fq << 4) | j);
        {
            unsigned ex[5];
            ex[0] = (f2ord(s1r[1] + s2v[0]) & 0xFFFFFF00u) | (unsigned)(((4 + fq) << 4) | 0);
            ex[1] = (f2ord(s1r[1] + s2v[1]) & 0xFFFFFF00u) | (unsigned)(((4 + fq) << 4) | 1);
            ex[2] = (f2ord(s1r[1] + s2v[2]) & 0xFFFFFF00u) | (unsigned)(((4 + fq) << 4) | 2);
            ex[3] = (f2ord(s1r[2] + s2v[0]) & 0xFFFFFF00u) | (unsigned)(((8 + fq) << 4) | 0);
            ex[4] = (f2ord(s1r[3] + s2v[0]) & 0xFFFFFF00u) | (unsigned)(((12 + fq) << 4) | 0);
#pragma unroll
            for (int e = 0; e < 5; ++e) {
                unsigned x = ex[e];
#pragma unroll
                for (int t = 0; t < 16; ++t) { const unsigned c = cu[t]; const unsigned mx = x > c ? x : c; x = x > c ? c : x; cu[t] = mx; }
            }
        }
        xlane_top16(cu, 16); xlane_top16(cu, 32);
        if (fq == 0) {
            float ex[16], den = 0.f; int eid[16];
            const float m0 = ord2f(cu[0] & 0xFFFFFF00u);
#pragma unroll
            for (int t = 0; t < 16; ++t) {
                ex[t] = __expf(ord2f(cu[t] & 0xFFFFFF00u) - m0); den += ex[t];
                const int i = (cu[t] >> 4) & 15, j = cu[t] & 15;
                eid[t] = (int)ids[fr * 32 + i] * 128 + (int)ids[fr * 32 + 16 + j];
            }
            const float inv = 1.f / den;
            int* ip = IDX + (size_t)(row0 + fr) * 128 + hd * 16;
            float* gp = GATE + (size_t)(row0 + fr) * 128 + hd * 16;
#pragma unroll
            for (int t = 0; t < 16; t += 4) {
                *(int4*)(ip + t) = make_int4(eid[t], eid[t + 1], eid[t + 2], eid[t + 3]);
                *(float4*)(gp + t) = make_float4(ex[t] * inv, ex[t + 1] * inv, ex[t + 2] * inv, ex[t + 3] * inv);
            }
        }
    }
}

__device__ __forceinline__ void phase_tabconv(const Params& P, int l) {
    const float4* U = (const float4*)(P.in[37] + (size_t)l * 16384 * 1024);
    const float4* V = (const float4*)(P.in[38] + (size_t)l * 16384 * 1024);
    ushort4* TU = (ushort4*)(P.ws + OFF_TBU);
    ushort4* TV = (ushort4*)(P.ws + OFF_TBV);
    const size_t n4 = (size_t)16384 * 256;
    for (size_t i = (size_t)blockIdx.x * 256 + otid(); i < n4; i += (size_t)gridDim.x * 256) {
        const float4 a = U[i], b = V[i];
        ushort4 oa, ob;
        oa.x = f2bf(a.x); oa.y = f2bf(a.y); oa.z = f2bf(a.z); oa.w = f2bf(a.w);
        ob.x = f2bf(b.x); ob.y = f2bf(b.y); ob.z = f2bf(b.z); ob.w = f2bf(b.w);
        TU[i] = oa; TV[i] = ob;
    }
}
__device__ __forceinline__ float dot2bf(unsigned a, unsigned b, float acc) { return __builtin_amdgcn_fdot2_f32_bf16(__builtin_bit_cast(bf16x2, a), __builtin_bit_cast(bf16x2, b), acc, false); }
__device__ __forceinline__ float dot8(const uint4& a, const uint4& b, float acc) { acc = dot2bf(a.x, b.x, acc); acc = dot2bf(a.y, b.y, acc); acc = dot2bf(a.z, b.z, acc); return dot2bf(a.w, b.w, acc); }
__device__ __forceinline__ void phase_gather(const Params& P, int l, unsigned char* smem) {
    const int tid = otid(), lane = tid & 63, wave = __builtin_amdgcn_readfirstlane(tid >> 6);
    float* XS = (float*)(P.ws + OFF_XS);
    const float* MOD = (const float*)(P.ws + OFF_MOD);
    const bf16_t* H2 = (const bf16_t*)(P.ws + OFF_H2);
    bf16_t* H = (bf16_t*)(P.ws + OFF_H);
    const int* IDX = (const int*)(P.ws + OFF_IDX);
    const float* GATE = (const float*)(P.ws + OFF_GATE);
    const bf16_t* TU = (const bf16_t*)(P.ws + OFF_TBU);
    const bf16_t* TV = (const bf16_t*)(P.ws + OFF_TBV);
    float* coef = (float*)smem + wave * 128;
    for (int row = blockIdx.x * 4 + wave; row < MROWS; row += gridDim.x * 4) {
        if (l == 1 && (row % LTOT) < CTX) continue;
        const uint4 h0 = *(const uint4*)(H2 + (size_t)row * DM + 8 * lane), h1 = *(const uint4*)(H2 + (size_t)row * DM + 512 + 8 * lane);
        const int e0 = IDX[(size_t)row * 128 + lane], e1 = IDX[(size_t)row * 128 + 64 + lane];
        uint4 ra[8], rb[8];
#define LOADB(T, bt) { _Pragma("unroll") for (int i = 0; i < 8; ++i) { const int k = (bt) * 8 + i; const int e = __builtin_amdgcn_readlane(k < 64 ? e0 : e1, k & 63); \
            const uint4* rp = (const uint4*)((T) + (size_t)e * 1024); ra[i] = rp[lane]; rb[i] = rp[64 + lane]; } }
        for (int bt = 0; bt < 16; ++bt) {
            LOADB(TU, bt)
            float p[8];
#pragma unroll
            for (int i = 0; i < 8; ++i) p[i] = dot8(rb[i], h1, dot8(ra[i], h0, 0.f));
            float q[4], r2[2];
#pragma unroll
            for (int i = 0; i < 4; ++i) { const float sd = (lane & 32) ? p[i] : p[i + 4]; const float rc = __shfl_xor(sd, 32, 64); q[i] = ((lane & 32) ? p[i + 4] : p[i]) + rc; }
#pragma unroll
            for (int i = 0; i < 2; ++i) { const float sd = (lane & 16) ? q[i] : q[i + 2]; const float rc = __shfl_xor(sd, 16, 64); r2[i] = ((lane & 16) ? q[i + 2] : q[i]) + rc; }
            float sv;
            { const float sd = (lane & 8) ? r2[0] : r2[1]; const float rc = __shfl_xor(sd, 8, 64); sv = ((lane & 8) ? r2[1] : r2[0]) + rc; }
            sv += __shfl_xor(sv, 4, 64); sv += __shfl_xor(sv, 2, 64); sv += __shfl_xor(sv, 1, 64);
            if ((lane & 7) == 0) { const int k = bt * 8 + ((lane >> 3) & 7); coef[k] = gelu_tanh(sv) * GATE[(size_t)row * 128 + k]; }
        }
        float acc[16];
#pragma unroll
        for (int j = 0; j < 16; ++j) acc[j] = 0.f;
        for (int bt = 0; bt < 16; ++bt) {
            LOADB(TV, bt)
#pragma unroll
            for (int i = 0; i < 8; ++i) {
                const float c = coef[bt * 8 + i];
                const unsigned w[8] = {ra[i].x, ra[i].y, ra[i].z, ra[i].w, rb[i].x, rb[i].y, rb[i].z, rb[i].w};
#pragma unroll
                for (int j = 0; j < 8; ++j) { acc[2 * j] += c * __uint_as_float(w[j] << 16); acc[2 * j + 1] += c * __uint_as_float(w[j] & 0xFFFF0000u); }
            }
        }
#undef LOADB
        const float* mod = MOD + (size_t)(l * 5 + modrow(row)) * 6144;
        float v[16]; float s = 0.f;
#pragma unroll
        for (int hh = 0; hh < 2; ++hh) {
            const int d = 512 * hh + 8 * lane;
            const float4 x0 = *(const float4*)(XS + (size_t)row * DM + d), x1 = *(const float4*)(XS + (size_t)row * DM + d + 4);
            const float4 g0 = *(const float4*)(mod + 5120 + d), g1 = *(const float4*)(mod + 5120 + d + 4);
            v[8 * hh + 0] = ALPHA * x0.x + g0.x * acc[8 * hh + 0]; v[8 * hh + 1] = ALPHA * x0.y + g0.y * acc[8 * hh + 1];
            v[8 * hh + 2] = ALPHA * x0.z + g0.z * acc[8 * hh + 2]; v[8 * hh + 3] = ALPHA * x0.w + g0.w * acc[8 * hh + 3];
            v[8 * hh + 4] = ALPHA * x1.x + g1.x * acc[8 * hh + 4]; v[8 * hh + 5] = ALPHA * x1.y + g1.y * acc[8 * hh + 5];
            v[8 * hh + 6] = ALPHA * x1.z + g1.z * acc[8 * hh + 6]; v[8 * hh + 7] = ALPHA * x1.w + g1.w * acc[8 * hh + 7];
        }
#pragma unroll
        for (int j = 0; j < 16; ++j) s += v[j];
        const float mean = wave_sum(s) * (1.f / 1024.f);
        float qq = 0.f;
#pragma unroll
        for (int j = 0; j < 16; ++j) { v[j] -= mean; qq += v[j] * v[j]; }
        const float rs = rsqrtf(wave_sum(qq) * (1.f / 1024.f) + 1e-5f);
        const float* mod1 = MOD + (size_t)(1 * 5 + modrow(row)) * 6144;
#pragma unroll
        for (int hh = 0; hh < 2; ++hh) {
            const int d = 512 * hh + 8 * lane;
            float o[8];
#pragma unroll
            for (int j = 0; j < 8; ++j) o[j] = v[8 * hh + j] * rs * P.in[10][l * 1024 + d + j] + P.in[11][l * 1024 + d + j];
            if (l == 0) {
                *(float4*)(XS + (size_t)row * DM + d) = make_float4(o[0], o[1], o[2], o[3]);
                *(float4*)(XS + (size_t)row * DM + d + 4) = make_float4(o[4], o[5], o[6], o[7]);
                bf16_t hb[8];
#pragma unroll
                for (int j = 0; j < 8; ++j) hb[j] = f2bf(o[j] * (1.f + mod1[1024 + d + j]) + mod1[d + j]);
                uint4 pk; pk.x = hb[0] | ((unsigned)hb[1] << 16); pk.y = hb[2] | ((unsigned)hb[3] << 16); pk.z = hb[4] | ((unsigned)hb[5] << 16); pk.w = hb[6] | ((unsigned)hb[7] << 16);
                *(uint4*)(H + (size_t)row * DM + d) = pk;
            } else {
                const int b = row / LTOT, t = row % LTOT - CTX;
                if (*(volatile unsigned*)(P.ws + OFF_BAR + 15360) != 0u) { o[0] = __int_as_float(0x7fc00000); }
                float* op = P.out + ((size_t)b * SEQ + t) * DM + d;
                *(float4*)op = make_float4(o[0], o[1], o[2], o[3]);
                *(float4*)(op + 4) = make_float4(o[4], o[5], o[6], o[7]);
            }
        }
    }
}

__device__ __forceinline__ void s5_prep_unit(const Params& P, int l, int g, unsigned char* smem) {
    const int tid = otid();
    float* Kt = (float*)smem;
    float* bbr = Kt + 8192; float* bbi = bbr + 1024; float* cr = bbi + 1024; float* ci = cr + 1024; float* pwr = ci + 1024; float* pwi = pwr + 17 * 64;
    bf16_t* MS = (bf16_t*)(P.ws + OFF_S5MS) + (size_t)(l * 16 + g) * 256 * 256;
    bf16_t* MY = (bf16_t*)(P.ws + OFF_S5MY) + (size_t)(l * 16 + g) * 256 * 512;
    float* LB = (float*)(P.ws + OFF_S5LB) + (size_t)(l * 16 + g) * 256;
    for (int dir = 0; dir < 2; ++dir) {
        __syncthreads();
        const int ldg = (l * 2 + dir) * 16 + g;
        if (tid < 64) {
            const int p = tid;
            const float dt = expf(P.in[14][ldg]);
            const float lre = P.in[12][ldg * 64 + p], lim = P.in[13][ldg * 64 + p];
            for (int d = 0; d <= 16; ++d) { const float mag = expf(lre * dt * (float)d), ang = lim * dt * (float)d; pwr[d * 64 + p] = mag * cosf(ang); pwi[d * 64 + p] = mag * sinf(ang); }
            const float lb_re = pwr[64 + p], lb_im = pwi[64 + p];
            const float den = lre * lre + lim * lim, nr = lb_re - 1.f, ni = lb_im;
            const float co_re = (nr * lre + ni * lim) / den, co_im = (ni * lre - nr * lim) / den;
            for (int h = 0; h < 16; ++h) {
                const float br = P.in[15][((size_t)ldg * 64 + p) * 16 + h], bi = P.in[16][((size_t)ldg * 64 + p) * 16 + h];
                bbr[p * 16 + h] = co_re * br - co_im * bi; bbi[p * 16 + h] = co_re * bi + co_im * br;
            }
            LB[dir * 128 + p] = pwr[16 * 64 + p]; LB[dir * 128 + 64 + p] = pwi[16 * 64 + p];
        }
        for (int e = tid; e < 1024; e += 256) { cr[e] = P.in[17][(size_t)ldg * 1024 + e]; ci[e] = P.in[18][(size_t)ldg * 1024 + e]; }
        __syncthreads();
        for (int e = tid; e < 4096; e += 256) {
            const int d = e >> 8, h = (e >> 4) & 15, h2 = e & 15;
            float acc = 0.f;
            for (int p = 0; p < 64; ++p) {
                const float Pr = pwr[d * 64 + p], Pi = pwi[d * 64 + p], br = bbr[p * 16 + h2], bi = bbi[p * 16 + h2];
                acc += cr[h * 64 + p] * (Pr * br - Pi * bi) - ci[h * 64 + p] * (Pr * bi + Pi * br);
            }
            Kt[dir * 4096 + e] = acc;
        }
        for (int e = tid; e < 128 * 256; e += 256) {
            const int q = e >> 8, col = e & 255, j = col >> 4, h2 = col & 15, p = q & 63;
            const int ex = dir == 0 ? 15 - j : j;
            const float Pr = pwr[ex * 64 + p], Pi = pwi[ex * 64 + p], br = bbr[p * 16 + h2], bi = bbi[p * 16 + h2];
            MS[(size_t)(dir * 128 + q) * 256 + col] = f2bf(q < 64 ? Pr * br - Pi * bi : Pr * bi + Pi * br);
        }
        for (int e = tid; e < 256 * 128; e += 256) {
            const int ri = e >> 7, q = e & 127, t = ri >> 4, h = ri & 15, p = q & 63;
            const int ex = dir == 0 ? t + 1 : 16 - t;
            const float Lr = pwr[ex * 64 + p], Li = pwi[ex * 64 + p], c_r = cr[h * 64 + p], c_i = ci[h * 64 + p];
            MY[(size_t)ri * 512 + 256 + dir * 128 + q] = f2bf(q < 64 ? c_r * Lr - c_i * Li : -(c_r * Li + c_i * Lr));
        }
    }
    __syncthreads();
    for (int e = tid; e < 256 * 256; e += 256) {
        const int ri = e >> 8, col = e & 255, t = ri >> 4, h = ri & 15, j = col >> 4, h2 = col & 15;
        float v = 0.f;
        if (j <= t) v += Kt[(t - j) * 256 + h * 16 + h2];
        if (j >= t) v += Kt[4096 + (j - t) * 256 + h * 16 + h2];
        MY[(size_t)ri * 512 + col] = f2bf(v);
    }
}
__device__ __forceinline__ void s5_passA(const Params& P, int l, int bid, int nb) {
    const int lane = otid() & 63, wave = __builtin_amdgcn_readfirstlane(otid() >> 6), fr = lane & 15, fq = lane >> 4;
    const bf16_t* Pb = (const bf16_t*)(P.ws + OFF_P);
    float* ST = (float*)(P.ws + OFF_S5ST);
    for (int it = bid * 4 + wave; it < 16 * 17 * 4; it += nb * 4) {
        const int g = it / 68, mt = (it % 68) >> 2, nt = it & 3;
        const bf16_t* MS = (const bf16_t*)(P.ws + OFF_S5MS) + (size_t)(l * 16 + g) * 256 * 256;
        f32x4 acc[4][4];
#pragma unroll
        for (int i = 0; i < 4; ++i)
#pragma unroll
            for (int j = 0; j < 4; ++j) acc[i][j] = (f32x4){0.f, 0.f, 0.f, 0.f};
        const bf16_t* ap[4];
#pragma unroll
        for (int i = 0; i < 4; ++i) { const int m = mt * 64 + 16 * i + fr, b = m / 272, c = m % 272; ap[i] = Pb + (size_t)(b * LTOT + c * 16) * PIN + g * 16; }
        const bf16_t* bp = MS + (size_t)(nt * 64 + fr) * 256 + 8 * fq;
        for (int k0 = 0; k0 < 256; k0 += 32) {
            const int k = k0 + 8 * fq;
            bf16x8 a[4], bb[4];
#pragma unroll
            for (int i = 0; i < 4; ++i) a[i] = *(const bf16x8*)(ap[i] + (size_t)(k >> 4) * PIN + (k & 15));
#pragma unroll
            for (int j = 0; j < 4; ++j) bb[j] = *(const bf16x8*)(bp + (size_t)(16 * j) * 256 + k0);
#pragma unroll
            for (int i = 0; i < 4; ++i)
#pragma unroll
                for (int j = 0; j < 4; ++j) acc[i][j] = __builtin_amdgcn_mfma_f32_16x16x32_bf16(a[i], bb[j], acc[i][j], 0, 0, 0);
        }
#pragma unroll
        for (int i = 0; i < 4; ++i)
#pragma unroll
            for (int r = 0; r < 4; ++r) {
                const int m = mt * 64 + 16 * i + 4 * fq + r, b = m / 272, c = m % 272;
                float* dst = ST + ((size_t)(b * 16 + g) * 272 + c) * 256 + nt * 64 + fr;
#pragma unroll
                for (int j = 0; j < 4; ++j) dst[16 * j] = acc[i][j][r];
            }
    }
}
__device__ __forceinline__ void s5_carry(const Params& P, int l, int bid, int nb) {
    float* ST = (float*)(P.ws + OFF_S5ST);
    for (int u = bid; u < 32; u += nb) {
        const int gid = u * 256 + otid(), p = gid & 63, dir = (gid >> 6) & 1, g = (gid >> 7) & 15, b = gid >> 11;
        const float* LB = (const float*)(P.ws + OFF_S5LB) + (size_t)(l * 16 + g) * 256 + dir * 128;
        const float lr = LB[p], li = LB[64 + p];
        float* base = ST + (size_t)(b * 16 + g) * 272 * 256 + dir * 128 + p;
        float sr = 0.f, si = 0.f;
        for (int c0 = 0; c0 < 272; c0 += 16) {
            float tr[16], ti[16];
#pragma unroll
            for (int i = 0; i < 16; ++i) { const int cc = c0 + i, c = dir == 0 ? cc : (cc < 16 ? 15 - cc : 287 - cc); tr[i] = base[(size_t)c * 256]; ti[i] = base[(size_t)c * 256 + 64]; }
#pragma unroll
            for (int i = 0; i < 16; ++i) {
                const int cc = c0 + i, c = dir == 0 ? cc : (cc < 16 ? 15 - cc : 287 - cc);
                base[(size_t)c * 256] = sr; base[(size_t)c * 256 + 64] = si;
                const float nr = lr * sr - li * si + tr[i], ni = lr * si + li * sr + ti[i];
                sr = nr; si = ni;
            }
        }
    }
}
__device__ __forceinline__ void s5_passC(const Params& P, int l, int bid, int nb) {
    const int lane = otid() & 63, wave = __builtin_amdgcn_readfirstlane(otid() >> 6), fr = lane & 15, fq = lane >> 4;
    const bf16_t* Pb = (const bf16_t*)(P.ws + OFF_P);
    const float* ST = (const float*)(P.ws + OFF_S5ST);
    bf16_t* YA = (bf16_t*)(P.ws + OFF_YP);
    for (int it = bid * 4 + wave; it < 16 * 17 * 4; it += nb * 4) {
        const int g = it / 68, mt = (it % 68) >> 2, nt = it & 3;
        const bf16_t* MY = (const bf16_t*)(P.ws + OFF_S5MY) + (size_t)(l * 16 + g) * 256 * 512;
        f32x4 acc[4][4];
#pragma unroll
        for (int i = 0; i < 4; ++i)
#pragma unroll
            for (int j = 0; j < 4; ++j) acc[i][j] = (f32x4){0.f, 0.f, 0.f, 0.f};
        const bf16_t* ap[4]; const float* sp[4];
#pragma unroll
        for (int i = 0; i < 4; ++i) {
            const int m = mt * 64 + 16 * i + fr, b = m / 272, c = m % 272;
            ap[i] = Pb + (size_t)(b * LTOT + c * 16) * PIN + g * 16;
            sp[i] = ST + ((size_t)(b * 16 + g) * 272 + c) * 256;
        }
        const bf16_t* bp = MY + (size_t)(nt * 64 + fr) * 512 + 8 * fq;
        for (int k0 = 0; k0 < 512; k0 += 32) {
            const int k = k0 + 8 * fq;
            bf16x8 a[4], bb[4];
            if (k0 < 256) {
#pragma unroll
                for (int i = 0; i < 4; ++i) a[i] = *(const bf16x8*)(ap[i] + (size_t)(k >> 4) * PIN + (k & 15));
            } else {
#pragma unroll
                for (int i = 0; i < 4; ++i) {
                    const float4 s0 = *(const float4*)(sp[i] + (k - 256)), s1 = *(const float4*)(sp[i] + (k - 256) + 4);
                    bf16x8 t;
                    t[0] = (short)f2bf(s0.x); t[1] = (short)f2bf(s0.y); t[2] = (short)f2bf(s0.z); t[3] = (short)f2bf(s0.w);
                    t[4] = (short)f2bf(s1.x); t[5] = (short)f2bf(s1.y); t[6] = (short)f2bf(s1.z); t[7] = (short)f2bf(s1.w);
                    a[i] = t;
                }
            }
#pragma unroll
            for (int j = 0; j < 4; ++j) bb[j] = *(const bf16x8*)(bp + (size_t)(16 * j) * 512 + k0);
#pragma unroll
            for (int i = 0; i < 4; ++i)
#pragma unroll
                for (int j = 0; j < 4; ++j) acc[i][j] = __builtin_amdgcn_mfma_f32_16x16x32_bf16(a[i], bb[j], acc[i][j], 0, 0, 0);
        }
        const float dsk = P.in[19][l * 256 + g * 16 + fr];
#pragma unroll
        for (int i = 0; i < 4; ++i)
#pragma unroll
            for (int r = 0; r < 4; ++r) {
                const int m = mt * 64 + 16 * i + 4 * fq + r, b = m / 272, c = m % 272;
#pragma unroll
                for (int j = 0; j < 4; ++j) {
                    const int t = nt * 4 + j;
                    const size_t row = (size_t)(b * LTOT + c * 16 + t);
                    const float u = bf2f(Pb[row * PIN + g * 16 + fr]);
                    YA[row * DM + g * 16 + fr] = f2bf(gelu_tanh(acc[i][j][r] + dsk * u));
                }
            }
    }
}


#define OFF_T8 (OFF_RW + (size_t)100 * 1024 * 1024)
#define OFF_T8S (OFF_T8 + (size_t)2 * 16384 * 1024)
typedef float f32x2 __attribute__((ext_vector_type(2)));
__device__ __forceinline__ void phase_tabconv8(const Params& P, int l) {
    const int lane = otid() & 63, wave = __builtin_amdgcn_readfirstlane(otid() >> 6);
    unsigned char* T8 = P.ws + OFF_T8;
    float* T8S = (float*)(P.ws + OFF_T8S);
    for (int row = blockIdx.x * 4 + wave; row < 32768; row += gridDim.x * 4) {
        const float* src = P.in[37 + (row >> 14)] + ((size_t)l * 16384 + (row & 16383)) * 1024 + 16 * lane;
        f32x4 x[4];
        float am = 0.f;
#pragma unroll
        for (int j = 0; j < 4; ++j) { x[j] = *(const f32x4*)(src + 4 * j); am = fmaxf(am, fmaxf(fmaxf(fabsf(x[j][0]), fabsf(x[j][1])), fmaxf(fabsf(x[j][2]), fabsf(x[j][3])))); }
#pragma unroll
        for (int o = 32; o > 0; o >>= 1) am = fmaxf(am, __shfl_xor(am, o, 64));
        const float sc = am > 0.f ? 224.f / am : 1.f;
        u32x4 pk;
#pragma unroll
        for (int j = 0; j < 4; ++j) {
            int p = __builtin_amdgcn_cvt_pk_fp8_f32(x[j][0] * sc, x[j][1] * sc, 0, false);
            p = __builtin_amdgcn_cvt_pk_fp8_f32(x[j][2] * sc, x[j][3] * sc, p, true);
            pk[j] = (unsigned)p;
        }
        *(u32x4*)(T8 + (size_t)row * 1024 + 16 * lane) = pk;
        if (lane == 0) T8S[row] = am * (1.f / 224.f);
    }
}
__device__ __forceinline__ void phase_gather8(const Params& P, int l, unsigned char* smem) {
    const int tid = otid(), lane = tid & 63, wave = __builtin_amdgcn_readfirstlane(tid >> 6);
    float* XS = (float*)(P.ws + OFF_XS);
    const float* MOD = (const float*)(P.ws + OFF_MOD);
    const bf16_t* H2 = (const bf16_t*)(P.ws + OFF_H2);
    bf16_t* H = (bf16_t*)(P.ws + OFF_H);
    const int* IDX = (const int*)(P.ws + OFF_IDX);
    const float* GATE = (const float*)(P.ws + OFF_GATE);
    const unsigned char* TU = P.ws + OFF_T8;
    const unsigned char* TV = TU + (size_t)16384 * 1024;
    const float* SU = (const float*)(P.ws + OFF_T8S);
    const float* SV = SU + 16384;
    float* coef = (float*)smem + wave * 128;
    for (int row = blockIdx.x * 4 + wave; row < MROWS; row += gridDim.x * 4) {
        if (l == 1 && (row % LTOT) < CTX) continue;
        float hv[16];
        {
            const u32x4 h0 = *(const u32x4*)(H2 + (size_t)row * DM + 16 * lane), h1 = *(const u32x4*)(H2 + (size_t)row * DM + 16 * lane + 8);
#pragma unroll
            for (int j = 0; j < 4; ++j) { hv[2 * j] = __uint_as_float(h0[j] << 16); hv[2 * j + 1] = __uint_as_float(h0[j] & 0xFFFF0000u); hv[8 + 2 * j] = __uint_as_float(h1[j] << 16); hv[9 + 2 * j] = __uint_as_float(h1[j] & 0xFFFF0000u); }
        }
        const int e0 = IDX[(size_t)row * 128 + lane], e1 = IDX[(size_t)row * 128 + 64 + lane];
        const float g0 = GATE[(size_t)row * 128 + lane], g1 = GATE[(size_t)row * 128 + 64 + lane];
        const float su0 = SU[e0], su1 = SU[e1], sv0 = SV[e0], sv1 = SV[e1];
        u32x4 rr[8];
#define LOAD8(T, bt) { _Pragma("unroll") for (int i = 0; i < 8; ++i) { const int k = (bt) * 8 + i; const int e = __builtin_amdgcn_readlane(k < 64 ? e0 : e1, k & 63); \
            rr[i] = *(const u32x4*)((T) + (size_t)e * 1024 + 16 * lane); } }
        for (int bt = 0; bt < 16; ++bt) {
            LOAD8(TU, bt)
            float p[8];
#pragma unroll
            for (int i = 0; i < 8; ++i) {
                float a = 0.f;
#pragma unroll
                for (int j = 0; j < 4; ++j) {
                    const f32x2 lo = __builtin_amdgcn_cvt_pk_f32_fp8((int)rr[i][j], false), hi = __builtin_amdgcn_cvt_pk_f32_fp8((int)rr[i][j], true);
                    a += lo[0] * hv[4 * j] + lo[1] * hv[4 * j + 1] + hi[0] * hv[4 * j + 2] + hi[1] * hv[4 * j + 3];
                }
                p[i] = a;
            }
            float q[4], r2[2];
#pragma unroll
            for (int i = 0; i < 4; ++i) { const float sd = (lane & 32) ? p[i] : p[i + 4]; const float rc = __shfl_xor(sd, 32, 64); q[i] = ((lane & 32) ? p[i + 4] : p[i]) + rc; }
#pragma unroll
            for (int i = 0; i < 2; ++i) { const float sd = (lane & 16) ? q[i] : q[i + 2]; const float rc = __shfl_xor(sd, 16, 64); r2[i] = ((lane & 16) ? q[i + 2] : q[i]) + rc; }
            float sv;
            { const float sd = (lane & 8) ? r2[0] : r2[1]; const float rc = __shfl_xor(sd, 8, 64); sv = ((lane & 8) ? r2[1] : r2[0]) + rc; }
            sv += __shfl_xor(sv, 4, 64); sv += __shfl_xor(sv, 2, 64); sv += __shfl_xor(sv, 1, 64);
            const int k = bt * 8 + ((lane >> 3) & 7);
            const float suk = __shfl(k < 64 ? su0 : su1, k & 63, 64), svk = __shfl(k < 64 ? sv0 : sv1, k & 63, 64), gk = __shfl(k < 64 ? g0 : g1, k & 63, 64);
            if ((lane & 7) == 0) coef[k] = gelu_tanh(sv * suk) * gk * svk;
        }
        float acc[16];
#pragma unroll
        for (int j = 0; j < 16; ++j) acc[j] = 0.f;
        for (int bt = 0; bt < 16; ++bt) {
            LOAD8(TV, bt)
#pragma unroll
            for (int i = 0; i < 8; ++i) {
                const float c = coef[bt * 8 + i];
#pragma unroll
                for (int j = 0; j < 4; ++j) {
                    const f32x2 lo = __builtin_amdgcn_cvt_pk_f32_fp8((int)rr[i][j], false), hi = __builtin_amdgcn_cvt_pk_f32_fp8((int)rr[i][j], true);
                    acc[4 * j] += c * lo[0]; acc[4 * j + 1] += c * lo[1]; acc[4 * j + 2] += c * hi[0]; acc[4 * j + 3] += c * hi[1];
                }
            }
        }
#undef LOAD8
        const float* mod = MOD + (size_t)(l * 5 + modrow(row)) * 6144;
        const int d0 = 16 * lane;
        float v[16]; float s = 0.f;
#pragma unroll
        for (int j = 0; j < 4; ++j) {
            const f32x4 x = *(const f32x4*)(XS + (size_t)row * DM + d0 + 4 * j), g = *(const f32x4*)(mod + 5120 + d0 + 4 * j);
#pragma unroll
            for (int e = 0; e < 4; ++e) { v[4 * j + e] = ALPHA * x[e] + g[e] * acc[4 * j + e]; s += v[4 * j + e]; }
        }
        const float mean = wave_sum(s) * (1.f / 1024.f);
        float qq = 0.f;
#pragma unroll
        for (int j = 0; j < 16; ++j) { v[j] -= mean; qq += v[j] * v[j]; }
        const float rs = rsqrtf(wave_sum(qq) * (1.f / 1024.f) + 1e-5f);
        const float* mod1 = MOD + (size_t)(1 * 5 + modrow(row)) * 6144;
#pragma unroll
        for (int j = 0; j < 4; ++j) {
            const int d = d0 + 4 * j;
            const f32x4 gg = *(const f32x4*)(P.in[10] + l * 1024 + d), bb = *(const f32x4*)(P.in[11] + l * 1024 + d);
            f32x4 o;
#pragma unroll
            for (int e = 0; e < 4; ++e) o[e] = v[4 * j + e] * rs * gg[e] + bb[e];
            if (l == 0) {
                *(f32x4*)(XS + (size_t)row * DM + d) = o;
                const f32x4 sh = *(const f32x4*)(mod1 + d), sc = *(const f32x4*)(mod1 + 1024 + d);
                const unsigned w0 = f2bf(o[0] * (1.f + sc[0]) + sh[0]) | ((unsigned)f2bf(o[1] * (1.f + sc[1]) + sh[1]) << 16);
                const unsigned w1 = f2bf(o[2] * (1.f + sc[2]) + sh[2]) | ((unsigned)f2bf(o[3] * (1.f + sc[3]) + sh[3]) << 16);
                *(uint2*)(H + (size_t)row * DM + d) = make_uint2(w0, w1);
            } else {
                const int b = row / LTOT, t = row % LTOT - CTX;
                *(f32x4*)(P.out + ((size_t)b * SEQ + t) * DM + d) = o;
            }
        }
    }
}

#define OFF_SG (OFF_RW + (size_t)1088 * 8 * 8 * 1024 * 2)
__device__ __forceinline__ size_t rw_group(int b, int dir, int tau_base) {
    const int p = dir == 0 ? tau_base : (tau_base < CTX ? (CTX - 1 - tau_base) : (LTOT + CTX - 1 - tau_base));
    return (size_t)((b * LTOT + p) >> 4);
}
__device__ __forceinline__ float bfw(unsigned w, int half) { return __uint_as_float(half ? (w & 0xFFFF0000u) : (w << 16)); }
struct RwPrep { u32x4 lw0, lw1; uint2 r, k, kap, a; };
__device__ __forceinline__ void rwkv_prep_load(const bf16_t* RW, int b, int hd, int dir, int tau_base, int wave, int lane, RwPrep& R) {
    const bf16_t* base = RW + (rw_group(b, dir, tau_base) * 8 + hd) * 8192 + lane * 16;
    R.lw0 = *(const u32x4*)(base + (6 + dir) * 1024); R.lw1 = *(const u32x4*)(base + (6 + dir) * 1024 + 8);
    const int off = dir ? 12 - 4 * wave : 4 * wave;
    R.r = *(const uint2*)(base + off); R.k = *(const uint2*)(base + 1024 + off); R.kap = *(const uint2*)(base + 3 * 1024 + off); R.a = *(const uint2*)(base + (4 + dir) * 1024 + off);
}
__device__ __forceinline__ void rwkv_prep_finish(const RwPrep& R, unsigned char* buf, float ka, int wave, int lane, int dir) {
    bf16_t* KR = (bf16_t*)buf; bf16_t* BK = (bf16_t*)(buf + 4608); bf16_t* BbT = (bf16_t*)(buf + 9216); bf16_t* KbT = (bf16_t*)(buf + 11264); float* gT = (float*)(buf + 13312);
    float lwt[16];
#pragma unroll
    for (int i = 0; i < 4; ++i) { lwt[2 * i] = bfw(R.lw0[i], 0); lwt[2 * i + 1] = bfw(R.lw0[i], 1); lwt[8 + 2 * i] = bfw(R.lw1[i], 0); lwt[9 + 2 * i] = bfw(R.lw1[i], 1); }
    float cs[16];
    {
        float c = 0.f;
#pragma unroll
        for (int j = 0; j < 16; ++j) { c += dir ? lwt[15 - j] : lwt[j]; cs[j] = c; }
    }
    const float c15 = cs[15];
    if (wave == 0) gT[lane] = __expf(c15);
    float cpw[4], ctw[4];
#pragma unroll
    for (int tt = 0; tt < 4; ++tt) {
        cpw[tt] = wave == 0 ? (tt == 0 ? 0.f : cs[tt - 1 < 0 ? 0 : tt - 1]) : (wave == 1 ? cs[3 + tt] : (wave == 2 ? cs[7 + tt] : cs[11 + tt]));
        ctw[tt] = wave == 0 ? cs[tt] : (wave == 1 ? cs[4 + tt] : (wave == 2 ? cs[8 + tt] : cs[12 + tt]));
    }
    float rt[4], kt4[4], kp[4], at[4];
    rt[0] = bfw(R.r.x, 0); rt[1] = bfw(R.r.x, 1); rt[2] = bfw(R.r.y, 0); rt[3] = bfw(R.r.y, 1);
    kt4[0] = bfw(R.k.x, 0); kt4[1] = bfw(R.k.x, 1); kt4[2] = bfw(R.k.y, 0); kt4[3] = bfw(R.k.y, 1);
    kp[0] = bfw(R.kap.x, 0); kp[1] = bfw(R.kap.x, 1); kp[2] = bfw(R.kap.y, 0); kp[3] = bfw(R.kap.y, 1);
    at[0] = bfw(R.a.x, 0); at[1] = bfw(R.a.x, 1); at[2] = bfw(R.a.y, 0); at[3] = bfw(R.a.y, 1);
    bf16_t bb[4], kb[4];
#pragma unroll
    for (int tt = 0; tt < 4; ++tt) {
        const int t = 4 * wave + tt;
        const float r = dir ? rt[3 - tt] : rt[tt], k = dir ? kt4[3 - tt] : kt4[tt], kap = dir ? kp[3 - tt] : kp[tt], a = dir ? at[3 - tt] : at[tt];
        const float ep = __expf(cpw[tt]), et = __expf(ctw[tt]), em = __expf(-ctw[tt]), eT = __expf(c15 - ctw[tt]);
        const float beta = kap * a, kt = k * (1.f + (a - 1.f) * ka);
        KR[t * 72 + lane] = f2bf(kap * ep); KR[(16 + t) * 72 + lane] = f2bf(r * et);
        BK[t * 72 + lane] = f2bf(beta * em); BK[(16 + t) * 72 + lane] = f2bf(kt * em);
        bb[tt] = f2bf(beta * eT); kb[tt] = f2bf(kt * eT);
    }
    uint2 pb, pk;
    pb.x = bb[0] | ((unsigned)bb[1] << 16); pb.y = bb[2] | ((unsigned)bb[3] << 16);
    pk.x = kb[0] | ((unsigned)kb[1] << 16); pk.y = kb[2] | ((unsigned)kb[3] << 16);
    *(uint2*)(BbT + lane * 16 + 4 * wave) = pb;
    *(uint2*)(KbT + lane * 16 + 4 * wave) = pk;
}
template <int NV>
__device__ __forceinline__ void rwkv_vt_load(const bf16_t* RW, int b, int hd, int dir, int tau_base, int vbase, int lane, u32x4& x) {
    const bf16_t* base = RW + (rw_group(b, dir, tau_base) * 8 + hd) * 8192 + 2 * 1024;
    if (NV == 2) {
        const int vl = lane & 31, th = lane >> 5;
        x = *(const u32x4*)(base + (vbase + vl) * 16 + (dir ? 8 - 8 * th : 8 * th));
    } else {
        const int vl = lane & 15, tq = lane >> 4;
        const uint2 y = *(const uint2*)(base + (vbase + vl) * 16 + (dir ? 12 - 4 * tq : 4 * tq));
        x[0] = y.x; x[1] = y.y; x[2] = 0u; x[3] = 0u;
    }
}
__device__ __forceinline__ unsigned swap16(unsigned w) { return (w >> 16) | (w << 16); }
template <int NV>
__device__ __forceinline__ void rwkv_vt_store(const u32x4& x, bf16_t* VT, int lane, int dir) {
    if (NV == 2) {
        const int vl = lane & 31, th = lane >> 5;
        u32x4 pk;
        if (dir) { pk[0] = swap16(x[3]); pk[1] = swap16(x[2]); pk[2] = swap16(x[1]); pk[3] = swap16(x[0]); } else pk = x;
        *(u32x4*)(VT + vl * 16 + th * 8) = pk;
    } else {
        const int vl = lane & 15, tq = lane >> 4;
        uint2 pk;
        if (dir) { pk.x = swap16(x[1]); pk.y = swap16(x[0]); } else { pk.x = x[0]; pk.y = x[1]; }
        *(uint2*)(VT + vl * 16 + tq * 4) = pk;
    }
}
template <int NV, bool HASV, bool OUT>
__device__ __forceinline__ void rwkv_mfma_step(f32x4 (&X)[4][NV], const unsigned char* buf, const bf16_t* VT, f32x4 (&Yout)[NV], int lane) {
    const bf16_t* KR = (const bf16_t*)buf; const bf16_t* BK = (const bf16_t*)(buf + 4608); const bf16_t* BbT = (const bf16_t*)(buf + 9216); const bf16_t* KbT = (const bf16_t*)(buf + 11264); const float* gT = (const float*)(buf + 13312);
    const int fr = lane & 15, fq = lane >> 4;
    const f32x4 z4 = {0.f, 0.f, 0.f, 0.f};
    f32x4 cA = z4, cN = z4, cAk = z4, cRb = z4, cRk = z4;
#pragma unroll
    for (int ks = 0; ks < 2; ++ks) {
        const bf16x8 kh = *(const bf16x8*)(KR + fr * 72 + 32 * ks + 8 * fq), rh = *(const bf16x8*)(KR + (16 + fr) * 72 + 32 * ks + 8 * fq);
        const bf16x8 bc = *(const bf16x8*)(BK + fr * 72 + 32 * ks + 8 * fq), kc = *(const bf16x8*)(BK + (16 + fr) * 72 + 32 * ks + 8 * fq);
        cA = mfma32(kh, bc, cA); cN = mfma32(bc, kh, cN); cAk = mfma32(kc, kh, cAk);
        if (OUT) { cRb = mfma32(bc, rh, cRb); cRk = mfma32(kc, rh, cRk); }
    }
    f32x4 dg;
#pragma unroll
    for (int r = 0; r < 4; ++r) {
        const int row = 4 * fq + r;
        dg[r] = (row == fr) ? 1.f : 0.f;
        cA[r] = (fr < row) ? cA[r] : 0.f;
        cN[r] = (row < fr) ? cN[r] : 0.f;
        cAk[r] = (row < fr) ? cAk[r] : 0.f;
        cRb[r] = (row <= fr) ? cRb[r] : 0.f;
        cRk[r] = (row <= fr) ? cRk[r] : 0.f;
    }
    const bf16x4 a4 = to4(cA), n4 = to4(cN);
    const f32x4 cA2 = mfma16(n4, a4, z4), cN2 = mfma16(a4, n4, z4);
    const bf16x4 a24 = to4(cA2), n24 = to4(cN2);
    const f32x4 cA4 = mfma16(n24, a24, z4), cN4 = mfma16(a24, n24, z4);
    const f32x4 cA8 = mfma16(to4(cN4), to4(cA4), z4);
    const f32x4 T1 = mfma16(to4(dg - cA), to4(dg + cN2), z4);
    const f32x4 T2 = mfma16(to4(dg + cA4), to4(T1), z4);
    const f32x4 WT = mfma16(to4(dg + cA8), to4(T2), z4);
    const bf16x4 wt4 = to4(WT), aak4 = to4(cAk), rab4 = to4(cRb), rak4 = to4(cRk);
    bf16x8 aK[2], aR[2];
#pragma unroll
    for (int ks = 0; ks < 2; ++ks) {
        aK[ks] = cat8(*(const bf16x4*)(KR + fr * 72 + 32 * ks + 4 * fq), *(const bf16x4*)(KR + fr * 72 + 32 * ks + 16 + 4 * fq));
        if (OUT) aR[ks] = cat8(*(const bf16x4*)(KR + (16 + fr) * 72 + 32 * ks + 4 * fq), *(const bf16x4*)(KR + (16 + fr) * 72 + 32 * ks + 16 + 4 * fq));
    }
    bf16x4 u4[NV], vt4[NV];
#pragma unroll
    for (int nj = 0; nj < NV; ++nj) {
        const bf16x8 b0 = cat8(to4(X[0][nj]), to4(X[1][nj])), b1 = cat8(to4(X[2][nj]), to4(X[3][nj]));
        f32x4 G = mfma32(aK[1], b1, mfma32(aK[0], b0, z4));
        if (HASV) { vt4[nj] = *(const bf16x4*)(VT + (16 * nj + fr) * 16 + 4 * fq); G = mfma16(aak4, vt4[nj], G); }
        const f32x4 U = mfma16(wt4, to4(G), z4);
        u4[nj] = to4(-U);
        if (OUT) {
            f32x4 Yv = mfma32(aR[1], b1, mfma32(aR[0], b0, z4));
            Yv = mfma16(rab4, u4[nj], Yv);
            if (HASV) Yv = mfma16(rak4, vt4[nj], Yv);
            Yout[nj] = Yv;
        }
    }
#pragma unroll
    for (int mi = 0; mi < 4; ++mi) {
        const f32x4 g4 = *(const f32x4*)(gT + 16 * mi + 4 * fq);
        const bf16x4 bb4 = *(const bf16x4*)(BbT + (16 * mi + fr) * 16 + 4 * fq), kb4 = *(const bf16x4*)(KbT + (16 * mi + fr) * 16 + 4 * fq);
#pragma unroll
        for (int nj = 0; nj < NV; ++nj) {
            f32x4 x = X[mi][nj] * g4;
            x = mfma16(bb4, u4[nj], x);
            if (HASV) x = mfma16(kb4, vt4[nj], x);
            X[mi][nj] = x;
        }
    }
}
__device__ __forceinline__ void rwkv_passA(const Params& P, int l, unsigned char* smem, int bid, int nb) {
    const int lane = otid() & 63, wave = __builtin_amdgcn_readfirstlane(otid() >> 6), fr = lane & 15, fq = lane >> 4;
    const bf16_t* RW = (const bf16_t*)(P.ws + OFF_RW);
    float* RXL = (float*)(P.ws + OFF_RXL);
    bf16_t* RXP = (bf16_t*)P.out;
    for (int item = bid; item < 64 * RW_NCH; item += nb) {
        const int seq = item / RW_NCH, c = item % RW_NCH, dir = seq & 1, hd = (seq >> 1) & 7, b = seq >> 4;
        const float ka = P.in[31][l * 512 + hd * 64 + lane];
        const int tau0 = c * 128;
        f32x4 X[4][2], Yd[2];
#pragma unroll
        for (int mi = 0; mi < 4; ++mi)
#pragma unroll
            for (int nj = 0; nj < 2; ++nj)
#pragma unroll
                for (int r = 0; r < 4; ++r) X[mi][nj][r] = (wave >= 2 && (16 * mi + 4 * fq + r) == (16 * (2 * (wave - 2) + nj) + fr)) ? 1.f : 0.f;
        bf16_t* VTw = (bf16_t*)(smem + RW_VT0 + wave * 2048);
        RwPrep R; u32x4 vx;
        rwkv_prep_load(RW, b, hd, dir, tau0, wave, lane, R);
        if (wave < 2) rwkv_vt_load<2>(RW, b, hd, dir, tau0, 32 * wave, lane, vx);
        rwkv_prep_finish(R, smem, ka, wave, lane, dir);
        if (wave < 2) rwkv_vt_store<2>(vx, VTw, lane, dir);
        __syncthreads();
        for (int s = 0; s < 8; ++s) {
            if (s < 7) rwkv_prep_load(RW, b, hd, dir, tau0 + (s + 1) * 16, wave, lane, R);
            if (wave < 2) rwkv_mfma_step<2, true, false>(X, smem + (s & 1) * RW_BUF, VTw + (s & 1) * 512, Yd, lane);
            else rwkv_mfma_step<2, false, false>(X, smem + (s & 1) * RW_BUF, VTw, Yd, lane);
            if (s < 7) {
                if (wave < 2) rwkv_vt_load<2>(RW, b, hd, dir, tau0 + (s + 1) * 16, 32 * wave, lane, vx);
                rwkv_prep_finish(R, smem + ((s + 1) & 1) * RW_BUF, ka, wave, lane, dir);
                if (wave < 2) rwkv_vt_store<2>(vx, VTw + ((s + 1) & 1) * 512, lane, dir);
            }
            __syncthreads();
        }
        if (wave < 2) {
#pragma unroll
            for (int mi = 0; mi < 4; ++mi)
#pragma unroll
                for (int nj = 0; nj < 2; ++nj) *(f32x4*)(RXL + (((size_t)item * 16 + mi * 4 + 2 * wave + nj) * 64 + lane) * 4) = X[mi][nj];
        } else {
#pragma unroll
            for (int mi = 0; mi < 4; ++mi)
#pragma unroll
                for (int nj = 0; nj < 2; ++nj)
#pragma unroll
                    for (int r = 0; r < 4; ++r) RXP[(size_t)item * 4096 + (16 * mi + 4 * fq + r) * 64 + 16 * (2 * (wave - 2) + nj) + fr] = f2bf(X[mi][nj][r]);
        }
    }
}
__device__ __forceinline__ void rwkv_passB(const Params& P, int bid, int nb) {
    const int lane = otid() & 63, wave = __builtin_amdgcn_readfirstlane(otid() >> 6), fr = lane & 15, fq = lane >> 4;
    float* RXL = (float*)(P.ws + OFF_RXL);
    const bf16_t* RXP = (const bf16_t*)P.out;
    for (int it = bid * 4 + wave; it < 256; it += nb * 4) {
        const int seq = it >> 2, nj = it & 3;
        f32x4 X[4];
#pragma unroll
        for (int mi = 0; mi < 4; ++mi) X[mi] = (f32x4){0.f, 0.f, 0.f, 0.f};
        for (int c = 0; c < RW_NCH; ++c) {
            const size_t item = (size_t)seq * RW_NCH + c;
            f32x4 L[4]; bf16x8 a[4][2];
#pragma unroll
            for (int mi = 0; mi < 4; ++mi) {
                L[mi] = *(const f32x4*)(RXL + ((item * 16 + mi * 4 + nj) * 64 + lane) * 4);
                const bf16_t* xp = RXP + item * 4096 + (16 * mi + fr) * 64;
#pragma unroll
                for (int ks = 0; ks < 2; ++ks) a[mi][ks] = cat8(*(const bf16x4*)(xp + 32 * ks + 4 * fq), *(const bf16x4*)(xp + 32 * ks + 16 + 4 * fq));
            }
            const bf16x8 b0 = cat8(to4(X[0]), to4(X[1])), b1 = cat8(to4(X[2]), to4(X[3]));
#pragma unroll
            for (int mi = 0; mi < 4; ++mi) {
                *(f32x4*)(RXL + ((item * 16 + mi * 4 + nj) * 64 + lane) * 4) = X[mi];
                X[mi] = mfma32(a[mi][1], b1, mfma32(a[mi][0], b0, L[mi]));
            }
        }
    }
}
template <bool CHECK>
__device__ __forceinline__ void rwkv_passC(const Params& P, int l, unsigned char* smem, int bid, int nb, int mode = 0) {
    const int lane = otid() & 63, wave = __builtin_amdgcn_readfirstlane(otid() >> 6), fr = lane & 15, fq = lane >> 4;
    const bf16_t* RW = (const bf16_t*)(P.ws + OFF_RW);
    const float* RXL = (const float*)(P.ws + OFF_RXL);
    for (int item = bid; item < 64 * RW_NCH; item += nb) {
        const int seq = item / RW_NCH, c = item % RW_NCH, dir = seq & 1, hd = (seq >> 1) & 7, b = seq >> 4;
        if (l == 1 && dir == 0 && c < 2) continue;
        if (l == 1 && dir == 1 && c < 2) continue;
        bf16_t* YP = (bf16_t*)(P.ws + OFF_YP) + (size_t)dir * MROWS * DM;
        const float ka = P.in[31][l * 512 + hd * 64 + lane];
        const int tau0 = c * 128;
        f32x4 X[4][1], Yo[1];
#pragma unroll
        for (int mi = 0; mi < 4; ++mi) X[mi][0] = *(const f32x4*)(RXL + (((size_t)item * 16 + mi * 4 + wave) * 64 + lane) * 4);
        bf16_t* VTw = (bf16_t*)(smem + RW_VT0 + wave * 2048);
        RwPrep R; u32x4 vx;
        rwkv_prep_load(RW, b, hd, dir, tau0, wave, lane, R);
        rwkv_vt_load<1>(RW, b, hd, dir, tau0, 16 * wave, lane, vx);
        rwkv_prep_finish(R, smem, ka, wave, lane, dir);
        rwkv_vt_store<1>(vx, VTw, lane, dir);
        __syncthreads();
        for (int s = 0; s < 8; ++s) {
            if (s < 7 && mode != 2) {
                rwkv_prep_load(RW, b, hd, dir, tau0 + (s + 1) * 16, wave, lane, R);
                rwkv_vt_load<1>(RW, b, hd, dir, tau0 + (s + 1) * 16, 16 * wave, lane, vx);
            }
            if (mode != 1) rwkv_mfma_step<1, true, true>(X, smem + (s & 1) * RW_BUF, VTw + (s & 1) * 512, Yo, lane);
            if (s < 7 && mode != 2) {
                rwkv_prep_finish(R, smem + ((s + 1) & 1) * RW_BUF, ka, wave, lane, dir);
                rwkv_vt_store<1>(vx, VTw + ((s + 1) & 1) * 512, lane, dir);
            }
#pragma unroll
            for (int r = 0; r < 4; ++r) {
                const int row = row_of(b, dir, tau0 + s * 16 + 4 * fq + r);
                if (mode) {} else if (CHECK) { if (YP[(size_t)row * DM + 512 + hd * 64 + 16 * wave + fr] != f2bf(Yo[0][r])) atomicAdd((unsigned*)(P.ws + OFF_BAR + 15360), 1u); }
                else YP[(size_t)row * DM + 512 + hd * 64 + 16 * wave + fr] = f2bf(Yo[0][r]);
            }
            __syncthreads();
        }
    }
}


#define HG_NCH 34
#define HG_BUF 7168
#define HG_VT0 14336
#define OFF_O_RXP 0ull
#define OFF_O_HXL ((size_t)2176 * 8192)
#define OFF_O_HD (OFF_O_HXL + (size_t)1088 * 8192)
struct HgPrep { u32x4 lf0, lf1; uint2 q, v; };
__device__ __forceinline__ void hgrn_prep_load(const bf16_t* HGT, int b, int hd, int dir, int tau_base, int vbase, int wave, int lane, HgPrep& R) {
    const bf16_t* base = HGT + (rw_group(b, dir, tau_base) * 4 + hd) * 4096;
    R.lf0 = *(const u32x4*)(base + (2 + dir) * 1024 + lane * 16); R.lf1 = *(const u32x4*)(base + (2 + dir) * 1024 + lane * 16 + 8);
    R.q = *(const uint2*)(base + lane * 16 + (dir ? 12 - 4 * wave : 4 * wave));
    const int vl = lane & 15, tq = lane >> 4;
    R.v = *(const uint2*)(base + 1024 + (vbase + vl) * 16 + (dir ? 12 - 4 * tq : 4 * tq));
}
__device__ __forceinline__ float hgrn_prep_finish(const HgPrep& R, unsigned char* buf, bf16_t* VT, int wave, int lane, int dir) {
    bf16_t* QH = (bf16_t*)buf; bf16_t* KC = (bf16_t*)(buf + 2304); bf16_t* KbT = (bf16_t*)(buf + 4608); float* gT = (float*)(buf + 6656);
    float lft_[16];
#pragma unroll
    for (int i = 0; i < 4; ++i) { lft_[2 * i] = bfw(R.lf0[i], 0); lft_[2 * i + 1] = bfw(R.lf0[i], 1); lft_[8 + 2 * i] = bfw(R.lf1[i], 0); lft_[9 + 2 * i] = bfw(R.lf1[i], 1); }
    float cs[16], ls[16];
    {
        float c = 0.f;
#pragma unroll
        for (int j = 0; j < 16; ++j) { ls[j] = dir ? lft_[15 - j] : lft_[j]; c += ls[j]; cs[j] = c; }
    }
    const float c15 = cs[15];
    if (wave == 0) gT[lane] = __expf(c15);
    float qt[4];
    qt[0] = bfw(R.q.x, 0); qt[1] = bfw(R.q.x, 1); qt[2] = bfw(R.q.y, 0); qt[3] = bfw(R.q.y, 1);
    bf16_t kb[4];
#pragma unroll
    for (int tt = 0; tt < 4; ++tt) {
        const int t = 4 * wave + tt;
        const float ct = wave == 0 ? cs[tt] : (wave == 1 ? cs[4 + tt] : (wave == 2 ? cs[8 + tt] : cs[12 + tt]));
        const float lft = wave == 0 ? ls[tt] : (wave == 1 ? ls[4 + tt] : (wave == 2 ? ls[8 + tt] : ls[12 + tt]));
        const float k = 1.f - __expf(lft);
        const float q = dir ? qt[3 - tt] : qt[tt];
        QH[t * 72 + lane] = f2bf(q * __expf(ct));
        KC[t * 72 + lane] = f2bf(k * __expf(fminf(-ct, 80.f)));
        kb[tt] = f2bf(k * __expf(c15 - ct));
    }
    uint2 pk; pk.x = kb[0] | ((unsigned)kb[1] << 16); pk.y = kb[2] | ((unsigned)kb[3] << 16);
    *(uint2*)(KbT + lane * 16 + 4 * wave) = pk;
    {
        const int vl = lane & 15, tq = lane >> 4;
        uint2 pv;
        if (dir) { pv.x = swap16(R.v.y); pv.y = swap16(R.v.x); } else pv = R.v;
        *(uint2*)(VT + vl * 16 + tq * 4) = pv;
    }
    return c15;
}
template <bool OUT>
__device__ __forceinline__ void hgrn_mfma_step(f32x4 (&X)[4], const unsigned char* buf, const bf16_t* VT, f32x4& Yout, int lane) {
    const bf16_t* QH = (const bf16_t*)buf; const bf16_t* KC = (const bf16_t*)(buf + 2304); const bf16_t* KbT = (const bf16_t*)(buf + 4608); const float* gT = (const float*)(buf + 6656);
    const int fr = lane & 15, fq = lane >> 4;
    const f32x4 z4 = {0.f, 0.f, 0.f, 0.f};
    const bf16x4 vt4 = *(const bf16x4*)(VT + fr * 16 + 4 * fq);
    if (OUT) {
        f32x4 cAT = z4;
#pragma unroll
        for (int ks = 0; ks < 2; ++ks) {
            const bf16x8 kc = *(const bf16x8*)(KC + fr * 72 + 32 * ks + 8 * fq), qh = *(const bf16x8*)(QH + fr * 72 + 32 * ks + 8 * fq);
            cAT = mfma32(kc, qh, cAT);
        }
#pragma unroll
        for (int r = 0; r < 4; ++r) cAT[r] = ((4 * fq + r) <= fr) ? cAT[r] : 0.f;
        const bf16x8 aQ0 = cat8(*(const bf16x4*)(QH + fr * 72 + 4 * fq), *(const bf16x4*)(QH + fr * 72 + 16 + 4 * fq));
        const bf16x8 aQ1 = cat8(*(const bf16x4*)(QH + fr * 72 + 32 + 4 * fq), *(const bf16x4*)(QH + fr * 72 + 48 + 4 * fq));
        const bf16x8 b0 = cat8(to4(X[0]), to4(X[1])), b1 = cat8(to4(X[2]), to4(X[3]));
        f32x4 O = mfma32(aQ1, b1, mfma32(aQ0, b0, z4));
        Yout = mfma16(to4(cAT), vt4, O);
    }
#pragma unroll
    for (int mi = 0; mi < 4; ++mi) {
        const f32x4 g4 = *(const f32x4*)(gT + 16 * mi + 4 * fq);
        const bf16x4 kb4 = *(const bf16x4*)(KbT + (16 * mi + fr) * 16 + 4 * fq);
        X[mi] = mfma16(kb4, vt4, X[mi] * g4);
    }
}
__device__ __forceinline__ float hgrn_lb(const Params& P, int l, int dir, int ch) {
    if (l == 0) return 0.f;
    const float a0 = P.in[22][(dir * 2 + 0) * 256 + ch], a1 = P.in[22][(dir * 2 + 1) * 256 + ch];
    const float m = fmaxf(a0, a1), e0 = __expf(a0 - m), e1 = __expf(a1 - m);
    return e1 / (e0 + e1);
}
template <bool OUT>
__device__ __forceinline__ void hgrn_pass(const Params& P, int l, unsigned char* smem, int bid, int nb) {
    const int lane = otid() & 63, wave = __builtin_amdgcn_readfirstlane(otid() >> 6), fr = lane & 15, fq = lane >> 4;
    const bf16_t* Pb = (const bf16_t*)((unsigned char*)P.out + OFF_O_HGT);
    bf16_t* HXL = (bf16_t*)((unsigned char*)P.out + OFF_O_HXL);
    float* HD = (float*)((unsigned char*)P.out + OFF_O_HD);
    for (int item = bid; item < 32 * HG_NCH; item += nb) {
        const int seq = item / HG_NCH, c = item % HG_NCH, dir = seq & 1, hd = (seq >> 1) & 3, b = seq >> 3;
        if (OUT && l == 1 && c < 2) continue;
        bf16_t* YP = (bf16_t*)(P.ws + OFF_YP) + (size_t)dir * MROWS * DM;
        const int tau0 = c * 128;
        f32x4 X[4], Yo;
#pragma unroll
        for (int mi = 0; mi < 4; ++mi) { if (OUT) { const uint2 w = *(const uint2*)(HXL + (((size_t)item * 16 + mi * 4 + wave) * 64 + lane) * 4); X[mi] = (f32x4){bfw(w.x, 0), bfw(w.x, 1), bfw(w.y, 0), bfw(w.y, 1)}; } else X[mi] = (f32x4){0.f, 0.f, 0.f, 0.f}; }
        bf16_t* VTw = (bf16_t*)(smem + HG_VT0 + wave * 1024);
        HgPrep R;
        hgrn_prep_load(Pb, b, hd, dir, tau0, 16 * wave, wave, lane, R);
        float ctot = hgrn_prep_finish(R, smem, VTw, wave, lane, dir);
        __syncthreads();
        for (int s = 0; s < 8; ++s) {
            if (s < 7) hgrn_prep_load(Pb, b, hd, dir, tau0 + (s + 1) * 16, 16 * wave, wave, lane, R);
            hgrn_mfma_step<OUT>(X, smem + (s & 1) * HG_BUF, VTw + (s & 1) * 256, Yo, lane);
            if (s < 7) ctot += hgrn_prep_finish(R, smem + ((s + 1) & 1) * HG_BUF, VTw + ((s + 1) & 1) * 256, wave, lane, dir);
            if (OUT) {
#pragma unroll
                for (int r = 0; r < 4; ++r) {
                    const int row = row_of(b, dir, tau0 + s * 16 + 4 * fq + r);
                    YP[(size_t)row * DM + 256 + hd * 64 + 16 * wave + fr] = f2bf(Yo[r]);
                }
            }
            __syncthreads();
        }
        if (!OUT) {
#pragma unroll
            for (int mi = 0; mi < 4; ++mi) *(uint2*)(HXL + (((size_t)item * 16 + mi * 4 + wave) * 64 + lane) * 4) = make_uint2(pk2bf(X[mi][0], X[mi][1]), pk2bf(X[mi][2], X[mi][3]));
            if (wave == 0) HD[(size_t)item * 64 + lane] = __expf(ctot);
        }
    }
}
__device__ __forceinline__ void hgrn_carry(const Params& P, int bid, int nb) {
    bf16_t* HXL = (bf16_t*)((unsigned char*)P.out + OFF_O_HXL);
    const float* HD = (const float*)((unsigned char*)P.out + OFF_O_HD);
    for (int u = bid; u < 128; u += nb) {
        const int gid = u * 256 + otid(), ln = gid & 63, tile = (gid >> 6) & 15, seq = gid >> 10;
        const int mi = tile >> 2, fq = ln >> 4;
        f32x4 x = {0.f, 0.f, 0.f, 0.f};
        for (int c0 = 0; c0 < HG_NCH; c0 += 17) {
            uint2 L[17];
#pragma unroll
            for (int i = 0; i < 17; ++i) {
                const size_t item = (size_t)seq * HG_NCH + c0 + i;
                L[i] = *(const uint2*)(HXL + ((item * 16 + tile) * 64 + ln) * 4);
            }
#pragma unroll
            for (int i = 0; i < 17; ++i) {
                const size_t item = (size_t)seq * HG_NCH + c0 + i;
                const f32x4 D = *(const f32x4*)(HD + item * 64 + 16 * mi + 4 * fq);
                *(uint2*)(HXL + ((item * 16 + tile) * 64 + ln) * 4) = make_uint2(pk2bf(x[0], x[1]), pk2bf(x[2], x[3]));
                x = D * x + (f32x4){bfw(L[i].x, 0), bfw(L[i].x, 1), bfw(L[i].y, 0), bfw(L[i].y, 1)};
            }
        }
    }
}


__device__ __forceinline__ void phase_rwprep2(const Params& P, int l, unsigned char* smem, int bid, int nb) {
    const int tid = otid(), lane = tid & 63, wave = __builtin_amdgcn_readfirstlane(tid >> 6), fr = lane & 15, fq = lane >> 4;
    const bf16_t* Pb = (const bf16_t*)(P.ws + OFF_P);
    bf16_t* RW = (bf16_t*)(P.ws + OFF_RW);
    bf16_t* SG = (bf16_t*)(P.ws + OFF_SG);
    const bf16_t* LW = (const bf16_t*)(P.ws + OFF_LW);
    const float* mu = P.in[24] + l * 1920;
    bf16_t* AL = (bf16_t*)smem;
    float muv[8];
#pragma unroll
    for (int jj = 0; jj < 8; ++jj) muv[jj] = (tid + 256 * jj) < 1920 ? mu[tid + 256 * jj] : 0.f;
    const float kk0 = P.in[30][l * 512 + tid], kk1 = P.in[30][l * 512 + 256 + tid];
    for (int u = bid; u < MROWS / 16; u += nb) {
        const int r0 = u * 16;
        __syncthreads();
#pragma unroll 1
        for (int it = 0; it < 4; ++it) {
            bf16_t pv[4][8], nv[4][8]; bool ok[4];
#pragma unroll
            for (int tt = 0; tt < 4; ++tt) {
                const int row_ = r0 + 4 * it + tt, p_ = row_ % LTOT; int nbr_;
                {
                    const int m = tid & 3;
                    if (p_ < CTX) { nbr_ = (m & 1) ? row_ + 1 : row_ - 1; ok[tt] = (m & 1) ? (p_ < CTX - 1) : (p_ > 0); }
                    else {
                        const int t_ = p_ - CTX, gr = t_ >> 6, gc = t_ & 63;
                        nbr_ = m == 0 ? row_ - 1 : (m == 1 ? row_ + 1 : (m == 2 ? row_ - 64 : row_ + 64));
                        ok[tt] = m == 0 ? (gc > 0) : (m == 1 ? (gc < 63) : (m == 2 ? (gr > 0) : (gr < 63)));
                    }
                }
                if (!ok[tt]) nbr_ = row_;
                const bf16_t* pp_ = Pb + (size_t)row_ * PIN + 1536 + tid; const bf16_t* pn_ = Pb + (size_t)nbr_ * PIN + 1536 + tid;
#pragma unroll
                for (int jj = 0; jj < 8; ++jj) { if (jj < 7 || tid < 128) { pv[tt][jj] = pp_[256 * jj]; nv[tt][jj] = pn_[256 * jj]; } else { pv[tt][jj] = 0; nv[tt][jj] = 0; } }
            }
            float q8[8][4];
#pragma unroll
            for (int tt = 0; tt < 4; ++tt) {
                const int i = 4 * it + tt, row = r0 + i;
                float sv[8];
#pragma unroll
                for (int jj = 0; jj < 8; ++jj) {
                    const float pvf = bf2f(pv[tt][jj]);
                    const float nvf = ok[tt] ? bf2f(nv[tt][jj]) : 0.f;
                    sv[jj] = pvf + muv[jj] * (nvf - pvf);
                }
                const float a0 = sv[2] * kk0, a1 = sv[3] * kk1;
                const float n0 = fmaxf(sqrtf(wave_sum(a0 * a0)), 1e-12f), n1 = fmaxf(sqrtf(wave_sum(a1 * a1)), 1e-12f);
                q8[0][tt] = sv[0]; q8[1][tt] = sv[1]; q8[2][tt] = sv[2]; q8[3][tt] = sv[3]; q8[4][tt] = sv[4]; q8[5][tt] = sv[5]; q8[6][tt] = a0 / n0; q8[7][tt] = a1 / n1;
                if (tid < 128) { SG[(size_t)row * 128 + tid] = f2bf(sigmoidf_(sv[6])); AL[((2 + (tid >> 6)) * 16 + i) * 72 + (tid & 63)] = f2bf(sv[7]); }
                else AL[(((tid - 128) >> 6) * 16 + i) * 72 + (tid & 63)] = f2bf(tanhf(sv[6]));
            }
#pragma unroll
            for (int q = 0; q < 8; ++q) {
                const int ch = tid + 256 * (q & 1), f = q >> 1;
                *(uint2*)(RW + (((size_t)u * 8 + (ch >> 6)) * 8 + f) * 1024 + (ch & 63) * 16 + 4 * it) = make_uint2(pk2bf(q8[q][0], q8[q][1]), pk2bf(q8[q][2], q8[q][3]));
            }
        }
        __syncthreads();
        {
            const int d = wave & 1, isA = wave >> 1;
            const bf16x8 a0 = *(const bf16x8*)(AL + (wave * 16 + fr) * 72 + 8 * fq), a1 = *(const bf16x8*)(AL + (wave * 16 + fr) * 72 + 32 + 8 * fq);
            const bf16_t* W = LW + (size_t)isA * 131072 + (size_t)(l * 2 + d) * 512 * 64;
            const float* bias = P.in[isA ? 27 : 25] + (l * 2 + d) * 512;
            const int fld = (isA ? 4 : 6) + d;
            for (int nj = 0; nj < 32; ++nj) {
                const bf16x8 b0 = *(const bf16x8*)(W + (size_t)(16 * nj + fr) * 64 + 8 * fq), b1 = *(const bf16x8*)(W + (size_t)(16 * nj + fr) * 64 + 32 + 8 * fq);
                const f32x4 acc = mfma32(a1, b1, mfma32(a0, b0, (f32x4){0.f, 0.f, 0.f, 0.f}));
                const int c = 16 * nj + fr;
                const float bs = bias[c];
                float o4[4];
#pragma unroll
                for (int r = 0; r < 4; ++r) { const float sg = sigmoidf_(bs + acc[r]); o4[r] = isA ? sg : -0.60653066f * sg; }
                *(uint2*)(RW + (((size_t)u * 8 + (c >> 6)) * 8 + fld) * 1024 + (c & 63) * 16 + 4 * fq) = make_uint2(pk2bf(o4[0], o4[1]), pk2bf(o4[2], o4[3]));
            }
        }
    }
}
__device__ __forceinline__ void phase_post2(const Params& P, int l) {
    const int tid = otid(), lane = tid & 63, wave = __builtin_amdgcn_readfirstlane(tid >> 6), fr = lane & 15, fq = lane >> 4;
    const bf16_t* Pb = (const bf16_t*)(P.ws + OFF_P);
    const bf16_t* RW = (const bf16_t*)(P.ws + OFF_RW);
    const bf16_t* YF = (const bf16_t*)(P.ws + OFF_YP);
    const bf16_t* YB = YF + (size_t)MROWS * DM;
    const bf16_t* LW = (const bf16_t*)(P.ws + OFF_LW);
    const bf16_t* SG = (const bf16_t*)(P.ws + OFF_SG);
    bf16_t* MIX = (bf16_t*)(P.ws + OFF_MIX);
    const f32x4 z4 = {0.f, 0.f, 0.f, 0.f};
    for (int u = blockIdx.x; u < MROWS / 16; u += gridDim.x) {
        const int r0 = u * 16;
        if (l == 1 && (r0 % LTOT) < CTX) continue;
        {
            f32x4 acc[4] = {z4, z4, z4, z4};
            const bf16_t* ap = YF + (size_t)(r0 + fr) * DM + 8 * fq;
            const bf16_t* bp = LW + (size_t)3 * 131072 + (size_t)(l * 256 + 64 * wave + fr) * 256 + 8 * fq;
#pragma unroll
            for (int ks = 0; ks < 8; ++ks) {
                const bf16x8 a = *(const bf16x8*)(ap + 32 * ks);
#pragma unroll
                for (int j = 0; j < 4; ++j) acc[j] = mfma32(a, *(const bf16x8*)(bp + (size_t)(16 * j) * 256 + 32 * ks), acc[j]);
            }
#pragma unroll
            for (int j = 0; j < 4; ++j) {
                const int n = 64 * wave + 16 * j + fr;
                const float gb = P.in[21][l * 256 + n];
#pragma unroll
                for (int r = 0; r < 4; ++r) {
                    const size_t row = (size_t)(r0 + 4 * fq + r);
                    MIX[row * DM + n] = f2bf(bf2f(YF[row * DM + n]) * sigmoidf_(acc[j][r] + gb));
                }
            }
        }
        {
            const int i = tid >> 4, c0 = (tid & 15) * 16; const size_t row = (size_t)(r0 + i);
            float o[16], ss = 0.f;
#pragma unroll
            for (int j = 0; j < 16; ++j) { o[j] = bf2f(YF[row * DM + 256 + c0 + j]) + bf2f(YB[row * DM + 256 + c0 + j]); ss += o[j] * o[j]; }
            ss += __shfl_xor(ss, 1, 64); ss += __shfl_xor(ss, 2, 64);
            const float rs = rsqrtf(ss * (1.f / 64.f) + 1e-6f);
#pragma unroll
            for (int j = 0; j < 16; ++j) {
                const float gr = bf2f(Pb[row * PIN + 1280 + c0 + j]);
                MIX[row * DM + 256 + c0 + j] = f2bf(o[j] * rs * P.in[23][l * 256 + c0 + j] * gr);
            }
        }
#pragma unroll 1
        for (int hh = 0; hh < 2; ++hh) {
            const int h = 2 * wave + hh;
            f32x4 g[4] = {z4, z4, z4, z4};
            const bf16_t* ap = SG + (size_t)(r0 + fr) * 128 + 8 * fq;
            const bf16_t* bp = LW + (size_t)2 * 131072 + (size_t)(l * 512 + h * 64 + fr) * 128 + 8 * fq;
#pragma unroll
            for (int ks = 0; ks < 4; ++ks) {
                const bf16x8 a = *(const bf16x8*)(ap + 32 * ks);
#pragma unroll
                for (int j = 0; j < 4; ++j) g[j] = mfma32(a, *(const bf16x8*)(bp + (size_t)(16 * j) * 128 + 32 * ks), g[j]);
            }
            const bf16_t* gb = RW + ((size_t)u * 8 + h) * 8192 + 4 * fq;
            uint2 fr_[4], fk_[4], fv_[4], fa_[4], fb_[4];
#pragma unroll
            for (int j = 0; j < 4; ++j) {
                const bf16_t* e = gb + (16 * j + fr) * 16;
                fr_[j] = *(const uint2*)e; fk_[j] = *(const uint2*)(e + 1024); fv_[j] = *(const uint2*)(e + 2048); fa_[j] = *(const uint2*)(e + 4096); fb_[j] = *(const uint2*)(e + 5120);
            }
#pragma unroll
            for (int r = 0; r < 4; ++r) {
                const size_t row = (size_t)(r0 + 4 * fq + r);
                float y[4], vv[4], sum = 0.f, bon = 0.f;
#pragma unroll
                for (int j = 0; j < 4; ++j) {
                    const int c = h * 64 + 16 * j + fr;
                    y[j] = bf2f(YF[row * DM + 512 + c]) + bf2f(YB[row * DM + 512 + c]);
                    sum += y[j];
                    const float rr = bfw(r < 2 ? fr_[j].x : fr_[j].y, r & 1), k = bfw(r < 2 ? fk_[j].x : fk_[j].y, r & 1);
                    const float af = bfw(r < 2 ? fa_[j].x : fa_[j].y, r & 1), ab = bfw(r < 2 ? fb_[j].x : fb_[j].y, r & 1);
                    const float ka = P.in[31][l * 512 + c];
                    vv[j] = bfw(r < 2 ? fv_[j].x : fv_[j].y, r & 1);
                    bon += rr * P.in[32][l * 512 + c] * k * (2.f + (af + ab - 2.f) * ka);
                }
#pragma unroll
                for (int o = 1; o < 16; o <<= 1) { sum += __shfl_xor(sum, o, 64); bon += __shfl_xor(bon, o, 64); }
                const float mean = sum * (1.f / 64.f);
                float var = 0.f;
#pragma unroll
                for (int j = 0; j < 4; ++j) { const float d = y[j] - mean; var += d * d; }
#pragma unroll
                for (int o = 1; o < 16; o <<= 1) var += __shfl_xor(var, o, 64);
                const float rs = rsqrtf(var * (1.f / 64.f) + 64e-5f);
#pragma unroll
                for (int j = 0; j < 4; ++j) {
                    const int c = h * 64 + 16 * j + fr;
                    const float yn = (y[j] - mean) * rs * P.in[33][l * 512 + c] + P.in[34][l * 512 + c];
                    MIX[row * DM + 512 + c] = f2bf((yn + bon * vv[j]) * g[j][r]);
                }
            }
        }
    }
}

#define OFF_CTR (OFF_BAR + 14336)
#define ONE (1 << 20)
__device__ __forceinline__ int next_item(const Params& P, int ph, unsigned char* smem) {
    volatile LAS int* slot = (volatile LAS int*)(smem + 65552);
    __syncthreads();
    if (threadIdx.x == 0) *slot = (int)atomicAdd((unsigned*)(P.ws + OFF_CTR) + ph, 1u);
    __syncthreads();
    return __builtin_amdgcn_readfirstlane(*slot);
}
__device__ __forceinline__ void run_phase(const Params& P, int ph, unsigned char* smem, int rep) {
#ifndef ONLY
    if (ph == 0) { phase_prep(P, smem); return; }
    if (ph == 1) { phase_mkh(P); return; }
#else
    if (ph < 2) return;
#endif
    const int l = (ph - 2) / PPL, s = (ph - 2) % PPL;
#ifdef ONLY
    if (s != ONLY) return;
#endif
    switch (s) {
    case 0: gemm3_bf16((const bf16_t*)(P.ws + OFF_H), DM, (const bf16_t*)(P.ws + OFF_WIN) + (size_t)l * PIN * DM, DM, MROWS, PIN, DM, false, Epi4Inproj{(bf16_t*)(P.ws + OFF_P), (const float*)(P.ws + OFF_LBT) + l * 512, (bf16_t*)((unsigned char*)P.out + OFF_O_HGT)}, smem, 7, 9); break;
    case 1:
        for (;;) {
            int i = next_item(P, ph, smem);
#ifdef PROBE_P1
            if (i >= 2448 && i < 2448 + (PROBE_P1 == 1 ? 1088 : (PROBE_P1 == 2 ? 1088 : 272))) i = i - 2448 + (PROBE_P1 == 1 ? 0 : (PROBE_P1 == 2 ? 1088 : 2176));
            else
#endif
            if (i >= 1088 + 1088 + 272) break;
            if (i < 1088) hgrn_pass<false>(P, l, smem, i, ONE);
            else if (i < 2176) phase_rwprep2(P, l, smem, i - 1088, ONE);
            else s5_passA(P, l, i - 2176, ONE);
        }
        break;
    case 2:
        for (;;) {
            const int i = next_item(P, ph, smem);
            if (i >= 2176 + 128 + 32) break;
            if (i < 2176) rwkv_passA(P, l, smem, i, ONE);
            else if (i < 2176 + 128) hgrn_carry(P, i - 2176, ONE);
            else s5_carry(P, l, i - 2176 - 128, ONE);
        }
        break;
    case 3:
        for (;;) {
            int i = next_item(P, ph, smem);
#ifdef PROBE_P3
            if (i >= 1424 && i < 1424 + (PROBE_P3 == 1 ? 1088 : 272)) i = i - 1424 + (PROBE_P3 == 1 ? 0 : 1088);
            else
#endif
            if (i >= 1088 + 272 + 64) break;
            if (i < 1088) hgrn_pass<true>(P, l, smem, i, ONE);
            else if (i < 1088 + 272) s5_passC(P, l, i - 1088, ONE);
            else rwkv_passB(P, i - 1088 - 272, ONE);
        }
        break;
    case 4:
        for (;;) {
            const int i = next_item(P, ph, smem);
#ifdef PROBE_C
            if (i >= 2176 && i < 4352) { rwkv_passC<false>(P, l, smem, i - 2176, ONE, PROBE_C); continue; }
            if (i >= 4352) break;
#else
            if (i >= 2176) break;
#endif
            rwkv_passC<false>(P, l, smem, i, ONE);
        }
        break;
    case 5: phase_post2(P, l); break;
    case 6: gemm3_bf16((const bf16_t*)(P.ws + OFF_MIX), DM, (const bf16_t*)(P.ws + OFF_WOUT) + (size_t)l * DM * DM, DM, MROWS, DM, DM, l == 1, Epi4F32{(float*)(P.ws + OFF_TMP), DM}, smem, 8, 8); phase_tabconv8(P, l); break;
    case 7: phase_ln1(P, l); break;
    case 8: gemm3_bf16((const bf16_t*)(P.ws + OFF_H2), DM, (const bf16_t*)(P.ws + OFF_WQ) + (size_t)l * 2048 * DM, DM, MROWS, 2048, DM, l == 1, Epi4Bf16{(bf16_t*)(P.ws + OFF_Q), 2048}, smem, 8, 8); break;
    case 9: phase_topk2(P, l, smem); break;
    case 10: phase_gather8(P, l, smem); break;
    }
}

__global__ void __launch_bounds__(256, 2) mega(Params P) {
    __shared__ __attribute__((aligned(16))) unsigned char smem[66048];
#if SINGLE
    cg::grid_group grid = cg::this_grid();
    if (threadIdx.x < 4) ((volatile LAS unsigned*)(smem + 65536))[threadIdx.x] = 0u;
    __syncthreads();
    XcdBarrier xb = xcd_barrier_post((unsigned*)(P.ws + OFF_BAR), (volatile LAS unsigned*)(smem + 65536));
#endif
#ifdef PROBE_T
    unsigned long long tacc_ = 0;
#endif
    for (int ph = P.ph_lo; ph < P.ph_hi; ++ph) {
        int nrep = 1;
#ifdef DUPMASK
        if (ph >= 2 && ((DUPMASK >> ((ph - 2) % PPL)) & 1)) nrep = 2;
#endif
#ifdef DUP1MASK
        if (ph >= 2 + PPL && ((DUP1MASK >> ((ph - 2) % PPL)) & 1)) nrep = 2;
#endif
#ifdef PROBE_P
        if (ph == 0) nrep = 2;
#endif
        for (int rep = 0; rep < nrep; ++rep) {
#ifdef PROBE_T
            const unsigned long long t0_ = __builtin_amdgcn_s_memrealtime();
#endif
            run_phase(P, ph, smem, rep);
#if SINGLE
            if (ph + 1 < P.ph_hi || rep + 1 < nrep) {
                if (ph == 0 && rep == 0) { asm volatile("s_waitcnt vmcnt(0)" ::: "memory"); __syncthreads(); grid.sync(); }
                else xcd_barrier(xb);
            }
#endif
#ifdef PROBE_T
            if (PROBE_T == 99 ? true : PROBE_T == 98 ? (ph >= 2 && ((ph - 2) % PPL == 0 || (ph - 2) % PPL == 10)) : (PROBE_T >= 100 ? (ph == PROBE_T - 100) : (ph >= 2 && (ph - 2) % PPL == PROBE_T))) tacc_ += __builtin_amdgcn_s_memrealtime() - t0_;
#endif
        }
    }
#ifdef PROBE_T
    if (blockIdx.x == 0) { const unsigned long long te_ = __builtin_amdgcn_s_memrealtime() + tacc_; while (__builtin_amdgcn_s_memrealtime() < te_) __builtin_amdgcn_s_sleep(8); }
#endif
}

extern "C" void kernel_launch(void* const* d_in, const int* in_sizes, int n_in, void* d_out, int out_size, void* d_ws, size_t ws_size, hipStream_t stream) {
    static int grid = 0;
    if (grid == 0) {
        if (n_in != 39 || ws_size < OFF_END) { fprintf(stderr, "kernel_launch: unexpected n_in %d or ws_size %zu (need %zu)\n", n_in, ws_size, (size_t)OFF_END); grid = -1; return; }
        int dev = 0, cus = 0, per_cu = 0;
        hipGetDevice(&dev);
        hipDeviceGetAttribute(&cus, hipDeviceAttributeMultiprocessorCount, dev);
        hipOccupancyMaxActiveBlocksPerMultiprocessor(&per_cu, mega, 256, 0);
        if (per_cu < 1) per_cu = 1;
        if (per_cu > 2) per_cu = 2;
        grid = cus * per_cu;
    }
    if (grid < 0) return;
    hipMemsetAsync((unsigned char*)d_ws + OFF_BAR, 0, 16384, stream);
    Params p{};
    for (int i = 0; i < 39; ++i) p.in[i] = (const float*)d_in[i];
    p.out = (float*)d_out; p.ws = (unsigned char*)d_ws;
#if SINGLE
    p.ph_lo = 0; p.ph_hi = NPH;
    void* args[] = {&p};
    hipError_t e = hipLaunchCooperativeKernel((void*)mega, dim3(grid), dim3(256), args, 0, stream);
    if (e != hipSuccess) fprintf(stderr, "cooperative launch failed: %s (grid %d)\n", hipGetErrorString(e), grid);
#else
    for (int ph = 0; ph < NPH; ++ph) {
        p.ph_lo = ph; p.ph_hi = ph + 1;
        hipLaunchKernelGGL(mega, dim3(grid), dim3(256), 0, stream, p);
    }
#endif
}
```

```cpp
#include <hip/hip_runtime.h>
#include <hip/hip_cooperative_groups.h>
#include <cstdio>
namespace cg = cooperative_groups;

#ifndef SINGLE
#define SINGLE 1
#endif

typedef unsigned short bf16_t;
typedef __bf16 bf16x2 __attribute__((ext_vector_type(2)));
typedef short bf16x8 __attribute__((ext_vector_type(8)));
typedef float f32x4 __attribute__((ext_vector_type(4)));

#define DM 1024
#define NB 4
#define SEQ 4096
#define CTX 256
#define LTOT 4352
#define MROWS 17408
#define PIN 3456
#define RWW 4224
#define NPH 24
#define PPL 11
#define ALPHA 1.41421356237f

#define OFF_XS 0ull
#define OFF_P (OFF_XS + (size_t)MROWS * DM * 4)
#define OFF_RW (OFF_P + (size_t)MROWS * PIN * 2)
#define OFF_YP (OFF_RW + (size_t)MROWS * RWW * 2)
#define OFF_MIX (OFF_YP + (size_t)2 * MROWS * DM * 2)
#define OFF_MOD (OFF_MIX + (size_t)MROWS * DM * 2)
#define OFF_WIN (OFF_MOD + (size_t)2 * 5 * 6144 * 4)
#define OFF_WOUT (OFF_WIN + (size_t)2 * PIN * DM * 2)
#define OFF_WQ (OFF_WOUT + (size_t)2 * DM * DM * 2)
#define OFF_S5MS (OFF_WQ + (size_t)2 * 2048 * DM * 2)
#define OFF_S5MY (OFF_S5MS + (size_t)2 * 16 * 256 * 256 * 2)
#define OFF_S5LB (OFF_S5MY + (size_t)2 * 16 * 256 * 512 * 2)
#define OFF_S5ST (OFF_S5LB + (size_t)2 * 16 * 2 * 128 * 4)
#define OFF_BAR (OFF_S5ST + (size_t)4 * 16 * 272 * 256 * 4)
#define OFF_KEYB (OFF_BAR + 16384)
#define OFF_LW (OFF_KEYB + (size_t)2 * 8 * 2 * 128 * 128 * 2)
#define OFF_LBT (OFF_LW + (size_t)4 * 131072 * 2)
#define OFF_END (OFF_LBT + 4096)
#define OFF_RXL OFF_MIX
#define OFF_TMP OFF_P
#define OFF_H OFF_YP
#define OFF_H2 (OFF_YP + (size_t)MROWS * DM * 2)
#define OFF_Q OFF_RW
#define OFF_IDX (OFF_RW + (size_t)MROWS * 2048 * 2)
#define OFF_GATE (OFF_IDX + (size_t)MROWS * 128 * 4)
#define OFF_TBU OFF_P
#define OFF_TBV (OFF_P + (size_t)16384 * 1024 * 2)

#define OFF_O_HGT ((size_t)2176 * 8192 + (size_t)1088 * 8192 + (size_t)1088 * 256)
struct Params {
    const float* in[39];
    float* out;
    unsigned char* ws;
    int ph_lo, ph_hi;
};

__device__ __forceinline__ bf16_t f2bf(float f) { const __bf16 h = (__bf16)f; return __builtin_bit_cast(bf16_t, h); }
typedef float f32x2_ __attribute__((ext_vector_type(2)));
__device__ __forceinline__ unsigned pk2bf(float a, float b) { const f32x2_ v = {a, b}; return __builtin_bit_cast(unsigned, __builtin_convertvector(v, bf16x2)); }
__device__ __forceinline__ float bf2f(bf16_t h) { return __uint_as_float(((unsigned)h) << 16); }
__device__ __forceinline__ float sigmoidf_(float x) { return 1.f / (1.f + __expf(-x)); }
__device__ __forceinline__ float siluf_(float x) { return x * sigmoidf_(x); }
__device__ __forceinline__ float gelu_tanh(float x) {
    const float u = 0.7978845608028654f * (x + 0.044715f * x * x * x);
    return 0.5f * x * (1.f + tanhf(u));
}
__device__ __forceinline__ float wave_sum(float v) {
#pragma unroll
    for (int o = 32; o > 0; o >>= 1) v += __shfl_xor(v, o, 64);
    return v;
}
typedef short bf16x4 __attribute__((ext_vector_type(4)));
#define RW_NCH 34
#define RW_BUF 13824
#define RW_VT0 27648
__device__ __forceinline__ f32x4 mfma32(bf16x8 a, bf16x8 b, f32x4 c) { return __builtin_amdgcn_mfma_f32_16x16x32_bf16(a, b, c, 0, 0, 0); }
__device__ __forceinline__ f32x4 mfma16(bf16x4 a, bf16x4 b, f32x4 c) {
    bf16x8 a8, b8;
    a8[0] = a[0]; a8[1] = a[1]; a8[2] = a[2]; a8[3] = a[3]; a8[4] = 0; a8[5] = 0; a8[6] = 0; a8[7] = 0;
    b8[0] = b[0]; b8[1] = b[1]; b8[2] = b[2]; b8[3] = b[3]; b8[4] = 0; b8[5] = 0; b8[6] = 0; b8[7] = 0;
    return __builtin_amdgcn_mfma_f32_16x16x32_bf16(a8, b8, c, 0, 0, 0);
}
typedef unsigned u32x2_ __attribute__((ext_vector_type(2)));
__device__ __forceinline__ bf16x4 to4(f32x4 v) { const u32x2_ p = {pk2bf(v[0], v[1]), pk2bf(v[2], v[3])}; return __builtin_bit_cast(bf16x4, p); }
__device__ __forceinline__ bf16x8 cat8(bf16x4 a, bf16x4 b) { bf16x8 o; o[0] = a[0]; o[1] = a[1]; o[2] = a[2]; o[3] = a[3]; o[4] = b[0]; o[5] = b[1]; o[6] = b[2]; o[7] = b[3]; return o; }

__device__ __forceinline__ int otid() { int t = threadIdx.x; asm volatile("" : "+v"(t)); return t; }
__device__ __forceinline__ float rdlane(float v, int l) { return __int_as_float(__builtin_amdgcn_readlane(__float_as_int(v), l)); }
__device__ __forceinline__ int row_of(int b, int dir, int tau) {
    const int p = dir == 0 ? tau : (tau < CTX ? (CTX - 1 - tau) : (LTOT + CTX - 1 - tau));
    return b * LTOT + p;
}
__device__ __forceinline__ int modrow(int row) { const int p = row % LTOT; return p < CTX ? 4 : row / LTOT; }

__device__ __forceinline__ void s5_prep_unit(const Params& P, int l, int g, int part, unsigned char* smem);

#define XB_TMO      128
#define XB_XCNT(j)  (256  + 64 * (j))
#define XB_XSUB(j)  (1280 + 64 * (j))
#define XB_XGEN(j)  (2304 + 64 * (j))
#define XB_TOP      3328
#define XB_TOPGEN   3392
#define XCD_BAR_WORDS 3456
#define XB_SPIN_CAP (1u << 22)
#define LAS __attribute__((address_space(3)))
__device__ __forceinline__ unsigned xb_ld(unsigned* p)              { return __hip_atomic_load(p, __ATOMIC_RELAXED, __HIP_MEMORY_SCOPE_AGENT); }
__device__ __forceinline__ unsigned xb_add(unsigned* p, unsigned v) { return __hip_atomic_fetch_add(p, v, __ATOMIC_RELAXED, __HIP_MEMORY_SCOPE_AGENT); }
__device__ __forceinline__ unsigned xb_xcc_id() { return (unsigned)__builtin_amdgcn_s_getreg((3 << 11) | 20) & 0xFu; }
#define XB_SPIN(cond, bar) do { unsigned _sp = 0; while (cond) { __builtin_amdgcn_s_sleep(1); \
    if ((++_sp & 255u) == 0u) { if (xb_ld(&(bar)[XB_TMO])) break; if (_sp > XB_SPIN_CAP) { atomicAdd(&(bar)[XB_TMO], 1u); break; } } } } while (0)
struct XcdBarrier { unsigned* bar; unsigned x; volatile LAS unsigned* st; };
__device__ __forceinline__ XcdBarrier xcd_barrier_post(unsigned* bar, volatile LAS unsigned* st) {
    XcdBarrier b; b.bar = bar; b.x = xb_xcc_id(); b.st = st;
    if (threadIdx.x == 0) (void)xb_add(&bar[XB_XCNT(b.x)], 1u);
    return b;
}
__device__ __forceinline__ void xcd_barrier_complete(unsigned* bar, unsigned x, unsigned& nloc, unsigned& nx) {
    const unsigned G = gridDim.x * gridDim.y * gridDim.z;
    unsigned sum, cnt, mine, sp = 0u;
    for (;;) {
        sum = 0u; cnt = 0u; mine = 0u;
#pragma unroll
        for (unsigned j = 0; j < 16; ++j) { const unsigned c = xb_ld(&bar[XB_XCNT(j)]); sum += c; cnt += (c > 0u) ? 1u : 0u; mine = (j == x) ? c : mine; }
        if (sum == G) break;
        __builtin_amdgcn_s_sleep(1);
        if ((++sp & 255u) == 0u) { if (xb_ld(&bar[XB_TMO])) break; if (sp > XB_SPIN_CAP) { atomicAdd(&bar[XB_TMO], 1u); break; } }
    }
    nloc = mine > 0u ? mine : 1u; nx = cnt > 0u ? cnt : 1u;
}
__device__ __forceinline__ void xcd_barrier(const XcdBarrier& b) {
    asm volatile("s_waitcnt vmcnt(0)" ::: "memory");
    __syncthreads();
    if (threadIdx.x == 0) {
        unsigned* bar = b.bar;
        __builtin_amdgcn_s_waitcnt(0);
        unsigned nloc = b.st[0], nx = b.st[1];
        if (nloc == 0u) { xcd_barrier_complete(bar, b.x, nloc, nx); b.st[0] = nloc; b.st[1] = nx; }
        const unsigned old = xb_add(&bar[XB_XSUB(b.x)], 1u);
        const unsigned gen = old / nloc;
        if (old + 1u == (gen + 1u) * nloc) {
            __builtin_amdgcn_fence(__ATOMIC_RELEASE, "agent");
            asm volatile("s_waitcnt vmcnt(0)" ::: "memory");
            const unsigned og = xb_add(&bar[XB_TOP], 1u);
            const unsigned tg = og / nx;
            if (og + 1u == (tg + 1u) * nx) xb_add(&bar[XB_TOPGEN], 1u);
            else XB_SPIN(xb_ld(&bar[XB_TOPGEN]) == tg, bar);
            __builtin_amdgcn_fence(__ATOMIC_ACQUIRE, "agent");
            xb_add(&bar[XB_XGEN(b.x)], 1u);
            asm volatile("s_waitcnt vmcnt(0)" ::: "memory");
        } else {
            XB_SPIN(xb_ld(&bar[XB_XGEN(b.x)]) == gen, bar);
            __builtin_amdgcn_fence(__ATOMIC_ACQUIRE, "agent");
            asm volatile("s_waitcnt vmcnt(0)" ::: "memory");
        }
    }
    __syncthreads();
}

__device__ __forceinline__ void phase_prep(const Params& P, unsigned char* smem) {
    const int tid = otid(), lane = tid & 63, wave = __builtin_amdgcn_readfirstlane(tid >> 6);
    float* MOD = (float*)(P.ws + OFF_MOD);
    float* XS = (float*)(P.ws + OFF_XS);
    const int U_MOD = 192, U_COPY = MROWS / 16, U_TIN = 2 * 16 * 54, U_TOUT = 2 * 16 * 16, U_TQ = 2 * 16 * 32;
    const int U_S5 = 128, U_KEY = 64 + 64;
    const int total = U_S5 + U_KEY + U_MOD + U_COPY + U_TIN + U_TOUT + U_TQ;
    for (int u0 = blockIdx.x; u0 < total; u0 += gridDim.x) {
        __syncthreads();
        if (u0 < U_S5) {
            if (u0 == 0) {
                float* LBT = (float*)(P.ws + OFF_LBT);
                for (int i = tid; i < 1024; i += 256) {
                    const int ll = i >> 9, dir = (i >> 8) & 1, ch = i & 255;
                    float lbv = 0.f;
                    if (ll == 1) { const float a0 = P.in[22][(dir * 2 + 0) * 256 + ch], a1 = P.in[22][(dir * 2 + 1) * 256 + ch]; const float m = fmaxf(a0, a1), e0 = __expf(a0 - m), e1 = __expf(a1 - m); lbv = e1 / (e0 + e1); }
                    LBT[i] = lbv;
                }
            }
            s5_prep_unit(P, u0 >> 6, (u0 >> 2) & 15, u0 & 3, smem); continue;
        }
        if (u0 < U_S5 + 64) {
            bf16_t* KB = (bf16_t*)(P.ws + OFF_KEYB);
            const size_t base = (size_t)(u0 - U_S5) * 8192;
            for (int i = tid; i < 8192; i += 256) KB[base + i] = f2bf(P.in[36][base + i]);
            continue;
        }
        if (u0 < U_S5 + U_KEY) {
            bf16_t* LW = (bf16_t*)(P.ws + OFF_LW);
            const int base = (u0 - U_S5 - 64) * 8192;
            for (int i = tid; i < 8192; i += 256) {
                const int o = base + i, which = o >> 17, e = o & 131071;
                float v;
                if (which < 2) { const int j = e & 63, c = (e >> 6) & 511, ld = e >> 15; v = P.in[which == 0 ? 26 : 28][((size_t)ld * 64 + j) * 512 + c]; }
                else if (which == 2) { const int j = e & 127, c = (e >> 7) & 511, ll = e >> 16; v = P.in[29][((size_t)ll * 128 + j) * 512 + c]; }
                else { const int k = e & 255, n = (e >> 8) & 255, ll = e >> 16; v = P.in[20][((size_t)ll * 256 + k) * 256 + n]; }
                LW[o] = f2bf(v);
            }
            continue;
        }
        const int u = u0 - U_S5 - U_KEY;
        if (u < U_MOD) {
            const int l = u / 96, j0 = (u % 96) * 64;
            float* sl = (float*)smem;
            for (int i = tid; i < 5 * 1024; i += 256) {
                const int r = i >> 10, k = i & 1023;
                const float cv = r < 4 ? P.in[1][r * 1024 + k] : P.in[3][k];
                sl[i] = siluf_(cv);
            }
            __syncthreads();
            float acc[5] = {0.f, 0.f, 0.f, 0.f, 0.f};
            const float* W = P.in[4] + (size_t)l * 1024 * 6144 + j0 + lane;
            for (int k = wave * 256; k < wave * 256 + 256; ++k) {
                const float w = W[(size_t)k * 6144];
#pragma unroll
                for (int r = 0; r < 5; ++r) acc[r] += sl[r * 1024 + k] * w;
            }
            float* red = (float*)(smem + 5 * 1024 * 4);
#pragma unroll
            for (int r = 0; r < 5; ++r) red[(wave * 5 + r) * 64 + lane] = acc[r];
            __syncthreads();
            for (int i = tid; i < 5 * 64; i += 256) {
                const int r = i / 64, jj = i % 64;
                float s = P.in[5][l * 6144 + j0 + jj];
                for (int w = 0; w < 4; ++w) s += red[(w * 5 + r) * 64 + jj];
                MOD[(l * 5 + r) * 6144 + j0 + jj] = s;
            }
        } else if (u < U_MOD + U_COPY) {
            const int r0 = (u - U_MOD) * 16;
            for (int i = tid; i < 16 * 256; i += 256) {
                const int row = r0 + (i >> 8), c4 = i & 255;
                const int b = row / LTOT, p = row % LTOT;
                const float4* src = p < CTX ? (const float4*)(P.in[2] + ((size_t)b * CTX + p) * DM) : (const float4*)(P.in[0] + ((size_t)b * SEQ + (p - CTX)) * DM);
                ((float4*)(XS + (size_t)row * DM))[c4] = src[c4];
            }
        } else {
            int v = u - U_MOD - U_COPY;
            const float* W; bf16_t* Wt; int N;
            if (v < U_TIN) { const int l = v / (16 * 54); v %= 16 * 54; N = PIN; W = P.in[6] + (size_t)l * 1024 * PIN; Wt = (bf16_t*)(P.ws + OFF_WIN) + (size_t)l * PIN * 1024; }
            else if (v < U_TIN + U_TOUT) { v -= U_TIN; const int l = v / 256; v %= 256; N = 1024; W = P.in[7] + (size_t)l * 1024 * 1024; Wt = (bf16_t*)(P.ws + OFF_WOUT) + (size_t)l * 1024 * 1024; }
            else { v -= U_TIN + U_TOUT; const int l = v / 512; v %= 512; N = 2048; W = P.in[35] + (size_t)l * 1024 * 2048; Wt = (bf16_t*)(P.ws + OFF_WQ) + (size_t)l * 2048 * 1024; }
            const int ntn = N / 64, kt = v / ntn, nt = v % ntn;
            float* t = (float*)smem;
            for (int i = tid; i < 64 * 64; i += 256) { const int kk = i >> 6, nn = i & 63; t[kk * 65 + nn] = W[(size_t)(kt * 64 + kk) * N + nt * 64 + nn]; }
            __syncthreads();
            for (int i = tid; i < 64 * 64; i += 256) { const int nn = i >> 6, kk = i & 63; Wt[(size_t)(nt * 64 + nn) * 1024 + kt * 64 + kk] = f2bf(t[kk * 65 + nn]); }
        }
    }
}

__device__ __forceinline__ void phase_mkh(const Params& P) {
    const int lane = otid() & 63, wave = __builtin_amdgcn_readfirstlane(otid() >> 6);
    const float* XS = (const float*)(P.ws + OFF_XS);
    const float* MOD = (const float*)(P.ws + OFF_MOD);
    bf16_t* H = (bf16_t*)(P.ws + OFF_H);
    for (int row = blockIdx.x * 4 + wave; row < MROWS; row += gridDim.x * 4) {
        const float* mod = MOD + (size_t)(0 * 5 + modrow(row)) * 6144;
#pragma unroll
        for (int j = 0; j < 4; ++j) {
            const int d = 256 * j + 4 * lane;
            const float4 x = *(const float4*)(XS + (size_t)row * DM + d);
            const float4 sh = *(const float4*)(mod + d), sc = *(const float4*)(mod + 1024 + d);
            ushort4 o;
            o.x = f2bf(x.x * (1.f + sc.x) + sh.x); o.y = f2bf(x.y * (1.f + sc.y) + sh.y);
            o.z = f2bf(x.z * (1.f + sc.z) + sh.z); o.w = f2bf(x.w * (1.f + sc.w) + sh.w);
            *(ushort4*)(H + (size_t)row * DM + d) = o;
        }
    }
}

template <class EPI>
__device__ __forceinline__ void gemm_bf16(const bf16_t* A, int lda, const bf16_t* Bt, int ldb, int M, int N, int K, bool skipctx, EPI epi) {
    const int lane = otid() & 63, wave = __builtin_amdgcn_readfirstlane(otid() >> 6);
    const int ntm = M / 128, ntn = N / 128;
    const int fr = lane & 15, fq = lane >> 4;
    for (int tile = blockIdx.x; tile < ntm * ntn; tile += gridDim.x) {
        const int tm = tile / ntn, tn = tile % ntn;
        const int m0 = tm * 128 + (wave >> 1) * 64, n0 = tn * 128 + (wave & 1) * 64;
        if (skipctx && (m0 % LTOT) < CTX) continue;
        f32x4 acc[4][4];
#pragma unroll
        for (int i = 0; i < 4; ++i)
#pragma unroll
            for (int j = 0; j < 4; ++j) acc[i][j] = (f32x4){0.f, 0.f, 0.f, 0.f};
        const bf16_t* ap = A + (size_t)(m0 + fr) * lda + 8 * fq;
        const bf16_t* bp = Bt + (size_t)(n0 + fr) * ldb + 8 * fq;
        for (int k0 = 0; k0 < K; k0 += 32) {
            bf16x8 a[4], b[4];
#pragma unroll
            for (int i = 0; i < 4; ++i) a[i] = *(const bf16x8*)(ap + (size_t)(16 * i) * lda + k0);
#pragma unroll
            for (int j = 0; j < 4; ++j) b[j] = *(const bf16x8*)(bp + (size_t)(16 * j) * ldb + k0);
#pragma unroll
            for (int i = 0; i < 4; ++i)
#pragma unroll
                for (int j = 0; j < 4; ++j) acc[i][j] = __builtin_amdgcn_mfma_f32_16x16x32_bf16(a[i], b[j], acc[i][j], 0, 0, 0);
        }
#pragma unroll
        for (int i = 0; i < 4; ++i)
#pragma unroll
            for (int j = 0; j < 4; ++j)
#pragma unroll
                for (int r = 0; r < 4; ++r) epi(m0 + 16 * i + 4 * fq + r, n0 + 16 * j + fr, acc[i][j][r]);
    }
}

typedef float f32x16 __attribute__((ext_vector_type(16)));
typedef unsigned u32x4 __attribute__((ext_vector_type(4)));
#define G2_LD 72
template <class EPI>
__device__ __forceinline__ void gemm2_bf16(const bf16_t* A, int lda, const bf16_t* Bt, int ldb, int M, int N, int K, bool skipctx, EPI epi, unsigned char* smem) {
    const int tid = otid(), lane = tid & 63, wave = __builtin_amdgcn_readfirstlane(tid >> 6);
    const int ntm = M / 128, ntn = N / 128;
    bf16_t* As = (bf16_t*)smem;
    bf16_t* Bs = As + 128 * G2_LD;
    const int lr = tid >> 3, lc = (tid & 7) * 8;
    const int wm = (wave >> 1) * 64, wn = (wave & 1) * 64;
    const int fr = lane & 31, fh = lane >> 5;
    for (int tile = blockIdx.x; tile < ntm * ntn; tile += gridDim.x) {
        const int tm = tile / ntn, tn = tile % ntn;
        if (skipctx && ((tm * 128) % LTOT) < CTX) continue;
        const bf16_t* ag = A + (size_t)(tm * 128 + lr) * lda + lc;
        const bf16_t* bg = Bt + (size_t)(tn * 128 + lr) * ldb + lc;
        f32x16 acc[2][2];
        {
            const f32x16 z16 = {0.f, 0.f, 0.f, 0.f, 0.f, 0.f, 0.f, 0.f, 0.f, 0.f, 0.f, 0.f, 0.f, 0.f, 0.f, 0.f};
            acc[0][0] = z16; acc[0][1] = z16; acc[1][0] = z16; acc[1][1] = z16;
        }
        u32x4 ra0[4], rb0[4], ra1[4], rb1[4];
#define G2_LOAD(RA, RB, kk_) { const int kq = (kk_) < K ? (kk_) : 0; _Pragma("unroll") for (int i = 0; i < 4; ++i) { RA[i] = *(const u32x4*)(ag + (size_t)(32 * i) * lda + kq); RB[i] = *(const u32x4*)(bg + (size_t)(32 * i) * ldb + kq); } }
#define G2_STORE(RA, RB) { _Pragma("unroll") for (int i = 0; i < 4; ++i) { *(u32x4*)(As + (lr + 32 * i) * G2_LD + lc) = RA[i]; *(u32x4*)(Bs + (lr + 32 * i) * G2_LD + lc) = RB[i]; } }
#define G2_COMPUTE() { _Pragma("unroll") for (int kk = 0; kk < 4; ++kk) { bf16x8 a[2], b[2]; \
            _Pragma("unroll") for (int i = 0; i < 2; ++i) a[i] = *(const bf16x8*)(As + (wm + 32 * i + fr) * G2_LD + 16 * kk + 8 * fh); \
            _Pragma("unroll") for (int j = 0; j < 2; ++j) b[j] = *(const bf16x8*)(Bs + (wn + 32 * j + fr) * G2_LD + 16 * kk + 8 * fh); \
            _Pragma("unroll") for (int i = 0; i < 2; ++i) _Pragma("unroll") for (int j = 0; j < 2; ++j) acc[i][j] = __builtin_amdgcn_mfma_f32_32x32x16_bf16(a[i], b[j], acc[i][j], 0, 0, 0); } }
        G2_LOAD(ra0, rb0, 0)
        G2_LOAD(ra1, rb1, 64)
        __syncthreads();
        G2_STORE(ra0, rb0)
        __syncthreads();
        G2_LOAD(ra0, rb0, 128)
        for (int k0 = 0; k0 < K; k0 += 128) {
            G2_COMPUTE()
            __syncthreads();
            G2_STORE(ra1, rb1)
            __syncthreads();
            G2_LOAD(ra1, rb1, k0 + 192)
            G2_COMPUTE()
            if (k0 + 128 < K) {
                __syncthreads();
                G2_STORE(ra0, rb0)
                __syncthreads();
                G2_LOAD(ra0, rb0, k0 + 256)
            }
        }
#undef G2_LOAD
#undef G2_STORE
#undef G2_COMPUTE
#pragma unroll
        for (int i = 0; i < 2; ++i)
#pragma unroll
            for (int j = 0; j < 2; ++j)
#pragma unroll
                for (int q = 0; q < 16; ++q) epi(tm * 128 + wm + 32 * i + (q & 3) + 8 * (q >> 2) + 4 * fh, tn * 128 + wn + 32 * j + fr, acc[i][j][q]);
    }
}

template <class EPI>
__device__ __forceinline__ void gemm3_bf16(const bf16_t* A, int lda, const bf16_t* Bt, int ldb, int M, int N, int K, bool skipctx, EPI epi, unsigned char* smem, int TMS, int TNS) {
    const int tid = otid(), lane = tid & 63, wave = __builtin_amdgcn_readfirstlane(tid >> 6);
    const int ntm = M / 128, ntn = N / 128, nkt = K / 64;
    const int wm = (wave >> 1) * 64, wn = (wave & 1) * 64;
    const int fr = lane & 31, fh = lane >> 5;
    const int rr = lane >> 3, cc = lane & 7;
    const int gcol = (cc ^ rr) * 8;
    const int nSm = (ntm + TMS - 1) / TMS, nSn = (ntn + TNS - 1) / TNS, S = TMS * TNS;
    const int xg = blockIdx.x & 7, lb = blockIdx.x >> 3, nlb = gridDim.x >> 3;
    for (int st = xg; st < nSm * nSn; st += 8)
    for (int t = lb; t < S; t += nlb) {
        const int tm = (st / nSn) * TMS + t % TMS, tn = (st % nSn) * TNS + t / TMS;
        if (tm >= ntm || tn >= ntn) continue;
        if (skipctx && ((tm * 128) % LTOT) < CTX) continue;
        const bf16_t* ag = A + (size_t)(tm * 128 + 32 * wave + rr) * lda + gcol;
        const bf16_t* bg = Bt + (size_t)(tn * 128 + 32 * wave + rr) * ldb + gcol;
        f32x16 acc[2][2];
        {
            const f32x16 z16 = {0.f, 0.f, 0.f, 0.f, 0.f, 0.f, 0.f, 0.f, 0.f, 0.f, 0.f, 0.f, 0.f, 0.f, 0.f, 0.f};
            acc[0][0] = z16; acc[0][1] = z16; acc[1][0] = z16; acc[1][1] = z16;
        }
#define G3_ISSUE(kt_, b_) { unsigned char* la_ = smem + (b_) * 32768 + (32 * wave) * 128; unsigned char* lb_ = la_ + 16384; \
            _Pragma("unroll") for (int q = 0; q < 4; ++q) { \
                __builtin_amdgcn_global_load_lds((const unsigned*)(ag + (size_t)(8 * q) * lda + (kt_) * 64), (LAS unsigned*)(la_ + q * 1024), 16, 0, 0); \
                __builtin_amdgcn_global_load_lds((const unsigned*)(bg + (size_t)(8 * q) * ldb + (kt_) * 64), (LAS unsigned*)(lb_ + q * 1024), 16, 0, 0); } }
        __syncthreads();
        G3_ISSUE(0, 0)
        asm volatile("s_waitcnt vmcnt(0)" ::: "memory");
        __syncthreads();
        for (int kt = 0; kt < nkt; ++kt) {
            if (kt + 1 < nkt) G3_ISSUE(kt + 1, (kt + 1) & 1)
            const unsigned char* As = smem + (kt & 1) * 32768;
            const unsigned char* Bs = As + 16384;
#pragma unroll
            for (int kk = 0; kk < 4; ++kk) {
                bf16x8 a[2], b[2];
#pragma unroll
                for (int i = 0; i < 2; ++i) { const int r = wm + 32 * i + fr; a[i] = *(const bf16x8*)(As + r * 128 + (((2 * kk + fh) ^ (r & 7)) << 4)); }
#pragma unroll
                for (int j = 0; j < 2; ++j) { const int r = wn + 32 * j + fr; b[j] = *(const bf16x8*)(Bs + r * 128 + (((2 * kk + fh) ^ (r & 7)) << 4)); }
#pragma unroll
                for (int i = 0; i < 2; ++i)
#pragma unroll
                    for (int j = 0; j < 2; ++j) acc[i][j] = __builtin_amdgcn_mfma_f32_32x32x16_bf16(b[j], a[i], acc[i][j], 0, 0, 0);
            }
            asm volatile("s_waitcnt vmcnt(0)" ::: "memory");
            __syncthreads();
        }
#undef G3_ISSUE
#pragma unroll
        for (int i = 0; i < 2; ++i)
#pragma unroll
            for (int j = 0; j < 2; ++j)
#pragma unroll
                for (int g = 0; g < 4; ++g)
                    epi.store4(tm * 128 + wm + 32 * i + fr, tn * 128 + wn + 32 * j + 8 * g + 4 * fh, acc[i][j][4 * g], acc[i][j][4 * g + 1], acc[i][j][4 * g + 2], acc[i][j][4 * g + 3]);
    }
}
struct Epi4Bf16 { bf16_t* C; int ldc;
    __device__ __forceinline__ void store4(int r, int c, float v0, float v1, float v2, float v3) const {
        *(uint2*)(C + (size_t)r * ldc + c) = make_uint2(f2bf(v0) | ((unsigned)f2bf(v1) << 16), f2bf(v2) | ((unsigned)f2bf(v3) << 16)); } };
struct Epi4F32 { float* C; int ldc;
    __device__ __forceinline__ void store4(int r, int c, float v0, float v1, float v2, float v3) const { *(f32x4*)(C + (size_t)r * ldc + c) = (f32x4){v0, v1, v2, v3}; } };
struct Epi4Inproj { bf16_t* C; const float* lbt; bf16_t* hgt;
    __device__ __forceinline__ float tr(int c, float v) const {
        if (c >= 256 && c < 1536) {
            if (c < 512 || c >= 1280) v = siluf_(v);
            else if (c >= 768) { const float lb = lbt[c - 768]; v = __logf(lb + (1.f - lb) * sigmoidf_(v)); }
        }
        return v;
    }
    __device__ __forceinline__ void store4(int r, int c, float v0, float v1, float v2, float v3) const {
        v0 = tr(c, v0); v1 = tr(c + 1, v1); v2 = tr(c + 2, v2); v3 = tr(c + 3, v3);
        if (c >= 256 && c < 1280) {
            const int e = c - 256, f = e >> 8, hd = (e >> 6) & 3, ch = e & 63;
            bf16_t* d = hgt + ((((size_t)(r >> 4) * 4 + hd) * 4 + f) * 64 + ch) * 16 + (r & 15);
            d[0] = f2bf(v0); d[16] = f2bf(v1); d[32] = f2bf(v2); d[48] = f2bf(v3);
        } else
            *(uint2*)(C + (size_t)r * PIN + c) = make_uint2(pk2bf(v0, v1), pk2bf(v2, v3));
    } };
struct EpiInproj {
    bf16_t* C; const float* lbt;
    __device__ __forceinline__ void operator()(int r, int c, float v) const {
        if (c >= 256 && c < 1536) {
            if (c < 512 || c >= 1280) v = siluf_(v);
            else if (c >= 768) { const float lb = lbt[c - 768]; v = __logf(lb + (1.f - lb) * sigmoidf_(v)); }
        }
        C[(size_t)r * PIN + c] = f2bf(v);
    }
};
struct EpiBf16 { bf16_t* C; int ldc; __device__ __forceinline__ void operator()(int r, int c, float v) const { C[(size_t)r * ldc + c] = f2bf(v); } };
struct EpiF32 { float* C; int ldc; __device__ __forceinline__ void operator()(int r, int c, float v) const { C[(size_t)r * ldc + c] = v; } };

__device__ __forceinline__ void phase_rwprep(const Params& P, int l, unsigned char* smem) {
    const int tid = otid();
    const bf16_t* Pb = (const bf16_t*)(P.ws + OFF_P);
    bf16_t* RW = (bf16_t*)(P.ws + OFF_RW);
    const float* mu = P.in[24] + l * 1920;
    const float* k_k = P.in[30] + l * 512;
    float* tw = (float*)smem;
    float* al = tw + 2 * 8 * 64;
    float* kk2 = al + 2 * 8 * 64;
    float* nrm = kk2 + 8 * 512;
    for (int u = blockIdx.x; u < MROWS / 8; u += gridDim.x) {
        const int r0 = u * 8;
        __syncthreads();
        for (int i = 0; i < 8; ++i) {
            const int row = r0 + i, p = row % LTOT;
            int nb[4]; bool ok[4];
            if (p < CTX) {
                nb[0] = row - 1; ok[0] = p > 0; nb[1] = row + 1; ok[1] = p < CTX - 1; nb[2] = nb[0]; ok[2] = ok[0]; nb[3] = nb[1]; ok[3] = ok[1];
            } else {
                const int t = p - CTX, gr = t >> 6, gc = t & 63;
                nb[0] = row - 1; ok[0] = gc > 0; nb[1] = row + 1; ok[1] = gc < 63; nb[2] = row - 64; ok[2] = gr > 0; nb[3] = row + 64; ok[3] = gr < 63;
            }
            for (int c = tid; c < 1920; c += 256) {
                const int m = c & 3;
                const float pv = bf2f(Pb[(size_t)row * PIN + 1536 + c]);
                const float nv = ok[m] ? bf2f(Pb[(size_t)nb[m] * PIN + 1536 + c]) : 0.f;
                const float s = pv + mu[c] * (nv - pv);
                bf16_t* rw = RW + (size_t)row * RWW;
                if (c < 512) rw[c] = f2bf(s);
                else if (c < 1024) { rw[c] = f2bf(s); kk2[i * 512 + (c - 512)] = s * k_k[c - 512]; }
                else if (c < 1536) rw[c] = f2bf(s);
                else if (c < 1664) rw[4096 + (c - 1536)] = f2bf(sigmoidf_(s));
                else if (c < 1728) tw[(0 * 8 + i) * 64 + (c - 1664)] = tanhf(s);
                else if (c < 1792) tw[(1 * 8 + i) * 64 + (c - 1728)] = tanhf(s);
                else if (c < 1856) al[(0 * 8 + i) * 64 + (c - 1792)] = s;
                else al[(1 * 8 + i) * 64 + (c - 1856)] = s;
            }
        }
        __syncthreads();
        {
            const int pair = tid >> 2, q = tid & 3, i = pair >> 3, hd = pair & 7;
            float s = 0.f;
            for (int j = 0; j < 16; ++j) { const float v = kk2[i * 512 + hd * 64 + q * 16 + j]; s += v * v; }
            s += __shfl_xor(s, 1, 64); s += __shfl_xor(s, 2, 64);
            if (q == 0) nrm[pair] = fmaxf(sqrtf(s), 1e-12f);
        }
        __syncthreads();
        for (int e = tid; e < 8 * 512; e += 256) {
            const int i = e >> 9, c = e & 511;
            RW[(size_t)(r0 + i) * RWW + 1536 + c] = f2bf(kk2[e] / nrm[i * 8 + (c >> 6)]);
        }
        for (int d = 0; d < 2; ++d) {
            const float* wup = P.in[26] + (size_t)(l * 2 + d) * 64 * 512;
            const float* aup = P.in[28] + (size_t)(l * 2 + d) * 64 * 512;
            const float* w0 = P.in[25] + (l * 2 + d) * 512;
            const float* a0 = P.in[27] + (l * 2 + d) * 512;
            float zw[2][8], za[2][8];
#pragma unroll
            for (int i = 0; i < 8; ++i) { zw[0][i] = zw[1][i] = za[0][i] = za[1][i] = 0.f; }
            for (int j = 0; j < 64; ++j) {
                const float w_0 = wup[j * 512 + tid], w_1 = wup[j * 512 + tid + 256];
                const float a_0 = aup[j * 512 + tid], a_1 = aup[j * 512 + tid + 256];
#pragma unroll
                for (int i = 0; i < 8; ++i) {
                    const float t = tw[(d * 8 + i) * 64 + j], a = al[(d * 8 + i) * 64 + j];
                    zw[0][i] += t * w_0; zw[1][i] += t * w_1; za[0][i] += a * a_0; za[1][i] += a * a_1;
                }
            }
#pragma unroll
            for (int i = 0; i < 8; ++i) {
                bf16_t* rw = RW + (size_t)(r0 + i) * RWW;
#pragma unroll
                for (int h = 0; h < 2; ++h) {
                    const int c = tid + 256 * h;
                    rw[2048 + d * 512 + c] = f2bf(sigmoidf_(a0[c] + za[h][i]));
                    rw[3072 + d * 512 + c] = f2bf(-0.60653066f * sigmoidf_(w0[c] + zw[h][i]));
                }
            }
        }
    }
}

__device__ __forceinline__ void scan_rwkv(const Params& P, int l, int item) {
    const int lane = otid() & 63;
    const int dir = item & 1, hd = (item >> 1) & 7, b = item >> 4;
    const bf16_t* RW = (const bf16_t*)(P.ws + OFF_RW);
    bf16_t* YP = (bf16_t*)(P.ws + OFF_YP) + (size_t)dir * MROWS * DM;
    const float ka = P.in[31][l * 512 + hd * 64 + lane];
    float S[64];
#pragma unroll
    for (int k = 0; k < 64; ++k) S[k] = 0.f;
    for (int tau = 0; tau < LTOT; ++tau) {
        const int row = row_of(b, dir, tau);
#ifdef EXP_T2
        if ((tau & 127) == 0) {
            float* RXL = (float*)(P.ws + OFF_RXL);
            const size_t itm = (size_t)item * 34 + (tau >> 7);
#pragma unroll
            for (int kk = 0; kk < 64; ++kk) RXL[((itm * 16 + (kk >> 4) * 4 + (lane >> 4)) * 64 + ((kk >> 2) & 3) * 16 + (lane & 15)) * 4 + (kk & 3)] = S[kk];
        }
#endif
        const bf16_t* rw = RW + (size_t)row * RWW + hd * 64 + lane;
        const float r = bf2f(rw[0]), k = bf2f(rw[512]), v = bf2f(rw[1024]), kap = bf2f(rw[1536]);
        const float a = bf2f(rw[2048 + dir * 512]), lw = bf2f(rw[3072 + dir * 512]);
        const float w = __expf(lw), kt = k * (1.f + (a - 1.f) * ka), beta = kap * a;
        float sk = 0.f;
#pragma unroll
        for (int kk = 0; kk < 64; ++kk) { sk += S[kk] * rdlane(kap, kk); if ((kk & 7) == 7) __builtin_amdgcn_sched_barrier(0); }
        float y = 0.f;
#pragma unroll
        for (int kk = 0; kk < 64; ++kk) {
            const float s = S[kk] * rdlane(w, kk) - sk * rdlane(beta, kk) + v * rdlane(kt, kk);
            S[kk] = s;
            y += s * rdlane(r, kk);
            if ((kk & 3) == 3) __builtin_amdgcn_sched_barrier(0);
        }
        YP[(size_t)row * DM + 512 + hd * 64 + lane] = f2bf(y);
    }
}
__device__ __forceinline__ void scan_hgrn(const Params& P, int l, int item) {
    const int lane = otid() & 63;
    const int dir = item & 1, hd = (item >> 1) & 3, b = item >> 3;
    const bf16_t* Pb = (const bf16_t*)(P.ws + OFF_P);
    bf16_t* YP = (bf16_t*)(P.ws + OFF_YP) + (size_t)dir * MROWS * DM;
    float lb = 0.f;
    if (l == 1) {
        const float a0 = P.in[22][(dir * 2 + 0) * 256 + hd * 64 + lane], a1 = P.in[22][(dir * 2 + 1) * 256 + hd * 64 + lane];
        const float m = fmaxf(a0, a1), e0 = __expf(a0 - m), e1 = __expf(a1 - m);
        lb = e1 / (e0 + e1);
    }
    float S[64];
#pragma unroll
    for (int k = 0; k < 64; ++k) S[k] = 0.f;
    for (int tau = 0; tau < LTOT; ++tau) {
        const int row = row_of(b, dir, tau);
        const bf16_t* pr = Pb + (size_t)row * PIN + 256 + hd * 64 + lane;
        const float q = siluf_(bf2f(pr[0])), v = bf2f(pr[256]);
        const float f = lb + (1.f - lb) * sigmoidf_(bf2f(pr[512 + dir * 256]));
        const float kq = 1.f - f;
        float o = 0.f;
#pragma unroll
        for (int dk = 0; dk < 64; ++dk) {
            const float s = rdlane(f, dk) * S[dk] + rdlane(kq, dk) * v;
            S[dk] = s;
            o += s * rdlane(q, dk);
            if ((dk & 7) == 7) __builtin_amdgcn_sched_barrier(0);
        }
        YP[(size_t)row * DM + 256 + hd * 64 + lane] = f2bf(o);
    }
}
__device__ __forceinline__ void scan_s5(const Params& P, int l, int item) {
    const int lane = otid() & 63;
    const int dir = item & 1, g = (item >> 1) & 15, b = item >> 5;
    const bf16_t* Pb = (const bf16_t*)(P.ws + OFF_P);
    bf16_t* YP = (bf16_t*)(P.ws + OFF_YP) + (size_t)dir * MROWS * DM;
    const int ldg = (l * 2 + dir) * 16 + g;
    const float dt = expf(P.in[14][ldg]);
    const float lre = P.in[12][ldg * 64 + lane], lim = P.in[13][ldg * 64 + lane];
    const float mag = expf(lre * dt), ang = lim * dt;
    const float lb_re = mag * cosf(ang), lb_im = mag * sinf(ang);
    const float den = lre * lre + lim * lim, nr = lb_re - 1.f, ni = lb_im;
    const float co_re = (nr * lre + ni * lim) / den, co_im = (ni * lre - nr * lim) / den;
    float bb_re[16], bb_im[16], c_re[16], c_im[16];
#pragma unroll
    for (int h = 0; h < 16; ++h) {
        const float br = P.in[15][((size_t)ldg * 64 + lane) * 16 + h], bi = P.in[16][((size_t)ldg * 64 + lane) * 16 + h];
        bb_re[h] = co_re * br - co_im * bi; bb_im[h] = co_re * bi + co_im * br;
        c_re[h] = P.in[17][((size_t)ldg * 16 + h) * 64 + lane]; c_im[h] = P.in[18][((size_t)ldg * 16 + h) * 64 + lane];
    }
    float s_re = 0.f, s_im = 0.f;
    for (int tau = 0; tau < LTOT; ++tau) {
        const int row = row_of(b, dir, tau);
        const float uv = bf2f(Pb[(size_t)row * PIN + g * 16 + (lane & 15)]);
        float bu_re = 0.f, bu_im = 0.f;
#pragma unroll
        for (int h = 0; h < 16; ++h) { const float uh = rdlane(uv, h); bu_re += bb_re[h] * uh; bu_im += bb_im[h] * uh; }
        const float n_re = lb_re * s_re - lb_im * s_im + bu_re, n_im = lb_re * s_im + lb_im * s_re + bu_im;
        s_re = n_re; s_im = n_im;
        float yo = 0.f;
#pragma unroll
        for (int h = 0; h < 16; ++h) { const float t = wave_sum(c_re[h] * s_re - c_im[h] * s_im); yo = (lane == h) ? t : yo; }
        if (lane < 16) YP[(size_t)row * DM + g * 16 + lane] = f2bf(yo);
    }
}
__device__ __forceinline__ void phase_scans(const Params& P, int l) {
    const int wave = __builtin_amdgcn_readfirstlane(otid() >> 6);
    for (int it = wave * gridDim.x + blockIdx.x; it < 32; it += 4 * gridDim.x) scan_hgrn(P, l, it);
}

__device__ __forceinline__ void phase_post(const Params& P, int l, unsigned char* smem) {
    const int tid = otid();
    const bf16_t* Pb = (const bf16_t*)(P.ws + OFF_P);
    const bf16_t* RW = (const bf16_t*)(P.ws + OFF_RW);
    const bf16_t* YF = (const bf16_t*)(P.ws + OFF_YP);
    const bf16_t* YB = YF + (size_t)MROWS * DM;
    bf16_t* MIX = (bf16_t*)(P.ws + OFF_MIX);
    float* ypre = (float*)smem;
    float* sg = ypre + 8 * 256;
    for (int u = blockIdx.x; u < MROWS / 8; u += gridDim.x) {
        const int r0 = u * 8;
        if (l == 1 && (r0 % LTOT) < CTX) continue;
        __syncthreads();
        for (int i = 0; i < 8; ++i) {
            const int row = r0 + i;
            ypre[i * 256 + tid] = bf2f(YF[(size_t)row * DM + tid]);
        }
        for (int e = tid; e < 8 * 128; e += 256) sg[e] = bf2f(RW[(size_t)(r0 + (e >> 7)) * RWW + 4096 + (e & 127)]);
        __syncthreads();
        {
            float z[8];
            const float gb = P.in[21][l * 256 + tid];
#pragma unroll
            for (int i = 0; i < 8; ++i) z[i] = gb;
            const float* gw = P.in[20] + (size_t)l * 256 * 256 + tid;
            for (int k = 0; k < 256; ++k) {
                const float w = gw[k * 256];
#pragma unroll
                for (int i = 0; i < 8; ++i) z[i] += ypre[i * 256 + k] * w;
            }
#pragma unroll
            for (int i = 0; i < 8; ++i) MIX[(size_t)(r0 + i) * DM + tid] = f2bf(ypre[i * 256 + tid] * sigmoidf_(z[i]));
        }
        {
            const int i = tid >> 5, c0 = (tid & 31) * 8, row = r0 + i;
            float o[8], ss = 0.f;
#pragma unroll
            for (int j = 0; j < 8; ++j) { o[j] = bf2f(YF[(size_t)row * DM + 256 + c0 + j]) + bf2f(YB[(size_t)row * DM + 256 + c0 + j]); ss += o[j] * o[j]; }
            ss += __shfl_xor(ss, 1, 64); ss += __shfl_xor(ss, 2, 64); ss += __shfl_xor(ss, 4, 64);
            const float rs = rsqrtf(ss * (1.f / 64.f) + 1e-6f);
#pragma unroll
            for (int j = 0; j < 8; ++j) {
                const float gr = bf2f(Pb[(size_t)row * PIN + 256 + 1024 + c0 + j]);
                MIX[(size_t)row * DM + 256 + c0 + j] = f2bf(o[j] * rs * P.in[23][l * 256 + c0 + j] * siluf_(gr));
            }
        }
        {
            const int i = tid >> 5, c0 = (tid & 31) * 16, row = r0 + i;
            const bf16_t* rw = RW + (size_t)row * RWW;
            float y[16], vv[16], sum = 0.f, bon = 0.f;
#pragma unroll
            for (int j = 0; j < 16; ++j) {
                const int c = c0 + j;
                y[j] = bf2f(YF[(size_t)row * DM + 512 + c]) + bf2f(YB[(size_t)row * DM + 512 + c]);
                sum += y[j];
                const float r = bf2f(rw[c]), k = bf2f(rw[512 + c]), af = bf2f(rw[2048 + c]), ab = bf2f(rw[2560 + c]);
                const float ka = P.in[31][l * 512 + c];
                vv[j] = bf2f(rw[1024 + c]);
                bon += r * P.in[32][l * 512 + c] * (k * (1.f + (af - 1.f) * ka) + k * (1.f + (ab - 1.f) * ka));
            }
            sum += __shfl_xor(sum, 1, 64); sum += __shfl_xor(sum, 2, 64);
            bon += __shfl_xor(bon, 1, 64); bon += __shfl_xor(bon, 2, 64);
            const float mean = sum * (1.f / 64.f);
            float var = 0.f;
#pragma unroll
            for (int j = 0; j < 16; ++j) { const float d = y[j] - mean; var += d * d; }
            var += __shfl_xor(var, 1, 64); var += __shfl_xor(var, 2, 64);
            const float rs = rsqrtf(var * (1.f / 64.f) + 64e-5f);
            float g[16];
#pragma unroll
            for (int j = 0; j < 16; ++j) g[j] = 0.f;
            const float* gup = P.in[29] + (size_t)l * 128 * 512 + c0;
            for (int jj = 0; jj < 128; ++jj) {
                const float s = sg[i * 128 + jj];
                const float4 w0 = *(const float4*)(gup + jj * 512), w1 = *(const float4*)(gup + jj * 512 + 4), w2 = *(const float4*)(gup + jj * 512 + 8), w3 = *(const float4*)(gup + jj * 512 + 12);
                g[0] += s * w0.x; g[1] += s * w0.y; g[2] += s * w0.z; g[3] += s * w0.w;
                g[4] += s * w1.x; g[5] += s * w1.y; g[6] += s * w1.z; g[7] += s * w1.w;
                g[8] += s * w2.x; g[9] += s * w2.y; g[10] += s * w2.z; g[11] += s * w2.w;
                g[12] += s * w3.x; g[13] += s * w3.y; g[14] += s * w3.z; g[15] += s * w3.w;
            }
#pragma unroll
            for (int j = 0; j < 16; ++j) {
                const int c = c0 + j;
                const float yn = (y[j] - mean) * rs * P.in[33][l * 512 + c] + P.in[34][l * 512 + c];
                MIX[(size_t)row * DM + 512 + c] = f2bf((yn + bon * vv[j]) * g[j]);
            }
        }
    }
}

__device__ __forceinline__ void phase_ln1(const Params& P, int l) {
    const int lane = otid() & 63, wave = __builtin_amdgcn_readfirstlane(otid() >> 6);
    float* XS = (float*)(P.ws + OFF_XS);
    const float* TMP = (const float*)(P.ws + OFF_TMP);
    const float* MOD = (const float*)(P.ws + OFF_MOD);
    bf16_t* H2 = (bf16_t*)(P.ws + OFF_H2);
    for (int row = blockIdx.x * 4 + wave; row < MROWS; row += gridDim.x * 4) {
        if (l == 1 && (row % LTOT) < CTX) continue;
        const float* mod = MOD + (size_t)(l * 5 + modrow(row)) * 6144;
        float v[16]; float s = 0.f;
#pragma unroll
        for (int j = 0; j < 4; ++j) {
            const int d = 256 * j + 4 * lane;
            const float4 x = *(const float4*)(XS + (size_t)row * DM + d), t = *(const float4*)(TMP + (size_t)row * DM + d), g = *(const float4*)(mod + 2048 + d);
            v[4 * j + 0] = ALPHA * x.x + g.x * t.x; v[4 * j + 1] = ALPHA * x.y + g.y * t.y; v[4 * j + 2] = ALPHA * x.z + g.z * t.z; v[4 * j + 3] = ALPHA * x.w + g.w * t.w;
            s += v[4 * j] + v[4 * j + 1] + v[4 * j + 2] + v[4 * j + 3];
        }
        const float mean = wave_sum(s) * (1.f / 1024.f);
        float q = 0.f;
#pragma unroll
        for (int j = 0; j < 16; ++j) { const float d = v[j] - mean; q += d * d; }
        const float rs = rsqrtf(wave_sum(q) * (1.f / 1024.f) + 1e-5f);
#pragma unroll
        for (int j = 0; j < 4; ++j) {
            const int d = 256 * j + 4 * lane;
            const float4 gg = *(const float4*)(P.in[8] + l * 1024 + d), bb = *(const float4*)(P.in[9] + l * 1024 + d);
            const float4 sh = *(const float4*)(mod + 3072 + d), sc = *(const float4*)(mod + 4096 + d);
            float4 o;
            o.x = (v[4 * j + 0] - mean) * rs * gg.x + bb.x; o.y = (v[4 * j + 1] - mean) * rs * gg.y + bb.y;
            o.z = (v[4 * j + 2] - mean) * rs * gg.z + bb.z; o.w = (v[4 * j + 3] - mean) * rs * gg.w + bb.w;
            *(float4*)(XS + (size_t)row * DM + d) = o;
            ushort4 h;
            h.x = f2bf(o.x * (1.f + sc.x) + sh.x); h.y = f2bf(o.y * (1.f + sc.y) + sh.y); h.z = f2bf(o.z * (1.f + sc.z) + sh.z); h.w = f2bf(o.w * (1.f + sc.w) + sh.w);
            *(ushort4*)(H2 + (size_t)row * DM + d) = h;
        }
    }
}

__device__ __forceinline__ unsigned f2ord(float f) { const unsigned u = __float_as_uint(f); return u ^ ((u >> 31) ? 0xFFFFFFFFu : 0x80000000u); }
__device__ __forceinline__ float ord2f(unsigned u) { return __uint_as_float((u >> 31) ? (u ^ 0x80000000u) : ~u); }
__device__ __forceinline__ void phase_topk(const Params& P, int l) {
    const int tid = otid();
    const bf16_t* Q = (const bf16_t*)(P.ws + OFF_Q);
    int* IDX = (int*)(P.ws + OFF_IDX);
    float* GATE = (float*)(P.ws + OFF_GATE);
    for (int u = blockIdx.x; u < 8 * (MROWS / 256); u += gridDim.x) {
        const int hd = u / (MROWS / 256), rb = u % (MROWS / 256);
        const int row = rb * 256 + tid;
        if (l == 1 && (row % LTOT) < CTX) continue;
        unsigned top[2][16];
#pragma unroll
        for (int half = 0; half < 2; ++half) {
            float q[128];
            const bf16_t* qp = Q + (size_t)row * 2048 + hd * 256 + half * 128;
#pragma unroll
            for (int d8 = 0; d8 < 16; ++d8) {
                const bf16x8 v = *(const bf16x8*)(qp + d8 * 8);
#pragma unroll
                for (int j = 0; j < 8; ++j) q[d8 * 8 + j] = bf2f((bf16_t)v[j]);
            }
#pragma unroll
            for (int j = 0; j < 16; ++j) top[half][j] = 0u;
            const float* kp = P.in[36] + ((size_t)((l * 8 + hd) * 2 + half)) * 128 * 128;
            for (int key = 0; key < 128; ++key) {
                const float* kr = kp + key * 128;
                float s0 = 0.f, s1 = 0.f, s2 = 0.f, s3 = 0.f;
#pragma unroll
                for (int d = 0; d < 128; d += 4) { s0 += q[d] * kr[d]; s1 += q[d + 1] * kr[d + 1]; s2 += q[d + 2] * kr[d + 2]; s3 += q[d + 3] * kr[d + 3]; if ((d & 31) == 28) __builtin_amdgcn_sched_barrier(0); }
                unsigned x = (f2ord((s0 + s1) + (s2 + s3)) & 0xFFFFFF80u) | (unsigned)(127 - key);
#pragma unroll
                for (int j = 0; j < 16; ++j) { const unsigned t = top[half][j]; const unsigned mx = x > t ? x : t; x = x > t ? t : x; top[half][j] = mx; }
            }
        }
        float cs[16]; int ce[16];
#pragma unroll
        for (int j = 0; j < 16; ++j) { cs[j] = -3.0e38f; ce[j] = 0; }
#pragma unroll
        for (int i = 0; i < 16; ++i) {
            const float s1v = ord2f(top[0][i] & 0xFFFFFF80u); const int i1 = 127 - (int)(top[0][i] & 127u);
#pragma unroll
            for (int j = 0; j < 16; ++j) {
                if ((i + 1) * (j + 1) <= 16) {
                    float x = s1v + ord2f(top[1][j] & 0xFFFFFF80u); int xe = i1 * 128 + (127 - (int)(top[1][j] & 127u));
#pragma unroll
                    for (int t = 0; t < 16; ++t) {
                        const bool gt = x > cs[t];
                        const float ts = cs[t]; const int te = ce[t];
                        cs[t] = gt ? x : ts; ce[t] = gt ? xe : te; x = gt ? ts : x; xe = gt ? te : xe;
                    }
                }
            }
        }
        float den = 0.f, ex[16];
#pragma unroll
        for (int t = 0; t < 16; ++t) { ex[t] = __expf(cs[t] - cs[0]); den += ex[t]; }
        const float inv = 1.f / den;
#pragma unroll
        for (int t = 0; t < 16; ++t) { IDX[(size_t)row * 128 + hd * 16 + t] = ce[t]; GATE[(size_t)row * 128 + hd * 16 + t] = ex[t] * inv; }
    }
}


__device__ __forceinline__ void ce_desc(unsigned& a, unsigned& b) { const unsigned hi = a > b ? a : b, lo = a > b ? b : a; a = hi; b = lo; }
__device__ __forceinline__ void bitonic_sort16(unsigned (&u)[16]) {
#pragma unroll
    for (int k = 2; k <= 16; k <<= 1)
#pragma unroll
        for (int j = k >> 1; j > 0; j >>= 1)
#pragma unroll
            for (int i = 0; i < 16; ++i) {
                const int p = i ^ j;
                if (p > i) { if ((i & k) == 0) ce_desc(u[i], u[p]); else ce_desc(u[p], u[i]); }
            }
}
__device__ __forceinline__ void bitonic_merge16(unsigned (&u)[16]) {
#pragma unroll
    for (int j = 8; j > 0; j >>= 1)
#pragma unroll
        for (int i = 0; i < 16; ++i) { const int p = i ^ j; if (p > i) ce_desc(u[i], u[p]); }
}
__device__ __forceinline__ void xlane_top16(unsigned (&u)[16], int xr) {
    unsigned o[16];
#pragma unroll
    for (int i = 0; i < 16; ++i) o[i] = (unsigned)__shfl_xor((int)u[15 - i], xr, 64);
#pragma unroll
    for (int i = 0; i < 16; ++i) u[i] = u[i] > o[i] ? u[i] : o[i];
    bitonic_merge16(u);
}
__device__ __forceinline__ void phase_topk2(const Params& P, int l, unsigned char* smem) {
    const int lane = otid() & 63, wave = __builtin_amdgcn_readfirstlane(otid() >> 6), fr = lane & 15, fq = lane >> 4;
    const bf16_t* Q = (const bf16_t*)(P.ws + OFF_Q);
    const bf16_t* KB = (const bf16_t*)(P.ws + OFF_KEYB);
    int* IDX = (int*)(P.ws + OFF_IDX);
    float* GATE = (float*)(P.ws + OFF_GATE);
    unsigned char* ids = smem + wave * 512;
    for (int it = blockIdx.x * 4 + wave; it < (MROWS / 16) * 8; it += gridDim.x * 4) {
        const int rt = it >> 3, hd = it & 7, row0 = rt * 16;
        if (l == 1 && (row0 % LTOT) < CTX) continue;
        unsigned top[2][16];
#pragma unroll
        for (int half = 0; half < 2; ++half) {
            f32x4 acc[8];
#pragma unroll
            for (int mi = 0; mi < 8; ++mi) acc[mi] = (f32x4){0.f, 0.f, 0.f, 0.f};
            const bf16_t* kp = KB + ((size_t)((l * 8 + hd) * 2 + half) * 128 + fr) * 128 + 8 * fq;
            const bf16_t* qp = Q + (size_t)(row0 + fr) * 2048 + hd * 256 + half * 128 + 8 * fq;
#pragma unroll
            for (int ks = 0; ks < 4; ++ks) {
                const bf16x8 qb = *(const bf16x8*)(qp + 32 * ks);
#pragma unroll
                for (int mi = 0; mi < 8; ++mi) acc[mi] = mfma32(*(const bf16x8*)(kp + (size_t)(16 * mi) * 128 + 32 * ks), qb, acc[mi]);
            }
            unsigned ua[16], ub[16];
#pragma unroll
            for (int mi = 0; mi < 4; ++mi)
#pragma unroll
                for (int r = 0; r < 4; ++r) {
                    ua[mi * 4 + r] = (f2ord(acc[mi][r]) & 0xFFFFFF80u) | (unsigned)(127 - (16 * mi + 4 * fq + r));
                    ub[mi * 4 + r] = (f2ord(acc[mi + 4][r]) & 0xFFFFFF80u) | (unsigned)(127 - (16 * (mi + 4) + 4 * fq + r));
                }
            bitonic_sort16(ua); bitonic_sort16(ub);
#pragma unroll
            for (int i = 0; i < 16; ++i) ua[i] = ua[i] > ub[15 - i] ? ua[i] : ub[15 - i];
            bitonic_merge16(ua);
            xlane_top16(ua, 16); xlane_top16(ua, 32);
#pragma unroll
            for (int i = 0; i < 16; ++i) top[half][i] = ua[i];
        }
        if (fq == 0) {
            unsigned w[8];
#pragma unroll
            for (int i = 0; i < 8; ++i) {
                const unsigned* t = i < 4 ? &top[0][4 * i] : &top[1][4 * (i - 4)];
                w[i] = (127u - (t[0] & 127u)) | ((127u - (t[1] & 127u)) << 8) | ((127u - (t[2] & 127u)) << 16) | ((127u - (t[3] & 127u)) << 24);
            }
            *(uint4*)(ids + fr * 32) = make_uint4(w[0], w[1], w[2], w[3]);
            *(uint4*)(ids + fr * 32 + 16) = make_uint4(w[4], w[5], w[6], w[7]);
        }
        float s2v[16];
#pragma unroll
        for (int j = 0; j < 16; ++j) s2v[j] = ord2f(top[1][j] & 0xFFFFFF80u);
        float s1r[4];
#pragma unroll
        for (int m = 0; m < 4; ++m) {
            const unsigned t = fq == 0 ? top[0][4 * m] : (fq == 1 ? top[0][4 * m + 1] : (fq == 2 ? top[0][4 * m + 2] : top[0][4 * m + 3]));
            s1r[m] = ord2f(t & 0xFFFFFF80u);
        }
        unsigned cu[16];
#pragma unroll
        for (int j = 0; j < 16; ++j) cu[j] = (f2ord(s1r[0] + s2v[j]) & 0xFFFFFF00u) | (unsigned)((fq << 4) | j);
        {
            unsigned ex[5];
            ex[0] = (f2ord(s1r[1] + s2v[0]) & 0xFFFFFF00u) | (unsigned)(((4 + fq) << 4) | 0);
            ex[1] = (f2ord(s1r[1] + s2v[1]) & 0xFFFFFF00u) | (unsigned)(((4 + fq) << 4) | 1);
            ex[2] = (f2ord(s1r[1] + s2v[2]) & 0xFFFFFF00u) | (unsigned)(((4 + fq) << 4) | 2);
            ex[3] = (f2ord(s1r[2] + s2v[0]) & 0xFFFFFF00u) | (unsigned)(((8 + fq) << 4) | 0);
            ex[4] = (f2ord(s1r[3] + s2v[0]) & 0xFFFFFF00u) | (unsigned)(((12 + fq) << 4) | 0);
#pragma unroll
            for (int e = 0; e < 5; ++e) {
                unsigned x = ex[e];
#pragma unroll
                for (int t = 0; t < 16; ++t) { const unsigned c = cu[t]; const unsigned mx = x > c ? x : c; x = x > c ? c : x; cu[t] = mx; }
            }
        }
        xlane_top16(cu, 16); xlane_top16(cu, 32);
        if (fq == 0) {
            float ex[16], den = 0.f; int eid[16];
            const float m0 = ord2f(cu[0] & 0xFFFFFF00u);
#pragma unroll
            for (int t = 0; t < 16; ++t) {
                ex[t] = __expf(ord2f(cu[t] & 0xFFFFFF00u) - m0); den += ex[t];
                const int i = (cu[t] >> 4) & 15, j = cu[t] & 15;
                eid[t] = (int)ids[fr * 32 + i] * 128 + (int)ids[fr * 32 + 16 + j];
            }
            const float inv = 1.f / den;
            int* ip = IDX + (size_t)(row0 + fr) * 128 + hd * 16;
            float* gp = GATE + (size_t)(row0 + fr) * 128 + hd * 16;
#pragma unroll
            for (int t = 0; t < 16; t += 4) {
                *(int4*)(ip + t) = make_int4(eid[t], eid[t + 1], eid[t + 2], eid[t + 3]);
                *(float4*)(gp + t) = make_float4(ex[t] * inv, ex[t + 1] * inv, ex[t + 2] * inv, ex[t + 3] * inv);
            }
        }
    }
}

__device__ __forceinline__ void phase_tabconv(const Params& P, int l) {
    const float4* U = (const float4*)(P.in[37] + (size_t)l * 16384 * 1024);
    const float4* V = (const float4*)(P.in[38] + (size_t)l * 16384 * 1024);
    ushort4* TU = (ushort4*)(P.ws + OFF_TBU);
    ushort4* TV = (ushort4*)(P.ws + OFF_TBV);
    const size_t n4 = (size_t)16384 * 256;
    for (size_t i = (size_t)blockIdx.x * 256 + otid(); i < n4; i += (size_t)gridDim.x * 256) {
        const float4 a = U[i], b = V[i];
        ushort4 oa, ob;
        oa.x = f2bf(a.x); oa.y = f2bf(a.y); oa.z = f2bf(a.z); oa.w = f2bf(a.w);
        ob.x = f2bf(b.x); ob.y = f2bf(b.y); ob.z = f2bf(b.z); ob.w = f2bf(b.w);
        TU[i] = oa; TV[i] = ob;
    }
}
__device__ __forceinline__ float dot2bf(unsigned a, unsigned b, float acc) { return __builtin_amdgcn_fdot2_f32_bf16(__builtin_bit_cast(bf16x2, a), __builtin_bit_cast(bf16x2, b), acc, false); }
__device__ __forceinline__ float dot8(const uint4& a, const uint4& b, float acc) { acc = dot2bf(a.x, b.x, acc); acc = dot2bf(a.y, b.y, acc); acc = dot2bf(a.z, b.z, acc); return dot2bf(a.w, b.w, acc); }
__device__ __forceinline__ void phase_gather(const Params& P, int l, unsigned char* smem) {
    const int tid = otid(), lane = tid & 63, wave = __builtin_amdgcn_readfirstlane(tid >> 6);
    float* XS = (float*)(P.ws + OFF_XS);
    const float* MOD = (const float*)(P.ws + OFF_MOD);
    const bf16_t* H2 = (const bf16_t*)(P.ws + OFF_H2);
    bf16_t* H = (bf16_t*)(P.ws + OFF_H);
    const int* IDX = (const int*)(P.ws + OFF_IDX);
    const float* GATE = (const float*)(P.ws + OFF_GATE);
    const bf16_t* TU = (const bf16_t*)(P.ws + OFF_TBU);
    const bf16_t* TV = (const bf16_t*)(P.ws + OFF_TBV);
    float* coef = (float*)smem + wave * 128;
    for (int row = blockIdx.x * 4 + wave; row < MROWS; row += gridDim.x * 4) {
        if (l == 1 && (row % LTOT) < CTX) continue;
        const uint4 h0 = *(const uint4*)(H2 + (size_t)row * DM + 8 * lane), h1 = *(const uint4*)(H2 + (size_t)row * DM + 512 + 8 * lane);
        const int e0 = IDX[(size_t)row * 128 + lane], e1 = IDX[(size_t)row * 128 + 64 + lane];
        uint4 ra[8], rb[8];
#define LOADB(T, bt) { _Pragma("unroll") for (int i = 0; i < 8; ++i) { const int k = (bt) * 8 + i; const int e = __builtin_amdgcn_readlane(k < 64 ? e0 : e1, k & 63); \
            const uint4* rp = (const uint4*)((T) + (size_t)e * 1024); ra[i] = rp[lane]; rb[i] = rp[64 + lane]; } }
        for (int bt = 0; bt < 16; ++bt) {
            LOADB(TU, bt)
            float p[8];
#pragma unroll
            for (int i = 0; i < 8; ++i) p[i] = dot8(rb[i], h1, dot8(ra[i], h0, 0.f));
            float q[4], r2[2];
#pragma unroll
            for (int i = 0; i < 4; ++i) { const float sd = (lane & 32) ? p[i] : p[i + 4]; const float rc = __shfl_xor(sd, 32, 64); q[i] = ((lane & 32) ? p[i + 4] : p[i]) + rc; }
#pragma unroll
            for (int i = 0; i < 2; ++i) { const float sd = (lane & 16) ? q[i] : q[i + 2]; const float rc = __shfl_xor(sd, 16, 64); r2[i] = ((lane & 16) ? q[i + 2] : q[i]) + rc; }
            float sv;
            { const float sd = (lane & 8) ? r2[0] : r2[1]; const float rc = __shfl_xor(sd, 8, 64); sv = ((lane & 8) ? r2[1] : r2[0]) + rc; }
            sv += __shfl_xor(sv, 4, 64); sv += __shfl_xor(sv, 2, 64); sv += __shfl_xor(sv, 1, 64);
            if ((lane & 7) == 0) { const int k = bt * 8 + ((lane >> 3) & 7); coef[k] = gelu_tanh(sv) * GATE[(size_t)row * 128 + k]; }
        }
        float acc[16];
#pragma unroll
        for (int j = 0; j < 16; ++j) acc[j] = 0.f;
        for (int bt = 0; bt < 16; ++bt) {
            LOADB(TV, bt)
#pragma unroll
            for (int i = 0; i < 8; ++i) {
                const float c = coef[bt * 8 + i];
                const unsigned w[8] = {ra[i].x, ra[i].y, ra[i].z, ra[i].w, rb[i].x, rb[i].y, rb[i].z, rb[i].w};
#pragma unroll
                for (int j = 0; j < 8; ++j) { acc[2 * j] += c * __uint_as_float(w[j] << 16); acc[2 * j + 1] += c * __uint_as_float(w[j] & 0xFFFF0000u); }
            }
        }
#undef LOADB
        const float* mod = MOD + (size_t)(l * 5 + modrow(row)) * 6144;
        float v[16]; float s = 0.f;
#pragma unroll
        for (int hh = 0; hh < 2; ++hh) {
            const int d = 512 * hh + 8 * lane;
            const float4 x0 = *(const float4*)(XS + (size_t)row * DM + d), x1 = *(const float4*)(XS + (size_t)row * DM + d + 4);
            const float4 g0 = *(const float4*)(mod + 5120 + d), g1 = *(const float4*)(mod + 5120 + d + 4);
            v[8 * hh + 0] = ALPHA * x0.x + g0.x * acc[8 * hh + 0]; v[8 * hh + 1] = ALPHA * x0.y + g0.y * acc[8 * hh + 1];
            v[8 * hh + 2] = ALPHA * x0.z + g0.z * acc[8 * hh + 2]; v[8 * hh + 3] = ALPHA * x0.w + g0.w * acc[8 * hh + 3];
            v[8 * hh + 4] = ALPHA * x1.x + g1.x * acc[8 * hh + 4]; v[8 * hh + 5] = ALPHA * x1.y + g1.y * acc[8 * hh + 5];
            v[8 * hh + 6] = ALPHA * x1.z + g1.z * acc[8 * hh + 6]; v[8 * hh + 7] = ALPHA * x1.w + g1.w * acc[8 * hh + 7];
        }
#pragma unroll
        for (int j = 0; j < 16; ++j) s += v[j];
        const float mean = wave_sum(s) * (1.f / 1024.f);
        float qq = 0.f;
#pragma unroll
        for (int j = 0; j < 16; ++j) { v[j] -= mean; qq += v[j] * v[j]; }
        const float rs = rsqrtf(wave_sum(qq) * (1.f / 1024.f) + 1e-5f);
        const float* mod1 = MOD + (size_t)(1 * 5 + modrow(row)) * 6144;
#pragma unroll
        for (int hh = 0; hh < 2; ++hh) {
            const int d = 512 * hh + 8 * lane;
            float o[8];
#pragma unroll
            for (int j = 0; j < 8; ++j) o[j] = v[8 * hh + j] * rs * P.in[10][l * 1024 + d + j] + P.in[11][l * 1024 + d + j];
            if (l == 0) {
                *(float4*)(XS + (size_t)row * DM + d) = make_float4(o[0], o[1], o[2], o[3]);
                *(float4*)(XS + (size_t)row * DM + d + 4) = make_float4(o[4], o[5], o[6], o[7]);
                bf16_t hb[8];
#pragma unroll
                for (int j = 0; j < 8; ++j) hb[j] = f2bf(o[j] * (1.f + mod1[1024 + d + j]) + mod1[d + j]);
                uint4 pk; pk.x = hb[0] | ((unsigned)hb[1] << 16); pk.y = hb[2] | ((unsigned)hb[3] << 16); pk.z = hb[4] | ((unsigned)hb[5] << 16); pk.w = hb[6] | ((unsigned)hb[7] << 16);
                *(uint4*)(H + (size_t)row * DM + d) = pk;
            } else {
                const int b = row / LTOT, t = row % LTOT - CTX;
                if (*(volatile unsigned*)(P.ws + OFF_BAR + 15360) != 0u) { o[0] = __int_as_float(0x7fc00000); }
                float* op = P.out + ((size_t)b * SEQ + t) * DM + d;
                *(float4*)op = make_float4(o[0], o[1], o[2], o[3]);
                *(float4*)(op + 4) = make_float4(o[4], o[5], o[6], o[7]);
            }
        }
    }
}

__device__ __forceinline__ void s5_prep_unit(const Params& P, int l, int g, int part, unsigned char* smem) {
    const int tid = otid();
    float* Kt = (float*)smem;
    float* bbr = Kt + 8192; float* bbi = bbr + 1024; float* cr = bbi + 1024; float* ci = cr + 1024; float* pwr = ci + 1024; float* pwi = pwr + 17 * 64;
    bf16_t* MS = (bf16_t*)(P.ws + OFF_S5MS) + (size_t)(l * 16 + g) * 256 * 256;
    bf16_t* MY = (bf16_t*)(P.ws + OFF_S5MY) + (size_t)(l * 16 + g) * 256 * 512;
    float* LB = (float*)(P.ws + OFF_S5LB) + (size_t)(l * 16 + g) * 256;
    for (int dir = 0; dir < 2; ++dir) {
        __syncthreads();
        const int ldg = (l * 2 + dir) * 16 + g;
        if (tid < 64) {
            const int p = tid;
            const float dt = expf(P.in[14][ldg]);
            const float lre = P.in[12][ldg * 64 + p], lim = P.in[13][ldg * 64 + p];
            for (int d = 0; d <= 16; ++d) { const float mag = expf(lre * dt * (float)d), ang = lim * dt * (float)d; pwr[d * 64 + p] = mag * cosf(ang); pwi[d * 64 + p] = mag * sinf(ang); }
            const float lb_re = pwr[64 + p], lb_im = pwi[64 + p];
            const float den = lre * lre + lim * lim, nr = lb_re - 1.f, ni = lb_im;
            const float co_re = (nr * lre + ni * lim) / den, co_im = (ni * lre - nr * lim) / den;
            for (int h = 0; h < 16; ++h) {
                const float br = P.in[15][((size_t)ldg * 64 + p) * 16 + h], bi = P.in[16][((size_t)ldg * 64 + p) * 16 + h];
                bbr[p * 16 + h] = co_re * br - co_im * bi; bbi[p * 16 + h] = co_re * bi + co_im * br;
            }
            if (part == 0) { LB[dir * 128 + p] = pwr[16 * 64 + p]; LB[dir * 128 + 64 + p] = pwi[16 * 64 + p]; }
        }
        for (int e = tid; e < 1024; e += 256) { cr[e] = P.in[17][(size_t)ldg * 1024 + e]; ci[e] = P.in[18][(size_t)ldg * 1024 + e]; }
        __syncthreads();
        for (int e0 = tid; e0 < 1024; e0 += 256) {
            const int e = part * 1024 + e0, d = e >> 8, h = (e >> 4) & 15, h2 = e & 15;
            float acc = 0.f;
            for (int p = 0; p < 64; ++p) {
                const float Pr = pwr[d * 64 + p], Pi = pwi[d * 64 + p], br = bbr[p * 16 + h2], bi = bbi[p * 16 + h2];
                acc += cr[h * 64 + p] * (Pr * br - Pi * bi) - ci[h * 64 + p] * (Pr * bi + Pi * br);
            }
            Kt[dir * 4096 + e] = acc;
        }
        for (int e = tid; e < 32 * 256; e += 256) {
            const int q = part * 32 + (e >> 8), col = e & 255, j = col >> 4, h2 = col & 15, p = q & 63;
            const int ex = dir == 0 ? 15 - j : j;
            const float Pr = pwr[ex * 64 + p], Pi = pwi[ex * 64 + p], br = bbr[p * 16 + h2], bi = bbi[p * 16 + h2];
            MS[(size_t)(dir * 128 + q) * 256 + col] = f2bf(q < 64 ? Pr * br - Pi * bi : Pr * bi + Pi * br);
        }
        for (int e = tid; e < 64 * 128; e += 256) {
            const int ri = part * 64 + (e >> 7), q = e & 127, t = ri >> 4, h = ri & 15, p = q & 63;
            const int ex = dir == 0 ? t + 1 : 16 - t;
            const float Lr = pwr[ex * 64 + p], Li = pwi[ex * 64 + p], c_r = cr[h * 64 + p], c_i = ci[h * 64 + p];
            MY[(size_t)ri * 512 + 256 + dir * 128 + q] = f2bf(q < 64 ? c_r * Lr - c_i * Li : -(c_r * Li + c_i * Lr));
        }
    }
    __syncthreads();
    for (int e = tid; e < 4 * 16 * 2 * 256; e += 256) {
        const int hh = e & 255, side = (e >> 8) & 1, k = (e >> 9) & 15, d = part * 4 + (e >> 13);
        if (k + d > 15 || (d == 0 && side == 1)) continue;
        const int t = side == 0 ? k + d : k, j = side == 0 ? k : k + d, h = hh >> 4, h2 = hh & 15;
        float v = side == 0 ? Kt[d * 256 + hh] : Kt[4096 + d * 256 + hh];
        if (d == 0) v += Kt[4096 + hh];
        MY[(size_t)(t * 16 + h) * 512 + j * 16 + h2] = f2bf(v);
    }
}
__device__ __forceinline__ void s5_passA(const Params& P, int l, int bid, int nb) {
    const int lane = otid() & 63, wave = __builtin_amdgcn_readfirstlane(otid() >> 6), fr = lane & 15, fq = lane >> 4;
    const bf16_t* Pb = (const bf16_t*)(P.ws + OFF_P);
    float* ST = (float*)(P.ws + OFF_S5ST);
    for (int it = bid * 4 + wave; it < 16 * 17 * 4; it += nb * 4) {
        const int g = it / 68, mt = (it % 68) >> 2, nt = it & 3;
        const bf16_t* MS = (const bf16_t*)(P.ws + OFF_S5MS) + (size_t)(l * 16 + g) * 256 * 256;
        f32x4 acc[4][4];
#pragma unroll
        for (int i = 0; i < 4; ++i)
#pragma unroll
            for (int j = 0; j < 4; ++j) acc[i][j] = (f32x4){0.f, 0.f, 0.f, 0.f};
        const bf16_t* ap[4];
#pragma unroll
        for (int i = 0; i < 4; ++i) { const int m = mt * 64 + 16 * i + fr, b = m / 272, c = m % 272; ap[i] = Pb + (size_t)(b * LTOT + c * 16) * PIN + g * 16; }
        const bf16_t* bp = MS + (size_t)(nt * 64 + fr) * 256 + 8 * fq;
        for (int k0 = 0; k0 < 256; k0 += 32) {
            const int k = k0 + 8 * fq;
            bf16x8 a[4], bb[4];
#pragma unroll
            for (int i = 0; i < 4; ++i) a[i] = *(const bf16x8*)(ap[i] + (size_t)(k >> 4) * PIN + (k & 15));
#pragma unroll
            for (int j = 0; j < 4; ++j) bb[j] = *(const bf16x8*)(bp + (size_t)(16 * j) * 256 + k0);
#pragma unroll
            for (int i = 0; i < 4; ++i)
#pragma unroll
                for (int j = 0; j < 4; ++j) acc[i][j] = __builtin_amdgcn_mfma_f32_16x16x32_bf16(a[i], bb[j], acc[i][j], 0, 0, 0);
        }
#pragma unroll
        for (int i = 0; i < 4; ++i)
#pragma unroll
            for (int r = 0; r < 4; ++r) {
                const int m = mt * 64 + 16 * i + 4 * fq + r, b = m / 272, c = m % 272;
                float* dst = ST + ((size_t)(b * 16 + g) * 272 + c) * 256 + nt * 64 + fr;
#pragma unroll
                for (int j = 0; j < 4; ++j) dst[16 * j] = acc[i][j][r];
            }
    }
}
__device__ __forceinline__ void s5_carry(const Params& P, int l, int bid, int nb) {
    float* ST = (float*)(P.ws + OFF_S5ST);
    for (int u = bid; u < 32; u += nb) {
        const int gid = u * 256 + otid(), p = gid & 63, dir = (gid >> 6) & 1, g = (gid >> 7) & 15, b = gid >> 11;
        const float* LB = (const float*)(P.ws + OFF_S5LB) + (size_t)(l * 16 + g) * 256 + dir * 128;
        const float lr = LB[p], li = LB[64 + p];
        float* base = ST + (size_t)(b * 16 + g) * 272 * 256 + dir * 128 + p;
        float sr = 0.f, si = 0.f;
        for (int c0 = 0; c0 < 272; c0 += 16) {
            float tr[16], ti[16];
#pragma unroll
            for (int i = 0; i < 16; ++i) { const int cc = c0 + i, c = dir == 0 ? cc : (cc < 16 ? 15 - cc : 287 - cc); tr[i] = base[(size_t)c * 256]; ti[i] = base[(size_t)c * 256 + 64]; }
#pragma unroll
            for (int i = 0; i < 16; ++i) {
                const int cc = c0 + i, c = dir == 0 ? cc : (cc < 16 ? 15 - cc : 287 - cc);
                base[(size_t)c * 256] = sr; base[(size_t)c * 256 + 64] = si;
                const float nr = lr * sr - li * si + tr[i], ni = lr * si + li * sr + ti[i];
                sr = nr; si = ni;
            }
        }
    }
}
__device__ __forceinline__ void s5_passC(const Params& P, int l, int bid, int nb) {
    const int lane = otid() & 63, wave = __builtin_amdgcn_readfirstlane(otid() >> 6), fr = lane & 15, fq = lane >> 4;
    const bf16_t* Pb = (const bf16_t*)(P.ws + OFF_P);
    const float* ST = (const float*)(P.ws + OFF_S5ST);
    bf16_t* YA = (bf16_t*)(P.ws + OFF_YP);
    for (int it = bid * 4 + wave; it < 16 * 17 * 4; it += nb * 4) {
        const int g = it / 68, mt = (it % 68) >> 2, nt = it & 3;
        const bf16_t* MY = (const bf16_t*)(P.ws + OFF_S5MY) + (size_t)(l * 16 + g) * 256 * 512;
        f32x4 acc[4][4];
#pragma unroll
        for (int i = 0; i < 4; ++i)
#pragma unroll
            for (int j = 0; j < 4; ++j) acc[i][j] = (f32x4){0.f, 0.f, 0.f, 0.f};
        const bf16_t* ap[4]; const float* sp[4];
#pragma unroll
        for (int i = 0; i < 4; ++i) {
            const int m = mt * 64 + 16 * i + fr, b = m / 272, c = m % 272;
            ap[i] = Pb + (size_t)(b * LTOT + c * 16) * PIN + g * 16;
            sp[i] = ST + ((size_t)(b * 16 + g) * 272 + c) * 256;
        }
        const bf16_t* bp = MY + (size_t)(nt * 64 + fr) * 512 + 8 * fq;
        for (int k0 = 0; k0 < 512; k0 += 32) {
            const int k = k0 + 8 * fq;
            bf16x8 a[4], bb[4];
            if (k0 < 256) {
#pragma unroll
                for (int i = 0; i < 4; ++i) a[i] = *(const bf16x8*)(ap[i] + (size_t)(k >> 4) * PIN + (k & 15));
            } else {
#pragma unroll
                for (int i = 0; i < 4; ++i) {
                    const float4 s0 = *(const float4*)(sp[i] + (k - 256)), s1 = *(const float4*)(sp[i] + (k - 256) + 4);
                    bf16x8 t;
                    t[0] = (short)f2bf(s0.x); t[1] = (short)f2bf(s0.y); t[2] = (short)f2bf(s0.z); t[3] = (short)f2bf(s0.w);
                    t[4] = (short)f2bf(s1.x); t[5] = (short)f2bf(s1.y); t[6] = (short)f2bf(s1.z); t[7] = (short)f2bf(s1.w);
                    a[i] = t;
                }
            }
#pragma unroll
            for (int j = 0; j < 4; ++j) bb[j] = *(const bf16x8*)(bp + (size_t)(16 * j) * 512 + k0);
#pragma unroll
            for (int i = 0; i < 4; ++i)
#pragma unroll
                for (int j = 0; j < 4; ++j) acc[i][j] = __builtin_amdgcn_mfma_f32_16x16x32_bf16(a[i], bb[j], acc[i][j], 0, 0, 0);
        }
        const float dsk = P.in[19][l * 256 + g * 16 + fr];
#pragma unroll
        for (int i = 0; i < 4; ++i)
#pragma unroll
            for (int r = 0; r < 4; ++r) {
                const int m = mt * 64 + 16 * i + 4 * fq + r, b = m / 272, c = m % 272;
#pragma unroll
                for (int j = 0; j < 4; ++j) {
                    const int t = nt * 4 + j;
                    const size_t row = (size_t)(b * LTOT + c * 16 + t);
                    const float u = bf2f(Pb[row * PIN + g * 16 + fr]);
                    YA[row * DM + g * 16 + fr] = f2bf(gelu_tanh(acc[i][j][r] + dsk * u));
                }
            }
    }
}


#define OFF_T8 (OFF_RW + (size_t)100 * 1024 * 1024)
#define OFF_T8S (OFF_T8 + (size_t)2 * 16384 * 1024)
typedef float f32x2 __attribute__((ext_vector_type(2)));
__device__ __forceinline__ void phase_tabconv8(const Params& P, int l) {
    const int lane = otid() & 63, wave = __builtin_amdgcn_readfirstlane(otid() >> 6);
    unsigned char* T8 = P.ws + OFF_T8;
    float* T8S = (float*)(P.ws + OFF_T8S);
    for (int row = blockIdx.x * 4 + wave; row < 32768; row += gridDim.x * 4) {
        const float* src = P.in[37 + (row >> 14)] + ((size_t)l * 16384 + (row & 16383)) * 1024 + 16 * lane;
        f32x4 x[4];
        float am = 0.f;
#pragma unroll
        for (int j = 0; j < 4; ++j) { x[j] = *(const f32x4*)(src + 4 * j); am = fmaxf(am, fmaxf(fmaxf(fabsf(x[j][0]), fabsf(x[j][1])), fmaxf(fabsf(x[j][2]), fabsf(x[j][3])))); }
#pragma unroll
        for (int o = 32; o > 0; o >>= 1) am = fmaxf(am, __shfl_xor(am, o, 64));
        const float sc = am > 0.f ? 224.f / am : 1.f;
        u32x4 pk;
#pragma unroll
        for (int j = 0; j < 4; ++j) {
            int p = __builtin_amdgcn_cvt_pk_fp8_f32(x[j][0] * sc, x[j][1] * sc, 0, false);
            p = __builtin_amdgcn_cvt_pk_fp8_f32(x[j][2] * sc, x[j][3] * sc, p, true);
            pk[j] = (unsigned)p;
        }
        *(u32x4*)(T8 + (size_t)row * 1024 + 16 * lane) = pk;
        if (lane == 0) T8S[row] = am * (1.f / 224.f);
    }
}
__device__ __forceinline__ void phase_gather8(const Params& P, int l, unsigned char* smem) {
    const int tid = otid(), lane = tid & 63, wave = __builtin_amdgcn_readfirstlane(tid >> 6);
    float* XS = (float*)(P.ws + OFF_XS);
    const float* MOD = (const float*)(P.ws + OFF_MOD);
    const bf16_t* H2 = (const bf16_t*)(P.ws + OFF_H2);
    bf16_t* H = (bf16_t*)(P.ws + OFF_H);
    const int* IDX = (const int*)(P.ws + OFF_IDX);
    const float* GATE = (const float*)(P.ws + OFF_GATE);
    const unsigned char* TU = P.ws + OFF_T8;
    const unsigned char* TV = TU + (size_t)16384 * 1024;
    const float* SU = (const float*)(P.ws + OFF_T8S);
    const float* SV = SU + 16384;
    float* coef = (float*)smem + wave * 128;
    for (int row = blockIdx.x * 4 + wave; row < MROWS; row += gridDim.x * 4) {
        if (l == 1 && (row % LTOT) < CTX) continue;
        float hv[16];
        {
            const u32x4 h0 = *(const u32x4*)(H2 + (size_t)row * DM + 16 * lane), h1 = *(const u32x4*)(H2 + (size_t)row * DM + 16 * lane + 8);
#pragma unroll
            for (int j = 0; j < 4; ++j) { hv[2 * j] = __uint_as_float(h0[j] << 16); hv[2 * j + 1] = __uint_as_float(h0[j] & 0xFFFF0000u); hv[8 + 2 * j] = __uint_as_float(h1[j] << 16); hv[9 + 2 * j] = __uint_as_float(h1[j] & 0xFFFF0000u); }
        }
        const int e0 = IDX[(size_t)row * 128 + lane], e1 = IDX[(size_t)row * 128 + 64 + lane];
        const float g0 = GATE[(size_t)row * 128 + lane], g1 = GATE[(size_t)row * 128 + 64 + lane];
        const float su0 = SU[e0], su1 = SU[e1], sv0 = SV[e0], sv1 = SV[e1];
        u32x4 rr[16];
#define LOAD8(T, bt) { _Pragma("unroll") for (int i = 0; i < 16; ++i) { const int k = (bt) * 16 + i; const int e = __builtin_amdgcn_readlane(k < 64 ? e0 : e1, k & 63); \
            rr[i] = *(const u32x4*)((T) + (size_t)e * 1024 + 16 * lane); } }
        for (int bt2 = 0; bt2 < 8; ++bt2) {
            LOAD8(TU, bt2)
#pragma unroll
          for (int hb = 0; hb < 2; ++hb) {
            const int bt = bt2 * 2 + hb;
            float p[8];
#pragma unroll
            for (int i = 0; i < 8; ++i) {
                float a = 0.f;
#pragma unroll
                for (int j = 0; j < 4; ++j) {
                    const f32x2 lo = __builtin_amdgcn_cvt_pk_f32_fp8((int)rr[8 * hb + i][j], false), hi = __builtin_amdgcn_cvt_pk_f32_fp8((int)rr[8 * hb + i][j], true);
                    a += lo[0] * hv[4 * j] + lo[1] * hv[4 * j + 1] + hi[0] * hv[4 * j + 2] + hi[1] * hv[4 * j + 3];
                }
                p[i] = a;
            }
            float q[4], r2[2];
#pragma unroll
            for (int i = 0; i < 4; ++i) { const float sd = (lane & 32) ? p[i] : p[i + 4]; const float rc = __shfl_xor(sd, 32, 64); q[i] = ((lane & 32) ? p[i + 4] : p[i]) + rc; }
#pragma unroll
            for (int i = 0; i < 2; ++i) { const float sd = (lane & 16) ? q[i] : q[i + 2]; const float rc = __shfl_xor(sd, 16, 64); r2[i] = ((lane & 16) ? q[i + 2] : q[i]) + rc; }
            float sv;
            { const float sd = (lane & 8) ? r2[0] : r2[1]; const float rc = __shfl_xor(sd, 8, 64); sv = ((lane & 8) ? r2[1] : r2[0]) + rc; }
            sv += __shfl_xor(sv, 4, 64); sv += __shfl_xor(sv, 2, 64); sv += __shfl_xor(sv, 1, 64);
            const int k = bt * 8 + ((lane >> 3) & 7);
            const float suk = __shfl(k < 64 ? su0 : su1, k & 63, 64), svk = __shfl(k < 64 ? sv0 : sv1, k & 63, 64), gk = __shfl(k < 64 ? g0 : g1, k & 63, 64);
            if ((lane & 7) == 0) coef[k] = gelu_tanh(sv * suk) * gk * svk;
          }
        }
        float acc[16];
#pragma unroll
        for (int j = 0; j < 16; ++j) acc[j] = 0.f;
        for (int bt = 0; bt < 8; ++bt) {
            LOAD8(TV, bt)
#pragma unroll
            for (int i = 0; i < 16; ++i) {
                const float c = coef[bt * 16 + i];
#pragma unroll
                for (int j = 0; j < 4; ++j) {
                    const f32x2 lo = __builtin_amdgcn_cvt_pk_f32_fp8((int)rr[i][j], false), hi = __builtin_amdgcn_cvt_pk_f32_fp8((int)rr[i][j], true);
                    acc[4 * j] += c * lo[0]; acc[4 * j + 1] += c * lo[1]; acc[4 * j + 2] += c * hi[0]; acc[4 * j + 3] += c * hi[1];
                }
            }
        }
#undef LOAD8
        const float* mod = MOD + (size_t)(l * 5 + modrow(row)) * 6144;
        const int d0 = 16 * lane;
        float v[16]; float s = 0.f;
#pragma unroll
        for (int j = 0; j < 4; ++j) {
            const f32x4 x = *(const f32x4*)(XS + (size_t)row * DM + d0 + 4 * j), g = *(const f32x4*)(mod + 5120 + d0 + 4 * j);
#pragma unroll
            for (int e = 0; e < 4; ++e) { v[4 * j + e] = ALPHA * x[e] + g[e] * acc[4 * j + e]; s += v[4 * j + e]; }
        }
        const float mean = wave_sum(s) * (1.f / 1024.f);
        float qq = 0.f;
#pragma unroll
        for (int j = 0; j < 16; ++j) { v[j] -= mean; qq += v[j] * v[j]; }
        const float rs = rsqrtf(wave_sum(qq) * (1.f / 1024.f) + 1e-5f);
        const float* mod1 = MOD + (size_t)(1 * 5 + modrow(row)) * 6144;
#pragma unroll
        for (int j = 0; j < 4; ++j) {
            const int d = d0 + 4 * j;
            const f32x4 gg = *(const f32x4*)(P.in[10] + l * 1024 + d), bb = *(const f32x4*)(P.in[11] + l * 1024 + d);
            f32x4 o;
#pragma unroll
            for (int e = 0; e < 4; ++e) o[e] = v[4 * j + e] * rs * gg[e] + bb[e];
            if (l == 0) {
                *(f32x4*)(XS + (size_t)row * DM + d) = o;
                const f32x4 sh = *(const f32x4*)(mod1 + d), sc = *(const f32x4*)(mod1 + 1024 + d);
                const unsigned w0 = f2bf(o[0] * (1.f + sc[0]) + sh[0]) | ((unsigned)f2bf(o[1] * (1.f + sc[1]) + sh[1]) << 16);
                const unsigned w1 = f2bf(o[2] * (1.f + sc[2]) + sh[2]) | ((unsigned)f2bf(o[3] * (1.f + sc[3]) + sh[3]) << 16);
                *(uint2*)(H + (size_t)row * DM + d) = make_uint2(w0, w1);
            } else {
                const int b = row / LTOT, t = row % LTOT - CTX;
                *(f32x4*)(P.out + ((size_t)b * SEQ + t) * DM + d) = o;
            }
        }
    }
}

#define OFF_SG (OFF_RW + (size_t)1088 * 8 * 8 * 1024 * 2)
__device__ __forceinline__ size_t rw_group(int b, int dir, int tau_base) {
    const int p = dir == 0 ? tau_base : (tau_base < CTX ? (CTX - 1 - tau_base) : (LTOT + CTX - 1 - tau_base));
    return (size_t)((b * LTOT + p) >> 4);
}
__device__ __forceinline__ float bfw(unsigned w, int half) { return __uint_as_float(half ? (w & 0xFFFF0000u) : (w << 16)); }
struct RwPrep { u32x4 lw0, lw1; uint2 r, k, kap, a; };
__device__ __forceinline__ void rwkv_prep_load(const bf16_t* RW, int b, int hd, int dir, int tau_base, int wave, int lane, RwPrep& R) {
    const bf16_t* base = RW + (rw_group(b, dir, tau_base) * 8 + hd) * 8192 + lane * 16;
    R.lw0 = *(const u32x4*)(base + (6 + dir) * 1024); R.lw1 = *(const u32x4*)(base + (6 + dir) * 1024 + 8);
    const int off = dir ? 12 - 4 * wave : 4 * wave;
    R.r = *(const uint2*)(base + off); R.k = *(const uint2*)(base + 1024 + off); R.kap = *(const uint2*)(base + 3 * 1024 + off); R.a = *(const uint2*)(base + (4 + dir) * 1024 + off);
}
__device__ __forceinline__ void rwkv_prep_finish(const RwPrep& R, unsigned char* buf, float ka, int wave, int lane, int dir) {
    bf16_t* KR = (bf16_t*)buf; bf16_t* BK = (bf16_t*)(buf + 4608); bf16_t* BbT = (bf16_t*)(buf + 9216); bf16_t* KbT = (bf16_t*)(buf + 11264); float* gT = (float*)(buf + 13312);
    float lwt[16];
#pragma unroll
    for (int i = 0; i < 4; ++i) { lwt[2 * i] = bfw(R.lw0[i], 0); lwt[2 * i + 1] = bfw(R.lw0[i], 1); lwt[8 + 2 * i] = bfw(R.lw1[i], 0); lwt[9 + 2 * i] = bfw(R.lw1[i], 1); }
    float cs[16];
    {
        float c = 0.f;
#pragma unroll
        for (int j = 0; j < 16; ++j) { c += dir ? lwt[15 - j] : lwt[j]; cs[j] = c; }
    }
    const float c15 = cs[15];
    if (wave == 0) gT[lane] = __expf(c15);
    float cpw[4], ctw[4];
#pragma unroll
    for (int tt = 0; tt < 4; ++tt) {
        cpw[tt] = wave == 0 ? (tt == 0 ? 0.f : cs[tt - 1 < 0 ? 0 : tt - 1]) : (wave == 1 ? cs[3 + tt] : (wave == 2 ? cs[7 + tt] : cs[11 + tt]));
        ctw[tt] = wave == 0 ? cs[tt] : (wave == 1 ? cs[4 + tt] : (wave == 2 ? cs[8 + tt] : cs[12 + tt]));
    }
    float rt[4], kt4[4], kp[4], at[4];
    rt[0] = bfw(R.r.x, 0); rt[1] = bfw(R.r.x, 1); rt[2] = bfw(R.r.y, 0); rt[3] = bfw(R.r.y, 1);
    kt4[0] = bfw(R.k.x, 0); kt4[1] = bfw(R.k.x, 1); kt4[2] = bfw(R.k.y, 0); kt4[3] = bfw(R.k.y, 1);
    kp[0] = bfw(R.kap.x, 0); kp[1] = bfw(R.kap.x, 1); kp[2] = bfw(R.kap.y, 0); kp[3] = bfw(R.kap.y, 1);
    at[0] = bfw(R.a.x, 0); at[1] = bfw(R.a.x, 1); at[2] = bfw(R.a.y, 0); at[3] = bfw(R.a.y, 1);
    bf16_t bb[4], kb[4];
#pragma unroll
    for (int tt = 0; tt < 4; ++tt) {
        const int t = 4 * wave + tt;
        const float r = dir ? rt[3 - tt] : rt[tt], k = dir ? kt4[3 - tt] : kt4[tt], kap = dir ? kp[3 - tt] : kp[tt], a = dir ? at[3 - tt] : at[tt];
        const float ep = __expf(cpw[tt]), et = __expf(ctw[tt]), em = __expf(-ctw[tt]), eT = __expf(c15 - ctw[tt]);
        const float beta = kap * a, kt = k * (1.f + (a - 1.f) * ka);
        KR[t * 72 + lane] = f2bf(kap * ep); KR[(16 + t) * 72 + lane] = f2bf(r * et);
        BK[t * 72 + lane] = f2bf(beta * em); BK[(16 + t) * 72 + lane] = f2bf(kt * em);
        bb[tt] = f2bf(beta * eT); kb[tt] = f2bf(kt * eT);
    }
    uint2 pb, pk;
    pb.x = bb[0] | ((unsigned)bb[1] << 16); pb.y = bb[2] | ((unsigned)bb[3] << 16);
    pk.x = kb[0] | ((unsigned)kb[1] << 16); pk.y = kb[2] | ((unsigned)kb[3] << 16);
    *(uint2*)(BbT + lane * 16 + 4 * wave) = pb;
    *(uint2*)(KbT + lane * 16 + 4 * wave) = pk;
}
template <int NV>
__device__ __forceinline__ void rwkv_vt_load(const bf16_t* RW, int b, int hd, int dir, int tau_base, int vbase, int lane, u32x4& x) {
    const bf16_t* base = RW + (rw_group(b, dir, tau_base) * 8 + hd) * 8192 + 2 * 1024;
    if (NV == 2) {
        const int vl = lane & 31, th = lane >> 5;
        x = *(const u32x4*)(base + (vbase + vl) * 16 + (dir ? 8 - 8 * th : 8 * th));
    } else {
        const int vl = lane & 15, tq = lane >> 4;
        const uint2 y = *(const uint2*)(base + (vbase + vl) * 16 + (dir ? 12 - 4 * tq : 4 * tq));
        x[0] = y.x; x[1] = y.y; x[2] = 0u; x[3] = 0u;
    }
}
__device__ __forceinline__ unsigned swap16(unsigned w) { return (w >> 16) | (w << 16); }
template <int NV>
__device__ __forceinline__ void rwkv_vt_store(const u32x4& x, bf16_t* VT, int lane, int dir) {
    if (NV == 2) {
        const int vl = lane & 31, th = lane >> 5;
        u32x4 pk;
        if (dir) { pk[0] = swap16(x[3]); pk[1] = swap16(x[2]); pk[2] = swap16(x[1]); pk[3] = swap16(x[0]); } else pk = x;
        *(u32x4*)(VT + vl * 16 + th * 8) = pk;
    } else {
        const int vl = lane & 15, tq = lane >> 4;
        uint2 pk;
        if (dir) { pk.x = swap16(x[1]); pk.y = swap16(x[0]); } else { pk.x = x[0]; pk.y = x[1]; }
        *(uint2*)(VT + vl * 16 + tq * 4) = pk;
    }
}
template <int NV, bool HASV, bool OUT>
__device__ __forceinline__ void rwkv_mfma_step(f32x4 (&X)[4][NV], const unsigned char* buf, const bf16_t* VT, f32x4 (&Yout)[NV], int lane) {
    const bf16_t* KR = (const bf16_t*)buf; const bf16_t* BK = (const bf16_t*)(buf + 4608); const bf16_t* BbT = (const bf16_t*)(buf + 9216); const bf16_t* KbT = (const bf16_t*)(buf + 11264); const float* gT = (const float*)(buf + 13312);
    const int fr = lane & 15, fq = lane >> 4;
    const f32x4 z4 = {0.f, 0.f, 0.f, 0.f};
    f32x4 cA = z4, cN = z4, cAk = z4, cRb = z4, cRk = z4;
#pragma unroll
    for (int ks = 0; ks < 2; ++ks) {
        const bf16x8 kh = *(const bf16x8*)(KR + fr * 72 + 32 * ks + 8 * fq), rh = *(const bf16x8*)(KR + (16 + fr) * 72 + 32 * ks + 8 * fq);
        const bf16x8 bc = *(const bf16x8*)(BK + fr * 72 + 32 * ks + 8 * fq), kc = *(const bf16x8*)(BK + (16 + fr) * 72 + 32 * ks + 8 * fq);
        cA = mfma32(kh, bc, cA); cN = mfma32(bc, kh, cN); cAk = mfma32(kc, kh, cAk);
        if (OUT) { cRb = mfma32(bc, rh, cRb); cRk = mfma32(kc, rh, cRk); }
    }
    f32x4 dg;
#pragma unroll
    for (int r = 0; r < 4; ++r) {
        const int row = 4 * fq + r;
        dg[r] = (row == fr) ? 1.f : 0.f;
        cA[r] = (fr < row) ? cA[r] : 0.f;
        cN[r] = (row < fr) ? cN[r] : 0.f;
        cAk[r] = (row < fr) ? cAk[r] : 0.f;
        cRb[r] = (row <= fr) ? cRb[r] : 0.f;
        cRk[r] = (row <= fr) ? cRk[r] : 0.f;
    }
    const bf16x4 a4 = to4(cA), n4 = to4(cN);
    const f32x4 cA2 = mfma16(n4, a4, z4), cN2 = mfma16(a4, n4, z4);
    const bf16x4 a24 = to4(cA2), n24 = to4(cN2);
    const f32x4 cA4 = mfma16(n24, a24, z4), cN4 = mfma16(a24, n24, z4);
    const f32x4 cA8 = mfma16(to4(cN4), to4(cA4), z4);
    const f32x4 T1 = mfma16(to4(dg - cA), to4(dg + cN2), z4);
    const f32x4 T2 = mfma16(to4(dg + cA4), to4(T1), z4);
    const f32x4 WT = mfma16(to4(dg + cA8), to4(T2), z4);
    const bf16x4 wt4 = to4(WT), aak4 = to4(cAk), rab4 = to4(cRb), rak4 = to4(cRk);
    bf16x8 aK[2], aR[2];
#pragma unroll
    for (int ks = 0; ks < 2; ++ks) {
        aK[ks] = cat8(*(const bf16x4*)(KR + fr * 72 + 32 * ks + 4 * fq), *(const bf16x4*)(KR + fr * 72 + 32 * ks + 16 + 4 * fq));
        if (OUT) aR[ks] = cat8(*(const bf16x4*)(KR + (16 + fr) * 72 + 32 * ks + 4 * fq), *(const bf16x4*)(KR + (16 + fr) * 72 + 32 * ks + 16 + 4 * fq));
    }
    bf16x4 u4[NV], vt4[NV];
#pragma unroll
    for (int nj = 0; nj < NV; ++nj) {
        const bf16x8 b0 = cat8(to4(X[0][nj]), to4(X[1][nj])), b1 = cat8(to4(X[2][nj]), to4(X[3][nj]));
        f32x4 G = mfma32(aK[1], b1, mfma32(aK[0], b0, z4));
        if (HASV) { vt4[nj] = *(const bf16x4*)(VT + (16 * nj + fr) * 16 + 4 * fq); G = mfma16(aak4, vt4[nj], G); }
        const f32x4 U = mfma16(wt4, to4(G), z4);
        u4[nj] = to4(-U);
        if (OUT) {
            f32x4 Yv = mfma32(aR[1], b1, mfma32(aR[0], b0, z4));
            Yv = mfma16(rab4, u4[nj], Yv);
            if (HASV) Yv = mfma16(rak4, vt4[nj], Yv);
            Yout[nj] = Yv;
        }
    }
#pragma unroll
    for (int mi = 0; mi < 4; ++mi) {
        const f32x4 g4 = *(const f32x4*)(gT + 16 * mi + 4 * fq);
        const bf16x4 bb4 = *(const bf16x4*)(BbT + (16 * mi + fr) * 16 + 4 * fq), kb4 = *(const bf16x4*)(KbT + (16 * mi + fr) * 16 + 4 * fq);
#pragma unroll
        for (int nj = 0; nj < NV; ++nj) {
            f32x4 x = X[mi][nj] * g4;
            x = mfma16(bb4, u4[nj], x);
            if (HASV) x = mfma16(kb4, vt4[nj], x);
            X[mi][nj] = x;
        }
    }
}
__device__ __forceinline__ void rwkv_passA(const Params& P, int l, unsigned char* smem, int bid, int nb) {
    const int lane = otid() & 63, wave = __builtin_amdgcn_readfirstlane(otid() >> 6), fr = lane & 15, fq = lane >> 4;
    const bf16_t* RW = (const bf16_t*)(P.ws + OFF_RW);
    float* RXL = (float*)(P.ws + OFF_RXL);
    bf16_t* RXP = (bf16_t*)P.out;
    for (int item = bid; item < 64 * RW_NCH; item += nb) {
        const int seq = item / RW_NCH, c = item % RW_NCH, dir = seq & 1, hd = (seq >> 1) & 7, b = seq >> 4;
        const float ka = P.in[31][l * 512 + hd * 64 + lane];
        const int tau0 = c * 128;
        f32x4 X[4][2], Yd[2];
#pragma unroll
        for (int mi = 0; mi < 4; ++mi)
#pragma unroll
            for (int nj = 0; nj < 2; ++nj)
#pragma unroll
                for (int r = 0; r < 4; ++r) X[mi][nj][r] = (wave >= 2 && (16 * mi + 4 * fq + r) == (16 * (2 * (wave - 2) + nj) + fr)) ? 1.f : 0.f;
        bf16_t* VTw = (bf16_t*)(smem + RW_VT0 + wave * 2048);
        RwPrep R; u32x4 vx;
        rwkv_prep_load(RW, b, hd, dir, tau0, wave, lane, R);
        if (wave < 2) rwkv_vt_load<2>(RW, b, hd, dir, tau0, 32 * wave, lane, vx);
        rwkv_prep_finish(R, smem, ka, wave, lane, dir);
        if (wave < 2) rwkv_vt_store<2>(vx, VTw, lane, dir);
        __syncthreads();
        for (int s = 0; s < 8; ++s) {
            if (s < 7) rwkv_prep_load(RW, b, hd, dir, tau0 + (s + 1) * 16, wave, lane, R);
            if (wave < 2) rwkv_mfma_step<2, true, false>(X, smem + (s & 1) * RW_BUF, VTw + (s & 1) * 512, Yd, lane);
            else rwkv_mfma_step<2, false, false>(X, smem + (s & 1) * RW_BUF, VTw, Yd, lane);
            if (s < 7) {
                if (wave < 2) rwkv_vt_load<2>(RW, b, hd, dir, tau0 + (s + 1) * 16, 32 * wave, lane, vx);
                rwkv_prep_finish(R, smem + ((s + 1) & 1) * RW_BUF, ka, wave, lane, dir);
                if (wave < 2) rwkv_vt_store<2>(vx, VTw + ((s + 1) & 1) * 512, lane, dir);
            }
            __syncthreads();
        }
        if (wave < 2) {
#pragma unroll
            for (int mi = 0; mi < 4; ++mi)
#pragma unroll
                for (int nj = 0; nj < 2; ++nj) *(f32x4*)(RXL + (((size_t)item * 16 + mi * 4 + 2 * wave + nj) * 64 + lane) * 4) = X[mi][nj];
        } else {
#pragma unroll
            for (int mi = 0; mi < 4; ++mi)
#pragma unroll
                for (int nj = 0; nj < 2; ++nj)
#pragma unroll
                    for (int r = 0; r < 4; ++r) RXP[(size_t)item * 4096 + (16 * mi + 4 * fq + r) * 64 + 16 * (2 * (wave - 2) + nj) + fr] = f2bf(X[mi][nj][r]);
        }
    }
}
__device__ __forceinline__ void rwkv_passB(const Params& P, int bid, int nb) {
    const int lane = otid() & 63, wave = __builtin_amdgcn_readfirstlane(otid() >> 6), fr = lane & 15, fq = lane >> 4;
    float* RXL = (float*)(P.ws + OFF_RXL);
    const bf16_t* RXP = (const bf16_t*)P.out;
    for (int it = bid * 4 + wave; it < 256; it += nb * 4) {
        const int seq = it >> 2, nj = it & 3;
        f32x4 X[4];
#pragma unroll
        for (int mi = 0; mi < 4; ++mi) X[mi] = (f32x4){0.f, 0.f, 0.f, 0.f};
        f32x4 L[4], Ln[4]; bf16x8 a[4][2], an[4][2];
#define PB_LOAD(LL, AA, cc) { const size_t item_ = (size_t)seq * RW_NCH + (cc); _Pragma("unroll") for (int mi = 0; mi < 4; ++mi) { \
            LL[mi] = *(const f32x4*)(RXL + ((item_ * 16 + mi * 4 + nj) * 64 + lane) * 4); \
            const bf16_t* xp = RXP + item_ * 4096 + (16 * mi + fr) * 64; \
            _Pragma("unroll") for (int ks = 0; ks < 2; ++ks) AA[mi][ks] = cat8(*(const bf16x4*)(xp + 32 * ks + 4 * fq), *(const bf16x4*)(xp + 32 * ks + 16 + 4 * fq)); } }
        PB_LOAD(L, a, 0)
        for (int c = 0; c < RW_NCH; ++c) {
            const size_t item = (size_t)seq * RW_NCH + c;
            if (c + 1 < RW_NCH) PB_LOAD(Ln, an, c + 1)
            const bf16x8 b0 = cat8(to4(X[0]), to4(X[1])), b1 = cat8(to4(X[2]), to4(X[3]));
#pragma unroll
            for (int mi = 0; mi < 4; ++mi) {
                *(f32x4*)(RXL + ((item * 16 + mi * 4 + nj) * 64 + lane) * 4) = X[mi];
                X[mi] = mfma32(a[mi][1], b1, mfma32(a[mi][0], b0, L[mi]));
            }
#pragma unroll
            for (int mi = 0; mi < 4; ++mi) { L[mi] = Ln[mi]; a[mi][0] = an[mi][0]; a[mi][1] = an[mi][1]; }
        }
#undef PB_LOAD
    }
}
template <bool CHECK>
__device__ __forceinline__ void rwkv_passC(const Params& P, int l, unsigned char* smem, int bid, int nb, int mode = 0) {
    const int lane = otid() & 63, wave = __builtin_amdgcn_readfirstlane(otid() >> 6), fr = lane & 15, fq = lane >> 4;
    const bf16_t* RW = (const bf16_t*)(P.ws + OFF_RW);
    const float* RXL = (const float*)(P.ws + OFF_RXL);
    for (int item = bid; item < 64 * RW_NCH; item += nb) {
        const int seq = item / RW_NCH, c = item % RW_NCH, dir = seq & 1, hd = (seq >> 1) & 7, b = seq >> 4;
        if (l == 1 && dir == 0 && c < 2) continue;
        if (l == 1 && dir == 1 && c < 2) continue;
        bf16_t* YP = (bf16_t*)(P.ws + OFF_YP) + (size_t)dir * MROWS * DM;
        const float ka = P.in[31][l * 512 + hd * 64 + lane];
        const int tau0 = c * 128;
        f32x4 X[4][1], Yo[1];
#pragma unroll
        for (int mi = 0; mi < 4; ++mi) X[mi][0] = *(const f32x4*)(RXL + (((size_t)item * 16 + mi * 4 + wave) * 64 + lane) * 4);
        bf16_t* VTw = (bf16_t*)(smem + RW_VT0 + wave * 2048);
        RwPrep R; u32x4 vx;
        rwkv_prep_load(RW, b, hd, dir, tau0, wave, lane, R);
        rwkv_vt_load<1>(RW, b, hd, dir, tau0, 16 * wave, lane, vx);
        rwkv_prep_finish(R, smem, ka, wave, lane, dir);
        rwkv_vt_store<1>(vx, VTw, lane, dir);
        __syncthreads();
        for (int s = 0; s < 8; ++s) {
            if (s < 7 && mode != 2) {
                rwkv_prep_load(RW, b, hd, dir, tau0 + (s + 1) * 16, wave, lane, R);
                rwkv_vt_load<1>(RW, b, hd, dir, tau0 + (s + 1) * 16, 16 * wave, lane, vx);
            }
            if (mode != 1) rwkv_mfma_step<1, true, true>(X, smem + (s & 1) * RW_BUF, VTw + (s & 1) * 512, Yo, lane);
            if (s < 7 && mode != 2) {
                rwkv_prep_finish(R, smem + ((s + 1) & 1) * RW_BUF, ka, wave, lane, dir);
                rwkv_vt_store<1>(vx, VTw + ((s + 1) & 1) * 512, lane, dir);
            }
#pragma unroll
            for (int r = 0; r < 4; ++r) {
                const int row = row_of(b, dir, tau0 + s * 16 + 4 * fq + r);
                if (mode) {} else if (CHECK) { if (YP[(size_t)row * DM + 512 + hd * 64 + 16 * wave + fr] != f2bf(Yo[0][r])) atomicAdd((unsigned*)(P.ws + OFF_BAR + 15360), 1u); }
                else YP[(size_t)row * DM + 512 + hd * 64 + 16 * wave + fr] = f2bf(Yo[0][r]);
            }
            __syncthreads();
        }
    }
}


#define HG_NCH 34
#define HG_BUF 7168
#define HG_VT0 14336
#define OFF_O_RXP 0ull
#define OFF_O_HXL ((size_t)2176 * 8192)
#define OFF_O_HD (OFF_O_HXL + (size_t)1088 * 8192)
struct HgPrep { u32x4 lf0, lf1; uint2 q, v; };
__device__ __forceinline__ void hgrn_prep_load(const bf16_t* HGT, int b, int hd, int dir, int tau_base, int vbase, int wave, int lane, HgPrep& R) {
    const bf16_t* base = HGT + (rw_group(b, dir, tau_base) * 4 + hd) * 4096;
    R.lf0 = *(const u32x4*)(base + (2 + dir) * 1024 + lane * 16); R.lf1 = *(const u32x4*)(base + (2 + dir) * 1024 + lane * 16 + 8);
    R.q = *(const uint2*)(base + lane * 16 + (dir ? 12 - 4 * wave : 4 * wave));
    const int vl = lane & 15, tq = lane >> 4;
    R.v = *(const uint2*)(base + 1024 + (vbase + vl) * 16 + (dir ? 12 - 4 * tq : 4 * tq));
}
__device__ __forceinline__ float hgrn_prep_finish(const HgPrep& R, unsigned char* buf, bf16_t* VT, int wave, int lane, int dir) {
    bf16_t* QH = (bf16_t*)buf; bf16_t* KC = (bf16_t*)(buf + 2304); bf16_t* KbT = (bf16_t*)(buf + 4608); float* gT = (float*)(buf + 6656);
    float lft_[16];
#pragma unroll
    for (int i = 0; i < 4; ++i) { lft_[2 * i] = bfw(R.lf0[i], 0); lft_[2 * i + 1] = bfw(R.lf0[i], 1); lft_[8 + 2 * i] = bfw(R.lf1[i], 0); lft_[9 + 2 * i] = bfw(R.lf1[i], 1); }
    float cs[16], ls[16];
    {
        float c = 0.f;
#pragma unroll
        for (int j = 0; j < 16; ++j) { ls[j] = dir ? lft_[15 - j] : lft_[j]; c += ls[j]; cs[j] = c; }
    }
    const float c15 = cs[15];
    if (wave == 0) gT[lane] = __expf(c15);
    float qt[4];
    qt[0] = bfw(R.q.x, 0); qt[1] = bfw(R.q.x, 1); qt[2] = bfw(R.q.y, 0); qt[3] = bfw(R.q.y, 1);
    bf16_t kb[4];
#pragma unroll
    for (int tt = 0; tt < 4; ++tt) {
        const int t = 4 * wave + tt;
        const float ct = wave == 0 ? cs[tt] : (wave == 1 ? cs[4 + tt] : (wave == 2 ? cs[8 + tt] : cs[12 + tt]));
        const float lft = wave == 0 ? ls[tt] : (wave == 1 ? ls[4 + tt] : (wave == 2 ? ls[8 + tt] : ls[12 + tt]));
        const float k = 1.f - __expf(lft);
        const float q = dir ? qt[3 - tt] : qt[tt];
        QH[t * 72 + lane] = f2bf(q * __expf(ct));
        KC[t * 72 + lane] = f2bf(k * __expf(fminf(-ct, 80.f)));
        kb[tt] = f2bf(k * __expf(c15 - ct));
    }
    uint2 pk; pk.x = kb[0] | ((unsigned)kb[1] << 16); pk.y = kb[2] | ((unsigned)kb[3] << 16);
    *(uint2*)(KbT + lane * 16 + 4 * wave) = pk;
    {
        const int vl = lane & 15, tq = lane >> 4;
        uint2 pv;
        if (dir) { pv.x = swap16(R.v.y); pv.y = swap16(R.v.x); } else pv = R.v;
        *(uint2*)(VT + vl * 16 + tq * 4) = pv;
    }
    return c15;
}
template <bool OUT>
__device__ __forceinline__ void hgrn_mfma_step(f32x4 (&X)[4], const unsigned char* buf, const bf16_t* VT, f32x4& Yout, int lane) {
    const bf16_t* QH = (const bf16_t*)buf; const bf16_t* KC = (const bf16_t*)(buf + 2304); const bf16_t* KbT = (const bf16_t*)(buf + 4608); const float* gT = (const float*)(buf + 6656);
    const int fr = lane & 15, fq = lane >> 4;
    const f32x4 z4 = {0.f, 0.f, 0.f, 0.f};
    const bf16x4 vt4 = *(const bf16x4*)(VT + fr * 16 + 4 * fq);
    if (OUT) {
        f32x4 cAT = z4;
#pragma unroll
        for (int ks = 0; ks < 2; ++ks) {
            const bf16x8 kc = *(const bf16x8*)(KC + fr * 72 + 32 * ks + 8 * fq), qh = *(const bf16x8*)(QH + fr * 72 + 32 * ks + 8 * fq);
            cAT = mfma32(kc, qh, cAT);
        }
#pragma unroll
        for (int r = 0; r < 4; ++r) cAT[r] = ((4 * fq + r) <= fr) ? cAT[r] : 0.f;
        const bf16x8 aQ0 = cat8(*(const bf16x4*)(QH + fr * 72 + 4 * fq), *(const bf16x4*)(QH + fr * 72 + 16 + 4 * fq));
        const bf16x8 aQ1 = cat8(*(const bf16x4*)(QH + fr * 72 + 32 + 4 * fq), *(const bf16x4*)(QH + fr * 72 + 48 + 4 * fq));
        const bf16x8 b0 = cat8(to4(X[0]), to4(X[1])), b1 = cat8(to4(X[2]), to4(X[3]));
        f32x4 O = mfma32(aQ1, b1, mfma32(aQ0, b0, z4));
        Yout = mfma16(to4(cAT), vt4, O);
    }
#pragma unroll
    for (int mi = 0; mi < 4; ++mi) {
        const f32x4 g4 = *(const f32x4*)(gT + 16 * mi + 4 * fq);
        const bf16x4 kb4 = *(const bf16x4*)(KbT + (16 * mi + fr) * 16 + 4 * fq);
        X[mi] = mfma16(kb4, vt4, X[mi] * g4);
    }
}
__device__ __forceinline__ float hgrn_lb(const Params& P, int l, int dir, int ch) {
    if (l == 0) return 0.f;
    const float a0 = P.in[22][(dir * 2 + 0) * 256 + ch], a1 = P.in[22][(dir * 2 + 1) * 256 + ch];
    const float m = fmaxf(a0, a1), e0 = __expf(a0 - m), e1 = __expf(a1 - m);
    return e1 / (e0 + e1);
}
template <bool OUT>
__device__ __forceinline__ void hgrn_pass(const Params& P, int l, unsigned char* smem, int bid, int nb) {
    const int lane = otid() & 63, wave = __builtin_amdgcn_readfirstlane(otid() >> 6), fr = lane & 15, fq = lane >> 4;
    const bf16_t* Pb = (const bf16_t*)((unsigned char*)P.out + OFF_O_HGT);
    bf16_t* HXL = (bf16_t*)((unsigned char*)P.out + OFF_O_HXL);
    float* HD = (float*)((unsigned char*)P.out + OFF_O_HD);
    for (int item = bid; item < 32 * HG_NCH; item += nb) {
        const int seq = item / HG_NCH, c = item % HG_NCH, dir = seq & 1, hd = (seq >> 1) & 3, b = seq >> 3;
        if (OUT && l == 1 && c < 2) continue;
        bf16_t* YP = (bf16_t*)(P.ws + OFF_YP) + (size_t)dir * MROWS * DM;
        const int tau0 = c * 128;
        f32x4 X[4], Yo;
#pragma unroll
        for (int mi = 0; mi < 4; ++mi) { if (OUT) { const uint2 w = *(const uint2*)(HXL + (((size_t)item * 16 + mi * 4 + wave) * 64 + lane) * 4); X[mi] = (f32x4){bfw(w.x, 0), bfw(w.x, 1), bfw(w.y, 0), bfw(w.y, 1)}; } else X[mi] = (f32x4){0.f, 0.f, 0.f, 0.f}; }
        bf16_t* VTw = (bf16_t*)(smem + HG_VT0 + wave * 1024);
        HgPrep R;
        hgrn_prep_load(Pb, b, hd, dir, tau0, 16 * wave, wave, lane, R);
        float ctot = hgrn_prep_finish(R, smem, VTw, wave, lane, dir);
        __syncthreads();
        for (int s = 0; s < 8; ++s) {
            if (s < 7) hgrn_prep_load(Pb, b, hd, dir, tau0 + (s + 1) * 16, 16 * wave, wave, lane, R);
            hgrn_mfma_step<OUT>(X, smem + (s & 1) * HG_BUF, VTw + (s & 1) * 256, Yo, lane);
            if (s < 7) ctot += hgrn_prep_finish(R, smem + ((s + 1) & 1) * HG_BUF, VTw + ((s + 1) & 1) * 256, wave, lane, dir);
            if (OUT) {
#pragma unroll
                for (int r = 0; r < 4; ++r) {
                    const int row = row_of(b, dir, tau0 + s * 16 + 4 * fq + r);
                    YP[(size_t)row * DM + 256 + hd * 64 + 16 * wave + fr] = f2bf(Yo[r]);
                }
            }
            __syncthreads();
        }
        if (!OUT) {
#pragma unroll
            for (int mi = 0; mi < 4; ++mi) *(uint2*)(HXL + (((size_t)item * 16 + mi * 4 + wave) * 64 + lane) * 4) = make_uint2(pk2bf(X[mi][0], X[mi][1]), pk2bf(X[mi][2], X[mi][3]));
            if (wave == 0) HD[(size_t)item * 64 + lane] = __expf(ctot);
        }
    }
}
__device__ __forceinline__ void hgrn_carry(const Params& P, int bid, int nb) {
    bf16_t* HXL = (bf16_t*)((unsigned char*)P.out + OFF_O_HXL);
    const float* HD = (const float*)((unsigned char*)P.out + OFF_O_HD);
    for (int u = bid; u < 128; u += nb) {
        const int gid = u * 256 + otid(), ln = gid & 63, tile = (gid >> 6) & 15, seq = gid >> 10;
        const int mi = tile >> 2, fq = ln >> 4;
        f32x4 x = {0.f, 0.f, 0.f, 0.f};
        for (int c0 = 0; c0 < HG_NCH; c0 += 17) {
            uint2 L[17];
#pragma unroll
            for (int i = 0; i < 17; ++i) {
                const size_t item = (size_t)seq * HG_NCH + c0 + i;
                L[i] = *(const uint2*)(HXL + ((item * 16 + tile) * 64 + ln) * 4);
            }
#pragma unroll
            for (int i = 0; i < 17; ++i) {
                const size_t item = (size_t)seq * HG_NCH + c0 + i;
                const f32x4 D = *(const f32x4*)(HD + item * 64 + 16 * mi + 4 * fq);
                *(uint2*)(HXL + ((item * 16 + tile) * 64 + ln) * 4) = make_uint2(pk2bf(x[0], x[1]), pk2bf(x[2], x[3]));
                x = D * x + (f32x4){bfw(L[i].x, 0), bfw(L[i].x, 1), bfw(L[i].y, 0), bfw(L[i].y, 1)};
            }
        }
    }
}


__device__ __forceinline__ void phase_rwprep2(const Params& P, int l, unsigned char* smem, int bid, int nb) {
    const int tid = otid(), lane = tid & 63, wave = __builtin_amdgcn_readfirstlane(tid >> 6), fr = lane & 15, fq = lane >> 4;
    const bf16_t* Pb = (const bf16_t*)(P.ws + OFF_P);
    bf16_t* RW = (bf16_t*)(P.ws + OFF_RW);
    bf16_t* SG = (bf16_t*)(P.ws + OFF_SG);
    const bf16_t* LW = (const bf16_t*)(P.ws + OFF_LW);
    const float* mu = P.in[24] + l * 1920;
    bf16_t* AL = (bf16_t*)smem;
    float muv[8];
#pragma unroll
    for (int jj = 0; jj < 8; ++jj) muv[jj] = (tid + 256 * jj) < 1920 ? mu[tid + 256 * jj] : 0.f;
    const float kk0 = P.in[30][l * 512 + tid], kk1 = P.in[30][l * 512 + 256 + tid];
    for (int u = bid; u < MROWS / 16; u += nb) {
        const int r0 = u * 16;
        __syncthreads();
#pragma unroll 1
        for (int it = 0; it < 4; ++it) {
            bf16_t pv[4][8], nv[4][8]; bool ok[4];
#pragma unroll
            for (int tt = 0; tt < 4; ++tt) {
                const int row_ = r0 + 4 * it + tt, p_ = row_ % LTOT; int nbr_;
                {
                    const int m = tid & 3;
                    if (p_ < CTX) { nbr_ = (m & 1) ? row_ + 1 : row_ - 1; ok[tt] = (m & 1) ? (p_ < CTX - 1) : (p_ > 0); }
                    else {
                        const int t_ = p_ - CTX, gr = t_ >> 6, gc = t_ & 63;
                        nbr_ = m == 0 ? row_ - 1 : (m == 1 ? row_ + 1 : (m == 2 ? row_ - 64 : row_ + 64));
                        ok[tt] = m == 0 ? (gc > 0) : (m == 1 ? (gc < 63) : (m == 2 ? (gr > 0) : (gr < 63)));
                    }
                }
                if (!ok[tt]) nbr_ = row_;
                const bf16_t* pp_ = Pb + (size_t)row_ * PIN + 1536 + tid; const bf16_t* pn_ = Pb + (size_t)nbr_ * PIN + 1536 + tid;
#pragma unroll
                for (int jj = 0; jj < 8; ++jj) { if (jj < 7 || tid < 128) { pv[tt][jj] = pp_[256 * jj]; nv[tt][jj] = pn_[256 * jj]; } else { pv[tt][jj] = 0; nv[tt][jj] = 0; } }
            }
            float q8[8][4];
#pragma unroll
            for (int tt = 0; tt < 4; ++tt) {
                const int i = 4 * it + tt, row = r0 + i;
                float sv[8];
#pragma unroll
                for (int jj = 0; jj < 8; ++jj) {
                    const float pvf = bf2f(pv[tt][jj]);
                    const float nvf = ok[tt] ? bf2f(nv[tt][jj]) : 0.f;
                    sv[jj] = pvf + muv[jj] * (nvf - pvf);
                }
                const float a0 = sv[2] * kk0, a1 = sv[3] * kk1;
                const float n0 = fmaxf(sqrtf(wave_sum(a0 * a0)), 1e-12f), n1 = fmaxf(sqrtf(wave_sum(a1 * a1)), 1e-12f);
                q8[0][tt] = sv[0]; q8[1][tt] = sv[1]; q8[2][tt] = sv[2]; q8[3][tt] = sv[3]; q8[4][tt] = sv[4]; q8[5][tt] = sv[5]; q8[6][tt] = a0 / n0; q8[7][tt] = a1 / n1;
                if (tid < 128) { SG[(size_t)row * 128 + tid] = f2bf(sigmoidf_(sv[6])); AL[((2 + (tid >> 6)) * 16 + i) * 72 + (tid & 63)] = f2bf(sv[7]); }
                else AL[(((tid - 128) >> 6) * 16 + i) * 72 + (tid & 63)] = f2bf(tanhf(sv[6]));
            }
#pragma unroll
            for (int q = 0; q < 8; ++q) {
                const int ch = tid + 256 * (q & 1), f = q >> 1;
                *(uint2*)(RW + (((size_t)u * 8 + (ch >> 6)) * 8 + f) * 1024 + (ch & 63) * 16 + 4 * it) = make_uint2(pk2bf(q8[q][0], q8[q][1]), pk2bf(q8[q][2], q8[q][3]));
            }
        }
        __syncthreads();
        {
            const int d = wave & 1, isA = wave >> 1;
            const bf16x8 a0 = *(const bf16x8*)(AL + (wave * 16 + fr) * 72 + 8 * fq), a1 = *(const bf16x8*)(AL + (wave * 16 + fr) * 72 + 32 + 8 * fq);
            const bf16_t* W = LW + (size_t)isA * 131072 + (size_t)(l * 2 + d) * 512 * 64;
            const float* bias = P.in[isA ? 27 : 25] + (l * 2 + d) * 512;
            const int fld = (isA ? 4 : 6) + d;
#pragma unroll 1
            for (int nj0 = 0; nj0 < 32; nj0 += 8) {
              bf16x8 bq0[8], bq1[8]; float bsq[8];
#pragma unroll
              for (int q = 0; q < 8; ++q) { bq0[q] = *(const bf16x8*)(W + (size_t)(16 * (nj0 + q) + fr) * 64 + 8 * fq); bq1[q] = *(const bf16x8*)(W + (size_t)(16 * (nj0 + q) + fr) * 64 + 32 + 8 * fq); bsq[q] = bias[16 * (nj0 + q) + fr]; }
#pragma unroll
              for (int q = 0; q < 8; ++q) {
                const int nj = nj0 + q;
                const f32x4 acc = mfma32(a1, bq1[q], mfma32(a0, bq0[q], (f32x4){0.f, 0.f, 0.f, 0.f}));
                const int c = 16 * nj + fr;
                const float bs = bsq[q];
                float o4[4];
#pragma unroll
                for (int r = 0; r < 4; ++r) { const float sg = sigmoidf_(bs + acc[r]); o4[r] = isA ? sg : -0.60653066f * sg; }
                *(uint2*)(RW + (((size_t)u * 8 + (c >> 6)) * 8 + fld) * 1024 + (c & 63) * 16 + 4 * fq) = make_uint2(pk2bf(o4[0], o4[1]), pk2bf(o4[2], o4[3]));
              }
            }
        }
    }
}
__device__ __forceinline__ void phase_post2(const Params& P, int l, int bid, int nb, int parts) {
    const int tid = otid(), lane = tid & 63, wave = __builtin_amdgcn_readfirstlane(tid >> 6), fr = lane & 15, fq = lane >> 4;
    const bf16_t* Pb = (const bf16_t*)(P.ws + OFF_P);
    const bf16_t* RW = (const bf16_t*)(P.ws + OFF_RW);
    const bf16_t* YF = (const bf16_t*)(P.ws + OFF_YP);
    const bf16_t* YB = YF + (size_t)MROWS * DM;
    const bf16_t* LW = (const bf16_t*)(P.ws + OFF_LW);
    const bf16_t* SG = (const bf16_t*)(P.ws + OFF_SG);
    bf16_t* MIX = (bf16_t*)(P.ws + OFF_MIX);
    const f32x4 z4 = {0.f, 0.f, 0.f, 0.f};
    for (int u = bid; u < MROWS / 16; u += nb) {
        const int r0 = u * 16;
        if (l == 1 && (r0 % LTOT) < CTX) continue;
        if (parts & 1) {
            f32x4 acc[4] = {z4, z4, z4, z4};
            const bf16_t* ap = YF + (size_t)(r0 + fr) * DM + 8 * fq;
            const bf16_t* bp = LW + (size_t)3 * 131072 + (size_t)(l * 256 + 64 * wave + fr) * 256 + 8 * fq;
#pragma unroll
            for (int ks = 0; ks < 8; ++ks) {
                const bf16x8 a = *(const bf16x8*)(ap + 32 * ks);
#pragma unroll
                for (int j = 0; j < 4; ++j) acc[j] = mfma32(a, *(const bf16x8*)(bp + (size_t)(16 * j) * 256 + 32 * ks), acc[j]);
            }
#pragma unroll
            for (int j = 0; j < 4; ++j) {
                const int n = 64 * wave + 16 * j + fr;
                const float gb = P.in[21][l * 256 + n];
#pragma unroll
                for (int r = 0; r < 4; ++r) {
                    const size_t row = (size_t)(r0 + 4 * fq + r);
                    MIX[row * DM + n] = f2bf(bf2f(YF[row * DM + n]) * sigmoidf_(acc[j][r] + gb));
                }
            }
        }
        if (parts & 2) {
            const int i = tid >> 4, c0 = (tid & 15) * 16; const size_t row = (size_t)(r0 + i);
            float o[16], ss = 0.f;
#pragma unroll
            for (int j = 0; j < 16; ++j) { o[j] = bf2f(YF[row * DM + 256 + c0 + j]) + bf2f(YB[row * DM + 256 + c0 + j]); ss += o[j] * o[j]; }
            ss += __shfl_xor(ss, 1, 64); ss += __shfl_xor(ss, 2, 64);
            const float rs = rsqrtf(ss * (1.f / 64.f) + 1e-6f);
#pragma unroll
            for (int j = 0; j < 16; ++j) {
                const float gr = bf2f(Pb[row * PIN + 1280 + c0 + j]);
                MIX[row * DM + 256 + c0 + j] = f2bf(o[j] * rs * P.in[23][l * 256 + c0 + j] * gr);
            }
        }
        if (parts & 4)
#pragma unroll 1
        for (int hh = 0; hh < 2; ++hh) {
            const int h = 2 * wave + hh;
            f32x4 g[4] = {z4, z4, z4, z4};
            const bf16_t* ap = SG + (size_t)(r0 + fr) * 128 + 8 * fq;
            const bf16_t* bp = LW + (size_t)2 * 131072 + (size_t)(l * 512 + h * 64 + fr) * 128 + 8 * fq;
#pragma unroll
            for (int ks = 0; ks < 4; ++ks) {
                const bf16x8 a = *(const bf16x8*)(ap + 32 * ks);
#pragma unroll
                for (int j = 0; j < 4; ++j) g[j] = mfma32(a, *(const bf16x8*)(bp + (size_t)(16 * j) * 128 + 32 * ks), g[j]);
            }
            const bf16_t* gb = RW + ((size_t)u * 8 + h) * 8192 + 4 * fq;
            uint2 fr_[4], fk_[4], fv_[4], fa_[4], fb_[4];
#pragma unroll
            for (int j = 0; j < 4; ++j) {
                const bf16_t* e = gb + (16 * j + fr) * 16;
                fr_[j] = *(const uint2*)e; fk_[j] = *(const uint2*)(e + 1024); fv_[j] = *(const uint2*)(e + 2048); fa_[j] = *(const uint2*)(e + 4096); fb_[j] = *(const uint2*)(e + 5120);
            }
#pragma unroll
            for (int r = 0; r < 4; ++r) {
                const size_t row = (size_t)(r0 + 4 * fq + r);
                float y[4], vv[4], sum = 0.f, bon = 0.f;
#pragma unroll
                for (int j = 0; j < 4; ++j) {
                    const int c = h * 64 + 16 * j + fr;
                    y[j] = bf2f(YF[row * DM + 512 + c]) + bf2f(YB[row * DM + 512 + c]);
                    sum += y[j];
                    const float rr = bfw(r < 2 ? fr_[j].x : fr_[j].y, r & 1), k = bfw(r < 2 ? fk_[j].x : fk_[j].y, r & 1);
                    const float af = bfw(r < 2 ? fa_[j].x : fa_[j].y, r & 1), ab = bfw(r < 2 ? fb_[j].x : fb_[j].y, r & 1);
                    const float ka = P.in[31][l * 512 + c];
                    vv[j] = bfw(r < 2 ? fv_[j].x : fv_[j].y, r & 1);
                    bon += rr * P.in[32][l * 512 + c] * k * (2.f + (af + ab - 2.f) * ka);
                }
#pragma unroll
                for (int o = 1; o < 16; o <<= 1) { sum += __shfl_xor(sum, o, 64); bon += __shfl_xor(bon, o, 64); }
                const float mean = sum * (1.f / 64.f);
                float var = 0.f;
#pragma unroll
                for (int j = 0; j < 4; ++j) { const float d = y[j] - mean; var += d * d; }
#pragma unroll
                for (int o = 1; o < 16; o <<= 1) var += __shfl_xor(var, o, 64);
                const float rs = rsqrtf(var * (1.f / 64.f) + 64e-5f);
#pragma unroll
                for (int j = 0; j < 4; ++j) {
                    const int c = h * 64 + 16 * j + fr;
                    const float yn = (y[j] - mean) * rs * P.in[33][l * 512 + c] + P.in[34][l * 512 + c];
                    MIX[row * DM + 512 + c] = f2bf((yn + bon * vv[j]) * g[j][r]);
                }
            }
        }
    }
}

#define OFF_CTR (OFF_BAR + 14336)
#define ONE (1 << 20)
__device__ __forceinline__ int next_item(const Params& P, int ph, unsigned char* smem) {
    volatile LAS int* slot = (volatile LAS int*)(smem + 65552);
    __syncthreads();
    if (threadIdx.x == 0) *slot = (int)atomicAdd((unsigned*)(P.ws + OFF_CTR) + ph, 1u);
    __syncthreads();
    return __builtin_amdgcn_readfirstlane(*slot);
}
__device__ __forceinline__ void run_phase(const Params& P, int ph, unsigned char* smem, int rep) {
#ifndef ONLY
    if (ph == 0) { phase_prep(P, smem); return; }
    if (ph == 1) { phase_mkh(P); return; }
#else
    if (ph < 2) return;
#endif
    const int l = (ph - 2) / PPL, s = (ph - 2) % PPL;
#ifdef ONLY
    if (s != ONLY) return;
#endif
    switch (s) {
    case 0: gemm3_bf16((const bf16_t*)(P.ws + OFF_H), DM, (const bf16_t*)(P.ws + OFF_WIN) + (size_t)l * PIN * DM, DM, MROWS, PIN, DM, false, Epi4Inproj{(bf16_t*)(P.ws + OFF_P), (const float*)(P.ws + OFF_LBT) + l * 512, (bf16_t*)((unsigned char*)P.out + OFF_O_HGT)}, smem, 7, 9); break;
    case 1:
        for (;;) {
            int i = next_item(P, ph, smem);
#ifdef PROBE_P1
            if (i >= 2448 && i < 2448 + (PROBE_P1 == 1 ? 1088 : (PROBE_P1 == 2 ? 1088 : 272))) i = i - 2448 + (PROBE_P1 == 1 ? 0 : (PROBE_P1 == 2 ? 1088 : 2176));
            else
#endif
            if (i >= 1088 + 1088 + 272) break;
            if (i < 1088) hgrn_pass<false>(P, l, smem, i, ONE);
            else if (i < 2176) phase_rwprep2(P, l, smem, i - 1088, ONE);
            else s5_passA(P, l, i - 2176, ONE);
        }
        break;
    case 2:
        for (;;) {
            const int i = next_item(P, ph, smem);
            if (i >= 2176 + 128 + 32) break;
            if (i < 2176) rwkv_passA(P, l, smem, i, ONE);
            else if (i < 2176 + 128) hgrn_carry(P, i - 2176, ONE);
            else s5_carry(P, l, i - 2176 - 128, ONE);
        }
        break;
    case 3:
        for (;;) {
            int i = next_item(P, ph, smem);
#ifdef PROBE_P3
            if (i >= 1424 && i < 1424 + (PROBE_P3 == 1 ? 1088 : 272)) i = i - 1424 + (PROBE_P3 == 1 ? 64 : 64 + 1088);
            else
#endif
            if (i >= 1088 + 272 + 64) break;
            if (i < 64) rwkv_passB(P, i, ONE);
            else if (i < 64 + 1088) hgrn_pass<true>(P, l, smem, i - 64, ONE);
            else s5_passC(P, l, i - 64 - 1088, ONE);
        }
        break;
    case 4:
        for (;;) {
            const int i = next_item(P, ph, smem);
#ifdef PROBE_C
            if (i >= 2176 && i < 4352) { rwkv_passC<false>(P, l, smem, i - 2176, ONE, PROBE_C); continue; }
            if (i >= 4352) break;
#else
            if (i >= 2176) break;
#endif
            rwkv_passC<false>(P, l, smem, i, ONE);
        }
        break;
    case 5:
        for (;;) {
            const int i = next_item(P, ph, smem);
            if (i >= 3 * 1088) break;
            phase_post2(P, l, i % 1088, ONE, i < 1088 ? 4 : (i < 2176 ? 1 : 2));
        }
        break;
    case 6: gemm3_bf16((const bf16_t*)(P.ws + OFF_MIX), DM, (const bf16_t*)(P.ws + OFF_WOUT) + (size_t)l * DM * DM, DM, MROWS, DM, DM, l == 1, Epi4F32{(float*)(P.ws + OFF_TMP), DM}, smem, 8, 8); phase_tabconv8(P, l); break;
    case 7: phase_ln1(P, l); break;
    case 8: gemm3_bf16((const bf16_t*)(P.ws + OFF_H2), DM, (const bf16_t*)(P.ws + OFF_WQ) + (size_t)l * 2048 * DM, DM, MROWS, 2048, DM, l == 1, Epi4Bf16{(bf16_t*)(P.ws + OFF_Q), 2048}, smem, 8, 8); break;
    case 9: phase_topk2(P, l, smem); break;
    case 10: phase_gather8(P, l, smem); break;
    }
}

__global__ void __launch_bounds__(256, 2) mega(Params P) {
    __shared__ __attribute__((aligned(16))) unsigned char smem[66048];
#if SINGLE
    cg::grid_group grid = cg::this_grid();
    if (threadIdx.x < 4) ((volatile LAS unsigned*)(smem + 65536))[threadIdx.x] = 0u;
    __syncthreads();
    XcdBarrier xb = xcd_barrier_post((unsigned*)(P.ws + OFF_BAR), (volatile LAS unsigned*)(smem + 65536));
#endif
#ifdef PROBE_T
    unsigned long long tacc_ = 0;
#endif
    for (int ph = P.ph_lo; ph < P.ph_hi; ++ph) {
        int nrep = 1;
#ifdef DUPMASK
        if (ph >= 2 && ((DUPMASK >> ((ph - 2) % PPL)) & 1)) nrep = 2;
#endif
#ifdef DUP1MASK
        if (ph >= 2 + PPL && ((DUP1MASK >> ((ph - 2) % PPL)) & 1)) nrep = 2;
#endif
#ifdef PROBE_P
        if (ph == 0) nrep = 2;
#endif
        for (int rep = 0; rep < nrep; ++rep) {
#ifdef PROBE_T
            const unsigned long long t0_ = __builtin_amdgcn_s_memrealtime();
#endif
            run_phase(P, ph, smem, rep);
#if SINGLE
#ifdef PROBE_T
            const unsigned long long tb_ = __builtin_amdgcn_s_memrealtime();
#endif
            if (ph + 1 < P.ph_hi || rep + 1 < nrep) {
                if (ph == 0 && rep == 0) { asm volatile("s_waitcnt vmcnt(0)" ::: "memory"); __syncthreads(); grid.sync(); }
                else xcd_barrier(xb);
            }
#ifdef PROBE_T
            if (PROBE_T == 95) tacc_ += __builtin_amdgcn_s_memrealtime() - tb_;
#endif
#endif
#ifdef PROBE_T
            if (PROBE_T == 99 ? true : PROBE_T == 97 ? (ph < 13) : PROBE_T == 96 ? (ph >= 13) : PROBE_T == 98 ? (ph >= 2 && ((ph - 2) % PPL == 0 || (ph - 2) % PPL == 10)) : (PROBE_T >= 100 ? (ph == PROBE_T - 100) : (ph >= 2 && (ph - 2) % PPL == PROBE_T))) tacc_ += __builtin_amdgcn_s_memrealtime() - t0_;
#endif
        }
    }
#ifdef PROBE_T
    if (blockIdx.x == 0) { const unsigned long long te_ = __builtin_amdgcn_s_memrealtime() + tacc_; while (__builtin_amdgcn_s_memrealtime() < te_) __builtin_amdgcn_s_sleep(8); }
#endif
}

extern "C" void kernel_launch(void* const* d_in, const int* in_sizes, int n_in, void* d_out, int out_size, void* d_ws, size_t ws_size, hipStream_t stream) {
    static int grid = 0;
    if (grid == 0) {
        if (n_in != 39 || ws_size < OFF_END) { fprintf(stderr, "kernel_launch: unexpected n_in %d or ws_size %zu (need %zu)\n", n_in, ws_size, (size_t)OFF_END); grid = -1; return; }
        int dev = 0, cus = 0, per_cu = 0;
        hipGetDevice(&dev);
        hipDeviceGetAttribute(&cus, hipDeviceAttributeMultiprocessorCount, dev);
        hipOccupancyMaxActiveBlocksPerMultiprocessor(&per_cu, mega, 256, 0);
        if (per_cu < 1) per_cu = 1;
        if (per_cu > 2) per_cu = 2;
        grid = cus * per_cu;
    }
    if (grid < 0) return;
    hipMemsetAsync((unsigned char*)d_ws + OFF_BAR, 0, 16384, stream);
    Params p{};
    for (int i = 0; i < 39; ++i) p.in[i] = (const float*)d_in[i];
    p.out = (float*)d_out; p.ws = (unsigned char*)d_ws;
#if SINGLE
    p.ph_lo = 0; p.ph_hi = NPH;
    void* args[] = {&p};
    hipError_t e = hipLaunchCooperativeKernel((void*)mega, dim3(grid), dim3(256), args, 0, stream);
    if (e != hipSuccess) fprintf(stderr, "cooperative launch failed: %s (grid %d)\n", hipGetErrorString(e), grid);
#else
    for (int ph = 0; ph < NPH; ++ph) {
        p.ph_lo = ph; p.ph_hi = ph + 1;
        hipLaunchKernelGGL(mega, dim3(grid), dim3(256), 0, stream, p);
    }
#endif
}
```

```cpp
#include <hip/hip_runtime.h>
#include <hip/hip_cooperative_groups.h>
#include <cstdio>
namespace cg = cooperative_groups;

#ifndef SINGLE
#define SINGLE 1
#endif

typedef unsigned short bf16_t;
typedef __bf16 bf16x2 __attribute__((ext_vector_type(2)));
typedef short bf16x8 __attribute__((ext_vector_type(8)));
typedef float f32x4 __attribute__((ext_vector_type(4)));

#define DM 1024
#define NB 4
#define SEQ 4096
#define CTX 256
#define LTOT 4352
#define MROWS 17408
#define PIN 3456
#define RWW 4224
#define NPH 24
#define PPL 11
#define ALPHA 1.41421356237f

#define OFF_XS 0ull
#define OFF_P (OFF_XS + (size_t)MROWS * DM * 4)
#define OFF_RW (OFF_P + (size_t)MROWS * PIN * 2)
#define OFF_YP (OFF_RW + (size_t)MROWS * RWW * 2)
#define OFF_MIX (OFF_YP + (size_t)2 * MROWS * DM * 2)
#define OFF_MOD (OFF_MIX + (size_t)MROWS * DM * 2)
#define OFF_WIN (OFF_MOD + (size_t)2 * 5 * 6144 * 4)
#define OFF_WOUT (OFF_WIN + (size_t)2 * PIN * DM * 2)
#define OFF_WQ (OFF_WOUT + (size_t)2 * DM * DM * 2)
#define OFF_S5MS (OFF_WQ + (size_t)2 * 2048 * DM * 2)
#define OFF_S5MY (OFF_S5MS + (size_t)2 * 16 * 256 * 256 * 2)
#define OFF_S5LB (OFF_S5MY + (size_t)2 * 16 * 256 * 512 * 2)
#define OFF_S5ST (OFF_S5LB + (size_t)2 * 16 * 2 * 128 * 4)
#define OFF_BAR (OFF_S5ST + (size_t)4 * 16 * 272 * 256 * 4)
#define OFF_KEYB (OFF_BAR + 16384)
#define OFF_LW (OFF_KEYB + (size_t)2 * 8 * 2 * 128 * 128 * 2)
#define OFF_LBT (OFF_LW + (size_t)4 * 131072 * 2)
#define OFF_END (OFF_LBT + 4096)
#define OFF_RXL OFF_MIX
#define OFF_TMP OFF_P
#define OFF_H OFF_YP
#define OFF_H2 (OFF_YP + (size_t)MROWS * DM * 2)
#define OFF_Q OFF_RW
#define OFF_IDX (OFF_RW + (size_t)MROWS * 2048 * 2)
#define OFF_GATE (OFF_IDX + (size_t)MROWS * 128 * 4)
#define OFF_TBU OFF_P
#define OFF_TBV (OFF_P + (size_t)16384 * 1024 * 2)

#define OFF_O_HGT ((size_t)2176 * 8192 + (size_t)1088 * 8192 + (size_t)1088 * 256)
struct Params {
    const float* in[39];
    float* out;
    unsigned char* ws;
    int ph_lo, ph_hi;
};

__device__ __forceinline__ bf16_t f2bf(float f) { const __bf16 h = (__bf16)f; return __builtin_bit_cast(bf16_t, h); }
typedef float f32x2_ __attribute__((ext_vector_type(2)));
__device__ __forceinline__ unsigned pk2bf(float a, float b) { const f32x2_ v = {a, b}; return __builtin_bit_cast(unsigned, __builtin_convertvector(v, bf16x2)); }
__device__ __forceinline__ float bf2f(bf16_t h) { return __uint_as_float(((unsigned)h) << 16); }
__device__ __forceinline__ float sigmoidf_(float x) { return 1.f / (1.f + __expf(-x)); }
__device__ __forceinline__ float siluf_(float x) { return x * sigmoidf_(x); }
__device__ __forceinline__ float gelu_tanh(float x) {
    const float u = 0.7978845608028654f * (x + 0.044715f * x * x * x);
    return 0.5f * x * (1.f + tanhf(u));
}
__device__ __forceinline__ float wave_sum(float v) {
#pragma unroll
    for (int o = 32; o > 0; o >>= 1) v += __shfl_xor(v, o, 64);
    return v;
}
typedef short bf16x4 __attribute__((ext_vector_type(4)));
#define RW_NCH 34
#define RW_BUF 13824
#define RW_VT0 27648
__device__ __forceinline__ f32x4 mfma32(bf16x8 a, bf16x8 b, f32x4 c) { return __builtin_amdgcn_mfma_f32_16x16x32_bf16(a, b, c, 0, 0, 0); }
__device__ __forceinline__ f32x4 mfma16(bf16x4 a, bf16x4 b, f32x4 c) {
    bf16x8 a8, b8;
    a8[0] = a[0]; a8[1] = a[1]; a8[2] = a[2]; a8[3] = a[3]; a8[4] = 0; a8[5] = 0; a8[6] = 0; a8[7] = 0;
    b8[0] = b[0]; b8[1] = b[1]; b8[2] = b[2]; b8[3] = b[3]; b8[4] = 0; b8[5] = 0; b8[6] = 0; b8[7] = 0;
    return __builtin_amdgcn_mfma_f32_16x16x32_bf16(a8, b8, c, 0, 0, 0);
}
typedef unsigned u32x2_ __attribute__((ext_vector_type(2)));
__device__ __forceinline__ bf16x4 to4(f32x4 v) { const u32x2_ p = {pk2bf(v[0], v[1]), pk2bf(v[2], v[3])}; return __builtin_bit_cast(bf16x4, p); }
__device__ __forceinline__ bf16x8 cat8(bf16x4 a, bf16x4 b) { bf16x8 o; o[0] = a[0]; o[1] = a[1]; o[2] = a[2]; o[3] = a[3]; o[4] = b[0]; o[5] = b[1]; o[6] = b[2]; o[7] = b[3]; return o; }

__device__ __forceinline__ int otid() { int t = threadIdx.x; asm volatile("" : "+v"(t)); return t; }
__device__ __forceinline__ float rdlane(float v, int l) { return __int_as_float(__builtin_amdgcn_readlane(__float_as_int(v), l)); }
__device__ __forceinline__ int row_of(int b, int dir, int tau) {
    const int p = dir == 0 ? tau : (tau < CTX ? (CTX - 1 - tau) : (LTOT + CTX - 1 - tau));
    return b * LTOT + p;
}
__device__ __forceinline__ int modrow(int row) { const int p = row % LTOT; return p < CTX ? 4 : row / LTOT; }

__device__ __forceinline__ void s5_prep_unit(const Params& P, int l, int g, int part, unsigned char* smem);

#define XB_TMO      128
#define XB_XCNT(j)  (256  + 64 * (j))
#define XB_XSUB(j)  (1280 + 64 * (j))
#define XB_XGEN(j)  (2304 + 64 * (j))
#define XB_TOP      3328
#define XB_TOPGEN   3392
#define XCD_BAR_WORDS 3456
#define XB_SPIN_CAP (1u << 22)
#define LAS __attribute__((address_space(3)))
__device__ __forceinline__ unsigned xb_ld(unsigned* p)              { return __hip_atomic_load(p, __ATOMIC_RELAXED, __HIP_MEMORY_SCOPE_AGENT); }
__device__ __forceinline__ unsigned xb_add(unsigned* p, unsigned v) { return __hip_atomic_fetch_add(p, v, __ATOMIC_RELAXED, __HIP_MEMORY_SCOPE_AGENT); }
__device__ __forceinline__ unsigned xb_xcc_id() { return (unsigned)__builtin_amdgcn_s_getreg((3 << 11) | 20) & 0xFu; }
#define XB_SPIN(cond, bar) do { unsigned _sp = 0; while (cond) { __builtin_amdgcn_s_sleep(1); \
    if ((++_sp & 255u) == 0u) { if (xb_ld(&(bar)[XB_TMO])) break; if (_sp > XB_SPIN_CAP) { atomicAdd(&(bar)[XB_TMO], 1u); break; } } } } while (0)
struct XcdBarrier { unsigned* bar; unsigned x; volatile LAS unsigned* st; };
__device__ __forceinline__ XcdBarrier xcd_barrier_post(unsigned* bar, volatile LAS unsigned* st) {
    XcdBarrier b; b.bar = bar; b.x = xb_xcc_id(); b.st = st;
    if (threadIdx.x == 0) (void)xb_add(&bar[XB_XCNT(b.x)], 1u);
    return b;
}
__device__ __forceinline__ void xcd_barrier_complete(unsigned* bar, unsigned x, unsigned& nloc, unsigned& nx) {
    const unsigned G = gridDim.x * gridDim.y * gridDim.z;
    unsigned sum, cnt, mine, sp = 0u;
    for (;;) {
        sum = 0u; cnt = 0u; mine = 0u;
#pragma unroll
        for (unsigned j = 0; j < 16; ++j) { const unsigned c = xb_ld(&bar[XB_XCNT(j)]); sum += c; cnt += (c > 0u) ? 1u : 0u; mine = (j == x) ? c : mine; }
        if (sum == G) break;
        __builtin_amdgcn_s_sleep(1);
        if ((++sp & 255u) == 0u) { if (xb_ld(&bar[XB_TMO])) break; if (sp > XB_SPIN_CAP) { atomicAdd(&bar[XB_TMO], 1u); break; } }
    }
    nloc = mine > 0u ? mine : 1u; nx = cnt > 0u ? cnt : 1u;
}
__device__ __forceinline__ void xcd_barrier(const XcdBarrier& b) {
    asm volatile("s_waitcnt vmcnt(0)" ::: "memory");
    __syncthreads();
    if (threadIdx.x == 0) {
        unsigned* bar = b.bar;
        __builtin_amdgcn_s_waitcnt(0);
        unsigned nloc = b.st[0], nx = b.st[1];
        if (nloc == 0u) { xcd_barrier_complete(bar, b.x, nloc, nx); b.st[0] = nloc; b.st[1] = nx; }
        const unsigned old = xb_add(&bar[XB_XSUB(b.x)], 1u);
        const unsigned gen = old / nloc;
        if (old + 1u == (gen + 1u) * nloc) {
            __builtin_amdgcn_fence(__ATOMIC_RELEASE, "agent");
            asm volatile("s_waitcnt vmcnt(0)" ::: "memory");
            const unsigned og = xb_add(&bar[XB_TOP], 1u);
            const unsigned tg = og / nx;
            if (og + 1u == (tg + 1u) * nx) xb_add(&bar[XB_TOPGEN], 1u);
            else XB_SPIN(xb_ld(&bar[XB_TOPGEN]) == tg, bar);
            __builtin_amdgcn_fence(__ATOMIC_ACQUIRE, "agent");
            xb_add(&bar[XB_XGEN(b.x)], 1u);
            asm volatile("s_waitcnt vmcnt(0)" ::: "memory");
        } else {
            XB_SPIN(xb_ld(&bar[XB_XGEN(b.x)]) == gen, bar);
            __builtin_amdgcn_fence(__ATOMIC_ACQUIRE, "agent");
            asm volatile("s_waitcnt vmcnt(0)" ::: "memory");
        }
    }
    __syncthreads();
}

__device__ __forceinline__ void phase_prep(const Params& P, unsigned char* smem) {
    const int tid = otid(), lane = tid & 63, wave = __builtin_amdgcn_readfirstlane(tid >> 6);
    float* MOD = (float*)(P.ws + OFF_MOD);
    float* XS = (float*)(P.ws + OFF_XS);
    const int U_MOD = 192, U_COPY = MROWS / 16, U_TIN = 2 * 16 * 54, U_TOUT = 2 * 16 * 16, U_TQ = 2 * 16 * 32;
    const int U_S5 = 128, U_KEY = 64 + 64;
    const int total = U_S5 + U_KEY + U_MOD + U_COPY + U_TIN + U_TOUT + U_TQ;
    for (int u0 = blockIdx.x; u0 < total; u0 += gridDim.x) {
        __syncthreads();
        if (u0 < U_S5) {
            if (u0 == 0) {
                float* LBT = (float*)(P.ws + OFF_LBT);
                for (int i = tid; i < 1024; i += 256) {
                    const int ll = i >> 9, dir = (i >> 8) & 1, ch = i & 255;
                    float lbv = 0.f;
                    if (ll == 1) { const float a0 = P.in[22][(dir * 2 + 0) * 256 + ch], a1 = P.in[22][(dir * 2 + 1) * 256 + ch]; const float m = fmaxf(a0, a1), e0 = __expf(a0 - m), e1 = __expf(a1 - m); lbv = e1 / (e0 + e1); }
                    LBT[i] = lbv;
                }
            }
            s5_prep_unit(P, u0 >> 6, (u0 >> 2) & 15, u0 & 3, smem); continue;
        }
        if (u0 < U_S5 + 64) {
            bf16_t* KB = (bf16_t*)(P.ws + OFF_KEYB);
            const size_t base = (size_t)(u0 - U_S5) * 8192;
            for (int i = tid; i < 8192; i += 256) KB[base + i] = f2bf(P.in[36][base + i]);
            continue;
        }
        if (u0 < U_S5 + U_KEY) {
            bf16_t* LW = (bf16_t*)(P.ws + OFF_LW);
            const int base = (u0 - U_S5 - 64) * 8192;
            for (int i = tid; i < 8192; i += 256) {
                const int o = base + i, which = o >> 17, e = o & 131071;
                float v;
                if (which < 2) { const int j = e & 63, c = (e >> 6) & 511, ld = e >> 15; v = P.in[which == 0 ? 26 : 28][((size_t)ld * 64 + j) * 512 + c]; }
                else if (which == 2) { const int j = e & 127, c = (e >> 7) & 511, ll = e >> 16; v = P.in[29][((size_t)ll * 128 + j) * 512 + c]; }
                else { const int k = e & 255, n = (e >> 8) & 255, ll = e >> 16; v = P.in[20][((size_t)ll * 256 + k) * 256 + n]; }
                LW[o] = f2bf(v);
            }
            continue;
        }
        const int u = u0 - U_S5 - U_KEY;
        if (u < U_MOD) {
            const int l = u / 96, j0 = (u % 96) * 64;
            float* sl = (float*)smem;
            for (int i = tid; i < 5 * 1024; i += 256) {
                const int r = i >> 10, k = i & 1023;
                const float cv = r < 4 ? P.in[1][r * 1024 + k] : P.in[3][k];
                sl[i] = siluf_(cv);
            }
            __syncthreads();
            float acc[5] = {0.f, 0.f, 0.f, 0.f, 0.f};
            const float* W = P.in[4] + (size_t)l * 1024 * 6144 + j0 + lane;
            for (int k = wave * 256; k < wave * 256 + 256; ++k) {
                const float w = W[(size_t)k * 6144];
#pragma unroll
                for (int r = 0; r < 5; ++r) acc[r] += sl[r * 1024 + k] * w;
            }
            float* red = (float*)(smem + 5 * 1024 * 4);
#pragma unroll
            for (int r = 0; r < 5; ++r) red[(wave * 5 + r) * 64 + lane] = acc[r];
            __syncthreads();
            for (int i = tid; i < 5 * 64; i += 256) {
                const int r = i / 64, jj = i % 64;
                float s = P.in[5][l * 6144 + j0 + jj];
                for (int w = 0; w < 4; ++w) s += red[(w * 5 + r) * 64 + jj];
                MOD[(l * 5 + r) * 6144 + j0 + jj] = s;
            }
        } else if (u < U_MOD + U_COPY) {
            const int r0 = (u - U_MOD) * 16;
            for (int i = tid; i < 16 * 256; i += 256) {
                const int row = r0 + (i >> 8), c4 = i & 255;
                const int b = row / LTOT, p = row % LTOT;
                const float4* src = p < CTX ? (const float4*)(P.in[2] + ((size_t)b * CTX + p) * DM) : (const float4*)(P.in[0] + ((size_t)b * SEQ + (p - CTX)) * DM);
                ((float4*)(XS + (size_t)row * DM))[c4] = src[c4];
            }
        } else {
            int v = u - U_MOD - U_COPY;
            const float* W; bf16_t* Wt; int N;
            if (v < U_TIN) { const int l = v / (16 * 54); v %= 16 * 54; N = PIN; W = P.in[6] + (size_t)l * 1024 * PIN; Wt = (bf16_t*)(P.ws + OFF_WIN) + (size_t)l * PIN * 1024; }
            else if (v < U_TIN + U_TOUT) { v -= U_TIN; const int l = v / 256; v %= 256; N = 1024; W = P.in[7] + (size_t)l * 1024 * 1024; Wt = (bf16_t*)(P.ws + OFF_WOUT) + (size_t)l * 1024 * 1024; }
            else { v -= U_TIN + U_TOUT; const int l = v / 512; v %= 512; N = 2048; W = P.in[35] + (size_t)l * 1024 * 2048; Wt = (bf16_t*)(P.ws + OFF_WQ) + (size_t)l * 2048 * 1024; }
            const int ntn = N / 64, kt = v / ntn, nt = v % ntn;
            float* t = (float*)smem;
            for (int i = tid; i < 64 * 64; i += 256) { const int kk = i >> 6, nn = i & 63; t[kk * 65 + nn] = W[(size_t)(kt * 64 + kk) * N + nt * 64 + nn]; }
            __syncthreads();
            for (int i = tid; i < 64 * 64; i += 256) { const int nn = i >> 6, kk = i & 63; Wt[(size_t)(nt * 64 + nn) * 1024 + kt * 64 + kk] = f2bf(t[kk * 65 + nn]); }
        }
    }
}

__device__ __forceinline__ void phase_mkh(const Params& P) {
    const int lane = otid() & 63, wave = __builtin_amdgcn_readfirstlane(otid() >> 6);
    const float* XS = (const float*)(P.ws + OFF_XS);
    const float* MOD = (const float*)(P.ws + OFF_MOD);
    bf16_t* H = (bf16_t*)(P.ws + OFF_H);
    for (int row = blockIdx.x * 4 + wave; row < MROWS; row += gridDim.x * 4) {
        const float* mod = MOD + (size_t)(0 * 5 + modrow(row)) * 6144;
#pragma unroll
        for (int j = 0; j < 4; ++j) {
            const int d = 256 * j + 4 * lane;
            const float4 x = *(const float4*)(XS + (size_t)row * DM + d);
            const float4 sh = *(const float4*)(mod + d), sc = *(const float4*)(mod + 1024 + d);
            ushort4 o;
            o.x = f2bf(x.x * (1.f + sc.x) + sh.x); o.y = f2bf(x.y * (1.f + sc.y) + sh.y);
            o.z = f2bf(x.z * (1.f + sc.z) + sh.z); o.w = f2bf(x.w * (1.f + sc.w) + sh.w);
            *(ushort4*)(H + (size_t)row * DM + d) = o;
        }
    }
}

template <class EPI>
__device__ __forceinline__ void gemm_bf16(const bf16_t* A, int lda, const bf16_t* Bt, int ldb, int M, int N, int K, bool skipctx, EPI epi) {
    const int lane = otid() & 63, wave = __builtin_amdgcn_readfirstlane(otid() >> 6);
    const int ntm = M / 128, ntn = N / 128;
    const int fr = lane & 15, fq = lane >> 4;
    for (int tile = blockIdx.x; tile < ntm * ntn; tile += gridDim.x) {
        const int tm = tile / ntn, tn = tile % ntn;
        const int m0 = tm * 128 + (wave >> 1) * 64, n0 = tn * 128 + (wave & 1) * 64;
        if (skipctx && (m0 % LTOT) < CTX) continue;
        f32x4 acc[4][4];
#pragma unroll
        for (int i = 0; i < 4; ++i)
#pragma unroll
            for (int j = 0; j < 4; ++j) acc[i][j] = (f32x4){0.f, 0.f, 0.f, 0.f};
        const bf16_t* ap = A + (size_t)(m0 + fr) * lda + 8 * fq;
        const bf16_t* bp = Bt + (size_t)(n0 + fr) * ldb + 8 * fq;
        for (int k0 = 0; k0 < K; k0 += 32) {
            bf16x8 a[4], b[4];
#pragma unroll
            for (int i = 0; i < 4; ++i) a[i] = *(const bf16x8*)(ap + (size_t)(16 * i) * lda + k0);
#pragma unroll
            for (int j = 0; j < 4; ++j) b[j] = *(const bf16x8*)(bp + (size_t)(16 * j) * ldb + k0);
#pragma unroll
            for (int i = 0; i < 4; ++i)
#pragma unroll
                for (int j = 0; j < 4; ++j) acc[i][j] = __builtin_amdgcn_mfma_f32_16x16x32_bf16(a[i], b[j], acc[i][j], 0, 0, 0);
        }
#pragma unroll
        for (int i = 0; i < 4; ++i)
#pragma unroll
            for (int j = 0; j < 4; ++j)
#pragma unroll
                for (int r = 0; r < 4; ++r) epi(m0 + 16 * i + 4 * fq + r, n0 + 16 * j + fr, acc[i][j][r]);
    }
}

typedef float f32x16 __attribute__((ext_vector_type(16)));
typedef unsigned u32x4 __attribute__((ext_vector_type(4)));
#define G2_LD 72
template <class EPI>
__device__ __forceinline__ void gemm2_bf16(const bf16_t* A, int lda, const bf16_t* Bt, int ldb, int M, int N, int K, bool skipctx, EPI epi, unsigned char* smem) {
    const int tid = otid(), lane = tid & 63, wave = __builtin_amdgcn_readfirstlane(tid >> 6);
    const int ntm = M / 128, ntn = N / 128;
    bf16_t* As = (bf16_t*)smem;
    bf16_t* Bs = As + 128 * G2_LD;
    const int lr = tid >> 3, lc = (tid & 7) * 8;
    const int wm = (wave >> 1) * 64, wn = (wave & 1) * 64;
    const int fr = lane & 31, fh = lane >> 5;
    for (int tile = blockIdx.x; tile < ntm * ntn; tile += gridDim.x) {
        const int tm = tile / ntn, tn = tile % ntn;
        if (skipctx && ((tm * 128) % LTOT) < CTX) continue;
        const bf16_t* ag = A + (size_t)(tm * 128 + lr) * lda + lc;
        const bf16_t* bg = Bt + (size_t)(tn * 128 + lr) * ldb + lc;
        f32x16 acc[2][2];
        {
            const f32x16 z16 = {0.f, 0.f, 0.f, 0.f, 0.f, 0.f, 0.f, 0.f, 0.f, 0.f, 0.f, 0.f, 0.f, 0.f, 0.f, 0.f};
            acc[0][0] = z16; acc[0][1] = z16; acc[1][0] = z16; acc[1][1] = z16;
        }
        u32x4 ra0[4], rb0[4], ra1[4], rb1[4];
#define G2_LOAD(RA, RB, kk_) { const int kq = (kk_) < K ? (kk_) : 0; _Pragma("unroll") for (int i = 0; i < 4; ++i) { RA[i] = *(const u32x4*)(ag + (size_t)(32 * i) * lda + kq); RB[i] = *(const u32x4*)(bg + (size_t)(32 * i) * ldb + kq); } }
#define G2_STORE(RA, RB) { _Pragma("unroll") for (int i = 0; i < 4; ++i) { *(u32x4*)(As + (lr + 32 * i) * G2_LD + lc) = RA[i]; *(u32x4*)(Bs + (lr + 32 * i) * G2_LD + lc) = RB[i]; } }
#define G2_COMPUTE() { _Pragma("unroll") for (int kk = 0; kk < 4; ++kk) { bf16x8 a[2], b[2]; \
            _Pragma("unroll") for (int i = 0; i < 2; ++i) a[i] = *(const bf16x8*)(As + (wm + 32 * i + fr) * G2_LD + 16 * kk + 8 * fh); \
            _Pragma("unroll") for (int j = 0; j < 2; ++j) b[j] = *(const bf16x8*)(Bs + (wn + 32 * j + fr) * G2_LD + 16 * kk + 8 * fh); \
            _Pragma("unroll") for (int i = 0; i < 2; ++i) _Pragma("unroll") for (int j = 0; j < 2; ++j) acc[i][j] = __builtin_amdgcn_mfma_f32_32x32x16_bf16(a[i], b[j], acc[i][j], 0, 0, 0); } }
        G2_LOAD(ra0, rb0, 0)
        G2_LOAD(ra1, rb1, 64)
        __syncthreads();
        G2_STORE(ra0, rb0)
        __syncthreads();
        G2_LOAD(ra0, rb0, 128)
        for (int k0 = 0; k0 < K; k0 += 128) {
            G2_COMPUTE()
            __syncthreads();
            G2_STORE(ra1, rb1)
            __syncthreads();
            G2_LOAD(ra1, rb1, k0 + 192)
            G2_COMPUTE()
            if (k0 + 128 < K) {
                __syncthreads();
                G2_STORE(ra0, rb0)
                __syncthreads();
                G2_LOAD(ra0, rb0, k0 + 256)
            }
        }
#undef G2_LOAD
#undef G2_STORE
#undef G2_COMPUTE
#pragma unroll
        for (int i = 0; i < 2; ++i)
#pragma unroll
            for (int j = 0; j < 2; ++j)
#pragma unroll
                for (int q = 0; q < 16; ++q) epi(tm * 128 + wm + 32 * i + (q & 3) + 8 * (q >> 2) + 4 * fh, tn * 128 + wn + 32 * j + fr, acc[i][j][q]);
    }
}

template <class EPI>
__device__ __forceinline__ void gemm3_bf16(const bf16_t* A, int lda, const bf16_t* Bt, int ldb, int M, int N, int K, bool skipctx, EPI epi, unsigned char* smem, int TMS, int TNS) {
    const int tid = otid(), lane = tid & 63, wave = __builtin_amdgcn_readfirstlane(tid >> 6);
    const int ntm = M / 128, ntn = N / 128, nkt = K / 64;
    const int wm = (wave >> 1) * 64, wn = (wave & 1) * 64;
    const int fr = lane & 31, fh = lane >> 5;
    const int rr = lane >> 3, cc = lane & 7;
    const int gcol = (cc ^ rr) * 8;
    const int nSm = (ntm + TMS - 1) / TMS, nSn = (ntn + TNS - 1) / TNS, S = TMS * TNS;
    const int xg = blockIdx.x & 7, lb = blockIdx.x >> 3, nlb = gridDim.x >> 3;
    for (int st = xg; st < nSm * nSn; st += 8)
    for (int t = lb; t < S; t += nlb) {
        const int tm = (st / nSn) * TMS + t % TMS, tn = (st % nSn) * TNS + t / TMS;
        if (tm >= ntm || tn >= ntn) continue;
        if (skipctx && ((tm * 128) % LTOT) < CTX) continue;
        const bf16_t* ag = A + (size_t)(tm * 128 + 32 * wave + rr) * lda + gcol;
        const bf16_t* bg = Bt + (size_t)(tn * 128 + 32 * wave + rr) * ldb + gcol;
        f32x16 acc[2][2];
        {
            const f32x16 z16 = {0.f, 0.f, 0.f, 0.f, 0.f, 0.f, 0.f, 0.f, 0.f, 0.f, 0.f, 0.f, 0.f, 0.f, 0.f, 0.f};
            acc[0][0] = z16; acc[0][1] = z16; acc[1][0] = z16; acc[1][1] = z16;
        }
#define G3_ISSUE(kt_, b_) { unsigned char* la_ = smem + (b_) * 32768 + (32 * wave) * 128; unsigned char* lb_ = la_ + 16384; \
            _Pragma("unroll") for (int q = 0; q < 4; ++q) { \
                __builtin_amdgcn_global_load_lds((const unsigned*)(ag + (size_t)(8 * q) * lda + (kt_) * 64), (LAS unsigned*)(la_ + q * 1024), 16, 0, 0); \
                __builtin_amdgcn_global_load_lds((const unsigned*)(bg + (size_t)(8 * q) * ldb + (kt_) * 64), (LAS unsigned*)(lb_ + q * 1024), 16, 0, 0); } }
        __syncthreads();
        G3_ISSUE(0, 0)
        asm volatile("s_waitcnt vmcnt(0)" ::: "memory");
        __syncthreads();
        for (int kt = 0; kt < nkt; ++kt) {
            if (kt + 1 < nkt) G3_ISSUE(kt + 1, (kt + 1) & 1)
            const unsigned char* As = smem + (kt & 1) * 32768;
            const unsigned char* Bs = As + 16384;
#pragma unroll
            for (int kk = 0; kk < 4; ++kk) {
                bf16x8 a[2], b[2];
#pragma unroll
                for (int i = 0; i < 2; ++i) { const int r = wm + 32 * i + fr; a[i] = *(const bf16x8*)(As + r * 128 + (((2 * kk + fh) ^ (r & 7)) << 4)); }
#pragma unroll
                for (int j = 0; j < 2; ++j) { const int r = wn + 32 * j + fr; b[j] = *(const bf16x8*)(Bs + r * 128 + (((2 * kk + fh) ^ (r & 7)) << 4)); }
#pragma unroll
                for (int i = 0; i < 2; ++i)
#pragma unroll
                    for (int j = 0; j < 2; ++j) acc[i][j] = __builtin_amdgcn_mfma_f32_32x32x16_bf16(b[j], a[i], acc[i][j], 0, 0, 0);
            }
            asm volatile("s_waitcnt vmcnt(0)" ::: "memory");
            __syncthreads();
        }
#undef G3_ISSUE
#pragma unroll
        for (int i = 0; i < 2; ++i)
#pragma unroll
            for (int j = 0; j < 2; ++j)
#pragma unroll
                for (int g = 0; g < 4; ++g)
                    epi.store4(tm * 128 + wm + 32 * i + fr, tn * 128 + wn + 32 * j + 8 * g + 4 * fh, acc[i][j][4 * g], acc[i][j][4 * g + 1], acc[i][j][4 * g + 2], acc[i][j][4 * g + 3]);
    }
}
struct Epi4Bf16 { bf16_t* C; int ldc;
    __device__ __forceinline__ void store4(int r, int c, float v0, float v1, float v2, float v3) const {
        *(uint2*)(C + (size_t)r * ldc + c) = make_uint2(f2bf(v0) | ((unsigned)f2bf(v1) << 16), f2bf(v2) | ((unsigned)f2bf(v3) << 16)); } };
struct Epi4F32 { float* C; int ldc;
    __device__ __forceinline__ void store4(int r, int c, float v0, float v1, float v2, float v3) const { *(f32x4*)(C + (size_t)r * ldc + c) = (f32x4){v0, v1, v2, v3}; } };
struct Epi4Inproj { bf16_t* C; const float* lbt; bf16_t* hgt;
    __device__ __forceinline__ float tr(int c, float v) const {
        if (c >= 256 && c < 1536) {
            if (c < 512 || c >= 1280) v = siluf_(v);
            else if (c >= 768) { const float lb = lbt[c - 768]; v = __logf(lb + (1.f - lb) * sigmoidf_(v)); }
        }
        return v;
    }
    __device__ __forceinline__ void store4(int r, int c, float v0, float v1, float v2, float v3) const {
        v0 = tr(c, v0); v1 = tr(c + 1, v1); v2 = tr(c + 2, v2); v3 = tr(c + 3, v3);
        if (c >= 256 && c < 1280) {
            const int e = c - 256, f = e >> 8, hd = (e >> 6) & 3, ch = e & 63;
            bf16_t* d = hgt + ((((size_t)(r >> 4) * 4 + hd) * 4 + f) * 64 + ch) * 16 + (r & 15);
            d[0] = f2bf(v0); d[16] = f2bf(v1); d[32] = f2bf(v2); d[48] = f2bf(v3);
        } else
            *(uint2*)(C + (size_t)r * PIN + c) = make_uint2(pk2bf(v0, v1), pk2bf(v2, v3));
    } };
struct EpiInproj {
    bf16_t* C; const float* lbt;
    __device__ __forceinline__ void operator()(int r, int c, float v) const {
        if (c >= 256 && c < 1536) {
            if (c < 512 || c >= 1280) v = siluf_(v);
            else if (c >= 768) { const float lb = lbt[c - 768]; v = __logf(lb + (1.f - lb) * sigmoidf_(v)); }
        }
        C[(size_t)r * PIN + c] = f2bf(v);
    }
};
struct EpiBf16 { bf16_t* C; int ldc; __device__ __forceinline__ void operator()(int r, int c, float v) const { C[(size_t)r * ldc + c] = f2bf(v); } };
struct EpiF32 { float* C; int ldc; __device__ __forceinline__ void operator()(int r, int c, float v) const { C[(size_t)r * ldc + c] = v; } };

__device__ __forceinline__ void phase_rwprep(const Params& P, int l, unsigned char* smem) {
    const int tid = otid();
    const bf16_t* Pb = (const bf16_t*)(P.ws + OFF_P);
    bf16_t* RW = (bf16_t*)(P.ws + OFF_RW);
    const float* mu = P.in[24] + l * 1920;
    const float* k_k = P.in[30] + l * 512;
    float* tw = (float*)smem;
    float* al = tw + 2 * 8 * 64;
    float* kk2 = al + 2 * 8 * 64;
    float* nrm = kk2 + 8 * 512;
    for (int u = blockIdx.x; u < MROWS / 8; u += gridDim.x) {
        const int r0 = u * 8;
        __syncthreads();
        for (int i = 0; i < 8; ++i) {
            const int row = r0 + i, p = row % LTOT;
            int nb[4]; bool ok[4];
            if (p < CTX) {
                nb[0] = row - 1; ok[0] = p > 0; nb[1] = row + 1; ok[1] = p < CTX - 1; nb[2] = nb[0]; ok[2] = ok[0]; nb[3] = nb[1]; ok[3] = ok[1];
            } else {
                const int t = p - CTX, gr = t >> 6, gc = t & 63;
                nb[0] = row - 1; ok[0] = gc > 0; nb[1] = row + 1; ok[1] = gc < 63; nb[2] = row - 64; ok[2] = gr > 0; nb[3] = row + 64; ok[3] = gr < 63;
            }
            for (int c = tid; c < 1920; c += 256) {
                const int m = c & 3;
                const float pv = bf2f(Pb[(size_t)row * PIN + 1536 + c]);
                const float nv = ok[m] ? bf2f(Pb[(size_t)nb[m] * PIN + 1536 + c]) : 0.f;
                const float s = pv + mu[c] * (nv - pv);
                bf16_t* rw = RW + (size_t)row * RWW;
                if (c < 512) rw[c] = f2bf(s);
                else if (c < 1024) { rw[c] = f2bf(s); kk2[i * 512 + (c - 512)] = s * k_k[c - 512]; }
                else if (c < 1536) rw[c] = f2bf(s);
                else if (c < 1664) rw[4096 + (c - 1536)] = f2bf(sigmoidf_(s));
                else if (c < 1728) tw[(0 * 8 + i) * 64 + (c - 1664)] = tanhf(s);
                else if (c < 1792) tw[(1 * 8 + i) * 64 + (c - 1728)] = tanhf(s);
                else if (c < 1856) al[(0 * 8 + i) * 64 + (c - 1792)] = s;
                else al[(1 * 8 + i) * 64 + (c - 1856)] = s;
            }
        }
        __syncthreads();
        {
            const int pair = tid >> 2, q = tid & 3, i = pair >> 3, hd = pair & 7;
            float s = 0.f;
            for (int j = 0; j < 16; ++j) { const float v = kk2[i * 512 + hd * 64 + q * 16 + j]; s += v * v; }
            s += __shfl_xor(s, 1, 64); s += __shfl_xor(s, 2, 64);
            if (q == 0) nrm[pair] = fmaxf(sqrtf(s), 1e-12f);
        }
        __syncthreads();
        for (int e = tid; e < 8 * 512; e += 256) {
            const int i = e >> 9, c = e & 511;
            RW[(size_t)(r0 + i) * RWW + 1536 + c] = f2bf(kk2[e] / nrm[i * 8 + (c >> 6)]);
        }
        for (int d = 0; d < 2; ++d) {
            const float* wup = P.in[26] + (size_t)(l * 2 + d) * 64 * 512;
            const float* aup = P.in[28] + (size_t)(l * 2 + d) * 64 * 512;
            const float* w0 = P.in[25] + (l * 2 + d) * 512;
            const float* a0 = P.in[27] + (l * 2 + d) * 512;
            float zw[2][8], za[2][8];
#pragma unroll
            for (int i = 0; i < 8; ++i) { zw[0][i] = zw[1][i] = za[0][i] = za[1][i] = 0.f; }
            for (int j = 0; j < 64; ++j) {
                const float w_0 = wup[j * 512 + tid], w_1 = wup[j * 512 + tid + 256];
                const float a_0 = aup[j * 512 + tid], a_1 = aup[j * 512 + tid + 256];
#pragma unroll
                for (int i = 0; i < 8; ++i) {
                    const float t = tw[(d * 8 + i) * 64 + j], a = al[(d * 8 + i) * 64 + j];
                    zw[0][i] += t * w_0; zw[1][i] += t * w_1; za[0][i] += a * a_0; za[1][i] += a * a_1;
                }
            }
#pragma unroll
            for (int i = 0; i < 8; ++i) {
                bf16_t* rw = RW + (size_t)(r0 + i) * RWW;
#pragma unroll
                for (int h = 0; h < 2; ++h) {
                    const int c = tid + 256 * h;
                    rw[2048 + d * 512 + c] = f2bf(sigmoidf_(a0[c] + za[h][i]));
                    rw[3072 + d * 512 + c] = f2bf(-0.60653066f * sigmoidf_(w0[c] + zw[h][i]));
                }
            }
        }
    }
}

__device__ __forceinline__ void scan_rwkv(const Params& P, int l, int item) {
    const int lane = otid() & 63;
    const int dir = item & 1, hd = (item >> 1) & 7, b = item >> 4;
    const bf16_t* RW = (const bf16_t*)(P.ws + OFF_RW);
    bf16_t* YP = (bf16_t*)(P.ws + OFF_YP) + (size_t)dir * MROWS * DM;
    const float ka = P.in[31][l * 512 + hd * 64 + lane];
    float S[64];
#pragma unroll
    for (int k = 0; k < 64; ++k) S[k] = 0.f;
    for (int tau = 0; tau < LTOT; ++tau) {
        const int row = row_of(b, dir, tau);
#ifdef EXP_T2
        if ((tau & 127) == 0) {
            float* RXL = (float*)(P.ws + OFF_RXL);
            const size_t itm = (size_t)item * 34 + (tau >> 7);
#pragma unroll
            for (int kk = 0; kk < 64; ++kk) RXL[((itm * 16 + (kk >> 4) * 4 + (lane >> 4)) * 64 + ((kk >> 2) & 3) * 16 + (lane & 15)) * 4 + (kk & 3)] = S[kk];
        }
#endif
        const bf16_t* rw = RW + (size_t)row * RWW + hd * 64 + lane;
        const float r = bf2f(rw[0]), k = bf2f(rw[512]), v = bf2f(rw[1024]), kap = bf2f(rw[1536]);
        const float a = bf2f(rw[2048 + dir * 512]), lw = bf2f(rw[3072 + dir * 512]);
        const float w = __expf(lw), kt = k * (1.f + (a - 1.f) * ka), beta = kap * a;
        float sk = 0.f;
#pragma unroll
        for (int kk = 0; kk < 64; ++kk) { sk += S[kk] * rdlane(kap, kk); if ((kk & 7) == 7) __builtin_amdgcn_sched_barrier(0); }
        float y = 0.f;
#pragma unroll
        for (int kk = 0; kk < 64; ++kk) {
            const float s = S[kk] * rdlane(w, kk) - sk * rdlane(beta, kk) + v * rdlane(kt, kk);
            S[kk] = s;
            y += s * rdlane(r, kk);
            if ((kk & 3) == 3) __builtin_amdgcn_sched_barrier(0);
        }
        YP[(size_t)row * DM + 512 + hd * 64 + lane] = f2bf(y);
    }
}
__device__ __forceinline__ void scan_hgrn(const Params& P, int l, int item) {
    const int lane = otid() & 63;
    const int dir = item & 1, hd = (item >> 1) & 3, b = item >> 3;
    const bf16_t* Pb = (const bf16_t*)(P.ws + OFF_P);
    bf16_t* YP = (bf16_t*)(P.ws + OFF_YP) + (size_t)dir * MROWS * DM;
    float lb = 0.f;
    if (l == 1) {
        const float a0 = P.in[22][(dir * 2 + 0) * 256 + hd * 64 + lane], a1 = P.in[22][(dir * 2 + 1) * 256 + hd * 64 + lane];
        const float m = fmaxf(a0, a1), e0 = __expf(a0 - m), e1 = __expf(a1 - m);
        lb = e1 / (e0 + e1);
    }
    float S[64];
#pragma unroll
    for (int k = 0; k < 64; ++k) S[k] = 0.f;
    for (int tau = 0; tau < LTOT; ++tau) {
        const int row = row_of(b, dir, tau);
        const bf16_t* pr = Pb + (size_t)row * PIN + 256 + hd * 64 + lane;
        const float q = siluf_(bf2f(pr[0])), v = bf2f(pr[256]);
        const float f = lb + (1.f - lb) * sigmoidf_(bf2f(pr[512 + dir * 256]));
        const float kq = 1.f - f;
        float o = 0.f;
#pragma unroll
        for (int dk = 0; dk < 64; ++dk) {
            const float s = rdlane(f, dk) * S[dk] + rdlane(kq, dk) * v;
            S[dk] = s;
            o += s * rdlane(q, dk);
            if ((dk & 7) == 7) __builtin_amdgcn_sched_barrier(0);
        }
        YP[(size_t)row * DM + 256 + hd * 64 + lane] = f2bf(o);
    }
}
__device__ __forceinline__ void scan_s5(const Params& P, int l, int item) {
    const int lane = otid() & 63;
    const int dir = item & 1, g = (item >> 1) & 15, b = item >> 5;
    const bf16_t* Pb = (const bf16_t*)(P.ws + OFF_P);
    bf16_t* YP = (bf16_t*)(P.ws + OFF_YP) + (size_t)dir * MROWS * DM;
    const int ldg = (l * 2 + dir) * 16 + g;
    const float dt = expf(P.in[14][ldg]);
    const float lre = P.in[12][ldg * 64 + lane], lim = P.in[13][ldg * 64 + lane];
    const float mag = expf(lre * dt), ang = lim * dt;
    const float lb_re = mag * cosf(ang), lb_im = mag * sinf(ang);
    const float den = lre * lre + lim * lim, nr = lb_re - 1.f, ni = lb_im;
    const float co_re = (nr * lre + ni * lim) / den, co_im = (ni * lre - nr * lim) / den;
    float bb_re[16], bb_im[16], c_re[16], c_im[16];
#pragma unroll
    for (int h = 0; h < 16; ++h) {
        const float br = P.in[15][((size_t)ldg * 64 + lane) * 16 + h], bi = P.in[16][((size_t)ldg * 64 + lane) * 16 + h];
        bb_re[h] = co_re * br - co_im * bi; bb_im[h] = co_re * bi + co_im * br;
        c_re[h] = P.in[17][((size_t)ldg * 16 + h) * 64 + lane]; c_im[h] = P.in[18][((size_t)ldg * 16 + h) * 64 + lane];
    }
    float s_re = 0.f, s_im = 0.f;
    for (int tau = 0; tau < LTOT; ++tau) {
        const int row = row_of(b, dir, tau);
        const float uv = bf2f(Pb[(size_t)row * PIN + g * 16 + (lane & 15)]);
        float bu_re = 0.f, bu_im = 0.f;
#pragma unroll
        for (int h = 0; h < 16; ++h) { const float uh = rdlane(uv, h); bu_re += bb_re[h] * uh; bu_im += bb_im[h] * uh; }
        const float n_re = lb_re * s_re - lb_im * s_im + bu_re, n_im = lb_re * s_im + lb_im * s_re + bu_im;
        s_re = n_re; s_im = n_im;
        float yo = 0.f;
#pragma unroll
        for (int h = 0; h < 16; ++h) { const float t = wave_sum(c_re[h] * s_re - c_im[h] * s_im); yo = (lane == h) ? t : yo; }
        if (lane < 16) YP[(size_t)row * DM + g * 16 + lane] = f2bf(yo);
    }
}
__device__ __forceinline__ void phase_scans(const Params& P, int l) {
    const int wave = __builtin_amdgcn_readfirstlane(otid() >> 6);
    for (int it = wave * gridDim.x + blockIdx.x; it < 32; it += 4 * gridDim.x) scan_hgrn(P, l, it);
}

__device__ __forceinline__ void phase_post(const Params& P, int l, unsigned char* smem) {
    const int tid = otid();
    const bf16_t* Pb = (const bf16_t*)(P.ws + OFF_P);
    const bf16_t* RW = (const bf16_t*)(P.ws + OFF_RW);
    const bf16_t* YF = (const bf16_t*)(P.ws + OFF_YP);
    const bf16_t* YB = YF + (size_t)MROWS * DM;
    bf16_t* MIX = (bf16_t*)(P.ws + OFF_MIX);
    float* ypre = (float*)smem;
    float* sg = ypre + 8 * 256;
    for (int u = blockIdx.x; u < MROWS / 8; u += gridDim.x) {
        const int r0 = u * 8;
        if (l == 1 && (r0 % LTOT) < CTX) continue;
        __syncthreads();
        for (int i = 0; i < 8; ++i) {
            const int row = r0 + i;
            ypre[i * 256 + tid] = bf2f(YF[(size_t)row * DM + tid]);
        }
        for (int e = tid; e < 8 * 128; e += 256) sg[e] = bf2f(RW[(size_t)(r0 + (e >> 7)) * RWW + 4096 + (e & 127)]);
        __syncthreads();
        {
            float z[8];
            const float gb = P.in[21][l * 256 + tid];
#pragma unroll
            for (int i = 0; i < 8; ++i) z[i] = gb;
            const float* gw = P.in[20] + (size_t)l * 256 * 256 + tid;
            for (int k = 0; k < 256; ++k) {
                const float w = gw[k * 256];
#pragma unroll
                for (int i = 0; i < 8; ++i) z[i] += ypre[i * 256 + k] * w;
            }
#pragma unroll
            for (int i = 0; i < 8; ++i) MIX[(size_t)(r0 + i) * DM + tid] = f2bf(ypre[i * 256 + tid] * sigmoidf_(z[i]));
        }
        {
            const int i = tid >> 5, c0 = (tid & 31) * 8, row = r0 + i;
            float o[8], ss = 0.f;
#pragma unroll
            for (int j = 0; j < 8; ++j) { o[j] = bf2f(YF[(size_t)row * DM + 256 + c0 + j]) + bf2f(YB[(size_t)row * DM + 256 + c0 + j]); ss += o[j] * o[j]; }
            ss += __shfl_xor(ss, 1, 64); ss += __shfl_xor(ss, 2, 64); ss += __shfl_xor(ss, 4, 64);
            const float rs = rsqrtf(ss * (1.f / 64.f) + 1e-6f);
#pragma unroll
            for (int j = 0; j < 8; ++j) {
                const float gr = bf2f(Pb[(size_t)row * PIN + 256 + 1024 + c0 + j]);
                MIX[(size_t)row * DM + 256 + c0 + j] = f2bf(o[j] * rs * P.in[23][l * 256 + c0 + j] * siluf_(gr));
            }
        }
        {
            const int i = tid >> 5, c0 = (tid & 31) * 16, row = r0 + i;
            const bf16_t* rw = RW + (size_t)row * RWW;
            float y[16], vv[16], sum = 0.f, bon = 0.f;
#pragma unroll
            for (int j = 0; j < 16; ++j) {
                const int c = c0 + j;
                y[j] = bf2f(YF[(size_t)row * DM + 512 + c]) + bf2f(YB[(size_t)row * DM + 512 + c]);
                sum += y[j];
                const float r = bf2f(rw[c]), k = bf2f(rw[512 + c]), af = bf2f(rw[2048 + c]), ab = bf2f(rw[2560 + c]);
                const float ka = P.in[31][l * 512 + c];
                vv[j] = bf2f(rw[1024 + c]);
                bon += r * P.in[32][l * 512 + c] * (k * (1.f + (af - 1.f) * ka) + k * (1.f + (ab - 1.f) * ka));
            }
            sum += __shfl_xor(sum, 1, 64); sum += __shfl_xor(sum, 2, 64);
            bon += __shfl_xor(bon, 1, 64); bon += __shfl_xor(bon, 2, 64);
            const float mean = sum * (1.f / 64.f);
            float var = 0.f;
#pragma unroll
            for (int j = 0; j < 16; ++j) { const float d = y[j] - mean; var += d * d; }
            var += __shfl_xor(var, 1, 64); var += __shfl_xor(var, 2, 64);
            const float rs = rsqrtf(var * (1.f / 64.f) + 64e-5f);
            float g[16];
#pragma unroll
            for (int j = 0; j < 16; ++j) g[j] = 0.f;
            const float* gup = P.in[29] + (size_t)l * 128 * 512 + c0;
            for (int jj = 0; jj < 128; ++jj) {
                const float s = sg[i * 128 + jj];
                const float4 w0 = *(const float4*)(gup + jj * 512), w1 = *(const float4*)(gup + jj * 512 + 4), w2 = *(const float4*)(gup + jj * 512 + 8), w3 = *(const float4*)(gup + jj * 512 + 12);
                g[0] += s * w0.x; g[1] += s * w0.y; g[2] += s * w0.z; g[3] += s * w0.w;
                g[4] += s * w1.x; g[5] += s * w1.y; g[6] += s * w1.z; g[7] += s * w1.w;
                g[8] += s * w2.x; g[9] += s * w2.y; g[10] += s * w2.z; g[11] += s * w2.w;
                g[12] += s * w3.x; g[13] += s * w3.y; g[14] += s * w3.z; g[15] += s * w3.w;
            }
#pragma unroll
            for (int j = 0; j < 16; ++j) {
                const int c = c0 + j;
                const float yn = (y[j] - mean) * rs * P.in[33][l * 512 + c] + P.in[34][l * 512 + c];
                MIX[(size_t)row * DM + 512 + c] = f2bf((yn + bon * vv[j]) * g[j]);
            }
        }
    }
}

__device__ __forceinline__ void phase_ln1(const Params& P, int l) {
    const int lane = otid() & 63, wave = __builtin_amdgcn_readfirstlane(otid() >> 6);
    float* XS = (float*)(P.ws + OFF_XS);
    const float* TMP = (const float*)(P.ws + OFF_TMP);
    const float* MOD = (const float*)(P.ws + OFF_MOD);
    bf16_t* H2 = (bf16_t*)(P.ws + OFF_H2);
    for (int row = blockIdx.x * 4 + wave; row < MROWS; row += gridDim.x * 4) {
        if (l == 1 && (row % LTOT) < CTX) continue;
        const float* mod = MOD + (size_t)(l * 5 + modrow(row)) * 6144;
        float v[16]; float s = 0.f;
#pragma unroll
        for (int j = 0; j < 4; ++j) {
            const int d = 256 * j + 4 * lane;
            const float4 x = *(const float4*)(XS + (size_t)row * DM + d), t = *(const float4*)(TMP + (size_t)row * DM + d), g = *(const float4*)(mod + 2048 + d);
            v[4 * j + 0] = ALPHA * x.x + g.x * t.x; v[4 * j + 1] = ALPHA * x.y + g.y * t.y; v[4 * j + 2] = ALPHA * x.z + g.z * t.z; v[4 * j + 3] = ALPHA * x.w + g.w * t.w;
            s += v[4 * j] + v[4 * j + 1] + v[4 * j + 2] + v[4 * j + 3];
        }
        const float mean = wave_sum(s) * (1.f / 1024.f);
        float q = 0.f;
#pragma unroll
        for (int j = 0; j < 16; ++j) { const float d = v[j] - mean; q += d * d; }
        const float rs = rsqrtf(wave_sum(q) * (1.f / 1024.f) + 1e-5f);
#pragma unroll
        for (int j = 0; j < 4; ++j) {
            const int d = 256 * j + 4 * lane;
            const float4 gg = *(const float4*)(P.in[8] + l * 1024 + d), bb = *(const float4*)(P.in[9] + l * 1024 + d);
            const float4 sh = *(const float4*)(mod + 3072 + d), sc = *(const float4*)(mod + 4096 + d);
            float4 o;
            o.x = (v[4 * j + 0] - mean) * rs * gg.x + bb.x; o.y = (v[4 * j + 1] - mean) * rs * gg.y + bb.y;
            o.z = (v[4 * j + 2] - mean) * rs * gg.z + bb.z; o.w = (v[4 * j + 3] - mean) * rs * gg.w + bb.w;
            *(float4*)(XS + (size_t)row * DM + d) = o;
            ushort4 h;
            h.x = f2bf(o.x * (1.f + sc.x) + sh.x); h.y = f2bf(o.y * (1.f + sc.y) + sh.y); h.z = f2bf(o.z * (1.f + sc.z) + sh.z); h.w = f2bf(o.w * (1.f + sc.w) + sh.w);
            *(ushort4*)(H2 + (size_t)row * DM + d) = h;
        }
    }
}

__device__ __forceinline__ unsigned f2ord(float f) { const unsigned u = __float_as_uint(f); return u ^ ((u >> 31) ? 0xFFFFFFFFu : 0x80000000u); }
__device__ __forceinline__ float ord2f(unsigned u) { return __uint_as_float((u >> 31) ? (u ^ 0x80000000u) : ~u); }
__device__ __forceinline__ void phase_topk(const Params& P, int l) {
    const int tid = otid();
    const bf16_t* Q = (const bf16_t*)(P.ws + OFF_Q);
    int* IDX = (int*)(P.ws + OFF_IDX);
    float* GATE = (float*)(P.ws + OFF_GATE);
    for (int u = blockIdx.x; u < 8 * (MROWS / 256); u += gridDim.x) {
        const int hd = u / (MROWS / 256), rb = u % (MROWS / 256);
        const int row = rb * 256 + tid;
        if (l == 1 && (row % LTOT) < CTX) continue;
        unsigned top[2][16];
#pragma unroll
        for (int half = 0; half < 2; ++half) {
            float q[128];
            const bf16_t* qp = Q + (size_t)row * 2048 + hd * 256 + half * 128;
#pragma unroll
            for (int d8 = 0; d8 < 16; ++d8) {
                const bf16x8 v = *(const bf16x8*)(qp + d8 * 8);
#pragma unroll
                for (int j = 0; j < 8; ++j) q[d8 * 8 + j] = bf2f((bf16_t)v[j]);
            }
#pragma unroll
            for (int j = 0; j < 16; ++j) top[half][j] = 0u;
            const float* kp = P.in[36] + ((size_t)((l * 8 + hd) * 2 + half)) * 128 * 128;
            for (int key = 0; key < 128; ++key) {
                const float* kr = kp + key * 128;
                float s0 = 0.f, s1 = 0.f, s2 = 0.f, s3 = 0.f;
#pragma unroll
                for (int d = 0; d < 128; d += 4) { s0 += q[d] * kr[d]; s1 += q[d + 1] * kr[d + 1]; s2 += q[d + 2] * kr[d + 2]; s3 += q[d + 3] * kr[d + 3]; if ((d & 31) == 28) __builtin_amdgcn_sched_barrier(0); }
                unsigned x = (f2ord((s0 + s1) + (s2 + s3)) & 0xFFFFFF80u) | (unsigned)(127 - key);
#pragma unroll
                for (int j = 0; j < 16; ++j) { const unsigned t = top[half][j]; const unsigned mx = x > t ? x : t; x = x > t ? t : x; top[half][j] = mx; }
            }
        }
        float cs[16]; int ce[16];
#pragma unroll
        for (int j = 0; j < 16; ++j) { cs[j] = -3.0e38f; ce[j] = 0; }
#pragma unroll
        for (int i = 0; i < 16; ++i) {
            const float s1v = ord2f(top[0][i] & 0xFFFFFF80u); const int i1 = 127 - (int)(top[0][i] & 127u);
#pragma unroll
            for (int j = 0; j < 16; ++j) {
                if ((i + 1) * (j + 1) <= 16) {
                    float x = s1v + ord2f(top[1][j] & 0xFFFFFF80u); int xe = i1 * 128 + (127 - (int)(top[1][j] & 127u));
#pragma unroll
                    for (int t = 0; t < 16; ++t) {
                        const bool gt = x > cs[t];
                        const float ts = cs[t]; const int te = ce[t];
                        cs[t] = gt ? x : ts; ce[t] = gt ? xe : te; x = gt ? ts : x; xe = gt ? te : xe;
                    }
                }
            }
        }
        float den = 0.f, ex[16];
#pragma unroll
        for (int t = 0; t < 16; ++t) { ex[t] = __expf(cs[t] - cs[0]); den += ex[t]; }
        const float inv = 1.f / den;
#pragma unroll
        for (int t = 0; t < 16; ++t) { IDX[(size_t)row * 128 + hd * 16 + t] = ce[t]; GATE[(size_t)row * 128 + hd * 16 + t] = ex[t] * inv; }
    }
}


__device__ __forceinline__ void ce_desc(unsigned& a, unsigned& b) { const unsigned hi = a > b ? a : b, lo = a > b ? b : a; a = hi; b = lo; }
__device__ __forceinline__ void bitonic_sort16(unsigned (&u)[16]) {
#pragma unroll
    for (int k = 2; k <= 16; k <<= 1)
#pragma unroll
        for (int j = k >> 1; j > 0; j >>= 1)
#pragma unroll
            for (int i = 0; i < 16; ++i) {
                const int p = i ^ j;
                if (p > i) { if ((i & k) == 0) ce_desc(u[i], u[p]); else ce_desc(u[p], u[i]); }
            }
}
__device__ __forceinline__ void bitonic_merge16(unsigned (&u)[16]) {
#pragma unroll
    for (int j = 8; j > 0; j >>= 1)
#pragma unroll
        for (int i = 0; i < 16; ++i) { const int p = i ^ j; if (p > i) ce_desc(u[i], u[p]); }
}
__device__ __forceinline__ void xlane_top16(unsigned (&u)[16], int xr) {
    unsigned o[16];
#pragma unroll
    for (int i = 0; i < 16; ++i) o[i] = (unsigned)__shfl_xor((int)u[15 - i], xr, 64);
#pragma unroll
    for (int i = 0; i < 16; ++i) u[i] = u[i] > o[i] ? u[i] : o[i];
    bitonic_merge16(u);
}
__device__ __forceinline__ void phase_topk2(const Params& P, int l, unsigned char* smem) {
    const int lane = otid() & 63, wave = __builtin_amdgcn_readfirstlane(otid() >> 6), fr = lane & 15, fq = lane >> 4;
    const bf16_t* Q = (const bf16_t*)(P.ws + OFF_Q);
    const bf16_t* KB = (const bf16_t*)(P.ws + OFF_KEYB);
    int* IDX = (int*)(P.ws + OFF_IDX);
    float* GATE = (float*)(P.ws + OFF_GATE);
    unsigned char* ids = smem + wave * 512;
    for (int it = blockIdx.x * 4 + wave; it < (MROWS / 16) * 8; it += gridDim.x * 4) {
        const int rt = it >> 3, hd = it & 7, row0 = rt * 16;
        if (l == 1 && (row0 % LTOT) < CTX) continue;
        unsigned top[2][16];
#pragma unroll
        for (int half = 0; half < 2; ++half) {
            f32x4 acc[8];
#pragma unroll
            for (int mi = 0; mi < 8; ++mi) acc[mi] = (f32x4){0.f, 0.f, 0.f, 0.f};
            const bf16_t* kp = KB + ((size_t)((l * 8 + hd) * 2 + half) * 128 + fr) * 128 + 8 * fq;
            const bf16_t* qp = Q + (size_t)(row0 + fr) * 2048 + hd * 256 + half * 128 + 8 * fq;
#pragma unroll
            for (int ks = 0; ks < 4; ++ks) {
                const bf16x8 qb = *(const bf16x8*)(qp + 32 * ks);
#pragma unroll
                for (int mi = 0; mi < 8; ++mi) acc[mi] = mfma32(*(const bf16x8*)(kp + (size_t)(16 * mi) * 128 + 32 * ks), qb, acc[mi]);
            }
            unsigned ua[16], ub[16];
#pragma unroll
            for (int mi = 0; mi < 4; ++mi)
#pragma unroll
                for (int r = 0; r < 4; ++r) {
                    ua[mi * 4 + r] = (f2ord(acc[mi][r]) & 0xFFFFFF80u) | (unsigned)(127 - (16 * mi + 4 * fq + r));
                    ub[mi * 4 + r] = (f2ord(acc[mi + 4][r]) & 0xFFFFFF80u) | (unsigned)(127 - (16 * (mi + 4) + 4 * fq + r));
                }
            bitonic_sort16(ua); bitonic_sort16(ub);
#pragma unroll
            for (int i = 0; i < 16; ++i) ua[i] = ua[i] > ub[15 - i] ? ua[i] : ub[15 - i];
            bitonic_merge16(ua);
            xlane_top16(ua, 16); xlane_top16(ua, 32);
#pragma unroll
            for (int i = 0; i < 16; ++i) top[half][i] = ua[i];
        }
        if (fq == 0) {
            unsigned w[8];
#pragma unroll
            for (int i = 0; i < 8; ++i) {
                const unsigned* t = i < 4 ? &top[0][4 * i] : &top[1][4 * (i - 4)];
                w[i] = (127u - (t[0] & 127u)) | ((127u - (t[1] & 127u)) << 8) | ((127u - (t[2] & 127u)) << 16) | ((127u - (t[3] & 127u)) << 24);
            }
            *(uint4*)(ids + fr * 32) = make_uint4(w[0], w[1], w[2], w[3]);
            *(uint4*)(ids + fr * 32 + 16) = make_uint4(w[4], w[5], w[6], w[7]);
        }
        float s2v[16];
#pragma unroll
        for (int j = 0; j < 16; ++j) s2v[j] = ord2f(top[1][j] & 0xFFFFFF80u);
        float s1r[4];
#pragma unroll
        for (int m = 0; m < 4; ++m) {
            const unsigned t = fq == 0 ? top[0][4 * m] : (fq == 1 ? top[0][4 * m + 1] : (fq == 2 ? top[0][4 * m + 2] : top[0][4 * m + 3]));
            s1r[m] = ord2f(t & 0xFFFFFF80u);
        }
        unsigned cu[16];
#pragma unroll
        for (int j = 0; j < 16; ++j) cu[j] = (f2ord(s1r[0] + s2v[j]) & 0xFFFFFF00u) | (unsigned)((fq << 4) | j);
        {
            unsigned ex[5];
            ex[0] = (f2ord(s1r[1] + s2v[0]) & 0xFFFFFF00u) | (unsigned)(((4 + fq) << 4) | 0);
            ex[1] = (f2ord(s1r[1] + s2v[1]) & 0xFFFFFF00u) | (unsigned)(((4 + fq) << 4) | 1);
            ex[2] = (f2ord(s1r[1] + s2v[2]) & 0xFFFFFF00u) | (unsigned)(((4 + fq) << 4) | 2);
            ex[3] = (f2ord(s1r[2] + s2v[0]) & 0xFFFFFF00u) | (unsigned)(((8 + fq) << 4) | 0);
            ex[4] = (f2ord(s1r[3] + s2v[0]) & 0xFFFFFF00u) | (unsigned)(((12 + fq) << 4) | 0);
#pragma unroll
            for (int e = 0; e < 5; ++e) {
                unsigned x = ex[e];
#pragma unroll
                for (int t = 0; t < 16; ++t) { const unsigned c = cu[t]; const unsigned mx = x > c ? x : c; x = x > c ? c : x; cu[t] = mx; }
            }
        }
        xlane_top16(cu, 16); xlane_top16(cu, 32);
        if (fq == 0) {
            float ex[16], den = 0.f; int eid[16];
            const float m0 = ord2f(cu[0] & 0xFFFFFF00u);
#pragma unroll
            for (int t = 0; t < 16; ++t) {
                ex[t] = __expf(ord2f(cu[t] & 0xFFFFFF00u) - m0); den += ex[t];
                const int i = (cu[t] >> 4) & 15, j = cu[t] & 15;
                eid[t] = (int)ids[fr * 32 + i] * 128 + (int)ids[fr * 32 + 16 + j];
            }
            const float inv = 1.f / den;
            int* ip = IDX + (size_t)(row0 + fr) * 128 + hd * 16;
            float* gp = GATE + (size_t)(row0 + fr) * 128 + hd * 16;
#pragma unroll
            for (int t = 0; t < 16; t += 4) {
                *(int4*)(ip + t) = make_int4(eid[t], eid[t + 1], eid[t + 2], eid[t + 3]);
                *(float4*)(gp + t) = make_float4(ex[t] * inv, ex[t + 1] * inv, ex[t + 2] * inv, ex[t + 3] * inv);
            }
        }
    }
}

__device__ __forceinline__ void phase_tabconv(const Params& P, int l) {
    const float4* U = (const float4*)(P.in[37] + (size_t)l * 16384 * 1024);
    const float4* V = (const float4*)(P.in[38] + (size_t)l * 16384 * 1024);
    ushort4* TU = (ushort4*)(P.ws + OFF_TBU);
    ushort4* TV = (ushort4*)(P.ws + OFF_TBV);
    const size_t n4 = (size_t)16384 * 256;
    for (size_t i = (size_t)blockIdx.x * 256 + otid(); i < n4; i += (size_t)gridDim.x * 256) {
        const float4 a = U[i], b = V[i];
        ushort4 oa, ob;
        oa.x = f2bf(a.x); oa.y = f2bf(a.y); oa.z = f2bf(a.z); oa.w = f2bf(a.w);
        ob.x = f2bf(b.x); ob.y = f2bf(b.y); ob.z = f2bf(b.z); ob.w = f2bf(b.w);
        TU[i] = oa; TV[i] = ob;
    }
}
__device__ __forceinline__ float dot2bf(unsigned a, unsigned b, float acc) { return __builtin_amdgcn_fdot2_f32_bf16(__builtin_bit_cast(bf16x2, a), __builtin_bit_cast(bf16x2, b), acc, false); }
__device__ __forceinline__ float dot8(const uint4& a, const uint4& b, float acc) { acc = dot2bf(a.x, b.x, acc); acc = dot2bf(a.y, b.y, acc); acc = dot2bf(a.z, b.z, acc); return dot2bf(a.w, b.w, acc); }
__device__ __forceinline__ void phase_gather(const Params& P, int l, unsigned char* smem) {
    const int tid = otid(), lane = tid & 63, wave = __builtin_amdgcn_readfirstlane(tid >> 6);
    float* XS = (float*)(P.ws + OFF_XS);
    const float* MOD = (const float*)(P.ws + OFF_MOD);
    const bf16_t* H2 = (const bf16_t*)(P.ws + OFF_H2);
    bf16_t* H = (bf16_t*)(P.ws + OFF_H);
    const int* IDX = (const int*)(P.ws + OFF_IDX);
    const float* GATE = (const float*)(P.ws + OFF_GATE);
    const bf16_t* TU = (const bf16_t*)(P.ws + OFF_TBU);
    const bf16_t* TV = (const bf16_t*)(P.ws + OFF_TBV);
    float* coef = (float*)smem + wave * 128;
    for (int row = blockIdx.x * 4 + wave; row < MROWS; row += gridDim.x * 4) {
        if (l == 1 && (row % LTOT) < CTX) continue;
        const uint4 h0 = *(const uint4*)(H2 + (size_t)row * DM + 8 * lane), h1 = *(const uint4*)(H2 + (size_t)row * DM + 512 + 8 * lane);
        const int e0 = IDX[(size_t)row * 128 + lane], e1 = IDX[(size_t)row * 128 + 64 + lane];
        uint4 ra[8], rb[8];
#define LOADB(T, bt) { _Pragma("unroll") for (int i = 0; i < 8; ++i) { const int k = (bt) * 8 + i; const int e = __builtin_amdgcn_readlane(k < 64 ? e0 : e1, k & 63); \
            const uint4* rp = (const uint4*)((T) + (size_t)e * 1024); ra[i] = rp[lane]; rb[i] = rp[64 + lane]; } }
        for (int bt = 0; bt < 16; ++bt) {
            LOADB(TU, bt)
            float p[8];
#pragma unroll
            for (int i = 0; i < 8; ++i) p[i] = dot8(rb[i], h1, dot8(ra[i], h0, 0.f));
            float q[4], r2[2];
#pragma unroll
            for (int i = 0; i < 4; ++i) { const float sd = (lane & 32) ? p[i] : p[i + 4]; const float rc = __shfl_xor(sd, 32, 64); q[i] = ((lane & 32) ? p[i + 4] : p[i]) + rc; }
#pragma unroll
            for (int i = 0; i < 2; ++i) { const float sd = (lane & 16) ? q[i] : q[i + 2]; const float rc = __shfl_xor(sd, 16, 64); r2[i] = ((lane & 16) ? q[i + 2] : q[i]) + rc; }
            float sv;
            { const float sd = (lane & 8) ? r2[0] : r2[1]; const float rc = __shfl_xor(sd, 8, 64); sv = ((lane & 8) ? r2[1] : r2[0]) + rc; }
            sv += __shfl_xor(sv, 4, 64); sv += __shfl_xor(sv, 2, 64); sv += __shfl_xor(sv, 1, 64);
            if ((lane & 7) == 0) { const int k = bt * 8 + ((lane >> 3) & 7); coef[k] = gelu_tanh(sv) * GATE[(size_t)row * 128 + k]; }
        }
        float acc[16];
#pragma unroll
        for (int j = 0; j < 16; ++j) acc[j] = 0.f;
        for (int bt = 0; bt < 16; ++bt) {
            LOADB(TV, bt)
#pragma unroll
            for (int i = 0; i < 8; ++i) {
                const float c = coef[bt * 8 + i];
                const unsigned w[8] = {ra[i].x, ra[i].y, ra[i].z, ra[i].w, rb[i].x, rb[i].y, rb[i].z, rb[i].w};
#pragma unroll
                for (int j = 0; j < 8; ++j) { acc[2 * j] += c * __uint_as_float(w[j] << 16); acc[2 * j + 1] += c * __uint_as_float(w[j] & 0xFFFF0000u); }
            }
        }
#undef LOADB
        const float* mod = MOD + (size_t)(l * 5 + modrow(row)) * 6144;
        float v[16]; float s = 0.f;
#pragma unroll
        for (int hh = 0; hh < 2; ++hh) {
            const int d = 512 * hh + 8 * lane;
            const float4 x0 = *(const float4*)(XS + (size_t)row * DM + d), x1 = *(const float4*)(XS + (size_t)row * DM + d + 4);
            const float4 g0 = *(const float4*)(mod + 5120 + d), g1 = *(const float4*)(mod + 5120 + d + 4);
            v[8 * hh + 0] = ALPHA * x0.x + g0.x * acc[8 * hh + 0]; v[8 * hh + 1] = ALPHA * x0.y + g0.y * acc[8 * hh + 1];
            v[8 * hh + 2] = ALPHA * x0.z + g0.z * acc[8 * hh + 2]; v[8 * hh + 3] = ALPHA * x0.w + g0.w * acc[8 * hh + 3];
            v[8 * hh + 4] = ALPHA * x1.x + g1.x * acc[8 * hh + 4]; v[8 * hh + 5] = ALPHA * x1.y + g1.y * acc[8 * hh + 5];
            v[8 * hh + 6] = ALPHA * x1.z + g1.z * acc[8 * hh + 6]; v[8 * hh + 7] = ALPHA * x1.w + g1.w * acc[8 * hh + 7];
        }
#pragma unroll
        for (int j = 0; j < 16; ++j) s += v[j];
        const float mean = wave_sum(s) * (1.f / 1024.f);
        float qq = 0.f;
#pragma unroll
        for (int j = 0; j < 16; ++j) { v[j] -= mean; qq += v[j] * v[j]; }
        const float rs = rsqrtf(wave_sum(qq) * (1.f / 1024.f) + 1e-5f);
        const float* mod1 = MOD + (size_t)(1 * 5 + modrow(row)) * 6144;
#pragma unroll
        for (int hh = 0; hh < 2; ++hh) {
            const int d = 512 * hh + 8 * lane;
            float o[8];
#pragma unroll
            for (int j = 0; j < 8; ++j) o[j] = v[8 * hh + j] * rs * P.in[10][l * 1024 + d + j] + P.in[11][l * 1024 + d + j];
            if (l == 0) {
                *(float4*)(XS + (size_t)row * DM + d) = make_float4(o[0], o[1], o[2], o[3]);
                *(float4*)(XS + (size_t)row * DM + d + 4) = make_float4(o[4], o[5], o[6], o[7]);
                bf16_t hb[8];
#pragma unroll
                for (int j = 0; j < 8; ++j) hb[j] = f2bf(o[j] * (1.f + mod1[1024 + d + j]) + mod1[d + j]);
                uint4 pk; pk.x = hb[0] | ((unsigned)hb[1] << 16); pk.y = hb[2] | ((unsigned)hb[3] << 16); pk.z = hb[4] | ((unsigned)hb[5] << 16); pk.w = hb[6] | ((unsigned)hb[7] << 16);
                *(uint4*)(H + (size_t)row * DM + d) = pk;
            } else {
                const int b = row / LTOT, t = row % LTOT - CTX;
                if (*(volatile unsigned*)(P.ws + OFF_BAR + 15360) != 0u) { o[0] = __int_as_float(0x7fc00000); }
                float* op = P.out + ((size_t)b * SEQ + t) * DM + d;
                *(float4*)op = make_float4(o[0], o[1], o[2], o[3]);
                *(float4*)(op + 4) = make_float4(o[4], o[5], o[6], o[7]);
            }
        }
    }
}

__device__ __forceinline__ void s5_prep_unit(const Params& P, int l, int g, int part, unsigned char* smem) {
    const int tid = otid();
    float* Kt = (float*)smem;
    float* bbr = Kt + 8192; float* bbi = bbr + 1024; float* cr = bbi + 1024; float* ci = cr + 1024; float* pwr = ci + 1024; float* pwi = pwr + 17 * 64;
    bf16_t* MS = (bf16_t*)(P.ws + OFF_S5MS) + (size_t)(l * 16 + g) * 256 * 256;
    bf16_t* MY = (bf16_t*)(P.ws + OFF_S5MY) + (size_t)(l * 16 + g) * 256 * 512;
    float* LB = (float*)(P.ws + OFF_S5LB) + (size_t)(l * 16 + g) * 256;
    for (int dir = 0; dir < 2; ++dir) {
        __syncthreads();
        const int ldg = (l * 2 + dir) * 16 + g;
        if (tid < 64) {
            const int p = tid;
            const float dt = expf(P.in[14][ldg]);
            const float lre = P.in[12][ldg * 64 + p], lim = P.in[13][ldg * 64 + p];
            for (int d = 0; d <= 16; ++d) { const float mag = expf(lre * dt * (float)d), ang = lim * dt * (float)d; pwr[d * 64 + p] = mag * cosf(ang); pwi[d * 64 + p] = mag * sinf(ang); }
            const float lb_re = pwr[64 + p], lb_im = pwi[64 + p];
            const float den = lre * lre + lim * lim, nr = lb_re - 1.f, ni = lb_im;
            const float co_re = (nr * lre + ni * lim) / den, co_im = (ni * lre - nr * lim) / den;
            for (int h = 0; h < 16; ++h) {
                const float br = P.in[15][((size_t)ldg * 64 + p) * 16 + h], bi = P.in[16][((size_t)ldg * 64 + p) * 16 + h];
                bbr[p * 16 + h] = co_re * br - co_im * bi; bbi[p * 16 + h] = co_re * bi + co_im * br;
            }
            if (part == 0) { LB[dir * 128 + p] = pwr[16 * 64 + p]; LB[dir * 128 + 64 + p] = pwi[16 * 64 + p]; }
        }
        for (int e = tid; e < 1024; e += 256) { cr[e] = P.in[17][(size_t)ldg * 1024 + e]; ci[e] = P.in[18][(size_t)ldg * 1024 + e]; }
        __syncthreads();
        for (int e0 = tid; e0 < 1024; e0 += 256) {
            const int e = part * 1024 + e0, d = e >> 8, h = (e >> 4) & 15, h2 = e & 15;
            float acc = 0.f;
            for (int p = 0; p < 64; ++p) {
                const float Pr = pwr[d * 64 + p], Pi = pwi[d * 64 + p], br = bbr[p * 16 + h2], bi = bbi[p * 16 + h2];
                acc += cr[h * 64 + p] * (Pr * br - Pi * bi) - ci[h * 64 + p] * (Pr * bi + Pi * br);
            }
            Kt[dir * 4096 + e] = acc;
        }
        for (int e = tid; e < 32 * 256; e += 256) {
            const int q = part * 32 + (e >> 8), col = e & 255, j = col >> 4, h2 = col & 15, p = q & 63;
            const int ex = dir == 0 ? 15 - j : j;
            const float Pr = pwr[ex * 64 + p], Pi = pwi[ex * 64 + p], br = bbr[p * 16 + h2], bi = bbi[p * 16 + h2];
            MS[(size_t)(dir * 128 + q) * 256 + col] = f2bf(q < 64 ? Pr * br - Pi * bi : Pr * bi + Pi * br);
        }
        for (int e = tid; e < 64 * 128; e += 256) {
            const int ri = part * 64 + (e >> 7), q = e & 127, t = ri >> 4, h = ri & 15, p = q & 63;
            const int ex = dir == 0 ? t + 1 : 16 - t;
            const float Lr = pwr[ex * 64 + p], Li = pwi[ex * 64 + p], c_r = cr[h * 64 + p], c_i = ci[h * 64 + p];
            MY[(size_t)ri * 512 + 256 + dir * 128 + q] = f2bf(q < 64 ? c_r * Lr - c_i * Li : -(c_r * Li + c_i * Lr));
        }
    }
    __syncthreads();
    for (int e = tid; e < 4 * 16 * 2 * 256; e += 256) {
        const int hh = e & 255, side = (e >> 8) & 1, k = (e >> 9) & 15, d = part * 4 + (e >> 13);
        if (k + d > 15 || (d == 0 && side == 1)) continue;
        const int t = side == 0 ? k + d : k, j = side == 0 ? k : k + d, h = hh >> 4, h2 = hh & 15;
        float v = side == 0 ? Kt[d * 256 + hh] : Kt[4096 + d * 256 + hh];
        if (d == 0) v += Kt[4096 + hh];
        MY[(size_t)(t * 16 + h) * 512 + j * 16 + h2] = f2bf(v);
    }
}
__device__ __forceinline__ void s5_passA(const Params& P, int l, int bid, int nb) {
    const int lane = otid() & 63, wave = __builtin_amdgcn_readfirstlane(otid() >> 6), fr = lane & 15, fq = lane >> 4;
    const bf16_t* Pb = (const bf16_t*)(P.ws + OFF_P);
    float* ST = (float*)(P.ws + OFF_S5ST);
    for (int it = bid * 4 + wave; it < 16 * 17 * 4; it += nb * 4) {
        const int g = it / 68, mt = (it % 68) >> 2, nt = it & 3;
        const bf16_t* MS = (const bf16_t*)(P.ws + OFF_S5MS) + (size_t)(l * 16 + g) * 256 * 256;
        f32x4 acc[4][4];
#pragma unroll
        for (int i = 0; i < 4; ++i)
#pragma unroll
            for (int j = 0; j < 4; ++j) acc[i][j] = (f32x4){0.f, 0.f, 0.f, 0.f};
        const bf16_t* ap[4];
#pragma unroll
        for (int i = 0; i < 4; ++i) { const int m = mt * 64 + 16 * i + fr, b = m / 272, c = m % 272; ap[i] = Pb + (size_t)(b * LTOT + c * 16) * PIN + g * 16; }
        const bf16_t* bp = MS + (size_t)(nt * 64 + fr) * 256 + 8 * fq;
        for (int k0 = 0; k0 < 256; k0 += 32) {
            const int k = k0 + 8 * fq;
            bf16x8 a[4], bb[4];
#pragma unroll
            for (int i = 0; i < 4; ++i) a[i] = *(const bf16x8*)(ap[i] + (size_t)(k >> 4) * PIN + (k & 15));
#pragma unroll
            for (int j = 0; j < 4; ++j) bb[j] = *(const bf16x8*)(bp + (size_t)(16 * j) * 256 + k0);
#pragma unroll
            for (int i = 0; i < 4; ++i)
#pragma unroll
                for (int j = 0; j < 4; ++j) acc[i][j] = __builtin_amdgcn_mfma_f32_16x16x32_bf16(a[i], bb[j], acc[i][j], 0, 0, 0);
        }
#pragma unroll
        for (int i = 0; i < 4; ++i)
#pragma unroll
            for (int r = 0; r < 4; ++r) {
                const int m = mt * 64 + 16 * i + 4 * fq + r, b = m / 272, c = m % 272;
                float* dst = ST + ((size_t)(b * 16 + g) * 272 + c) * 256 + nt * 64 + fr;
#pragma unroll
                for (int j = 0; j < 4; ++j) dst[16 * j] = acc[i][j][r];
            }
    }
}
__device__ __forceinline__ void s5_carry(const Params& P, int l, int bid, int nb) {
    float* ST = (float*)(P.ws + OFF_S5ST);
    for (int u = bid; u < 32; u += nb) {
        const int gid = u * 256 + otid(), p = gid & 63, dir = (gid >> 6) & 1, g = (gid >> 7) & 15, b = gid >> 11;
        const float* LB = (const float*)(P.ws + OFF_S5LB) + (size_t)(l * 16 + g) * 256 + dir * 128;
        const float lr = LB[p], li = LB[64 + p];
        float* base = ST + (size_t)(b * 16 + g) * 272 * 256 + dir * 128 + p;
        float sr = 0.f, si = 0.f;
        for (int c0 = 0; c0 < 272; c0 += 16) {
            float tr[16], ti[16];
#pragma unroll
            for (int i = 0; i < 16; ++i) { const int cc = c0 + i, c = dir == 0 ? cc : (cc < 16 ? 15 - cc : 287 - cc); tr[i] = base[(size_t)c * 256]; ti[i] = base[(size_t)c * 256 + 64]; }
#pragma unroll
            for (int i = 0; i < 16; ++i) {
                const int cc = c0 + i, c = dir == 0 ? cc : (cc < 16 ? 15 - cc : 287 - cc);
                base[(size_t)c * 256] = sr; base[(size_t)c * 256 + 64] = si;
                const float nr = lr * sr - li * si + tr[i], ni = lr * si + li * sr + ti[i];
                sr = nr; si = ni;
            }
        }
    }
}
__device__ __forceinline__ void s5_passC(const Params& P, int l, int bid, int nb) {
    const int lane = otid() & 63, wave = __builtin_amdgcn_readfirstlane(otid() >> 6), fr = lane & 15, fq = lane >> 4;
    const bf16_t* Pb = (const bf16_t*)(P.ws + OFF_P);
    const float* ST = (const float*)(P.ws + OFF_S5ST);
    bf16_t* YA = (bf16_t*)(P.ws + OFF_YP);
    for (int it = bid * 4 + wave; it < 16 * 17 * 4; it += nb * 4) {
        const int g = it / 68, mt = (it % 68) >> 2, nt = it & 3;
        const bf16_t* MY = (const bf16_t*)(P.ws + OFF_S5MY) + (size_t)(l * 16 + g) * 256 * 512;
        f32x4 acc[4][4];
#pragma unroll
        for (int i = 0; i < 4; ++i)
#pragma unroll
            for (int j = 0; j < 4; ++j) acc[i][j] = (f32x4){0.f, 0.f, 0.f, 0.f};
        const bf16_t* ap[4]; const float* sp[4];
#pragma unroll
        for (int i = 0; i < 4; ++i) {
            const int m = mt * 64 + 16 * i + fr, b = m / 272, c = m % 272;
            ap[i] = Pb + (size_t)(b * LTOT + c * 16) * PIN + g * 16;
            sp[i] = ST + ((size_t)(b * 16 + g) * 272 + c) * 256;
        }
        const bf16_t* bp = MY + (size_t)(nt * 64 + fr) * 512 + 8 * fq;
        for (int k0 = 0; k0 < 512; k0 += 32) {
            const int k = k0 + 8 * fq;
            bf16x8 a[4], bb[4];
            if (k0 < 256) {
#pragma unroll
                for (int i = 0; i < 4; ++i) a[i] = *(const bf16x8*)(ap[i] + (size_t)(k >> 4) * PIN + (k & 15));
            } else {
#pragma unroll
                for (int i = 0; i < 4; ++i) {
                    const float4 s0 = *(const float4*)(sp[i] + (k - 256)), s1 = *(const float4*)(sp[i] + (k - 256) + 4);
                    bf16x8 t;
                    t[0] = (short)f2bf(s0.x); t[1] = (short)f2bf(s0.y); t[2] = (short)f2bf(s0.z); t[3] = (short)f2bf(s0.w);
                    t[4] = (short)f2bf(s1.x); t[5] = (short)f2bf(s1.y); t[6] = (short)f2bf(s1.z); t[7] = (short)f2bf(s1.w);
                    a[i] = t;
                }
            }
#pragma unroll
            for (int j = 0; j < 4; ++j) bb[j] = *(const bf16x8*)(bp + (size_t)(16 * j) * 512 + k0);
#pragma unroll
            for (int i = 0; i < 4; ++i)
#pragma unroll
                for (int j = 0; j < 4; ++j) acc[i][j] = __builtin_amdgcn_mfma_f32_16x16x32_bf16(a[i], bb[j], acc[i][j], 0, 0, 0);
        }
        const float dsk = P.in[19][l * 256 + g * 16 + fr];
#pragma unroll
        for (int i = 0; i < 4; ++i)
#pragma unroll
            for (int r = 0; r < 4; ++r) {
                const int m = mt * 64 + 16 * i + 4 * fq + r, b = m / 272, c = m % 272;
#pragma unroll
                for (int j = 0; j < 4; ++j) {
                    const int t = nt * 4 + j;
                    const size_t row = (size_t)(b * LTOT + c * 16 + t);
                    const float u = bf2f(Pb[row * PIN + g * 16 + fr]);
                    YA[row * DM + g * 16 + fr] = f2bf(gelu_tanh(acc[i][j][r] + dsk * u));
                }
            }
    }
}


#define OFF_T8 (OFF_RW + (size_t)100 * 1024 * 1024)
#define OFF_T8S (OFF_T8 + (size_t)2 * 16384 * 1024)
typedef float f32x2 __attribute__((ext_vector_type(2)));
__device__ __forceinline__ void phase_tabconv8(const Params& P, int l) {
    const int lane = otid() & 63, wave = __builtin_amdgcn_readfirstlane(otid() >> 6);
    unsigned char* T8 = P.ws + OFF_T8;
    float* T8S = (float*)(P.ws + OFF_T8S);
    for (int row = blockIdx.x * 4 + wave; row < 32768; row += gridDim.x * 4) {
        const float* src = P.in[37 + (row >> 14)] + ((size_t)l * 16384 + (row & 16383)) * 1024 + 16 * lane;
        f32x4 x[4];
        float am = 0.f;
#pragma unroll
        for (int j = 0; j < 4; ++j) { x[j] = *(const f32x4*)(src + 4 * j); am = fmaxf(am, fmaxf(fmaxf(fabsf(x[j][0]), fabsf(x[j][1])), fmaxf(fabsf(x[j][2]), fabsf(x[j][3])))); }
#pragma unroll
        for (int o = 32; o > 0; o >>= 1) am = fmaxf(am, __shfl_xor(am, o, 64));
        const float sc = am > 0.f ? 127.f / am : 1.f;
        u32x4 pk;
#pragma unroll
        for (int j = 0; j < 4; ++j) {
            const int off = (row >> 14) ? 128 : 0;
            const unsigned q0 = (unsigned)(__float2int_rn(x[j][0] * sc) + off) & 0xFFu, q1 = (unsigned)(__float2int_rn(x[j][1] * sc) + off) & 0xFFu;
            const unsigned q2 = (unsigned)(__float2int_rn(x[j][2] * sc) + off) & 0xFFu, q3 = (unsigned)(__float2int_rn(x[j][3] * sc) + off) & 0xFFu;
            pk[j] = q0 | (q1 << 8) | (q2 << 16) | (q3 << 24);
        }
        *(u32x4*)(T8 + (size_t)row * 1024 + 16 * lane) = pk;
        if (lane == 0) T8S[row] = am * (1.f / 127.f);
    }
}
__device__ __forceinline__ void phase_gather8(const Params& P, int l, unsigned char* smem) {
    const int tid = otid(), lane = tid & 63, wave = __builtin_amdgcn_readfirstlane(tid >> 6);
    float* XS = (float*)(P.ws + OFF_XS);
    const float* MOD = (const float*)(P.ws + OFF_MOD);
    const bf16_t* H2 = (const bf16_t*)(P.ws + OFF_H2);
    bf16_t* H = (bf16_t*)(P.ws + OFF_H);
    const int* IDX = (const int*)(P.ws + OFF_IDX);
    const float* GATE = (const float*)(P.ws + OFF_GATE);
    const unsigned char* TU = P.ws + OFF_T8;
    const unsigned char* TV = TU + (size_t)16384 * 1024;
    const float* SU = (const float*)(P.ws + OFF_T8S);
    const float* SV = SU + 16384;
    float* coef = (float*)smem + wave * 128;
    unsigned char* h8s = smem + 2048 + wave * 1024;
    for (int row = blockIdx.x * 4 + wave; row < MROWS; row += gridDim.x * 4) {
        if (l == 1 && (row % LTOT) < CTX) continue;
        float hv[16];
        {
            const u32x4 h0 = *(const u32x4*)(H2 + (size_t)row * DM + 16 * lane), h1 = *(const u32x4*)(H2 + (size_t)row * DM + 16 * lane + 8);
#pragma unroll
            for (int j = 0; j < 4; ++j) { hv[2 * j] = __uint_as_float(h0[j] << 16); hv[2 * j + 1] = __uint_as_float(h0[j] & 0xFFFF0000u); hv[8 + 2 * j] = __uint_as_float(h1[j] << 16); hv[9 + 2 * j] = __uint_as_float(h1[j] & 0xFFFF0000u); }
        }
        float hinv; u32x4 hq8[8];
        {
            float am = 0.f;
#pragma unroll
            for (int j = 0; j < 16; ++j) am = fmaxf(am, fabsf(hv[j]));
#pragma unroll
            for (int o = 32; o > 0; o >>= 1) am = fmaxf(am, __shfl_xor(am, o, 64));
            const float hs = am > 0.f ? 127.f / am : 1.f;
            hinv = am * (1.f / 127.f);
            u32x4 hq;
#pragma unroll
            for (int j = 0; j < 4; ++j)
                hq[j] = ((unsigned)__float2int_rn(hv[4 * j] * hs) & 0xFFu) | (((unsigned)__float2int_rn(hv[4 * j + 1] * hs) & 0xFFu) << 8) | (((unsigned)__float2int_rn(hv[4 * j + 2] * hs) & 0xFFu) << 16) | (((unsigned)__float2int_rn(hv[4 * j + 3] * hs) & 0xFFu) << 24);
            *(u32x4*)(h8s + 16 * lane) = hq;
#pragma unroll
            for (int sp = 0; sp < 8; ++sp) hq8[sp] = *(const u32x4*)(h8s + 16 * (lane & 7) + 128 * sp);
        }
        const int e0 = IDX[(size_t)row * 128 + lane], e1 = IDX[(size_t)row * 128 + 64 + lane];
        {
            const int r8 = lane >> 3, c8 = lane & 7;
            u32x4 wa[8], wb[8];
            int ea, eb;
#define ZLOAD(W, E, bt) { E = IDX[(size_t)row * 128 + 8 * (bt) + r8]; const unsigned char* ub_ = TU + (size_t)E * 1024 + 16 * c8; \
                _Pragma("unroll") for (int sp = 0; sp < 8; ++sp) W[sp] = *(const u32x4*)(ub_ + 128 * sp); }
#define ZCOMP(W, E, bt) { int a_ = 0; \
                _Pragma("unroll") for (int sp = 0; sp < 8; ++sp) _Pragma("unroll") for (int j = 0; j < 4; ++j) a_ = __builtin_amdgcn_sdot4((int)W[sp][j], (int)hq8[sp][j], a_, false); \
                float p_ = (float)a_; p_ += __shfl_xor(p_, 1, 64); p_ += __shfl_xor(p_, 2, 64); p_ += __shfl_xor(p_, 4, 64); \
                if (c8 == 0) { const int k_ = 8 * (bt) + r8; coef[k_] = gelu_tanh(p_ * SU[E] * hinv) * GATE[(size_t)row * 128 + k_] * SV[E]; } }
            ZLOAD(wa, ea, 0)
#pragma unroll 1
            for (int bt = 0; bt < 16; bt += 2) {
                ZLOAD(wb, eb, bt + 1)
                ZCOMP(wa, ea, bt)
                if (bt + 2 < 16) ZLOAD(wa, ea, bt + 2)
                ZCOMP(wb, eb, bt + 1)
            }
#undef ZLOAD
#undef ZCOMP
        }
        u32x4 rr[16];
#define LOAD8(T, bt) { _Pragma("unroll") for (int i = 0; i < 16; ++i) { const int k = (bt) * 16 + i; const int e = __builtin_amdgcn_readlane(k < 64 ? e0 : e1, k & 63); \
            rr[i] = *(const u32x4*)((T) + (size_t)e * 1024 + 16 * lane); } }
        float acc[16], csum = 0.f;
#pragma unroll
        for (int j = 0; j < 16; ++j) acc[j] = 0.f;
        for (int bt = 0; bt < 8; ++bt) {
            LOAD8(TV, bt)
#pragma unroll
            for (int i = 0; i < 16; ++i) {
                const float c = coef[bt * 16 + i];
                csum += c;
#pragma unroll
                for (int j = 0; j < 4; ++j) {
                    const unsigned w = rr[i][j];
                    acc[4 * j] += c * (float)(w & 0xFFu); acc[4 * j + 1] += c * (float)((w >> 8) & 0xFFu); acc[4 * j + 2] += c * (float)((w >> 16) & 0xFFu); acc[4 * j + 3] += c * (float)(w >> 24);
                }
            }
        }
#undef LOAD8
#pragma unroll
        for (int j = 0; j < 16; ++j) acc[j] -= 128.f * csum;
        const float* mod = MOD + (size_t)(l * 5 + modrow(row)) * 6144;
        const int d0 = 16 * lane;
        float v[16]; float s = 0.f;
#pragma unroll
        for (int j = 0; j < 4; ++j) {
            const f32x4 x = *(const f32x4*)(XS + (size_t)row * DM + d0 + 4 * j), g = *(const f32x4*)(mod + 5120 + d0 + 4 * j);
#pragma unroll
            for (int e = 0; e < 4; ++e) { v[4 * j + e] = ALPHA * x[e] + g[e] * acc[4 * j + e]; s += v[4 * j + e]; }
        }
        const float mean = wave_sum(s) * (1.f / 1024.f);
        float qq = 0.f;
#pragma unroll
        for (int j = 0; j < 16; ++j) { v[j] -= mean; qq += v[j] * v[j]; }
        const float rs = rsqrtf(wave_sum(qq) * (1.f / 1024.f) + 1e-5f);
        const float* mod1 = MOD + (size_t)(1 * 5 + modrow(row)) * 6144;
#pragma unroll
        for (int j = 0; j < 4; ++j) {
            const int d = d0 + 4 * j;
            const f32x4 gg = *(const f32x4*)(P.in[10] + l * 1024 + d), bb = *(const f32x4*)(P.in[11] + l * 1024 + d);
            f32x4 o;
#pragma unroll
            for (int e = 0; e < 4; ++e) o[e] = v[4 * j + e] * rs * gg[e] + bb[e];
            if (l == 0) {
                *(f32x4*)(XS + (size_t)row * DM + d) = o;
                const f32x4 sh = *(const f32x4*)(mod1 + d), sc = *(const f32x4*)(mod1 + 1024 + d);
                const unsigned w0 = f2bf(o[0] * (1.f + sc[0]) + sh[0]) | ((unsigned)f2bf(o[1] * (1.f + sc[1]) + sh[1]) << 16);
                const unsigned w1 = f2bf(o[2] * (1.f + sc[2]) + sh[2]) | ((unsigned)f2bf(o[3] * (1.f + sc[3]) + sh[3]) << 16);
                *(uint2*)(H + (size_t)row * DM + d) = make_uint2(w0, w1);
            } else {
                const int b = row / LTOT, t = row % LTOT - CTX;
                *(f32x4*)(P.out + ((size_t)b * SEQ + t) * DM + d) = o;
            }
        }
    }
}

#define OFF_SG (OFF_RW + (size_t)1088 * 8 * 8 * 1024 * 2)
__device__ __forceinline__ size_t rw_group(int b, int dir, int tau_base) {
    const int p = dir == 0 ? tau_base : (tau_base < CTX ? (CTX - 1 - tau_base) : (LTOT + CTX - 1 - tau_base));
    return (size_t)((b * LTOT + p) >> 4);
}
__device__ __forceinline__ float bfw(unsigned w, int half) { return __uint_as_float(half ? (w & 0xFFFF0000u) : (w << 16)); }
struct RwPrep { u32x4 lw0, lw1; uint2 r, k, kap, a; };
__device__ __forceinline__ void rwkv_prep_load(const bf16_t* RW, int b, int hd, int dir, int tau_base, int wave, int lane, RwPrep& R) {
    const bf16_t* base = RW + (rw_group(b, dir, tau_base) * 8 + hd) * 8192 + lane * 16;
    R.lw0 = *(const u32x4*)(base + (6 + dir) * 1024); R.lw1 = *(const u32x4*)(base + (6 + dir) * 1024 + 8);
    const int off = dir ? 12 - 4 * wave : 4 * wave;
    R.r = *(const uint2*)(base + off); R.k = *(const uint2*)(base + 1024 + off); R.kap = *(const uint2*)(base + 3 * 1024 + off); R.a = *(const uint2*)(base + (4 + dir) * 1024 + off);
}
__device__ __forceinline__ void rwkv_prep_finish(const RwPrep& R, unsigned char* buf, float ka, int wave, int lane, int dir) {
    bf16_t* KR = (bf16_t*)buf; bf16_t* BK = (bf16_t*)(buf + 4608); bf16_t* BbT = (bf16_t*)(buf + 9216); bf16_t* KbT = (bf16_t*)(buf + 11264); float* gT = (float*)(buf + 13312);
    float lwt[16];
#pragma unroll
    for (int i = 0; i < 4; ++i) { lwt[2 * i] = bfw(R.lw0[i], 0); lwt[2 * i + 1] = bfw(R.lw0[i], 1); lwt[8 + 2 * i] = bfw(R.lw1[i], 0); lwt[9 + 2 * i] = bfw(R.lw1[i], 1); }
    float cs[16];
    {
        float c = 0.f;
#pragma unroll
        for (int j = 0; j < 16; ++j) { c += dir ? lwt[15 - j] : lwt[j]; cs[j] = c; }
    }
    const float c15 = cs[15];
    if (wave == 0) gT[lane] = __expf(c15);
    float cpw[4], ctw[4];
#pragma unroll
    for (int tt = 0; tt < 4; ++tt) {
        cpw[tt] = wave == 0 ? (tt == 0 ? 0.f : cs[tt - 1 < 0 ? 0 : tt - 1]) : (wave == 1 ? cs[3 + tt] : (wave == 2 ? cs[7 + tt] : cs[11 + tt]));
        ctw[tt] = wave == 0 ? cs[tt] : (wave == 1 ? cs[4 + tt] : (wave == 2 ? cs[8 + tt] : cs[12 + tt]));
    }
    float rt[4], kt4[4], kp[4], at[4];
    rt[0] = bfw(R.r.x, 0); rt[1] = bfw(R.r.x, 1); rt[2] = bfw(R.r.y, 0); rt[3] = bfw(R.r.y, 1);
    kt4[0] = bfw(R.k.x, 0); kt4[1] = bfw(R.k.x, 1); kt4[2] = bfw(R.k.y, 0); kt4[3] = bfw(R.k.y, 1);
    kp[0] = bfw(R.kap.x, 0); kp[1] = bfw(R.kap.x, 1); kp[2] = bfw(R.kap.y, 0); kp[3] = bfw(R.kap.y, 1);
    at[0] = bfw(R.a.x, 0); at[1] = bfw(R.a.x, 1); at[2] = bfw(R.a.y, 0); at[3] = bfw(R.a.y, 1);
    bf16_t bb[4], kb[4];
#pragma unroll
    for (int tt = 0; tt < 4; ++tt) {
        const int t = 4 * wave + tt;
        const float r = dir ? rt[3 - tt] : rt[tt], k = dir ? kt4[3 - tt] : kt4[tt], kap = dir ? kp[3 - tt] : kp[tt], a = dir ? at[3 - tt] : at[tt];
        const float ep = __expf(cpw[tt]), et = __expf(ctw[tt]), em = __expf(-ctw[tt]), eT = __expf(c15 - ctw[tt]);
        const float beta = kap * a, kt = k * (1.f + (a - 1.f) * ka);
        KR[t * 72 + lane] = f2bf(kap * ep); KR[(16 + t) * 72 + lane] = f2bf(r * et);
        BK[t * 72 + lane] = f2bf(beta * em); BK[(16 + t) * 72 + lane] = f2bf(kt * em);
        bb[tt] = f2bf(beta * eT); kb[tt] = f2bf(kt * eT);
    }
    uint2 pb, pk;
    pb.x = bb[0] | ((unsigned)bb[1] << 16); pb.y = bb[2] | ((unsigned)bb[3] << 16);
    pk.x = kb[0] | ((unsigned)kb[1] << 16); pk.y = kb[2] | ((unsigned)kb[3] << 16);
    *(uint2*)(BbT + lane * 16 + 4 * wave) = pb;
    *(uint2*)(KbT + lane * 16 + 4 * wave) = pk;
}
template <int NV>
__device__ __forceinline__ void rwkv_vt_load(const bf16_t* RW, int b, int hd, int dir, int tau_base, int vbase, int lane, u32x4& x) {
    const bf16_t* base = RW + (rw_group(b, dir, tau_base) * 8 + hd) * 8192 + 2 * 1024;
    if (NV == 2) {
        const int vl = lane & 31, th = lane >> 5;
        x = *(const u32x4*)(base + (vbase + vl) * 16 + (dir ? 8 - 8 * th : 8 * th));
    } else {
        const int vl = lane & 15, tq = lane >> 4;
        const uint2 y = *(const uint2*)(base + (vbase + vl) * 16 + (dir ? 12 - 4 * tq : 4 * tq));
        x[0] = y.x; x[1] = y.y; x[2] = 0u; x[3] = 0u;
    }
}
__device__ __forceinline__ unsigned swap16(unsigned w) { return (w >> 16) | (w << 16); }
template <int NV>
__device__ __forceinline__ void rwkv_vt_store(const u32x4& x, bf16_t* VT, int lane, int dir) {
    if (NV == 2) {
        const int vl = lane & 31, th = lane >> 5;
        u32x4 pk;
        if (dir) { pk[0] = swap16(x[3]); pk[1] = swap16(x[2]); pk[2] = swap16(x[1]); pk[3] = swap16(x[0]); } else pk = x;
        *(u32x4*)(VT + vl * 16 + th * 8) = pk;
    } else {
        const int vl = lane & 15, tq = lane >> 4;
        uint2 pk;
        if (dir) { pk.x = swap16(x[1]); pk.y = swap16(x[0]); } else { pk.x = x[0]; pk.y = x[1]; }
        *(uint2*)(VT + vl * 16 + tq * 4) = pk;
    }
}
template <int NV, bool HASV, bool OUT>
__device__ __forceinline__ void rwkv_mfma_step(f32x4 (&X)[4][NV], const unsigned char* buf, const bf16_t* VT, f32x4 (&Yout)[NV], int lane) {
    const bf16_t* KR = (const bf16_t*)buf; const bf16_t* BK = (const bf16_t*)(buf + 4608); const bf16_t* BbT = (const bf16_t*)(buf + 9216); const bf16_t* KbT = (const bf16_t*)(buf + 11264); const float* gT = (const float*)(buf + 13312);
    const int fr = lane & 15, fq = lane >> 4;
    const f32x4 z4 = {0.f, 0.f, 0.f, 0.f};
    f32x4 cA = z4, cN = z4, cAk = z4, cRb = z4, cRk = z4;
#pragma unroll
    for (int ks = 0; ks < 2; ++ks) {
        const bf16x8 kh = *(const bf16x8*)(KR + fr * 72 + 32 * ks + 8 * fq), rh = *(const bf16x8*)(KR + (16 + fr) * 72 + 32 * ks + 8 * fq);
        const bf16x8 bc = *(const bf16x8*)(BK + fr * 72 + 32 * ks + 8 * fq), kc = *(const bf16x8*)(BK + (16 + fr) * 72 + 32 * ks + 8 * fq);
        cA = mfma32(kh, bc, cA); cN = mfma32(bc, kh, cN); cAk = mfma32(kc, kh, cAk);
        if (OUT) { cRb = mfma32(bc, rh, cRb); cRk = mfma32(kc, rh, cRk); }
    }
    f32x4 dg;
#pragma unroll
    for (int r = 0; r < 4; ++r) {
        const int row = 4 * fq + r;
        dg[r] = (row == fr) ? 1.f : 0.f;
        cA[r] = (fr < row) ? cA[r] : 0.f;
        cN[r] = (row < fr) ? cN[r] : 0.f;
        cAk[r] = (row < fr) ? cAk[r] : 0.f;
        cRb[r] = (row <= fr) ? cRb[r] : 0.f;
        cRk[r] = (row <= fr) ? cRk[r] : 0.f;
    }
    const bf16x4 a4 = to4(cA), n4 = to4(cN);
    const f32x4 cA2 = mfma16(n4, a4, z4), cN2 = mfma16(a4, n4, z4);
    const bf16x4 a24 = to4(cA2), n24 = to4(cN2);
    const f32x4 cA4 = mfma16(n24, a24, z4), cN4 = mfma16(a24, n24, z4);
    const f32x4 cA8 = mfma16(to4(cN4), to4(cA4), z4);
    const f32x4 T1 = mfma16(to4(dg - cA), to4(dg + cN2), z4);
    const f32x4 T2 = mfma16(to4(dg + cA4), to4(T1), z4);
    const f32x4 WT = mfma16(to4(dg + cA8), to4(T2), z4);
    const bf16x4 wt4 = to4(WT), aak4 = to4(cAk), rab4 = to4(cRb), rak4 = to4(cRk);
    bf16x8 aK[2], aR[2];
#pragma unroll
    for (int ks = 0; ks < 2; ++ks) {
        aK[ks] = cat8(*(const bf16x4*)(KR + fr * 72 + 32 * ks + 4 * fq), *(const bf16x4*)(KR + fr * 72 + 32 * ks + 16 + 4 * fq));
        if (OUT) aR[ks] = cat8(*(const bf16x4*)(KR + (16 + fr) * 72 + 32 * ks + 4 * fq), *(const bf16x4*)(KR + (16 + fr) * 72 + 32 * ks + 16 + 4 * fq));
    }
    bf16x4 u4[NV], vt4[NV];
#pragma unroll
    for (int nj = 0; nj < NV; ++nj) {
        const bf16x8 b0 = cat8(to4(X[0][nj]), to4(X[1][nj])), b1 = cat8(to4(X[2][nj]), to4(X[3][nj]));
        f32x4 G = mfma32(aK[1], b1, mfma32(aK[0], b0, z4));
        if (HASV) { vt4[nj] = *(const bf16x4*)(VT + (16 * nj + fr) * 16 + 4 * fq); G = mfma16(aak4, vt4[nj], G); }
        const f32x4 U = mfma16(wt4, to4(G), z4);
        u4[nj] = to4(-U);
        if (OUT) {
            f32x4 Yv = mfma32(aR[1], b1, mfma32(aR[0], b0, z4));
            Yv = mfma16(rab4, u4[nj], Yv);
            if (HASV) Yv = mfma16(rak4, vt4[nj], Yv);
            Yout[nj] = Yv;
        }
    }
#pragma unroll
    for (int mi = 0; mi < 4; ++mi) {
        const f32x4 g4 = *(const f32x4*)(gT + 16 * mi + 4 * fq);
        const bf16x4 bb4 = *(const bf16x4*)(BbT + (16 * mi + fr) * 16 + 4 * fq), kb4 = *(const bf16x4*)(KbT + (16 * mi + fr) * 16 + 4 * fq);
#pragma unroll
        for (int nj = 0; nj < NV; ++nj) {
            f32x4 x = X[mi][nj] * g4;
            x = mfma16(bb4, u4[nj], x);
            if (HASV) x = mfma16(kb4, vt4[nj], x);
            X[mi][nj] = x;
        }
    }
}
__device__ __forceinline__ void rwkv_passA(const Params& P, int l, unsigned char* smem, int bid, int nb) {
    const int lane = otid() & 63, wave = __builtin_amdgcn_readfirstlane(otid() >> 6), fr = lane & 15, fq = lane >> 4;
    const bf16_t* RW = (const bf16_t*)(P.ws + OFF_RW);
    float* RXL = (float*)(P.ws + OFF_RXL);
    bf16_t* RXP = (bf16_t*)P.out;
    for (int item = bid; item < 64 * RW_NCH; item += nb) {
        const int seq = item / RW_NCH, c = item % RW_NCH, dir = seq & 1, hd = (seq >> 1) & 7, b = seq >> 4;
        const float ka = P.in[31][l * 512 + hd * 64 + lane];
        const int tau0 = c * 128;
        f32x4 X[4][2], Yd[2];
#pragma unroll
        for (int mi = 0; mi < 4; ++mi)
#pragma unroll
            for (int nj = 0; nj < 2; ++nj)
#pragma unroll
                for (int r = 0; r < 4; ++r) X[mi][nj][r] = (wave >= 2 && (16 * mi + 4 * fq + r) == (16 * (2 * (wave - 2) + nj) + fr)) ? 1.f : 0.f;
        bf16_t* VTw = (bf16_t*)(smem + RW_VT0 + wave * 2048);
        RwPrep R; u32x4 vx;
        rwkv_prep_load(RW, b, hd, dir, tau0, wave, lane, R);
        if (wave < 2) rwkv_vt_load<2>(RW, b, hd, dir, tau0, 32 * wave, lane, vx);
        rwkv_prep_finish(R, smem, ka, wave, lane, dir);
        if (wave < 2) rwkv_vt_store<2>(vx, VTw, lane, dir);
        __syncthreads();
        for (int s = 0; s < 8; ++s) {
            if (s < 7) rwkv_prep_load(RW, b, hd, dir, tau0 + (s + 1) * 16, wave, lane, R);
            if (wave < 2) rwkv_mfma_step<2, true, false>(X, smem + (s & 1) * RW_BUF, VTw + (s & 1) * 512, Yd, lane);
            else rwkv_mfma_step<2, false, false>(X, smem + (s & 1) * RW_BUF, VTw, Yd, lane);
            if (s < 7) {
                if (wave < 2) rwkv_vt_load<2>(RW, b, hd, dir, tau0 + (s + 1) * 16, 32 * wave, lane, vx);
                rwkv_prep_finish(R, smem + ((s + 1) & 1) * RW_BUF, ka, wave, lane, dir);
                if (wave < 2) rwkv_vt_store<2>(vx, VTw + ((s + 1) & 1) * 512, lane, dir);
            }
            __syncthreads();
        }
        if (wave < 2) {
#pragma unroll
            for (int mi = 0; mi < 4; ++mi)
#pragma unroll
                for (int nj = 0; nj < 2; ++nj) *(f32x4*)(RXL + (((size_t)item * 16 + mi * 4 + 2 * wave + nj) * 64 + lane) * 4) = X[mi][nj];
        } else {
#pragma unroll
            for (int mi = 0; mi < 4; ++mi)
#pragma unroll
                for (int nj = 0; nj < 2; ++nj)
#pragma unroll
                    for (int r = 0; r < 4; ++r) RXP[(size_t)item * 4096 + (16 * mi + 4 * fq + r) * 64 + 16 * (2 * (wave - 2) + nj) + fr] = f2bf(X[mi][nj][r]);
        }
    }
}
__device__ __forceinline__ void rwkv_passB(const Params& P, int bid, int nb) {
    const int lane = otid() & 63, wave = __builtin_amdgcn_readfirstlane(otid() >> 6), fr = lane & 15, fq = lane >> 4;
    float* RXL = (float*)(P.ws + OFF_RXL);
    const bf16_t* RXP = (const bf16_t*)P.out;
    for (int it = bid * 4 + wave; it < 256; it += nb * 4) {
        const int seq = it >> 2, nj = it & 3;
        f32x4 X[4];
#pragma unroll
        for (int mi = 0; mi < 4; ++mi) X[mi] = (f32x4){0.f, 0.f, 0.f, 0.f};
        f32x4 L[4], Ln[4]; bf16x8 a[4][2], an[4][2];
#define PB_LOAD(LL, AA, cc) { const size_t item_ = (size_t)seq * RW_NCH + (cc); _Pragma("unroll") for (int mi = 0; mi < 4; ++mi) { \
            LL[mi] = *(const f32x4*)(RXL + ((item_ * 16 + mi * 4 + nj) * 64 + lane) * 4); \
            const bf16_t* xp = RXP + item_ * 4096 + (16 * mi + fr) * 64; \
            _Pragma("unroll") for (int ks = 0; ks < 2; ++ks) AA[mi][ks] = cat8(*(const bf16x4*)(xp + 32 * ks + 4 * fq), *(const bf16x4*)(xp + 32 * ks + 16 + 4 * fq)); } }
        PB_LOAD(L, a, 0)
        for (int c = 0; c < RW_NCH; ++c) {
            const size_t item = (size_t)seq * RW_NCH + c;
            if (c + 1 < RW_NCH) PB_LOAD(Ln, an, c + 1)
            const bf16x8 b0 = cat8(to4(X[0]), to4(X[1])), b1 = cat8(to4(X[2]), to4(X[3]));
#pragma unroll
            for (int mi = 0; mi < 4; ++mi) {
                *(f32x4*)(RXL + ((item * 16 + mi * 4 + nj) * 64 + lane) * 4) = X[mi];
                X[mi] = mfma32(a[mi][1], b1, mfma32(a[mi][0], b0, L[mi]));
            }
#pragma unroll
            for (int mi = 0; mi < 4; ++mi) { L[mi] = Ln[mi]; a[mi][0] = an[mi][0]; a[mi][1] = an[mi][1]; }
        }
#undef PB_LOAD
    }
}
template <bool CHECK>
__device__ __forceinline__ void rwkv_passC(const Params& P, int l, unsigned char* smem, int bid, int nb, int mode = 0) {
    const int lane = otid() & 63, wave = __builtin_amdgcn_readfirstlane(otid() >> 6), fr = lane & 15, fq = lane >> 4;
    const bf16_t* RW = (const bf16_t*)(P.ws + OFF_RW);
    const float* RXL = (const float*)(P.ws + OFF_RXL);
    for (int item = bid; item < 64 * RW_NCH; item += nb) {
        const int seq = item / RW_NCH, c = item % RW_NCH, dir = seq & 1, hd = (seq >> 1) & 7, b = seq >> 4;
        if (l == 1 && dir == 0 && c < 2) continue;
        if (l == 1 && dir == 1 && c < 2) continue;
        bf16_t* YP = (bf16_t*)(P.ws + OFF_YP) + (size_t)dir * MROWS * DM;
        const float ka = P.in[31][l * 512 + hd * 64 + lane];
        const int tau0 = c * 128;
        f32x4 X[4][1], Yo[1];
#pragma unroll
        for (int mi = 0; mi < 4; ++mi) X[mi][0] = *(const f32x4*)(RXL + (((size_t)item * 16 + mi * 4 + wave) * 64 + lane) * 4);
        bf16_t* VTw = (bf16_t*)(smem + RW_VT0 + wave * 2048);
        RwPrep R; u32x4 vx;
        rwkv_prep_load(RW, b, hd, dir, tau0, wave, lane, R);
        rwkv_vt_load<1>(RW, b, hd, dir, tau0, 16 * wave, lane, vx);
        rwkv_prep_finish(R, smem, ka, wave, lane, dir);
        rwkv_vt_store<1>(vx, VTw, lane, dir);
        __syncthreads();
        for (int s = 0; s < 8; ++s) {
            if (s < 7 && mode != 2) {
                rwkv_prep_load(RW, b, hd, dir, tau0 + (s + 1) * 16, wave, lane, R);
                rwkv_vt_load<1>(RW, b, hd, dir, tau0 + (s + 1) * 16, 16 * wave, lane, vx);
            }
            if (mode != 1) rwkv_mfma_step<1, true, true>(X, smem + (s & 1) * RW_BUF, VTw + (s & 1) * 512, Yo, lane);
            if (s < 7 && mode != 2) {
                rwkv_prep_finish(R, smem + ((s + 1) & 1) * RW_BUF, ka, wave, lane, dir);
                rwkv_vt_store<1>(vx, VTw + ((s + 1) & 1) * 512, lane, dir);
            }
#pragma unroll
            for (int r = 0; r < 4; ++r) {
                const int row = row_of(b, dir, tau0 + s * 16 + 4 * fq + r);
                if (mode) {} else if (CHECK) { if (YP[(size_t)row * DM + 512 + hd * 64 + 16 * wave + fr] != f2bf(Yo[0][r])) atomicAdd((unsigned*)(P.ws + OFF_BAR + 15360), 1u); }
                else YP[(size_t)row * DM + 512 + hd * 64 + 16 * wave + fr] = f2bf(Yo[0][r]);
            }
            __syncthreads();
        }
    }
}


#define HG_NCH 34
#define HG_BUF 7168
#define HG_VT0 14336
#define OFF_O_RXP 0ull
#define OFF_O_HXL ((size_t)2176 * 8192)
#define OFF_O_HD (OFF_O_HXL + (size_t)1088 * 8192)
struct HgPrep { u32x4 lf0, lf1; uint2 q, v; };
__device__ __forceinline__ void hgrn_prep_load(const bf16_t* HGT, int b, int hd, int dir, int tau_base, int vbase, int wave, int lane, HgPrep& R) {
    const bf16_t* base = HGT + (rw_group(b, dir, tau_base) * 4 + hd) * 4096;
    R.lf0 = *(const u32x4*)(base + (2 + dir) * 1024 + lane * 16); R.lf1 = *(const u32x4*)(base + (2 + dir) * 1024 + lane * 16 + 8);
    R.q = *(const uint2*)(base + lane * 16 + (dir ? 12 - 4 * wave : 4 * wave));
    const int vl = lane & 15, tq = lane >> 4;
    R.v = *(const uint2*)(base + 1024 + (vbase + vl) * 16 + (dir ? 12 - 4 * tq : 4 * tq));
}
__device__ __forceinline__ float hgrn_prep_finish(const HgPrep& R, unsigned char* buf, bf16_t* VT, int wave, int lane, int dir) {
    bf16_t* QH = (bf16_t*)buf; bf16_t* KC = (bf16_t*)(buf + 2304); bf16_t* KbT = (bf16_t*)(buf + 4608); float* gT = (float*)(buf + 6656);
    float lft_[16];
#pragma unroll
    for (int i = 0; i < 4; ++i) { lft_[2 * i] = bfw(R.lf0[i], 0); lft_[2 * i + 1] = bfw(R.lf0[i], 1); lft_[8 + 2 * i] = bfw(R.lf1[i], 0); lft_[9 + 2 * i] = bfw(R.lf1[i], 1); }
    float cs[16], ls[16];
    {
        float c = 0.f;
#pragma unroll
        for (int j = 0; j < 16; ++j) { ls[j] = dir ? lft_[15 - j] : lft_[j]; c += ls[j]; cs[j] = c; }
    }
    const float c15 = cs[15];
    if (wave == 0) gT[lane] = __expf(c15);
    float qt[4];
    qt[0] = bfw(R.q.x, 0); qt[1] = bfw(R.q.x, 1); qt[2] = bfw(R.q.y, 0); qt[3] = bfw(R.q.y, 1);
    bf16_t kb[4];
#pragma unroll
    for (int tt = 0; tt < 4; ++tt) {
        const int t = 4 * wave + tt;
        const float ct = wave == 0 ? cs[tt] : (wave == 1 ? cs[4 + tt] : (wave == 2 ? cs[8 + tt] : cs[12 + tt]));
        const float lft = wave == 0 ? ls[tt] : (wave == 1 ? ls[4 + tt] : (wave == 2 ? ls[8 + tt] : ls[12 + tt]));
        const float k = 1.f - __expf(lft);
        const float q = dir ? qt[3 - tt] : qt[tt];
        QH[t * 72 + lane] = f2bf(q * __expf(ct));
        KC[t * 72 + lane] = f2bf(k * __expf(fminf(-ct, 80.f)));
        kb[tt] = f2bf(k * __expf(c15 - ct));
    }
    uint2 pk; pk.x = kb[0] | ((unsigned)kb[1] << 16); pk.y = kb[2] | ((unsigned)kb[3] << 16);
    *(uint2*)(KbT + lane * 16 + 4 * wave) = pk;
    {
        const int vl = lane & 15, tq = lane >> 4;
        uint2 pv;
        if (dir) { pv.x = swap16(R.v.y); pv.y = swap16(R.v.x); } else pv = R.v;
        *(uint2*)(VT + vl * 16 + tq * 4) = pv;
    }
    return c15;
}
template <bool OUT>
__device__ __forceinline__ void hgrn_mfma_step(f32x4 (&X)[4], const unsigned char* buf, const bf16_t* VT, f32x4& Yout, int lane) {
    const bf16_t* QH = (const bf16_t*)buf; const bf16_t* KC = (const bf16_t*)(buf + 2304); const bf16_t* KbT = (const bf16_t*)(buf + 4608); const float* gT = (const float*)(buf + 6656);
    const int fr = lane & 15, fq = lane >> 4;
    const f32x4 z4 = {0.f, 0.f, 0.f, 0.f};
    const bf16x4 vt4 = *(const bf16x4*)(VT + fr * 16 + 4 * fq);
    if (OUT) {
        f32x4 cAT = z4;
#pragma unroll
        for (int ks = 0; ks < 2; ++ks) {
            const bf16x8 kc = *(const bf16x8*)(KC + fr * 72 + 32 * ks + 8 * fq), qh = *(const bf16x8*)(QH + fr * 72 + 32 * ks + 8 * fq);
            cAT = mfma32(kc, qh, cAT);
        }
#pragma unroll
        for (int r = 0; r < 4; ++r) cAT[r] = ((4 * fq + r) <= fr) ? cAT[r] : 0.f;
        const bf16x8 aQ0 = cat8(*(const bf16x4*)(QH + fr * 72 + 4 * fq), *(const bf16x4*)(QH + fr * 72 + 16 + 4 * fq));
        const bf16x8 aQ1 = cat8(*(const bf16x4*)(QH + fr * 72 + 32 + 4 * fq), *(const bf16x4*)(QH + fr * 72 + 48 + 4 * fq));
        const bf16x8 b0 = cat8(to4(X[0]), to4(X[1])), b1 = cat8(to4(X[2]), to4(X[3]));
        f32x4 O = mfma32(aQ1, b1, mfma32(aQ0, b0, z4));
        Yout = mfma16(to4(cAT), vt4, O);
    }
#pragma unroll
    for (int mi = 0; mi < 4; ++mi) {
        const f32x4 g4 = *(const f32x4*)(gT + 16 * mi + 4 * fq);
        const bf16x4 kb4 = *(const bf16x4*)(KbT + (16 * mi + fr) * 16 + 4 * fq);
        X[mi] = mfma16(kb4, vt4, X[mi] * g4);
    }
}
__device__ __forceinline__ float hgrn_lb(const Params& P, int l, int dir, int ch) {
    if (l == 0) return 0.f;
    const float a0 = P.in[22][(dir * 2 + 0) * 256 + ch], a1 = P.in[22][(dir * 2 + 1) * 256 + ch];
    const float m = fmaxf(a0, a1), e0 = __expf(a0 - m), e1 = __expf(a1 - m);
    return e1 / (e0 + e1);
}
template <bool OUT>
__device__ __forceinline__ void hgrn_pass(const Params& P, int l, unsigned char* smem, int bid, int nb) {
    const int lane = otid() & 63, wave = __builtin_amdgcn_readfirstlane(otid() >> 6), fr = lane & 15, fq = lane >> 4;
    const bf16_t* Pb = (const bf16_t*)((unsigned char*)P.out + OFF_O_HGT);
    bf16_t* HXL = (bf16_t*)((unsigned char*)P.out + OFF_O_HXL);
    float* HD = (float*)((unsigned char*)P.out + OFF_O_HD);
    for (int item = bid; item < 32 * HG_NCH; item += nb) {
        const int seq = item / HG_NCH, c = item % HG_NCH, dir = seq & 1, hd = (seq >> 1) & 3, b = seq >> 3;
        if (OUT && l == 1 && c < 2) continue;
        bf16_t* YP = (bf16_t*)(P.ws + OFF_YP) + (size_t)dir * MROWS * DM;
        const int tau0 = c * 128;
        f32x4 X[4], Yo;
#pragma unroll
        for (int mi = 0; mi < 4; ++mi) { if (OUT) { const uint2 w = *(const uint2*)(HXL + (((size_t)item * 16 + mi * 4 + wave) * 64 + lane) * 4); X[mi] = (f32x4){bfw(w.x, 0), bfw(w.x, 1), bfw(w.y, 0), bfw(w.y, 1)}; } else X[mi] = (f32x4){0.f, 0.f, 0.f, 0.f}; }
        bf16_t* VTw = (bf16_t*)(smem + HG_VT0 + wave * 1024);
        HgPrep R;
        hgrn_prep_load(Pb, b, hd, dir, tau0, 16 * wave, wave, lane, R);
        float ctot = hgrn_prep_finish(R, smem, VTw, wave, lane, dir);
        __syncthreads();
        for (int s = 0; s < 8; ++s) {
            if (s < 7) hgrn_prep_load(Pb, b, hd, dir, tau0 + (s + 1) * 16, 16 * wave, wave, lane, R);
            hgrn_mfma_step<OUT>(X, smem + (s & 1) * HG_BUF, VTw + (s & 1) * 256, Yo, lane);
            if (s < 7) ctot += hgrn_prep_finish(R, smem + ((s + 1) & 1) * HG_BUF, VTw + ((s + 1) & 1) * 256, wave, lane, dir);
            if (OUT) {
#pragma unroll
                for (int r = 0; r < 4; ++r) {
                    const int row = row_of(b, dir, tau0 + s * 16 + 4 * fq + r);
                    YP[(size_t)row * DM + 256 + hd * 64 + 16 * wave + fr] = f2bf(Yo[r]);
                }
            }
            __syncthreads();
        }
        if (!OUT) {
#pragma unroll
            for (int mi = 0; mi < 4; ++mi) *(uint2*)(HXL + (((size_t)item * 16 + mi * 4 + wave) * 64 + lane) * 4) = make_uint2(pk2bf(X[mi][0], X[mi][1]), pk2bf(X[mi][2], X[mi][3]));
            if (wave == 0) HD[(size_t)item * 64 + lane] = __expf(ctot);
        }
    }
}
__device__ __forceinline__ void hgrn_carry(const Params& P, int bid, int nb) {
    bf16_t* HXL = (bf16_t*)((unsigned char*)P.out + OFF_O_HXL);
    const float* HD = (const float*)((unsigned char*)P.out + OFF_O_HD);
    for (int u = bid; u < 128; u += nb) {
        const int gid = u * 256 + otid(), ln = gid & 63, tile = (gid >> 6) & 15, seq = gid >> 10;
        const int mi = tile >> 2, fq = ln >> 4;
        f32x4 x = {0.f, 0.f, 0.f, 0.f};
        for (int c0 = 0; c0 < HG_NCH; c0 += 17) {
            uint2 L[17];
#pragma unroll
            for (int i = 0; i < 17; ++i) {
                const size_t item = (size_t)seq * HG_NCH + c0 + i;
                L[i] = *(const uint2*)(HXL + ((item * 16 + tile) * 64 + ln) * 4);
            }
#pragma unroll
            for (int i = 0; i < 17; ++i) {
                const size_t item = (size_t)seq * HG_NCH + c0 + i;
                const f32x4 D = *(const f32x4*)(HD + item * 64 + 16 * mi + 4 * fq);
                *(uint2*)(HXL + ((item * 16 + tile) * 64 + ln) * 4) = make_uint2(pk2bf(x[0], x[1]), pk2bf(x[2], x[3]));
                x = D * x + (f32x4){bfw(L[i].x, 0), bfw(L[i].x, 1), bfw(L[i].y, 0), bfw(L[i].y, 1)};
            }
        }
    }
}


__device__ __forceinline__ void phase_rwprep2(const Params& P, int l, unsigned char* smem, int bid, int nb) {
    const int tid = otid(), lane = tid & 63, wave = __builtin_amdgcn_readfirstlane(tid >> 6), fr = lane & 15, fq = lane >> 4;
    const bf16_t* Pb = (const bf16_t*)(P.ws + OFF_P);
    bf16_t* RW = (bf16_t*)(P.ws + OFF_RW);
    bf16_t* SG = (bf16_t*)(P.ws + OFF_SG);
    const bf16_t* LW = (const bf16_t*)(P.ws + OFF_LW);
    const float* mu = P.in[24] + l * 1920;
    bf16_t* AL = (bf16_t*)smem;
    float muv[8];
#pragma unroll
    for (int jj = 0; jj < 8; ++jj) muv[jj] = (tid + 256 * jj) < 1920 ? mu[tid + 256 * jj] : 0.f;
    const float kk0 = P.in[30][l * 512 + tid], kk1 = P.in[30][l * 512 + 256 + tid];
    for (int u = bid; u < MROWS / 16; u += nb) {
        const int r0 = u * 16;
        __syncthreads();
#pragma unroll 1
        for (int it = 0; it < 4; ++it) {
            bf16_t pv[4][8], nv[4][8]; bool ok[4];
#pragma unroll
            for (int tt = 0; tt < 4; ++tt) {
                const int row_ = r0 + 4 * it + tt, p_ = row_ % LTOT; int nbr_;
                {
                    const int m = tid & 3;
                    if (p_ < CTX) { nbr_ = (m & 1) ? row_ + 1 : row_ - 1; ok[tt] = (m & 1) ? (p_ < CTX - 1) : (p_ > 0); }
                    else {
                        const int t_ = p_ - CTX, gr = t_ >> 6, gc = t_ & 63;
                        nbr_ = m == 0 ? row_ - 1 : (m == 1 ? row_ + 1 : (m == 2 ? row_ - 64 : row_ + 64));
                        ok[tt] = m == 0 ? (gc > 0) : (m == 1 ? (gc < 63) : (m == 2 ? (gr > 0) : (gr < 63)));
                    }
                }
                if (!ok[tt]) nbr_ = row_;
                const bf16_t* pp_ = Pb + (size_t)row_ * PIN + 1536 + tid; const bf16_t* pn_ = Pb + (size_t)nbr_ * PIN + 1536 + tid;
#pragma unroll
                for (int jj = 0; jj < 8; ++jj) { if (jj < 7 || tid < 128) { pv[tt][jj] = pp_[256 * jj]; nv[tt][jj] = pn_[256 * jj]; } else { pv[tt][jj] = 0; nv[tt][jj] = 0; } }
            }
            float q8[8][4];
#pragma unroll
            for (int tt = 0; tt < 4; ++tt) {
                const int i = 4 * it + tt, row = r0 + i;
                float sv[8];
#pragma unroll
                for (int jj = 0; jj < 8; ++jj) {
                    const float pvf = bf2f(pv[tt][jj]);
                    const float nvf = ok[tt] ? bf2f(nv[tt][jj]) : 0.f;
                    sv[jj] = pvf + muv[jj] * (nvf - pvf);
                }
                const float a0 = sv[2] * kk0, a1 = sv[3] * kk1;
                const float n0 = fmaxf(sqrtf(wave_sum(a0 * a0)), 1e-12f), n1 = fmaxf(sqrtf(wave_sum(a1 * a1)), 1e-12f);
                q8[0][tt] = sv[0]; q8[1][tt] = sv[1]; q8[2][tt] = sv[2]; q8[3][tt] = sv[3]; q8[4][tt] = sv[4]; q8[5][tt] = sv[5]; q8[6][tt] = a0 / n0; q8[7][tt] = a1 / n1;
                if (tid < 128) { SG[(size_t)row * 128 + tid] = f2bf(sigmoidf_(sv[6])); AL[((2 + (tid >> 6)) * 16 + i) * 72 + (tid & 63)] = f2bf(sv[7]); }
                else AL[(((tid - 128) >> 6) * 16 + i) * 72 + (tid & 63)] = f2bf(tanhf(sv[6]));
            }
#pragma unroll
            for (int q = 0; q < 8; ++q) {
                const int ch = tid + 256 * (q & 1), f = q >> 1;
                *(uint2*)(RW + (((size_t)u * 8 + (ch >> 6)) * 8 + f) * 1024 + (ch & 63) * 16 + 4 * it) = make_uint2(pk2bf(q8[q][0], q8[q][1]), pk2bf(q8[q][2], q8[q][3]));
            }
        }
        __syncthreads();
        {
            const int d = wave & 1, isA = wave >> 1;
            const bf16x8 a0 = *(const bf16x8*)(AL + (wave * 16 + fr) * 72 + 8 * fq), a1 = *(const bf16x8*)(AL + (wave * 16 + fr) * 72 + 32 + 8 * fq);
            const bf16_t* W = LW + (size_t)isA * 131072 + (size_t)(l * 2 + d) * 512 * 64;
            const float* bias = P.in[isA ? 27 : 25] + (l * 2 + d) * 512;
            const int fld = (isA ? 4 : 6) + d;
#pragma unroll 1
            for (int nj0 = 0; nj0 < 32; nj0 += 8) {
              bf16x8 bq0[8], bq1[8]; float bsq[8];
#pragma unroll
              for (int q = 0; q < 8; ++q) { bq0[q] = *(const bf16x8*)(W + (size_t)(16 * (nj0 + q) + fr) * 64 + 8 * fq); bq1[q] = *(const bf16x8*)(W + (size_t)(16 * (nj0 + q) + fr) * 64 + 32 + 8 * fq); bsq[q] = bias[16 * (nj0 + q) + fr]; }
#pragma unroll
              for (int q = 0; q < 8; ++q) {
                const int nj = nj0 + q;
                const f32x4 acc = mfma32(a1, bq1[q], mfma32(a0, bq0[q], (f32x4){0.f, 0.f, 0.f, 0.f}));
                const int c = 16 * nj + fr;
                const float bs = bsq[q];
                float o4[4];
#pragma unroll
                for (int r = 0; r < 4; ++r) { const float sg = sigmoidf_(bs + acc[r]); o4[r] = isA ? sg : -0.60653066f * sg; }
                *(uint2*)(RW + (((size_t)u * 8 + (c >> 6)) * 8 + fld) * 1024 + (c & 63) * 16 + 4 * fq) = make_uint2(pk2bf(o4[0], o4[1]), pk2bf(o4[2], o4[3]));
              }
            }
        }
    }
}
__device__ __forceinline__ void phase_post2(const Params& P, int l, int bid, int nb, int parts) {
    const int tid = otid(), lane = tid & 63, wave = __builtin_amdgcn_readfirstlane(tid >> 6), fr = lane & 15, fq = lane >> 4;
    const bf16_t* Pb = (const bf16_t*)(P.ws + OFF_P);
    const bf16_t* RW = (const bf16_t*)(P.ws + OFF_RW);
    const bf16_t* YF = (const bf16_t*)(P.ws + OFF_YP);
    const bf16_t* YB = YF + (size_t)MROWS * DM;
    const bf16_t* LW = (const bf16_t*)(P.ws + OFF_LW);
    const bf16_t* SG = (const bf16_t*)(P.ws + OFF_SG);
    bf16_t* MIX = (bf16_t*)(P.ws + OFF_MIX);
    const f32x4 z4 = {0.f, 0.f, 0.f, 0.f};
    for (int u = bid; u < MROWS / 16; u += nb) {
        const int r0 = u * 16;
        if (l == 1 && (r0 % LTOT) < CTX) continue;
        if (parts & 1) {
            f32x4 acc[4] = {z4, z4, z4, z4};
            const bf16_t* ap = YF + (size_t)(r0 + fr) * DM + 8 * fq;
            const bf16_t* bp = LW + (size_t)3 * 131072 + (size_t)(l * 256 + 64 * wave + fr) * 256 + 8 * fq;
#pragma unroll
            for (int ks = 0; ks < 8; ++ks) {
                const bf16x8 a = *(const bf16x8*)(ap + 32 * ks);
#pragma unroll
                for (int j = 0; j < 4; ++j) acc[j] = mfma32(a, *(const bf16x8*)(bp + (size_t)(16 * j) * 256 + 32 * ks), acc[j]);
            }
#pragma unroll
            for (int j = 0; j < 4; ++j) {
                const int n = 64 * wave + 16 * j + fr;
                const float gb = P.in[21][l * 256 + n];
#pragma unroll
                for (int r = 0; r < 4; ++r) {
                    const size_t row = (size_t)(r0 + 4 * fq + r);
                    MIX[row * DM + n] = f2bf(bf2f(YF[row * DM + n]) * sigmoidf_(acc[j][r] + gb));
                }
            }
        }
        if (parts & 2) {
            const int i = tid >> 4, c0 = (tid & 15) * 16; const size_t row = (size_t)(r0 + i);
            float o[16], ss = 0.f;
#pragma unroll
            for (int j = 0; j < 16; ++j) { o[j] = bf2f(YF[row * DM + 256 + c0 + j]) + bf2f(YB[row * DM + 256 + c0 + j]); ss += o[j] * o[j]; }
            ss += __shfl_xor(ss, 1, 64); ss += __shfl_xor(ss, 2, 64);
            const float rs = rsqrtf(ss * (1.f / 64.f) + 1e-6f);
#pragma unroll
            for (int j = 0; j < 16; ++j) {
                const float gr = bf2f(Pb[row * PIN + 1280 + c0 + j]);
                MIX[row * DM + 256 + c0 + j] = f2bf(o[j] * rs * P.in[23][l * 256 + c0 + j] * gr);
            }
        }
        if (parts & 4)
#pragma unroll 1
        for (int hh = 0; hh < 2; ++hh) {
            const int h = 2 * wave + hh;
            f32x4 g[4] = {z4, z4, z4, z4};
            const bf16_t* ap = SG + (size_t)(r0 + fr) * 128 + 8 * fq;
            const bf16_t* bp = LW + (size_t)2 * 131072 + (size_t)(l * 512 + h * 64 + fr) * 128 + 8 * fq;
#pragma unroll
            for (int ks = 0; ks < 4; ++ks) {
                const bf16x8 a = *(const bf16x8*)(ap + 32 * ks);
#pragma unroll
                for (int j = 0; j < 4; ++j) g[j] = mfma32(a, *(const bf16x8*)(bp + (size_t)(16 * j) * 128 + 32 * ks), g[j]);
            }
            const bf16_t* gb = RW + ((size_t)u * 8 + h) * 8192 + 4 * fq;
            uint2 fr_[4], fk_[4], fv_[4], fa_[4], fb_[4];
#pragma unroll
            for (int j = 0; j < 4; ++j) {
                const bf16_t* e = gb + (16 * j + fr) * 16;
                fr_[j] = *(const uint2*)e; fk_[j] = *(const uint2*)(e + 1024); fv_[j] = *(const uint2*)(e + 2048); fa_[j] = *(const uint2*)(e + 4096); fb_[j] = *(const uint2*)(e + 5120);
            }
#pragma unroll
            for (int r = 0; r < 4; ++r) {
                const size_t row = (size_t)(r0 + 4 * fq + r);
                float y[4], vv[4], sum = 0.f, bon = 0.f;
#pragma unroll
                for (int j = 0; j < 4; ++j) {
                    const int c = h * 64 + 16 * j + fr;
                    y[j] = bf2f(YF[row * DM + 512 + c]) + bf2f(YB[row * DM + 512 + c]);
                    sum += y[j];
                    const float rr = bfw(r < 2 ? fr_[j].x : fr_[j].y, r & 1), k = bfw(r < 2 ? fk_[j].x : fk_[j].y, r & 1);
                    const float af = bfw(r < 2 ? fa_[j].x : fa_[j].y, r & 1), ab = bfw(r < 2 ? fb_[j].x : fb_[j].y, r & 1);
                    const float ka = P.in[31][l * 512 + c];
                    vv[j] = bfw(r < 2 ? fv_[j].x : fv_[j].y, r & 1);
                    bon += rr * P.in[32][l * 512 + c] * k * (2.f + (af + ab - 2.f) * ka);
                }
#pragma unroll
                for (int o = 1; o < 16; o <<= 1) { sum += __shfl_xor(sum, o, 64); bon += __shfl_xor(bon, o, 64); }
                const float mean = sum * (1.f / 64.f);
                float var = 0.f;
#pragma unroll
                for (int j = 0; j < 4; ++j) { const float d = y[j] - mean; var += d * d; }
#pragma unroll
                for (int o = 1; o < 16; o <<= 1) var += __shfl_xor(var, o, 64);
                const float rs = rsqrtf(var * (1.f / 64.f) + 64e-5f);
#pragma unroll
                for (int j = 0; j < 4; ++j) {
                    const int c = h * 64 + 16 * j + fr;
                    const float yn = (y[j] - mean) * rs * P.in[33][l * 512 + c] + P.in[34][l * 512 + c];
                    MIX[row * DM + 512 + c] = f2bf((yn + bon * vv[j]) * g[j][r]);
                }
            }
        }
    }
}

#define OFF_CTR (OFF_BAR + 14336)
#define ONE (1 << 20)
__device__ __forceinline__ int next_item(const Params& P, int ph, unsigned char* smem) {
    volatile LAS int* slot = (volatile LAS int*)(smem + 65552);
    __syncthreads();
    if (threadIdx.x == 0) *slot = (int)atomicAdd((unsigned*)(P.ws + OFF_CTR) + ph, 1u);
    __syncthreads();
    return __builtin_amdgcn_readfirstlane(*slot);
}
__device__ __forceinline__ void run_phase(const Params& P, int ph, unsigned char* smem, int rep) {
#ifndef ONLY
    if (ph == 0) { phase_prep(P, smem); return; }
    if (ph == 1) { phase_mkh(P); return; }
#else
    if (ph < 2) return;
#endif
    const int l = (ph - 2) / PPL, s = (ph - 2) % PPL;
#ifdef ONLY
    if (s != ONLY) return;
#endif
    switch (s) {
    case 0: gemm3_bf16((const bf16_t*)(P.ws + OFF_H), DM, (const bf16_t*)(P.ws + OFF_WIN) + (size_t)l * PIN * DM, DM, MROWS, PIN, DM, false, Epi4Inproj{(bf16_t*)(P.ws + OFF_P), (const float*)(P.ws + OFF_LBT) + l * 512, (bf16_t*)((unsigned char*)P.out + OFF_O_HGT)}, smem, 7, 9); break;
    case 1:
        for (;;) {
            int i = next_item(P, ph, smem);
#ifdef PROBE_P1
            if (i >= 2448 && i < 2448 + (PROBE_P1 == 1 ? 1088 : (PROBE_P1 == 2 ? 1088 : 272))) i = i - 2448 + (PROBE_P1 == 1 ? 0 : (PROBE_P1 == 2 ? 1088 : 2176));
            else
#endif
            if (i >= 1088 + 1088 + 272) break;
            if (i < 1088) hgrn_pass<false>(P, l, smem, i, ONE);
            else if (i < 2176) phase_rwprep2(P, l, smem, i - 1088, ONE);
            else s5_passA(P, l, i - 2176, ONE);
        }
        break;
    case 2:
        for (;;) {
            const int i = next_item(P, ph, smem);
            if (i >= 2176 + 128 + 32) break;
            if (i < 2176) rwkv_passA(P, l, smem, i, ONE);
            else if (i < 2176 + 128) hgrn_carry(P, i - 2176, ONE);
            else s5_carry(P, l, i - 2176 - 128, ONE);
        }
        break;
    case 3:
        for (;;) {
            int i = next_item(P, ph, smem);
#ifdef PROBE_P3
            if (i >= 1424 && i < 1424 + (PROBE_P3 == 1 ? 1088 : 272)) i = i - 1424 + (PROBE_P3 == 1 ? 64 : 64 + 1088);
            else
#endif
            if (i >= 1088 + 272 + 64) break;
            if (i < 64) rwkv_passB(P, i, ONE);
            else if (i < 64 + 1088) hgrn_pass<true>(P, l, smem, i - 64, ONE);
            else s5_passC(P, l, i - 64 - 1088, ONE);
        }
        break;
    case 4:
        for (;;) {
            const int i = next_item(P, ph, smem);
#ifdef PROBE_C
            if (i >= 2176 && i < 4352) { rwkv_passC<false>(P, l, smem, i - 2176, ONE, PROBE_C); continue; }
            if (i >= 4352) break;
#else
            if (i >= 2176) break;
#endif
            rwkv_passC<false>(P, l, smem, i, ONE);
        }
        break;
    case 5:
        for (;;) {
            const int i = next_item(P, ph, smem);
            if (i >= 3 * 1088) break;
            phase_post2(P, l, i % 1088, ONE, i < 1088 ? 4 : (i < 2176 ? 1 : 2));
        }
        break;
    case 6: gemm3_bf16((const bf16_t*)(P.ws + OFF_MIX), DM, (const bf16_t*)(P.ws + OFF_WOUT) + (size_t)l * DM * DM, DM, MROWS, DM, DM, l == 1, Epi4F32{(float*)(P.ws + OFF_TMP), DM}, smem, 8, 8); phase_tabconv8(P, l); break;
    case 7: phase_ln1(P, l); break;
    case 8: gemm3_bf16((const bf16_t*)(P.ws + OFF_H2), DM, (const bf16_t*)(P.ws + OFF_WQ) + (size_t)l * 2048 * DM, DM, MROWS, 2048, DM, l == 1, Epi4Bf16{(bf16_t*)(P.ws + OFF_Q), 2048}, smem, 8, 8); break;
    case 9: phase_topk2(P, l, smem); break;
    case 10: phase_gather8(P, l, smem); break;
    }
}

__global__ void __launch_bounds__(256, 2) mega(Params P) {
    __shared__ __attribute__((aligned(16))) unsigned char smem[66048];
#if SINGLE
    cg::grid_group grid = cg::this_grid();
    if (threadIdx.x < 4) ((volatile LAS unsigned*)(smem + 65536))[threadIdx.x] = 0u;
    __syncthreads();
    XcdBarrier xb = xcd_barrier_post((unsigned*)(P.ws + OFF_BAR), (volatile LAS unsigned*)(smem + 65536));
#endif
#ifdef PROBE_T
    unsigned long long tacc_ = 0;
#endif
    for (int ph = P.ph_lo; ph < P.ph_hi; ++ph) {
        int nrep = 1;
#ifdef DUPMASK
        if (ph >= 2 && ((DUPMASK >> ((ph - 2) % PPL)) & 1)) nrep = 2;
#endif
#ifdef DUP1MASK
        if (ph >= 2 + PPL && ((DUP1MASK >> ((ph - 2) % PPL)) & 1)) nrep = 2;
#endif
#ifdef PROBE_P
        if (ph == 0) nrep = 2;
#endif
        for (int rep = 0; rep < nrep; ++rep) {
#ifdef PROBE_T
            const unsigned long long t0_ = __builtin_amdgcn_s_memrealtime();
#endif
            run_phase(P, ph, smem, rep);
#if SINGLE
#ifdef PROBE_T
            const unsigned long long tb_ = __builtin_amdgcn_s_memrealtime();
#endif
            if (ph + 1 < P.ph_hi || rep + 1 < nrep) {
                if (ph == 0 && rep == 0) { asm volatile("s_waitcnt vmcnt(0)" ::: "memory"); __syncthreads(); grid.sync(); }
                else xcd_barrier(xb);
            }
#ifdef PROBE_T
            if (PROBE_T == 95) tacc_ += __builtin_amdgcn_s_memrealtime() - tb_;
#endif
#endif
#ifdef PROBE_T
            if (PROBE_T == 99 ? true : PROBE_T == 97 ? (ph < 13) : PROBE_T == 96 ? (ph >= 13) : PROBE_T == 98 ? (ph >= 2 && ((ph - 2) % PPL == 0 || (ph - 2) % PPL == 10)) : (PROBE_T >= 100 ? (ph == PROBE_T - 100) : (ph >= 2 && (ph - 2) % PPL == PROBE_T))) tacc_ += __builtin_amdgcn_s_memrealtime() - t0_;
#endif
        }
    }
#ifdef PROBE_T
    if (blockIdx.x == 0) { const unsigned long long te_ = __builtin_amdgcn_s_memrealtime() + tacc_; while (__builtin_amdgcn_s_memrealtime() < te_) __builtin_amdgcn_s_sleep(8); }
#endif
}

extern "C" void kernel_launch(void* const* d_in, const int* in_sizes, int n_in, void* d_out, int out_size, void* d_ws, size_t ws_size, hipStream_t stream) {
    static int grid = 0;
    if (grid == 0) {
        if (n_in != 39 || ws_size < OFF_END) { fprintf(stderr, "kernel_launch: unexpected n_in %d or ws_size %zu (need %zu)\n", n_in, ws_size, (size_t)OFF_END); grid = -1; return; }
        int dev = 0, cus = 0, per_cu = 0;
        hipGetDevice(&dev);
        hipDeviceGetAttribute(&cus, hipDeviceAttributeMultiprocessorCount, dev);
        hipOccupancyMaxActiveBlocksPerMultiprocessor(&per_cu, mega, 256, 0);
        if (per_cu < 1) per_cu = 1;
        if (per_cu > 2) per_cu = 2;
        grid = cus * per_cu;
    }
    if (grid < 0) return;
    hipMemsetAsync((unsigned char*)d_ws + OFF_BAR, 0, 16384, stream);
    Params p{};
    for (int i = 0; i < 39; ++i) p.in[i] = (const float*)d_in[i];
    p.out = (float*)d_out; p.ws = (unsigned char*)d_ws;
#if SINGLE
    p.ph_lo = 0; p.ph_hi = NPH;
    void* args[] = {&p};
    hipError_t e = hipLaunchCooperativeKernel((void*)mega, dim3(grid), dim3(256), args, 0, stream);
    if (e != hipSuccess) fprintf(stderr, "cooperative launch failed: %s (grid %d)\n", hipGetErrorString(e), grid);
#else
    for (int ph = 0; ph < NPH; ++ph) {
        p.ph_lo = ph; p.ph_hi = ph + 1;
        hipLaunchKernelGGL(mega, dim3(grid), dim3(256), 0, stream, p);
    }
#endif
}
```

```cpp
#include <hip/hip_runtime.h>
#include <hip/hip_cooperative_groups.h>
#include <cstdio>
namespace cg = cooperative_groups;

#ifndef SINGLE
#define SINGLE 1
#endif

typedef unsigned short bf16_t;
typedef __bf16 bf16x2 __attribute__((ext_vector_type(2)));
typedef short bf16x8 __attribute__((ext_vector_type(8)));
typedef float f32x4 __attribute__((ext_vector_type(4)));
typedef unsigned u32x4 __attribute__((ext_vector_type(4)));
typedef int i32x4 __attribute__((ext_vector_type(4)));
typedef int i32x16 __attribute__((ext_vector_type(16)));

#define DM 1024
#define NB 4
#define SEQ 4096
#define CTX 256
#define LTOT 4352
#define MROWS 17408
#define PIN 3456
#define RWW 4224
#define NPH 26
#define PPL 12
#define ALPHA 1.41421356237f

#define OFF_XS 0ull
#define OFF_P (OFF_XS + (size_t)MROWS * DM * 4)
#define OFF_RW (OFF_P + (size_t)MROWS * PIN * 2)
#define OFF_YP (OFF_RW + (size_t)MROWS * RWW * 2)
#define OFF_MIX (OFF_YP + (size_t)2 * MROWS * DM * 2)
#define OFF_MOD (OFF_MIX + (size_t)MROWS * DM * 2)
#define OFF_WIN (OFF_MOD + (size_t)2 * 5 * 6144 * 4)
#define OFF_WOUT (OFF_WIN + (size_t)2 * PIN * DM * 2)
#define OFF_WQ (OFF_WOUT + (size_t)2 * DM * DM * 2)
#define OFF_WIN8 OFF_WIN
#define OFF_WINS (OFF_WIN + (size_t)2 * PIN * DM)
#define OFF_WQ8 OFF_WQ
#define OFF_WQS (OFF_WQ + (size_t)2 * 2048 * DM)
#define OFF_S5MS (OFF_WQ + (size_t)2 * 2048 * DM * 2)
#define OFF_S5MY (OFF_S5MS + (size_t)2 * 16 * 256 * 256 * 2)
#define OFF_S5LB (OFF_S5MY + (size_t)2 * 16 * 256 * 512 * 2)
#define OFF_S5ST (OFF_S5LB + (size_t)2 * 16 * 2 * 128 * 4)
#define OFF_BAR (OFF_S5ST + (size_t)4 * 16 * 272 * 256 * 4)
#define OFF_KEYB (OFF_BAR + 16384)
#define OFF_LW (OFF_KEYB + (size_t)2 * 8 * 2 * 128 * 128 * 2)
#define OFF_LBT (OFF_LW + (size_t)4 * 131072 * 2)
#define OFF_H8 (OFF_LBT + 4096)
#define OFF_HS (OFF_H8 + (size_t)MROWS * DM)
#define OFF_END (OFF_HS + (size_t)MROWS * 4)
#define OFF_RXL OFF_MIX
#define OFF_TMP OFF_P
#define OFF_H OFF_YP
#define OFF_HI8 OFF_H
#define OFF_HIS (OFF_H + (size_t)MROWS * DM)
#define OFF_H2 (OFF_YP + (size_t)MROWS * DM * 2)
#define OFF_Q OFF_RW
#define OFF_IDX (OFF_RW + (size_t)MROWS * 2048 * 2)
#define OFF_GATE (OFF_IDX + (size_t)MROWS * 128 * 4)
#define OFF_TBU OFF_P
#define OFF_TBV (OFF_P + (size_t)16384 * 1024 * 2)

#define OFF_O_HGT ((size_t)2176 * 8192 + (size_t)1088 * 8192 + (size_t)1088 * 256)
struct Params {
    const float* in[39];
    float* out;
    unsigned char* ws;
    int ph_lo, ph_hi;
};

__device__ __forceinline__ bf16_t f2bf(float f) { const __bf16 h = (__bf16)f; return __builtin_bit_cast(bf16_t, h); }
typedef float f32x2_ __attribute__((ext_vector_type(2)));
__device__ __forceinline__ unsigned pk2bf(float a, float b) { const f32x2_ v = {a, b}; return __builtin_bit_cast(unsigned, __builtin_convertvector(v, bf16x2)); }
__device__ __forceinline__ float bf2f(bf16_t h) { return __uint_as_float(((unsigned)h) << 16); }
__device__ __forceinline__ float sigmoidf_(float x) { return 1.f / (1.f + __expf(-x)); }
__device__ __forceinline__ float siluf_(float x) { return x * sigmoidf_(x); }
__device__ __forceinline__ float gelu_tanh(float x) {
    const float u = 0.7978845608028654f * (x + 0.044715f * x * x * x);
    return 0.5f * x * (1.f + tanhf(u));
}
__device__ __forceinline__ float wave_sum(float v) {
#pragma unroll
    for (int o = 32; o > 0; o >>= 1) v += __shfl_xor(v, o, 64);
    return v;
}
typedef short bf16x4 __attribute__((ext_vector_type(4)));
#define RW_NCH 34
#define RW_BUF 13824
#define RW_VT0 27648
__device__ __forceinline__ f32x4 mfma32(bf16x8 a, bf16x8 b, f32x4 c) { return __builtin_amdgcn_mfma_f32_16x16x32_bf16(a, b, c, 0, 0, 0); }
__device__ __forceinline__ f32x4 mfma16(bf16x4 a, bf16x4 b, f32x4 c) {
    bf16x8 a8, b8;
    a8[0] = a[0]; a8[1] = a[1]; a8[2] = a[2]; a8[3] = a[3]; a8[4] = 0; a8[5] = 0; a8[6] = 0; a8[7] = 0;
    b8[0] = b[0]; b8[1] = b[1]; b8[2] = b[2]; b8[3] = b[3]; b8[4] = 0; b8[5] = 0; b8[6] = 0; b8[7] = 0;
    return __builtin_amdgcn_mfma_f32_16x16x32_bf16(a8, b8, c, 0, 0, 0);
}
typedef unsigned u32x2_ __attribute__((ext_vector_type(2)));
__device__ __forceinline__ bf16x4 to4(f32x4 v) { const u32x2_ p = {pk2bf(v[0], v[1]), pk2bf(v[2], v[3])}; return __builtin_bit_cast(bf16x4, p); }
__device__ __forceinline__ bf16x8 cat8(bf16x4 a, bf16x4 b) { bf16x8 o; o[0] = a[0]; o[1] = a[1]; o[2] = a[2]; o[3] = a[3]; o[4] = b[0]; o[5] = b[1]; o[6] = b[2]; o[7] = b[3]; return o; }

__device__ __forceinline__ int otid() { int t = threadIdx.x; asm volatile("" : "+v"(t)); return t; }
__device__ __forceinline__ float rdlane(float v, int l) { return __int_as_float(__builtin_amdgcn_readlane(__float_as_int(v), l)); }
__device__ __forceinline__ int row_of(int b, int dir, int tau) {
    const int p = dir == 0 ? tau : (tau < CTX ? (CTX - 1 - tau) : (LTOT + CTX - 1 - tau));
    return b * LTOT + p;
}
__device__ __forceinline__ const float* xin_row(const Params& P, int row) {
    const int b = row / LTOT, p = row % LTOT;
    return p < CTX ? P.in[2] + ((size_t)b * CTX + p) * DM : P.in[0] + ((size_t)b * SEQ + (p - CTX)) * DM;
}
__device__ __forceinline__ int modrow(int row) { const int p = row % LTOT; return p < CTX ? 4 : row / LTOT; }

__device__ __forceinline__ void s5_prep_unit(const Params& P, int l, int g, int part, unsigned char* smem);

#define XB_TMO      128
#define XB_XCNT(j)  (256  + 64 * (j))
#define XB_XSUB(j)  (1280 + 64 * (j))
#define XB_XGEN(j)  (2304 + 64 * (j))
#define XB_TOP      3328
#define XB_TOPGEN   3392
#define XCD_BAR_WORDS 3456
#define XB_SPIN_CAP (1u << 22)
#define LAS __attribute__((address_space(3)))
__device__ __forceinline__ unsigned xb_ld(unsigned* p)              { return __hip_atomic_load(p, __ATOMIC_RELAXED, __HIP_MEMORY_SCOPE_AGENT); }
__device__ __forceinline__ unsigned xb_add(unsigned* p, unsigned v) { return __hip_atomic_fetch_add(p, v, __ATOMIC_RELAXED, __HIP_MEMORY_SCOPE_AGENT); }
__device__ __forceinline__ unsigned xb_xcc_id() { return (unsigned)__builtin_amdgcn_s_getreg((3 << 11) | 20) & 0xFu; }
#define XB_SPIN(cond, bar) do { unsigned _sp = 0; while (cond) { __builtin_amdgcn_s_sleep(1); \
    if ((++_sp & 255u) == 0u) { if (xb_ld(&(bar)[XB_TMO])) break; if (_sp > XB_SPIN_CAP) { atomicAdd(&(bar)[XB_TMO], 1u); break; } } } } while (0)
struct XcdBarrier { unsigned* bar; unsigned x; volatile LAS unsigned* st; };
__device__ __forceinline__ XcdBarrier xcd_barrier_post(unsigned* bar, volatile LAS unsigned* st) {
    XcdBarrier b; b.bar = bar; b.x = xb_xcc_id(); b.st = st;
    if (threadIdx.x == 0) (void)xb_add(&bar[XB_XCNT(b.x)], 1u);
    return b;
}
__device__ __forceinline__ void xcd_barrier_complete(unsigned* bar, unsigned x, unsigned& nloc, unsigned& nx) {
    const unsigned G = gridDim.x * gridDim.y * gridDim.z;
    unsigned sum, cnt, mine, sp = 0u;
    for (;;) {
        sum = 0u; cnt = 0u; mine = 0u;
#pragma unroll
        for (unsigned j = 0; j < 16; ++j) { const unsigned c = xb_ld(&bar[XB_XCNT(j)]); sum += c; cnt += (c > 0u) ? 1u : 0u; mine = (j == x) ? c : mine; }
        if (sum == G) break;
        __builtin_amdgcn_s_sleep(1);
        if ((++sp & 255u) == 0u) { if (xb_ld(&bar[XB_TMO])) break; if (sp > XB_SPIN_CAP) { atomicAdd(&bar[XB_TMO], 1u); break; } }
    }
    nloc = mine > 0u ? mine : 1u; nx = cnt > 0u ? cnt : 1u;
}
__device__ __forceinline__ void xcd_barrier(const XcdBarrier& b) {
    asm volatile("s_waitcnt vmcnt(0)" ::: "memory");
    __syncthreads();
    if (threadIdx.x == 0) {
        unsigned* bar = b.bar;
        __builtin_amdgcn_s_waitcnt(0);
        unsigned nloc = b.st[0], nx = b.st[1];
        if (nloc == 0u) { xcd_barrier_complete(bar, b.x, nloc, nx); b.st[0] = nloc; b.st[1] = nx; }
        const unsigned old = xb_add(&bar[XB_XSUB(b.x)], 1u);
        const unsigned gen = old / nloc;
        if (old + 1u == (gen + 1u) * nloc) {
            __builtin_amdgcn_fence(__ATOMIC_RELEASE, "agent");
            asm volatile("s_waitcnt vmcnt(0)" ::: "memory");
            const unsigned og = xb_add(&bar[XB_TOP], 1u);
            const unsigned tg = og / nx;
            if (og + 1u == (tg + 1u) * nx) xb_add(&bar[XB_TOPGEN], 1u);
            else XB_SPIN(xb_ld(&bar[XB_TOPGEN]) == tg, bar);
            __builtin_amdgcn_fence(__ATOMIC_ACQUIRE, "agent");
            xb_add(&bar[XB_XGEN(b.x)], 1u);
            asm volatile("s_waitcnt vmcnt(0)" ::: "memory");
        } else {
            XB_SPIN(xb_ld(&bar[XB_XGEN(b.x)]) == gen, bar);
            __builtin_amdgcn_fence(__ATOMIC_ACQUIRE, "agent");
            asm volatile("s_waitcnt vmcnt(0)" ::: "memory");
        }
    }
    __syncthreads();
}

__device__ __forceinline__ void phase_prep(const Params& P, unsigned char* smem) {
    const int tid = otid(), lane = tid & 63, wave = __builtin_amdgcn_readfirstlane(tid >> 6);
    float* MOD = (float*)(P.ws + OFF_MOD);
    float* XS = (float*)(P.ws + OFF_XS);
    const int U_MOD = 192, U_COPY = 0, U_TIN = 0, U_TOUT = 2 * 16 * 16, U_TQ = 2 * 32 + 2 * 54;
    const int U_S5 = 128, U_KEY = 64 + 64;
    const int total = U_S5 + U_KEY + U_MOD + U_COPY + U_TIN + U_TOUT + U_TQ;
    for (int u0 = blockIdx.x; u0 < total; u0 += gridDim.x) {
        __syncthreads();
        if (u0 < U_S5) {
            if (u0 == 0) {
                float* LBT = (float*)(P.ws + OFF_LBT);
                for (int i = tid; i < 1024; i += 256) {
                    const int ll = i >> 9, dir = (i >> 8) & 1, ch = i & 255;
                    float lbv = 0.f;
                    if (ll == 1) { const float a0 = P.in[22][(dir * 2 + 0) * 256 + ch], a1 = P.in[22][(dir * 2 + 1) * 256 + ch]; const float m = fmaxf(a0, a1), e0 = __expf(a0 - m), e1 = __expf(a1 - m); lbv = e1 / (e0 + e1); }
                    LBT[i] = lbv;
                }
            }
            s5_prep_unit(P, u0 >> 6, (u0 >> 2) & 15, u0 & 3, smem); continue;
        }
        if (u0 < U_S5 + 64) {
            bf16_t* KB = (bf16_t*)(P.ws + OFF_KEYB);
            const size_t base = (size_t)(u0 - U_S5) * 8192;
            for (int i = tid; i < 8192; i += 256) KB[base + i] = f2bf(P.in[36][base + i]);
            continue;
        }
        if (u0 < U_S5 + U_KEY) {
            bf16_t* LW = (bf16_t*)(P.ws + OFF_LW);
            const int base = (u0 - U_S5 - 64) * 8192;
            for (int i = tid; i < 8192; i += 256) {
                const int o = base + i, which = o >> 17, e = o & 131071;
                float v;
                if (which < 2) { const int j = e & 63, c = (e >> 6) & 511, ld = e >> 15; v = P.in[which == 0 ? 26 : 28][((size_t)ld * 64 + j) * 512 + c]; }
                else if (which == 2) { const int j = e & 127, c = (e >> 7) & 511, ll = e >> 16; v = P.in[29][((size_t)ll * 128 + j) * 512 + c]; }
                else { const int k = e & 255, n = (e >> 8) & 255, ll = e >> 16; v = P.in[20][((size_t)ll * 256 + k) * 256 + n]; }
                LW[o] = f2bf(v);
            }
            continue;
        }
        const int u = u0 - U_S5 - U_KEY;
        if (u < U_MOD) {
            const int l = u / 96, j0 = (u % 96) * 64;
            float* sl = (float*)smem;
            for (int i = tid; i < 5 * 1024; i += 256) {
                const int r = i >> 10, k = i & 1023;
                const float cv = r < 4 ? P.in[1][r * 1024 + k] : P.in[3][k];
                sl[i] = siluf_(cv);
            }
            __syncthreads();
            float acc[5] = {0.f, 0.f, 0.f, 0.f, 0.f};
            const float* W = P.in[4] + (size_t)l * 1024 * 6144 + j0 + lane;
            for (int k0 = wave * 256; k0 < wave * 256 + 256; k0 += 16) {
                float wv[16];
#pragma unroll
                for (int q = 0; q < 16; ++q) wv[q] = W[(size_t)(k0 + q) * 6144];
#pragma unroll
                for (int q = 0; q < 16; ++q)
#pragma unroll
                    for (int r = 0; r < 5; ++r) acc[r] += sl[r * 1024 + k0 + q] * wv[q];
            }
            float* red = (float*)(smem + 5 * 1024 * 4);
#pragma unroll
            for (int r = 0; r < 5; ++r) red[(wave * 5 + r) * 64 + lane] = acc[r];
            __syncthreads();
            for (int i = tid; i < 5 * 64; i += 256) {
                const int r = i / 64, jj = i % 64;
                float s = P.in[5][l * 6144 + j0 + jj];
                for (int w = 0; w < 4; ++w) s += red[(w * 5 + r) * 64 + jj];
                MOD[(l * 5 + r) * 6144 + j0 + jj] = s;
            }
        } else if (u < U_MOD + U_COPY) {
            const int r0 = (u - U_MOD) * 16;
            for (int i = tid; i < 16 * 256; i += 256) {
                const int row = r0 + (i >> 8), c4 = i & 255;
                const int b = row / LTOT, p = row % LTOT;
                const float4* src = p < CTX ? (const float4*)(P.in[2] + ((size_t)b * CTX + p) * DM) : (const float4*)(P.in[0] + ((size_t)b * SEQ + (p - CTX)) * DM);
                ((float4*)(XS + (size_t)row * DM))[c4] = src[c4];
            }
        } else if (u >= U_MOD + U_COPY + U_TIN + U_TOUT) {
            int v = u - U_MOD - U_COPY - U_TIN - U_TOUT;
            const bool isq = v < 64; if (!isq) v -= 64;
            const int N = isq ? 2048 : PIN, l = isq ? (v >> 5) : (v / 54), cb = isq ? (v & 31) : (v % 54);
            const float* W = (isq ? P.in[35] : P.in[6]) + (size_t)l * 1024 * N + cb * 64 + lane;
            float am = 0.f;
            for (int k0 = wave * 256; k0 < wave * 256 + 256; k0 += 32) {
                float wv[32];
#pragma unroll
                for (int q = 0; q < 32; ++q) wv[q] = W[(size_t)(k0 + q) * N];
#pragma unroll
                for (int q = 0; q < 32; ++q) am = fmaxf(am, fabsf(wv[q]));
            }
            float* red = (float*)smem;
            red[wave * 64 + lane] = am;
            __syncthreads();
            if (tid < 64) ((float*)(P.ws + (isq ? OFF_WQS : OFF_WINS)))[l * N + cb * 64 + tid] = fmaxf(fmaxf(red[tid], red[64 + tid]), fmaxf(red[128 + tid], red[192 + tid])) * (1.f / 127.f);
        } else {
            int v = u - U_MOD - U_COPY;
            const float* W; bf16_t* Wt; int N;
            if (v < U_TIN) { const int l = v / (16 * 54); v %= 16 * 54; N = PIN; W = P.in[6] + (size_t)l * 1024 * PIN; Wt = (bf16_t*)(P.ws + OFF_WIN) + (size_t)l * PIN * 1024; }
            else { v -= U_TIN; const int l = v / 256; v %= 256; N = 1024; W = P.in[7] + (size_t)l * 1024 * 1024; Wt = (bf16_t*)(P.ws + OFF_WOUT) + (size_t)l * 1024 * 1024; }
            const int ntn = N / 64, kt = v / ntn, nt = v % ntn;
            float* t = (float*)smem;
#pragma unroll
            for (int q = 0; q < 4; ++q) {
                const int i = tid + 256 * q, kk = i >> 4, n4 = (i & 15) * 4;
                const float4 v = *(const float4*)(W + (size_t)(kt * 64 + kk) * N + nt * 64 + n4);
                t[kk * 65 + n4] = v.x; t[kk * 65 + n4 + 1] = v.y; t[kk * 65 + n4 + 2] = v.z; t[kk * 65 + n4 + 3] = v.w;
            }
            __syncthreads();
            {
                const int nn = tid >> 2, k0 = (tid & 3) * 16;
                unsigned w[8];
#pragma unroll
                for (int q = 0; q < 8; ++q) w[q] = pk2bf(t[(k0 + 2 * q) * 65 + nn], t[(k0 + 2 * q + 1) * 65 + nn]);
                bf16_t* dst = Wt + (size_t)(nt * 64 + nn) * 1024 + kt * 64 + k0;
                *(u32x4*)dst = (u32x4){w[0], w[1], w[2], w[3]};
                *(u32x4*)(dst + 8) = (u32x4){w[4], w[5], w[6], w[7]};
            }
        }
    }
}

__device__ __forceinline__ void phase_mkh(const Params& P, unsigned char* smem) {
    const int lane = otid() & 63, wave = __builtin_amdgcn_readfirstlane(otid() >> 6);
    const float* MOD = (const float*)(P.ws + OFF_MOD);
    unsigned char* HI8 = P.ws + OFF_HI8; float* HIS = (float*)(P.ws + OFF_HIS);
    for (int row = blockIdx.x * 4 + wave; row < MROWS; row += gridDim.x * 4) {
        const float* mod = MOD + (size_t)(0 * 5 + modrow(row)) * 6144;
        float v[16];
#pragma unroll
        for (int j = 0; j < 4; ++j) {
            const int d = 256 * j + 4 * lane;
            const float4 x = *(const float4*)(xin_row(P, row) + d);
            const float4 sh = *(const float4*)(mod + d), sc = *(const float4*)(mod + 1024 + d);
            v[4 * j] = x.x * (1.f + sc.x) + sh.x; v[4 * j + 1] = x.y * (1.f + sc.y) + sh.y; v[4 * j + 2] = x.z * (1.f + sc.z) + sh.z; v[4 * j + 3] = x.w * (1.f + sc.w) + sh.w;
        }
        float am = 0.f;
#pragma unroll
        for (int j = 0; j < 16; ++j) am = fmaxf(am, fabsf(v[j]));
#pragma unroll
        for (int o = 32; o > 0; o >>= 1) am = fmaxf(am, __shfl_xor(am, o, 64));
        const float hs = am > 0.f ? 127.f / am : 1.f;
#pragma unroll
        for (int j = 0; j < 4; ++j)
            *(unsigned*)(HI8 + (size_t)row * DM + 256 * j + 4 * lane) = ((unsigned)__float2int_rn(v[4 * j] * hs) & 0xFFu) | (((unsigned)__float2int_rn(v[4 * j + 1] * hs) & 0xFFu) << 8) | (((unsigned)__float2int_rn(v[4 * j + 2] * hs) & 0xFFu) << 16) | (((unsigned)__float2int_rn(v[4 * j + 3] * hs) & 0xFFu) << 24);
        if (lane == 0) HIS[row] = am * (1.f / 127.f);
    }
    {
        const int tid = otid();
        float* t = (float*)smem;
        for (int v0 = blockIdx.x; v0 < 2 * 16 * 32 + 2 * 16 * 54; v0 += gridDim.x) {
            const bool isq = v0 < 1024; const int v = isq ? v0 : v0 - 1024;
            const int N = isq ? 2048 : PIN, ntn = N / 64, l = v / (16 * ntn), kt = (v % (16 * ntn)) / ntn, nt = v % ntn;
            const float* W = (isq ? P.in[35] : P.in[6]) + (size_t)l * 1024 * N;
            const float* WS = (const float*)(P.ws + (isq ? OFF_WQS : OFF_WINS)) + l * N;
            unsigned char* W8 = P.ws + (isq ? OFF_WQ8 : OFF_WIN8) + (size_t)l * N * 1024;
            __syncthreads();
#pragma unroll
            for (int q = 0; q < 4; ++q) {
                const int i = tid + 256 * q, kk = i >> 4, n4 = (i & 15) * 4;
                const float4 x = *(const float4*)(W + (size_t)(kt * 64 + kk) * N + nt * 64 + n4);
                t[kk * 65 + n4] = x.x; t[kk * 65 + n4 + 1] = x.y; t[kk * 65 + n4 + 2] = x.z; t[kk * 65 + n4 + 3] = x.w;
            }
            __syncthreads();
            const int nn = tid >> 2, k0 = (tid & 3) * 16;
            const float sc = WS[nt * 64 + nn], inv = sc > 0.f ? 1.f / sc : 0.f;
            u32x4 w;
#pragma unroll
            for (int q = 0; q < 4; ++q)
                w[q] = ((unsigned)__float2int_rn(t[(k0 + 4 * q) * 65 + nn] * inv) & 0xFFu) | (((unsigned)__float2int_rn(t[(k0 + 4 * q + 1) * 65 + nn] * inv) & 0xFFu) << 8)
                     | (((unsigned)__float2int_rn(t[(k0 + 4 * q + 2) * 65 + nn] * inv) & 0xFFu) << 16) | (((unsigned)__float2int_rn(t[(k0 + 4 * q + 3) * 65 + nn] * inv) & 0xFFu) << 24);
            *(u32x4*)(W8 + (size_t)(nt * 64 + nn) * 1024 + kt * 64 + k0) = w;
        }
    }
}

template <class EPI>
__device__ __forceinline__ void gemm_bf16(const bf16_t* A, int lda, const bf16_t* Bt, int ldb, int M, int N, int K, bool skipctx, EPI epi) {
    const int lane = otid() & 63, wave = __builtin_amdgcn_readfirstlane(otid() >> 6);
    const int ntm = M / 128, ntn = N / 128;
    const int fr = lane & 15, fq = lane >> 4;
    for (int tile = blockIdx.x; tile < ntm * ntn; tile += gridDim.x) {
        const int tm = tile / ntn, tn = tile % ntn;
        const int m0 = tm * 128 + (wave >> 1) * 64, n0 = tn * 128 + (wave & 1) * 64;
        if (skipctx && (m0 % LTOT) < CTX) continue;
        f32x4 acc[4][4];
#pragma unroll
        for (int i = 0; i < 4; ++i)
#pragma unroll
            for (int j = 0; j < 4; ++j) acc[i][j] = (f32x4){0.f, 0.f, 0.f, 0.f};
        const bf16_t* ap = A + (size_t)(m0 + fr) * lda + 8 * fq;
        const bf16_t* bp = Bt + (size_t)(n0 + fr) * ldb + 8 * fq;
        for (int k0 = 0; k0 < K; k0 += 32) {
            bf16x8 a[4], b[4];
#pragma unroll
            for (int i = 0; i < 4; ++i) a[i] = *(const bf16x8*)(ap + (size_t)(16 * i) * lda + k0);
#pragma unroll
            for (int j = 0; j < 4; ++j) b[j] = *(const bf16x8*)(bp + (size_t)(16 * j) * ldb + k0);
#pragma unroll
            for (int i = 0; i < 4; ++i)
#pragma unroll
                for (int j = 0; j < 4; ++j) acc[i][j] = __builtin_amdgcn_mfma_f32_16x16x32_bf16(a[i], b[j], acc[i][j], 0, 0, 0);
        }
#pragma unroll
        for (int i = 0; i < 4; ++i)
#pragma unroll
            for (int j = 0; j < 4; ++j)
#pragma unroll
                for (int r = 0; r < 4; ++r) epi(m0 + 16 * i + 4 * fq + r, n0 + 16 * j + fr, acc[i][j][r]);
    }
}

typedef float f32x16 __attribute__((ext_vector_type(16)));
#define G2_LD 72
template <class EPI>
__device__ __forceinline__ void gemm2_bf16(const bf16_t* A, int lda, const bf16_t* Bt, int ldb, int M, int N, int K, bool skipctx, EPI epi, unsigned char* smem) {
    const int tid = otid(), lane = tid & 63, wave = __builtin_amdgcn_readfirstlane(tid >> 6);
    const int ntm = M / 128, ntn = N / 128;
    bf16_t* As = (bf16_t*)smem;
    bf16_t* Bs = As + 128 * G2_LD;
    const int lr = tid >> 3, lc = (tid & 7) * 8;
    const int wm = (wave >> 1) * 64, wn = (wave & 1) * 64;
    const int fr = lane & 31, fh = lane >> 5;
    for (int tile = blockIdx.x; tile < ntm * ntn; tile += gridDim.x) {
        const int tm = tile / ntn, tn = tile % ntn;
        if (skipctx && ((tm * 128) % LTOT) < CTX) continue;
        const bf16_t* ag = A + (size_t)(tm * 128 + lr) * lda + lc;
        const bf16_t* bg = Bt + (size_t)(tn * 128 + lr) * ldb + lc;
        f32x16 acc[2][2];
        {
            const f32x16 z16 = {0.f, 0.f, 0.f, 0.f, 0.f, 0.f, 0.f, 0.f, 0.f, 0.f, 0.f, 0.f, 0.f, 0.f, 0.f, 0.f};
            acc[0][0] = z16; acc[0][1] = z16; acc[1][0] = z16; acc[1][1] = z16;
        }
        u32x4 ra0[4], rb0[4], ra1[4], rb1[4];
#define G2_LOAD(RA, RB, kk_) { const int kq = (kk_) < K ? (kk_) : 0; _Pragma("unroll") for (int i = 0; i < 4; ++i) { RA[i] = *(const u32x4*)(ag + (size_t)(32 * i) * lda + kq); RB[i] = *(const u32x4*)(bg + (size_t)(32 * i) * ldb + kq); } }
#define G2_STORE(RA, RB) { _Pragma("unroll") for (int i = 0; i < 4; ++i) { *(u32x4*)(As + (lr + 32 * i) * G2_LD + lc) = RA[i]; *(u32x4*)(Bs + (lr + 32 * i) * G2_LD + lc) = RB[i]; } }
#define G2_COMPUTE() { _Pragma("unroll") for (int kk = 0; kk < 4; ++kk) { bf16x8 a[2], b[2]; \
            _Pragma("unroll") for (int i = 0; i < 2; ++i) a[i] = *(const bf16x8*)(As + (wm + 32 * i + fr) * G2_LD + 16 * kk + 8 * fh); \
            _Pragma("unroll") for (int j = 0; j < 2; ++j) b[j] = *(const bf16x8*)(Bs + (wn + 32 * j + fr) * G2_LD + 16 * kk + 8 * fh); \
            _Pragma("unroll") for (int i = 0; i < 2; ++i) _Pragma("unroll") for (int j = 0; j < 2; ++j) acc[i][j] = __builtin_amdgcn_mfma_f32_32x32x16_bf16(a[i], b[j], acc[i][j], 0, 0, 0); } }
        G2_LOAD(ra0, rb0, 0)
        G2_LOAD(ra1, rb1, 64)
        __syncthreads();
        G2_STORE(ra0, rb0)
        __syncthreads();
        G2_LOAD(ra0, rb0, 128)
        for (int k0 = 0; k0 < K; k0 += 128) {
            G2_COMPUTE()
            __syncthreads();
            G2_STORE(ra1, rb1)
            __syncthreads();
            G2_LOAD(ra1, rb1, k0 + 192)
            G2_COMPUTE()
            if (k0 + 128 < K) {
                __syncthreads();
                G2_STORE(ra0, rb0)
                __syncthreads();
                G2_LOAD(ra0, rb0, k0 + 256)
            }
        }
#undef G2_LOAD
#undef G2_STORE
#undef G2_COMPUTE
#pragma unroll
        for (int i = 0; i < 2; ++i)
#pragma unroll
            for (int j = 0; j < 2; ++j)
#pragma unroll
                for (int q = 0; q < 16; ++q) epi(tm * 128 + wm + 32 * i + (q & 3) + 8 * (q >> 2) + 4 * fh, tn * 128 + wn + 32 * j + fr, acc[i][j][q]);
    }
}

template <class EPI>
__device__ __forceinline__ void gemm3_bf16(const bf16_t* A, int lda, const bf16_t* Bt, int ldb, int M, int N, int K, bool skipctx, EPI epi, unsigned char* smem, int TMS, int TNS) {
    const int tid = otid(), lane = tid & 63, wave = __builtin_amdgcn_readfirstlane(tid >> 6);
    const int ntm = M / 128, ntn = N / 128, nkt = K / 64;
    const int wm = (wave >> 1) * 64, wn = (wave & 1) * 64;
    const int fr = lane & 31, fh = lane >> 5;
    const int rr = lane >> 3, cc = lane & 7;
    const int gcol = (cc ^ rr) * 8;
    const int nSm = (ntm + TMS - 1) / TMS, nSn = (ntn + TNS - 1) / TNS, S = TMS * TNS;
    const int xg = blockIdx.x & 7, lb = blockIdx.x >> 3, nlb = gridDim.x >> 3;
    const int nST = nSm * nSn, nfull = nST & ~7, rpt = (S + nlb - 1) / nlb;
    const int nit = (nfull >> 3) * rpt + ((nST - nfull) * S + (int)gridDim.x - 1) / (int)gridDim.x;
    for (int it = 0; it < nit; ++it) {
        int st, t;
        if (it < (nfull >> 3) * rpt) { st = xg + 8 * (it / rpt); t = lb + (it % rpt) * nlb; if (t >= S) continue; }
        else { const int g = (int)blockIdx.x + (it - (nfull >> 3) * rpt) * (int)gridDim.x; if (g >= (nST - nfull) * S) continue; st = nfull + g / S; t = g % S; }
        const int tm = (st / nSn) * TMS + t % TMS, tn = (st % nSn) * TNS + t / TMS;
        if (tm >= ntm || tn >= ntn) continue;
        if (skipctx && ((tm * 128) % LTOT) < CTX) continue;
        const bf16_t* ag = A + (size_t)(tm * 128 + 32 * wave + rr) * lda + gcol;
        const bf16_t* bg = Bt + (size_t)(tn * 128 + 32 * wave + rr) * ldb + gcol;
        f32x16 acc[2][2];
        {
            const f32x16 z16 = {0.f, 0.f, 0.f, 0.f, 0.f, 0.f, 0.f, 0.f, 0.f, 0.f, 0.f, 0.f, 0.f, 0.f, 0.f, 0.f};
            acc[0][0] = z16; acc[0][1] = z16; acc[1][0] = z16; acc[1][1] = z16;
        }
#define G3_ISSUE(kt_, b_) { unsigned char* la_ = smem + (b_) * 32768 + (32 * wave) * 128; unsigned char* lb_ = la_ + 16384; \
            _Pragma("unroll") for (int q = 0; q < 4; ++q) { \
                __builtin_amdgcn_global_load_lds((const unsigned*)(ag + (size_t)(8 * q) * lda + (kt_) * 64), (LAS unsigned*)(la_ + q * 1024), 16, 0, 0); \
                __builtin_amdgcn_global_load_lds((const unsigned*)(bg + (size_t)(8 * q) * ldb + (kt_) * 64), (LAS unsigned*)(lb_ + q * 1024), 16, 0, 0); } }
        __syncthreads();
        G3_ISSUE(0, 0)
        asm volatile("s_waitcnt vmcnt(0)" ::: "memory");
        __syncthreads();
        for (int kt = 0; kt < nkt; ++kt) {
            if (kt + 1 < nkt) G3_ISSUE(kt + 1, (kt + 1) & 1)
            const unsigned char* As = smem + (kt & 1) * 32768;
            const unsigned char* Bs = As + 16384;
#pragma unroll
            for (int kk = 0; kk < 4; ++kk) {
                bf16x8 a[2], b[2];
#pragma unroll
                for (int i = 0; i < 2; ++i) { const int r = wm + 32 * i + fr; a[i] = *(const bf16x8*)(As + r * 128 + (((2 * kk + fh) ^ (r & 7)) << 4)); }
#pragma unroll
                for (int j = 0; j < 2; ++j) { const int r = wn + 32 * j + fr; b[j] = *(const bf16x8*)(Bs + r * 128 + (((2 * kk + fh) ^ (r & 7)) << 4)); }
#pragma unroll
                for (int i = 0; i < 2; ++i)
#pragma unroll
                    for (int j = 0; j < 2; ++j) acc[i][j] = __builtin_amdgcn_mfma_f32_32x32x16_bf16(b[j], a[i], acc[i][j], 0, 0, 0);
            }
            asm volatile("s_waitcnt vmcnt(0)" ::: "memory");
            __syncthreads();
        }
#undef G3_ISSUE
#pragma unroll
        for (int i = 0; i < 2; ++i)
#pragma unroll
            for (int j = 0; j < 2; ++j)
#pragma unroll
                for (int g = 0; g < 4; ++g)
                    epi.store4(tm * 128 + wm + 32 * i + fr, tn * 128 + wn + 32 * j + 8 * g + 4 * fh, acc[i][j][4 * g], acc[i][j][4 * g + 1], acc[i][j][4 * g + 2], acc[i][j][4 * g + 3]);
    }
}
__device__ __forceinline__ bool g3_next(int& it, int nit, int nfull, int rpt, int xg, int lb, int nlb, int S, int nST, int nSn, int TMS, int ntm, int ntn, bool skipctx, int& tm, int& tn) {
    while (it < nit) {
        const int i_ = it++;
        int st, t;
        if (i_ < (nfull >> 3) * rpt) { st = xg + 8 * (i_ / rpt); t = lb + (i_ % rpt) * nlb; if (t >= S) continue; }
        else { const int g = (int)blockIdx.x + (i_ - (nfull >> 3) * rpt) * (int)gridDim.x; if (g >= (nST - nfull) * S) continue; st = nfull + g / S; t = g % S; }
        const int tm_ = (st / nSn) * TMS + t % TMS, tn_ = (st % nSn) * (S / TMS) + t / TMS;
        if (tm_ >= ntm || tn_ >= ntn) continue;
        if (skipctx && ((tm_ * 128) % LTOT) < CTX) continue;
        tm = tm_; tn = tn_;
        return true;
    }
    return false;
}
template <class EPI>
__device__ __forceinline__ void gemm3_i8(const unsigned char* A, int lda, const unsigned char* Bt, int ldb, int M, int N, int K, bool skipctx, EPI epi, unsigned char* smem, int TMS, int TNS) {
    const int tid = otid(), lane = tid & 63, wave = __builtin_amdgcn_readfirstlane(tid >> 6);
    const int ntm = M / 128, ntn = N / 128, nkt = K / 128;
    const int wm = (wave >> 1) * 64, wn = (wave & 1) * 64;
    const int fr = lane & 31, fh = lane >> 5;
    const int rr = lane >> 3, cc = lane & 7;
    const int gcol = (cc ^ rr) * 16;
    const int nSm = (ntm + TMS - 1) / TMS, nSn = (ntn + TNS - 1) / TNS, S = TMS * TNS;
    const int xg = blockIdx.x & 7, lb = blockIdx.x >> 3, nlb = gridDim.x >> 3;
    const int nST = nSm * nSn, nfull = nST & ~7, rpt = (S + nlb - 1) / nlb;
    const int nit = (nfull >> 3) * rpt + ((nST - nfull) * S + (int)gridDim.x - 1) / (int)gridDim.x;
#define G3_ISSUE(ag_, bg_, kt_, b_) { unsigned char* la_ = smem + (b_) * 32768 + (32 * wave) * 128; unsigned char* lb_ = la_ + 16384; \
            _Pragma("unroll") for (int q = 0; q < 4; ++q) { \
                __builtin_amdgcn_global_load_lds((const unsigned*)((ag_) + (size_t)(8 * q) * lda + (kt_) * 128), (LAS unsigned*)(la_ + q * 1024), 16, 0, 0); \
                __builtin_amdgcn_global_load_lds((const unsigned*)((bg_) + (size_t)(8 * q) * ldb + (kt_) * 128), (LAS unsigned*)(lb_ + q * 1024), 16, 0, 0); } }
    int it = 0, tm = 0, tn = 0;
    bool have = g3_next(it, nit, nfull, rpt, xg, lb, nlb, S, nST, nSn, TMS, ntm, ntn, skipctx, tm, tn);
    const unsigned char* ag = A + (size_t)(tm * 128 + 32 * wave + rr) * lda + gcol;
    const unsigned char* bg = Bt + (size_t)(tn * 128 + 32 * wave + rr) * ldb + gcol;
    __syncthreads();
    if (have) G3_ISSUE(ag, bg, 0, 0)
    while (have) {
        i32x16 acc[2][2];
        {
            const i32x16 z16 = {0, 0, 0, 0, 0, 0, 0, 0, 0, 0, 0, 0, 0, 0, 0, 0};
            acc[0][0] = z16; acc[0][1] = z16; acc[1][0] = z16; acc[1][1] = z16;
        }
        asm volatile("s_waitcnt vmcnt(0)" ::: "memory");
        __syncthreads();
        for (int kt = 0; kt < nkt; ++kt) {
            if (kt + 1 < nkt) G3_ISSUE(ag, bg, kt + 1, (kt + 1) & 1)
            const unsigned char* As = smem + (kt & 1) * 32768;
            const unsigned char* Bs = As + 16384;
#pragma unroll
            for (int kk = 0; kk < 4; ++kk) {
                i32x4 a[2], b[2];
#pragma unroll
                for (int i = 0; i < 2; ++i) { const int r = wm + 32 * i + fr; a[i] = *(const i32x4*)(As + r * 128 + (((2 * kk + fh) ^ (r & 7)) << 4)); }
#pragma unroll
                for (int j = 0; j < 2; ++j) { const int r = wn + 32 * j + fr; b[j] = *(const i32x4*)(Bs + r * 128 + (((2 * kk + fh) ^ (r & 7)) << 4)); }
#pragma unroll
                for (int i = 0; i < 2; ++i)
#pragma unroll
                    for (int j = 0; j < 2; ++j) acc[i][j] = EPI::ROWS_IN_REGS ? __builtin_amdgcn_mfma_i32_32x32x32_i8(a[i], b[j], acc[i][j], 0, 0, 0) : __builtin_amdgcn_mfma_i32_32x32x32_i8(b[j], a[i], acc[i][j], 0, 0, 0);
            }
            asm volatile("s_waitcnt vmcnt(0)" ::: "memory");
            __syncthreads();
        }
        int tm2 = 0, tn2 = 0;
        const bool have2 = g3_next(it, nit, nfull, rpt, xg, lb, nlb, S, nST, nSn, TMS, ntm, ntn, skipctx, tm2, tn2);
        const unsigned char* ag2 = A + (size_t)(tm2 * 128 + 32 * wave + rr) * lda + gcol;
        const unsigned char* bg2 = Bt + (size_t)(tn2 * 128 + 32 * wave + rr) * ldb + gcol;
        if (have2) G3_ISSUE(ag2, bg2, 0, 0)
        if (EPI::ROWS_IN_REGS) {
#pragma unroll
            for (int i = 0; i < 2; ++i)
#pragma unroll
                for (int j = 0; j < 2; ++j)
#pragma unroll
                    for (int q = 0; q < 16; ++q)
                        epi.store1(tm * 128 + wm + 32 * i + (q & 3) + 8 * (q >> 2) + 4 * fh, tn * 128 + wn + 32 * j + fr, (float)acc[i][j][q]);
        } else
#pragma unroll
        for (int i = 0; i < 2; ++i)
#pragma unroll
            for (int j = 0; j < 2; ++j)
#pragma unroll
                for (int g = 0; g < 4; ++g)
                    epi.store4(tm * 128 + wm + 32 * i + fr, tn * 128 + wn + 32 * j + 8 * g + 4 * fh, (float)acc[i][j][4 * g], (float)acc[i][j][4 * g + 1], (float)acc[i][j][4 * g + 2], (float)acc[i][j][4 * g + 3]);
        tm = tm2; tn = tn2; ag = ag2; bg = bg2; have = have2;
    }
#undef G3_ISSUE
}
struct Epi4Bf16 { bf16_t* C; int ldc;
    __device__ __forceinline__ void store4(int r, int c, float v0, float v1, float v2, float v3) const {
        *(uint2*)(C + (size_t)r * ldc + c) = make_uint2(f2bf(v0) | ((unsigned)f2bf(v1) << 16), f2bf(v2) | ((unsigned)f2bf(v3) << 16)); } };
struct Epi4F32 { float* C; int ldc;
    __device__ __forceinline__ void store4(int r, int c, float v0, float v1, float v2, float v3) const { *(f32x4*)(C + (size_t)r * ldc + c) = (f32x4){v0, v1, v2, v3}; } };
struct Epi4Q8 { bf16_t* C; int ldc; const float* rs; const float* cs;
    static constexpr bool ROWS_IN_REGS = true;
    __device__ __forceinline__ void store1(int r, int c, float v) const { C[(size_t)r * ldc + c] = f2bf(v * rs[r] * cs[c]); }
    __device__ __forceinline__ void store4(int r, int c, float v0, float v1, float v2, float v3) const {
        const float a = rs[r]; const f32x4 b = *(const f32x4*)(cs + c);
        *(uint2*)(C + (size_t)r * ldc + c) = make_uint2(pk2bf(v0 * a * b[0], v1 * a * b[1]), pk2bf(v2 * a * b[2], v3 * a * b[3])); } };
struct Epi4Inproj { bf16_t* C; const float* lbt; bf16_t* hgt;
    __device__ __forceinline__ float tr(int c, float v) const {
        if (c >= 256 && c < 1536) {
            if (c < 512 || c >= 1280) v = siluf_(v);
            else if (c >= 768) { const float lb = lbt[c - 768]; v = __logf(lb + (1.f - lb) * sigmoidf_(v)); }
        }
        return v;
    }
    __device__ __forceinline__ void store4(int r, int c, float v0, float v1, float v2, float v3) const {
        v0 = tr(c, v0); v1 = tr(c + 1, v1); v2 = tr(c + 2, v2); v3 = tr(c + 3, v3);
        if (c >= 256 && c < 1280) {
            const int e = c - 256, f = e >> 8, hd = (e >> 6) & 3, ch = e & 63;
            bf16_t* d = hgt + ((((size_t)(r >> 4) * 4 + hd) * 4 + f) * 64 + ch) * 16 + (r & 15);
            d[0] = f2bf(v0); d[16] = f2bf(v1); d[32] = f2bf(v2); d[48] = f2bf(v3);
        } else
            *(uint2*)(C + (size_t)r * PIN + c) = make_uint2(pk2bf(v0, v1), pk2bf(v2, v3));
    } };
struct Epi4Inproj8 { bf16_t* C; const float* lbt; bf16_t* hgt; const float* rs; const float* cs;
    static constexpr bool ROWS_IN_REGS = false;
    __device__ __forceinline__ void store1(int, int, float) const {}
    __device__ __forceinline__ float tr(int c, float v) const {
        if (c >= 256 && c < 1536) {
            if (c < 512 || c >= 1280) v = siluf_(v);
            else if (c >= 768) { const float lb = lbt[c - 768]; v = __logf(lb + (1.f - lb) * sigmoidf_(v)); }
        }
        return v;
    }
    __device__ __forceinline__ void store4(int r, int c, float v0, float v1, float v2, float v3) const {
        { const float a = rs[r]; const f32x4 b = *(const f32x4*)(cs + c); v0 *= a * b[0]; v1 *= a * b[1]; v2 *= a * b[2]; v3 *= a * b[3]; }
        v0 = tr(c, v0); v1 = tr(c + 1, v1); v2 = tr(c + 2, v2); v3 = tr(c + 3, v3);
        if (c >= 256 && c < 1280) {
            const int e = c - 256, f = e >> 8, hd = (e >> 6) & 3, ch = e & 63;
            bf16_t* d = hgt + ((((size_t)(r >> 4) * 4 + hd) * 4 + f) * 64 + ch) * 16 + (r & 15);
            d[0] = f2bf(v0); d[16] = f2bf(v1); d[32] = f2bf(v2); d[48] = f2bf(v3);
        } else
            *(uint2*)(C + (size_t)r * PIN + c) = make_uint2(pk2bf(v0, v1), pk2bf(v2, v3));
    } };
struct EpiInproj {
    bf16_t* C; const float* lbt;
    __device__ __forceinline__ void operator()(int r, int c, float v) const {
        if (c >= 256 && c < 1536) {
            if (c < 512 || c >= 1280) v = siluf_(v);
            else if (c >= 768) { const float lb = lbt[c - 768]; v = __logf(lb + (1.f - lb) * sigmoidf_(v)); }
        }
        C[(size_t)r * PIN + c] = f2bf(v);
    }
};
struct EpiBf16 { bf16_t* C; int ldc; __device__ __forceinline__ void operator()(int r, int c, float v) const { C[(size_t)r * ldc + c] = f2bf(v); } };
struct EpiF32 { float* C; int ldc; __device__ __forceinline__ void operator()(int r, int c, float v) const { C[(size_t)r * ldc + c] = v; } };

__device__ __forceinline__ void phase_rwprep(const Params& P, int l, unsigned char* smem) {
    const int tid = otid();
    const bf16_t* Pb = (const bf16_t*)(P.ws + OFF_P);
    bf16_t* RW = (bf16_t*)(P.ws + OFF_RW);
    const float* mu = P.in[24] + l * 1920;
    const float* k_k = P.in[30] + l * 512;
    float* tw = (float*)smem;
    float* al = tw + 2 * 8 * 64;
    float* kk2 = al + 2 * 8 * 64;
    float* nrm = kk2 + 8 * 512;
    for (int u = blockIdx.x; u < MROWS / 8; u += gridDim.x) {
        const int r0 = u * 8;
        __syncthreads();
        for (int i = 0; i < 8; ++i) {
            const int row = r0 + i, p = row % LTOT;
            int nb[4]; bool ok[4];
            if (p < CTX) {
                nb[0] = row - 1; ok[0] = p > 0; nb[1] = row + 1; ok[1] = p < CTX - 1; nb[2] = nb[0]; ok[2] = ok[0]; nb[3] = nb[1]; ok[3] = ok[1];
            } else {
                const int t = p - CTX, gr = t >> 6, gc = t & 63;
                nb[0] = row - 1; ok[0] = gc > 0; nb[1] = row + 1; ok[1] = gc < 63; nb[2] = row - 64; ok[2] = gr > 0; nb[3] = row + 64; ok[3] = gr < 63;
            }
            for (int c = tid; c < 1920; c += 256) {
                const int m = c & 3;
                const float pv = bf2f(Pb[(size_t)row * PIN + 1536 + c]);
                const float nv = ok[m] ? bf2f(Pb[(size_t)nb[m] * PIN + 1536 + c]) : 0.f;
                const float s = pv + mu[c] * (nv - pv);
                bf16_t* rw = RW + (size_t)row * RWW;
                if (c < 512) rw[c] = f2bf(s);
                else if (c < 1024) { rw[c] = f2bf(s); kk2[i * 512 + (c - 512)] = s * k_k[c - 512]; }
                else if (c < 1536) rw[c] = f2bf(s);
                else if (c < 1664) rw[4096 + (c - 1536)] = f2bf(sigmoidf_(s));
                else if (c < 1728) tw[(0 * 8 + i) * 64 + (c - 1664)] = tanhf(s);
                else if (c < 1792) tw[(1 * 8 + i) * 64 + (c - 1728)] = tanhf(s);
                else if (c < 1856) al[(0 * 8 + i) * 64 + (c - 1792)] = s;
                else al[(1 * 8 + i) * 64 + (c - 1856)] = s;
            }
        }
        __syncthreads();
        {
            const int pair = tid >> 2, q = tid & 3, i = pair >> 3, hd = pair & 7;
            float s = 0.f;
            for (int j = 0; j < 16; ++j) { const float v = kk2[i * 512 + hd * 64 + q * 16 + j]; s += v * v; }
            s += __shfl_xor(s, 1, 64); s += __shfl_xor(s, 2, 64);
            if (q == 0) nrm[pair] = fmaxf(sqrtf(s), 1e-12f);
        }
        __syncthreads();
        for (int e = tid; e < 8 * 512; e += 256) {
            const int i = e >> 9, c = e & 511;
            RW[(size_t)(r0 + i) * RWW + 1536 + c] = f2bf(kk2[e] / nrm[i * 8 + (c >> 6)]);
        }
        for (int d = 0; d < 2; ++d) {
            const float* wup = P.in[26] + (size_t)(l * 2 + d) * 64 * 512;
            const float* aup = P.in[28] + (size_t)(l * 2 + d) * 64 * 512;
            const float* w0 = P.in[25] + (l * 2 + d) * 512;
            const float* a0 = P.in[27] + (l * 2 + d) * 512;
            float zw[2][8], za[2][8];
#pragma unroll
            for (int i = 0; i < 8; ++i) { zw[0][i] = zw[1][i] = za[0][i] = za[1][i] = 0.f; }
            for (int j = 0; j < 64; ++j) {
                const float w_0 = wup[j * 512 + tid], w_1 = wup[j * 512 + tid + 256];
                const float a_0 = aup[j * 512 + tid], a_1 = aup[j * 512 + tid + 256];
#pragma unroll
                for (int i = 0; i < 8; ++i) {
                    const float t = tw[(d * 8 + i) * 64 + j], a = al[(d * 8 + i) * 64 + j];
                    zw[0][i] += t * w_0; zw[1][i] += t * w_1; za[0][i] += a * a_0; za[1][i] += a * a_1;
                }
            }
#pragma unroll
            for (int i = 0; i < 8; ++i) {
                bf16_t* rw = RW + (size_t)(r0 + i) * RWW;
#pragma unroll
                for (int h = 0; h < 2; ++h) {
                    const int c = tid + 256 * h;
                    rw[2048 + d * 512 + c] = f2bf(sigmoidf_(a0[c] + za[h][i]));
                    rw[3072 + d * 512 + c] = f2bf(-0.60653066f * sigmoidf_(w0[c] + zw[h][i]));
                }
            }
        }
    }
}

__device__ __forceinline__ void scan_rwkv(const Params& P, int l, int item) {
    const int lane = otid() & 63;
    const int dir = item & 1, hd = (item >> 1) & 7, b = item >> 4;
    const bf16_t* RW = (const bf16_t*)(P.ws + OFF_RW);
    bf16_t* YP = (bf16_t*)(P.ws + OFF_YP) + (size_t)dir * MROWS * DM;
    const float ka = P.in[31][l * 512 + hd * 64 + lane];
    float S[64];
#pragma unroll
    for (int k = 0; k < 64; ++k) S[k] = 0.f;
    for (int tau = 0; tau < LTOT; ++tau) {
        const int row = row_of(b, dir, tau);
#ifdef EXP_T2
        if ((tau & 127) == 0) {
            float* RXL = (float*)(P.ws + OFF_RXL);
            const size_t itm = (size_t)item * 34 + (tau >> 7);
#pragma unroll
            for (int kk = 0; kk < 64; ++kk) RXL[((itm * 16 + (kk >> 4) * 4 + (lane >> 4)) * 64 + ((kk >> 2) & 3) * 16 + (lane & 15)) * 4 + (kk & 3)] = S[kk];
        }
#endif
        const bf16_t* rw = RW + (size_t)row * RWW + hd * 64 + lane;
        const float r = bf2f(rw[0]), k = bf2f(rw[512]), v = bf2f(rw[1024]), kap = bf2f(rw[1536]);
        const float a = bf2f(rw[2048 + dir * 512]), lw = bf2f(rw[3072 + dir * 512]);
        const float w = __expf(lw), kt = k * (1.f + (a - 1.f) * ka), beta = kap * a;
        float sk = 0.f;
#pragma unroll
        for (int kk = 0; kk < 64; ++kk) { sk += S[kk] * rdlane(kap, kk); if ((kk & 7) == 7) __builtin_amdgcn_sched_barrier(0); }
        float y = 0.f;
#pragma unroll
        for (int kk = 0; kk < 64; ++kk) {
            const float s = S[kk] * rdlane(w, kk) - sk * rdlane(beta, kk) + v * rdlane(kt, kk);
            S[kk] = s;
            y += s * rdlane(r, kk);
            if ((kk & 3) == 3) __builtin_amdgcn_sched_barrier(0);
        }
        YP[(size_t)row * DM + 512 + hd * 64 + lane] = f2bf(y);
    }
}
__device__ __forceinline__ void scan_hgrn(const Params& P, int l, int item) {
    const int lane = otid() & 63;
    const int dir = item & 1, hd = (item >> 1) & 3, b = item >> 3;
    const bf16_t* Pb = (const bf16_t*)(P.ws + OFF_P);
    bf16_t* YP = (bf16_t*)(P.ws + OFF_YP) + (size_t)dir * MROWS * DM;
    float lb = 0.f;
    if (l == 1) {
        const float a0 = P.in[22][(dir * 2 + 0) * 256 + hd * 64 + lane], a1 = P.in[22][(dir * 2 + 1) * 256 + hd * 64 + lane];
        const float m = fmaxf(a0, a1), e0 = __expf(a0 - m), e1 = __expf(a1 - m);
        lb = e1 / (e0 + e1);
    }
    float S[64];
#pragma unroll
    for (int k = 0; k < 64; ++k) S[k] = 0.f;
    for (int tau = 0; tau < LTOT; ++tau) {
        const int row = row_of(b, dir, tau);
        const bf16_t* pr = Pb + (size_t)row * PIN + 256 + hd * 64 + lane;
        const float q = siluf_(bf2f(pr[0])), v = bf2f(pr[256]);
        const float f = lb + (1.f - lb) * sigmoidf_(bf2f(pr[512 + dir * 256]));
        const float kq = 1.f - f;
        float o = 0.f;
#pragma unroll
        for (int dk = 0; dk < 64; ++dk) {
            const float s = rdlane(f, dk) * S[dk] + rdlane(kq, dk) * v;
            S[dk] = s;
            o += s * rdlane(q, dk);
            if ((dk & 7) == 7) __builtin_amdgcn_sched_barrier(0);
        }
        YP[(size_t)row * DM + 256 + hd * 64 + lane] = f2bf(o);
    }
}
__device__ __forceinline__ void scan_s5(const Params& P, int l, int item) {
    const int lane = otid() & 63;
    const int dir = item & 1, g = (item >> 1) & 15, b = item >> 5;
    const bf16_t* Pb = (const bf16_t*)(P.ws + OFF_P);
    bf16_t* YP = (bf16_t*)(P.ws + OFF_YP) + (size_t)dir * MROWS * DM;
    const int ldg = (l * 2 + dir) * 16 + g;
    const float dt = expf(P.in[14][ldg]);
    const float lre = P.in[12][ldg * 64 + lane], lim = P.in[13][ldg * 64 + lane];
    const float mag = expf(lre * dt), ang = lim * dt;
    const float lb_re = mag * cosf(ang), lb_im = mag * sinf(ang);
    const float den = lre * lre + lim * lim, nr = lb_re - 1.f, ni = lb_im;
    const float co_re = (nr * lre + ni * lim) / den, co_im = (ni * lre - nr * lim) / den;
    float bb_re[16], bb_im[16], c_re[16], c_im[16];
#pragma unroll
    for (int h = 0; h < 16; ++h) {
        const float br = P.in[15][((size_t)ldg * 64 + lane) * 16 + h], bi = P.in[16][((size_t)ldg * 64 + lane) * 16 + h];
        bb_re[h] = co_re * br - co_im * bi; bb_im[h] = co_re * bi + co_im * br;
        c_re[h] = P.in[17][((size_t)ldg * 16 + h) * 64 + lane]; c_im[h] = P.in[18][((size_t)ldg * 16 + h) * 64 + lane];
    }
    float s_re = 0.f, s_im = 0.f;
    for (int tau = 0; tau < LTOT; ++tau) {
        const int row = row_of(b, dir, tau);
        const float uv = bf2f(Pb[(size_t)row * PIN + g * 16 + (lane & 15)]);
        float bu_re = 0.f, bu_im = 0.f;
#pragma unroll
        for (int h = 0; h < 16; ++h) { const float uh = rdlane(uv, h); bu_re += bb_re[h] * uh; bu_im += bb_im[h] * uh; }
        const float n_re = lb_re * s_re - lb_im * s_im + bu_re, n_im = lb_re * s_im + lb_im * s_re + bu_im;
        s_re = n_re; s_im = n_im;
        float yo = 0.f;
#pragma unroll
        for (int h = 0; h < 16; ++h) { const float t = wave_sum(c_re[h] * s_re - c_im[h] * s_im); yo = (lane == h) ? t : yo; }
        if (lane < 16) YP[(size_t)row * DM + g * 16 + lane] = f2bf(yo);
    }
}
__device__ __forceinline__ void phase_scans(const Params& P, int l) {
    const int wave = __builtin_amdgcn_readfirstlane(otid() >> 6);
    for (int it = wave * gridDim.x + blockIdx.x; it < 32; it += 4 * gridDim.x) scan_hgrn(P, l, it);
}

__device__ __forceinline__ void phase_post(const Params& P, int l, unsigned char* smem) {
    const int tid = otid();
    const bf16_t* Pb = (const bf16_t*)(P.ws + OFF_P);
    const bf16_t* RW = (const bf16_t*)(P.ws + OFF_RW);
    const bf16_t* YF = (const bf16_t*)(P.ws + OFF_YP);
    const bf16_t* YB = YF + (size_t)MROWS * DM;
    bf16_t* MIX = (bf16_t*)(P.ws + OFF_MIX);
    float* ypre = (float*)smem;
    float* sg = ypre + 8 * 256;
    for (int u = blockIdx.x; u < MROWS / 8; u += gridDim.x) {
        const int r0 = u * 8;
        if (l == 1 && (r0 % LTOT) < CTX) continue;
        __syncthreads();
        for (int i = 0; i < 8; ++i) {
            const int row = r0 + i;
            ypre[i * 256 + tid] = bf2f(YF[(size_t)row * DM + tid]);
        }
        for (int e = tid; e < 8 * 128; e += 256) sg[e] = bf2f(RW[(size_t)(r0 + (e >> 7)) * RWW + 4096 + (e & 127)]);
        __syncthreads();
        {
            float z[8];
            const float gb = P.in[21][l * 256 + tid];
#pragma unroll
            for (int i = 0; i < 8; ++i) z[i] = gb;
            const float* gw = P.in[20] + (size_t)l * 256 * 256 + tid;
            for (int k = 0; k < 256; ++k) {
                const float w = gw[k * 256];
#pragma unroll
                for (int i = 0; i < 8; ++i) z[i] += ypre[i * 256 + k] * w;
            }
#pragma unroll
            for (int i = 0; i < 8; ++i) MIX[(size_t)(r0 + i) * DM + tid] = f2bf(ypre[i * 256 + tid] * sigmoidf_(z[i]));
        }
        {
            const int i = tid >> 5, c0 = (tid & 31) * 8, row = r0 + i;
            float o[8], ss = 0.f;
#pragma unroll
            for (int j = 0; j < 8; ++j) { o[j] = bf2f(YF[(size_t)row * DM + 256 + c0 + j]) + bf2f(YB[(size_t)row * DM + 256 + c0 + j]); ss += o[j] * o[j]; }
            ss += __shfl_xor(ss, 1, 64); ss += __shfl_xor(ss, 2, 64); ss += __shfl_xor(ss, 4, 64);
            const float rs = rsqrtf(ss * (1.f / 64.f) + 1e-6f);
#pragma unroll
            for (int j = 0; j < 8; ++j) {
                const float gr = bf2f(Pb[(size_t)row * PIN + 256 + 1024 + c0 + j]);
                MIX[(size_t)row * DM + 256 + c0 + j] = f2bf(o[j] * rs * P.in[23][l * 256 + c0 + j] * siluf_(gr));
            }
        }
        {
            const int i = tid >> 5, c0 = (tid & 31) * 16, row = r0 + i;
            const bf16_t* rw = RW + (size_t)row * RWW;
            float y[16], vv[16], sum = 0.f, bon = 0.f;
#pragma unroll
            for (int j = 0; j < 16; ++j) {
                const int c = c0 + j;
                y[j] = bf2f(YF[(size_t)row * DM + 512 + c]) + bf2f(YB[(size_t)row * DM + 512 + c]);
                sum += y[j];
                const float r = bf2f(rw[c]), k = bf2f(rw[512 + c]), af = bf2f(rw[2048 + c]), ab = bf2f(rw[2560 + c]);
                const float ka = P.in[31][l * 512 + c];
                vv[j] = bf2f(rw[1024 + c]);
                bon += r * P.in[32][l * 512 + c] * (k * (1.f + (af - 1.f) * ka) + k * (1.f + (ab - 1.f) * ka));
            }
            sum += __shfl_xor(sum, 1, 64); sum += __shfl_xor(sum, 2, 64);
            bon += __shfl_xor(bon, 1, 64); bon += __shfl_xor(bon, 2, 64);
            const float mean = sum * (1.f / 64.f);
            float var = 0.f;
#pragma unroll
            for (int j = 0; j < 16; ++j) { const float d = y[j] - mean; var += d * d; }
            var += __shfl_xor(var, 1, 64); var += __shfl_xor(var, 2, 64);
            const float rs = rsqrtf(var * (1.f / 64.f) + 64e-5f);
            float g[16];
#pragma unroll
            for (int j = 0; j < 16; ++j) g[j] = 0.f;
            const float* gup = P.in[29] + (size_t)l * 128 * 512 + c0;
            for (int jj = 0; jj < 128; ++jj) {
                const float s = sg[i * 128 + jj];
                const float4 w0 = *(const float4*)(gup + jj * 512), w1 = *(const float4*)(gup + jj * 512 + 4), w2 = *(const float4*)(gup + jj * 512 + 8), w3 = *(const float4*)(gup + jj * 512 + 12);
                g[0] += s * w0.x; g[1] += s * w0.y; g[2] += s * w0.z; g[3] += s * w0.w;
                g[4] += s * w1.x; g[5] += s * w1.y; g[6] += s * w1.z; g[7] += s * w1.w;
                g[8] += s * w2.x; g[9] += s * w2.y; g[10] += s * w2.z; g[11] += s * w2.w;
                g[12] += s * w3.x; g[13] += s * w3.y; g[14] += s * w3.z; g[15] += s * w3.w;
            }
#pragma unroll
            for (int j = 0; j < 16; ++j) {
                const int c = c0 + j;
                const float yn = (y[j] - mean) * rs * P.in[33][l * 512 + c] + P.in[34][l * 512 + c];
                MIX[(size_t)row * DM + 512 + c] = f2bf((yn + bon * vv[j]) * g[j]);
            }
        }
    }
}

__device__ __forceinline__ void phase_ln1(const Params& P, int l) {
    const int lane = otid() & 63, wave = __builtin_amdgcn_readfirstlane(otid() >> 6);
    float* XS = (float*)(P.ws + OFF_XS);
    const float* TMP = (const float*)(P.ws + OFF_TMP);
    const float* MOD = (const float*)(P.ws + OFF_MOD);
    unsigned char* H8 = P.ws + OFF_H8; float* HS = (float*)(P.ws + OFF_HS);
    for (int row = blockIdx.x * 4 + wave; row < MROWS; row += gridDim.x * 4) {
        if (l == 1 && (row % LTOT) < CTX) continue;
        const float* mod = MOD + (size_t)(l * 5 + modrow(row)) * 6144;
        float v[16]; float s = 0.f;
#pragma unroll
        for (int j = 0; j < 4; ++j) {
            const int d = 256 * j + 4 * lane;
            const float4 x = *(const float4*)((l == 0 ? xin_row(P, row) : XS + (size_t)row * DM) + d), t = *(const float4*)(TMP + (size_t)row * DM + d), g = *(const float4*)(mod + 2048 + d);
            v[4 * j + 0] = ALPHA * x.x + g.x * t.x; v[4 * j + 1] = ALPHA * x.y + g.y * t.y; v[4 * j + 2] = ALPHA * x.z + g.z * t.z; v[4 * j + 3] = ALPHA * x.w + g.w * t.w;
            s += v[4 * j] + v[4 * j + 1] + v[4 * j + 2] + v[4 * j + 3];
        }
        const float mean = wave_sum(s) * (1.f / 1024.f);
        float q = 0.f;
#pragma unroll
        for (int j = 0; j < 16; ++j) { const float d = v[j] - mean; q += d * d; }
        const float rs = rsqrtf(wave_sum(q) * (1.f / 1024.f) + 1e-5f);
#pragma unroll
        for (int j = 0; j < 4; ++j) {
            const int d = 256 * j + 4 * lane;
            const float4 gg = *(const float4*)(P.in[8] + l * 1024 + d), bb = *(const float4*)(P.in[9] + l * 1024 + d);
            const float4 sh = *(const float4*)(mod + 3072 + d), sc = *(const float4*)(mod + 4096 + d);
            float4 o;
            o.x = (v[4 * j + 0] - mean) * rs * gg.x + bb.x; o.y = (v[4 * j + 1] - mean) * rs * gg.y + bb.y;
            o.z = (v[4 * j + 2] - mean) * rs * gg.z + bb.z; o.w = (v[4 * j + 3] - mean) * rs * gg.w + bb.w;
            *(float4*)(XS + (size_t)row * DM + d) = o;
            ushort4 h;
            h.x = f2bf(o.x * (1.f + sc.x) + sh.x); h.y = f2bf(o.y * (1.f + sc.y) + sh.y); h.z = f2bf(o.z * (1.f + sc.z) + sh.z); h.w = f2bf(o.w * (1.f + sc.w) + sh.w);
            v[4 * j + 0] = __uint_as_float((unsigned)h.x << 16); v[4 * j + 1] = __uint_as_float((unsigned)h.y << 16); v[4 * j + 2] = __uint_as_float((unsigned)h.z << 16); v[4 * j + 3] = __uint_as_float((unsigned)h.w << 16);
        }
        float am = 0.f;
#pragma unroll
        for (int j = 0; j < 16; ++j) am = fmaxf(am, fabsf(v[j]));
#pragma unroll
        for (int o = 32; o > 0; o >>= 1) am = fmaxf(am, __shfl_xor(am, o, 64));
        const float hs = am > 0.f ? 127.f / am : 1.f;
#pragma unroll
        for (int j = 0; j < 4; ++j)
            *(unsigned*)(H8 + (size_t)row * DM + 256 * j + 4 * lane) = ((unsigned)__float2int_rn(v[4 * j] * hs) & 0xFFu) | (((unsigned)__float2int_rn(v[4 * j + 1] * hs) & 0xFFu) << 8) | (((unsigned)__float2int_rn(v[4 * j + 2] * hs) & 0xFFu) << 16) | (((unsigned)__float2int_rn(v[4 * j + 3] * hs) & 0xFFu) << 24);
        if (lane == 0) HS[row] = am * (1.f / 127.f);
    }
}

__device__ __forceinline__ unsigned f2ord(float f) { const unsigned u = __float_as_uint(f); return u ^ ((u >> 31) ? 0xFFFFFFFFu : 0x80000000u); }
__device__ __forceinline__ float ord2f(unsigned u) { return __uint_as_float((u >> 31) ? (u ^ 0x80000000u) : ~u); }
__device__ __forceinline__ void phase_topk(const Params& P, int l) {
    const int tid = otid();
    const bf16_t* Q = (const bf16_t*)(P.ws + OFF_Q);
    int* IDX = (int*)(P.ws + OFF_IDX);
    float* GATE = (float*)(P.ws + OFF_GATE);
    for (int u = blockIdx.x; u < 8 * (MROWS / 256); u += gridDim.x) {
        const int hd = u / (MROWS / 256), rb = u % (MROWS / 256);
        const int row = rb * 256 + tid;
        if (l == 1 && (row % LTOT) < CTX) continue;
        unsigned top[2][16];
#pragma unroll
        for (int half = 0; half < 2; ++half) {
            float q[128];
            const bf16_t* qp = Q + (size_t)row * 2048 + hd * 256 + half * 128;
#pragma unroll
            for (int d8 = 0; d8 < 16; ++d8) {
                const bf16x8 v = *(const bf16x8*)(qp + d8 * 8);
#pragma unroll
                for (int j = 0; j < 8; ++j) q[d8 * 8 + j] = bf2f((bf16_t)v[j]);
            }
#pragma unroll
            for (int j = 0; j < 16; ++j) top[half][j] = 0u;
            const float* kp = P.in[36] + ((size_t)((l * 8 + hd) * 2 + half)) * 128 * 128;
            for (int key = 0; key < 128; ++key) {
                const float* kr = kp + key * 128;
                float s0 = 0.f, s1 = 0.f, s2 = 0.f, s3 = 0.f;
#pragma unroll
                for (int d = 0; d < 128; d += 4) { s0 += q[d] * kr[d]; s1 += q[d + 1] * kr[d + 1]; s2 += q[d + 2] * kr[d + 2]; s3 += q[d + 3] * kr[d + 3]; if ((d & 31) == 28) __builtin_amdgcn_sched_barrier(0); }
                unsigned x = (f2ord((s0 + s1) + (s2 + s3)) & 0xFFFFFF80u) | (unsigned)(127 - key);
#pragma unroll
                for (int j = 0; j < 16; ++j) { const unsigned t = top[half][j]; const unsigned mx = x > t ? x : t; x = x > t ? t : x; top[half][j] = mx; }
            }
        }
        float cs[16]; int ce[16];
#pragma unroll
        for (int j = 0; j < 16; ++j) { cs[j] = -3.0e38f; ce[j] = 0; }
#pragma unroll
        for (int i = 0; i < 16; ++i) {
            const float s1v = ord2f(top[0][i] & 0xFFFFFF80u); const int i1 = 127 - (int)(top[0][i] & 127u);
#pragma unroll
            for (int j = 0; j < 16; ++j) {
                if ((i + 1) * (j + 1) <= 16) {
                    float x = s1v + ord2f(top[1][j] & 0xFFFFFF80u); int xe = i1 * 128 + (127 - (int)(top[1][j] & 127u));
#pragma unroll
                    for (int t = 0; t < 16; ++t) {
                        const bool gt = x > cs[t];
                        const float ts = cs[t]; const int te = ce[t];
                        cs[t] = gt ? x : ts; ce[t] = gt ? xe : te; x = gt ? ts : x; xe = gt ? te : xe;
                    }
                }
            }
        }
        float den = 0.f, ex[16];
#pragma unroll
        for (int t = 0; t < 16; ++t) { ex[t] = __expf(cs[t] - cs[0]); den += ex[t]; }
        const float inv = 1.f / den;
#pragma unroll
        for (int t = 0; t < 16; ++t) { IDX[(size_t)row * 128 + hd * 16 + t] = ce[t]; GATE[(size_t)row * 128 + hd * 16 + t] = ex[t] * inv; }
    }
}


__device__ __forceinline__ void ce_desc(unsigned& a, unsigned& b) { const unsigned hi = a > b ? a : b, lo = a > b ? b : a; a = hi; b = lo; }
__device__ __forceinline__ void bitonic_sort16(unsigned (&u)[16]) {
#pragma unroll
    for (int k = 2; k <= 16; k <<= 1)
#pragma unroll
        for (int j = k >> 1; j > 0; j >>= 1)
#pragma unroll
            for (int i = 0; i < 16; ++i) {
                const int p = i ^ j;
                if (p > i) { if ((i & k) == 0) ce_desc(u[i], u[p]); else ce_desc(u[p], u[i]); }
            }
}
__device__ __forceinline__ void bitonic_merge16(unsigned (&u)[16]) {
#pragma unroll
    for (int j = 8; j > 0; j >>= 1)
#pragma unroll
        for (int i = 0; i < 16; ++i) { const int p = i ^ j; if (p > i) ce_desc(u[i], u[p]); }
}
__device__ __forceinline__ void xlane_top16(unsigned (&u)[16], int xr) {
    unsigned o[16];
#pragma unroll
    for (int i = 0; i < 16; ++i) o[i] = (unsigned)__shfl_xor((int)u[15 - i], xr, 64);
#pragma unroll
    for (int i = 0; i < 16; ++i) u[i] = u[i] > o[i] ? u[i] : o[i];
    bitonic_merge16(u);
}
__device__ __forceinline__ void phase_topk2(const Params& P, int l, unsigned char* smem) {
    const int lane = otid() & 63, wave = __builtin_amdgcn_readfirstlane(otid() >> 6), fr = lane & 15, fq = lane >> 4;
    const bf16_t* Q = (const bf16_t*)(P.ws + OFF_Q);
    const bf16_t* KB = (const bf16_t*)(P.ws + OFF_KEYB);
    int* IDX = (int*)(P.ws + OFF_IDX);
    float* GATE = (float*)(P.ws + OFF_GATE);
    unsigned char* ids = smem + 66560 + wave * 512;
    unsigned char* kst = smem;
    {
        const bf16_t* ksrc = KB + (size_t)((l * 8 + (blockIdx.x & 7)) * 2) * 128 * 128;
        __syncthreads();
#pragma unroll
        for (int q = 0; q < 16; ++q) {
            const int kr = 64 * wave + 4 * q + (lane >> 4);
            __builtin_amdgcn_global_load_lds((const unsigned*)(ksrc + (size_t)kr * 128 + (((lane & 15) ^ (kr & 15)) << 3)), (LAS unsigned*)(kst + (64 * wave + 4 * q) * 256), 16, 0, 0);
        }
        asm volatile("s_waitcnt vmcnt(0)" ::: "memory");
        __syncthreads();
    }
    for (int G = blockIdx.x; G < 8 * (MROWS / 64); G += gridDim.x) {
        const int hd = G & 7, rtq = G >> 3, rt = 4 * rtq + wave, row0 = rt * 16;
        if (l == 1 && ((rtq * 64) % LTOT) < CTX) continue;
        unsigned top[2][16];
#pragma unroll
        for (int half = 0; half < 2; ++half) {
            f32x4 acc[8];
#pragma unroll
            for (int mi = 0; mi < 8; ++mi) acc[mi] = (f32x4){0.f, 0.f, 0.f, 0.f};
            const bf16_t* qp = Q + (size_t)(row0 + fr) * 2048 + hd * 256 + half * 128 + 8 * fq;
            bf16x8 qb[4];
#pragma unroll
            for (int ks = 0; ks < 4; ++ks) qb[ks] = *(const bf16x8*)(qp + 32 * ks);
#pragma unroll
            for (int ks = 0; ks < 4; ++ks) {
#pragma unroll
                for (int mi = 0; mi < 8; ++mi) acc[mi] = mfma32(*(const bf16x8*)(kst + (128 * half + 16 * mi + fr) * 256 + (((4 * ks + fq) ^ fr) << 4)), qb[ks], acc[mi]);
            }
            unsigned ua[16], ub[16];
#pragma unroll
            for (int mi = 0; mi < 4; ++mi)
#pragma unroll
                for (int r = 0; r < 4; ++r) {
                    ua[mi * 4 + r] = (f2ord(acc[mi][r]) & 0xFFFFFF80u) | (unsigned)(127 - (16 * mi + 4 * fq + r));
                    ub[mi * 4 + r] = (f2ord(acc[mi + 4][r]) & 0xFFFFFF80u) | (unsigned)(127 - (16 * (mi + 4) + 4 * fq + r));
                }
            bitonic_sort16(ua); bitonic_sort16(ub);
#pragma unroll
            for (int i = 0; i < 16; ++i) ua[i] = ua[i] > ub[15 - i] ? ua[i] : ub[15 - i];
            bitonic_merge16(ua);
            xlane_top16(ua, 16); xlane_top16(ua, 32);
#pragma unroll
            for (int i = 0; i < 16; ++i) top[half][i] = ua[i];
        }
        if (fq == 0) {
            unsigned w[8];
#pragma unroll
            for (int i = 0; i < 8; ++i) {
                const unsigned* t = i < 4 ? &top[0][4 * i] : &top[1][4 * (i - 4)];
                w[i] = (127u - (t[0] & 127u)) | ((127u - (t[1] & 127u)) << 8) | ((127u - (t[2] & 127u)) << 16) | ((127u - (t[3] & 127u)) << 24);
            }
            *(uint4*)(ids + fr * 32) = make_uint4(w[0], w[1], w[2], w[3]);
            *(uint4*)(ids + fr * 32 + 16) = make_uint4(w[4], w[5], w[6], w[7]);
        }
        float s2v[16];
#pragma unroll
        for (int j = 0; j < 16; ++j) s2v[j] = ord2f(top[1][j] & 0xFFFFFF80u);
        float s1r[4];
#pragma unroll
        for (int m = 0; m < 4; ++m) {
            const unsigned t = fq == 0 ? top[0][4 * m] : (fq == 1 ? top[0][4 * m + 1] : (fq == 2 ? top[0][4 * m + 2] : top[0][4 * m + 3]));
            s1r[m] = ord2f(t & 0xFFFFFF80u);
        }
        unsigned cu[16];
#pragma unroll
        for (int j = 0; j < 16; ++j) cu[j] = (f2ord(s1r[0] + s2v[j]) & 0xFFFFFF00u) | (unsigned)((fq << 4) | j);
        {
            unsigned ex[5];
            ex[0] = (f2ord(s1r[1] + s2v[0]) & 0xFFFFFF00u) | (unsigned)(((4 + fq) << 4) | 0);
            ex[1] = (f2ord(s1r[1] + s2v[1]) & 0xFFFFFF00u) | (unsigned)(((4 + fq) << 4) | 1);
            ex[2] = (f2ord(s1r[1] + s2v[2]) & 0xFFFFFF00u) | (unsigned)(((4 + fq) << 4) | 2);
            ex[3] = (f2ord(s1r[2] + s2v[0]) & 0xFFFFFF00u) | (unsigned)(((8 + fq) << 4) | 0);
            ex[4] = (f2ord(s1r[3] + s2v[0]) & 0xFFFFFF00u) | (unsigned)(((12 + fq) << 4) | 0);
#pragma unroll
            for (int e = 0; e < 5; ++e) {
                unsigned x = ex[e];
#pragma unroll
                for (int t = 0; t < 16; ++t) { const unsigned c = cu[t]; const unsigned mx = x > c ? x : c; x = x > c ? c : x; cu[t] = mx; }
            }
        }
        xlane_top16(cu, 16); xlane_top16(cu, 32);
        if (fq == 0) {
            float ex[16], den = 0.f; int eid[16];
            const float m0 = ord2f(cu[0] & 0xFFFFFF00u);
#pragma unroll
            for (int t = 0; t < 16; ++t) {
                ex[t] = __expf(ord2f(cu[t] & 0xFFFFFF00u) - m0); den += ex[t];
                const int i = (cu[t] >> 4) & 15, j = cu[t] & 15;
                eid[t] = (int)ids[fr * 32 + i] * 128 + (int)ids[fr * 32 + 16 + j];
            }
            const float inv = 1.f / den;
            int* ip = IDX + (size_t)(row0 + fr) * 128 + hd * 16;
            float* gp = GATE + (size_t)(row0 + fr) * 128 + hd * 16;
#pragma unroll
            for (int t = 0; t < 16; t += 4) {
                *(int4*)(ip + t) = make_int4(eid[t], eid[t + 1], eid[t + 2], eid[t + 3]);
                *(float4*)(gp + t) = make_float4(ex[t] * inv, ex[t + 1] * inv, ex[t + 2] * inv, ex[t + 3] * inv);
            }
        }
    }
}

__device__ __forceinline__ void phase_tabconv(const Params& P, int l) {
    const float4* U = (const float4*)(P.in[37] + (size_t)l * 16384 * 1024);
    const float4* V = (const float4*)(P.in[38] + (size_t)l * 16384 * 1024);
    ushort4* TU = (ushort4*)(P.ws + OFF_TBU);
    ushort4* TV = (ushort4*)(P.ws + OFF_TBV);
    const size_t n4 = (size_t)16384 * 256;
    for (size_t i = (size_t)blockIdx.x * 256 + otid(); i < n4; i += (size_t)gridDim.x * 256) {
        const float4 a = U[i], b = V[i];
        ushort4 oa, ob;
        oa.x = f2bf(a.x); oa.y = f2bf(a.y); oa.z = f2bf(a.z); oa.w = f2bf(a.w);
        ob.x = f2bf(b.x); ob.y = f2bf(b.y); ob.z = f2bf(b.z); ob.w = f2bf(b.w);
        TU[i] = oa; TV[i] = ob;
    }
}
__device__ __forceinline__ float dot2bf(unsigned a, unsigned b, float acc) { return __builtin_amdgcn_fdot2_f32_bf16(__builtin_bit_cast(bf16x2, a), __builtin_bit_cast(bf16x2, b), acc, false); }
__device__ __forceinline__ float dot8(const uint4& a, const uint4& b, float acc) { acc = dot2bf(a.x, b.x, acc); acc = dot2bf(a.y, b.y, acc); acc = dot2bf(a.z, b.z, acc); return dot2bf(a.w, b.w, acc); }
__device__ __forceinline__ void phase_gather(const Params& P, int l, unsigned char* smem) {
    const int tid = otid(), lane = tid & 63, wave = __builtin_amdgcn_readfirstlane(tid >> 6);
    float* XS = (float*)(P.ws + OFF_XS);
    const float* MOD = (const float*)(P.ws + OFF_MOD);
    const bf16_t* H2 = (const bf16_t*)(P.ws + OFF_H2);
    bf16_t* H = (bf16_t*)(P.ws + OFF_H);
    const int* IDX = (const int*)(P.ws + OFF_IDX);
    const float* GATE = (const float*)(P.ws + OFF_GATE);
    const bf16_t* TU = (const bf16_t*)(P.ws + OFF_TBU);
    const bf16_t* TV = (const bf16_t*)(P.ws + OFF_TBV);
    float* coef = (float*)smem + wave * 128;
    for (int row = blockIdx.x * 4 + wave; row < MROWS; row += gridDim.x * 4) {
        if (l == 1 && (row % LTOT) < CTX) continue;
        const uint4 h0 = *(const uint4*)(H2 + (size_t)row * DM + 8 * lane), h1 = *(const uint4*)(H2 + (size_t)row * DM + 512 + 8 * lane);
        const int e0 = IDX[(size_t)row * 128 + lane], e1 = IDX[(size_t)row * 128 + 64 + lane];
        uint4 ra[8], rb[8];
#define LOADB(T, bt) { _Pragma("unroll") for (int i = 0; i < 8; ++i) { const int k = (bt) * 8 + i; const int e = __builtin_amdgcn_readlane(k < 64 ? e0 : e1, k & 63); \
            const uint4* rp = (const uint4*)((T) + (size_t)e * 1024); ra[i] = rp[lane]; rb[i] = rp[64 + lane]; } }
        for (int bt = 0; bt < 16; ++bt) {
            LOADB(TU, bt)
            float p[8];
#pragma unroll
            for (int i = 0; i < 8; ++i) p[i] = dot8(rb[i], h1, dot8(ra[i], h0, 0.f));
            float q[4], r2[2];
#pragma unroll
            for (int i = 0; i < 4; ++i) { const float sd = (lane & 32) ? p[i] : p[i + 4]; const float rc = __shfl_xor(sd, 32, 64); q[i] = ((lane & 32) ? p[i + 4] : p[i]) + rc; }
#pragma unroll
            for (int i = 0; i < 2; ++i) { const float sd = (lane & 16) ? q[i] : q[i + 2]; const float rc = __shfl_xor(sd, 16, 64); r2[i] = ((lane & 16) ? q[i + 2] : q[i]) + rc; }
            float sv;
            { const float sd = (lane & 8) ? r2[0] : r2[1]; const float rc = __shfl_xor(sd, 8, 64); sv = ((lane & 8) ? r2[1] : r2[0]) + rc; }
            sv += __shfl_xor(sv, 4, 64); sv += __shfl_xor(sv, 2, 64); sv += __shfl_xor(sv, 1, 64);
            if ((lane & 7) == 0) { const int k = bt * 8 + ((lane >> 3) & 7); coef[k] = gelu_tanh(sv) * GATE[(size_t)row * 128 + k]; }
        }
        float acc[16];
#pragma unroll
        for (int j = 0; j < 16; ++j) acc[j] = 0.f;
        for (int bt = 0; bt < 16; ++bt) {
            LOADB(TV, bt)
#pragma unroll
            for (int i = 0; i < 8; ++i) {
                const float c = coef[bt * 8 + i];
                const unsigned w[8] = {ra[i].x, ra[i].y, ra[i].z, ra[i].w, rb[i].x, rb[i].y, rb[i].z, rb[i].w};
#pragma unroll
                for (int j = 0; j < 8; ++j) { acc[2 * j] += c * __uint_as_float(w[j] << 16); acc[2 * j + 1] += c * __uint_as_float(w[j] & 0xFFFF0000u); }
            }
        }
#undef LOADB
        const float* mod = MOD + (size_t)(l * 5 + modrow(row)) * 6144;
        float v[16]; float s = 0.f;
#pragma unroll
        for (int hh = 0; hh < 2; ++hh) {
            const int d = 512 * hh + 8 * lane;
            const float4 x0 = *(const float4*)(XS + (size_t)row * DM + d), x1 = *(const float4*)(XS + (size_t)row * DM + d + 4);
            const float4 g0 = *(const float4*)(mod + 5120 + d), g1 = *(const float4*)(mod + 5120 + d + 4);
            v[8 * hh + 0] = ALPHA * x0.x + g0.x * acc[8 * hh + 0]; v[8 * hh + 1] = ALPHA * x0.y + g0.y * acc[8 * hh + 1];
            v[8 * hh + 2] = ALPHA * x0.z + g0.z * acc[8 * hh + 2]; v[8 * hh + 3] = ALPHA * x0.w + g0.w * acc[8 * hh + 3];
            v[8 * hh + 4] = ALPHA * x1.x + g1.x * acc[8 * hh + 4]; v[8 * hh + 5] = ALPHA * x1.y + g1.y * acc[8 * hh + 5];
            v[8 * hh + 6] = ALPHA * x1.z + g1.z * acc[8 * hh + 6]; v[8 * hh + 7] = ALPHA * x1.w + g1.w * acc[8 * hh + 7];
        }
#pragma unroll
        for (int j = 0; j < 16; ++j) s += v[j];
        const float mean = wave_sum(s) * (1.f / 1024.f);
        float qq = 0.f;
#pragma unroll
        for (int j = 0; j < 16; ++j) { v[j] -= mean; qq += v[j] * v[j]; }
        const float rs = rsqrtf(wave_sum(qq) * (1.f / 1024.f) + 1e-5f);
        const float* mod1 = MOD + (size_t)(1 * 5 + modrow(row)) * 6144;
#pragma unroll
        for (int hh = 0; hh < 2; ++hh) {
            const int d = 512 * hh + 8 * lane;
            float o[8];
#pragma unroll
            for (int j = 0; j < 8; ++j) o[j] = v[8 * hh + j] * rs * P.in[10][l * 1024 + d + j] + P.in[11][l * 1024 + d + j];
            if (l == 0) {
                *(float4*)(XS + (size_t)row * DM + d) = make_float4(o[0], o[1], o[2], o[3]);
                *(float4*)(XS + (size_t)row * DM + d + 4) = make_float4(o[4], o[5], o[6], o[7]);
                bf16_t hb[8];
#pragma unroll
                for (int j = 0; j < 8; ++j) hb[j] = f2bf(o[j] * (1.f + mod1[1024 + d + j]) + mod1[d + j]);
                uint4 pk; pk.x = hb[0] | ((unsigned)hb[1] << 16); pk.y = hb[2] | ((unsigned)hb[3] << 16); pk.z = hb[4] | ((unsigned)hb[5] << 16); pk.w = hb[6] | ((unsigned)hb[7] << 16);
                *(uint4*)(H + (size_t)row * DM + d) = pk;
            } else {
                const int b = row / LTOT, t = row % LTOT - CTX;
                if (*(volatile unsigned*)(P.ws + OFF_BAR + 15360) != 0u) { o[0] = __int_as_float(0x7fc00000); }
                float* op = P.out + ((size_t)b * SEQ + t) * DM + d;
                *(float4*)op = make_float4(o[0], o[1], o[2], o[3]);
                *(float4*)(op + 4) = make_float4(o[4], o[5], o[6], o[7]);
            }
        }
    }
}

__device__ __forceinline__ void s5_prep_unit(const Params& P, int l, int g, int part, unsigned char* smem) {
    const int tid = otid();
    float* Kt = (float*)smem;
    float* bbr = Kt + 8192; float* bbi = bbr + 1024; float* cr = bbi + 1024; float* ci = cr + 1024; float* pwr = ci + 1024; float* pwi = pwr + 17 * 64;
    bf16_t* MS = (bf16_t*)(P.ws + OFF_S5MS) + (size_t)(l * 16 + g) * 256 * 256;
    bf16_t* MY = (bf16_t*)(P.ws + OFF_S5MY) + (size_t)(l * 16 + g) * 256 * 512;
    float* LB = (float*)(P.ws + OFF_S5LB) + (size_t)(l * 16 + g) * 256;
    for (int dir = 0; dir < 2; ++dir) {
        __syncthreads();
        const int ldg = (l * 2 + dir) * 16 + g;
        if (tid < 64) {
            const int p = tid;
            const float dt = expf(P.in[14][ldg]);
            const float lre = P.in[12][ldg * 64 + p], lim = P.in[13][ldg * 64 + p];
            for (int d = 0; d <= 16; ++d) { const float mag = expf(lre * dt * (float)d), ang = lim * dt * (float)d; pwr[d * 64 + p] = mag * cosf(ang); pwi[d * 64 + p] = mag * sinf(ang); }
            const float lb_re = pwr[64 + p], lb_im = pwi[64 + p];
            const float den = lre * lre + lim * lim, nr = lb_re - 1.f, ni = lb_im;
            const float co_re = (nr * lre + ni * lim) / den, co_im = (ni * lre - nr * lim) / den;
            for (int h = 0; h < 16; ++h) {
                const float br = P.in[15][((size_t)ldg * 64 + p) * 16 + h], bi = P.in[16][((size_t)ldg * 64 + p) * 16 + h];
                bbr[p * 16 + h] = co_re * br - co_im * bi; bbi[p * 16 + h] = co_re * bi + co_im * br;
            }
            if (part == 0) { LB[dir * 128 + p] = pwr[16 * 64 + p]; LB[dir * 128 + 64 + p] = pwi[16 * 64 + p]; }
        }
        for (int e = tid; e < 1024; e += 256) { cr[e] = P.in[17][(size_t)ldg * 1024 + e]; ci[e] = P.in[18][(size_t)ldg * 1024 + e]; }
        __syncthreads();
        for (int e0 = tid; e0 < 1024; e0 += 256) {
            const int e = part * 1024 + e0, d = e >> 8, h = (e >> 4) & 15, h2 = e & 15;
            float acc = 0.f;
            for (int p = 0; p < 64; ++p) {
                const float Pr = pwr[d * 64 + p], Pi = pwi[d * 64 + p], br = bbr[p * 16 + h2], bi = bbi[p * 16 + h2];
                acc += cr[h * 64 + p] * (Pr * br - Pi * bi) - ci[h * 64 + p] * (Pr * bi + Pi * br);
            }
            Kt[dir * 4096 + e] = acc;
        }
        for (int e = tid; e < 32 * 256; e += 256) {
            const int q = part * 32 + (e >> 8), col = e & 255, j = col >> 4, h2 = col & 15, p = q & 63;
            const int ex = dir == 0 ? 15 - j : j;
            const float Pr = pwr[ex * 64 + p], Pi = pwi[ex * 64 + p], br = bbr[p * 16 + h2], bi = bbi[p * 16 + h2];
            MS[(size_t)(dir * 128 + q) * 256 + col] = f2bf(q < 64 ? Pr * br - Pi * bi : Pr * bi + Pi * br);
        }
        for (int e = tid; e < 64 * 128; e += 256) {
            const int ri = part * 64 + (e >> 7), q = e & 127, t = ri >> 4, h = ri & 15, p = q & 63;
            const int ex = dir == 0 ? t + 1 : 16 - t;
            const float Lr = pwr[ex * 64 + p], Li = pwi[ex * 64 + p], c_r = cr[h * 64 + p], c_i = ci[h * 64 + p];
            MY[(size_t)ri * 512 + 256 + dir * 128 + q] = f2bf(q < 64 ? c_r * Lr - c_i * Li : -(c_r * Li + c_i * Lr));
        }
    }
    __syncthreads();
    for (int e = tid; e < 4 * 16 * 2 * 256; e += 256) {
        const int hh = e & 255, side = (e >> 8) & 1, k = (e >> 9) & 15, d = part * 4 + (e >> 13);
        if (k + d > 15 || (d == 0 && side == 1)) continue;
        const int t = side == 0 ? k + d : k, j = side == 0 ? k : k + d, h = hh >> 4, h2 = hh & 15;
        float v = side == 0 ? Kt[d * 256 + hh] : Kt[4096 + d * 256 + hh];
        if (d == 0) { v += Kt[4096 + hh]; if (h == h2) v += P.in[19][l * 256 + g * 16 + h]; }
        MY[(size_t)(t * 16 + h) * 512 + j * 16 + h2] = f2bf(v);
    }
}
__device__ __forceinline__ void s5_passA(const Params& P, int l, int bid, int nb) {
    const int lane = otid() & 63, wave = __builtin_amdgcn_readfirstlane(otid() >> 6), fr = lane & 15, fq = lane >> 4;
    const bf16_t* Pb = (const bf16_t*)(P.ws + OFF_P);
    float* ST = (float*)(P.ws + OFF_S5ST);
    for (int it = bid * 4 + wave; it < 16 * 17 * 4; it += nb * 4) {
        const int g = it / 68, mt = (it % 68) >> 2, nt = it & 3;
        const bf16_t* MS = (const bf16_t*)(P.ws + OFF_S5MS) + (size_t)(l * 16 + g) * 256 * 256;
        f32x4 acc[4][4];
#pragma unroll
        for (int i = 0; i < 4; ++i)
#pragma unroll
            for (int j = 0; j < 4; ++j) acc[i][j] = (f32x4){0.f, 0.f, 0.f, 0.f};
        const bf16_t* ap[4];
#pragma unroll
        for (int i = 0; i < 4; ++i) { const int m = mt * 64 + 16 * i + fr, b = m / 272, c = m % 272; ap[i] = Pb + (size_t)(b * LTOT + c * 16) * PIN + g * 16; }
        const bf16_t* bp = MS + (size_t)(nt * 64 + fr) * 256 + 8 * fq;
#pragma unroll
        for (int k0 = 0; k0 < 256; k0 += 32) {
            const int k = k0 + 8 * fq;
            bf16x8 a[4], bb[4];
#pragma unroll
            for (int i = 0; i < 4; ++i) a[i] = *(const bf16x8*)(ap[i] + (size_t)(k >> 4) * PIN + (k & 15));
#pragma unroll
            for (int j = 0; j < 4; ++j) bb[j] = *(const bf16x8*)(bp + (size_t)(16 * j) * 256 + k0);
#pragma unroll
            for (int i = 0; i < 4; ++i)
#pragma unroll
                for (int j = 0; j < 4; ++j) acc[i][j] = __builtin_amdgcn_mfma_f32_16x16x32_bf16(a[i], bb[j], acc[i][j], 0, 0, 0);
        }
#pragma unroll
        for (int i = 0; i < 4; ++i)
#pragma unroll
            for (int r = 0; r < 4; ++r) {
                const int m = mt * 64 + 16 * i + 4 * fq + r, b = m / 272, c = m % 272;
                float* dst = ST + ((size_t)(b * 16 + g) * 272 + c) * 256 + nt * 64 + fr;
#pragma unroll
                for (int j = 0; j < 4; ++j) dst[16 * j] = acc[i][j][r];
            }
    }
}
__device__ __forceinline__ void s5_carry(const Params& P, int l, int bid, int nb) {
    float* ST = (float*)(P.ws + OFF_S5ST);
    for (int u = bid; u < 32; u += nb) {
        const int gid = u * 256 + otid(), p = gid & 63, dir = (gid >> 6) & 1, g = (gid >> 7) & 15, b = gid >> 11;
        const float* LB = (const float*)(P.ws + OFF_S5LB) + (size_t)(l * 16 + g) * 256 + dir * 128;
        const float lr = LB[p], li = LB[64 + p];
        float* base = ST + (size_t)(b * 16 + g) * 272 * 256 + dir * 128 + p;
        float sr = 0.f, si = 0.f;
        for (int c0 = 0; c0 < 272; c0 += 16) {
            float tr[16], ti[16];
#pragma unroll
            for (int i = 0; i < 16; ++i) { const int cc = c0 + i, c = dir == 0 ? cc : (cc < 16 ? 15 - cc : 287 - cc); tr[i] = base[(size_t)c * 256]; ti[i] = base[(size_t)c * 256 + 64]; }
#pragma unroll
            for (int i = 0; i < 16; ++i) {
                const int cc = c0 + i, c = dir == 0 ? cc : (cc < 16 ? 15 - cc : 287 - cc);
                base[(size_t)c * 256] = sr; base[(size_t)c * 256 + 64] = si;
                const float nr = lr * sr - li * si + tr[i], ni = lr * si + li * sr + ti[i];
                sr = nr; si = ni;
            }
        }
    }
}
__device__ __forceinline__ void s5_passC(const Params& P, int l, int bid, int nb) {
    const int lane = otid() & 63, wave = __builtin_amdgcn_readfirstlane(otid() >> 6), fr = lane & 15, fq = lane >> 4;
    const bf16_t* Pb = (const bf16_t*)(P.ws + OFF_P);
    const float* ST = (const float*)(P.ws + OFF_S5ST);
    bf16_t* YA = (bf16_t*)(P.ws + OFF_YP);
    for (int it = bid * 4 + wave; it < 16 * 17 * 4; it += nb * 4) {
        const int g = it / 68, mt = (it % 68) >> 2, nt = it & 3;
        const bf16_t* MY = (const bf16_t*)(P.ws + OFF_S5MY) + (size_t)(l * 16 + g) * 256 * 512;
        f32x4 acc[4][4];
#pragma unroll
        for (int i = 0; i < 4; ++i)
#pragma unroll
            for (int j = 0; j < 4; ++j) acc[i][j] = (f32x4){0.f, 0.f, 0.f, 0.f};
        const bf16_t* ap[4]; const float* sp[4];
#pragma unroll
        for (int i = 0; i < 4; ++i) {
            const int m = mt * 64 + 16 * i + fr, b = m / 272, c = m % 272;
            ap[i] = Pb + (size_t)(b * LTOT + c * 16) * PIN + g * 16;
            sp[i] = ST + ((size_t)(b * 16 + g) * 272 + c) * 256;
        }
        const bf16_t* bp = MY + (size_t)(nt * 64 + fr) * 512 + 8 * fq;
#pragma unroll
        for (int k0 = 0; k0 < 512; k0 += 32) {
            const int k = k0 + 8 * fq;
            bf16x8 a[4], bb[4];
            if (k0 < 256) {
#pragma unroll
                for (int i = 0; i < 4; ++i) a[i] = *(const bf16x8*)(ap[i] + (size_t)(k >> 4) * PIN + (k & 15));
            } else {
#pragma unroll
                for (int i = 0; i < 4; ++i) {
                    const float4 s0 = *(const float4*)(sp[i] + (k - 256)), s1 = *(const float4*)(sp[i] + (k - 256) + 4);
                    bf16x8 t;
                    t[0] = (short)f2bf(s0.x); t[1] = (short)f2bf(s0.y); t[2] = (short)f2bf(s0.z); t[3] = (short)f2bf(s0.w);
                    t[4] = (short)f2bf(s1.x); t[5] = (short)f2bf(s1.y); t[6] = (short)f2bf(s1.z); t[7] = (short)f2bf(s1.w);
                    a[i] = t;
                }
            }
#pragma unroll
            for (int j = 0; j < 4; ++j) bb[j] = *(const bf16x8*)(bp + (size_t)(16 * j) * 512 + k0);
#pragma unroll
            for (int i = 0; i < 4; ++i)
#pragma unroll
                for (int j = 0; j < 4; ++j) acc[i][j] = __builtin_amdgcn_mfma_f32_16x16x32_bf16(a[i], bb[j], acc[i][j], 0, 0, 0);
        }
#pragma unroll
        for (int i = 0; i < 4; ++i)
#pragma unroll
            for (int r = 0; r < 4; ++r) {
                const int m = mt * 64 + 16 * i + 4 * fq + r, b = m / 272, c = m % 272;
#pragma unroll
                for (int j = 0; j < 4; ++j) {
                    const int t = nt * 4 + j;
                    const size_t row = (size_t)(b * LTOT + c * 16 + t);
                    YA[row * DM + g * 16 + fr] = f2bf(gelu_tanh(acc[i][j][r]));
                }
            }
    }
}


#define OFF_T8 (OFF_RW + (size_t)100 * 1024 * 1024)
#define OFF_T8S (OFF_T8 + (size_t)2 * 16384 * 1024)
typedef float f32x2 __attribute__((ext_vector_type(2)));
__device__ __forceinline__ void phase_tabconv8(const Params& P, int l) {
    const int lane = otid() & 63, wave = __builtin_amdgcn_readfirstlane(otid() >> 6);
    unsigned char* T8 = P.ws + OFF_T8;
    float* T8S = (float*)(P.ws + OFF_T8S);
    const int stride = gridDim.x * 4;
    int row = blockIdx.x * 4 + wave;
    f32x4 x[4], xn[4];
#define TC_LOAD(X, r_) { const float* src_ = P.in[37 + ((r_) >> 14)] + ((size_t)l * 16384 + ((r_) & 16383)) * 1024; \
        _Pragma("unroll") for (int j = 0; j < 4; ++j) X[j] = *(const f32x4*)(src_ + (((r_) >> 14) ? 256 * j + 4 * lane : 16 * lane + 4 * j)); }
    if (row < 32768) TC_LOAD(x, row)
    for (; row < 32768; row += stride) {
        if (row + stride < 32768) TC_LOAD(xn, row + stride)
        float am = 0.f;
#pragma unroll
        for (int j = 0; j < 4; ++j) am = fmaxf(am, fmaxf(fmaxf(fabsf(x[j][0]), fabsf(x[j][1])), fmaxf(fabsf(x[j][2]), fabsf(x[j][3]))));
#pragma unroll
        for (int o = 32; o > 0; o >>= 1) am = fmaxf(am, __shfl_xor(am, o, 64));
        const float sc = am > 0.f ? 127.f / am : 1.f;
        u32x4 pk;
#pragma unroll
        for (int j = 0; j < 4; ++j) {
            const int off = (row >> 14) ? 128 : 0;
            const unsigned q0 = (unsigned)(__float2int_rn(x[j][0] * sc) + off) & 0xFFu, q1 = (unsigned)(__float2int_rn(x[j][1] * sc) + off) & 0xFFu;
            const unsigned q2 = (unsigned)(__float2int_rn(x[j][2] * sc) + off) & 0xFFu, q3 = (unsigned)(__float2int_rn(x[j][3] * sc) + off) & 0xFFu;
            pk[j] = q0 | (q1 << 8) | (q2 << 16) | (q3 << 24);
        }
        *(u32x4*)(T8 + (size_t)row * 1024 + 16 * lane) = pk;
        if (lane == 0) T8S[2 * (row & 16383) + (row >> 14)] = am * (1.f / 127.f);
#pragma unroll
        for (int j = 0; j < 4; ++j) x[j] = xn[j];
    }
#undef TC_LOAD
}
#define OFF_PZ OFF_Q
__device__ __forceinline__ void phase_peerz(const Params& P, int l, unsigned char* smem) {
    const int tid = otid(), lane = tid & 63, wave = __builtin_amdgcn_readfirstlane(tid >> 6);
    const int* IDX = (const int*)(P.ws + OFF_IDX);
    const unsigned char* TU = P.ws + OFF_T8;
    float* PZ = (float*)(P.ws + OFF_PZ);
    const int xg = blockIdx.x & 7, w = (blockIdx.x >> 3) * 4 + wave, nw = (gridDim.x >> 3) * 4;
    unsigned char* h8 = smem + wave * 8192;
    unsigned* list = (unsigned*)(smem + 32768) + wave * 1032;
    float* hinvs = (float*)(smem + 49664) + wave * 8;
    const int r8 = lane >> 3, c8 = lane & 7;
    const unsigned char* H8 = P.ws + OFF_H8; const float* HS = (const float*)(P.ws + OFF_HS);
    u32x4 hl[8]; int el[8][2]; float hsv[8];
#define ZPRE(base_) { _Pragma("unroll") for (int i = 0; i < 8; ++i) { const int row = min((base_) + nw * i, MROWS - 1); \
            hl[i] = *(const u32x4*)(H8 + (size_t)row * DM + 16 * lane); hsv[i] = HS[row]; \
            el[i][0] = IDX[(size_t)row * 128 + lane]; el[i][1] = IDX[(size_t)row * 128 + 64 + lane]; } }
    ZPRE(w)
    for (int base = w; base < MROWS; base += nw * 8) {
        int n = 0;
#pragma unroll
        for (int i = 0; i < 8; ++i) {
            const int row = base + nw * i;
            const bool live = row < MROWS && !(l == 1 && (row % LTOT) < CTX);
            *(u32x4*)(h8 + i * 1024 + 16 * lane) = hl[i];
            if (lane == 0) hinvs[i] = hsv[i];
#pragma unroll
            for (int hh = 0; hh < 2; ++hh) {
                const int e = el[i][hh];
                const bool in = live && (e >> 11) == xg;
                const unsigned long long m = __ballot(in);
                const int rk = __builtin_amdgcn_mbcnt_hi((unsigned)(m >> 32), __builtin_amdgcn_mbcnt_lo((unsigned)m, 0u));
                if (in) list[n + rk] = (unsigned)e | ((unsigned)(64 * hh + lane) << 14) | ((unsigned)i << 21);
                n += __popcll(m);
            }
        }
        ZPRE(base + nw * 8)
        n = __builtin_amdgcn_readfirstlane(n);
        if (n == 0) continue;
        const int nb = (n + 7) >> 3;
        if (lane < 8 && n + lane < nb * 8) list[n + lane] = ((unsigned)xg << 11) | 0x80000000u;
        u32x4 wa[8], wb[8];
        unsigned ea, eb;
#define ZLOAD(W, EV, b) { EV = list[8 * (b) + r8]; const unsigned char* ub_ = TU + (size_t)(EV & 16383u) * 1024 + 16 * c8; \
            _Pragma("unroll") for (int sp = 0; sp < 8; ++sp) W[sp] = *(const u32x4*)(ub_ + 128 * sp); }
#define ZCOMP(W, EV) { const int sl_ = (EV >> 21) & 7; int a_ = 0; \
            _Pragma("unroll") for (int sp = 0; sp < 8; ++sp) { const u32x4 hq_ = *(const u32x4*)(h8 + sl_ * 1024 + 16 * c8 + 128 * sp); \
                _Pragma("unroll") for (int j = 0; j < 4; ++j) a_ = __builtin_amdgcn_sdot4((int)W[sp][j], (int)hq_[j], a_, false); } \
            float p_ = (float)a_; p_ += __shfl_xor(p_, 1, 64); p_ += __shfl_xor(p_, 2, 64); p_ += __shfl_xor(p_, 4, 64); \
            if (c8 == 0 && !(EV >> 31)) PZ[(size_t)(base + nw * sl_) * 128 + ((EV >> 14) & 127u)] = p_ * hinvs[sl_]; }
        ZLOAD(wa, ea, 0)
        int bt = 0;
#pragma unroll 1
        for (; bt + 2 < nb; bt += 2) {
            ZLOAD(wb, eb, bt + 1)
            ZCOMP(wa, ea)
            ZLOAD(wa, ea, bt + 2)
            ZCOMP(wb, eb)
        }
        if (bt + 1 < nb) { ZLOAD(wb, eb, bt + 1) ZCOMP(wa, ea) ZCOMP(wb, eb) }
        else { ZCOMP(wa, ea) }
#undef ZLOAD
#undef ZCOMP
    }
#undef ZPRE
}
__device__ __forceinline__ void phase_gather8(const Params& P, int l, unsigned char* smem) {
    const int tid = otid(), lane = tid & 63, wave = __builtin_amdgcn_readfirstlane(tid >> 6);
    float* XS = (float*)(P.ws + OFF_XS);
    const float* MOD = (const float*)(P.ws + OFF_MOD);
    unsigned char* HI8 = P.ws + OFF_HI8; float* HIS = (float*)(P.ws + OFF_HIS);
    const int* IDX = (const int*)(P.ws + OFF_IDX);
    const float* GATE = (const float*)(P.ws + OFF_GATE);
    const float* PZ = (const float*)(P.ws + OFF_PZ);
    const unsigned char* TV = P.ws + OFF_T8 + (size_t)16384 * 1024;
    const float2* SUV = (const float2*)(P.ws + OFF_T8S);
    float* coef = (float*)smem + wave * 128;
    for (int row = blockIdx.x * 4 + wave; row < MROWS; row += gridDim.x * 4) {
        if (l == 1 && (row % LTOT) < CTX) continue;
        const int e0 = IDX[(size_t)row * 128 + lane], e1 = IDX[(size_t)row * 128 + 64 + lane];
        {
            const float p0 = PZ[(size_t)row * 128 + lane], p1 = PZ[(size_t)row * 128 + 64 + lane];
            const float g0 = GATE[(size_t)row * 128 + lane], g1 = GATE[(size_t)row * 128 + 64 + lane];
            const float2 s0 = SUV[e0], s1 = SUV[e1];
            coef[lane] = gelu_tanh(p0 * s0.x) * g0 * s0.y;
            coef[64 + lane] = gelu_tanh(p1 * s1.x) * g1 * s1.y;
        }
        u32x4 rr[16];
#define LOAD8(T, bt) { _Pragma("unroll") for (int i = 0; i < 16; ++i) { const int k = (bt) * 16 + i; const int e = __builtin_amdgcn_readlane(k < 64 ? e0 : e1, k & 63); \
            rr[i] = *(const u32x4*)((T) + (size_t)e * 1024 + 16 * lane); } }
        float acc[16], csum = 0.f;
#pragma unroll
        for (int j = 0; j < 16; ++j) acc[j] = 0.f;
        for (int bt = 0; bt < 8; ++bt) {
            LOAD8(TV, bt)
#pragma unroll
            for (int i = 0; i < 16; ++i) {
                const float c = coef[bt * 16 + i];
                csum += c;
#pragma unroll
                for (int j = 0; j < 4; ++j) {
                    const unsigned w = rr[i][j];
                    acc[4 * j] += c * (float)(w & 0xFFu); acc[4 * j + 1] += c * (float)((w >> 8) & 0xFFu); acc[4 * j + 2] += c * (float)((w >> 16) & 0xFFu); acc[4 * j + 3] += c * (float)(w >> 24);
                }
            }
        }
#undef LOAD8
#pragma unroll
        for (int j = 0; j < 16; ++j) acc[j] -= 128.f * csum;
        const float* mod = MOD + (size_t)(l * 5 + modrow(row)) * 6144;
        const int d0 = 16 * lane;
        float v[16]; float s = 0.f;
#pragma unroll
        for (int j = 0; j < 4; ++j) {
            const f32x4 x = *(const f32x4*)(XS + (size_t)row * DM + 256 * j + 4 * lane), g = *(const f32x4*)(mod + 5120 + 256 * j + 4 * lane);
#pragma unroll
            for (int e = 0; e < 4; ++e) { v[4 * j + e] = ALPHA * x[e] + g[e] * acc[4 * j + e]; s += v[4 * j + e]; }
        }
        const float mean = wave_sum(s) * (1.f / 1024.f);
        float qq = 0.f;
#pragma unroll
        for (int j = 0; j < 16; ++j) { v[j] -= mean; qq += v[j] * v[j]; }
        const float rs = rsqrtf(wave_sum(qq) * (1.f / 1024.f) + 1e-5f);
        const float* mod1 = MOD + (size_t)(1 * 5 + modrow(row)) * 6144;
#pragma unroll
        for (int j = 0; j < 4; ++j) {
            const int d = 256 * j + 4 * lane;
            const f32x4 gg = *(const f32x4*)(P.in[10] + l * 1024 + d), bb = *(const f32x4*)(P.in[11] + l * 1024 + d);
            f32x4 o;
#pragma unroll
            for (int e = 0; e < 4; ++e) o[e] = v[4 * j + e] * rs * gg[e] + bb[e];
            if (l == 0) {
                *(f32x4*)(XS + (size_t)row * DM + d) = o;
                const f32x4 sh = *(const f32x4*)(mod1 + d), sc = *(const f32x4*)(mod1 + 1024 + d);
#pragma unroll
                for (int e = 0; e < 4; ++e) v[4 * j + e] = o[e] * (1.f + sc[e]) + sh[e];
            } else {
                const int b = row / LTOT, t = row % LTOT - CTX;
                *(f32x4*)(P.out + ((size_t)b * SEQ + t) * DM + d) = o;
            }
        }
        if (l == 0) {
            float am = 0.f;
#pragma unroll
            for (int j = 0; j < 16; ++j) am = fmaxf(am, fabsf(v[j]));
#pragma unroll
            for (int o = 32; o > 0; o >>= 1) am = fmaxf(am, __shfl_xor(am, o, 64));
            const float hs = am > 0.f ? 127.f / am : 1.f;
            u32x4 hq;
#pragma unroll
            for (int j = 0; j < 4; ++j)
                hq[j] = ((unsigned)__float2int_rn(v[4 * j] * hs) & 0xFFu) | (((unsigned)__float2int_rn(v[4 * j + 1] * hs) & 0xFFu) << 8) | (((unsigned)__float2int_rn(v[4 * j + 2] * hs) & 0xFFu) << 16) | (((unsigned)__float2int_rn(v[4 * j + 3] * hs) & 0xFFu) << 24);
#pragma unroll
            for (int j = 0; j < 4; ++j) *(unsigned*)(HI8 + (size_t)row * DM + 256 * j + 4 * lane) = hq[j];
            if (lane == 0) HIS[row] = am * (1.f / 127.f);
        }
    }
}

#define OFF_SG (OFF_RW + (size_t)1088 * 8 * 8 * 1024 * 2)
__device__ __forceinline__ size_t rw_group(int b, int dir, int tau_base) {
    const int p = dir == 0 ? tau_base : (tau_base < CTX ? (CTX - 1 - tau_base) : (LTOT + CTX - 1 - tau_base));
    return (size_t)((b * LTOT + p) >> 4);
}
__device__ __forceinline__ float bfw(unsigned w, int half) { return __uint_as_float(half ? (w & 0xFFFF0000u) : (w << 16)); }
struct RwPrep { u32x4 lw0, lw1; uint2 r, k, kap, a; };
__device__ __forceinline__ void rwkv_prep_load(const bf16_t* RW, int b, int hd, int dir, int tau_base, int wave, int lane, RwPrep& R) {
    const bf16_t* base = RW + (rw_group(b, dir, tau_base) * 8 + hd) * 8192 + lane * 16;
    R.lw0 = *(const u32x4*)(base + (6 + dir) * 1024); R.lw1 = *(const u32x4*)(base + (6 + dir) * 1024 + 8);
    const int off = dir ? 12 - 4 * wave : 4 * wave;
    R.r = *(const uint2*)(base + off); R.k = *(const uint2*)(base + 1024 + off); R.kap = *(const uint2*)(base + 3 * 1024 + off); R.a = *(const uint2*)(base + (4 + dir) * 1024 + off);
}
__device__ __forceinline__ void rwkv_prep_finish(const RwPrep& R, unsigned char* buf, float ka, int wave, int lane, int dir) {
    bf16_t* KR = (bf16_t*)buf; bf16_t* BK = (bf16_t*)(buf + 4608); bf16_t* BbT = (bf16_t*)(buf + 9216); bf16_t* KbT = (bf16_t*)(buf + 11264); float* gT = (float*)(buf + 13312);
    float lwt[16];
#pragma unroll
    for (int i = 0; i < 4; ++i) { lwt[2 * i] = bfw(R.lw0[i], 0); lwt[2 * i + 1] = bfw(R.lw0[i], 1); lwt[8 + 2 * i] = bfw(R.lw1[i], 0); lwt[9 + 2 * i] = bfw(R.lw1[i], 1); }
    float cs[16];
    {
        float c = 0.f;
#pragma unroll
        for (int j = 0; j < 16; ++j) { c += dir ? lwt[15 - j] : lwt[j]; cs[j] = c; }
    }
    const float c15 = cs[15];
    if (wave == 0) gT[lane] = __expf(c15);
    float cpw[4], ctw[4];
#pragma unroll
    for (int tt = 0; tt < 4; ++tt) {
        cpw[tt] = wave == 0 ? (tt == 0 ? 0.f : cs[tt - 1 < 0 ? 0 : tt - 1]) : (wave == 1 ? cs[3 + tt] : (wave == 2 ? cs[7 + tt] : cs[11 + tt]));
        ctw[tt] = wave == 0 ? cs[tt] : (wave == 1 ? cs[4 + tt] : (wave == 2 ? cs[8 + tt] : cs[12 + tt]));
    }
    float rt[4], kt4[4], kp[4], at[4];
    rt[0] = bfw(R.r.x, 0); rt[1] = bfw(R.r.x, 1); rt[2] = bfw(R.r.y, 0); rt[3] = bfw(R.r.y, 1);
    kt4[0] = bfw(R.k.x, 0); kt4[1] = bfw(R.k.x, 1); kt4[2] = bfw(R.k.y, 0); kt4[3] = bfw(R.k.y, 1);
    kp[0] = bfw(R.kap.x, 0); kp[1] = bfw(R.kap.x, 1); kp[2] = bfw(R.kap.y, 0); kp[3] = bfw(R.kap.y, 1);
    at[0] = bfw(R.a.x, 0); at[1] = bfw(R.a.x, 1); at[2] = bfw(R.a.y, 0); at[3] = bfw(R.a.y, 1);
    bf16_t bb[4], kb[4];
#pragma unroll
    for (int tt = 0; tt < 4; ++tt) {
        const int t = 4 * wave + tt;
        const float r = dir ? rt[3 - tt] : rt[tt], k = dir ? kt4[3 - tt] : kt4[tt], kap = dir ? kp[3 - tt] : kp[tt], a = dir ? at[3 - tt] : at[tt];
        const float ep = __expf(cpw[tt]), et = __expf(ctw[tt]), em = __expf(-ctw[tt]), eT = __expf(c15 - ctw[tt]);
        const float beta = kap * a, kt = k * (1.f + (a - 1.f) * ka);
        KR[t * 72 + lane] = f2bf(kap * ep); KR[(16 + t) * 72 + lane] = f2bf(r * et);
        BK[t * 72 + lane] = f2bf(beta * em); BK[(16 + t) * 72 + lane] = f2bf(kt * em);
        bb[tt] = f2bf(beta * eT); kb[tt] = f2bf(kt * eT);
    }
    uint2 pb, pk;
    pb.x = bb[0] | ((unsigned)bb[1] << 16); pb.y = bb[2] | ((unsigned)bb[3] << 16);
    pk.x = kb[0] | ((unsigned)kb[1] << 16); pk.y = kb[2] | ((unsigned)kb[3] << 16);
    *(uint2*)(BbT + lane * 16 + 4 * wave) = pb;
    *(uint2*)(KbT + lane * 16 + 4 * wave) = pk;
}
template <int NV>
__device__ __forceinline__ void rwkv_vt_load(const bf16_t* RW, int b, int hd, int dir, int tau_base, int vbase, int lane, u32x4& x) {
    const bf16_t* base = RW + (rw_group(b, dir, tau_base) * 8 + hd) * 8192 + 2 * 1024;
    if (NV == 2) {
        const int vl = lane & 31, th = lane >> 5;
        x = *(const u32x4*)(base + (vbase + vl) * 16 + (dir ? 8 - 8 * th : 8 * th));
    } else {
        const int vl = lane & 15, tq = lane >> 4;
        const uint2 y = *(const uint2*)(base + (vbase + vl) * 16 + (dir ? 12 - 4 * tq : 4 * tq));
        x[0] = y.x; x[1] = y.y; x[2] = 0u; x[3] = 0u;
    }
}
__device__ __forceinline__ unsigned swap16(unsigned w) { return (w >> 16) | (w << 16); }
template <int NV>
__device__ __forceinline__ void rwkv_vt_store(const u32x4& x, bf16_t* VT, int lane, int dir) {
    if (NV == 2) {
        const int vl = lane & 31, th = lane >> 5;
        u32x4 pk;
        if (dir) { pk[0] = swap16(x[3]); pk[1] = swap16(x[2]); pk[2] = swap16(x[1]); pk[3] = swap16(x[0]); } else pk = x;
        *(u32x4*)(VT + vl * 16 + th * 8) = pk;
    } else {
        const int vl = lane & 15, tq = lane >> 4;
        uint2 pk;
        if (dir) { pk.x = swap16(x[1]); pk.y = swap16(x[0]); } else { pk.x = x[0]; pk.y = x[1]; }
        *(uint2*)(VT + vl * 16 + tq * 4) = pk;
    }
}
template <int NV, bool HASV, bool OUT>
__device__ __forceinline__ void rwkv_mfma_step(f32x4 (&X)[4][NV], const unsigned char* buf, const bf16_t* VT, f32x4 (&Yout)[NV], int lane) {
    const bf16_t* KR = (const bf16_t*)buf; const bf16_t* BK = (const bf16_t*)(buf + 4608); const bf16_t* BbT = (const bf16_t*)(buf + 9216); const bf16_t* KbT = (const bf16_t*)(buf + 11264); const float* gT = (const float*)(buf + 13312);
    const int fr = lane & 15, fq = lane >> 4;
    const f32x4 z4 = {0.f, 0.f, 0.f, 0.f};
    f32x4 cA = z4, cN = z4, cAk = z4, cRb = z4, cRk = z4;
#pragma unroll
    for (int ks = 0; ks < 2; ++ks) {
        const bf16x8 kh = *(const bf16x8*)(KR + fr * 72 + 32 * ks + 8 * fq), rh = *(const bf16x8*)(KR + (16 + fr) * 72 + 32 * ks + 8 * fq);
        const bf16x8 bc = *(const bf16x8*)(BK + fr * 72 + 32 * ks + 8 * fq), kc = *(const bf16x8*)(BK + (16 + fr) * 72 + 32 * ks + 8 * fq);
        cA = mfma32(kh, bc, cA); cN = mfma32(bc, kh, cN); cAk = mfma32(kc, kh, cAk);
        if (OUT) { cRb = mfma32(bc, rh, cRb); cRk = mfma32(kc, rh, cRk); }
    }
    f32x4 dg;
#pragma unroll
    for (int r = 0; r < 4; ++r) {
        const int row = 4 * fq + r;
        dg[r] = (row == fr) ? 1.f : 0.f;
        cA[r] = (fr < row) ? cA[r] : 0.f;
        cN[r] = (row < fr) ? cN[r] : 0.f;
        cAk[r] = (row < fr) ? cAk[r] : 0.f;
        cRb[r] = (row <= fr) ? cRb[r] : 0.f;
        cRk[r] = (row <= fr) ? cRk[r] : 0.f;
    }
    const bf16x4 a4 = to4(cA), n4 = to4(cN);
    const f32x4 cA2 = mfma16(n4, a4, z4), cN2 = mfma16(a4, n4, z4);
    const bf16x4 a24 = to4(cA2), n24 = to4(cN2);
    const f32x4 cA4 = mfma16(n24, a24, z4), cN4 = mfma16(a24, n24, z4);
    const f32x4 cA8 = mfma16(to4(cN4), to4(cA4), z4);
    const f32x4 T1 = mfma16(to4(dg - cA), to4(dg + cN2), z4);
    const f32x4 T2 = mfma16(to4(dg + cA4), to4(T1), z4);
    const f32x4 WT = mfma16(to4(dg + cA8), to4(T2), z4);
    const bf16x4 wt4 = to4(WT), aak4 = to4(cAk), rab4 = to4(cRb), rak4 = to4(cRk);
    bf16x8 aK[2], aR[2];
#pragma unroll
    for (int ks = 0; ks < 2; ++ks) {
        aK[ks] = cat8(*(const bf16x4*)(KR + fr * 72 + 32 * ks + 4 * fq), *(const bf16x4*)(KR + fr * 72 + 32 * ks + 16 + 4 * fq));
        if (OUT) aR[ks] = cat8(*(const bf16x4*)(KR + (16 + fr) * 72 + 32 * ks + 4 * fq), *(const bf16x4*)(KR + (16 + fr) * 72 + 32 * ks + 16 + 4 * fq));
    }
    bf16x4 u4[NV], vt4[NV];
#pragma unroll
    for (int nj = 0; nj < NV; ++nj) {
        const bf16x8 b0 = cat8(to4(X[0][nj]), to4(X[1][nj])), b1 = cat8(to4(X[2][nj]), to4(X[3][nj]));
        f32x4 G = mfma32(aK[1], b1, mfma32(aK[0], b0, z4));
        if (HASV) { vt4[nj] = *(const bf16x4*)(VT + (16 * nj + fr) * 16 + 4 * fq); G = mfma16(aak4, vt4[nj], G); }
        const f32x4 U = mfma16(wt4, to4(G), z4);
        u4[nj] = to4(-U);
        if (OUT) {
            f32x4 Yv = mfma32(aR[1], b1, mfma32(aR[0], b0, z4));
            Yv = mfma16(rab4, u4[nj], Yv);
            if (HASV) Yv = mfma16(rak4, vt4[nj], Yv);
            Yout[nj] = Yv;
        }
    }
#pragma unroll
    for (int mi = 0; mi < 4; ++mi) {
        const f32x4 g4 = *(const f32x4*)(gT + 16 * mi + 4 * fq);
        const bf16x4 bb4 = *(const bf16x4*)(BbT + (16 * mi + fr) * 16 + 4 * fq), kb4 = *(const bf16x4*)(KbT + (16 * mi + fr) * 16 + 4 * fq);
#pragma unroll
        for (int nj = 0; nj < NV; ++nj) {
            f32x4 x = X[mi][nj] * g4;
            x = mfma16(bb4, u4[nj], x);
            if (HASV) x = mfma16(kb4, vt4[nj], x);
            X[mi][nj] = x;
        }
    }
}
__device__ __forceinline__ void rwkv_passA(const Params& P, int l, unsigned char* smem, int bid, int nb) {
    const int lane = otid() & 63, wave = __builtin_amdgcn_readfirstlane(otid() >> 6), fr = lane & 15, fq = lane >> 4;
    const bf16_t* RW = (const bf16_t*)(P.ws + OFF_RW);
    float* RXL = (float*)(P.ws + OFF_RXL);
    bf16_t* RXP = (bf16_t*)P.out;
    for (int item = bid; item < 64 * RW_NCH; item += nb) {
        const int seq = item / RW_NCH, c = item % RW_NCH, dir = seq & 1, hd = (seq >> 1) & 7, b = seq >> 4;
        const float ka = P.in[31][l * 512 + hd * 64 + lane];
        const int tau0 = c * 128;
        f32x4 X[4][2], Yd[2];
#pragma unroll
        for (int mi = 0; mi < 4; ++mi)
#pragma unroll
            for (int nj = 0; nj < 2; ++nj)
#pragma unroll
                for (int r = 0; r < 4; ++r) X[mi][nj][r] = (wave >= 2 && (16 * mi + 4 * fq + r) == (16 * (2 * (wave - 2) + nj) + fr)) ? 1.f : 0.f;
        bf16_t* VTw = (bf16_t*)(smem + RW_VT0 + wave * 2048);
        RwPrep Ra, Rb; u32x4 vx;
        rwkv_prep_load(RW, b, hd, dir, tau0, wave, lane, Ra);
        if (wave < 2) rwkv_vt_load<2>(RW, b, hd, dir, tau0, 32 * wave, lane, vx);
        rwkv_prep_load(RW, b, hd, dir, tau0 + 16, wave, lane, Rb);
        rwkv_prep_finish(Ra, smem, ka, wave, lane, dir);
        if (wave < 2) rwkv_vt_store<2>(vx, VTw, lane, dir);
        rwkv_prep_load(RW, b, hd, dir, tau0 + 32, wave, lane, Ra);
        __syncthreads();
#pragma unroll 1
        for (int s = 0; s < 8; s += 2) {
            if (wave < 2) rwkv_mfma_step<2, true, false>(X, smem, VTw, Yd, lane);
            else rwkv_mfma_step<2, false, false>(X, smem, VTw, Yd, lane);
            if (wave < 2) rwkv_vt_load<2>(RW, b, hd, dir, tau0 + (s + 1) * 16, 32 * wave, lane, vx);
            rwkv_prep_finish(Rb, smem + RW_BUF, ka, wave, lane, dir);
            if (wave < 2) rwkv_vt_store<2>(vx, VTw + 512, lane, dir);
            if (s + 3 < 8) rwkv_prep_load(RW, b, hd, dir, tau0 + (s + 3) * 16, wave, lane, Rb);
            __syncthreads();
            if (wave < 2) rwkv_mfma_step<2, true, false>(X, smem + RW_BUF, VTw + 512, Yd, lane);
            else rwkv_mfma_step<2, false, false>(X, smem + RW_BUF, VTw, Yd, lane);
            if (s + 2 < 8) {
                if (wave < 2) rwkv_vt_load<2>(RW, b, hd, dir, tau0 + (s + 2) * 16, 32 * wave, lane, vx);
                rwkv_prep_finish(Ra, smem, ka, wave, lane, dir);
                if (wave < 2) rwkv_vt_store<2>(vx, VTw, lane, dir);
                if (s + 4 < 8) rwkv_prep_load(RW, b, hd, dir, tau0 + (s + 4) * 16, wave, lane, Ra);
            }
            __syncthreads();
        }
        if (wave < 2) {
#pragma unroll
            for (int mi = 0; mi < 4; ++mi)
#pragma unroll
                for (int nj = 0; nj < 2; ++nj) *(f32x4*)(RXL + (((size_t)item * 16 + mi * 4 + 2 * wave + nj) * 64 + lane) * 4) = X[mi][nj];
        } else {
#pragma unroll
            for (int mi = 0; mi < 4; ++mi)
#pragma unroll
                for (int nj = 0; nj < 2; ++nj)
#pragma unroll
                    for (int r = 0; r < 4; ++r) RXP[(size_t)item * 4096 + ((mi * 2 + (wave - 2)) * 64 + (fr >> 2) * 16 + 4 * fq + r) * 8 + nj * 4 + (fr & 3)] = f2bf(X[mi][nj][r]);
        }
    }
}
__device__ __forceinline__ void rwkv_passB(const Params& P, int bid, int nb, unsigned char* smem) {
    const int lane = otid() & 63, wave = __builtin_amdgcn_readfirstlane(otid() >> 6);
    float* RXL = (float*)(P.ws + OFF_RXL);
    const bf16_t* RXP = (const bf16_t*)P.out;
    const int seq = bid, nj = wave;
    f32x4 X[4];
#pragma unroll
    for (int mi = 0; mi < 4; ++mi) X[mi] = (f32x4){0.f, 0.f, 0.f, 0.f};
    f32x4 L0[4], L1[4], L2[4]; u32x4 q0[2], q1[2], q2[2];
#define PB_LOAD(LL, QQ, cc) { const size_t item_ = (size_t)seq * RW_NCH + (cc); _Pragma("unroll") for (int mi = 0; mi < 4; ++mi) \
            LL[mi] = *(const f32x4*)(RXL + ((item_ * 16 + mi * 4 + nj) * 64 + lane) * 4); \
        _Pragma("unroll") for (int q = 0; q < 2; ++q) QQ[q] = *(const u32x4*)(RXP + item_ * 4096 + ((2 * wave + q) * 64 + lane) * 8); }
#define PB_STEP(LL, QQ, cc) { const size_t item_ = (size_t)seq * RW_NCH + (cc); \
        unsigned char* as_ = smem + ((cc) & 1) * 8192; \
        *(u32x4*)(as_ + ((2 * wave) * 64 + lane) * 16) = QQ[0]; *(u32x4*)(as_ + ((2 * wave + 1) * 64 + lane) * 16) = QQ[1]; \
        __syncthreads(); \
        bf16x8 af[4][2]; \
        _Pragma("unroll") for (int mi = 0; mi < 4; ++mi) _Pragma("unroll") for (int ks = 0; ks < 2; ++ks) af[mi][ks] = *(const bf16x8*)(as_ + ((mi * 2 + ks) * 64 + lane) * 16); \
        const bf16x8 b0 = cat8(to4(X[0]), to4(X[1])), b1 = cat8(to4(X[2]), to4(X[3])); \
        _Pragma("unroll") for (int mi = 0; mi < 4; ++mi) { \
            *(f32x4*)(RXL + ((item_ * 16 + mi * 4 + nj) * 64 + lane) * 4) = X[mi]; \
            X[mi] = mfma32(af[mi][1], b1, mfma32(af[mi][0], b0, LL[mi])); } }
    __syncthreads();
    PB_LOAD(L0, q0, 0) PB_LOAD(L1, q1, 1) PB_LOAD(L2, q2, 2)
    static_assert(RW_NCH % 3 == 1, "pass B steps three chunks per iteration plus one final step");
#pragma unroll 1
    for (int c0 = 0; c0 < RW_NCH - 1; c0 += 3) {
        PB_STEP(L0, q0, c0)
        PB_LOAD(L0, q0, c0 + 3)
        PB_STEP(L1, q1, c0 + 1)
        PB_LOAD(L1, q1, min(c0 + 4, RW_NCH - 1))
        PB_STEP(L2, q2, c0 + 2)
        PB_LOAD(L2, q2, min(c0 + 5, RW_NCH - 1))
    }
    PB_STEP(L0, q0, RW_NCH - 1)
#undef PB_LOAD
#undef PB_STEP
}
template <bool CHECK>
__device__ __forceinline__ void rwkv_passC(const Params& P, int l, unsigned char* smem, int bid, int nb, int mode = 0) {
    const int lane = otid() & 63, wave = __builtin_amdgcn_readfirstlane(otid() >> 6), fr = lane & 15, fq = lane >> 4;
    const bf16_t* RW = (const bf16_t*)(P.ws + OFF_RW);
    const float* RXL = (const float*)(P.ws + OFF_RXL);
    for (int item = bid; item < 64 * RW_NCH; item += nb) {
        const int seq = item / RW_NCH, c = item % RW_NCH, dir = seq & 1, hd = (seq >> 1) & 7, b = seq >> 4;
        if (l == 1 && dir == 0 && c < 2) continue;
        if (l == 1 && dir == 1 && c < 2) continue;
        bf16_t* YP = (bf16_t*)(P.ws + OFF_YP) + (size_t)dir * MROWS * DM;
        const float ka = P.in[31][l * 512 + hd * 64 + lane];
        const int tau0 = c * 128;
        f32x4 X[4][1], Yo[1];
#pragma unroll
        for (int mi = 0; mi < 4; ++mi) X[mi][0] = *(const f32x4*)(RXL + (((size_t)item * 16 + mi * 4 + wave) * 64 + lane) * 4);
        bf16_t* VTw = (bf16_t*)(smem + RW_VT0 + wave * 2048);
        RwPrep Ra, Rb; u32x4 vxa, vxb;
        rwkv_prep_load(RW, b, hd, dir, tau0, wave, lane, Ra);
        rwkv_vt_load<1>(RW, b, hd, dir, tau0, 16 * wave, lane, vxa);
        rwkv_prep_load(RW, b, hd, dir, tau0 + 16, wave, lane, Rb);
        rwkv_vt_load<1>(RW, b, hd, dir, tau0 + 16, 16 * wave, lane, vxb);
        rwkv_prep_finish(Ra, smem, ka, wave, lane, dir);
        rwkv_vt_store<1>(vxa, VTw, lane, dir);
        rwkv_prep_load(RW, b, hd, dir, tau0 + 32, wave, lane, Ra);
        rwkv_vt_load<1>(RW, b, hd, dir, tau0 + 32, 16 * wave, lane, vxa);
        __syncthreads();
#define PC_OUT(s_) { _Pragma("unroll") for (int r = 0; r < 4; ++r) { const int row = row_of(b, dir, tau0 + (s_) * 16 + 4 * fq + r); \
            if (CHECK) { if (YP[(size_t)row * DM + 512 + hd * 64 + 16 * wave + fr] != f2bf(Yo[0][r])) atomicAdd((unsigned*)(P.ws + OFF_BAR + 15360), 1u); } \
            else YP[(size_t)row * DM + 512 + hd * 64 + 16 * wave + fr] = f2bf(Yo[0][r]); } }
#pragma unroll 1
        for (int s = 0; s < 8; s += 2) {
            rwkv_mfma_step<1, true, true>(X, smem, VTw, Yo, lane);
            rwkv_prep_finish(Rb, smem + RW_BUF, ka, wave, lane, dir);
            rwkv_vt_store<1>(vxb, VTw + 512, lane, dir);
            if (s + 3 < 8) { rwkv_prep_load(RW, b, hd, dir, tau0 + (s + 3) * 16, wave, lane, Rb); rwkv_vt_load<1>(RW, b, hd, dir, tau0 + (s + 3) * 16, 16 * wave, lane, vxb); }
            PC_OUT(s)
            __syncthreads();
            rwkv_mfma_step<1, true, true>(X, smem + RW_BUF, VTw + 512, Yo, lane);
            if (s + 2 < 8) {
                rwkv_prep_finish(Ra, smem, ka, wave, lane, dir);
                rwkv_vt_store<1>(vxa, VTw, lane, dir);
                if (s + 4 < 8) { rwkv_prep_load(RW, b, hd, dir, tau0 + (s + 4) * 16, wave, lane, Ra); rwkv_vt_load<1>(RW, b, hd, dir, tau0 + (s + 4) * 16, 16 * wave, lane, vxa); }
            }
            PC_OUT(s + 1)
            __syncthreads();
        }
#undef PC_OUT
    }
}


#define HG_NCH 34
#define HG_BUF 7168
#define HG_VT0 14336
#define OFF_O_RXP 0ull
#define OFF_O_HXL ((size_t)2176 * 8192)
#define OFF_O_HD (OFF_O_HXL + (size_t)1088 * 8192)
struct HgPrep { u32x4 lf0, lf1; uint2 q, v; };
__device__ __forceinline__ void hgrn_prep_load(const bf16_t* HGT, int b, int hd, int dir, int tau_base, int vbase, int wave, int lane, HgPrep& R) {
    const bf16_t* base = HGT + (rw_group(b, dir, tau_base) * 4 + hd) * 4096;
    R.lf0 = *(const u32x4*)(base + (2 + dir) * 1024 + lane * 16); R.lf1 = *(const u32x4*)(base + (2 + dir) * 1024 + lane * 16 + 8);
    R.q = *(const uint2*)(base + lane * 16 + (dir ? 12 - 4 * wave : 4 * wave));
    const int vl = lane & 15, tq = lane >> 4;
    R.v = *(const uint2*)(base + 1024 + (vbase + vl) * 16 + (dir ? 12 - 4 * tq : 4 * tq));
}
__device__ __forceinline__ float hgrn_prep_finish(const HgPrep& R, unsigned char* buf, bf16_t* VT, int wave, int lane, int dir) {
    bf16_t* QH = (bf16_t*)buf; bf16_t* KC = (bf16_t*)(buf + 2304); bf16_t* KbT = (bf16_t*)(buf + 4608); float* gT = (float*)(buf + 6656);
    float lft_[16];
#pragma unroll
    for (int i = 0; i < 4; ++i) { lft_[2 * i] = bfw(R.lf0[i], 0); lft_[2 * i + 1] = bfw(R.lf0[i], 1); lft_[8 + 2 * i] = bfw(R.lf1[i], 0); lft_[9 + 2 * i] = bfw(R.lf1[i], 1); }
    float cs[16], ls[16];
    {
        float c = 0.f;
#pragma unroll
        for (int j = 0; j < 16; ++j) { ls[j] = dir ? lft_[15 - j] : lft_[j]; c += ls[j]; cs[j] = c; }
    }
    const float c15 = cs[15];
    if (wave == 0) gT[lane] = __expf(c15);
    float qt[4];
    qt[0] = bfw(R.q.x, 0); qt[1] = bfw(R.q.x, 1); qt[2] = bfw(R.q.y, 0); qt[3] = bfw(R.q.y, 1);
    bf16_t kb[4];
#pragma unroll
    for (int tt = 0; tt < 4; ++tt) {
        const int t = 4 * wave + tt;
        const float ct = wave == 0 ? cs[tt] : (wave == 1 ? cs[4 + tt] : (wave == 2 ? cs[8 + tt] : cs[12 + tt]));
        const float lft = wave == 0 ? ls[tt] : (wave == 1 ? ls[4 + tt] : (wave == 2 ? ls[8 + tt] : ls[12 + tt]));
        const float k = 1.f - __expf(lft);
        const float q = dir ? qt[3 - tt] : qt[tt];
        QH[t * 72 + lane] = f2bf(q * __expf(ct));
        KC[t * 72 + lane] = f2bf(k * __expf(fminf(-ct, 80.f)));
        kb[tt] = f2bf(k * __expf(c15 - ct));
    }
    uint2 pk; pk.x = kb[0] | ((unsigned)kb[1] << 16); pk.y = kb[2] | ((unsigned)kb[3] << 16);
    *(uint2*)(KbT + lane * 16 + 4 * wave) = pk;
    {
        const int vl = lane & 15, tq = lane >> 4;
        uint2 pv;
        if (dir) { pv.x = swap16(R.v.y); pv.y = swap16(R.v.x); } else pv = R.v;
        *(uint2*)(VT + vl * 16 + tq * 4) = pv;
    }
    return c15;
}
template <bool OUT>
__device__ __forceinline__ void hgrn_mfma_step(f32x4 (&X)[4], const unsigned char* buf, const bf16_t* VT, f32x4& Yout, int lane) {
    const bf16_t* QH = (const bf16_t*)buf; const bf16_t* KC = (const bf16_t*)(buf + 2304); const bf16_t* KbT = (const bf16_t*)(buf + 4608); const float* gT = (const float*)(buf + 6656);
    const int fr = lane & 15, fq = lane >> 4;
    const f32x4 z4 = {0.f, 0.f, 0.f, 0.f};
    const bf16x4 vt4 = *(const bf16x4*)(VT + fr * 16 + 4 * fq);
    if (OUT) {
        f32x4 cAT = z4;
#pragma unroll
        for (int ks = 0; ks < 2; ++ks) {
            const bf16x8 kc = *(const bf16x8*)(KC + fr * 72 + 32 * ks + 8 * fq), qh = *(const bf16x8*)(QH + fr * 72 + 32 * ks + 8 * fq);
            cAT = mfma32(kc, qh, cAT);
        }
#pragma unroll
        for (int r = 0; r < 4; ++r) cAT[r] = ((4 * fq + r) <= fr) ? cAT[r] : 0.f;
        const bf16x8 aQ0 = cat8(*(const bf16x4*)(QH + fr * 72 + 4 * fq), *(const bf16x4*)(QH + fr * 72 + 16 + 4 * fq));
        const bf16x8 aQ1 = cat8(*(const bf16x4*)(QH + fr * 72 + 32 + 4 * fq), *(const bf16x4*)(QH + fr * 72 + 48 + 4 * fq));
        const bf16x8 b0 = cat8(to4(X[0]), to4(X[1])), b1 = cat8(to4(X[2]), to4(X[3]));
        f32x4 O = mfma32(aQ1, b1, mfma32(aQ0, b0, z4));
        Yout = mfma16(to4(cAT), vt4, O);
    }
#pragma unroll
    for (int mi = 0; mi < 4; ++mi) {
        const f32x4 g4 = *(const f32x4*)(gT + 16 * mi + 4 * fq);
        const bf16x4 kb4 = *(const bf16x4*)(KbT + (16 * mi + fr) * 16 + 4 * fq);
        X[mi] = mfma16(kb4, vt4, X[mi] * g4);
    }
}
__device__ __forceinline__ float hgrn_lb(const Params& P, int l, int dir, int ch) {
    if (l == 0) return 0.f;
    const float a0 = P.in[22][(dir * 2 + 0) * 256 + ch], a1 = P.in[22][(dir * 2 + 1) * 256 + ch];
    const float m = fmaxf(a0, a1), e0 = __expf(a0 - m), e1 = __expf(a1 - m);
    return e1 / (e0 + e1);
}
template <bool OUT>
__device__ __forceinline__ void hgrn_pass(const Params& P, int l, unsigned char* smem, int bid, int nb) {
    const int lane = otid() & 63, wave = __builtin_amdgcn_readfirstlane(otid() >> 6), fr = lane & 15, fq = lane >> 4;
    const bf16_t* Pb = (const bf16_t*)((unsigned char*)P.out + OFF_O_HGT);
    bf16_t* HXL = (bf16_t*)((unsigned char*)P.out + OFF_O_HXL);
    float* HD = (float*)((unsigned char*)P.out + OFF_O_HD);
    for (int item = bid; item < 32 * HG_NCH; item += nb) {
        const int seq = item / HG_NCH, c = item % HG_NCH, dir = seq & 1, hd = (seq >> 1) & 3, b = seq >> 3;
        if (OUT && l == 1 && c < 2) continue;
        bf16_t* YP = (bf16_t*)(P.ws + OFF_YP) + (size_t)dir * MROWS * DM;
        const int tau0 = c * 128;
        f32x4 X[4], Yo;
#pragma unroll
        for (int mi = 0; mi < 4; ++mi) { if (OUT) { const uint2 w = *(const uint2*)(HXL + (((size_t)item * 16 + mi * 4 + wave) * 64 + lane) * 4); X[mi] = (f32x4){bfw(w.x, 0), bfw(w.x, 1), bfw(w.y, 0), bfw(w.y, 1)}; } else X[mi] = (f32x4){0.f, 0.f, 0.f, 0.f}; }
        bf16_t* VTw = (bf16_t*)(smem + HG_VT0 + wave * 1024);
        HgPrep R;
        hgrn_prep_load(Pb, b, hd, dir, tau0, 16 * wave, wave, lane, R);
        float ctot = hgrn_prep_finish(R, smem, VTw, wave, lane, dir);
        __syncthreads();
        for (int s = 0; s < 8; ++s) {
            if (s < 7) hgrn_prep_load(Pb, b, hd, dir, tau0 + (s + 1) * 16, 16 * wave, wave, lane, R);
            hgrn_mfma_step<OUT>(X, smem + (s & 1) * HG_BUF, VTw + (s & 1) * 256, Yo, lane);
            if (s < 7) ctot += hgrn_prep_finish(R, smem + ((s + 1) & 1) * HG_BUF, VTw + ((s + 1) & 1) * 256, wave, lane, dir);
            if (OUT) {
#pragma unroll
                for (int r = 0; r < 4; ++r) {
                    const int row = row_of(b, dir, tau0 + s * 16 + 4 * fq + r);
                    YP[(size_t)row * DM + 256 + hd * 64 + 16 * wave + fr] = f2bf(Yo[r]);
                }
            }
            __syncthreads();
        }
        if (!OUT) {
#pragma unroll
            for (int mi = 0; mi < 4; ++mi) *(uint2*)(HXL + (((size_t)item * 16 + mi * 4 + wave) * 64 + lane) * 4) = make_uint2(pk2bf(X[mi][0], X[mi][1]), pk2bf(X[mi][2], X[mi][3]));
            if (wave == 0) HD[(size_t)item * 64 + lane] = __expf(ctot);
        }
    }
}
__device__ __forceinline__ void hgrn_carry(const Params& P, int bid, int nb) {
    bf16_t* HXL = (bf16_t*)((unsigned char*)P.out + OFF_O_HXL);
    const float* HD = (const float*)((unsigned char*)P.out + OFF_O_HD);
    for (int u = bid; u < 128; u += nb) {
        const int gid = u * 256 + otid(), ln = gid & 63, tile = (gid >> 6) & 15, seq = gid >> 10;
        const int mi = tile >> 2, fq = ln >> 4;
        f32x4 x = {0.f, 0.f, 0.f, 0.f};
        for (int c0 = 0; c0 < HG_NCH; c0 += 17) {
            uint2 L[17];
#pragma unroll
            for (int i = 0; i < 17; ++i) {
                const size_t item = (size_t)seq * HG_NCH + c0 + i;
                L[i] = *(const uint2*)(HXL + ((item * 16 + tile) * 64 + ln) * 4);
            }
#pragma unroll
            for (int i = 0; i < 17; ++i) {
                const size_t item = (size_t)seq * HG_NCH + c0 + i;
                const f32x4 D = *(const f32x4*)(HD + item * 64 + 16 * mi + 4 * fq);
                *(uint2*)(HXL + ((item * 16 + tile) * 64 + ln) * 4) = make_uint2(pk2bf(x[0], x[1]), pk2bf(x[2], x[3]));
                x = D * x + (f32x4){bfw(L[i].x, 0), bfw(L[i].x, 1), bfw(L[i].y, 0), bfw(L[i].y, 1)};
            }
        }
    }
}


__device__ __forceinline__ void phase_rwprep2(const Params& P, int l, unsigned char* smem, int bid, int nb) {
    const int tid = otid(), lane = tid & 63, wave = __builtin_amdgcn_readfirstlane(tid >> 6), fr = lane & 15, fq = lane >> 4;
    const bf16_t* Pb = (const bf16_t*)(P.ws + OFF_P);
    bf16_t* RW = (bf16_t*)(P.ws + OFF_RW);
    bf16_t* SG = (bf16_t*)(P.ws + OFF_SG);
    const bf16_t* LW = (const bf16_t*)(P.ws + OFF_LW);
    const float* mu = P.in[24] + l * 1920;
    bf16_t* AL = (bf16_t*)smem;
    float muv[8];
#pragma unroll
    for (int jj = 0; jj < 8; ++jj) muv[jj] = (tid + 256 * jj) < 1920 ? mu[tid + 256 * jj] : 0.f;
    const float kk0 = P.in[30][l * 512 + tid], kk1 = P.in[30][l * 512 + 256 + tid];
    for (int u = bid; u < MROWS / 16; u += nb) {
        const int r0 = u * 16;
        __syncthreads();
        unsigned char* stg = smem + 9216;
        unsigned okm = 0u; int nsl;
        {
            const int m = tid & 3;
            const bool isctx = (r0 % LTOT) < CTX;
            nsl = isctx ? ((m & 1) ? 2 : 0) : (m == 0 ? 0 : (m == 1 ? 2 : (m == 2 ? 18 : 34)));
#pragma unroll
            for (int t = 0; t < 16; ++t) {
                const int p_ = (r0 + t) % LTOT; bool ok_;
                if (p_ < CTX) ok_ = (m & 1) ? (p_ < CTX - 1) : (p_ > 0);
                else { const int t_ = p_ - CTX, gr = t_ >> 6, gc = t_ & 63; ok_ = m == 0 ? (gc > 0) : (m == 1 ? (gc < 63) : (m == 2 ? (gr > 0) : (gr < 63))); }
                okm |= (ok_ ? 1u : 0u) << t;
            }
        }
#define RWP_STAGE(g) { __syncthreads(); \
            _Pragma("unroll 1") for (int i = wave; i < 50; i += 4) { \
                int rw_ = i < 18 ? r0 - 1 + i : (i < 34 ? r0 - 64 + (i - 18) : r0 + 64 + (i - 34)); rw_ = min(max(rw_, 0), MROWS - 1); \
                __builtin_amdgcn_global_load_lds((const unsigned*)(Pb + (size_t)rw_ * PIN + 1536 + 512 * (g) + 8 * lane), (LAS unsigned*)(stg + i * 1024), 16, 0, 0); } \
            asm volatile("s_waitcnt vmcnt(0)" ::: "memory"); __syncthreads(); }
#define RWP_PV(t, h) bf2f(*(const bf16_t*)(stg + (1 + (t)) * 1024 + 2 * (tid + 256 * (h))))
#define RWP_NV(t, h) bf2f(*(const bf16_t*)(stg + (nsl + (t)) * 1024 + 2 * (tid + 256 * (h))))
#define RWP_SV(t, h, j0) (RWP_PV(t, h) + muv[(j0) + (h)] * ((((okm >> (t)) & 1u) ? RWP_NV(t, h) : 0.f) - RWP_PV(t, h)))
#define RWP_STORE(f, h, W) { const int ch_ = tid + 256 * (h); bf16_t* d_ = RW + (((size_t)u * 8 + (ch_ >> 6)) * 8 + (f)) * 1024 + (ch_ & 63) * 16; \
            *(u32x4*)d_ = (u32x4){W[0], W[1], W[2], W[3]}; *(u32x4*)(d_ + 8) = (u32x4){W[4], W[5], W[6], W[7]}; }
#pragma unroll
        for (int g = 0; g < 3; ++g) {
            RWP_STAGE(g)
#pragma unroll
            for (int h = 0; h < 2; ++h) {
                unsigned wv[8], wk[8];
#pragma unroll
                for (int t2 = 0; t2 < 8; ++t2) {
                    const float s0 = RWP_SV(2 * t2, h, 2 * g), s1 = RWP_SV(2 * t2 + 1, h, 2 * g);
                    wv[t2] = pk2bf(s0, s1);
                    if (g == 1) {
                        const float kk = h ? kk1 : kk0, a0 = s0 * kk, a1 = s1 * kk;
                        const float n0 = fmaxf(sqrtf(wave_sum(a0 * a0)), 1e-12f), n1 = fmaxf(sqrtf(wave_sum(a1 * a1)), 1e-12f);
                        wk[t2] = pk2bf(a0 / n0, a1 / n1);
                    }
                }
                RWP_STORE(g, h, wv)
                if (g == 1) RWP_STORE(3, h, wk)
            }
        }
        {
            RWP_STAGE(3)
#pragma unroll
            for (int t = 0; t < 16; ++t) {
                const float s6 = RWP_SV(t, 0, 6);
                if (tid < 128) { const float s7 = RWP_SV(t, 1, 6); SG[(size_t)(r0 + t) * 128 + tid] = f2bf(sigmoidf_(s6)); AL[((2 + (tid >> 6)) * 16 + t) * 72 + (tid & 63)] = f2bf(s7); }
                else AL[(((tid - 128) >> 6) * 16 + t) * 72 + (tid & 63)] = f2bf(tanhf(s6));
            }
        }
#undef RWP_STAGE
#undef RWP_PV
#undef RWP_NV
#undef RWP_SV
#undef RWP_STORE
        __syncthreads();
        {
            const int d = wave & 1, isA = wave >> 1;
            const bf16x8 a0 = *(const bf16x8*)(AL + (wave * 16 + fr) * 72 + 8 * fq), a1 = *(const bf16x8*)(AL + (wave * 16 + fr) * 72 + 32 + 8 * fq);
            const bf16_t* W = LW + (size_t)isA * 131072 + (size_t)(l * 2 + d) * 512 * 64;
            const float* bias = P.in[isA ? 27 : 25] + (l * 2 + d) * 512;
            const int fld = (isA ? 4 : 6) + d;
#pragma unroll 1
            for (int nj0 = 0; nj0 < 32; nj0 += 8) {
              bf16x8 bq0[8], bq1[8]; float bsq[8];
#pragma unroll
              for (int q = 0; q < 8; ++q) { bq0[q] = *(const bf16x8*)(W + (size_t)(16 * (nj0 + q) + fr) * 64 + 8 * fq); bq1[q] = *(const bf16x8*)(W + (size_t)(16 * (nj0 + q) + fr) * 64 + 32 + 8 * fq); bsq[q] = bias[16 * (nj0 + q) + fr]; }
#pragma unroll
              for (int q = 0; q < 8; ++q) {
                const int nj = nj0 + q;
                const f32x4 acc = mfma32(a1, bq1[q], mfma32(a0, bq0[q], (f32x4){0.f, 0.f, 0.f, 0.f}));
                const int c = 16 * nj + fr;
                const float bs = bsq[q];
                float o4[4];
#pragma unroll
                for (int r = 0; r < 4; ++r) { const float sg = sigmoidf_(bs + acc[r]); o4[r] = isA ? sg : -0.60653066f * sg; }
                *(uint2*)(RW + (((size_t)u * 8 + (c >> 6)) * 8 + fld) * 1024 + (c & 63) * 16 + 4 * fq) = make_uint2(pk2bf(o4[0], o4[1]), pk2bf(o4[2], o4[3]));
              }
            }
        }
    }
}
__device__ __forceinline__ void phase_post2(const Params& P, int l, int bid, int nb, int parts) {
    const int tid = otid(), lane = tid & 63, wave = __builtin_amdgcn_readfirstlane(tid >> 6), fr = lane & 15, fq = lane >> 4;
    const bf16_t* Pb = (const bf16_t*)(P.ws + OFF_P);
    const bf16_t* RW = (const bf16_t*)(P.ws + OFF_RW);
    const bf16_t* YF = (const bf16_t*)(P.ws + OFF_YP);
    const bf16_t* YB = YF + (size_t)MROWS * DM;
    const bf16_t* LW = (const bf16_t*)(P.ws + OFF_LW);
    const bf16_t* SG = (const bf16_t*)(P.ws + OFF_SG);
    bf16_t* MIX = (bf16_t*)(P.ws + OFF_MIX);
    const f32x4 z4 = {0.f, 0.f, 0.f, 0.f};
    for (int u = bid; u < MROWS / 16; u += nb) {
        const int r0 = u * 16;
        if (l == 1 && (r0 % LTOT) < CTX) continue;
        if (parts & 1) {
            f32x4 acc[4] = {z4, z4, z4, z4};
            const bf16_t* ap = YF + (size_t)(r0 + fr) * DM + 8 * fq;
            const bf16_t* bp = LW + (size_t)3 * 131072 + (size_t)(l * 256 + 64 * wave + fr) * 256 + 8 * fq;
#pragma unroll
            for (int ks = 0; ks < 8; ++ks) {
                const bf16x8 a = *(const bf16x8*)(ap + 32 * ks);
#pragma unroll
                for (int j = 0; j < 4; ++j) acc[j] = mfma32(a, *(const bf16x8*)(bp + (size_t)(16 * j) * 256 + 32 * ks), acc[j]);
            }
#pragma unroll
            for (int j = 0; j < 4; ++j) {
                const int n = 64 * wave + 16 * j + fr;
                const float gb = P.in[21][l * 256 + n];
#pragma unroll
                for (int r = 0; r < 4; ++r) {
                    const size_t row = (size_t)(r0 + 4 * fq + r);
                    MIX[row * DM + n] = f2bf(bf2f(YF[row * DM + n]) * sigmoidf_(acc[j][r] + gb));
                }
            }
        }
        if (parts & 2) {
            const int i = tid >> 4, c0 = (tid & 15) * 16; const size_t row = (size_t)(r0 + i);
            float o[16], ss = 0.f;
#pragma unroll
            for (int j = 0; j < 16; ++j) { o[j] = bf2f(YF[row * DM + 256 + c0 + j]) + bf2f(YB[row * DM + 256 + c0 + j]); ss += o[j] * o[j]; }
            ss += __shfl_xor(ss, 1, 64); ss += __shfl_xor(ss, 2, 64);
            const float rs = rsqrtf(ss * (1.f / 64.f) + 1e-6f);
#pragma unroll
            for (int j = 0; j < 16; ++j) {
                const float gr = bf2f(Pb[row * PIN + 1280 + c0 + j]);
                MIX[row * DM + 256 + c0 + j] = f2bf(o[j] * rs * P.in[23][l * 256 + c0 + j] * gr);
            }
        }
        if (parts & 4)
#pragma unroll 1
        for (int hh = 0; hh < 2; ++hh) {
            const int h = 2 * wave + hh;
            f32x4 g[4] = {z4, z4, z4, z4};
            const bf16_t* ap = SG + (size_t)(r0 + fr) * 128 + 8 * fq;
            const bf16_t* bp = LW + (size_t)2 * 131072 + (size_t)(l * 512 + h * 64 + fr) * 128 + 8 * fq;
#pragma unroll
            for (int ks = 0; ks < 4; ++ks) {
                const bf16x8 a = *(const bf16x8*)(ap + 32 * ks);
#pragma unroll
                for (int j = 0; j < 4; ++j) g[j] = mfma32(a, *(const bf16x8*)(bp + (size_t)(16 * j) * 128 + 32 * ks), g[j]);
            }
            const bf16_t* gb = RW + ((size_t)u * 8 + h) * 8192 + 4 * fq;
            uint2 fr_[4], fk_[4], fv_[4], fa_[4], fb_[4];
#pragma unroll
            for (int j = 0; j < 4; ++j) {
                const bf16_t* e = gb + (16 * j + fr) * 16;
                fr_[j] = *(const uint2*)e; fk_[j] = *(const uint2*)(e + 1024); fv_[j] = *(const uint2*)(e + 2048); fa_[j] = *(const uint2*)(e + 4096); fb_[j] = *(const uint2*)(e + 5120);
            }
#pragma unroll
            for (int r = 0; r < 4; ++r) {
                const size_t row = (size_t)(r0 + 4 * fq + r);
                float y[4], vv[4], sum = 0.f, bon = 0.f;
#pragma unroll
                for (int j = 0; j < 4; ++j) {
                    const int c = h * 64 + 16 * j + fr;
                    y[j] = bf2f(YF[row * DM + 512 + c]) + bf2f(YB[row * DM + 512 + c]);
                    sum += y[j];
                    const float rr = bfw(r < 2 ? fr_[j].x : fr_[j].y, r & 1), k = bfw(r < 2 ? fk_[j].x : fk_[j].y, r & 1);
                    const float af = bfw(r < 2 ? fa_[j].x : fa_[j].y, r & 1), ab = bfw(r < 2 ? fb_[j].x : fb_[j].y, r & 1);
                    const float ka = P.in[31][l * 512 + c];
                    vv[j] = bfw(r < 2 ? fv_[j].x : fv_[j].y, r & 1);
                    bon += rr * P.in[32][l * 512 + c] * k * (2.f + (af + ab - 2.f) * ka);
                }
#pragma unroll
                for (int o = 1; o < 16; o <<= 1) { sum += __shfl_xor(sum, o, 64); bon += __shfl_xor(bon, o, 64); }
                const float mean = sum * (1.f / 64.f);
                float var = 0.f;
#pragma unroll
                for (int j = 0; j < 4; ++j) { const float d = y[j] - mean; var += d * d; }
#pragma unroll
                for (int o = 1; o < 16; o <<= 1) var += __shfl_xor(var, o, 64);
                const float rs = rsqrtf(var * (1.f / 64.f) + 64e-5f);
#pragma unroll
                for (int j = 0; j < 4; ++j) {
                    const int c = h * 64 + 16 * j + fr;
                    const float yn = (y[j] - mean) * rs * P.in[33][l * 512 + c] + P.in[34][l * 512 + c];
                    MIX[row * DM + 512 + c] = f2bf((yn + bon * vv[j]) * g[j][r]);
                }
            }
        }
    }
}

#define OFF_CTR (OFF_BAR + 14336)
#define ONE (1 << 20)
__device__ __forceinline__ int next_item(const Params& P, int ph, unsigned char* smem) {
    volatile LAS int* slot = (volatile LAS int*)(smem + 65552);
    __syncthreads();
    if (threadIdx.x == 0) *slot = (int)atomicAdd((unsigned*)(P.ws + OFF_CTR) + ph, 1u);
    __syncthreads();
    return __builtin_amdgcn_readfirstlane(*slot);
}
__device__ __forceinline__ void run_phase(const Params& P, int ph, unsigned char* smem, int rep) {
#ifndef ONLY
    if (ph == 0) { phase_prep(P, smem); return; }
    if (ph == 1) { phase_mkh(P, smem); return; }
#else
    if (ph < 2) return;
#endif
    const int l = (ph - 2) / PPL, s = (ph - 2) % PPL;
#ifdef ONLY
    if (s != ONLY) return;
#endif
    switch (s) {
    case 0: gemm3_i8(P.ws + OFF_HI8, DM, P.ws + OFF_WIN8 + (size_t)l * PIN * DM, DM, MROWS, PIN, DM, false, Epi4Inproj8{(bf16_t*)(P.ws + OFF_P), (const float*)(P.ws + OFF_LBT) + l * 512, (bf16_t*)((unsigned char*)P.out + OFF_O_HGT), (const float*)(P.ws + OFF_HIS), (const float*)(P.ws + OFF_WINS) + l * PIN}, smem, 7, 9); break;
    case 1:
        for (;;) {
            int i = next_item(P, ph, smem);
#ifdef PROBE_P1
            if (i >= 2448 && i < 2448 + (PROBE_P1 == 1 ? 1088 : (PROBE_P1 == 2 ? 1088 : 272))) i = i - 2448 + (PROBE_P1 == 1 ? 0 : (PROBE_P1 == 2 ? 1088 : 2176));
            else
#endif
            if (i >= 1088 + 1088 + 272) break;
            if (i >= 272 && i < 1360) hgrn_pass<false>(P, l, smem, i - 272, ONE);
            else if (i >= 1360) phase_rwprep2(P, l, smem, i - 1360, ONE);
            else s5_passA(P, l, i, ONE);
        }
        break;
    case 2:
        for (;;) {
            const int i = next_item(P, ph, smem);
            if (i >= 2176 + 128 + 32) break;
            if (i >= 160) rwkv_passA(P, l, smem, i - 160, ONE);
            else if (i >= 32) hgrn_carry(P, i - 32, ONE);
            else s5_carry(P, l, i, ONE);
        }
        break;
    case 3:
        for (;;) {
            int i = next_item(P, ph, smem);
#ifdef PROBE_P3
            if (i >= 1424 && i < 1424 + (PROBE_P3 == 1 ? 1088 : 272)) i = i - 1424 + (PROBE_P3 == 1 ? 64 : 64 + 1088);
            else
#endif
            if (i >= 1088 + 272 + 64) break;
            if (i < 64) rwkv_passB(P, i, ONE, smem);
            else if (i >= 64 + 272) hgrn_pass<true>(P, l, smem, i - 64 - 272, ONE);
            else s5_passC(P, l, i - 64, ONE);
        }
        break;
    case 4:
        for (;;) {
            const int i = next_item(P, ph, smem);
#ifdef PROBE_C
            if (i >= 2176 && i < 4352) { rwkv_passC<false>(P, l, smem, i - 2176, ONE, PROBE_C); continue; }
            if (i >= 4352) break;
#else
            if (i >= 2176) break;
#endif
            rwkv_passC<false>(P, l, smem, i, ONE);
        }
        break;
    case 5:
        for (;;) {
            const int i = next_item(P, ph, smem);
            if (i >= 3 * 1088) break;
            phase_post2(P, l, i % 1088, ONE, i < 1088 ? 4 : (i < 2176 ? 1 : 2));
        }
        break;
    case 6: gemm3_bf16((const bf16_t*)(P.ws + OFF_MIX), DM, (const bf16_t*)(P.ws + OFF_WOUT) + (size_t)l * DM * DM, DM, MROWS, DM, DM, l == 1, Epi4F32{(float*)(P.ws + OFF_TMP), DM}, smem, 8, 8); phase_tabconv8(P, l); break;
    case 7: phase_ln1(P, l); break;
    case 8: gemm3_i8(P.ws + OFF_H8, DM, P.ws + OFF_WQ8 + (size_t)l * 2048 * DM, DM, MROWS, 2048, DM, l == 1, Epi4Q8{(bf16_t*)(P.ws + OFF_Q), 2048, (const float*)(P.ws + OFF_HS), (const float*)(P.ws + OFF_WQS) + l * 2048}, smem, 8, 8); break;
    case 9: phase_topk2(P, l, smem); break;
    case 10: phase_peerz(P, l, smem); break;
    case 11: phase_gather8(P, l, smem); break;
    }
}

__global__ void __launch_bounds__(256, 2) mega(Params P) {
    __shared__ __attribute__((aligned(16))) unsigned char smem[68608];
#if SINGLE
    cg::grid_group grid = cg::this_grid();
    if (threadIdx.x < 4) ((volatile LAS unsigned*)(smem + 65536))[threadIdx.x] = 0u;
    __syncthreads();
    XcdBarrier xb = xcd_barrier_post((unsigned*)(P.ws + OFF_BAR), (volatile LAS unsigned*)(smem + 65536));
#endif
#ifdef PROBE_T
    unsigned long long tacc_ = 0;
#endif
    for (int ph = P.ph_lo; ph < P.ph_hi; ++ph) {
        int nrep = 1;
#ifdef DUPMASK
        if (ph >= 2 && ((DUPMASK >> ((ph - 2) % PPL)) & 1)) nrep = 2;
#endif
#ifdef DUP1MASK
        if (ph >= 2 + PPL && ((DUP1MASK >> ((ph - 2) % PPL)) & 1)) nrep = 2;
#endif
#ifdef PROBE_P
        if (ph == 0) nrep = 2;
#endif
        for (int rep = 0; rep < nrep; ++rep) {
#ifdef PROBE_T
            const unsigned long long t0_ = __builtin_amdgcn_s_memrealtime();
#endif
            run_phase(P, ph, smem, rep);
#if SINGLE
#ifdef PROBE_T
            const unsigned long long tb_ = __builtin_amdgcn_s_memrealtime();
#endif
            if (ph + 1 < P.ph_hi || rep + 1 < nrep) {
                if (P.ph_hi > NPH) { asm volatile("s_waitcnt vmcnt(0)" ::: "memory"); __syncthreads(); grid.sync(); }
                else xcd_barrier(xb);
            }
#ifdef PROBE_T
            if (PROBE_T == 95) tacc_ += __builtin_amdgcn_s_memrealtime() - tb_;
#endif
#endif
#ifdef PROBE_T
            if (PROBE_T == 99 ? true : PROBE_T == 97 ? (ph < 13) : PROBE_T == 96 ? (ph >= 13) : PROBE_T == 98 ? (ph >= 2 && ((ph - 2) % PPL == 0 || (ph - 2) % PPL == 10)) : (PROBE_T >= 100 ? (ph == PROBE_T - 100) : (ph >= 2 && (ph - 2) % PPL == PROBE_T))) tacc_ += __builtin_amdgcn_s_memrealtime() - t0_;
#endif
        }
    }
#ifdef PROBE_T
    if (blockIdx.x == 0) { const unsigned long long te_ = __builtin_amdgcn_s_memrealtime() + tacc_; while (__builtin_amdgcn_s_memrealtime() < te_) __builtin_amdgcn_s_sleep(8); }
#endif
}

extern "C" void kernel_launch(void* const* d_in, const int* in_sizes, int n_in, void* d_out, int out_size, void* d_ws, size_t ws_size, hipStream_t stream) {
    static int grid = 0;
    if (grid == 0) {
        if (n_in != 39 || ws_size < OFF_END) { fprintf(stderr, "kernel_launch: unexpected n_in %d or ws_size %zu (need %zu)\n", n_in, ws_size, (size_t)OFF_END); grid = -1; return; }
        int dev = 0, cus = 0, per_cu = 0;
        hipGetDevice(&dev);
        hipDeviceGetAttribute(&cus, hipDeviceAttributeMultiprocessorCount, dev);
        hipOccupancyMaxActiveBlocksPerMultiprocessor(&per_cu, mega, 256, 0);
        if (per_cu < 1) per_cu = 1;
        if (per_cu > 2) per_cu = 2;
        grid = cus * per_cu;
    }
    if (grid < 0) return;
    hipMemsetAsync((unsigned char*)d_ws + OFF_BAR, 0, 16384, stream);
    Params p{};
    for (int i = 0; i < 39; ++i) p.in[i] = (const float*)d_in[i];
    p.out = (float*)d_out; p.ws = (unsigned char*)d_ws;
#if SINGLE
    p.ph_lo = 0; p.ph_hi = NPH;
    void* args[] = {&p};
    hipError_t e = hipLaunchCooperativeKernel((void*)mega, dim3(grid), dim3(256), args, 0, stream);
    if (e != hipSuccess) fprintf(stderr, "cooperative launch failed: %s (grid %d)\n", hipGetErrorString(e), grid);
#else
    for (int ph = 0; ph < NPH; ++ph) {
        p.ph_lo = ph; p.ph_hi = ph + 1;
        hipLaunchKernelGGL(mega, dim3(grid), dim3(256), 0, stream, p);
    }
#endif
}
```
